# Optimizing an MI355X kernel written in HIP

```python
import jax, jax.numpy as jnp
from jax import lax
import numpy as np

D_MODEL = 1024
BATCH = 1
SEQ = 16384
DEPTH = 2

N_META = 16
CONV_CH = 512
CONV_K = 31
ATT_HEADS = 8
HEAD_DIM = 64
ATT_WIDTH = ATT_HEADS * HEAD_DIM
IDX_HEADS = 8
IDX_DIM = 64
TOPK_MAX = 256
Q_BLOCK = 128
ROPE_THETA = 10000.0
AB_SPLIT_WIDTHS = (CONV_CH, CONV_CH, ATT_WIDTH, ATT_WIDTH, ATT_WIDTH, IDX_HEADS * IDX_DIM, IDX_DIM, IDX_HEADS)
RNN_WIDTH = 1280
RNN_BLOCKS = 10
RNN_BLOCK_W = RNN_WIDTH // RNN_BLOCKS
RNN_CONV_K = 4
RG_C = 8.0
N_GROUPS = 4
EXPERTS_PER_GROUP = 8
N_EXPERTS = N_GROUPS * EXPERTS_PER_GROUP
TOP_K_INNER = 2
D_EXPERT = 512
EXPERT_BLOCK = 128
LN_EPS = 1e-5
DN_ALPHA = (2 * DEPTH) ** 0.25
DN_BETA = (8 * DEPTH) ** -0.25
N_EVEN = (DEPTH + 1) // 2
N_ODD = DEPTH // 2

kernel_name = 'hybrid_conv_dsa_rglru_hmoe'


def layer_norm(x, g, b):
    xf = x.astype(jnp.float32)
    mu = jnp.mean(xf, axis=-1, keepdims=True)
    var = jnp.mean(jnp.square(xf - mu), axis=-1, keepdims=True)
    y = (xf - mu) * lax.rsqrt(var + LN_EPS) * g.astype(jnp.float32) + b.astype(jnp.float32)
    return y.astype(x.dtype)


def causal_depthwise_conv(x, w, b):
    width, ch = w.shape
    y = lax.conv_general_dilated(x, w[:, None, :].astype(x.dtype), window_strides=(1,),
                                 padding=[(width - 1, 0)], dimension_numbers=('NWC', 'WIO', 'NWC'),
                                 feature_group_count=ch)
    return y + b.astype(x.dtype)


def rope(t, pos):
    d = t.shape[-1]
    half = d // 2
    inv_freq = ROPE_THETA ** (-2.0 * jnp.arange(half, dtype=jnp.float32) / d)
    ang = pos.astype(jnp.float32)[:, None] * inv_freq[None, :]
    cos = jnp.cos(ang)[None, :, None, :]
    sin = jnp.sin(ang)[None, :, None, :]
    t1 = t[..., :half].astype(jnp.float32)
    t2 = t[..., half:].astype(jnp.float32)
    return jnp.concatenate([t1 * cos - t2 * sin, t1 * sin + t2 * cos], axis=-1).astype(t.dtype)


def sparse_index_attention(q, k, v, qi, ki, wi, topk):
    bsz, length = q.shape[:2]
    n_blocks = -(-length // Q_BLOCK)
    padded = n_blocks * Q_BLOCK

    def pad(t):
        return jnp.pad(t, [(0, 0), (0, padded - length)] + [(0, 0)] * (t.ndim - 2))

    q, k, v, qi, ki, wi = (pad(t) for t in (q, k, v, qi, ki, wi))
    key_pos = jnp.arange(padded)
    ki32 = ki.astype(jnp.float32)
    take = jax.vmap(lambda t, i: t[i])

    def to_blocks(t):
        return jnp.moveaxis(t.reshape((bsz, n_blocks, Q_BLOCK) + t.shape[2:]), 1, 0)

    def block(args):
        qb, qib, wib, qpos = args
        logits = jnp.einsum('bqhd,bsd->bqhs', qib.astype(jnp.float32), ki32) * (IDX_DIM ** -0.5)
        score = jnp.einsum('bqhs,bqh->bqs', jax.nn.relu(logits), wib.astype(jnp.float32))
        score = jnp.where((key_pos[None, :] <= qpos[:, None])[None], score, -jnp.inf)
        _, idx = lax.top_k(score, topk)
        valid = idx <= qpos[None, :, None]
        k_sel = take(k, idx)
        v_sel = take(v, idx)
        s = jnp.einsum('bqhd,bqkhd->bqhk', qb.astype(jnp.float32), k_sel.astype(jnp.float32)) * (HEAD_DIM ** -0.5)
        p = jax.nn.softmax(jnp.where(valid[:, :, None, :], s, -jnp.inf), axis=-1)
        return jnp.einsum('bqhk,bqkhd->bqhd', p, v_sel.astype(jnp.float32)).astype(qb.dtype)

    out = lax.map(block, (to_blocks(q), to_blocks(qi), to_blocks(wi), key_pos.reshape(n_blocks, Q_BLOCK)))
    return jnp.moveaxis(out, 0, 1).reshape(bsz, padded, ATT_HEADS, HEAD_DIM)[:, :length]


def conv_sparse_attn_mixer(h, pos, n_keys, w_in, conv_w, conv_b, ln_g, ln_b, w_out):
    bsz, length, _ = h.shape
    offsets = np.cumsum(AB_SPLIT_WIDTHS)[:-1].tolist()
    a_val, a_gate, q, k, v, qi, ki, wi = jnp.split(h @ w_in, offsets, axis=-1)
    a = a_val * jax.nn.sigmoid(a_gate)
    a = jax.nn.silu(layer_norm(causal_depthwise_conv(a, conv_w, conv_b), ln_g, ln_b))
    q = rope(q.reshape(bsz, length, ATT_HEADS, HEAD_DIM), pos)
    k = rope(k.reshape(bsz, length, ATT_HEADS, HEAD_DIM), pos)
    v = v.reshape(bsz, length, ATT_HEADS, HEAD_DIM)
    qi = rope(qi.reshape(bsz, length, IDX_HEADS, IDX_DIM), pos)
    ki = rope(ki[:, :, None, :], pos)[:, :, 0]
    wi = wi * (IDX_HEADS ** -0.5)
    topk = min(TOPK_MAX, n_keys // 4)
    o = sparse_index_attention(q, k, v, qi, ki, wi, topk).reshape(bsz, length, ATT_WIDTH)
    return jnp.concatenate([a, o], axis=-1) @ w_out


def rg_lru(xr, w_a, b_a, w_x, b_x, lam):
    bsz, length, width = xr.shape
    xb = xr.reshape(bsz, length, RNN_BLOCKS, RNN_BLOCK_W)
    r = jax.nn.sigmoid(jnp.einsum('blnc,ncd->blnd', xb, w_a).reshape(bsz, length, width) + b_a).astype(jnp.float32)
    i = jax.nn.sigmoid(jnp.einsum('blnc,ncd->blnd', xb, w_x).reshape(bsz, length, width) + b_x).astype(jnp.float32)
    log_a = -RG_C * r * jax.nn.softplus(-lam.astype(jnp.float32))
    a = jnp.exp(log_a)
    u = jnp.sqrt(-jnp.expm1(2.0 * log_a)) * (i * xr.astype(jnp.float32))

    def combine(left, right):
        a1, b1 = left
        a2, b2 = right
        return a1 * a2, a2 * b1 + b2

    _, hs = lax.associative_scan(combine, (a, u), axis=1)
    return hs.astype(xr.dtype)


def rglru_mixer(h, w_in, conv_w, conv_b, w_a, b_a, w_x, b_x, lam, w_out):
    gate, xr = jnp.split(h @ w_in, 2, axis=-1)
    xr = causal_depthwise_conv(xr, conv_w, conv_b)
    y = rg_lru(xr, w_a, b_a, w_x, b_x, lam)
    return (jax.nn.gelu(gate) * y) @ w_out


def grouped_expert_ffn(xf, eid, w_gate, w_up, w_down):
    n_tok, d = xf.shape
    n_pairs = eid.shape[0]
    n_exp = w_gate.shape[0]
    order = jnp.argsort(eid)
    e_sorted = eid[order]
    counts = jnp.bincount(eid, length=n_exp)
    padded = (counts + EXPERT_BLOCK - 1) // EXPERT_BLOCK * EXPERT_BLOCK
    start = jnp.cumsum(counts) - counts
    pend = jnp.cumsum(padded)
    pstart = pend - padded
    dest = (pstart[e_sorted] + jnp.arange(n_pairs) - start[e_sorted]).astype(jnp.int32)
    n_blocks = -(-(n_pairs + n_exp * (EXPERT_BLOCK - 1)) // EXPERT_BLOCK)
    cap = n_blocks * EXPERT_BLOCK
    tok = jnp.full((cap,), n_tok, jnp.int32).at[dest].set((order // TOP_K_INNER).astype(jnp.int32))
    block_expert = jnp.minimum(jnp.searchsorted(pend, jnp.arange(n_blocks) * EXPERT_BLOCK, side='right'), n_exp - 1)
    x_pad = jnp.concatenate([xf, jnp.zeros((1, d), xf.dtype)], axis=0)
    xb = x_pad[tok].reshape(n_blocks, EXPERT_BLOCK, d)

    def run(args):
        xblk, e = args
        return (jax.nn.silu(xblk @ w_gate[e]) * (xblk @ w_up[e])) @ w_down[e]

    yb = lax.map(run, (xb, block_expert)).reshape(cap, d)
    slot_of_pair = jnp.zeros((n_pairs,), jnp.int32).at[order].set(dest)
    return yb[slot_of_pair]


def hierarchical_moe(h, wg, bg, we, be, w_gate, w_up, w_down):
    bsz, length, d = h.shape
    n_tok = bsz * length
    xf = h.reshape(n_tok, d)
    g_prob = jax.nn.softmax((xf @ wg + bg).astype(jnp.float32), axis=-1)
    g_p, g_idx = lax.top_k(g_prob, 1)
    e_logits = (xf @ we + be).astype(jnp.float32).reshape(n_tok, N_GROUPS, EXPERTS_PER_GROUP)
    e_logits = jnp.take_along_axis(e_logits, g_idx[:, :, None], axis=1)[:, 0]
    e_top, e_idx = lax.top_k(e_logits, TOP_K_INNER)
    gate = g_p * jax.nn.softmax(e_top, axis=-1)
    expert = (g_idx * EXPERTS_PER_GROUP + e_idx).reshape(-1)
    y_pairs = grouped_expert_ffn(xf, expert, w_gate, w_up, w_down).reshape(n_tok, TOP_K_INNER, d)
    y = jnp.einsum('nkd,nk->nd', y_pairs, gate.astype(y_pairs.dtype))
    return y.reshape(bsz, length, d)


def setup_inputs(seed: int = 0) -> dict:
    key = jax.random.key(seed)
    it = iter(jax.random.split(key, 32))

    def nrm(shape, scale):
        return jax.random.normal(next(it), shape, jnp.float32) * scale

    in_ab = int(sum(AB_SPLIT_WIDTHS))
    a0 = jax.random.uniform(next(it), (N_ODD, RNN_WIDTH), jnp.float32, minval=0.9, maxval=0.999)
    s = a0 ** (1.0 / RG_C)
    lam = jnp.log(s) - jnp.log1p(-s)
    return {
        'x': nrm((BATCH, SEQ, D_MODEL), 1.0),
        'meta_tokens': nrm((N_META, D_MODEL), 1.0),
        'ab_w_in': nrm((N_EVEN, D_MODEL, in_ab), D_MODEL ** -0.5),
        'ab_conv_w': nrm((N_EVEN, CONV_K, CONV_CH), CONV_K ** -0.5),
        'ab_conv_b': nrm((N_EVEN, CONV_CH), 0.02),
        'ab_ln_g': 1.0 + nrm((N_EVEN, CONV_CH), 0.02),
        'ab_ln_b': nrm((N_EVEN, CONV_CH), 0.02),
        'ab_w_out': nrm((N_EVEN, CONV_CH + ATT_WIDTH, D_MODEL), (CONV_CH + ATT_WIDTH) ** -0.5 * DN_BETA),
        'c_w_in': nrm((N_ODD, D_MODEL, 2 * RNN_WIDTH), D_MODEL ** -0.5),
        'c_conv_w': nrm((N_ODD, RNN_CONV_K, RNN_WIDTH), RNN_CONV_K ** -0.5),
        'c_conv_b': nrm((N_ODD, RNN_WIDTH), 0.02),
        'c_gate_a_w': nrm((N_ODD, RNN_BLOCKS, RNN_BLOCK_W, RNN_BLOCK_W), RNN_BLOCK_W ** -0.5),
        'c_gate_a_b': nrm((N_ODD, RNN_WIDTH), 0.02),
        'c_gate_x_w': nrm((N_ODD, RNN_BLOCKS, RNN_BLOCK_W, RNN_BLOCK_W), RNN_BLOCK_W ** -0.5),
        'c_gate_x_b': nrm((N_ODD, RNN_WIDTH), 0.02),
        'c_lambda': lam,
        'c_w_out': nrm((N_ODD, RNN_WIDTH, D_MODEL), RNN_WIDTH ** -0.5 * DN_BETA),
        'moe_router_group_w': nrm((DEPTH, D_MODEL, N_GROUPS), D_MODEL ** -0.5),
        'moe_router_group_b': nrm((DEPTH, N_GROUPS), 0.01),
        'moe_router_expert_w': nrm((DEPTH, D_MODEL, N_EXPERTS), D_MODEL ** -0.5),
        'moe_router_expert_b': nrm((DEPTH, N_EXPERTS), 0.01),
        'moe_w_gate': nrm((DEPTH, N_EXPERTS, D_MODEL, D_EXPERT), D_MODEL ** -0.5),
        'moe_w_up': nrm((DEPTH, N_EXPERTS, D_MODEL, D_EXPERT), D_MODEL ** -0.5),
        'moe_w_down': nrm((DEPTH, N_EXPERTS, D_EXPERT, D_MODEL), D_EXPERT ** -0.5 * DN_BETA),
        'ln_mix_g': 1.0 + nrm((DEPTH, D_MODEL), 0.02),
        'ln_mix_b': nrm((DEPTH, D_MODEL), 0.02),
        'ln_ffn_g': 1.0 + nrm((DEPTH, D_MODEL), 0.02),
        'ln_ffn_b': nrm((DEPTH, D_MODEL), 0.02),
    }


def reference(x, meta_tokens, ab_w_in, ab_conv_w, ab_conv_b, ab_ln_g, ab_ln_b, ab_w_out,
              c_w_in, c_conv_w, c_conv_b, c_gate_a_w, c_gate_a_b, c_gate_x_w, c_gate_x_b, c_lambda, c_w_out,
              moe_router_group_w, moe_router_group_b, moe_router_expert_w, moe_router_expert_b,
              moe_w_gate, moe_w_up, moe_w_down, ln_mix_g, ln_mix_b, ln_ffn_g, ln_ffn_b):
    bsz, seq, d = x.shape
    meta = jnp.broadcast_to(meta_tokens[None].astype(x.dtype), (bsz, N_META, d))
    h = jnp.concatenate([meta, x], axis=1)
    pos = jnp.arange(N_META + seq)
    for layer in range(DEPTH):
        j = layer // 2
        if layer % 2 == 0:
            m = conv_sparse_attn_mixer(h, pos, seq, ab_w_in[j], ab_conv_w[j], ab_conv_b[j],
                                       ab_ln_g[j], ab_ln_b[j], ab_w_out[j])
        else:
            m = rglru_mixer(h, c_w_in[j], c_conv_w[j], c_conv_b[j], c_gate_a_w[j], c_gate_a_b[j],
                            c_gate_x_w[j], c_gate_x_b[j], c_lambda[j], c_w_out[j])
        h = layer_norm(DN_ALPHA * h + m, ln_mix_g[layer], ln_mix_b[layer])
        f = hierarchical_moe(h, moe_router_group_w[layer], moe_router_group_b[layer],
                             moe_router_expert_w[layer], moe_router_expert_b[layer],
                             moe_w_gate[layer], moe_w_up[layer], moe_w_down[layer])
        h = layer_norm(DN_ALPHA * h + f, ln_ffn_g[layer], ln_ffn_b[layer])
    return h[:, N_META:]
```

```cpp
#include <hip/hip_runtime.h>
#include <cstdio>
#include <cstdint>
#include <cmath>

#ifndef N_LAUNCH_MODE
#define N_LAUNCH_MODE 1
#endif

#define DEVI __device__ __forceinline__
#define LAS __attribute__((address_space(3)))

constexpr int D = 1024, SEQ = 16384, NMETA = 16, L = SEQ + NMETA;
constexpr int CONV_CH = 512, CONV_K = 31, HD = 64, TOPK = 256;
constexpr int IN_AB = 3144;
constexpr int OFF_AVAL = 0, OFF_AGATE = 512, OFF_Q = 1024, OFF_K = 1536, OFF_V = 2048, OFF_QI = 2560, OFF_KI = 3072, OFF_WI = 3136;
constexpr int RNN_W = 1280, RNN_NB = 10, RNN_BW = 128, RNN_K = 4;
constexpr int NGRP = 4, EPG = 8, NE = 32, DE = 512;
constexpr int NPAIR = 2 * L;
constexpr float LN_EPS = 1e-5f;
constexpr float DN_ALPHA = 1.41421356237f;
constexpr int NTHREADS = 512;
constexpr int LDS_BYTES = 147456;

#define XB_TMO      128
#define XB_XCNT(j)  (256  + 64 * (j))
#define XB_XSUB(j)  (1280 + 64 * (j))
#define XB_XGEN(j)  (2304 + 64 * (j))
#define XB_TOP      3328
#define XB_TOPGEN   3392
#define XCD_BAR_WORDS 3456
#define XB_SPIN_CAP (1u << 22)
DEVI unsigned xb_ld(unsigned* p)              { return __hip_atomic_load(p, __ATOMIC_RELAXED, __HIP_MEMORY_SCOPE_AGENT); }
DEVI unsigned xb_add(unsigned* p, unsigned v) { return __hip_atomic_fetch_add(p, v, __ATOMIC_RELAXED, __HIP_MEMORY_SCOPE_AGENT); }
DEVI unsigned xb_xcc_id() { return (unsigned)__builtin_amdgcn_s_getreg((3 << 11) | 20) & 0xFu; }
#define XB_SPIN(cond, bar) do { unsigned _sp = 0; while (cond) { __builtin_amdgcn_s_sleep(1); \
    if ((++_sp & 255u) == 0u) { if (xb_ld(&(bar)[XB_TMO])) break; if (_sp > XB_SPIN_CAP) { atomicAdd(&(bar)[XB_TMO], 1u); break; } } } } while (0)
struct XcdBarrier { unsigned* bar; unsigned x; volatile LAS unsigned* st; };
DEVI XcdBarrier xcd_barrier_post(unsigned* bar, volatile LAS unsigned* st) {
    XcdBarrier b; b.bar = bar; b.x = xb_xcc_id(); b.st = st;
    if (threadIdx.x == 0) (void)xb_add(&bar[XB_XCNT(b.x)], 1u);
    return b;
}
DEVI void xcd_barrier_complete(unsigned* bar, unsigned x, unsigned& nloc, unsigned& nx) {
    const unsigned G = gridDim.x * gridDim.y * gridDim.z;
    unsigned sum, cnt, mine, sp = 0u;
    for (;;) {
        sum = 0u; cnt = 0u; mine = 0u;
#pragma unroll
        for (unsigned j = 0; j < 16; ++j) { const unsigned c = xb_ld(&bar[XB_XCNT(j)]); sum += c; cnt += (c > 0u) ? 1u : 0u; mine = (j == x) ? c : mine; }
        if (sum == G) break;
        __builtin_amdgcn_s_sleep(1);
        if ((++sp & 255u) == 0u) { if (xb_ld(&bar[XB_TMO])) break; if (sp > XB_SPIN_CAP) { atomicAdd(&bar[XB_TMO], 1u); break; } }
    }
    nloc = mine > 0u ? mine : 1u; nx = cnt > 0u ? cnt : 1u;
}
DEVI void xcd_barrier(const XcdBarrier& b) {
    asm volatile("s_waitcnt vmcnt(0)" ::: "memory");
    __syncthreads();
    if (threadIdx.x == 0) {
        unsigned* bar = b.bar;
        __builtin_amdgcn_s_waitcnt(0);
        unsigned nloc = b.st[0], nx = b.st[1];
        if (nloc == 0u) { xcd_barrier_complete(bar, b.x, nloc, nx); b.st[0] = nloc; b.st[1] = nx; }
        const unsigned old = xb_add(&bar[XB_XSUB(b.x)], 1u);
        const unsigned gen = old / nloc;
        if (old + 1u == (gen + 1u) * nloc) {
            __builtin_amdgcn_fence(__ATOMIC_RELEASE, "agent");
            asm volatile("s_waitcnt vmcnt(0)" ::: "memory");
            const unsigned og = xb_add(&bar[XB_TOP], 1u);
            const unsigned tg = og / nx;
            if (og + 1u == (tg + 1u) * nx) xb_add(&bar[XB_TOPGEN], 1u);
            else XB_SPIN(xb_ld(&bar[XB_TOPGEN]) == tg, bar);
            __builtin_amdgcn_fence(__ATOMIC_ACQUIRE, "agent");
            xb_add(&bar[XB_XGEN(b.x)], 1u);
            asm volatile("s_waitcnt vmcnt(0)" ::: "memory");
        } else {
            XB_SPIN(xb_ld(&bar[XB_XGEN(b.x)]) == gen, bar);
            __builtin_amdgcn_fence(__ATOMIC_ACQUIRE, "agent");
            asm volatile("s_waitcnt vmcnt(0)" ::: "memory");
        }
    }
    __syncthreads();
}

constexpr int LP = 16640;
constexpr int MAXSLOT = 40960;
constexpr int NCHUNK = 257, CP = 272;
constexpr size_t MiB = 1048576;
constexpr size_t WS_CTL = 0;
constexpr size_t CTL_CNT = 16384;
constexpr size_t CTL_CUR = 16384 + 256;
constexpr size_t CTL_BYTES = 32768;
constexpr size_t WS_ROPEC = 32768;
constexpr size_t WS_ROPES = WS_ROPEC + (size_t)LP * 32 * 4;
constexpr size_t WS_EID = WS_ROPES + (size_t)LP * 32 * 4;
constexpr size_t WS_GW = WS_EID + (size_t)NPAIR * 4;
constexpr size_t WS_SLOT = WS_GW + (size_t)NPAIR * 4;
constexpr size_t WS_MTILES = WS_SLOT + (size_t)NPAIR * 4;
constexpr size_t WS_WTA = WS_MTILES + 4096;
constexpr size_t WS_WTX = WS_WTA + (size_t)RNN_NB * 128 * 128 * 2;
constexpr size_t WS_AEND = WS_WTX + (size_t)RNN_NB * 128 * 128 * 2;
constexpr size_t WS_HEND = WS_AEND + (size_t)RNN_W * CP * 4;
constexpr size_t WS_CIN = WS_HEND + (size_t)RNN_W * CP * 4;
constexpr size_t WS_WR = WS_CIN + (size_t)RNN_W * CP * 4;
constexpr size_t WS_BIG = ((WS_WR + (size_t)2 * 64 * 3 * 64 * 16 + 255) / 256) * 256;
constexpr size_t R_WIN0 = 0;
constexpr size_t R_WOUT0 = R_WIN0 + (size_t)3328 * 1024 * 2;
constexpr size_t R_WGU = R_WOUT0 + (size_t)1024 * 1024 * 2;
constexpr size_t R_WD = R_WGU + (size_t)32 * 1024 * 1024 * 2;
constexpr size_t R_WIN1 = R_WD + (size_t)32 * 1024 * 512 * 2;
constexpr size_t R_WOUT1 = R_WIN1 + (size_t)2560 * 1024 * 2;
static_assert(R_WOUT1 + (size_t)1024 * 1280 * 2 <= 112 * MiB, "weights");
constexpr size_t R_A = 112 * MiB;
constexpr size_t R_H1 = 192 * MiB;
constexpr size_t R_H2 = 257 * MiB;
constexpr size_t R_C = 322 * MiB;
constexpr size_t R_GLU = 322 * MiB;
constexpr size_t SZ512 = (size_t)LP * 512 * 2;
constexpr size_t R_Q = R_GLU + SZ512, R_K = R_Q + SZ512, R_V = R_K + SZ512, R_QI = R_V + SZ512, R_KI = R_QI + SZ512, R_WI = R_KI + (size_t)LP * 64 * 2;
static_assert(R_WI + (size_t)LP * 8 * 4 <= 406 * MiB, "in-proj outputs");
constexpr size_t R_GATE = 322 * MiB;
constexpr size_t R_XR = R_GATE + (size_t)LP * 1280 * 2;
static_assert(R_XR + (size_t)LP * 1280 * 2 <= 406 * MiB, "layer-1 in-proj outputs");
constexpr size_t R_HM = 406 * MiB;
constexpr size_t WS_END = WS_BIG + R_HM + (size_t)MAXSLOT * 512 * 2;
static_assert(WS_END <= 512 * MiB, "ws");

struct Args { const float* in[28]; float* out; unsigned char* ws; int ph_lo, ph_hi; };

DEVI int otid() { int v = (int)threadIdx.x; asm volatile("" : "+v"(v)); return v; }
template <int CTRL> DEVI float dpp_f(float v) { return __int_as_float(__builtin_amdgcn_mov_dpp(__float_as_int(v), CTRL, 0xF, 0xF, true)); }
DEVI float wave_sum(float v) {
    v += dpp_f<0xB1>(v); v += dpp_f<0x4E>(v); v += dpp_f<0x141>(v); v += dpp_f<0x140>(v);
    return __int_as_float(__builtin_amdgcn_readlane(__float_as_int(v), 0)) + __int_as_float(__builtin_amdgcn_readlane(__float_as_int(v), 16))
         + __int_as_float(__builtin_amdgcn_readlane(__float_as_int(v), 32)) + __int_as_float(__builtin_amdgcn_readlane(__float_as_int(v), 48));
}
DEVI float wave_max(float v) {
#pragma unroll
    for (int o = 32; o > 0; o >>= 1) v = fmaxf(v, __shfl_xor(v, o));
    return v;
}
DEVI float sigm(float x) { return 1.0f / (1.0f + expf(-x)); }
DEVI float gelu_tanh(float x) { return 0.5f * x * (1.0f + tanhf(0.7978845608028654f * (x + 0.044715f * x * x * x))); }
DEVI unsigned f2key(float f) { unsigned u = __float_as_uint(f); return (u & 0x80000000u) ? ~u : (u | 0x80000000u); }

namespace pg8 {
#define PG8_LAS __attribute__((address_space(3)))
typedef unsigned short bf16_t;
typedef short bf16x8 __attribute__((ext_vector_type(8)));
typedef float f32x4 __attribute__((ext_vector_type(4)));
typedef unsigned u32x4 __attribute__((ext_vector_type(4)));
constexpr int BM = 256, BK = 64, HALF = 128, HTB = HALF * BK * 2  , STAGE_BYTES = 8 * HTB, NXCD = 8, WGM = 8;

__host__ __device__ __forceinline__ int lds_byte(int r, int c) { const int st = (r >> 4) * 2 + (c >> 5), rr = r & 15, cc = c & 31, ob = rr * 64 + cc * 2; return st * 1024 + (ob ^ (((ob >> 9) & 1) << 5)); }
__host__ __device__ __forceinline__ void stage_rc(int b, int& R, int& C) { const int st = b / 1024, sb = b % 1024, swz = sb ^ (((sb >> 9) & 1) << 5); R = (st >> 1) * 16 + swz / 64; C = (st & 1) * 32 + (swz % 64) / 2; }
__host__ __device__ __forceinline__ int perm32(int rho) { const int n = rho >> 4, i = rho & 15; return 8 * (i >> 2) + 4 * n + (i & 3); }

struct Unit { int pm, pn; };
struct Gemm { const bf16_t* A; const bf16_t* Bt; int M, N, K; };

struct StaticOrder {
    int nM, nN, nwg, G, c;
    __host__ __device__ void init(int M, int N, int G_, int c_) { nM = M / BM; nN = N / BM; nwg = nM * nN; G = G_; c = c_; }
    __host__ __device__ bool next(int i, Unit& u) const {
        const long L = (long)i * G + c; if (L >= nwg) return false;
        int wgid = (int)L; { const int q = nwg / NXCD, r = nwg % NXCD, xcd = wgid % NXCD, off = wgid / NXCD; wgid = (xcd < r ? xcd * (q + 1) : r * (q + 1) + (xcd - r) * q) + off; }
        const int nig = WGM * nN, gid = wgid / nig, fm = gid * WGM, gsz = (nM - fm) < WGM ? (nM - fm) : WGM;
        u.pm = fm + ((wgid % nig) % gsz); u.pn = (wgid % nig) / gsz; return true;
    }
    __device__ __forceinline__ void a_ready(const Unit&) const {}
    __device__ __forceinline__ void done(const Unit&) const {}
};

template <class Epi, class Sched>
__device__ __forceinline__ void gemm_phase(PG8_LAS unsigned char* lds, const Gemm g, const Sched& S, const Epi& E) {
    const int tid = threadIdx.x, wid = __builtin_amdgcn_readfirstlane(tid >> 6), lane = tid & 63, wr = wid >> 2, wc = wid & 3, fr = lane & 15, fq = lane >> 4;
    const int K = g.K, nt = K / BK;
    unsigned voffA[2], voffB[2];
#pragma unroll
    for (int i = 0; i < 2; ++i) { int R, C; stage_rc(tid * 16 + i * 8192, R, C); const int Rb = Epi::PERM ? ((R & ~31) + perm32(R & 31)) : R;
        voffA[i] = (unsigned)(R * K + C) * 2u; voffB[i] = (unsigned)(Rb * K + C) * 2u; }
    const size_t kstep = (size_t)(BK * 2);
    const size_t hstep = (size_t)HALF * K * 2;
    const size_t tstep = 2 * hstep;
    const unsigned ldsw = (unsigned)wid * 1024u;
    const int aoff = lds_byte(wr * 64 + fr, fq * 8), boff = lds_byte(wc * 32 + fr, fq * 8);
#define PG8_SA(b, h) (((b) * 2 + (h)) * HTB)
#define PG8_SB(b, h) ((4 + (b) * 2 + (h)) * HTB)
#define PG8_STAGE(bufoff, gbase, voff) do { _Pragma("unroll") for (int _i = 0; _i < 2; ++_i) \
        __builtin_amdgcn_global_load_lds((const unsigned*)((const char*)(gbase) + (voff)[_i]), (PG8_LAS unsigned*)(lds + (bufoff) + ldsw + _i * 8192), 16, 0, 0); } while (0)
#define PG8_LDA(dst, b, h) do { _Pragma("unroll") for (int m = 0; m < 4; ++m) _Pragma("unroll") for (int k = 0; k < 2; ++k) dst[m][k] = *(const PG8_LAS bf16x8*)(lds + PG8_SA(b, h) + aoff + m * 2048 + k * 1024); } while (0)
#define PG8_LDB(dst, b, h) do { _Pragma("unroll") for (int n = 0; n < 2; ++n) _Pragma("unroll") for (int k = 0; k < 2; ++k) dst[n][k] = *(const PG8_LAS bf16x8*)(lds + PG8_SB(b, h) + boff + n * 2048 + k * 1024); } while (0)
#define PG8_MMA(ai, bj, At, Bt) do { __builtin_amdgcn_s_setprio(1); _Pragma("unroll") for (int m = 0; m < 4; ++m) _Pragma("unroll") for (int n = 0; n < 2; ++n) _Pragma("unroll") for (int k = 0; k < 2; ++k) \
        acc[ai][bj][m][n] = __builtin_amdgcn_mfma_f32_16x16x32_bf16(Bt[n][k], At[m][k], acc[ai][bj][m][n], 0, 0, 0); __builtin_amdgcn_s_setprio(0); } while (0)
#define PG8_WAIT_V(n) asm volatile("s_waitcnt vmcnt(" #n ")" ::: "memory")
#define PG8_WAIT_L(n) asm volatile("s_waitcnt lgkmcnt(" #n ")" ::: "memory")
#define PG8_BAR __builtin_amdgcn_s_barrier()
#define PG8_SCHED __builtin_amdgcn_sched_barrier(0)
    Unit cur, nxt; int ui = 0;
    if (!S.next(0, cur)) return;
    f32x4 acc[2][2][4][2];
#pragma unroll
    for (int a = 0; a < 2; ++a)
#pragma unroll
        for (int b = 0; b < 2; ++b)
#pragma unroll
            for (int m = 0; m < 4; ++m)
#pragma unroll
                for (int n = 0; n < 2; ++n) acc[a][b][m][n] = (f32x4){0.f, 0.f, 0.f, 0.f};
    bf16x8 At[4][2], B0[2][2], B1[2][2];
    const char* cA = (const char*)g.A + (size_t)cur.pm * tstep; const char* cB = (const char*)g.Bt + (size_t)cur.pn * tstep;
    S.a_ready(cur);
    PG8_STAGE(PG8_SB(0, 0), cB, voffB); PG8_STAGE(PG8_SA(0, 0), cA, voffA); PG8_STAGE(PG8_SB(0, 1), cB + hstep, voffB); PG8_STAGE(PG8_SA(0, 1), cA + hstep, voffA);
    if (wr == 1) PG8_BAR;
    PG8_WAIT_V(4); PG8_BAR;
    PG8_STAGE(PG8_SB(1, 0), cB + kstep, voffB); PG8_STAGE(PG8_SA(1, 0), cA + kstep, voffA); PG8_STAGE(PG8_SB(1, 1), cB + hstep + kstep, voffB);
    PG8_WAIT_V(6); PG8_BAR;
    for (;;) {
        const bool has_next = S.next(ui + 1, nxt);
        const char* nA = has_next ? (const char*)g.A + (size_t)nxt.pm * tstep : cA; const char* nB = has_next ? (const char*)g.Bt + (size_t)nxt.pn * tstep : cB;
        for (int t = 0; t < nt; t += 2) {
            const bool last = (t == nt - 2);
            const char* a1 = cA + (size_t)(t + 1) * kstep;
            const char* a2 = last ? nA : cA + (size_t)(t + 2) * kstep; const char* b2 = last ? nB : cB + (size_t)(t + 2) * kstep;
            const char* a3 = a2 + kstep; const char* b3 = b2 + kstep;
            if (last && has_next) S.a_ready(nxt);
            PG8_LDB(B0, 0, 0); PG8_SCHED; PG8_LDA(At, 0, 0); PG8_STAGE(PG8_SA(1, 1), a1 + hstep, voffA);
            PG8_WAIT_L(8); PG8_BAR; PG8_WAIT_L(0); PG8_MMA(0, 0, At, B0); PG8_BAR; PG8_SCHED;
            PG8_LDB(B1, 0, 1); PG8_STAGE(PG8_SB(0, 0), b2, voffB);
            PG8_BAR; PG8_WAIT_L(0); PG8_MMA(0, 1, At, B1); PG8_BAR;
            PG8_LDA(At, 0, 1); PG8_STAGE(PG8_SA(0, 0), a2, voffA);
            PG8_BAR; PG8_WAIT_L(0); PG8_MMA(1, 0, At, B0); PG8_BAR; PG8_SCHED;
            PG8_STAGE(PG8_SB(0, 1), b2 + hstep, voffB);
            PG8_WAIT_V(6); PG8_BAR; PG8_MMA(1, 1, At, B1); PG8_BAR;
            PG8_LDB(B0, 1, 0); PG8_SCHED; PG8_LDA(At, 1, 0); PG8_STAGE(PG8_SA(0, 1), a2 + hstep, voffA);
            PG8_WAIT_L(8); PG8_BAR; PG8_WAIT_L(0); PG8_MMA(0, 0, At, B0); PG8_BAR; PG8_SCHED;
            PG8_LDB(B1, 1, 1); PG8_STAGE(PG8_SB(1, 0), b3, voffB);
            PG8_BAR; PG8_WAIT_L(0); PG8_MMA(0, 1, At, B1); PG8_BAR;
            PG8_LDA(At, 1, 1); PG8_STAGE(PG8_SA(1, 0), a3, voffA);
            PG8_BAR; PG8_WAIT_L(0); PG8_MMA(1, 0, At, B0); PG8_BAR; PG8_SCHED;
            PG8_STAGE(PG8_SB(1, 1), b3 + hstep, voffB);
            PG8_WAIT_V(6); PG8_BAR; PG8_MMA(1, 1, At, B1); PG8_BAR;
        }
        if constexpr (!Epi::AFTER_DRAIN) { E(acc, cur, wr, wc, fr, fq); S.done(cur); }
        if (!has_next) break;
#pragma unroll
        for (int a = 0; a < 2; ++a)
#pragma unroll
            for (int b = 0; b < 2; ++b)
#pragma unroll
                for (int m = 0; m < 4; ++m)
#pragma unroll
                    for (int n = 0; n < 2; ++n) acc[a][b][m][n] = (f32x4){0.f, 0.f, 0.f, 0.f};
        cur = nxt; cA = nA; cB = nB; ++ui;
    }
    PG8_WAIT_V(0);
    if (wr == 0) PG8_BAR;
    PG8_BAR;
    if constexpr (Epi::AFTER_DRAIN) { E.fused(acc, cur, wr, wc, fr, fq, lds, wid, lane); S.done(cur); }
#undef PG8_SA
#undef PG8_SB
#undef PG8_STAGE
#undef PG8_LDA
#undef PG8_LDB
#undef PG8_MMA
#undef PG8_WAIT_V
#undef PG8_WAIT_L
#undef PG8_BAR
#undef PG8_SCHED
}
}

DEVI void ln_row1024(float (&y)[16], const float* g, const float* b, int lane) {
    float s = 0.f;
#pragma unroll
    for (int i = 0; i < 16; ++i) s += y[i];
    const float mu = wave_sum(s) * (1.0f / 1024.0f);
    float q = 0.f;
#pragma unroll
    for (int i = 0; i < 16; ++i) { const float d = y[i] - mu; q += d * d; }
    const float rstd = 1.0f / sqrtf(wave_sum(q) * (1.0f / 1024.0f) + LN_EPS);
#pragma unroll
    for (int i = 0; i < 16; ++i) y[i] = (y[i] - mu) * rstd * g[lane + 64 * i] + b[lane + 64 * i];
}

DEVI void route_token(const float (&y)[16], float* ys, int t, int lane, const float* wg, const float* bg, const float* we, const float* be, int* eid, float* gw, unsigned* counts) {
    float lg[36];
#pragma unroll
    for (int j = 0; j < 36; ++j) lg[j] = 0.f;
#pragma unroll
    for (int i = 0; i < 16; ++i) ys[lane + 64 * i] = y[i];
#pragma unroll 1
    for (int i = 0; i < 16; ++i) {
        const int c = lane + 64 * i;
        const float yv = ys[c];
        const float4 g4 = *(const float4*)(wg + (size_t)c * 4);
        lg[0] += yv * g4.x; lg[1] += yv * g4.y; lg[2] += yv * g4.z; lg[3] += yv * g4.w;
#pragma unroll
        for (int j = 0; j < 8; ++j) { const float4 e4 = *(const float4*)(we + (size_t)c * 32 + j * 4);
            lg[4 + j * 4 + 0] += yv * e4.x; lg[4 + j * 4 + 1] += yv * e4.y; lg[4 + j * 4 + 2] += yv * e4.z; lg[4 + j * 4 + 3] += yv * e4.w; }
    }
#pragma unroll
    for (int j = 0; j < 36; ++j) lg[j] = wave_sum(lg[j]);
    if (lane == 0) {
        float gl[4]; int g = 0;
#pragma unroll
        for (int j = 0; j < 4; ++j) gl[j] = lg[j] + bg[j];
#pragma unroll
        for (int j = 1; j < 4; ++j) if (gl[j] > gl[g]) g = j;
        float den = 0.f;
#pragma unroll
        for (int j = 0; j < 4; ++j) den += expf(gl[j] - gl[g]);
        const float gp = 1.0f / den;
        float el[8];
#pragma unroll
        for (int j = 0; j < 8; ++j) { float v = 0.f;
#pragma unroll
            for (int gg = 0; gg < 4; ++gg) v = (gg == g) ? lg[4 + gg * 8 + j] + be[gg * 8 + j] : v;
            el[j] = v; }
        int i1 = 0;
#pragma unroll
        for (int j = 1; j < 8; ++j) if (el[j] > el[i1]) i1 = j;
        int i2 = (i1 == 0) ? 1 : 0;
#pragma unroll
        for (int j = 0; j < 8; ++j) if (j != i1 && el[j] > el[i2]) i2 = j;
        const float ex = expf(el[i2] - el[i1]);
        const float p1 = 1.0f / (1.0f + ex), p2 = ex / (1.0f + ex);
        const int e1 = g * 8 + i1, e2 = g * 8 + i2;
        eid[2 * t] = e1; eid[2 * t + 1] = e2; gw[2 * t] = gp * p1; gw[2 * t + 1] = gp * p2;
        atomicAdd(&counts[e1], 1u); atomicAdd(&counts[e2], 1u);
    }
}


DEVI void ln_row1024v(float (&y)[16], const float* g, const float* b, int lane) {
    float s = 0.f;
#pragma unroll
    for (int i = 0; i < 16; ++i) s += y[i];
    const float mu = wave_sum(s) * (1.0f / 1024.0f);
    float q = 0.f;
#pragma unroll
    for (int i = 0; i < 16; ++i) { const float d = y[i] - mu; q += d * d; }
    const float rstd = 1.0f / sqrtf(wave_sum(q) * (1.0f / 1024.0f) + LN_EPS);
#pragma unroll
    for (int i4 = 0; i4 < 4; ++i4) { const float4 g4 = *(const float4*)(g + 16 * lane + 4 * i4), b4 = *(const float4*)(b + 16 * lane + 4 * i4);
        y[4 * i4] = (y[4 * i4] - mu) * rstd * g4.x + b4.x; y[4 * i4 + 1] = (y[4 * i4 + 1] - mu) * rstd * g4.y + b4.y; y[4 * i4 + 2] = (y[4 * i4 + 2] - mu) * rstd * g4.z + b4.z; y[4 * i4 + 3] = (y[4 * i4 + 3] - mu) * rstd * g4.w + b4.w; }
}
DEVI void combine_row(float (&y)[16], const float* h, const unsigned short* Y0, const unsigned short* Y1, float g0, float g1, int lane) {
    const uint4 a0 = *(const uint4*)(Y0 + 16 * lane), a1 = *(const uint4*)(Y0 + 16 * lane + 8), b0 = *(const uint4*)(Y1 + 16 * lane), b1 = *(const uint4*)(Y1 + 16 * lane + 8);
    const unsigned aw[8] = {a0.x, a0.y, a0.z, a0.w, a1.x, a1.y, a1.z, a1.w}, bw[8] = {b0.x, b0.y, b0.z, b0.w, b1.x, b1.y, b1.z, b1.w};
#pragma unroll
    for (int i4 = 0; i4 < 4; ++i4) { const float4 hv = *(const float4*)(h + 16 * lane + 4 * i4);
        y[4 * i4]     = DN_ALPHA * hv.x + (g0 * __uint_as_float(aw[2 * i4] << 16) + g1 * __uint_as_float(bw[2 * i4] << 16));
        y[4 * i4 + 1] = DN_ALPHA * hv.y + (g0 * __uint_as_float(aw[2 * i4] & 0xFFFF0000u) + g1 * __uint_as_float(bw[2 * i4] & 0xFFFF0000u));
        y[4 * i4 + 2] = DN_ALPHA * hv.z + (g0 * __uint_as_float(aw[2 * i4 + 1] << 16) + g1 * __uint_as_float(bw[2 * i4 + 1] << 16));
        y[4 * i4 + 3] = DN_ALPHA * hv.w + (g0 * __uint_as_float(aw[2 * i4 + 1] & 0xFFFF0000u) + g1 * __uint_as_float(bw[2 * i4 + 1] & 0xFFFF0000u)); }
}
typedef float f32x4v __attribute__((ext_vector_type(4)));
DEVI void ln_route_block(int tb, int ntok, const float* Zsrc, float* Hdst, const float* g, const float* b, const float4* __restrict__ Wr, const float* bg, const float* be,
                         int* eid, float* gw, unsigned* counts, float* sm) {
    const int tid = otid(), lane = tid & 63, wave = tid >> 6;
    for (int i = 0; i < 8; ++i) { const int tl = wave * 8 + i;
        if (tl < ntok) { const size_t t = (size_t)(tb + tl); float y[16];
#pragma unroll
            for (int i4 = 0; i4 < 4; ++i4) { const float4 v = *(const float4*)(Zsrc + t * D + 16 * lane + 4 * i4); y[4 * i4] = v.x; y[4 * i4 + 1] = v.y; y[4 * i4 + 2] = v.z; y[4 * i4 + 3] = v.w; }
            ln_row1024v(y, g, b, lane);
#pragma unroll
            for (int i4 = 0; i4 < 4; ++i4) *(float4*)(Hdst + t * D + 16 * lane + 4 * i4) = make_float4(y[4 * i4], y[4 * i4 + 1], y[4 * i4 + 2], y[4 * i4 + 3]); } }
    asm volatile("s_waitcnt vmcnt(0)" ::: "memory");
    __syncthreads();
    if (wave * 16 < ntok) {
        const int t0 = tb + 16 * wave, row = lane & 15, kg = lane >> 4;
        f32x4v acc[3];
#pragma unroll
        for (int ct = 0; ct < 3; ++ct) acc[ct] = (f32x4v){0.f, 0.f, 0.f, 0.f};
        const float* arow = Hdst + (size_t)(t0 + row) * D + 4 * kg;
#pragma unroll 4
        for (int sstep = 0; sstep < 64; ++sstep) {
            const float4 a4 = *(const float4*)(arow + 16 * sstep);
#pragma unroll
            for (int ct = 0; ct < 3; ++ct) { const float4 b4 = Wr[(sstep * 3 + ct) * 64 + lane];
                acc[ct] = __builtin_amdgcn_mfma_f32_16x16x4f32(a4.x, b4.x, acc[ct], 0, 0, 0); acc[ct] = __builtin_amdgcn_mfma_f32_16x16x4f32(a4.y, b4.y, acc[ct], 0, 0, 0);
                acc[ct] = __builtin_amdgcn_mfma_f32_16x16x4f32(a4.z, b4.z, acc[ct], 0, 0, 0); acc[ct] = __builtin_amdgcn_mfma_f32_16x16x4f32(a4.w, b4.w, acc[ct], 0, 0, 0); }
        }
        float* Lg = sm + wave * 16 * 48;
#pragma unroll
        for (int ct = 0; ct < 3; ++ct)
#pragma unroll
            for (int j = 0; j < 4; ++j) Lg[(4 * kg + j) * 48 + 16 * ct + row] = acc[ct][j];
        asm volatile("s_waitcnt lgkmcnt(0)" ::: "memory");
        if (lane < 16) {
            const int t = t0 + lane; const float* lg = Lg + lane * 48;
            float gl[4]; int gsel = 0;
#pragma unroll
            for (int j = 0; j < 4; ++j) gl[j] = lg[j] + bg[j];
#pragma unroll
            for (int j = 1; j < 4; ++j) if (gl[j] > gl[gsel]) gsel = j;
            float den = 0.f;
#pragma unroll
            for (int j = 0; j < 4; ++j) den += expf(gl[j] - gl[gsel]);
            const float gp = 1.0f / den;
            float el[8];
#pragma unroll
            for (int j = 0; j < 8; ++j) el[j] = lg[4 + gsel * 8 + j] + be[gsel * 8 + j];
            int i1 = 0;
#pragma unroll
            for (int j = 1; j < 8; ++j) if (el[j] > el[i1]) i1 = j;
            int i2 = (i1 == 0) ? 1 : 0;
#pragma unroll
            for (int j = 0; j < 8; ++j) if (j != i1 && el[j] > el[i2]) i2 = j;
            float e1v = el[0], e2v = el[0];
#pragma unroll
            for (int j = 0; j < 8; ++j) { e1v = (j == i1) ? el[j] : e1v; e2v = (j == i2) ? el[j] : e2v; }
            const float ex = expf(e2v - e1v);
            const float p1 = 1.0f / (1.0f + ex), p2 = ex / (1.0f + ex);
            const int e1 = gsel * 8 + i1, e2 = gsel * 8 + i2;
            eid[2 * t] = e1; eid[2 * t + 1] = e2; gw[2 * t] = gp * p1; gw[2 * t + 1] = gp * p2;
            atomicAdd(&counts[e1], 1u); atomicAdd(&counts[e2], 1u);
        }
    }
    __syncthreads();
}

using pg8::f32x4; using pg8::Unit; typedef unsigned short bf16_t;
DEVI float bf2f(unsigned short b) { return __uint_as_float(((unsigned)b) << 16); }
DEVI float bflo(unsigned w) { return __uint_as_float(w << 16); }
DEVI float bfhi(unsigned w) { return __uint_as_float(w & 0xFFFF0000u); }
DEVI unsigned cvt_pk_bf16(float lo, float hi) { unsigned r; asm volatile("v_cvt_pk_bf16_f32 %0, %1, %2" : "=v"(r) : "v"(lo), "v"(hi)); return r; }
DEVI uint2 pack4(const f32x4 v) { return make_uint2(cvt_pk_bf16(v[0], v[1]), cvt_pk_bf16(v[2], v[3])); }
DEVI float fsigm(float x) { return 1.0f / (1.0f + __expf(-x)); }
DEVI unsigned pack4_fp8(const f32x4 v) { int w = __builtin_amdgcn_cvt_pk_fp8_f32(v[0], v[1], 0, false); w = __builtin_amdgcn_cvt_pk_fp8_f32(v[2], v[3], w, true); return (unsigned)w; }

DEVI int in0_srccol(int n) {
    if (n < 1024) { const int G = n >> 5, nn = (n >> 4) & 1, i = n & 15; return (nn ? OFF_AGATE : OFF_AVAL) + 16 * G + i; }
    if (n < 2048 || (n >= 2560 && n < 3072)) {
        const int base = n < 1536 ? OFF_Q : n < 2048 ? OFF_K : OFF_QI; const int loc = n & 511;
        const int G = loc >> 5, nn = (loc >> 4) & 1, i = loc & 15; return base + 64 * (G >> 1) + 32 * nn + 16 * (G & 1) + i; }
    if (n < 2560) return OFF_V + (n - 2048);
    if (n < 3136) { const int loc = n - 3072; const int G = loc >> 5, nn = (loc >> 4) & 1, i = loc & 15; return OFF_KI + 32 * nn + 16 * G + i; }
    if (n < 3144) return OFF_WI + (n - 3136);
    return -1;
}
struct EpiIn0 {
    static constexpr bool PERM = false, AFTER_DRAIN = false;
    bf16_t* GLU; bf16_t* KI; float* WI; const float* ropeC; const float* ropeS; unsigned char* KV8;
    DEVI void operator()(const f32x4 (&acc)[2][2][4][2], const Unit& u, int wr, int wc, int fr, int fq) const {
        const int pn = u.pn; const int rbase = u.pm * 256 + wr * 64 + fr;
        if (pn < 4) {
#pragma unroll
            for (int ai = 0; ai < 2; ++ai)
#pragma unroll
                for (int m = 0; m < 4; ++m) { const size_t row = rbase + ai * 128 + m * 16;
#pragma unroll
                    for (int bj = 0; bj < 2; ++bj) { const int G = 8 * pn + 4 * bj + wc; const f32x4 v = acc[ai][bj][m][0], g = acc[ai][bj][m][1]; f32x4 o;
#pragma unroll
                        for (int j = 0; j < 4; ++j) o[j] = v[j] * fsigm(g[j]);
                        *(uint2*)(GLU + row * 512 + 16 * G + 4 * fq) = pack4(o); } }
        } else if (pn == 8 || pn == 9) {
#pragma unroll
            for (int ai = 0; ai < 2; ++ai)
#pragma unroll
                for (int m = 0; m < 4; ++m) { const size_t row = rbase + ai * 128 + m * 16;
#pragma unroll
                    for (int bj = 0; bj < 2; ++bj)
#pragma unroll
                        for (int n = 0; n < 2; ++n) { const int col = 256 * (pn - 8) + 128 * bj + 32 * wc + 16 * n + 4 * fq;
                            *(unsigned*)(KV8 + row * 1024 + (size_t)(col >> 3) * 16 + 8 + (col & 7)) = pack4_fp8(acc[ai][bj][m][n]); } }
        } else if (pn == 12) {
            if (wc < 2) { const int d0 = 16 * wc + 4 * fq;
#pragma unroll
                for (int ai = 0; ai < 2; ++ai)
#pragma unroll
                    for (int m = 0; m < 4; ++m) { const size_t row = rbase + ai * 128 + m * 16;
                        const f32x4 c = *(const f32x4*)(ropeC + row * 32 + d0), s = *(const f32x4*)(ropeS + row * 32 + d0);
                        const f32x4 t1 = acc[ai][0][m][0], t2 = acc[ai][0][m][1];
                        *(uint2*)(KI + row * 64 + d0) = pack4(t1 * c - t2 * s); *(uint2*)(KI + row * 64 + 32 + d0) = pack4(t1 * s + t2 * c); }
            } else if (wc == 2 && fq < 2) {
#pragma unroll
                for (int ai = 0; ai < 2; ++ai)
#pragma unroll
                    for (int m = 0; m < 4; ++m) { const size_t row = rbase + ai * 128 + m * 16; *(f32x4*)(WI + row * 8 + 4 * fq) = acc[ai][0][m][0] * 0.35355339059327373f; }
            }
        } else {
            bf16_t* dst = GLU + (size_t)(pn < 6 ? 1 : pn < 8 ? 2 : 4) * LP * 512; const int pl = pn & 1; const int d0 = 16 * (wc & 1) + 4 * fq;
#pragma unroll
            for (int ai = 0; ai < 2; ++ai)
#pragma unroll
                for (int m = 0; m < 4; ++m) { const size_t row = rbase + ai * 128 + m * 16;
                    const f32x4 c = *(const f32x4*)(ropeC + row * 32 + d0), s = *(const f32x4*)(ropeS + row * 32 + d0);
#pragma unroll
                    for (int bj = 0; bj < 2; ++bj) { const int hh = 4 * pl + 2 * bj + (wc >> 1); const f32x4 t1 = acc[ai][bj][m][0], t2 = acc[ai][bj][m][1];
                        if (pn == 6 || pn == 7) { const int da = 64 * hh + d0, db = da + 32;
                            *(unsigned*)(KV8 + row * 1024 + (size_t)(da >> 3) * 16 + (da & 7)) = pack4_fp8(t1 * c - t2 * s); *(unsigned*)(KV8 + row * 1024 + (size_t)(db >> 3) * 16 + (db & 7)) = pack4_fp8(t1 * s + t2 * c);
                        } else { *(uint2*)(dst + row * 512 + 64 * hh + d0) = pack4(t1 * c - t2 * s); *(uint2*)(dst + row * 512 + 64 * hh + 32 + d0) = pack4(t1 * s + t2 * c); } } }
        }
    }
};
struct EpiRes0 {
    static constexpr bool PERM = false, AFTER_DRAIN = false;
    const float* x; const float* meta; float* Z;
    DEVI void operator()(const f32x4 (&acc)[2][2][4][2], const Unit& u, int wr, int wc, int fr, int fq) const {
        const int rbase = u.pm * 256 + wr * 64 + fr, cbase = u.pn * 256 + wc * 32 + 4 * fq;
#pragma unroll
        for (int ai = 0; ai < 2; ++ai)
#pragma unroll
            for (int m = 0; m < 4; ++m) { const int row = rbase + ai * 128 + m * 16;
                if (row < L) { const float* rs = row < NMETA ? meta + (size_t)row * D : x + (size_t)(row - NMETA) * D;
#pragma unroll
                    for (int bj = 0; bj < 2; ++bj)
#pragma unroll
                        for (int n = 0; n < 2; ++n) { const int col = cbase + 128 * bj + 16 * n; const f32x4 r4 = *(const f32x4*)(rs + col); *(f32x4*)(Z + (size_t)row * D + col) = r4 * DN_ALPHA + acc[ai][bj][m][n]; } } }
    }
};
struct EpiGateUp {
    static constexpr bool PERM = false, AFTER_DRAIN = false;
    bf16_t* Hm;
    DEVI void operator()(const f32x4 (&acc)[2][2][4][2], const Unit& u, int wr, int wc, int fr, int fq) const {
        const int pl = u.pn & 3; const int rbase = u.pm * 256 + wr * 64 + fr;
#pragma unroll
        for (int ai = 0; ai < 2; ++ai)
#pragma unroll
            for (int m = 0; m < 4; ++m) { const size_t row = rbase + ai * 128 + m * 16;
#pragma unroll
                for (int bj = 0; bj < 2; ++bj) { const int G = 8 * pl + 4 * bj + wc; const f32x4 g = acc[ai][bj][m][0], up = acc[ai][bj][m][1]; f32x4 o;
#pragma unroll
                    for (int j = 0; j < 4; ++j) o[j] = g[j] * fsigm(g[j]) * up[j];
                    *(uint2*)(Hm + row * 512 + 16 * G + 4 * fq) = pack4(o); } }
    }
};
struct EpiDown {
    static constexpr bool PERM = false, AFTER_DRAIN = false;
    bf16_t* Y;
    DEVI void operator()(const f32x4 (&acc)[2][2][4][2], const Unit& u, int wr, int wc, int fr, int fq) const {
        const int pl = u.pn & 3; const int rbase = u.pm * 256 + wr * 64 + fr, cbase = pl * 256 + wc * 32 + 4 * fq;
#pragma unroll
        for (int ai = 0; ai < 2; ++ai)
#pragma unroll
            for (int m = 0; m < 4; ++m) { const size_t row = rbase + ai * 128 + m * 16;
#pragma unroll
                for (int bj = 0; bj < 2; ++bj)
#pragma unroll
                    for (int n = 0; n < 2; ++n) *(uint2*)(Y + row * 1024 + cbase + 128 * bj + 16 * n) = pack4(acc[ai][bj][m][n]); }
    }
};
struct MoeOrder {
    const int* mt; int nunits, G, c;
    DEVI void init(const int* t, int G_, int c_) { mt = t; nunits = t[0] * 4; G = G_; c = c_; }
    DEVI bool next(int i, Unit& u) const { const int li = i * G + c; if (li >= nunits) return false; const int ti = li >> 2; u.pm = ti; u.pn = mt[4 + ti] * 4 + (li & 3); return true; }
    DEVI void a_ready(const Unit&) const {}
    DEVI void done(const Unit&) const {}
};

template <class F> DEVI void tr_tile(bf16_t* dst, int K, int n0, int k0, F src, float* sm) {
    const int tid = otid();
    __syncthreads();
    { const int nn = tid & 63, kb = tid >> 6;
#pragma unroll
      for (int p = 0; p < 8; ++p) { const int kk = kb + 8 * p; sm[kk * 65 + nn] = src(n0 + nn, k0 + kk); } }
    __syncthreads();
    { const int nn = tid >> 3, kq = (tid & 7) * 8; float v[8];
#pragma unroll
      for (int j = 0; j < 8; ++j) v[j] = sm[(kq + j) * 65 + nn];
      uint4 w; w.x = cvt_pk_bf16(v[0], v[1]); w.y = cvt_pk_bf16(v[2], v[3]); w.z = cvt_pk_bf16(v[4], v[5]); w.w = cvt_pk_bf16(v[6], v[7]);
      *(uint4*)(dst + (size_t)(n0 + nn) * K + k0 + kq) = w; }
}

struct TrJob { bf16_t* dst; const float* s0; const float* s1; int K, n0, k0, ld, mode; };
DEVI float tr_src(const TrJob& J, int n, int k) {
    if (J.mode == 0) return J.s0[(size_t)k * J.ld + n];
    if (J.mode == 1) { const int sc = in0_srccol(n); return sc < 0 ? 0.f : J.s0[(size_t)k * IN_AB + sc]; }
    const int ch = (n >> 5) * 16 + (n & 15); return ((n >> 4) & 1) ? J.s1[(size_t)k * DE + ch] : J.s0[(size_t)k * DE + ch];
}
DEVI void tr_fetch(const TrJob& J, float (&v)[8]) {
    const int tid = otid(), nn = tid & 63, kb = tid >> 6;
#pragma unroll
    for (int p = 0; p < 8; ++p) v[p] = tr_src(J, J.n0 + nn, J.k0 + kb + 8 * p);
}
DEVI void tr_commit(const TrJob& J, const float (&v)[8], float* sm) {
    const int tid = otid();
    __syncthreads();
    { const int nn = tid & 63, kb = tid >> 6;
#pragma unroll
      for (int p = 0; p < 8; ++p) sm[(kb + 8 * p) * 65 + nn] = v[p]; }
    __syncthreads();
    { const int nn = tid >> 3, kq = (tid & 7) * 8; float x[8];
#pragma unroll
      for (int j = 0; j < 8; ++j) x[j] = sm[(kq + j) * 65 + nn];
      uint4 w; w.x = cvt_pk_bf16(x[0], x[1]); w.y = cvt_pk_bf16(x[2], x[3]); w.z = cvt_pk_bf16(x[4], x[5]); w.w = cvt_pk_bf16(x[6], x[7]);
      *(uint4*)(J.dst + (size_t)(J.n0 + nn) * J.K + J.k0 + kq) = w; }
}
template <class Dec> DEVI void tr_run(int njobs, Dec dec, float* sm) {
    int j = blockIdx.x; const int G = gridDim.x;
    TrJob Ja{}, Jb{}; float va[8], vb[8];
    if (j < njobs) { Ja = dec(j); tr_fetch(Ja, va); }
    while (j < njobs) {
        int jn = j + G; if (jn < njobs) { Jb = dec(jn); tr_fetch(Jb, vb); }
        tr_commit(Ja, va, sm);
        j = jn; if (j >= njobs) break;
        jn = j + G; if (jn < njobs) { Ja = dec(jn); tr_fetch(Ja, va); }
        tr_commit(Jb, vb, sm);
        j = jn;
    }
    __syncthreads();
}

DEVI void moe_dispatch_mfma(const float* H, const int* eid, const unsigned* counts, unsigned* cursor, int* slot, int* mtiles, bf16_t* Xperm, int* sm_i, int gwave, int nwaves, int lane, int p_begin) {
    if (otid() == 0) { int o = 0; for (int e = 0; e < NE; ++e) { sm_i[e] = o; o += (((int)counts[e] + 255) >> 8) << 8; } }
    __syncthreads();
    for (int pb = p_begin + gwave * 16; pb < NPAIR; pb += nwaves * 16) {
        int sl = 0;
        if (lane < 16 && pb + lane < NPAIR) { const int e = eid[pb + lane]; sl = sm_i[e] + (int)atomicAdd(&cursor[e], 1u); slot[pb + lane] = sl; }
#pragma unroll 4
        for (int k = 0; k < 16; ++k) { const int p = pb + k; if (p >= NPAIR) break;
            const int s = __shfl(sl, k);
            const float4* src = (const float4*)(H + (size_t)(p >> 1) * D); uint2* dst = (uint2*)(Xperm + (size_t)s * D);
#pragma unroll
            for (int r = 0; r < 4; ++r) { const float4 v = src[lane + 64 * r]; dst[lane + 64 * r] = make_uint2(cvt_pk_bf16(v.x, v.y), cvt_pk_bf16(v.z, v.w)); } }
    }
    if (blockIdx.x == 0 && otid() == 0) { int n = 0; for (int e = 0; e < NE; ++e) { const int nt = ((int)counts[e] + 255) >> 8; for (int i = 0; i < nt; ++i) mtiles[4 + n++] = e; } mtiles[0] = n; }
    __syncthreads();
}

DEVI float gelu_fast(float x) { return x * fsigm(1.5957691216057308f * (x + 0.044715f * x * x * x)); }
struct EpiIn1 {
    static constexpr bool PERM = false, AFTER_DRAIN = false;
    bf16_t* G;
    DEVI void operator()(const f32x4 (&acc)[2][2][4][2], const Unit& u, int wr, int wc, int fr, int fq) const {
        const int pn = u.pn; const bool is_gate = pn < 5; const int rbase = u.pm * 256 + wr * 64 + fr;
        bf16_t* dst = G + (is_gate ? (size_t)0 : (size_t)LP * RNN_W) + (size_t)((is_gate ? pn : pn - 5) * 256 + wc * 32 + 4 * fq);
#pragma unroll
        for (int ai = 0; ai < 2; ++ai)
#pragma unroll
            for (int m = 0; m < 4; ++m) { const size_t row = rbase + ai * 128 + m * 16;
#pragma unroll
                for (int bj = 0; bj < 2; ++bj)
#pragma unroll
                    for (int n = 0; n < 2; ++n) { f32x4 v = acc[ai][bj][m][n];
                        if (is_gate) {
#pragma unroll
                            for (int j = 0; j < 4; ++j) v[j] = gelu_fast(v[j]); }
                        *(uint2*)(dst + row * RNN_W + 128 * bj + 16 * n) = pack4(v); } }
    }
};
struct EpiRes1 {
    static constexpr bool PERM = false, AFTER_DRAIN = false;
    const float* R; float* Z;
    DEVI void operator()(const f32x4 (&acc)[2][2][4][2], const Unit& u, int wr, int wc, int fr, int fq) const {
        const int rbase = u.pm * 256 + wr * 64 + fr, cbase = u.pn * 256 + wc * 32 + 4 * fq;
#pragma unroll
        for (int ai = 0; ai < 2; ++ai)
#pragma unroll
            for (int m = 0; m < 4; ++m) { const size_t row = rbase + ai * 128 + m * 16;
#pragma unroll
                for (int bj = 0; bj < 2; ++bj)
#pragma unroll
                    for (int n = 0; n < 2; ++n) { const int col = cbase + 128 * bj + 16 * n; const f32x4 r4 = *(const f32x4*)(R + row * D + col); *(f32x4*)(Z + row * D + col) = r4 * DN_ALPHA + acc[ai][bj][m][n]; } }
    }
};

typedef short bf16x8_t __attribute__((ext_vector_type(8)));
template <bool FINAL>
DEVI void rglru_unit(int c, int nb, const bf16_t* __restrict__ XR, const bf16_t* __restrict__ GATEg, const bf16_t* __restrict__ Wta, const bf16_t* __restrict__ Wtx,
                     const float* __restrict__ cw, const float* __restrict__ cb, const float* __restrict__ ba, const float* __restrict__ bx, const float* __restrict__ lam,
                     float* __restrict__ Aend, float* __restrict__ Hend, const float* __restrict__ CIN, bf16_t* __restrict__ YY, unsigned char* lds) {
    const int tid = otid(), lane = tid & 63, w = tid >> 6, col = lane & 15, quad = lane >> 4;
    bf16_t* xcb = (bf16_t*)lds;
    float* xcf = (float*)(lds + 64 * 136 * 2);
    const int t0 = c * 64, ch0 = nb * RNN_BW;
    bf16x8_t fa[4], fx[4];
    { const size_t wrow = ((size_t)nb * 128 + 16 * w + col) * 128 + 8 * quad;
#pragma unroll
      for (int ks = 0; ks < 4; ++ks) { fa[ks] = *(const bf16x8_t*)(Wta + wrow + 32 * ks); fx[ks] = *(const bf16x8_t*)(Wtx + wrow + 32 * ks); } }
    const int ch = ch0 + 16 * w + col;
    const float bav = ba[ch], bxv = bx[ch], lamv = lam[ch];
    const float cinv = FINAL ? CIN[(size_t)ch * CP + c] : 0.f;
    __syncthreads();
    {
        const int c8 = tid & 15, tr = tid >> 4;
        float wv[4][8], bv[8];
#pragma unroll
        for (int j = 0; j < 4; ++j) { const float4 w0 = *(const float4*)(cw + j * RNN_W + ch0 + 8 * c8), w1 = *(const float4*)(cw + j * RNN_W + ch0 + 8 * c8 + 4);
            wv[j][0] = w0.x; wv[j][1] = w0.y; wv[j][2] = w0.z; wv[j][3] = w0.w; wv[j][4] = w1.x; wv[j][5] = w1.y; wv[j][6] = w1.z; wv[j][7] = w1.w; }
        { const float4 b0 = *(const float4*)(cb + ch0 + 8 * c8), b1 = *(const float4*)(cb + ch0 + 8 * c8 + 4); bv[0] = b0.x; bv[1] = b0.y; bv[2] = b0.z; bv[3] = b0.w; bv[4] = b1.x; bv[5] = b1.y; bv[6] = b1.z; bv[7] = b1.w; }
#pragma unroll
        for (int half = 0; half < 2; ++half) { const int tl = tr + 32 * half, t = t0 + tl;
            float v[8];
#pragma unroll
            for (int i = 0; i < 8; ++i) v[i] = bv[i];
#pragma unroll
            for (int j = 0; j < 4; ++j) { const int tt = t - 3 + j;
                if (tt >= 0) { const uint4 xv = *(const uint4*)(XR + (size_t)tt * RNN_W + ch0 + 8 * c8);
                    v[0] += wv[j][0] * bflo(xv.x); v[1] += wv[j][1] * bfhi(xv.x); v[2] += wv[j][2] * bflo(xv.y); v[3] += wv[j][3] * bfhi(xv.y);
                    v[4] += wv[j][4] * bflo(xv.z); v[5] += wv[j][5] * bfhi(xv.z); v[6] += wv[j][6] * bflo(xv.w); v[7] += wv[j][7] * bfhi(xv.w); } }
            *(float4*)(xcf + tl * 132 + 8 * c8) = make_float4(v[0], v[1], v[2], v[3]); *(float4*)(xcf + tl * 132 + 8 * c8 + 4) = make_float4(v[4], v[5], v[6], v[7]);
            uint4 pk; pk.x = cvt_pk_bf16(v[0], v[1]); pk.y = cvt_pk_bf16(v[2], v[3]); pk.z = cvt_pk_bf16(v[4], v[5]); pk.w = cvt_pk_bf16(v[6], v[7]);
            *(uint4*)(xcb + tl * 136 + 8 * c8) = pk; }
    }
    __syncthreads();
    f32x4 ca[4], cx[4];
    {
#pragma unroll
        for (int mt = 0; mt < 4; ++mt) { ca[mt] = (f32x4){0.f, 0.f, 0.f, 0.f}; cx[mt] = (f32x4){0.f, 0.f, 0.f, 0.f};
#pragma unroll
            for (int ks = 0; ks < 4; ++ks) { const bf16x8_t af = *(const bf16x8_t*)(xcb + (16 * mt + col) * 136 + 32 * ks + 8 * quad);
                ca[mt] = __builtin_amdgcn_mfma_f32_16x16x32_bf16(af, fa[ks], ca[mt], 0, 0, 0);
                cx[mt] = __builtin_amdgcn_mfma_f32_16x16x32_bf16(af, fx[ks], cx[mt], 0, 0, 0); } }
    }
    const float sp = log1pf(expf(-lamv));
    float av[4][4], uv[4][4], As[4], Hs[4];
#pragma unroll
    for (int mt = 0; mt < 4; ++mt) { float A = 1.f, H = 0.f;
#pragma unroll
        for (int j = 0; j < 4; ++j) { const int tl = 16 * mt + 4 * quad + j;
            const float xcv = xcf[tl * 132 + 16 * w + col];
            const float r = fsigm(ca[mt][j] + bav), ig = fsigm(cx[mt][j] + bxv);
            const float la = -8.0f * r * sp;
            const float x2 = 2.0f * la;
            float em1 = x2 * (1.0f + x2 * (0.5f + x2 * (0.16666667f + x2 * (0.041666668f + x2 * (0.0083333338f + x2 * (0.0013888889f + x2 * 0.0001984127f))))));
            if (x2 < -0.5f) em1 = expm1f(x2);
            float a_ = __expf(la), u_ = sqrtf(-em1) * (ig * xcv);
            if (t0 + tl >= L) { a_ = 1.f; u_ = 0.f; }
            av[mt][j] = a_; uv[mt][j] = u_; H = a_ * H + u_; A *= a_; }
        As[mt] = A; Hs[mt] = H; }
    float carry = cinv, prod = 1.f, hin[4];
#pragma unroll
    for (int s = 0; s < 16; ++s) { const int mt = s >> 2, q = s & 3;
        if (quad == q) hin[mt] = carry;
        const float nw = As[mt] * carry + Hs[mt], np = As[mt] * prod;
        carry = __shfl(nw, q * 16 + col); prod = __shfl(np, q * 16 + col); }
    if (!FINAL) {
        if (quad == 0) { Aend[(size_t)ch * CP + c] = prod; Hend[(size_t)ch * CP + c] = carry; }
    } else {
#pragma unroll
        for (int mt = 0; mt < 4; ++mt) { float h = hin[mt];
#pragma unroll
            for (int j = 0; j < 4; ++j) { h = av[mt][j] * h + uv[mt][j]; xcf[(16 * mt + 4 * quad + j) * 132 + 16 * w + col] = h; } }
        __syncthreads();
        const int c8 = tid & 15, tr = tid >> 4;
#pragma unroll
        for (int half = 0; half < 2; ++half) { const int tl = tr + 32 * half, t = t0 + tl;
            if (t >= NMETA && t < L) {
                const float4 h0 = *(const float4*)(xcf + tl * 132 + 8 * c8), h1 = *(const float4*)(xcf + tl * 132 + 8 * c8 + 4);
                const uint4 g = *(const uint4*)(GATEg + (size_t)t * RNN_W + ch0 + 8 * c8);
                uint4 pk; pk.x = cvt_pk_bf16(bflo(g.x) * h0.x, bfhi(g.x) * h0.y); pk.y = cvt_pk_bf16(bflo(g.y) * h0.z, bfhi(g.y) * h0.w);
                pk.z = cvt_pk_bf16(bflo(g.z) * h1.x, bfhi(g.z) * h1.y); pk.w = cvt_pk_bf16(bflo(g.w) * h1.z, bfhi(g.w) * h1.w);
                *(uint4*)(YY + (size_t)t * RNN_W + ch0 + 8 * c8) = pk; } }
    }
}

constexpr int SW = 544;
constexpr int CB = 704;
constexpr int NTILE = L / 16;
typedef float f32x16 __attribute__((ext_vector_type(16)));
typedef float f32x2v __attribute__((ext_vector_type(2)));
constexpr int HROW = 2112;
constexpr int IL_HIST = 0, IL_CKEY = 0, IL_CIDX = 16 * CB * 4, IL_HIST2 = 2 * 16 * CB * 4, IL_ROWB = IL_HIST2 + 16 * 256 * 4, IL_WI = 16 * HROW * 4, IL_QST = IL_WI + 512, IL_QST2 = IL_QST + 256, IL_CCNT = IL_QST2 + 256, IL_FLAG = IL_CCNT + 64;
static_assert(IL_ROWB + 8 * SW * 4 <= IL_WI && IL_FLAG + 64 <= LDS_BYTES - 16, "indexer LDS");

DEVI float relu_i(float x) { const int v = __float_as_int(x); return __int_as_float(v > 0 ? v : 0); }
DEVI int hpos(unsigned w) { return (int)(w + (w >> 5)); }
template <int PASS, bool L0>
DEVI void idx_sweep(int q0, int nkb, int wave, int lane, const bf16x8_t (&Af)[4][4], const bf16_t* __restrict__ KI, unsigned char* lds, unsigned* __restrict__ SELM) {
    const int l31 = lane & 31, h2 = lane >> 5;
    unsigned* hist = (unsigned*)(lds + IL_HIST);
    const float* wiL = (const float*)(lds + IL_WI);
    const uint4* qst = (const uint4*)(lds + IL_QST);
    const uint4* qst2 = (const uint4*)(lds + IL_QST2);
    unsigned* ckey = (unsigned*)(lds + IL_CKEY); unsigned* cidx = (unsigned*)(lds + IL_CIDX); unsigned* ccnt = (unsigned*)(lds + IL_CCNT);
    const bf16_t* kp = KI + (size_t)l31 * 64 + 8 * h2;
    bf16x8_t Bn[4];
    if (wave < nkb) {
#pragma unroll
        for (int ks = 0; ks < 4; ++ks) Bn[ks] = *(const bf16x8_t*)(kp + (size_t)wave * 2048 + 16 * ks); }
    for (int kb = wave; kb < nkb; kb += 8) {
        const int s = kb * 32 + l31;
        bf16x8_t Bf[4];
#pragma unroll
        for (int ks = 0; ks < 4; ++ks) Bf[ks] = Bn[ks];
        if (kb + 8 < nkb) {
#pragma unroll
            for (int ks = 0; ks < 4; ++ks) Bn[ks] = *(const bf16x8_t*)(kp + (size_t)(kb + 8) * 2048 + 16 * ks); }
        f32x16 acc[4];
#pragma unroll
        for (int rb = 0; rb < 4; ++rb) {
#pragma unroll
            for (int i = 0; i < 16; ++i) acc[rb][i] = 0.f; }
#pragma unroll
        for (int ks = 0; ks < 4; ++ks)
#pragma unroll
            for (int rb = 0; rb < 4; ++rb) acc[rb] = __builtin_amdgcn_mfma_f32_32x32x16_bf16(Af[rb][ks], Bf[ks], acc[rb], 0, 0, 0);
        const bool edge = kb * 32 + 31 > q0;
#pragma unroll
        for (int rb = 0; rb < 4; ++rb) {
            const int qa = 4 * rb + 2 * h2;
            float4 w[2][2]; uint4 st[2];
#pragma unroll
            for (int e = 0; e < 2; ++e) { w[e][0] = *(const float4*)(wiL + (qa + e) * 8); w[e][1] = *(const float4*)(wiL + (qa + e) * 8 + 4);
                if (PASS == 2) st[e] = qst2[qa + e]; else if (!L0) st[e] = qst[qa + e]; }
#pragma unroll
            for (int e = 0; e < 2; ++e) {
                const int qs = qa + e;
                f32x2v s2 = (f32x2v){relu_i(acc[rb][8 * e + 0]), relu_i(acc[rb][8 * e + 1])} * (f32x2v){w[e][0].x, w[e][0].y};
                s2 = (f32x2v){relu_i(acc[rb][8 * e + 2]), relu_i(acc[rb][8 * e + 3])} * (f32x2v){w[e][0].z, w[e][0].w} + s2;
                s2 = (f32x2v){relu_i(acc[rb][8 * e + 4]), relu_i(acc[rb][8 * e + 5])} * (f32x2v){w[e][1].x, w[e][1].y} + s2;
                s2 = (f32x2v){relu_i(acc[rb][8 * e + 6]), relu_i(acc[rb][8 * e + 7])} * (f32x2v){w[e][1].z, w[e][1].w} + s2;
                const float sc = s2[0] + s2[1];
                const bool valid = !edge || s <= q0 + qs;
                const unsigned key = f2key(sc);
                if (PASS == 1) {
                    if (L0) { if (valid) { const unsigned bin = key >> 20; atomicAdd(&hist[qs * HROW + hpos(bin >> 1)], (bin & 1u) ? 0x10000u : 1u); } }
                    else if (valid && (key & st[e].x) == st[e].y) { const unsigned bin = (key >> st[e].z) & st[e].w; atomicAdd(&hist[qs * HROW + hpos(bin >> 1)], (bin & 1u) ? 0x10000u : 1u); }
                } else {
                    const bool all = st[e].z == 0xFFFFFFFFu;
                    const bool sel = valid && (all || key >= st[e].y);
                    const bool cnd = valid && !all && key >= st[e].x && key < st[e].y;
                    const unsigned long long bal = __ballot(sel);
                    if (l31 == 0) SELM[(size_t)(q0 + qs) * SW + kb] = h2 ? (unsigned)(bal >> 32) : (unsigned)bal;
                    if (cnd) { const unsigned n = atomicAdd(&ccnt[qs], 1u); if (n < (unsigned)CB) { ckey[qs * CB + n] = key; cidx[qs * CB + n] = (unsigned)s; } }
                }
            }
        }
    }
}

DEVI void indexer_tile(int q0, const bf16_t* __restrict__ QI, const bf16_t* __restrict__ KI, const float* __restrict__ WI, unsigned* __restrict__ SELM, unsigned* __restrict__ SELM2, unsigned char* lds) {
    const int tid = otid(), lane = tid & 63, wave = tid >> 6;
    unsigned* hist = (unsigned*)(lds + IL_HIST);
    float* wiL = (float*)(lds + IL_WI);
    uint4* qst = (uint4*)(lds + IL_QST); uint4* qst2 = (uint4*)(lds + IL_QST2);
    unsigned* ckey = (unsigned*)(lds + IL_CKEY); unsigned* cidx = (unsigned*)(lds + IL_CIDX); unsigned* hist2 = (unsigned*)(lds + IL_HIST2); unsigned* ccnt = (unsigned*)(lds + IL_CCNT);
    volatile unsigned* flag = (volatile unsigned*)(lds + IL_FLAG);
    const int nkb = (q0 + 16 + 31) >> 5;
    bf16x8_t Af[4][4];
    { const int rho = lane & 31, hq = lane >> 5; const int qq = 2 * ((rho >> 2) & 1) + (rho >> 4), head = 4 * ((rho >> 3) & 1) + (rho & 3);
#pragma unroll
      for (int rb = 0; rb < 4; ++rb)
#pragma unroll
          for (int ks = 0; ks < 4; ++ks) Af[rb][ks] = *(const bf16x8_t*)(QI + (size_t)(q0 + 4 * rb + qq) * 512 + head * 64 + 16 * ks + 8 * hq); }
    __syncthreads();
    if (tid < 128) wiL[tid] = WI[(size_t)q0 * 8 + tid] * 0.125f;
    if (tid < 16) { qst[tid] = make_uint4(0u, 0u, 20u, 4095u); qst2[tid] = make_uint4(0u, 0u, (unsigned)TOPK, 0u); ccnt[tid] = 0u; }
    for (int level = 0; level < 3; ++level) {
        for (int i = tid; i < 16 * HROW / 4; i += NTHREADS) ((uint4*)hist)[i] = make_uint4(0u, 0u, 0u, 0u);
        if (tid == 0) flag[0] = 0u;
        __syncthreads();
        if (level == 0) idx_sweep<1, true>(q0, nkb, wave, lane, Af, KI, lds, SELM); else idx_sweep<1, false>(q0, nkb, wave, lane, Af, KI, lds, SELM);
        __syncthreads();
#pragma unroll 1
        for (int qi = 0; qi < 2; ++qi) {
            const int qs = 2 * wave + qi;
            const uint4 st = qst[qs]; const uint4 b = qst2[qs];
            if (st.x == 0xFFFFFFFFu && st.y == 0u && st.w == 0u) continue;
            unsigned wv[32]; unsigned loc = 0u;
#pragma unroll
            for (int i = 0; i < 32; ++i) { wv[i] = hist[qs * HROW + 33 * lane + i]; loc += (wv[i] & 0xFFFFu) + (wv[i] >> 16); }
            unsigned suf = loc;
#pragma unroll
            for (int off = 1; off < 64; off <<= 1) { const unsigned o = __shfl_down(suf, off); if (lane + off < 64) suf += o; }
            const unsigned total = __shfl(suf, 0), above = suf - loc, need = b.z;
            if (level == 0 && total <= need) { if (lane == 0) { qst[qs] = make_uint4(0xFFFFFFFFu, 0u, 0u, 0u); qst2[qs] = make_uint4(0u, 0u, 0xFFFFFFFFu, 0u); } continue; }
            const bool mine = above < need && need <= above + loc;
            unsigned cum = above, c = 0u; int d = 0; bool found = false;
#pragma unroll
            for (int i = 31; i >= 0; --i) {
                const unsigned chi = wv[i] >> 16, clo = wv[i] & 0xFFFFu;
                if (!found && cum + chi >= need) { found = true; d = 64 * lane + 2 * i + 1; c = chi; } if (!found) cum += chi;
                if (!found && cum + clo >= need) { found = true; d = 64 * lane + 2 * i; c = clo; } if (!found) cum += clo; }
            if (mine) {
                const unsigned pval = st.y | ((unsigned)d << st.z), pmask = st.x | (st.w << st.z);
                const unsigned nneed = need - cum;
                const unsigned long long hi64 = (unsigned long long)pval + (1ull << st.z);
                const unsigned hi = hi64 > 0xFFFFFFFFull ? 0xFFFFFFFFu : (unsigned)hi64;
                if (c <= (unsigned)CB || level == 2) { qst[qs] = make_uint4(0xFFFFFFFFu, 0u, 0u, 0u); qst2[qs] = make_uint4(pval, hi, nneed, st.z); }
                else { const unsigned nsh = (level == 0) ? 8u : 0u, ndm = (level == 0) ? 4095u : 255u; qst[qs] = make_uint4(pmask, pval, nsh, ndm); qst2[qs] = make_uint4(pval, hi, nneed, st.z); flag[0] = 1u; }
            }
        }
        __syncthreads();
        if (flag[0] == 0u) break;
        __syncthreads();
    }
    __syncthreads();
    idx_sweep<2, false>(q0, nkb, wave, lane, Af, KI, lds, SELM);
    asm volatile("s_waitcnt vmcnt(0)" ::: "memory");
    __syncthreads();
#pragma unroll 1
    for (int qi = 0; qi < 2; ++qi) {
        const int qs = 2 * wave + qi;
        const uint4 b = qst2[qs];
        unsigned* rowb = (unsigned*)(lds + IL_ROWB) + wave * SW;
        unsigned* SR2 = SELM2 + (size_t)(q0 + qs) * SW;
        for (int i = lane; i < SW; i += 64) rowb[i] = 0u;
        asm volatile("s_waitcnt lgkmcnt(0)" ::: "memory");
        if (b.z != 0xFFFFFFFFu) {
            const unsigned need = b.z; const unsigned cn = ccnt[qs]; const int n = (int)(cn < (unsigned)CB ? cn : (unsigned)CB);
            const unsigned rem = b.w;
            const unsigned sh8 = rem > 8u ? rem - 8u : 0u; const unsigned m8 = rem >= 8u ? 255u : ((1u << rem) - 1u);
#pragma unroll
            for (int i = 0; i < 4; ++i) hist2[qs * 256 + 4 * lane + i] = 0u;
            asm volatile("s_waitcnt lgkmcnt(0)" ::: "memory");
            for (int i = lane; i < n; i += 64) atomicAdd(&hist2[qs * 256 + ((ckey[qs * CB + i] >> sh8) & m8)], 1u);
            asm volatile("s_waitcnt lgkmcnt(0)" ::: "memory");
            unsigned c4[4]; unsigned loc = 0u;
#pragma unroll
            for (int i = 0; i < 4; ++i) { c4[i] = hist2[qs * 256 + 4 * lane + i]; loc += c4[i]; }
            unsigned suf = loc;
#pragma unroll
            for (int off = 1; off < 64; off <<= 1) { const unsigned o = __shfl_down(suf, off); if (lane + off < 64) suf += o; }
            const unsigned above = suf - loc;
            const bool mine = above < need && need <= above + loc;
            unsigned b2 = 0u, need2 = 0u;
            if (mine) { unsigned cum = above; int i = 3; for (; i > 0; --i) { if (cum + c4[i] >= need) break; cum += c4[i]; } b2 = 4u * lane + i; need2 = need - cum; }
            const unsigned long long mb = __ballot(mine);
            if (mb == 0ull) {
                for (int i = lane; i < n; i += 64) if ((unsigned)i < need) { const unsigned ii = cidx[qs * CB + i]; atomicOr(&rowb[ii >> 5], 1u << (ii & 31u)); }
            } else {
                const int src = __ffsll((long long)mb) - 1;
                b2 = __shfl(b2, src); need2 = __shfl(need2, src);
                for (int i = lane; i < n; i += 64) {
                    const unsigned ki = ckey[qs * CB + i], ii = cidx[qs * CB + i]; const unsigned d8 = (ki >> sh8) & m8;
                    bool take = d8 > b2;
                    if (d8 == b2) { unsigned rank = 0u;
                        for (int j = 0; j < n; ++j) { const unsigned kj = ckey[qs * CB + j], ij = cidx[qs * CB + j]; if (((kj >> sh8) & m8) == b2 && (kj > ki || (kj == ki && ij < ii))) ++rank; }
                        take = rank < need2; }
                    if (take) atomicOr(&rowb[ii >> 5], 1u << (ii & 31u));
                }
            }
        }
        asm volatile("s_waitcnt lgkmcnt(0)" ::: "memory");
        for (int i = lane; i < SW; i += 64) SR2[i] = rowb[i];
        asm volatile("s_waitcnt lgkmcnt(0)" ::: "memory");
    }
}

constexpr int AW_BYTES = 512;
typedef short s16x2 __attribute__((ext_vector_type(2)));
DEVI float dot2bf(unsigned a, unsigned b, float c) { return __builtin_amdgcn_fdot2_f32_bf16(__builtin_bit_cast(s16x2, a), __builtin_bit_cast(s16x2, b), c, false); }
#define LDS_FENCE() asm volatile("s_waitcnt lgkmcnt(0)" ::: "memory")

struct AttnQ { float m, l, o[8]; };

DEVI void attn_issue(int b0, int n, const unsigned short* lst, const unsigned char* __restrict__ KV8, int lane, uint4 (&kv)[8]) {
    const int last = n - 1;
#pragma unroll
    for (int kk = 0; kk < 8; ++kk) { const int ii = b0 + kk; const int key = lst[ii < last ? ii : last]; kv[kk] = *(const uint4*)(KV8 + (size_t)key * 1024 + lane * 16); }
}
DEVI void attn_compute(AttnQ& S, int b0, int n, const float (&q)[8], const uint4 (&kv)[8]) {
    float sc[8]; float mx = S.m;
#pragma unroll
    for (int u = 0; u < 8; ++u) {
        const f32x2v k0 = __builtin_amdgcn_cvt_pk_f32_fp8((int)kv[u].x, false), k1 = __builtin_amdgcn_cvt_pk_f32_fp8((int)kv[u].x, true),
                     k2 = __builtin_amdgcn_cvt_pk_f32_fp8((int)kv[u].y, false), k3 = __builtin_amdgcn_cvt_pk_f32_fp8((int)kv[u].y, true);
        f32x2v d2 = k0 * (f32x2v){q[0], q[1]}; d2 = k1 * (f32x2v){q[2], q[3]} + d2; d2 = k2 * (f32x2v){q[4], q[5]} + d2; d2 = k3 * (f32x2v){q[6], q[7]} + d2;
        float d = d2[0] + d2[1];
        d += dpp_f<0xB1>(d); d += dpp_f<0x4E>(d); d += dpp_f<0x141>(d);
        sc[u] = (b0 + u < n) ? d : -INFINITY;
        mx = fmaxf(mx, sc[u]); }
    const float scale = __builtin_amdgcn_exp2f(S.m - mx);
    float ls = S.l * scale;
#pragma unroll
    for (int i = 0; i < 8; ++i) S.o[i] *= scale;
#pragma unroll
    for (int u = 0; u < 8; ++u) {
        const float p = __builtin_amdgcn_exp2f(sc[u] - mx); ls += p;
        const f32x2v v0 = __builtin_amdgcn_cvt_pk_f32_fp8((int)kv[u].z, false), v1 = __builtin_amdgcn_cvt_pk_f32_fp8((int)kv[u].z, true),
                     v2 = __builtin_amdgcn_cvt_pk_f32_fp8((int)kv[u].w, false), v3 = __builtin_amdgcn_cvt_pk_f32_fp8((int)kv[u].w, true);
        S.o[0] += p * v0[0]; S.o[1] += p * v0[1]; S.o[2] += p * v1[0]; S.o[3] += p * v1[1]; S.o[4] += p * v2[0]; S.o[5] += p * v2[1]; S.o[6] += p * v3[0]; S.o[7] += p * v3[1]; }
    S.l = ls; S.m = mx;
}

DEVI void attn_query(int t, const bf16_t* __restrict__ Qb, const unsigned char* __restrict__ KV8,
                     const unsigned* __restrict__ SELM, const unsigned* __restrict__ SELM2, bf16_t* __restrict__ AO, unsigned char* wl, int lane) {
    unsigned short* lst = (unsigned short*)wl;
    const unsigned* SR = SELM + (size_t)t * SW; const unsigned* SR2 = SELM2 + (size_t)t * SW;
    LDS_FENCE();
    const int nw = (t >> 5) + 1; int base = 0;
    for (int w0 = 0; w0 < nw; w0 += 64) {
        const int wi = w0 + lane; const unsigned wv = wi < nw ? (SR[wi] | SR2[wi]) : 0u;
        const int pc = __popc(wv); int pre = pc;
#pragma unroll
        for (int off = 1; off < 64; off <<= 1) { const int o_ = __shfl_up(pre, off); if (lane >= off) pre += o_; }
        int pos = base + pre - pc; unsigned mm = wv;
        while (mm) { const int bpos = __ffs((int)mm) - 1; mm &= mm - 1u; if (pos < TOPK) lst[pos] = (unsigned short)(wi * 32 + bpos); ++pos; }
        base += __shfl(pre, 63);
    }
    const int n = base < TOPK ? base : TOPK;
    float q[8];
    { const uint4 qv = ((const uint4*)(Qb + (size_t)t * 512))[lane]; const float qs = 0.18033688011112042f;
      q[0] = bflo(qv.x) * qs; q[1] = bfhi(qv.x) * qs; q[2] = bflo(qv.y) * qs; q[3] = bfhi(qv.y) * qs; q[4] = bflo(qv.z) * qs; q[5] = bfhi(qv.z) * qs; q[6] = bflo(qv.w) * qs; q[7] = bfhi(qv.w) * qs; }
    LDS_FENCE();
    AttnQ S; S.m = -INFINITY; S.l = 0.f;
#pragma unroll
    for (int d = 0; d < 8; ++d) S.o[d] = 0.f;
    uint4 ka[8], kb_[8], kc[8];
    attn_issue(0, n, lst, KV8, lane, ka);
    if (8 < n) attn_issue(8, n, lst, KV8, lane, kb_);
    for (int b0 = 0; b0 < n; b0 += 24) {
        if (b0 + 16 < n) attn_issue(b0 + 16, n, lst, KV8, lane, kc);
        attn_compute(S, b0, n, q, ka);
        if (b0 + 8 < n) {
            if (b0 + 24 < n) attn_issue(b0 + 24, n, lst, KV8, lane, ka);
            attn_compute(S, b0 + 8, n, q, kb_);
            if (b0 + 16 < n) {
                if (b0 + 32 < n) attn_issue(b0 + 32, n, lst, KV8, lane, kb_);
                attn_compute(S, b0 + 16, n, q, kc);
            }
        }
    }
    const int hd = lane >> 3, ch = lane & 7;
    const float inv = 1.0f / S.l;
    uint4 pk; pk.x = cvt_pk_bf16(S.o[0] * inv, S.o[1] * inv); pk.y = cvt_pk_bf16(S.o[2] * inv, S.o[3] * inv); pk.z = cvt_pk_bf16(S.o[4] * inv, S.o[5] * inv); pk.w = cvt_pk_bf16(S.o[6] * inv, S.o[7] * inv);
    *(uint4*)(AO + (size_t)t * 1024 + 512 + hd * 64 + ch * 8) = pk;
}

__global__ void __launch_bounds__(NTHREADS, 2) fwd(Args a) {
    extern __shared__ __attribute__((aligned(16))) unsigned char lds_raw[];
    float* smf = (float*)lds_raw;
    PG8_LAS unsigned char* ldsp = (PG8_LAS unsigned char*)lds_raw;
    const int nwaves = gridDim.x * 8;
#define PHASE_VARS const int tid = otid(); const int lane = tid & 63, wave = tid >> 6; const int gwave = blockIdx.x * 8 + wave; (void)lane; (void)wave; (void)gwave;
    unsigned char* ws = a.ws;
    unsigned* ctl = (unsigned*)(ws + WS_CTL);
    const int lo = a.ph_lo, hi = a.ph_hi;

    volatile LAS unsigned* bst = (volatile LAS unsigned*)((LAS unsigned char*)lds_raw + (LDS_BYTES - 16));
    if (threadIdx.x == 0) { bst[0] = 0u; bst[1] = 0u; bst[2] = 0u; bst[3] = 0u; }
    __syncthreads();
    XcdBarrier bar; bar.bar = ctl; bar.x = 0; bar.st = bst;
    if (hi - lo > 1) bar = xcd_barrier_post(ctl, bst);
#define IN(k) (lo <= (k) && (k) < hi)
#define SEAM(k) do { if (IN(k) && IN((k) + 1)) xcd_barrier(bar); } while (0)

    const float* x = a.in[0]; const float* meta = a.in[1];
    float* ropeC = (float*)(ws + WS_ROPEC); float* ropeS = (float*)(ws + WS_ROPES);
    int* eid = (int*)(ws + WS_EID); float* gw = (float*)(ws + WS_GW); int* slot = (int*)(ws + WS_SLOT); int* mtiles = (int*)(ws + WS_MTILES);
    unsigned* counts0 = (unsigned*)(ws + CTL_CNT); unsigned* counts1 = counts0 + 32;
    unsigned* cursor0 = (unsigned*)(ws + CTL_CUR); unsigned* cursor1 = cursor0 + 32;
    bf16_t* Wta = (bf16_t*)(ws + WS_WTA); bf16_t* Wtx = (bf16_t*)(ws + WS_WTX);
    float* Aend = (float*)(ws + WS_AEND); float* Hend = (float*)(ws + WS_HEND); float* CIN = (float*)(ws + WS_CIN);
    unsigned char* big = ws + WS_BIG;
    bf16_t* WIN0 = (bf16_t*)(big + R_WIN0); bf16_t* WOUT0 = (bf16_t*)(big + R_WOUT0); bf16_t* WGU = (bf16_t*)(big + R_WGU); bf16_t* WD = (bf16_t*)(big + R_WD);
    bf16_t* WIN1 = (bf16_t*)(big + R_WIN1); bf16_t* WOUT1 = (bf16_t*)(big + R_WOUT1);
    bf16_t* X0b = (bf16_t*)(big + R_A); bf16_t* AO = (bf16_t*)(big + R_A); bf16_t* Xperm = (bf16_t*)(big + R_A); bf16_t* X2b = (bf16_t*)(big + R_A); bf16_t* YY = (bf16_t*)(big + R_A);
    float* H1 = (float*)(big + R_H1); float* H3 = (float*)(big + R_H1); float* H2 = (float*)(big + R_H2); unsigned* SELM = (unsigned*)(big + R_H1); unsigned* SELM2 = (unsigned*)(big + R_H1 + 36 * MiB);
    float* Z = (float*)(big + R_C); bf16_t* Yb = (bf16_t*)(big + R_C); float* Z1 = (float*)(big + R_C);
    unsigned char* KV8 = big + R_K;
    bf16_t* GLU = (bf16_t*)(big + R_GLU); bf16_t* Qb = (bf16_t*)(big + R_Q); bf16_t* Kb = (bf16_t*)(big + R_K); bf16_t* Vb = (bf16_t*)(big + R_V);
    bf16_t* QIb = (bf16_t*)(big + R_QI); bf16_t* KIb = (bf16_t*)(big + R_KI); float* WIf = (float*)(big + R_WI);
    bf16_t* GATEg = (bf16_t*)(big + R_GATE); bf16_t* XRb = (bf16_t*)(big + R_XR);
    bf16_t* Hm = (bf16_t*)(big + R_HM);

    if (IN(0)) { PHASE_VARS;
        const float* w_in = a.in[2]; const float* w_out = a.in[7]; const float* wg = a.in[21]; const float* wu = a.in[22]; const float* wd = a.in[23];
        constexpr int J_IN0 = 52 * 16, J_OUT0 = 16 * 16, J_GU = 32 * 256, J_D = 32 * 128, J_IN1 = 40 * 16, J_OUT1 = 16 * 20, J_GT = 80;
        const float* w_in1 = a.in[8]; const float* w_out1 = a.in[16]; const float* wga = a.in[11]; const float* wgx = a.in[13];
        tr_run(J_IN0 + J_OUT0 + J_GU + J_D + J_IN1 + J_OUT1 + J_GT, [&](int j) -> TrJob {
            TrJob J{};
            if (j < J_IN0) { J.dst = WIN0; J.s0 = w_in; J.K = 1024; J.n0 = (j >> 4) * 64; J.k0 = (j & 15) * 64; J.mode = 1; return J; }
            j -= J_IN0;
            if (j < J_OUT0) { J.dst = WOUT0; J.s0 = w_out; J.ld = D; J.K = 1024; J.n0 = (j >> 4) * 64; J.k0 = (j & 15) * 64; J.mode = 0; return J; }
            j -= J_OUT0;
            if (j < J_GU) { const int e = j >> 8, t = j & 255; J.dst = WGU + (size_t)e * 1024 * 1024; J.s0 = wg + (size_t)e * D * DE; J.s1 = wu + (size_t)e * D * DE; J.K = 1024; J.n0 = (t >> 4) * 64; J.k0 = (t & 15) * 64; J.mode = 2; return J; }
            j -= J_GU;
            if (j < J_D) { const int e = j >> 7, t = j & 127; J.dst = WD + (size_t)e * 1024 * 512; J.s0 = wd + (size_t)e * DE * D; J.ld = D; J.K = 512; J.n0 = (t >> 3) * 64; J.k0 = (t & 7) * 64; J.mode = 0; return J; }
            j -= J_D;
            if (j < J_IN1) { J.dst = WIN1; J.s0 = w_in1; J.ld = 2 * RNN_W; J.K = 1024; J.n0 = (j >> 4) * 64; J.k0 = (j & 15) * 64; J.mode = 0; return J; }
            j -= J_IN1;
            if (j < J_OUT1) { J.dst = WOUT1; J.s0 = w_out1; J.ld = D; J.K = RNN_W; J.n0 = (j / 20) * 64; J.k0 = (j % 20) * 64; J.mode = 0; return J; }
            j -= J_OUT1;
            { const int which = j / 40, r = j % 40; const int nb = r >> 2;
              J.dst = (which ? Wtx : Wta) + (size_t)nb * 128 * 128; J.s0 = (which ? wgx : wga) + (size_t)nb * 128 * 128; J.ld = 128; J.K = 128; J.n0 = ((r >> 1) & 1) * 64; J.k0 = (r & 1) * 64; J.mode = 0; return J; }
        }, smf);
        for (size_t i = (size_t)blockIdx.x * NTHREADS + tid; i < (size_t)LP * 256; i += (size_t)gridDim.x * NTHREADS) {
            const size_t r = i >> 8, c4 = i & 255;
            float4 v = make_float4(0.f, 0.f, 0.f, 0.f);
            if (r < NMETA) v = ((const float4*)meta)[r * 256 + c4]; else if (r < L) v = ((const float4*)x)[(r - NMETA) * 256 + c4];
            ((uint2*)X0b)[i] = make_uint2(cvt_pk_bf16(v.x, v.y), cvt_pk_bf16(v.z, v.w));
        }
        for (int i = blockIdx.x * NTHREADS + tid; i < 2 * 64 * 3 * 64; i += gridDim.x * NTHREADS) {
            const int ln = i & 63, ct = (i >> 6) % 3, ss = (i / 192) & 63, ly = i / (192 * 64);
            const int col = 16 * ct + (ln & 15), k0 = 16 * ss + 4 * (ln >> 4);
            float v[4];
#pragma unroll
            for (int j = 0; j < 4; ++j) v[j] = col < 4 ? a.in[17][(size_t)ly * D * NGRP + (size_t)(k0 + j) * NGRP + col] : col < 36 ? a.in[19][(size_t)ly * D * NE + (size_t)(k0 + j) * NE + (col - 4)] : 0.f;
            ((float4*)(ws + WS_WR))[i] = make_float4(v[0], v[1], v[2], v[3]);
        }
        for (int i = blockIdx.x * NTHREADS + tid; i < LP * 32; i += gridDim.x * NTHREADS) {
            const int p = i >> 5, f = i & 31;
            const float inv = (float)pow(10000.0, -(double)f / 32.0);
            const float ang = (float)p * inv;
            ropeC[i] = (float)cos((double)ang); ropeS[i] = (float)sin((double)ang);
        }
    }
    SEAM(0);
    if (IN(1)) { PHASE_VARS;
        pg8::Gemm g{X0b, WIN0, LP, 3328, 1024}; pg8::StaticOrder S; S.init(LP, 3328, (int)gridDim.x, (int)blockIdx.x);
        EpiIn0 E{GLU, KIb, WIf, ropeC, ropeS, KV8};
        pg8::gemm_phase<EpiIn0, pg8::StaticOrder>(ldsp, g, S, E);
    }
    SEAM(1);
    if (IN(2)) { PHASE_VARS;
        const float* cw = a.in[3]; const float* cb = a.in[4]; const float* lg = a.in[5]; const float* lb = a.in[6];
        for (int g4 = gwave; g4 < L / 4; g4 += nwaves) {
            const int t0 = g4 * 4, c0 = lane * 8;
            float acc[4][8], wwin[4][8];
            { const float4 b0 = *(const float4*)(cb + c0), b1 = *(const float4*)(cb + c0 + 4);
#pragma unroll
              for (int q = 0; q < 4; ++q) { acc[q][0] = b0.x; acc[q][1] = b0.y; acc[q][2] = b0.z; acc[q][3] = b0.w; acc[q][4] = b1.x; acc[q][5] = b1.y; acc[q][6] = b1.z; acc[q][7] = b1.w; } }
#pragma unroll
            for (int r = 0; r < CONV_K + 3; ++r) {
                const int tt = t0 - (CONV_K - 1) + r;
                if (r < CONV_K) { const float4 w0 = *(const float4*)(cw + r * CONV_CH + c0), w1 = *(const float4*)(cw + r * CONV_CH + c0 + 4);
                    wwin[r & 3][0] = w0.x; wwin[r & 3][1] = w0.y; wwin[r & 3][2] = w0.z; wwin[r & 3][3] = w0.w; wwin[r & 3][4] = w1.x; wwin[r & 3][5] = w1.y; wwin[r & 3][6] = w1.z; wwin[r & 3][7] = w1.w; }
                if (tt >= 0) {
                    const uint4 xv = *(const uint4*)(GLU + (size_t)tt * 512 + c0);
                    const float x[8] = {bflo(xv.x), bfhi(xv.x), bflo(xv.y), bfhi(xv.y), bflo(xv.z), bfhi(xv.z), bflo(xv.w), bfhi(xv.w)};
#pragma unroll
                    for (int q = 0; q < 4; ++q) { const int j = r - q;
                        if (j >= 0 && j < CONV_K) {
#pragma unroll
                            for (int i = 0; i < 8; ++i) acc[q][i] += wwin[j & 3][i] * x[i]; } }
                }
            }
            float gv[8], bvv[8];
            { const float4 g0 = *(const float4*)(lg + c0), g1 = *(const float4*)(lg + c0 + 4), b0 = *(const float4*)(lb + c0), b1 = *(const float4*)(lb + c0 + 4);
              gv[0] = g0.x; gv[1] = g0.y; gv[2] = g0.z; gv[3] = g0.w; gv[4] = g1.x; gv[5] = g1.y; gv[6] = g1.z; gv[7] = g1.w; bvv[0] = b0.x; bvv[1] = b0.y; bvv[2] = b0.z; bvv[3] = b0.w; bvv[4] = b1.x; bvv[5] = b1.y; bvv[6] = b1.z; bvv[7] = b1.w; }
#pragma unroll
            for (int q = 0; q < 4; ++q) {
                float s_ = 0.f;
#pragma unroll
                for (int i = 0; i < 8; ++i) s_ += acc[q][i];
                const float mu = wave_sum(s_) * (1.0f / 512.0f);
                float qq = 0.f;
#pragma unroll
                for (int i = 0; i < 8; ++i) { const float d = acc[q][i] - mu; qq += d * d; }
                const float rstd = 1.0f / sqrtf(wave_sum(qq) * (1.0f / 512.0f) + LN_EPS);
                float o[8];
#pragma unroll
                for (int i = 0; i < 8; ++i) { const float yv = (acc[q][i] - mu) * rstd * gv[i] + bvv[i]; o[i] = yv * fsigm(yv); }
                uint4 w; w.x = cvt_pk_bf16(o[0], o[1]); w.y = cvt_pk_bf16(o[2], o[3]); w.z = cvt_pk_bf16(o[4], o[5]); w.w = cvt_pk_bf16(o[6], o[7]);
                *(uint4*)(AO + (size_t)(t0 + q) * 1024 + c0) = w;
            }
        }
        for (int r = 0; ; ++r) {
            const int idx = r * (int)gridDim.x + ((r & 1) ? (int)gridDim.x - 1 - (int)blockIdx.x : (int)blockIdx.x);
            if (idx >= NTILE) break;
            indexer_tile((NTILE - 1 - idx) * 16, QIb, KIb, WIf, SELM, SELM2, lds_raw);
        }
    }
    SEAM(2);
    if (IN(3)) { PHASE_VARS;
        unsigned char* wl = lds_raw + wave * AW_BYTES;
        for (int t = gwave; t < L; t += nwaves) attn_query(t, Qb, KV8, SELM, SELM2, AO, wl, lane);
    }
    SEAM(3);
    if (IN(4)) { PHASE_VARS;
        pg8::Gemm g{AO, WOUT0, LP, 1024, 1024}; pg8::StaticOrder S; S.init(LP, 1024, (int)gridDim.x, (int)blockIdx.x);
        EpiRes0 E{x, meta, Z};
        pg8::gemm_phase<EpiRes0, pg8::StaticOrder>(ldsp, g, S, E);
    }
    SEAM(4);
    if (IN(5)) {
        for (int tb = blockIdx.x * 64; tb < L; tb += gridDim.x * 64)
            ln_route_block(tb, (L - tb) < 64 ? (L - tb) : 64, Z, H1, a.in[24], a.in[25], (const float4*)(ws + WS_WR), a.in[18], a.in[20], eid, gw, counts0, smf);
    }
    SEAM(5);
    if (IN(6)) { PHASE_VARS; moe_dispatch_mfma(H1, eid, counts0, cursor0, slot, mtiles, Xperm, (int*)lds_raw, gwave, nwaves, lane, 0); }
    SEAM(6);
    if (IN(7)) { PHASE_VARS;
        pg8::Gemm g{Xperm, WGU, MAXSLOT, 1024, 1024}; MoeOrder S; S.init(mtiles, (int)gridDim.x, (int)blockIdx.x);
        EpiGateUp E{Hm};
        pg8::gemm_phase<EpiGateUp, MoeOrder>(ldsp, g, S, E);
    }
    SEAM(7);
    if (IN(8)) { PHASE_VARS;
        pg8::Gemm g{Hm, WD, MAXSLOT, 1024, 512}; MoeOrder S; S.init(mtiles, (int)gridDim.x, (int)blockIdx.x);
        EpiDown E{Yb};
        pg8::gemm_phase<EpiDown, MoeOrder>(ldsp, g, S, E);
    }
    SEAM(8);
    if (IN(9)) { PHASE_VARS;
        for (int t = gwave; t < L; t += nwaves) {
            const int s0 = slot[2 * t], s1 = slot[2 * t + 1]; const float g0 = gw[2 * t], g1 = gw[2 * t + 1];
            float y[16];
            combine_row(y, H1 + (size_t)t * D, Yb + (size_t)s0 * D, Yb + (size_t)s1 * D, g0, g1, lane);
            ln_row1024v(y, a.in[26], a.in[27], lane);
#pragma unroll
            for (int i4 = 0; i4 < 4; ++i4) *(float4*)(H2 + (size_t)t * D + 16 * lane + 4 * i4) = make_float4(y[4 * i4], y[4 * i4 + 1], y[4 * i4 + 2], y[4 * i4 + 3]);
            uint4 p0, p1; p0.x = cvt_pk_bf16(y[0], y[1]); p0.y = cvt_pk_bf16(y[2], y[3]); p0.z = cvt_pk_bf16(y[4], y[5]); p0.w = cvt_pk_bf16(y[6], y[7]);
            p1.x = cvt_pk_bf16(y[8], y[9]); p1.y = cvt_pk_bf16(y[10], y[11]); p1.z = cvt_pk_bf16(y[12], y[13]); p1.w = cvt_pk_bf16(y[14], y[15]);
            *(uint4*)(X2b + (size_t)t * D + 16 * lane) = p0; *(uint4*)(X2b + (size_t)t * D + 16 * lane + 8) = p1;
        }
        for (int i = blockIdx.x * NTHREADS + tid; i < (LP - L) * D / 8; i += gridDim.x * NTHREADS) ((uint4*)(X2b + (size_t)L * D))[i] = make_uint4(0u, 0u, 0u, 0u);
    }
    SEAM(9);
    if (IN(10)) {
        pg8::Gemm g{X2b, WIN1, LP, 2 * RNN_W, 1024}; pg8::StaticOrder S; S.init(LP, 2 * RNN_W, (int)gridDim.x, (int)blockIdx.x);
        EpiIn1 E{GATEg};
        pg8::gemm_phase<EpiIn1, pg8::StaticOrder>(ldsp, g, S, E);
    }
    SEAM(10);
    if (IN(11)) {
        for (int u = blockIdx.x; u < NCHUNK * RNN_NB; u += gridDim.x)
            rglru_unit<false>(u / RNN_NB, u % RNN_NB, XRb, GATEg, Wta, Wtx, a.in[9], a.in[10], a.in[12], a.in[14], a.in[15], Aend, Hend, CIN, YY, lds_raw);
    }
    SEAM(11);
    if (IN(12)) { PHASE_VARS;
        for (int ch = gwave; ch < RNN_W; ch += nwaves) {
            float A[5], H[5];
#pragma unroll
            for (int i = 0; i < 5; ++i) { const int c = 5 * lane + i; const bool ok = c < NCHUNK; A[i] = ok ? Aend[(size_t)ch * CP + c] : 1.f; H[i] = ok ? Hend[(size_t)ch * CP + c] : 0.f; }
            float Al = 1.f, Hl = 0.f;
#pragma unroll
            for (int i = 0; i < 5; ++i) { Hl = A[i] * Hl + H[i]; Al *= A[i]; }
#pragma unroll
            for (int off = 1; off < 64; off <<= 1) { const float Ap = __shfl_up(Al, off), Hp = __shfl_up(Hl, off); if (lane >= off) { Hl = Al * Hp + Hl; Al = Al * Ap; } }
            float cin = __shfl_up(Hl, 1); if (lane == 0) cin = 0.f;
#pragma unroll
            for (int i = 0; i < 5; ++i) { const int c = 5 * lane + i; if (c < NCHUNK) { CIN[(size_t)ch * CP + c] = cin; cin = A[i] * cin + H[i]; } }
        }
    }
    SEAM(12);
    if (IN(13)) {
        for (int u = blockIdx.x; u < NCHUNK * RNN_NB; u += gridDim.x)
            rglru_unit<true>(u / RNN_NB, u % RNN_NB, XRb, GATEg, Wta, Wtx, a.in[9], a.in[10], a.in[12], a.in[14], a.in[15], Aend, Hend, CIN, YY, lds_raw);
    }
    SEAM(13);
    if (IN(14)) {
        pg8::Gemm g{YY + (size_t)NMETA * RNN_W, WOUT1, SEQ, 1024, RNN_W}; pg8::StaticOrder S; S.init(SEQ, 1024, (int)gridDim.x, (int)blockIdx.x);
        EpiRes1 E{H2 + (size_t)NMETA * D, Z1 + (size_t)NMETA * D};
        pg8::gemm_phase<EpiRes1, pg8::StaticOrder>(ldsp, g, S, E);
    }
    SEAM(14);
    if (IN(15)) { PHASE_VARS;
        const float* wg = a.in[21] + (size_t)NE * D * DE; const float* wu = a.in[22] + (size_t)NE * D * DE; const float* wd = a.in[23] + (size_t)NE * DE * D;
        constexpr int J_GU = 32 * 256, J_D = 32 * 128;
        tr_run(J_GU + J_D, [&](int j) -> TrJob {
            TrJob J{};
            if (j < J_GU) { const int e = j >> 8, t = j & 255; J.dst = WGU + (size_t)e * 1024 * 1024; J.s0 = wg + (size_t)e * D * DE; J.s1 = wu + (size_t)e * D * DE; J.K = 1024; J.n0 = (t >> 4) * 64; J.k0 = (t & 15) * 64; J.mode = 2; return J; }
            j -= J_GU;
            { const int e = j >> 7, t = j & 127; J.dst = WD + (size_t)e * 1024 * 512; J.s0 = wd + (size_t)e * DE * D; J.ld = D; J.K = 512; J.n0 = (t >> 3) * 64; J.k0 = (t & 7) * 64; J.mode = 0; return J; }
        }, smf);
        __syncthreads();
        for (int tb = NMETA + blockIdx.x * 64; tb < L; tb += gridDim.x * 64)
            ln_route_block(tb, (L - tb) < 64 ? (L - tb) : 64, Z1, H3, a.in[24] + D, a.in[25] + D, (const float4*)(ws + WS_WR) + 64 * 3 * 64, a.in[18] + NGRP, a.in[20] + NE, eid, gw, counts1, smf);
    }
    SEAM(15);
    if (IN(16)) { PHASE_VARS; moe_dispatch_mfma(H3, eid, counts1, cursor1, slot, mtiles, Xperm, (int*)lds_raw, gwave, nwaves, lane, 2 * NMETA); }
    SEAM(16);
    if (IN(17)) {
        pg8::Gemm g{Xperm, WGU, MAXSLOT, 1024, 1024}; MoeOrder S; S.init(mtiles, (int)gridDim.x, (int)blockIdx.x);
        EpiGateUp E{Hm};
        pg8::gemm_phase<EpiGateUp, MoeOrder>(ldsp, g, S, E);
    }
    SEAM(17);
    if (IN(18)) {
        pg8::Gemm g{Hm, WD, MAXSLOT, 1024, 512}; MoeOrder S; S.init(mtiles, (int)gridDim.x, (int)blockIdx.x);
        EpiDown E{Yb};
        pg8::gemm_phase<EpiDown, MoeOrder>(ldsp, g, S, E);
    }
    SEAM(18);
    if (IN(19)) { PHASE_VARS;
        for (int t = NMETA + gwave; t < L; t += nwaves) {
            const int s0 = slot[2 * t], s1 = slot[2 * t + 1]; const float g0 = gw[2 * t], g1 = gw[2 * t + 1];
            float y[16];
            combine_row(y, H3 + (size_t)t * D, Yb + (size_t)s0 * D, Yb + (size_t)s1 * D, g0, g1, lane);
            ln_row1024v(y, a.in[26] + D, a.in[27] + D, lane);
#pragma unroll
            for (int i4 = 0; i4 < 4; ++i4) *(float4*)(a.out + (size_t)(t - NMETA) * D + 16 * lane + 4 * i4) = make_float4(y[4 * i4], y[4 * i4 + 1], y[4 * i4 + 2], y[4 * i4 + 3]);
        }
    }
#undef IN
#undef SEAM
}
constexpr int N_PHASES = 20;

extern "C" void kernel_launch(void* const* d_in, const int* in_sizes, int n_in, void* d_out, int out_size, void* d_ws, size_t ws_size, hipStream_t stream) {
    static int grid = 0;
    if (grid == 0) {
        if (n_in != 28 || out_size != SEQ * D || ws_size < WS_END) { fprintf(stderr, "kernel_launch: unexpected shapes n_in %d out %d ws %zu (need %zu)\n", n_in, out_size, ws_size, (size_t)WS_END); grid = -1; return; }
        int dev = 0, cus = 0;
        if (hipGetDevice(&dev) != hipSuccess || hipDeviceGetAttribute(&cus, hipDeviceAttributeMultiprocessorCount, dev) != hipSuccess) { grid = -1; return; }
        if (hipFuncSetAttribute((const void*)fwd, hipFuncAttributeMaxDynamicSharedMemorySize, LDS_BYTES) != hipSuccess) { fprintf(stderr, "kernel_launch: hipFuncSetAttribute failed\n"); grid = -1; return; }
        int per_cu = 0;
        if (hipOccupancyMaxActiveBlocksPerMultiprocessor(&per_cu, (const void*)fwd, NTHREADS, LDS_BYTES) != hipSuccess || per_cu < 1) fprintf(stderr, "kernel_launch: occupancy query says %d\n", per_cu);
        (void)hipGetLastError();
        grid = cus;
    }
    if (grid < 0) return;
    (void)hipMemsetAsync((char*)d_ws + WS_CTL, 0, CTL_BYTES, stream);
    Args a{};
    for (int i = 0; i < 28; ++i) a.in[i] = (const float*)d_in[i];
    a.out = (float*)d_out; a.ws = (unsigned char*)d_ws;
#if N_LAUNCH_MODE == 1
    a.ph_lo = 0; a.ph_hi = N_PHASES;
    hipLaunchKernelGGL(fwd, dim3(grid), dim3(NTHREADS), LDS_BYTES, stream, a);
#else
    for (int p = 0; p < N_PHASES; ++p) { a.ph_lo = p; a.ph_hi = p + 1; hipLaunchKernelGGL(fwd, dim3(grid), dim3(NTHREADS), LDS_BYTES, stream, a); }
#endif
}
```

```cpp
#include <hip/hip_runtime.h>
#include <cstdio>
#include <cstdint>
#include <cmath>

#ifndef N_LAUNCH_MODE
#define N_LAUNCH_MODE 1
#endif

#define DEVI __device__ __forceinline__
#define LAS __attribute__((address_space(3)))

constexpr int D = 1024, SEQ = 16384, NMETA = 16, L = SEQ + NMETA;
constexpr int CONV_CH = 512, CONV_K = 31, HD = 64, TOPK = 256;
constexpr int IN_AB = 3144;
constexpr int OFF_AVAL = 0, OFF_AGATE = 512, OFF_Q = 1024, OFF_K = 1536, OFF_V = 2048, OFF_QI = 2560, OFF_KI = 3072, OFF_WI = 3136;
constexpr int RNN_W = 1280, RNN_NB = 10, RNN_BW = 128, RNN_K = 4;
constexpr int NGRP = 4, EPG = 8, NE = 32, DE = 512;
constexpr int NPAIR = 2 * L;
constexpr float LN_EPS = 1e-5f;
constexpr float DN_ALPHA = 1.41421356237f;
constexpr int NTHREADS = 512;
constexpr int LDS_BYTES = 147456;

#define XB_TMO      128
#define XB_XCNT(j)  (256  + 64 * (j))
#define XB_XSUB(j)  (1280 + 64 * (j))
#define XB_XGEN(j)  (2304 + 64 * (j))
#define XB_TOP      3328
#define XB_TOPGEN   3392
#define XCD_BAR_WORDS 3456
#define XB_SPIN_CAP (1u << 22)
DEVI unsigned xb_ld(unsigned* p)              { return __hip_atomic_load(p, __ATOMIC_RELAXED, __HIP_MEMORY_SCOPE_AGENT); }
DEVI unsigned xb_add(unsigned* p, unsigned v) { return __hip_atomic_fetch_add(p, v, __ATOMIC_RELAXED, __HIP_MEMORY_SCOPE_AGENT); }
DEVI unsigned xb_xcc_id() { return (unsigned)__builtin_amdgcn_s_getreg((3 << 11) | 20) & 0xFu; }
#define XB_SPIN(cond, bar) do { unsigned _sp = 0; while (cond) { __builtin_amdgcn_s_sleep(1); \
    if ((++_sp & 255u) == 0u) { if (xb_ld(&(bar)[XB_TMO])) break; if (_sp > XB_SPIN_CAP) { atomicAdd(&(bar)[XB_TMO], 1u); break; } } } } while (0)
struct XcdBarrier { unsigned* bar; unsigned x; volatile LAS unsigned* st; };
DEVI XcdBarrier xcd_barrier_post(unsigned* bar, volatile LAS unsigned* st) {
    XcdBarrier b; b.bar = bar; b.x = xb_xcc_id(); b.st = st;
    if (threadIdx.x == 0) (void)xb_add(&bar[XB_XCNT(b.x)], 1u);
    return b;
}
DEVI void xcd_barrier_complete(unsigned* bar, unsigned x, unsigned& nloc, unsigned& nx) {
    const unsigned G = gridDim.x * gridDim.y * gridDim.z;
    unsigned sum, cnt, mine, sp = 0u;
    for (;;) {
        sum = 0u; cnt = 0u; mine = 0u;
#pragma unroll
        for (unsigned j = 0; j < 16; ++j) { const unsigned c = xb_ld(&bar[XB_XCNT(j)]); sum += c; cnt += (c > 0u) ? 1u : 0u; mine = (j == x) ? c : mine; }
        if (sum == G) break;
        __builtin_amdgcn_s_sleep(1);
        if ((++sp & 255u) == 0u) { if (xb_ld(&bar[XB_TMO])) break; if (sp > XB_SPIN_CAP) { atomicAdd(&bar[XB_TMO], 1u); break; } }
    }
    nloc = mine > 0u ? mine : 1u; nx = cnt > 0u ? cnt : 1u;
}
DEVI void xcd_barrier(const XcdBarrier& b) {
    asm volatile("s_waitcnt vmcnt(0)" ::: "memory");
    __syncthreads();
    if (threadIdx.x == 0) {
        unsigned* bar = b.bar;
        __builtin_amdgcn_s_waitcnt(0);
        unsigned nloc = b.st[0], nx = b.st[1];
        if (nloc == 0u) { xcd_barrier_complete(bar, b.x, nloc, nx); b.st[0] = nloc; b.st[1] = nx; }
        const unsigned old = xb_add(&bar[XB_XSUB(b.x)], 1u);
        const unsigned gen = old / nloc;
        if (old + 1u == (gen + 1u) * nloc) {
            __builtin_amdgcn_fence(__ATOMIC_RELEASE, "agent");
            asm volatile("s_waitcnt vmcnt(0)" ::: "memory");
            const unsigned og = xb_add(&bar[XB_TOP], 1u);
            const unsigned tg = og / nx;
            if (og + 1u == (tg + 1u) * nx) xb_add(&bar[XB_TOPGEN], 1u);
            else XB_SPIN(xb_ld(&bar[XB_TOPGEN]) == tg, bar);
            __builtin_amdgcn_fence(__ATOMIC_ACQUIRE, "agent");
            xb_add(&bar[XB_XGEN(b.x)], 1u);
            asm volatile("s_waitcnt vmcnt(0)" ::: "memory");
        } else {
            XB_SPIN(xb_ld(&bar[XB_XGEN(b.x)]) == gen, bar);
            __builtin_amdgcn_fence(__ATOMIC_ACQUIRE, "agent");
            asm volatile("s_waitcnt vmcnt(0)" ::: "memory");
        }
    }
    __syncthreads();
}

constexpr int LP = 16640;
constexpr int MAXSLOT = 40960;
constexpr int NCHUNK = 257, CP = 272;
constexpr size_t MiB = 1048576;
constexpr size_t WS_CTL = 0;
constexpr size_t CTL_CNT = 16384;
constexpr size_t CTL_CUR = 16384 + 256;
constexpr size_t CTL_BYTES = 32768;
constexpr size_t WS_ROPEC = 32768;
constexpr size_t WS_ROPES = WS_ROPEC + (size_t)LP * 32 * 4;
constexpr size_t WS_EID = WS_ROPES + (size_t)LP * 32 * 4;
constexpr size_t WS_GW = WS_EID + (size_t)NPAIR * 4;
constexpr size_t WS_SLOT = WS_GW + (size_t)NPAIR * 4;
constexpr size_t WS_MTILES = WS_SLOT + (size_t)NPAIR * 4;
constexpr size_t WS_WTA = WS_MTILES + 4096;
constexpr size_t WS_WTX = WS_WTA + (size_t)RNN_NB * 128 * 128 * 2;
constexpr size_t WS_AEND = WS_WTX + (size_t)RNN_NB * 128 * 128 * 2;
constexpr size_t WS_HEND = WS_AEND + (size_t)RNN_W * CP * 4;
constexpr size_t WS_CIN = WS_HEND + (size_t)RNN_W * CP * 4;
constexpr size_t WS_WR = WS_CIN + (size_t)RNN_W * CP * 4;
constexpr size_t WS_BIG = ((WS_WR + (size_t)2 * 64 * 3 * 64 * 16 + 255) / 256) * 256;
constexpr size_t R_WIN0 = 0;
constexpr size_t R_WOUT0 = R_WIN0 + (size_t)3328 * 1024 * 2;
constexpr size_t R_WGU = R_WOUT0 + (size_t)1024 * 1024 * 2;
constexpr size_t R_WD = R_WGU + (size_t)32 * 1024 * 1024 * 2;
constexpr size_t R_WIN1 = R_WD + (size_t)32 * 1024 * 512 * 2;
constexpr size_t R_WOUT1 = R_WIN1 + (size_t)2560 * 1024 * 2;
static_assert(R_WOUT1 + (size_t)1024 * 1280 * 2 <= 112 * MiB, "weights");
constexpr size_t R_A = 112 * MiB;
constexpr size_t R_H1 = 192 * MiB;
constexpr size_t R_H2 = 257 * MiB;
constexpr size_t R_C = 322 * MiB;
constexpr size_t R_GLU = 322 * MiB;
constexpr size_t SZ512 = (size_t)LP * 512 * 2;
constexpr size_t R_Q = R_GLU + SZ512, R_K = R_Q + SZ512, R_V = R_K + SZ512, R_QI = R_V + SZ512, R_KI = R_QI + SZ512, R_WI = R_KI + (size_t)LP * 64 * 2;
static_assert(R_WI + (size_t)LP * 8 * 4 <= 406 * MiB, "in-proj outputs");
constexpr size_t R_GATE = 322 * MiB;
constexpr size_t R_XR = R_GATE + (size_t)LP * 1280 * 2;
static_assert(R_XR + (size_t)LP * 1280 * 2 <= 406 * MiB, "layer-1 in-proj outputs");
constexpr size_t R_HM = 406 * MiB;
constexpr size_t WS_END = WS_BIG + R_HM + (size_t)MAXSLOT * 512 * 2;
static_assert(WS_END <= 512 * MiB, "ws");

struct Args { const float* in[28]; float* out; unsigned char* ws; int ph_lo, ph_hi; };

DEVI int otid() { int v = (int)threadIdx.x; asm volatile("" : "+v"(v)); return v; }
template <int CTRL> DEVI float dpp_f(float v) { return __int_as_float(__builtin_amdgcn_mov_dpp(__float_as_int(v), CTRL, 0xF, 0xF, true)); }
DEVI float wave_sum(float v) {
    v += dpp_f<0xB1>(v); v += dpp_f<0x4E>(v); v += dpp_f<0x141>(v); v += dpp_f<0x140>(v);
    return __int_as_float(__builtin_amdgcn_readlane(__float_as_int(v), 0)) + __int_as_float(__builtin_amdgcn_readlane(__float_as_int(v), 16))
         + __int_as_float(__builtin_amdgcn_readlane(__float_as_int(v), 32)) + __int_as_float(__builtin_amdgcn_readlane(__float_as_int(v), 48));
}
DEVI float wave_max(float v) {
#pragma unroll
    for (int o = 32; o > 0; o >>= 1) v = fmaxf(v, __shfl_xor(v, o));
    return v;
}
DEVI float sigm(float x) { return 1.0f / (1.0f + expf(-x)); }
DEVI float gelu_tanh(float x) { return 0.5f * x * (1.0f + tanhf(0.7978845608028654f * (x + 0.044715f * x * x * x))); }
DEVI unsigned f2key(float f) { unsigned u = __float_as_uint(f); return (u & 0x80000000u) ? ~u : (u | 0x80000000u); }

namespace pg8 {
#define PG8_LAS __attribute__((address_space(3)))
typedef unsigned short bf16_t;
typedef short bf16x8 __attribute__((ext_vector_type(8)));
typedef float f32x4 __attribute__((ext_vector_type(4)));
typedef unsigned u32x4 __attribute__((ext_vector_type(4)));
constexpr int BM = 256, BK = 64, HALF = 128, HTB = HALF * BK * 2  , STAGE_BYTES = 8 * HTB, NXCD = 8, WGM = 8;

__host__ __device__ __forceinline__ int lds_byte(int r, int c) { const int st = (r >> 4) * 2 + (c >> 5), rr = r & 15, cc = c & 31, ob = rr * 64 + cc * 2; return st * 1024 + (ob ^ (((ob >> 9) & 1) << 5)); }
__host__ __device__ __forceinline__ void stage_rc(int b, int& R, int& C) { const int st = b / 1024, sb = b % 1024, swz = sb ^ (((sb >> 9) & 1) << 5); R = (st >> 1) * 16 + swz / 64; C = (st & 1) * 32 + (swz % 64) / 2; }
__host__ __device__ __forceinline__ int perm32(int rho) { const int n = rho >> 4, i = rho & 15; return 8 * (i >> 2) + 4 * n + (i & 3); }

struct Unit { int pm, pn; };
struct Gemm { const bf16_t* A; const bf16_t* Bt; int M, N, K; };

struct StaticOrder {
    int nM, nN, nwg, G, c;
    __host__ __device__ void init(int M, int N, int G_, int c_) { nM = M / BM; nN = N / BM; nwg = nM * nN; G = G_; c = c_; }
    __host__ __device__ bool next(int i, Unit& u) const {
        const long L = (long)i * G + c; if (L >= nwg) return false;
        int wgid = (int)L; { const int q = nwg / NXCD, r = nwg % NXCD, xcd = wgid % NXCD, off = wgid / NXCD; wgid = (xcd < r ? xcd * (q + 1) : r * (q + 1) + (xcd - r) * q) + off; }
        const int nig = WGM * nN, gid = wgid / nig, fm = gid * WGM, gsz = (nM - fm) < WGM ? (nM - fm) : WGM;
        u.pm = fm + ((wgid % nig) % gsz); u.pn = (wgid % nig) / gsz; return true;
    }
    __device__ __forceinline__ void a_ready(const Unit&) const {}
    __device__ __forceinline__ void done(const Unit&) const {}
};

template <class Epi, class Sched>
__device__ __forceinline__ void gemm_phase(PG8_LAS unsigned char* lds, const Gemm g, const Sched& S, const Epi& E) {
    const int tid = threadIdx.x, wid = __builtin_amdgcn_readfirstlane(tid >> 6), lane = tid & 63, wr = wid >> 2, wc = wid & 3, fr = lane & 15, fq = lane >> 4;
    const int K = g.K, nt = K / BK;
    unsigned voffA[2], voffB[2];
#pragma unroll
    for (int i = 0; i < 2; ++i) { int R, C; stage_rc(tid * 16 + i * 8192, R, C); const int Rb = Epi::PERM ? ((R & ~31) + perm32(R & 31)) : R;
        voffA[i] = (unsigned)(R * K + C) * 2u; voffB[i] = (unsigned)(Rb * K + C) * 2u; }
    const size_t kstep = (size_t)(BK * 2);
    const size_t hstep = (size_t)HALF * K * 2;
    const size_t tstep = 2 * hstep;
    const unsigned ldsw = (unsigned)wid * 1024u;
    const int aoff = lds_byte(wr * 64 + fr, fq * 8), boff = lds_byte(wc * 32 + fr, fq * 8);
#define PG8_SA(b, h) (((b) * 2 + (h)) * HTB)
#define PG8_SB(b, h) ((4 + (b) * 2 + (h)) * HTB)
#define PG8_STAGE(bufoff, gbase, voff) do { _Pragma("unroll") for (int _i = 0; _i < 2; ++_i) \
        __builtin_amdgcn_global_load_lds((const unsigned*)((const char*)(gbase) + (voff)[_i]), (PG8_LAS unsigned*)(lds + (bufoff) + ldsw + _i * 8192), 16, 0, 0); } while (0)
#define PG8_LDA(dst, b, h) do { _Pragma("unroll") for (int m = 0; m < 4; ++m) _Pragma("unroll") for (int k = 0; k < 2; ++k) dst[m][k] = *(const PG8_LAS bf16x8*)(lds + PG8_SA(b, h) + aoff + m * 2048 + k * 1024); } while (0)
#define PG8_LDB(dst, b, h) do { _Pragma("unroll") for (int n = 0; n < 2; ++n) _Pragma("unroll") for (int k = 0; k < 2; ++k) dst[n][k] = *(const PG8_LAS bf16x8*)(lds + PG8_SB(b, h) + boff + n * 2048 + k * 1024); } while (0)
#define PG8_MMA(ai, bj, At, Bt) do { __builtin_amdgcn_s_setprio(1); _Pragma("unroll") for (int m = 0; m < 4; ++m) _Pragma("unroll") for (int n = 0; n < 2; ++n) _Pragma("unroll") for (int k = 0; k < 2; ++k) \
        acc[ai][bj][m][n] = __builtin_amdgcn_mfma_f32_16x16x32_bf16(Bt[n][k], At[m][k], acc[ai][bj][m][n], 0, 0, 0); __builtin_amdgcn_s_setprio(0); } while (0)
#define PG8_WAIT_V(n) asm volatile("s_waitcnt vmcnt(" #n ")" ::: "memory")
#define PG8_WAIT_L(n) asm volatile("s_waitcnt lgkmcnt(" #n ")" ::: "memory")
#define PG8_BAR __builtin_amdgcn_s_barrier()
#define PG8_SCHED __builtin_amdgcn_sched_barrier(0)
    Unit cur, nxt; int ui = 0;
    if (!S.next(0, cur)) return;
    f32x4 acc[2][2][4][2];
#pragma unroll
    for (int a = 0; a < 2; ++a)
#pragma unroll
        for (int b = 0; b < 2; ++b)
#pragma unroll
            for (int m = 0; m < 4; ++m)
#pragma unroll
                for (int n = 0; n < 2; ++n) acc[a][b][m][n] = (f32x4){0.f, 0.f, 0.f, 0.f};
    bf16x8 At[4][2], B0[2][2], B1[2][2];
    const char* cA = (const char*)g.A + (size_t)cur.pm * tstep; const char* cB = (const char*)g.Bt + (size_t)cur.pn * tstep;
    S.a_ready(cur);
    PG8_STAGE(PG8_SB(0, 0), cB, voffB); PG8_STAGE(PG8_SA(0, 0), cA, voffA); PG8_STAGE(PG8_SB(0, 1), cB + hstep, voffB); PG8_STAGE(PG8_SA(0, 1), cA + hstep, voffA);
    if (wr == 1) PG8_BAR;
    PG8_WAIT_V(4); PG8_BAR;
    PG8_STAGE(PG8_SB(1, 0), cB + kstep, voffB); PG8_STAGE(PG8_SA(1, 0), cA + kstep, voffA); PG8_STAGE(PG8_SB(1, 1), cB + hstep + kstep, voffB);
    PG8_WAIT_V(6); PG8_BAR;
    for (;;) {
        const bool has_next = S.next(ui + 1, nxt);
        const char* nA = has_next ? (const char*)g.A + (size_t)nxt.pm * tstep : cA; const char* nB = has_next ? (const char*)g.Bt + (size_t)nxt.pn * tstep : cB;
        for (int t = 0; t < nt; t += 2) {
            const bool last = (t == nt - 2);
            const char* a1 = cA + (size_t)(t + 1) * kstep;
            const char* a2 = last ? nA : cA + (size_t)(t + 2) * kstep; const char* b2 = last ? nB : cB + (size_t)(t + 2) * kstep;
            const char* a3 = a2 + kstep; const char* b3 = b2 + kstep;
            if (last && has_next) S.a_ready(nxt);
            PG8_LDB(B0, 0, 0); PG8_SCHED; PG8_LDA(At, 0, 0); PG8_STAGE(PG8_SA(1, 1), a1 + hstep, voffA);
            PG8_WAIT_L(8); PG8_BAR; PG8_WAIT_L(0); PG8_MMA(0, 0, At, B0); PG8_BAR; PG8_SCHED;
            PG8_LDB(B1, 0, 1); PG8_STAGE(PG8_SB(0, 0), b2, voffB);
            PG8_BAR; PG8_WAIT_L(0); PG8_MMA(0, 1, At, B1); PG8_BAR;
            PG8_LDA(At, 0, 1); PG8_STAGE(PG8_SA(0, 0), a2, voffA);
            PG8_BAR; PG8_WAIT_L(0); PG8_MMA(1, 0, At, B0); PG8_BAR; PG8_SCHED;
            PG8_STAGE(PG8_SB(0, 1), b2 + hstep, voffB);
            PG8_WAIT_V(6); PG8_BAR; PG8_MMA(1, 1, At, B1); PG8_BAR;
            PG8_LDB(B0, 1, 0); PG8_SCHED; PG8_LDA(At, 1, 0); PG8_STAGE(PG8_SA(0, 1), a2 + hstep, voffA);
            PG8_WAIT_L(8); PG8_BAR; PG8_WAIT_L(0); PG8_MMA(0, 0, At, B0); PG8_BAR; PG8_SCHED;
            PG8_LDB(B1, 1, 1); PG8_STAGE(PG8_SB(1, 0), b3, voffB);
            PG8_BAR; PG8_WAIT_L(0); PG8_MMA(0, 1, At, B1); PG8_BAR;
            PG8_LDA(At, 1, 1); PG8_STAGE(PG8_SA(1, 0), a3, voffA);
            PG8_BAR; PG8_WAIT_L(0); PG8_MMA(1, 0, At, B0); PG8_BAR; PG8_SCHED;
            PG8_STAGE(PG8_SB(1, 1), b3 + hstep, voffB);
            PG8_WAIT_V(6); PG8_BAR; PG8_MMA(1, 1, At, B1); PG8_BAR;
        }
        if constexpr (!Epi::AFTER_DRAIN) { E(acc, cur, wr, wc, fr, fq); S.done(cur); }
        if (!has_next) break;
#pragma unroll
        for (int a = 0; a < 2; ++a)
#pragma unroll
            for (int b = 0; b < 2; ++b)
#pragma unroll
                for (int m = 0; m < 4; ++m)
#pragma unroll
                    for (int n = 0; n < 2; ++n) acc[a][b][m][n] = (f32x4){0.f, 0.f, 0.f, 0.f};
        cur = nxt; cA = nA; cB = nB; ++ui;
    }
    PG8_WAIT_V(0);
    if (wr == 0) PG8_BAR;
    PG8_BAR;
    if constexpr (Epi::AFTER_DRAIN) { E.fused(acc, cur, wr, wc, fr, fq, lds, wid, lane); S.done(cur); }
#undef PG8_SA
#undef PG8_SB
#undef PG8_STAGE
#undef PG8_LDA
#undef PG8_LDB
#undef PG8_MMA
#undef PG8_WAIT_V
#undef PG8_WAIT_L
#undef PG8_BAR
#undef PG8_SCHED
}
}

DEVI void ln_row1024(float (&y)[16], const float* g, const float* b, int lane) {
    float s = 0.f;
#pragma unroll
    for (int i = 0; i < 16; ++i) s += y[i];
    const float mu = wave_sum(s) * (1.0f / 1024.0f);
    float q = 0.f;
#pragma unroll
    for (int i = 0; i < 16; ++i) { const float d = y[i] - mu; q += d * d; }
    const float rstd = 1.0f / sqrtf(wave_sum(q) * (1.0f / 1024.0f) + LN_EPS);
#pragma unroll
    for (int i = 0; i < 16; ++i) y[i] = (y[i] - mu) * rstd * g[lane + 64 * i] + b[lane + 64 * i];
}

DEVI void route_token(const float (&y)[16], float* ys, int t, int lane, const float* wg, const float* bg, const float* we, const float* be, int* eid, float* gw, unsigned* counts) {
    float lg[36];
#pragma unroll
    for (int j = 0; j < 36; ++j) lg[j] = 0.f;
#pragma unroll
    for (int i = 0; i < 16; ++i) ys[lane + 64 * i] = y[i];
#pragma unroll 1
    for (int i = 0; i < 16; ++i) {
        const int c = lane + 64 * i;
        const float yv = ys[c];
        const float4 g4 = *(const float4*)(wg + (size_t)c * 4);
        lg[0] += yv * g4.x; lg[1] += yv * g4.y; lg[2] += yv * g4.z; lg[3] += yv * g4.w;
#pragma unroll
        for (int j = 0; j < 8; ++j) { const float4 e4 = *(const float4*)(we + (size_t)c * 32 + j * 4);
            lg[4 + j * 4 + 0] += yv * e4.x; lg[4 + j * 4 + 1] += yv * e4.y; lg[4 + j * 4 + 2] += yv * e4.z; lg[4 + j * 4 + 3] += yv * e4.w; }
    }
#pragma unroll
    for (int j = 0; j < 36; ++j) lg[j] = wave_sum(lg[j]);
    if (lane == 0) {
        float gl[4]; int g = 0;
#pragma unroll
        for (int j = 0; j < 4; ++j) gl[j] = lg[j] + bg[j];
#pragma unroll
        for (int j = 1; j < 4; ++j) if (gl[j] > gl[g]) g = j;
        float den = 0.f;
#pragma unroll
        for (int j = 0; j < 4; ++j) den += expf(gl[j] - gl[g]);
        const float gp = 1.0f / den;
        float el[8];
#pragma unroll
        for (int j = 0; j < 8; ++j) { float v = 0.f;
#pragma unroll
            for (int gg = 0; gg < 4; ++gg) v = (gg == g) ? lg[4 + gg * 8 + j] + be[gg * 8 + j] : v;
            el[j] = v; }
        int i1 = 0;
#pragma unroll
        for (int j = 1; j < 8; ++j) if (el[j] > el[i1]) i1 = j;
        int i2 = (i1 == 0) ? 1 : 0;
#pragma unroll
        for (int j = 0; j < 8; ++j) if (j != i1 && el[j] > el[i2]) i2 = j;
        const float ex = expf(el[i2] - el[i1]);
        const float p1 = 1.0f / (1.0f + ex), p2 = ex / (1.0f + ex);
        const int e1 = g * 8 + i1, e2 = g * 8 + i2;
        eid[2 * t] = e1; eid[2 * t + 1] = e2; gw[2 * t] = gp * p1; gw[2 * t + 1] = gp * p2;
        atomicAdd(&counts[e1], 1u); atomicAdd(&counts[e2], 1u);
    }
}


DEVI void ln_row1024v(float (&y)[16], const float* g, const float* b, int lane) {
    float s = 0.f;
#pragma unroll
    for (int i = 0; i < 16; ++i) s += y[i];
    const float mu = wave_sum(s) * (1.0f / 1024.0f);
    float q = 0.f;
#pragma unroll
    for (int i = 0; i < 16; ++i) { const float d = y[i] - mu; q += d * d; }
    const float rstd = 1.0f / sqrtf(wave_sum(q) * (1.0f / 1024.0f) + LN_EPS);
#pragma unroll
    for (int i4 = 0; i4 < 4; ++i4) { const float4 g4 = *(const float4*)(g + 16 * lane + 4 * i4), b4 = *(const float4*)(b + 16 * lane + 4 * i4);
        y[4 * i4] = (y[4 * i4] - mu) * rstd * g4.x + b4.x; y[4 * i4 + 1] = (y[4 * i4 + 1] - mu) * rstd * g4.y + b4.y; y[4 * i4 + 2] = (y[4 * i4 + 2] - mu) * rstd * g4.z + b4.z; y[4 * i4 + 3] = (y[4 * i4 + 3] - mu) * rstd * g4.w + b4.w; }
}
DEVI void combine_row(float (&y)[16], const float* h, const unsigned short* Y0, const unsigned short* Y1, float g0, float g1, int lane) {
    const uint4 a0 = *(const uint4*)(Y0 + 16 * lane), a1 = *(const uint4*)(Y0 + 16 * lane + 8), b0 = *(const uint4*)(Y1 + 16 * lane), b1 = *(const uint4*)(Y1 + 16 * lane + 8);
    const unsigned aw[8] = {a0.x, a0.y, a0.z, a0.w, a1.x, a1.y, a1.z, a1.w}, bw[8] = {b0.x, b0.y, b0.z, b0.w, b1.x, b1.y, b1.z, b1.w};
#pragma unroll
    for (int i4 = 0; i4 < 4; ++i4) { const float4 hv = *(const float4*)(h + 16 * lane + 4 * i4);
        y[4 * i4]     = DN_ALPHA * hv.x + (g0 * __uint_as_float(aw[2 * i4] << 16) + g1 * __uint_as_float(bw[2 * i4] << 16));
        y[4 * i4 + 1] = DN_ALPHA * hv.y + (g0 * __uint_as_float(aw[2 * i4] & 0xFFFF0000u) + g1 * __uint_as_float(bw[2 * i4] & 0xFFFF0000u));
        y[4 * i4 + 2] = DN_ALPHA * hv.z + (g0 * __uint_as_float(aw[2 * i4 + 1] << 16) + g1 * __uint_as_float(bw[2 * i4 + 1] << 16));
        y[4 * i4 + 3] = DN_ALPHA * hv.w + (g0 * __uint_as_float(aw[2 * i4 + 1] & 0xFFFF0000u) + g1 * __uint_as_float(bw[2 * i4 + 1] & 0xFFFF0000u)); }
}
typedef float f32x4v __attribute__((ext_vector_type(4)));
DEVI void ln_route_block(int tb, int ntok, const float* Zsrc, float* Hdst, const float* g, const float* b, const float4* __restrict__ Wr, const float* bg, const float* be,
                         int* eid, float* gw, unsigned* counts, float* sm) {
    const int tid = otid(), lane = tid & 63, wave = tid >> 6;
    for (int i = 0; i < 8; ++i) { const int tl = wave * 8 + i;
        if (tl < ntok) { const size_t t = (size_t)(tb + tl); float y[16];
#pragma unroll
            for (int i4 = 0; i4 < 4; ++i4) { const float4 v = *(const float4*)(Zsrc + t * D + 16 * lane + 4 * i4); y[4 * i4] = v.x; y[4 * i4 + 1] = v.y; y[4 * i4 + 2] = v.z; y[4 * i4 + 3] = v.w; }
            ln_row1024v(y, g, b, lane);
#pragma unroll
            for (int i4 = 0; i4 < 4; ++i4) *(float4*)(Hdst + t * D + 16 * lane + 4 * i4) = make_float4(y[4 * i4], y[4 * i4 + 1], y[4 * i4 + 2], y[4 * i4 + 3]); } }
    asm volatile("s_waitcnt vmcnt(0)" ::: "memory");
    __syncthreads();
    if (wave * 16 < ntok) {
        const int t0 = tb + 16 * wave, row = lane & 15, kg = lane >> 4;
        f32x4v acc[3];
#pragma unroll
        for (int ct = 0; ct < 3; ++ct) acc[ct] = (f32x4v){0.f, 0.f, 0.f, 0.f};
        const float* arow = Hdst + (size_t)(t0 + row) * D + 4 * kg;
#pragma unroll 4
        for (int sstep = 0; sstep < 64; ++sstep) {
            const float4 a4 = *(const float4*)(arow + 16 * sstep);
#pragma unroll
            for (int ct = 0; ct < 3; ++ct) { const float4 b4 = Wr[(sstep * 3 + ct) * 64 + lane];
                acc[ct] = __builtin_amdgcn_mfma_f32_16x16x4f32(a4.x, b4.x, acc[ct], 0, 0, 0); acc[ct] = __builtin_amdgcn_mfma_f32_16x16x4f32(a4.y, b4.y, acc[ct], 0, 0, 0);
                acc[ct] = __builtin_amdgcn_mfma_f32_16x16x4f32(a4.z, b4.z, acc[ct], 0, 0, 0); acc[ct] = __builtin_amdgcn_mfma_f32_16x16x4f32(a4.w, b4.w, acc[ct], 0, 0, 0); }
        }
        float* Lg = sm + wave * 16 * 48;
#pragma unroll
        for (int ct = 0; ct < 3; ++ct)
#pragma unroll
            for (int j = 0; j < 4; ++j) Lg[(4 * kg + j) * 48 + 16 * ct + row] = acc[ct][j];
        asm volatile("s_waitcnt lgkmcnt(0)" ::: "memory");
        if (lane < 16) {
            const int t = t0 + lane; const float* lg = Lg + lane * 48;
            float gl[4]; int gsel = 0;
#pragma unroll
            for (int j = 0; j < 4; ++j) gl[j] = lg[j] + bg[j];
#pragma unroll
            for (int j = 1; j < 4; ++j) if (gl[j] > gl[gsel]) gsel = j;
            float den = 0.f;
#pragma unroll
            for (int j = 0; j < 4; ++j) den += expf(gl[j] - gl[gsel]);
            const float gp = 1.0f / den;
            float el[8];
#pragma unroll
            for (int j = 0; j < 8; ++j) el[j] = lg[4 + gsel * 8 + j] + be[gsel * 8 + j];
            int i1 = 0;
#pragma unroll
            for (int j = 1; j < 8; ++j) if (el[j] > el[i1]) i1 = j;
            int i2 = (i1 == 0) ? 1 : 0;
#pragma unroll
            for (int j = 0; j < 8; ++j) if (j != i1 && el[j] > el[i2]) i2 = j;
            float e1v = el[0], e2v = el[0];
#pragma unroll
            for (int j = 0; j < 8; ++j) { e1v = (j == i1) ? el[j] : e1v; e2v = (j == i2) ? el[j] : e2v; }
            const float ex = expf(e2v - e1v);
            const float p1 = 1.0f / (1.0f + ex), p2 = ex / (1.0f + ex);
            const int e1 = gsel * 8 + i1, e2 = gsel * 8 + i2;
            eid[2 * t] = e1; eid[2 * t + 1] = e2; gw[2 * t] = gp * p1; gw[2 * t + 1] = gp * p2;
            atomicAdd(&counts[e1], 1u); atomicAdd(&counts[e2], 1u);
        }
    }
    __syncthreads();
}

using pg8::f32x4; using pg8::Unit; typedef unsigned short bf16_t;
DEVI float bf2f(unsigned short b) { return __uint_as_float(((unsigned)b) << 16); }
DEVI float bflo(unsigned w) { return __uint_as_float(w << 16); }
DEVI float bfhi(unsigned w) { return __uint_as_float(w & 0xFFFF0000u); }
DEVI unsigned cvt_pk_bf16(float lo, float hi) { unsigned r; asm volatile("v_cvt_pk_bf16_f32 %0, %1, %2" : "=v"(r) : "v"(lo), "v"(hi)); return r; }
DEVI uint2 pack4(const f32x4 v) { return make_uint2(cvt_pk_bf16(v[0], v[1]), cvt_pk_bf16(v[2], v[3])); }
DEVI float fsigm(float x) { return 1.0f / (1.0f + __expf(-x)); }
DEVI unsigned pack4_fp8(const f32x4 v) { int w = __builtin_amdgcn_cvt_pk_fp8_f32(v[0], v[1], 0, false); w = __builtin_amdgcn_cvt_pk_fp8_f32(v[2], v[3], w, true); return (unsigned)w; }

DEVI int in0_srccol(int n) {
    if (n < 1024) { const int G = n >> 5, nn = (n >> 4) & 1, i = n & 15; return (nn ? OFF_AGATE : OFF_AVAL) + 16 * G + i; }
    if (n < 2048 || (n >= 2560 && n < 3072)) {
        const int base = n < 1536 ? OFF_Q : n < 2048 ? OFF_K : OFF_QI; const int loc = n & 511;
        const int G = loc >> 5, nn = (loc >> 4) & 1, i = loc & 15; return base + 64 * (G >> 1) + 32 * nn + 16 * (G & 1) + i; }
    if (n < 2560) return OFF_V + (n - 2048);
    if (n < 3136) { const int loc = n - 3072; const int G = loc >> 5, nn = (loc >> 4) & 1, i = loc & 15; return OFF_KI + 32 * nn + 16 * G + i; }
    if (n < 3144) return OFF_WI + (n - 3136);
    return -1;
}
struct EpiIn0 {
    static constexpr bool PERM = false, AFTER_DRAIN = false;
    bf16_t* GLU; bf16_t* KI; float* WI; const float* ropeC; const float* ropeS; unsigned char* KV8;
    DEVI void operator()(const f32x4 (&acc)[2][2][4][2], const Unit& u, int wr, int wc, int fr, int fq) const {
        const int pn = u.pn; const int rbase = u.pm * 256 + wr * 64 + fr;
        if (pn < 4) {
#pragma unroll
            for (int ai = 0; ai < 2; ++ai)
#pragma unroll
                for (int m = 0; m < 4; ++m) { const size_t row = rbase + ai * 128 + m * 16;
#pragma unroll
                    for (int bj = 0; bj < 2; ++bj) { const int G = 8 * pn + 4 * bj + wc; const f32x4 v = acc[ai][bj][m][0], g = acc[ai][bj][m][1]; f32x4 o;
#pragma unroll
                        for (int j = 0; j < 4; ++j) o[j] = v[j] * fsigm(g[j]);
                        *(uint2*)(GLU + row * 512 + 16 * G + 4 * fq) = pack4(o); } }
        } else if (pn == 8 || pn == 9) {
#pragma unroll
            for (int ai = 0; ai < 2; ++ai)
#pragma unroll
                for (int m = 0; m < 4; ++m) { const size_t row = rbase + ai * 128 + m * 16;
#pragma unroll
                    for (int bj = 0; bj < 2; ++bj)
#pragma unroll
                        for (int n = 0; n < 2; ++n) { const int col = 256 * (pn - 8) + 128 * bj + 32 * wc + 16 * n + 4 * fq;
                            *(unsigned*)(KV8 + row * 1024 + (size_t)(col >> 3) * 16 + 8 + (col & 7)) = pack4_fp8(acc[ai][bj][m][n]); } }
        } else if (pn == 12) {
            if (wc < 2) { const int d0 = 16 * wc + 4 * fq;
#pragma unroll
                for (int ai = 0; ai < 2; ++ai)
#pragma unroll
                    for (int m = 0; m < 4; ++m) { const size_t row = rbase + ai * 128 + m * 16;
                        const f32x4 c = *(const f32x4*)(ropeC + row * 32 + d0), s = *(const f32x4*)(ropeS + row * 32 + d0);
                        const f32x4 t1 = acc[ai][0][m][0], t2 = acc[ai][0][m][1];
                        *(uint2*)(KI + row * 64 + d0) = pack4(t1 * c - t2 * s); *(uint2*)(KI + row * 64 + 32 + d0) = pack4(t1 * s + t2 * c); }
            } else if (wc == 2 && fq < 2) {
#pragma unroll
                for (int ai = 0; ai < 2; ++ai)
#pragma unroll
                    for (int m = 0; m < 4; ++m) { const size_t row = rbase + ai * 128 + m * 16; *(f32x4*)(WI + row * 8 + 4 * fq) = acc[ai][0][m][0] * 0.35355339059327373f; }
            }
        } else {
            bf16_t* dst = GLU + (size_t)(pn < 6 ? 1 : pn < 8 ? 2 : 4) * LP * 512; const int pl = pn & 1; const int d0 = 16 * (wc & 1) + 4 * fq;
#pragma unroll
            for (int ai = 0; ai < 2; ++ai)
#pragma unroll
                for (int m = 0; m < 4; ++m) { const size_t row = rbase + ai * 128 + m * 16;
                    const f32x4 c = *(const f32x4*)(ropeC + row * 32 + d0), s = *(const f32x4*)(ropeS + row * 32 + d0);
#pragma unroll
                    for (int bj = 0; bj < 2; ++bj) { const int hh = 4 * pl + 2 * bj + (wc >> 1); const f32x4 t1 = acc[ai][bj][m][0], t2 = acc[ai][bj][m][1];
                        if (pn == 6 || pn == 7) { const int da = 64 * hh + d0, db = da + 32;
                            *(unsigned*)(KV8 + row * 1024 + (size_t)(da >> 3) * 16 + (da & 7)) = pack4_fp8(t1 * c - t2 * s); *(unsigned*)(KV8 + row * 1024 + (size_t)(db >> 3) * 16 + (db & 7)) = pack4_fp8(t1 * s + t2 * c);
                        } else { *(uint2*)(dst + row * 512 + 64 * hh + d0) = pack4(t1 * c - t2 * s); *(uint2*)(dst + row * 512 + 64 * hh + 32 + d0) = pack4(t1 * s + t2 * c); } } }
        }
    }
};
struct EpiRes0 {
    static constexpr bool PERM = false, AFTER_DRAIN = false;
    const float* x; const float* meta; float* Z;
    DEVI void operator()(const f32x4 (&acc)[2][2][4][2], const Unit& u, int wr, int wc, int fr, int fq) const {
        const int rbase = u.pm * 256 + wr * 64 + fr, cbase = u.pn * 256 + wc * 32 + 4 * fq;
#pragma unroll
        for (int ai = 0; ai < 2; ++ai)
#pragma unroll
            for (int m = 0; m < 4; ++m) { const int row = rbase + ai * 128 + m * 16;
                if (row < L) { const float* rs = row < NMETA ? meta + (size_t)row * D : x + (size_t)(row - NMETA) * D;
#pragma unroll
                    for (int bj = 0; bj < 2; ++bj)
#pragma unroll
                        for (int n = 0; n < 2; ++n) { const int col = cbase + 128 * bj + 16 * n; const f32x4 r4 = *(const f32x4*)(rs + col); *(f32x4*)(Z + (size_t)row * D + col) = r4 * DN_ALPHA + acc[ai][bj][m][n]; } } }
    }
};
struct EpiGateUp {
    static constexpr bool PERM = false, AFTER_DRAIN = false;
    bf16_t* Hm;
    DEVI void operator()(const f32x4 (&acc)[2][2][4][2], const Unit& u, int wr, int wc, int fr, int fq) const {
        const int pl = u.pn & 3; const int rbase = u.pm * 256 + wr * 64 + fr;
#pragma unroll
        for (int ai = 0; ai < 2; ++ai)
#pragma unroll
            for (int m = 0; m < 4; ++m) { const size_t row = rbase + ai * 128 + m * 16;
#pragma unroll
                for (int bj = 0; bj < 2; ++bj) { const int G = 8 * pl + 4 * bj + wc; const f32x4 g = acc[ai][bj][m][0], up = acc[ai][bj][m][1]; f32x4 o;
#pragma unroll
                    for (int j = 0; j < 4; ++j) o[j] = g[j] * fsigm(g[j]) * up[j];
                    *(uint2*)(Hm + row * 512 + 16 * G + 4 * fq) = pack4(o); } }
    }
};
struct EpiDown {
    static constexpr bool PERM = false, AFTER_DRAIN = false;
    bf16_t* Y;
    DEVI void operator()(const f32x4 (&acc)[2][2][4][2], const Unit& u, int wr, int wc, int fr, int fq) const {
        const int pl = u.pn & 3; const int rbase = u.pm * 256 + wr * 64 + fr, cbase = pl * 256 + wc * 32 + 4 * fq;
#pragma unroll
        for (int ai = 0; ai < 2; ++ai)
#pragma unroll
            for (int m = 0; m < 4; ++m) { const size_t row = rbase + ai * 128 + m * 16;
#pragma unroll
                for (int bj = 0; bj < 2; ++bj)
#pragma unroll
                    for (int n = 0; n < 2; ++n) *(uint2*)(Y + row * 1024 + cbase + 128 * bj + 16 * n) = pack4(acc[ai][bj][m][n]); }
    }
};
struct MoeOrder {
    const int* mt; int nunits, G, c;
    DEVI void init(const int* t, int G_, int c_) { mt = t; nunits = t[0] * 4; G = G_; c = c_; }
    DEVI bool next(int i, Unit& u) const { const int li = i * G + c; if (li >= nunits) return false; const int ti = li >> 2; u.pm = ti; u.pn = mt[4 + ti] * 4 + (li & 3); return true; }
    DEVI void a_ready(const Unit&) const {}
    DEVI void done(const Unit&) const {}
};

template <class F> DEVI void tr_tile(bf16_t* dst, int K, int n0, int k0, F src, float* sm) {
    const int tid = otid();
    __syncthreads();
    { const int nn = tid & 63, kb = tid >> 6;
#pragma unroll
      for (int p = 0; p < 8; ++p) { const int kk = kb + 8 * p; sm[kk * 65 + nn] = src(n0 + nn, k0 + kk); } }
    __syncthreads();
    { const int nn = tid >> 3, kq = (tid & 7) * 8; float v[8];
#pragma unroll
      for (int j = 0; j < 8; ++j) v[j] = sm[(kq + j) * 65 + nn];
      uint4 w; w.x = cvt_pk_bf16(v[0], v[1]); w.y = cvt_pk_bf16(v[2], v[3]); w.z = cvt_pk_bf16(v[4], v[5]); w.w = cvt_pk_bf16(v[6], v[7]);
      *(uint4*)(dst + (size_t)(n0 + nn) * K + k0 + kq) = w; }
}

struct TrJob { bf16_t* dst; const float* s0; const float* s1; int K, n0, k0, ld, mode; };
DEVI float tr_src(const TrJob& J, int n, int k) {
    if (J.mode == 0) return __builtin_nontemporal_load(J.s0 + (size_t)k * J.ld + n);
    if (J.mode == 1) { const int sc = in0_srccol(n); return sc < 0 ? 0.f : __builtin_nontemporal_load(J.s0 + (size_t)k * IN_AB + sc); }
    const int ch = (n >> 5) * 16 + (n & 15); return ((n >> 4) & 1) ? __builtin_nontemporal_load(J.s1 + (size_t)k * DE + ch) : __builtin_nontemporal_load(J.s0 + (size_t)k * DE + ch);
}
DEVI void tr_fetch(const TrJob& J, float (&v)[8]) {
    const int tid = otid(), nn = tid & 63, kb = tid >> 6;
#pragma unroll
    for (int p = 0; p < 8; ++p) v[p] = tr_src(J, J.n0 + nn, J.k0 + kb + 8 * p);
}
DEVI void tr_commit(const TrJob& J, const float (&v)[8], float* sm) {
    const int tid = otid();
    __syncthreads();
    { const int nn = tid & 63, kb = tid >> 6;
#pragma unroll
      for (int p = 0; p < 8; ++p) sm[(kb + 8 * p) * 65 + nn] = v[p]; }
    __syncthreads();
    { const int nn = tid >> 3, kq = (tid & 7) * 8; float x[8];
#pragma unroll
      for (int j = 0; j < 8; ++j) x[j] = sm[(kq + j) * 65 + nn];
      uint4 w; w.x = cvt_pk_bf16(x[0], x[1]); w.y = cvt_pk_bf16(x[2], x[3]); w.z = cvt_pk_bf16(x[4], x[5]); w.w = cvt_pk_bf16(x[6], x[7]);
      *(uint4*)(J.dst + (size_t)(J.n0 + nn) * J.K + J.k0 + kq) = w; }
}
template <class Dec> DEVI void tr_run(int njobs, Dec dec, float* sm) {
    int j = blockIdx.x; const int G = gridDim.x;
    TrJob Ja{}, Jb{}; float va[8], vb[8];
    if (j < njobs) { Ja = dec(j); tr_fetch(Ja, va); }
    while (j < njobs) {
        int jn = j + G; if (jn < njobs) { Jb = dec(jn); tr_fetch(Jb, vb); }
        tr_commit(Ja, va, sm);
        j = jn; if (j >= njobs) break;
        jn = j + G; if (jn < njobs) { Ja = dec(jn); tr_fetch(Ja, va); }
        tr_commit(Jb, vb, sm);
        j = jn;
    }
    __syncthreads();
}

DEVI void moe_dispatch_mfma(const float* H, const int* eid, const unsigned* counts, unsigned* cursor, int* slot, int* mtiles, bf16_t* Xperm, int* sm_i, int gwave, int nwaves, int lane, int p_begin) {
    if (otid() == 0) { int o = 0; for (int e = 0; e < NE; ++e) { sm_i[e] = o; o += (((int)counts[e] + 255) >> 8) << 8; } }
    __syncthreads();
    for (int pb = p_begin + gwave * 16; pb < NPAIR; pb += nwaves * 16) {
        int sl = 0;
        if (lane < 16 && pb + lane < NPAIR) { const int e = eid[pb + lane]; sl = sm_i[e] + (int)atomicAdd(&cursor[e], 1u); slot[pb + lane] = sl; }
#pragma unroll 4
        for (int k = 0; k < 16; ++k) { const int p = pb + k; if (p >= NPAIR) break;
            const int s = __shfl(sl, k);
            const float4* src = (const float4*)(H + (size_t)(p >> 1) * D); uint2* dst = (uint2*)(Xperm + (size_t)s * D);
#pragma unroll
            for (int r = 0; r < 4; ++r) { const float4 v = src[lane + 64 * r]; dst[lane + 64 * r] = make_uint2(cvt_pk_bf16(v.x, v.y), cvt_pk_bf16(v.z, v.w)); } }
    }
    if (blockIdx.x == 0 && otid() == 0) { int n = 0; for (int e = 0; e < NE; ++e) { const int nt = ((int)counts[e] + 255) >> 8; for (int i = 0; i < nt; ++i) mtiles[4 + n++] = e; } mtiles[0] = n; }
    __syncthreads();
}

DEVI float gelu_fast(float x) { return x * fsigm(1.5957691216057308f * (x + 0.044715f * x * x * x)); }
struct EpiIn1 {
    static constexpr bool PERM = false, AFTER_DRAIN = false;
    bf16_t* G;
    DEVI void operator()(const f32x4 (&acc)[2][2][4][2], const Unit& u, int wr, int wc, int fr, int fq) const {
        const int pn = u.pn; const bool is_gate = pn < 5; const int rbase = u.pm * 256 + wr * 64 + fr;
        bf16_t* dst = G + (is_gate ? (size_t)0 : (size_t)LP * RNN_W) + (size_t)((is_gate ? pn : pn - 5) * 256 + wc * 32 + 4 * fq);
#pragma unroll
        for (int ai = 0; ai < 2; ++ai)
#pragma unroll
            for (int m = 0; m < 4; ++m) { const size_t row = rbase + ai * 128 + m * 16;
#pragma unroll
                for (int bj = 0; bj < 2; ++bj)
#pragma unroll
                    for (int n = 0; n < 2; ++n) { f32x4 v = acc[ai][bj][m][n];
                        if (is_gate) {
#pragma unroll
                            for (int j = 0; j < 4; ++j) v[j] = gelu_fast(v[j]); }
                        *(uint2*)(dst + row * RNN_W + 128 * bj + 16 * n) = pack4(v); } }
    }
};
struct EpiRes1 {
    static constexpr bool PERM = false, AFTER_DRAIN = false;
    const float* R; float* Z;
    DEVI void operator()(const f32x4 (&acc)[2][2][4][2], const Unit& u, int wr, int wc, int fr, int fq) const {
        const int rbase = u.pm * 256 + wr * 64 + fr, cbase = u.pn * 256 + wc * 32 + 4 * fq;
#pragma unroll
        for (int ai = 0; ai < 2; ++ai)
#pragma unroll
            for (int m = 0; m < 4; ++m) { const size_t row = rbase + ai * 128 + m * 16;
#pragma unroll
                for (int bj = 0; bj < 2; ++bj)
#pragma unroll
                    for (int n = 0; n < 2; ++n) { const int col = cbase + 128 * bj + 16 * n; const f32x4 r4 = *(const f32x4*)(R + row * D + col); *(f32x4*)(Z + row * D + col) = r4 * DN_ALPHA + acc[ai][bj][m][n]; } }
    }
};

typedef short bf16x8_t __attribute__((ext_vector_type(8)));
template <bool FINAL>
DEVI void rglru_unit(int c, int nb, const bf16_t* __restrict__ XR, const bf16_t* __restrict__ GATEg, const bf16_t* __restrict__ Wta, const bf16_t* __restrict__ Wtx,
                     const float* __restrict__ cw, const float* __restrict__ cb, const float* __restrict__ ba, const float* __restrict__ bx, const float* __restrict__ lam,
                     float* __restrict__ Aend, float* __restrict__ Hend, const float* __restrict__ CIN, bf16_t* __restrict__ YY, unsigned char* lds) {
    const int tid = otid(), lane = tid & 63, w = tid >> 6, col = lane & 15, quad = lane >> 4;
    bf16_t* xcb = (bf16_t*)lds;
    float* xcf = (float*)(lds + 64 * 136 * 2);
    const int t0 = c * 64, ch0 = nb * RNN_BW;
    bf16x8_t fa[4], fx[4];
    { const size_t wrow = ((size_t)nb * 128 + 16 * w + col) * 128 + 8 * quad;
#pragma unroll
      for (int ks = 0; ks < 4; ++ks) { fa[ks] = *(const bf16x8_t*)(Wta + wrow + 32 * ks); fx[ks] = *(const bf16x8_t*)(Wtx + wrow + 32 * ks); } }
    const int ch = ch0 + 16 * w + col;
    const float bav = ba[ch], bxv = bx[ch], lamv = lam[ch];
    const float cinv = FINAL ? CIN[(size_t)ch * CP + c] : 0.f;
    __syncthreads();
    {
        const int c8 = tid & 15, tr = tid >> 4;
        float wv[4][8], bv[8];
#pragma unroll
        for (int j = 0; j < 4; ++j) { const float4 w0 = *(const float4*)(cw + j * RNN_W + ch0 + 8 * c8), w1 = *(const float4*)(cw + j * RNN_W + ch0 + 8 * c8 + 4);
            wv[j][0] = w0.x; wv[j][1] = w0.y; wv[j][2] = w0.z; wv[j][3] = w0.w; wv[j][4] = w1.x; wv[j][5] = w1.y; wv[j][6] = w1.z; wv[j][7] = w1.w; }
        { const float4 b0 = *(const float4*)(cb + ch0 + 8 * c8), b1 = *(const float4*)(cb + ch0 + 8 * c8 + 4); bv[0] = b0.x; bv[1] = b0.y; bv[2] = b0.z; bv[3] = b0.w; bv[4] = b1.x; bv[5] = b1.y; bv[6] = b1.z; bv[7] = b1.w; }
#pragma unroll
        for (int half = 0; half < 2; ++half) { const int tl = tr + 32 * half, t = t0 + tl;
            float v[8];
#pragma unroll
            for (int i = 0; i < 8; ++i) v[i] = bv[i];
#pragma unroll
            for (int j = 0; j < 4; ++j) { const int tt = t - 3 + j;
                if (tt >= 0) { const uint4 xv = *(const uint4*)(XR + (size_t)tt * RNN_W + ch0 + 8 * c8);
                    v[0] += wv[j][0] * bflo(xv.x); v[1] += wv[j][1] * bfhi(xv.x); v[2] += wv[j][2] * bflo(xv.y); v[3] += wv[j][3] * bfhi(xv.y);
                    v[4] += wv[j][4] * bflo(xv.z); v[5] += wv[j][5] * bfhi(xv.z); v[6] += wv[j][6] * bflo(xv.w); v[7] += wv[j][7] * bfhi(xv.w); } }
            *(float4*)(xcf + tl * 132 + 8 * c8) = make_float4(v[0], v[1], v[2], v[3]); *(float4*)(xcf + tl * 132 + 8 * c8 + 4) = make_float4(v[4], v[5], v[6], v[7]);
            uint4 pk; pk.x = cvt_pk_bf16(v[0], v[1]); pk.y = cvt_pk_bf16(v[2], v[3]); pk.z = cvt_pk_bf16(v[4], v[5]); pk.w = cvt_pk_bf16(v[6], v[7]);
            *(uint4*)(xcb + tl * 136 + 8 * c8) = pk; }
    }
    __syncthreads();
    f32x4 ca[4], cx[4];
    {
#pragma unroll
        for (int mt = 0; mt < 4; ++mt) { ca[mt] = (f32x4){0.f, 0.f, 0.f, 0.f}; cx[mt] = (f32x4){0.f, 0.f, 0.f, 0.f};
#pragma unroll
            for (int ks = 0; ks < 4; ++ks) { const bf16x8_t af = *(const bf16x8_t*)(xcb + (16 * mt + col) * 136 + 32 * ks + 8 * quad);
                ca[mt] = __builtin_amdgcn_mfma_f32_16x16x32_bf16(af, fa[ks], ca[mt], 0, 0, 0);
                cx[mt] = __builtin_amdgcn_mfma_f32_16x16x32_bf16(af, fx[ks], cx[mt], 0, 0, 0); } }
    }
    const float sp = log1pf(expf(-lamv));
    float av[4][4], uv[4][4], As[4], Hs[4];
#pragma unroll
    for (int mt = 0; mt < 4; ++mt) { float A = 1.f, H = 0.f;
#pragma unroll
        for (int j = 0; j < 4; ++j) { const int tl = 16 * mt + 4 * quad + j;
            const float xcv = xcf[tl * 132 + 16 * w + col];
            const float r = fsigm(ca[mt][j] + bav), ig = fsigm(cx[mt][j] + bxv);
            const float la = -8.0f * r * sp;
            const float x2 = 2.0f * la;
            float em1 = x2 * (1.0f + x2 * (0.5f + x2 * (0.16666667f + x2 * (0.041666668f + x2 * (0.0083333338f + x2 * (0.0013888889f + x2 * 0.0001984127f))))));
            if (x2 < -0.5f) em1 = expm1f(x2);
            float a_ = __expf(la), u_ = sqrtf(-em1) * (ig * xcv);
            if (t0 + tl >= L) { a_ = 1.f; u_ = 0.f; }
            av[mt][j] = a_; uv[mt][j] = u_; H = a_ * H + u_; A *= a_; }
        As[mt] = A; Hs[mt] = H; }
    float carry = cinv, prod = 1.f, hin[4];
#pragma unroll
    for (int s = 0; s < 16; ++s) { const int mt = s >> 2, q = s & 3;
        if (quad == q) hin[mt] = carry;
        const float nw = As[mt] * carry + Hs[mt], np = As[mt] * prod;
        carry = __shfl(nw, q * 16 + col); prod = __shfl(np, q * 16 + col); }
    if (!FINAL) {
        if (quad == 0) { Aend[(size_t)ch * CP + c] = prod; Hend[(size_t)ch * CP + c] = carry; }
    } else {
#pragma unroll
        for (int mt = 0; mt < 4; ++mt) { float h = hin[mt];
#pragma unroll
            for (int j = 0; j < 4; ++j) { h = av[mt][j] * h + uv[mt][j]; xcf[(16 * mt + 4 * quad + j) * 132 + 16 * w + col] = h; } }
        __syncthreads();
        const int c8 = tid & 15, tr = tid >> 4;
#pragma unroll
        for (int half = 0; half < 2; ++half) { const int tl = tr + 32 * half, t = t0 + tl;
            if (t >= NMETA && t < L) {
                const float4 h0 = *(const float4*)(xcf + tl * 132 + 8 * c8), h1 = *(const float4*)(xcf + tl * 132 + 8 * c8 + 4);
                const uint4 g = *(const uint4*)(GATEg + (size_t)t * RNN_W + ch0 + 8 * c8);
                uint4 pk; pk.x = cvt_pk_bf16(bflo(g.x) * h0.x, bfhi(g.x) * h0.y); pk.y = cvt_pk_bf16(bflo(g.y) * h0.z, bfhi(g.y) * h0.w);
                pk.z = cvt_pk_bf16(bflo(g.z) * h1.x, bfhi(g.z) * h1.y); pk.w = cvt_pk_bf16(bflo(g.w) * h1.z, bfhi(g.w) * h1.w);
                *(uint4*)(YY + (size_t)t * RNN_W + ch0 + 8 * c8) = pk; } }
    }
}

constexpr int SW = 544;
constexpr int CB = 704;
constexpr int NTILE = L / 16;
typedef float f32x16 __attribute__((ext_vector_type(16)));
typedef float f32x2v __attribute__((ext_vector_type(2)));
constexpr int HROW = 2112;
constexpr int IL_HIST = 0, IL_CKEY = 0, IL_CIDX = 16 * CB * 4, IL_HIST2 = 2 * 16 * CB * 4, IL_ROWB = IL_HIST2 + 16 * 256 * 4, IL_WI = 16 * HROW * 4, IL_QST = IL_WI + 512, IL_QST2 = IL_QST + 256, IL_CCNT = IL_QST2 + 256, IL_FLAG = IL_CCNT + 64;
static_assert(IL_ROWB + 8 * SW * 4 <= IL_WI && IL_FLAG + 64 <= LDS_BYTES - 16, "indexer LDS");

DEVI float relu_i(float x) { const int v = __float_as_int(x); return __int_as_float(v > 0 ? v : 0); }
DEVI int hpos(unsigned w) { return (int)(w + (w >> 5)); }
template <int PASS, bool L0>
DEVI void idx_sweep(int q0, int nkb, int wave, int lane, const bf16x8_t (&Af)[4][4], const bf16_t* __restrict__ KI, unsigned char* lds, unsigned* __restrict__ SELM) {
    const int l31 = lane & 31, h2 = lane >> 5;
    unsigned* hist = (unsigned*)(lds + IL_HIST);
    const float* wiL = (const float*)(lds + IL_WI);
    const uint4* qst = (const uint4*)(lds + IL_QST);
    const uint4* qst2 = (const uint4*)(lds + IL_QST2);
    unsigned* ckey = (unsigned*)(lds + IL_CKEY); unsigned* cidx = (unsigned*)(lds + IL_CIDX); unsigned* ccnt = (unsigned*)(lds + IL_CCNT);
    const bf16_t* kp = KI + (size_t)l31 * 64 + 8 * h2;
    bf16x8_t Bn[4];
    if (wave < nkb) {
#pragma unroll
        for (int ks = 0; ks < 4; ++ks) Bn[ks] = *(const bf16x8_t*)(kp + (size_t)wave * 2048 + 16 * ks); }
    for (int kb = wave; kb < nkb; kb += 8) {
        const int s = kb * 32 + l31;
        bf16x8_t Bf[4];
#pragma unroll
        for (int ks = 0; ks < 4; ++ks) Bf[ks] = Bn[ks];
        if (kb + 8 < nkb) {
#pragma unroll
            for (int ks = 0; ks < 4; ++ks) Bn[ks] = *(const bf16x8_t*)(kp + (size_t)(kb + 8) * 2048 + 16 * ks); }
        f32x16 acc[4];
#pragma unroll
        for (int rb = 0; rb < 4; ++rb) {
#pragma unroll
            for (int i = 0; i < 16; ++i) acc[rb][i] = 0.f; }
#pragma unroll
        for (int ks = 0; ks < 4; ++ks)
#pragma unroll
            for (int rb = 0; rb < 4; ++rb) acc[rb] = __builtin_amdgcn_mfma_f32_32x32x16_bf16(Af[rb][ks], Bf[ks], acc[rb], 0, 0, 0);
        const bool edge = kb * 32 + 31 > q0;
#pragma unroll
        for (int rb = 0; rb < 4; ++rb) {
            const int qa = 4 * rb + 2 * h2;
            float4 w[2][2]; uint4 st[2];
#pragma unroll
            for (int e = 0; e < 2; ++e) { w[e][0] = *(const float4*)(wiL + (qa + e) * 8); w[e][1] = *(const float4*)(wiL + (qa + e) * 8 + 4);
                if (PASS == 2) st[e] = qst2[qa + e]; else if (!L0) st[e] = qst[qa + e]; }
#pragma unroll
            for (int e = 0; e < 2; ++e) {
                const int qs = qa + e;
                f32x2v s2 = (f32x2v){relu_i(acc[rb][8 * e + 0]), relu_i(acc[rb][8 * e + 1])} * (f32x2v){w[e][0].x, w[e][0].y};
                s2 = (f32x2v){relu_i(acc[rb][8 * e + 2]), relu_i(acc[rb][8 * e + 3])} * (f32x2v){w[e][0].z, w[e][0].w} + s2;
                s2 = (f32x2v){relu_i(acc[rb][8 * e + 4]), relu_i(acc[rb][8 * e + 5])} * (f32x2v){w[e][1].x, w[e][1].y} + s2;
                s2 = (f32x2v){relu_i(acc[rb][8 * e + 6]), relu_i(acc[rb][8 * e + 7])} * (f32x2v){w[e][1].z, w[e][1].w} + s2;
                const float sc = s2[0] + s2[1];
                const bool valid = !edge || s <= q0 + qs;
                const unsigned key = f2key(sc);
                if (PASS == 1) {
                    if (L0) { if (valid) { const unsigned bin = key >> 20; atomicAdd(&hist[qs * HROW + hpos(bin >> 1)], (bin & 1u) ? 0x10000u : 1u); } }
                    else if (valid && (key & st[e].x) == st[e].y) { const unsigned bin = (key >> st[e].z) & st[e].w; atomicAdd(&hist[qs * HROW + hpos(bin >> 1)], (bin & 1u) ? 0x10000u : 1u); }
                } else {
                    const bool all = st[e].z == 0xFFFFFFFFu;
                    const bool sel = valid && (all || key >= st[e].y);
                    const bool cnd = valid && !all && key >= st[e].x && key < st[e].y;
                    const unsigned long long bal = __ballot(sel);
                    if (l31 == 0) SELM[(size_t)(q0 + qs) * SW + kb] = h2 ? (unsigned)(bal >> 32) : (unsigned)bal;
                    if (cnd) { const unsigned n = atomicAdd(&ccnt[qs], 1u); if (n < (unsigned)CB) { ckey[qs * CB + n] = key; cidx[qs * CB + n] = (unsigned)s; } }
                }
            }
        }
    }
}

DEVI void indexer_tile(int q0, const bf16_t* __restrict__ QI, const bf16_t* __restrict__ KI, const float* __restrict__ WI, unsigned* __restrict__ SELM, unsigned* __restrict__ SELM2, unsigned char* lds) {
    const int tid = otid(), lane = tid & 63, wave = tid >> 6;
    unsigned* hist = (unsigned*)(lds + IL_HIST);
    float* wiL = (float*)(lds + IL_WI);
    uint4* qst = (uint4*)(lds + IL_QST); uint4* qst2 = (uint4*)(lds + IL_QST2);
    unsigned* ckey = (unsigned*)(lds + IL_CKEY); unsigned* cidx = (unsigned*)(lds + IL_CIDX); unsigned* hist2 = (unsigned*)(lds + IL_HIST2); unsigned* ccnt = (unsigned*)(lds + IL_CCNT);
    volatile unsigned* flag = (volatile unsigned*)(lds + IL_FLAG);
    const int nkb = (q0 + 16 + 31) >> 5;
    bf16x8_t Af[4][4];
    { const int rho = lane & 31, hq = lane >> 5; const int qq = 2 * ((rho >> 2) & 1) + (rho >> 4), head = 4 * ((rho >> 3) & 1) + (rho & 3);
#pragma unroll
      for (int rb = 0; rb < 4; ++rb)
#pragma unroll
          for (int ks = 0; ks < 4; ++ks) Af[rb][ks] = *(const bf16x8_t*)(QI + (size_t)(q0 + 4 * rb + qq) * 512 + head * 64 + 16 * ks + 8 * hq); }
    __syncthreads();
    if (tid < 128) wiL[tid] = WI[(size_t)q0 * 8 + tid] * 0.125f;
    if (tid < 16) { qst[tid] = make_uint4(0u, 0u, 20u, 4095u); qst2[tid] = make_uint4(0u, 0u, (unsigned)TOPK, 0u); ccnt[tid] = 0u; }
    for (int level = 0; level < 3; ++level) {
        for (int i = tid; i < 16 * HROW / 4; i += NTHREADS) ((uint4*)hist)[i] = make_uint4(0u, 0u, 0u, 0u);
        if (tid == 0) flag[0] = 0u;
        __syncthreads();
        if (level == 0) idx_sweep<1, true>(q0, nkb, wave, lane, Af, KI, lds, SELM); else idx_sweep<1, false>(q0, nkb, wave, lane, Af, KI, lds, SELM);
        __syncthreads();
#pragma unroll 1
        for (int qi = 0; qi < 2; ++qi) {
            const int qs = 2 * wave + qi;
            const uint4 st = qst[qs]; const uint4 b = qst2[qs];
            if (st.x == 0xFFFFFFFFu && st.y == 0u && st.w == 0u) continue;
            unsigned wv[32]; unsigned loc = 0u;
#pragma unroll
            for (int i = 0; i < 32; ++i) { wv[i] = hist[qs * HROW + 33 * lane + i]; loc += (wv[i] & 0xFFFFu) + (wv[i] >> 16); }
            unsigned suf = loc;
#pragma unroll
            for (int off = 1; off < 64; off <<= 1) { const unsigned o = __shfl_down(suf, off); if (lane + off < 64) suf += o; }
            const unsigned total = __shfl(suf, 0), above = suf - loc, need = b.z;
            if (level == 0 && total <= need) { if (lane == 0) { qst[qs] = make_uint4(0xFFFFFFFFu, 0u, 0u, 0u); qst2[qs] = make_uint4(0u, 0u, 0xFFFFFFFFu, 0u); } continue; }
            const bool mine = above < need && need <= above + loc;
            unsigned cum = above, c = 0u; int d = 0; bool found = false;
#pragma unroll
            for (int i = 31; i >= 0; --i) {
                const unsigned chi = wv[i] >> 16, clo = wv[i] & 0xFFFFu;
                if (!found && cum + chi >= need) { found = true; d = 64 * lane + 2 * i + 1; c = chi; } if (!found) cum += chi;
                if (!found && cum + clo >= need) { found = true; d = 64 * lane + 2 * i; c = clo; } if (!found) cum += clo; }
            if (mine) {
                const unsigned pval = st.y | ((unsigned)d << st.z), pmask = st.x | (st.w << st.z);
                const unsigned nneed = need - cum;
                const unsigned long long hi64 = (unsigned long long)pval + (1ull << st.z);
                const unsigned hi = hi64 > 0xFFFFFFFFull ? 0xFFFFFFFFu : (unsigned)hi64;
                if (c <= (unsigned)CB || level == 2) { qst[qs] = make_uint4(0xFFFFFFFFu, 0u, 0u, 0u); qst2[qs] = make_uint4(pval, hi, nneed, st.z); }
                else { const unsigned nsh = (level == 0) ? 8u : 0u, ndm = (level == 0) ? 4095u : 255u; qst[qs] = make_uint4(pmask, pval, nsh, ndm); qst2[qs] = make_uint4(pval, hi, nneed, st.z); flag[0] = 1u; }
            }
        }
        __syncthreads();
        if (flag[0] == 0u) break;
        __syncthreads();
    }
    __syncthreads();
    idx_sweep<2, false>(q0, nkb, wave, lane, Af, KI, lds, SELM);
    asm volatile("s_waitcnt vmcnt(0)" ::: "memory");
    __syncthreads();
#pragma unroll 1
    for (int qi = 0; qi < 2; ++qi) {
        const int qs = 2 * wave + qi;
        const uint4 b = qst2[qs];
        unsigned* rowb = (unsigned*)(lds + IL_ROWB) + wave * SW;
        unsigned* SR2 = SELM2 + (size_t)(q0 + qs) * SW;
        for (int i = lane; i < SW; i += 64) rowb[i] = 0u;
        asm volatile("s_waitcnt lgkmcnt(0)" ::: "memory");
        if (b.z != 0xFFFFFFFFu) {
            const unsigned need = b.z; const unsigned cn = ccnt[qs]; const int n = (int)(cn < (unsigned)CB ? cn : (unsigned)CB);
            const unsigned rem = b.w;
            const unsigned sh8 = rem > 8u ? rem - 8u : 0u; const unsigned m8 = rem >= 8u ? 255u : ((1u << rem) - 1u);
#pragma unroll
            for (int i = 0; i < 4; ++i) hist2[qs * 256 + 4 * lane + i] = 0u;
            asm volatile("s_waitcnt lgkmcnt(0)" ::: "memory");
            for (int i = lane; i < n; i += 64) atomicAdd(&hist2[qs * 256 + ((ckey[qs * CB + i] >> sh8) & m8)], 1u);
            asm volatile("s_waitcnt lgkmcnt(0)" ::: "memory");
            unsigned c4[4]; unsigned loc = 0u;
#pragma unroll
            for (int i = 0; i < 4; ++i) { c4[i] = hist2[qs * 256 + 4 * lane + i]; loc += c4[i]; }
            unsigned suf = loc;
#pragma unroll
            for (int off = 1; off < 64; off <<= 1) { const unsigned o = __shfl_down(suf, off); if (lane + off < 64) suf += o; }
            const unsigned above = suf - loc;
            const bool mine = above < need && need <= above + loc;
            unsigned b2 = 0u, need2 = 0u;
            if (mine) { unsigned cum = above; int i = 3; for (; i > 0; --i) { if (cum + c4[i] >= need) break; cum += c4[i]; } b2 = 4u * lane + i; need2 = need - cum; }
            const unsigned long long mb = __ballot(mine);
            if (mb == 0ull) {
                for (int i = lane; i < n; i += 64) if ((unsigned)i < need) { const unsigned ii = cidx[qs * CB + i]; atomicOr(&rowb[ii >> 5], 1u << (ii & 31u)); }
            } else {
                const int src = __ffsll((long long)mb) - 1;
                b2 = __shfl(b2, src); need2 = __shfl(need2, src);
                for (int i = lane; i < n; i += 64) {
                    const unsigned ki = ckey[qs * CB + i], ii = cidx[qs * CB + i]; const unsigned d8 = (ki >> sh8) & m8;
                    bool take = d8 > b2;
                    if (d8 == b2) { unsigned rank = 0u;
                        for (int j = 0; j < n; ++j) { const unsigned kj = ckey[qs * CB + j], ij = cidx[qs * CB + j]; if (((kj >> sh8) & m8) == b2 && (kj > ki || (kj == ki && ij < ii))) ++rank; }
                        take = rank < need2; }
                    if (take) atomicOr(&rowb[ii >> 5], 1u << (ii & 31u));
                }
            }
        }
        asm volatile("s_waitcnt lgkmcnt(0)" ::: "memory");
        for (int i = lane; i < SW; i += 64) SR2[i] = rowb[i];
        asm volatile("s_waitcnt lgkmcnt(0)" ::: "memory");
    }
}

constexpr int AW_BYTES = 512;
typedef short s16x2 __attribute__((ext_vector_type(2)));
DEVI float dot2bf(unsigned a, unsigned b, float c) { return __builtin_amdgcn_fdot2_f32_bf16(__builtin_bit_cast(s16x2, a), __builtin_bit_cast(s16x2, b), c, false); }
#define LDS_FENCE() asm volatile("s_waitcnt lgkmcnt(0)" ::: "memory")

struct AttnQ { float m, l, o[8]; };

DEVI void attn_issue(int b0, int n, const unsigned short* lst, const unsigned char* __restrict__ KV8, int lane, uint4 (&kv)[8]) {
    const int last = n - 1;
#pragma unroll
    for (int kk = 0; kk < 8; ++kk) { const int ii = b0 + kk; const int key = lst[ii < last ? ii : last]; kv[kk] = *(const uint4*)(KV8 + (size_t)key * 1024 + lane * 16); }
}
DEVI void attn_compute(AttnQ& S, int b0, int n, const float (&q)[8], const uint4 (&kv)[8]) {
    float sc[8]; float mx = S.m;
#pragma unroll
    for (int u = 0; u < 8; ++u) {
        const f32x2v k0 = __builtin_amdgcn_cvt_pk_f32_fp8((int)kv[u].x, false), k1 = __builtin_amdgcn_cvt_pk_f32_fp8((int)kv[u].x, true),
                     k2 = __builtin_amdgcn_cvt_pk_f32_fp8((int)kv[u].y, false), k3 = __builtin_amdgcn_cvt_pk_f32_fp8((int)kv[u].y, true);
        f32x2v d2 = k0 * (f32x2v){q[0], q[1]}; d2 = k1 * (f32x2v){q[2], q[3]} + d2; d2 = k2 * (f32x2v){q[4], q[5]} + d2; d2 = k3 * (f32x2v){q[6], q[7]} + d2;
        float d = d2[0] + d2[1];
        d += dpp_f<0xB1>(d); d += dpp_f<0x4E>(d); d += dpp_f<0x141>(d);
        sc[u] = (b0 + u < n) ? d : -INFINITY;
        mx = fmaxf(mx, sc[u]); }
    const float scale = __builtin_amdgcn_exp2f(S.m - mx);
    float ls = S.l * scale;
#pragma unroll
    for (int i = 0; i < 8; ++i) S.o[i] *= scale;
#pragma unroll
    for (int u = 0; u < 8; ++u) {
        const float p = __builtin_amdgcn_exp2f(sc[u] - mx); ls += p;
        const f32x2v v0 = __builtin_amdgcn_cvt_pk_f32_fp8((int)kv[u].z, false), v1 = __builtin_amdgcn_cvt_pk_f32_fp8((int)kv[u].z, true),
                     v2 = __builtin_amdgcn_cvt_pk_f32_fp8((int)kv[u].w, false), v3 = __builtin_amdgcn_cvt_pk_f32_fp8((int)kv[u].w, true);
        S.o[0] += p * v0[0]; S.o[1] += p * v0[1]; S.o[2] += p * v1[0]; S.o[3] += p * v1[1]; S.o[4] += p * v2[0]; S.o[5] += p * v2[1]; S.o[6] += p * v3[0]; S.o[7] += p * v3[1]; }
    S.l = ls; S.m = mx;
}

DEVI void attn_query(int t, const bf16_t* __restrict__ Qb, const unsigned char* __restrict__ KV8,
                     const unsigned* __restrict__ SELM, const unsigned* __restrict__ SELM2, bf16_t* __restrict__ AO, unsigned char* wl, int lane) {
    unsigned short* lst = (unsigned short*)wl;
    const unsigned* SR = SELM + (size_t)t * SW; const unsigned* SR2 = SELM2 + (size_t)t * SW;
    LDS_FENCE();
    const int nw = (t >> 5) + 1; int base = 0;
    for (int w0 = 0; w0 < nw; w0 += 64) {
        const int wi = w0 + lane; const unsigned wv = wi < nw ? (SR[wi] | SR2[wi]) : 0u;
        const int pc = __popc(wv); int pre = pc;
#pragma unroll
        for (int off = 1; off < 64; off <<= 1) { const int o_ = __shfl_up(pre, off); if (lane >= off) pre += o_; }
        int pos = base + pre - pc; unsigned mm = wv;
        while (mm) { const int bpos = __ffs((int)mm) - 1; mm &= mm - 1u; if (pos < TOPK) lst[pos] = (unsigned short)(wi * 32 + bpos); ++pos; }
        base += __shfl(pre, 63);
    }
    const int n = base < TOPK ? base : TOPK;
    float q[8];
    { const uint4 qv = ((const uint4*)(Qb + (size_t)t * 512))[lane]; const float qs = 0.18033688011112042f;
      q[0] = bflo(qv.x) * qs; q[1] = bfhi(qv.x) * qs; q[2] = bflo(qv.y) * qs; q[3] = bfhi(qv.y) * qs; q[4] = bflo(qv.z) * qs; q[5] = bfhi(qv.z) * qs; q[6] = bflo(qv.w) * qs; q[7] = bfhi(qv.w) * qs; }
    LDS_FENCE();
    AttnQ S; S.m = -INFINITY; S.l = 0.f;
#pragma unroll
    for (int d = 0; d < 8; ++d) S.o[d] = 0.f;
    uint4 ka[8], kb_[8], kc[8];
    attn_issue(0, n, lst, KV8, lane, ka);
    if (8 < n) attn_issue(8, n, lst, KV8, lane, kb_);
    for (int b0 = 0; b0 < n; b0 += 24) {
        if (b0 + 16 < n) attn_issue(b0 + 16, n, lst, KV8, lane, kc);
        attn_compute(S, b0, n, q, ka);
        if (b0 + 8 < n) {
            if (b0 + 24 < n) attn_issue(b0 + 24, n, lst, KV8, lane, ka);
            attn_compute(S, b0 + 8, n, q, kb_);
            if (b0 + 16 < n) {
                if (b0 + 32 < n) attn_issue(b0 + 32, n, lst, KV8, lane, kb_);
                attn_compute(S, b0 + 16, n, q, kc);
            }
        }
    }
    const int hd = lane >> 3, ch = lane & 7;
    const float inv = 1.0f / S.l;
    uint4 pk; pk.x = cvt_pk_bf16(S.o[0] * inv, S.o[1] * inv); pk.y = cvt_pk_bf16(S.o[2] * inv, S.o[3] * inv); pk.z = cvt_pk_bf16(S.o[4] * inv, S.o[5] * inv); pk.w = cvt_pk_bf16(S.o[6] * inv, S.o[7] * inv);
    *(uint4*)(AO + (size_t)t * 1024 + 512 + hd * 64 + ch * 8) = pk;
}

__global__ void __launch_bounds__(NTHREADS, 2) fwd(Args a) {
    extern __shared__ __attribute__((aligned(16))) unsigned char lds_raw[];
    float* smf = (float*)lds_raw;
    PG8_LAS unsigned char* ldsp = (PG8_LAS unsigned char*)lds_raw;
    const int nwaves = gridDim.x * 8;
#define PHASE_VARS const int tid = otid(); const int lane = tid & 63, wave = tid >> 6; const int gwave = blockIdx.x * 8 + wave; (void)lane; (void)wave; (void)gwave;
    unsigned char* ws = a.ws;
    unsigned* ctl = (unsigned*)(ws + WS_CTL);
    const int lo = a.ph_lo, hi = a.ph_hi;

    volatile LAS unsigned* bst = (volatile LAS unsigned*)((LAS unsigned char*)lds_raw + (LDS_BYTES - 16));
    if (threadIdx.x == 0) { bst[0] = 0u; bst[1] = 0u; bst[2] = 0u; bst[3] = 0u; }
    __syncthreads();
    XcdBarrier bar; bar.bar = ctl; bar.x = 0; bar.st = bst;
    if (hi - lo > 1) bar = xcd_barrier_post(ctl, bst);
#define IN(k) (lo <= (k) && (k) < hi)
#define SEAM(k) do { if (IN(k) && IN((k) + 1)) xcd_barrier(bar); } while (0)

    const float* x = a.in[0]; const float* meta = a.in[1];
    float* ropeC = (float*)(ws + WS_ROPEC); float* ropeS = (float*)(ws + WS_ROPES);
    int* eid = (int*)(ws + WS_EID); float* gw = (float*)(ws + WS_GW); int* slot = (int*)(ws + WS_SLOT); int* mtiles = (int*)(ws + WS_MTILES);
    unsigned* counts0 = (unsigned*)(ws + CTL_CNT); unsigned* counts1 = counts0 + 32;
    unsigned* cursor0 = (unsigned*)(ws + CTL_CUR); unsigned* cursor1 = cursor0 + 32;
    bf16_t* Wta = (bf16_t*)(ws + WS_WTA); bf16_t* Wtx = (bf16_t*)(ws + WS_WTX);
    float* Aend = (float*)(ws + WS_AEND); float* Hend = (float*)(ws + WS_HEND); float* CIN = (float*)(ws + WS_CIN);
    unsigned char* big = ws + WS_BIG;
    bf16_t* WIN0 = (bf16_t*)(big + R_WIN0); bf16_t* WOUT0 = (bf16_t*)(big + R_WOUT0); bf16_t* WGU = (bf16_t*)(big + R_WGU); bf16_t* WD = (bf16_t*)(big + R_WD);
    bf16_t* WIN1 = (bf16_t*)(big + R_WIN1); bf16_t* WOUT1 = (bf16_t*)(big + R_WOUT1);
    bf16_t* X0b = (bf16_t*)(big + R_A); bf16_t* AO = (bf16_t*)(big + R_A); bf16_t* Xperm = (bf16_t*)(big + R_A); bf16_t* X2b = (bf16_t*)(big + R_A); bf16_t* YY = (bf16_t*)(big + R_A);
    float* H1 = (float*)(big + R_H1); float* H3 = (float*)(big + R_H1); float* H2 = (float*)(big + R_H2); unsigned* SELM = (unsigned*)(big + R_H1); unsigned* SELM2 = (unsigned*)(big + R_H1 + 36 * MiB);
    float* Z = (float*)(big + R_C); bf16_t* Yb = (bf16_t*)(big + R_C); float* Z1 = (float*)(big + R_C);
    unsigned char* KV8 = big + R_K;
    bf16_t* GLU = (bf16_t*)(big + R_GLU); bf16_t* Qb = (bf16_t*)(big + R_Q); bf16_t* Kb = (bf16_t*)(big + R_K); bf16_t* Vb = (bf16_t*)(big + R_V);
    bf16_t* QIb = (bf16_t*)(big + R_QI); bf16_t* KIb = (bf16_t*)(big + R_KI); float* WIf = (float*)(big + R_WI);
    bf16_t* GATEg = (bf16_t*)(big + R_GATE); bf16_t* XRb = (bf16_t*)(big + R_XR);
    bf16_t* Hm = (bf16_t*)(big + R_HM);

    if (IN(0)) { PHASE_VARS;
        const float* w_in = a.in[2]; const float* w_out = a.in[7]; const float* wg = a.in[21]; const float* wu = a.in[22]; const float* wd = a.in[23];
        constexpr int J_IN0 = 52 * 16, J_OUT0 = 16 * 16, J_GU = 32 * 256, J_D = 32 * 128, J_IN1 = 40 * 16, J_OUT1 = 16 * 20, J_GT = 80;
        const float* w_in1 = a.in[8]; const float* w_out1 = a.in[16]; const float* wga = a.in[11]; const float* wgx = a.in[13];
        tr_run(J_IN0 + J_OUT0 + J_GU + J_D + J_IN1 + J_OUT1 + J_GT, [&](int j) -> TrJob {
            TrJob J{};
            if (j < J_IN0) { J.dst = WIN0; J.s0 = w_in; J.K = 1024; J.n0 = (j >> 4) * 64; J.k0 = (j & 15) * 64; J.mode = 1; return J; }
            j -= J_IN0;
            if (j < J_OUT0) { J.dst = WOUT0; J.s0 = w_out; J.ld = D; J.K = 1024; J.n0 = (j >> 4) * 64; J.k0 = (j & 15) * 64; J.mode = 0; return J; }
            j -= J_OUT0;
            if (j < J_GU) { const int e = j >> 8, t = j & 255; J.dst = WGU + (size_t)e * 1024 * 1024; J.s0 = wg + (size_t)e * D * DE; J.s1 = wu + (size_t)e * D * DE; J.K = 1024; J.n0 = (t >> 4) * 64; J.k0 = (t & 15) * 64; J.mode = 2; return J; }
            j -= J_GU;
            if (j < J_D) { const int e = j >> 7, t = j & 127; J.dst = WD + (size_t)e * 1024 * 512; J.s0 = wd + (size_t)e * DE * D; J.ld = D; J.K = 512; J.n0 = (t >> 3) * 64; J.k0 = (t & 7) * 64; J.mode = 0; return J; }
            j -= J_D;
            if (j < J_IN1) { J.dst = WIN1; J.s0 = w_in1; J.ld = 2 * RNN_W; J.K = 1024; J.n0 = (j >> 4) * 64; J.k0 = (j & 15) * 64; J.mode = 0; return J; }
            j -= J_IN1;
            if (j < J_OUT1) { J.dst = WOUT1; J.s0 = w_out1; J.ld = D; J.K = RNN_W; J.n0 = (j / 20) * 64; J.k0 = (j % 20) * 64; J.mode = 0; return J; }
            j -= J_OUT1;
            { const int which = j / 40, r = j % 40; const int nb = r >> 2;
              J.dst = (which ? Wtx : Wta) + (size_t)nb * 128 * 128; J.s0 = (which ? wgx : wga) + (size_t)nb * 128 * 128; J.ld = 128; J.K = 128; J.n0 = ((r >> 1) & 1) * 64; J.k0 = (r & 1) * 64; J.mode = 0; return J; }
        }, smf);
        for (size_t i = (size_t)blockIdx.x * NTHREADS + tid; i < (size_t)LP * 256; i += (size_t)gridDim.x * NTHREADS) {
            const size_t r = i >> 8, c4 = i & 255;
            float4 v = make_float4(0.f, 0.f, 0.f, 0.f);
            if (r < NMETA) v = ((const float4*)meta)[r * 256 + c4]; else if (r < L) v = ((const float4*)x)[(r - NMETA) * 256 + c4];
            ((uint2*)X0b)[i] = make_uint2(cvt_pk_bf16(v.x, v.y), cvt_pk_bf16(v.z, v.w));
        }
        for (int i = blockIdx.x * NTHREADS + tid; i < 2 * 64 * 3 * 64; i += gridDim.x * NTHREADS) {
            const int ln = i & 63, ct = (i >> 6) % 3, ss = (i / 192) & 63, ly = i / (192 * 64);
            const int col = 16 * ct + (ln & 15), k0 = 16 * ss + 4 * (ln >> 4);
            float v[4];
#pragma unroll
            for (int j = 0; j < 4; ++j) v[j] = col < 4 ? a.in[17][(size_t)ly * D * NGRP + (size_t)(k0 + j) * NGRP + col] : col < 36 ? a.in[19][(size_t)ly * D * NE + (size_t)(k0 + j) * NE + (col - 4)] : 0.f;
            ((float4*)(ws + WS_WR))[i] = make_float4(v[0], v[1], v[2], v[3]);
        }
        for (int i = blockIdx.x * NTHREADS + tid; i < LP * 32; i += gridDim.x * NTHREADS) {
            const int p = i >> 5, f = i & 31;
            const float inv = (float)pow(10000.0, -(double)f / 32.0);
            const float ang = (float)p * inv;
            ropeC[i] = (float)cos((double)ang); ropeS[i] = (float)sin((double)ang);
        }
    }
    SEAM(0);
    if (IN(1)) { PHASE_VARS;
        pg8::Gemm g{X0b, WIN0, LP, 3328, 1024}; pg8::StaticOrder S; S.init(LP, 3328, (int)gridDim.x, (int)blockIdx.x);
        EpiIn0 E{GLU, KIb, WIf, ropeC, ropeS, KV8};
        pg8::gemm_phase<EpiIn0, pg8::StaticOrder>(ldsp, g, S, E);
    }
    SEAM(1);
    if (IN(2)) { PHASE_VARS;
        const float* cw = a.in[3]; const float* cb = a.in[4]; const float* lg = a.in[5]; const float* lb = a.in[6];
        for (int g4 = gwave; g4 < L / 4; g4 += nwaves) {
            const int t0 = g4 * 4, c0 = lane * 8;
            float acc[4][8], wwin[4][8];
            { const float4 b0 = *(const float4*)(cb + c0), b1 = *(const float4*)(cb + c0 + 4);
#pragma unroll
              for (int q = 0; q < 4; ++q) { acc[q][0] = b0.x; acc[q][1] = b0.y; acc[q][2] = b0.z; acc[q][3] = b0.w; acc[q][4] = b1.x; acc[q][5] = b1.y; acc[q][6] = b1.z; acc[q][7] = b1.w; } }
#pragma unroll
            for (int r = 0; r < CONV_K + 3; ++r) {
                const int tt = t0 - (CONV_K - 1) + r;
                if (r < CONV_K) { const float4 w0 = *(const float4*)(cw + r * CONV_CH + c0), w1 = *(const float4*)(cw + r * CONV_CH + c0 + 4);
                    wwin[r & 3][0] = w0.x; wwin[r & 3][1] = w0.y; wwin[r & 3][2] = w0.z; wwin[r & 3][3] = w0.w; wwin[r & 3][4] = w1.x; wwin[r & 3][5] = w1.y; wwin[r & 3][6] = w1.z; wwin[r & 3][7] = w1.w; }
                if (tt >= 0) {
                    const uint4 xv = *(const uint4*)(GLU + (size_t)tt * 512 + c0);
                    const float x[8] = {bflo(xv.x), bfhi(xv.x), bflo(xv.y), bfhi(xv.y), bflo(xv.z), bfhi(xv.z), bflo(xv.w), bfhi(xv.w)};
#pragma unroll
                    for (int q = 0; q < 4; ++q) { const int j = r - q;
                        if (j >= 0 && j < CONV_K) {
#pragma unroll
                            for (int i = 0; i < 8; ++i) acc[q][i] += wwin[j & 3][i] * x[i]; } }
                }
            }
            float gv[8], bvv[8];
            { const float4 g0 = *(const float4*)(lg + c0), g1 = *(const float4*)(lg + c0 + 4), b0 = *(const float4*)(lb + c0), b1 = *(const float4*)(lb + c0 + 4);
              gv[0] = g0.x; gv[1] = g0.y; gv[2] = g0.z; gv[3] = g0.w; gv[4] = g1.x; gv[5] = g1.y; gv[6] = g1.z; gv[7] = g1.w; bvv[0] = b0.x; bvv[1] = b0.y; bvv[2] = b0.z; bvv[3] = b0.w; bvv[4] = b1.x; bvv[5] = b1.y; bvv[6] = b1.z; bvv[7] = b1.w; }
#pragma unroll
            for (int q = 0; q < 4; ++q) {
                float s_ = 0.f;
#pragma unroll
                for (int i = 0; i < 8; ++i) s_ += acc[q][i];
                const float mu = wave_sum(s_) * (1.0f / 512.0f);
                float qq = 0.f;
#pragma unroll
                for (int i = 0; i < 8; ++i) { const float d = acc[q][i] - mu; qq += d * d; }
                const float rstd = 1.0f / sqrtf(wave_sum(qq) * (1.0f / 512.0f) + LN_EPS);
                float o[8];
#pragma unroll
                for (int i = 0; i < 8; ++i) { const float yv = (acc[q][i] - mu) * rstd * gv[i] + bvv[i]; o[i] = yv * fsigm(yv); }
                uint4 w; w.x = cvt_pk_bf16(o[0], o[1]); w.y = cvt_pk_bf16(o[2], o[3]); w.z = cvt_pk_bf16(o[4], o[5]); w.w = cvt_pk_bf16(o[6], o[7]);
                *(uint4*)(AO + (size_t)(t0 + q) * 1024 + c0) = w;
            }
        }
        for (int r = 0; ; ++r) {
            const int idx = r * (int)gridDim.x + ((r & 1) ? (int)gridDim.x - 1 - (int)blockIdx.x : (int)blockIdx.x);
            if (idx >= NTILE) break;
            indexer_tile((NTILE - 1 - idx) * 16, QIb, KIb, WIf, SELM, SELM2, lds_raw);
        }
    }
    SEAM(2);
    if (IN(3)) { PHASE_VARS;
        unsigned char* wl = lds_raw + wave * AW_BYTES;
        for (int t = gwave; t < L; t += nwaves) attn_query(t, Qb, KV8, SELM, SELM2, AO, wl, lane);
    }
    SEAM(3);
    if (IN(4)) { PHASE_VARS;
        pg8::Gemm g{AO, WOUT0, LP, 1024, 1024}; pg8::StaticOrder S; S.init(LP, 1024, (int)gridDim.x, (int)blockIdx.x);
        EpiRes0 E{x, meta, Z};
        pg8::gemm_phase<EpiRes0, pg8::StaticOrder>(ldsp, g, S, E);
    }
    SEAM(4);
    if (IN(5)) {
        for (int tb = blockIdx.x * 64; tb < L; tb += gridDim.x * 64)
            ln_route_block(tb, (L - tb) < 64 ? (L - tb) : 64, Z, H1, a.in[24], a.in[25], (const float4*)(ws + WS_WR), a.in[18], a.in[20], eid, gw, counts0, smf);
    }
    SEAM(5);
    if (IN(6)) { PHASE_VARS; moe_dispatch_mfma(H1, eid, counts0, cursor0, slot, mtiles, Xperm, (int*)lds_raw, gwave, nwaves, lane, 0); }
    SEAM(6);
    if (IN(7)) { PHASE_VARS;
        pg8::Gemm g{Xperm, WGU, MAXSLOT, 1024, 1024}; MoeOrder S; S.init(mtiles, (int)gridDim.x, (int)blockIdx.x);
        EpiGateUp E{Hm};
        pg8::gemm_phase<EpiGateUp, MoeOrder>(ldsp, g, S, E);
    }
    SEAM(7);
    if (IN(8)) { PHASE_VARS;
        pg8::Gemm g{Hm, WD, MAXSLOT, 1024, 512}; MoeOrder S; S.init(mtiles, (int)gridDim.x, (int)blockIdx.x);
        EpiDown E{Yb};
        pg8::gemm_phase<EpiDown, MoeOrder>(ldsp, g, S, E);
    }
    SEAM(8);
    if (IN(9)) { PHASE_VARS;
        for (int t = gwave; t < L; t += nwaves) {
            const int s0 = slot[2 * t], s1 = slot[2 * t + 1]; const float g0 = gw[2 * t], g1 = gw[2 * t + 1];
            float y[16];
            combine_row(y, H1 + (size_t)t * D, Yb + (size_t)s0 * D, Yb + (size_t)s1 * D, g0, g1, lane);
            ln_row1024v(y, a.in[26], a.in[27], lane);
#pragma unroll
            for (int i4 = 0; i4 < 4; ++i4) *(float4*)(H2 + (size_t)t * D + 16 * lane + 4 * i4) = make_float4(y[4 * i4], y[4 * i4 + 1], y[4 * i4 + 2], y[4 * i4 + 3]);
            uint4 p0, p1; p0.x = cvt_pk_bf16(y[0], y[1]); p0.y = cvt_pk_bf16(y[2], y[3]); p0.z = cvt_pk_bf16(y[4], y[5]); p0.w = cvt_pk_bf16(y[6], y[7]);
            p1.x = cvt_pk_bf16(y[8], y[9]); p1.y = cvt_pk_bf16(y[10], y[11]); p1.z = cvt_pk_bf16(y[12], y[13]); p1.w = cvt_pk_bf16(y[14], y[15]);
            *(uint4*)(X2b + (size_t)t * D + 16 * lane) = p0; *(uint4*)(X2b + (size_t)t * D + 16 * lane + 8) = p1;
        }
        for (int i = blockIdx.x * NTHREADS + tid; i < (LP - L) * D / 8; i += gridDim.x * NTHREADS) ((uint4*)(X2b + (size_t)L * D))[i] = make_uint4(0u, 0u, 0u, 0u);
    }
    SEAM(9);
    if (IN(10)) {
        pg8::Gemm g{X2b, WIN1, LP, 2 * RNN_W, 1024}; pg8::StaticOrder S; S.init(LP, 2 * RNN_W, (int)gridDim.x, (int)blockIdx.x);
        EpiIn1 E{GATEg};
        pg8::gemm_phase<EpiIn1, pg8::StaticOrder>(ldsp, g, S, E);
    }
    SEAM(10);
    if (IN(11)) {
        for (int u = blockIdx.x; u < NCHUNK * RNN_NB; u += gridDim.x)
            rglru_unit<false>(u / RNN_NB, u % RNN_NB, XRb, GATEg, Wta, Wtx, a.in[9], a.in[10], a.in[12], a.in[14], a.in[15], Aend, Hend, CIN, YY, lds_raw);
    }
    SEAM(11);
    if (IN(12)) { PHASE_VARS;
        for (int ch = gwave; ch < RNN_W; ch += nwaves) {
            float A[5], H[5];
#pragma unroll
            for (int i = 0; i < 5; ++i) { const int c = 5 * lane + i; const bool ok = c < NCHUNK; A[i] = ok ? Aend[(size_t)ch * CP + c] : 1.f; H[i] = ok ? Hend[(size_t)ch * CP + c] : 0.f; }
            float Al = 1.f, Hl = 0.f;
#pragma unroll
            for (int i = 0; i < 5; ++i) { Hl = A[i] * Hl + H[i]; Al *= A[i]; }
#pragma unroll
            for (int off = 1; off < 64; off <<= 1) { const float Ap = __shfl_up(Al, off), Hp = __shfl_up(Hl, off); if (lane >= off) { Hl = Al * Hp + Hl; Al = Al * Ap; } }
            float cin = __shfl_up(Hl, 1); if (lane == 0) cin = 0.f;
#pragma unroll
            for (int i = 0; i < 5; ++i) { const int c = 5 * lane + i; if (c < NCHUNK) { CIN[(size_t)ch * CP + c] = cin; cin = A[i] * cin + H[i]; } }
        }
    }
    SEAM(12);
    if (IN(13)) {
        for (int u = blockIdx.x; u < NCHUNK * RNN_NB; u += gridDim.x)
            rglru_unit<true>(u / RNN_NB, u % RNN_NB, XRb, GATEg, Wta, Wtx, a.in[9], a.in[10], a.in[12], a.in[14], a.in[15], Aend, Hend, CIN, YY, lds_raw);
    }
    SEAM(13);
    if (IN(14)) {
        pg8::Gemm g{YY + (size_t)NMETA * RNN_W, WOUT1, SEQ, 1024, RNN_W}; pg8::StaticOrder S; S.init(SEQ, 1024, (int)gridDim.x, (int)blockIdx.x);
        EpiRes1 E{H2 + (size_t)NMETA * D, Z1 + (size_t)NMETA * D};
        pg8::gemm_phase<EpiRes1, pg8::StaticOrder>(ldsp, g, S, E);
    }
    SEAM(14);
    if (IN(15)) { PHASE_VARS;
        const float* wg = a.in[21] + (size_t)NE * D * DE; const float* wu = a.in[22] + (size_t)NE * D * DE; const float* wd = a.in[23] + (size_t)NE * DE * D;
        constexpr int J_GU = 32 * 256, J_D = 32 * 128;
        tr_run(J_GU + J_D, [&](int j) -> TrJob {
            TrJob J{};
            if (j < J_GU) { const int e = j >> 8, t = j & 255; J.dst = WGU + (size_t)e * 1024 * 1024; J.s0 = wg + (size_t)e * D * DE; J.s1 = wu + (size_t)e * D * DE; J.K = 1024; J.n0 = (t >> 4) * 64; J.k0 = (t & 15) * 64; J.mode = 2; return J; }
            j -= J_GU;
            { const int e = j >> 7, t = j & 127; J.dst = WD + (size_t)e * 1024 * 512; J.s0 = wd + (size_t)e * DE * D; J.ld = D; J.K = 512; J.n0 = (t >> 3) * 64; J.k0 = (t & 7) * 64; J.mode = 0; return J; }
        }, smf);
        __syncthreads();
        for (int tb = NMETA + blockIdx.x * 64; tb < L; tb += gridDim.x * 64)
            ln_route_block(tb, (L - tb) < 64 ? (L - tb) : 64, Z1, H3, a.in[24] + D, a.in[25] + D, (const float4*)(ws + WS_WR) + 64 * 3 * 64, a.in[18] + NGRP, a.in[20] + NE, eid, gw, counts1, smf);
    }
    SEAM(15);
    if (IN(16)) { PHASE_VARS; moe_dispatch_mfma(H3, eid, counts1, cursor1, slot, mtiles, Xperm, (int*)lds_raw, gwave, nwaves, lane, 2 * NMETA); }
    SEAM(16);
    if (IN(17)) {
        pg8::Gemm g{Xperm, WGU, MAXSLOT, 1024, 1024}; MoeOrder S; S.init(mtiles, (int)gridDim.x, (int)blockIdx.x);
        EpiGateUp E{Hm};
        pg8::gemm_phase<EpiGateUp, MoeOrder>(ldsp, g, S, E);
    }
    SEAM(17);
    if (IN(18)) {
        pg8::Gemm g{Hm, WD, MAXSLOT, 1024, 512}; MoeOrder S; S.init(mtiles, (int)gridDim.x, (int)blockIdx.x);
        EpiDown E{Yb};
        pg8::gemm_phase<EpiDown, MoeOrder>(ldsp, g, S, E);
    }
    SEAM(18);
    if (IN(19)) { PHASE_VARS;
        for (int t = NMETA + gwave; t < L; t += nwaves) {
            const int s0 = slot[2 * t], s1 = slot[2 * t + 1]; const float g0 = gw[2 * t], g1 = gw[2 * t + 1];
            float y[16];
            combine_row(y, H3 + (size_t)t * D, Yb + (size_t)s0 * D, Yb + (size_t)s1 * D, g0, g1, lane);
            ln_row1024v(y, a.in[26] + D, a.in[27] + D, lane);
#pragma unroll
            for (int i4 = 0; i4 < 4; ++i4) *(float4*)(a.out + (size_t)(t - NMETA) * D + 16 * lane + 4 * i4) = make_float4(y[4 * i4], y[4 * i4 + 1], y[4 * i4 + 2], y[4 * i4 + 3]);
        }
    }
#undef IN
#undef SEAM
}
constexpr int N_PHASES = 20;

extern "C" void kernel_launch(void* const* d_in, const int* in_sizes, int n_in, void* d_out, int out_size, void* d_ws, size_t ws_size, hipStream_t stream) {
    static int grid = 0;
    if (grid == 0) {
        if (n_in != 28 || out_size != SEQ * D || ws_size < WS_END) { fprintf(stderr, "kernel_launch: unexpected shapes n_in %d out %d ws %zu (need %zu)\n", n_in, out_size, ws_size, (size_t)WS_END); grid = -1; return; }
        int dev = 0, cus = 0;
        if (hipGetDevice(&dev) != hipSuccess || hipDeviceGetAttribute(&cus, hipDeviceAttributeMultiprocessorCount, dev) != hipSuccess) { grid = -1; return; }
        if (hipFuncSetAttribute((const void*)fwd, hipFuncAttributeMaxDynamicSharedMemorySize, LDS_BYTES) != hipSuccess) { fprintf(stderr, "kernel_launch: hipFuncSetAttribute failed\n"); grid = -1; return; }
        int per_cu = 0;
        if (hipOccupancyMaxActiveBlocksPerMultiprocessor(&per_cu, (const void*)fwd, NTHREADS, LDS_BYTES) != hipSuccess || per_cu < 1) fprintf(stderr, "kernel_launch: occupancy query says %d\n", per_cu);
        (void)hipGetLastError();
        grid = cus;
    }
    if (grid < 0) return;
    (void)hipMemsetAsync((char*)d_ws + WS_CTL, 0, CTL_BYTES, stream);
    Args a{};
    for (int i = 0; i < 28; ++i) a.in[i] = (const float*)d_in[i];
    a.out = (float*)d_out; a.ws = (unsigned char*)d_ws;
#if N_LAUNCH_MODE == 1
    a.ph_lo = 0; a.ph_hi = N_PHASES;
    hipLaunchKernelGGL(fwd, dim3(grid), dim3(NTHREADS), LDS_BYTES, stream, a);
#else
    for (int p = 0; p < N_PHASES; ++p) { a.ph_lo = p; a.ph_hi = p + 1; hipLaunchKernelGGL(fwd, dim3(grid), dim3(NTHREADS), LDS_BYTES, stream, a); }
#endif
}
```

```cpp
#include <hip/hip_runtime.h>
#include <cstdio>
#include <cstdint>
#include <cmath>

#ifndef N_LAUNCH_MODE
#define N_LAUNCH_MODE 1
#endif

#define DEVI __device__ __forceinline__
#define LAS __attribute__((address_space(3)))

constexpr int D = 1024, SEQ = 16384, NMETA = 16, L = SEQ + NMETA;
constexpr int CONV_CH = 512, CONV_K = 31, HD = 64, TOPK = 256;
constexpr int IN_AB = 3144;
constexpr int OFF_AVAL = 0, OFF_AGATE = 512, OFF_Q = 1024, OFF_K = 1536, OFF_V = 2048, OFF_QI = 2560, OFF_KI = 3072, OFF_WI = 3136;
constexpr int RNN_W = 1280, RNN_NB = 10, RNN_BW = 128, RNN_K = 4;
constexpr int NGRP = 4, EPG = 8, NE = 32, DE = 512;
constexpr int NPAIR = 2 * L;
constexpr float LN_EPS = 1e-5f;
constexpr float DN_ALPHA = 1.41421356237f;
constexpr int NTHREADS = 512;
constexpr int LDS_BYTES = 147456;

#define XB_TMO      128
#define XB_XCNT(j)  (256  + 64 * (j))
#define XB_XSUB(j)  (1280 + 64 * (j))
#define XB_XGEN(j)  (2304 + 64 * (j))
#define XB_TOP      3328
#define XB_TOPGEN   3392
#define XCD_BAR_WORDS 3456
#define XB_SPIN_CAP (1u << 22)
DEVI unsigned xb_ld(unsigned* p)              { return __hip_atomic_load(p, __ATOMIC_RELAXED, __HIP_MEMORY_SCOPE_AGENT); }
DEVI unsigned xb_add(unsigned* p, unsigned v) { return __hip_atomic_fetch_add(p, v, __ATOMIC_RELAXED, __HIP_MEMORY_SCOPE_AGENT); }
DEVI unsigned xb_xcc_id() { return (unsigned)__builtin_amdgcn_s_getreg((3 << 11) | 20) & 0xFu; }
#define XB_SPIN(cond, bar) do { unsigned _sp = 0; while (cond) { __builtin_amdgcn_s_sleep(1); \
    if ((++_sp & 255u) == 0u) { if (xb_ld(&(bar)[XB_TMO])) break; if (_sp > XB_SPIN_CAP) { atomicAdd(&(bar)[XB_TMO], 1u); break; } } } } while (0)
struct XcdBarrier { unsigned* bar; unsigned x; volatile LAS unsigned* st; };
DEVI XcdBarrier xcd_barrier_post(unsigned* bar, volatile LAS unsigned* st) {
    XcdBarrier b; b.bar = bar; b.x = xb_xcc_id(); b.st = st;
    if (threadIdx.x == 0) (void)xb_add(&bar[XB_XCNT(b.x)], 1u);
    return b;
}
DEVI void xcd_barrier_complete(unsigned* bar, unsigned x, unsigned& nloc, unsigned& nx) {
    const unsigned G = gridDim.x * gridDim.y * gridDim.z;
    unsigned sum, cnt, mine, sp = 0u;
    for (;;) {
        sum = 0u; cnt = 0u; mine = 0u;
#pragma unroll
        for (unsigned j = 0; j < 16; ++j) { const unsigned c = xb_ld(&bar[XB_XCNT(j)]); sum += c; cnt += (c > 0u) ? 1u : 0u; mine = (j == x) ? c : mine; }
        if (sum == G) break;
        __builtin_amdgcn_s_sleep(1);
        if ((++sp & 255u) == 0u) { if (xb_ld(&bar[XB_TMO])) break; if (sp > XB_SPIN_CAP) { atomicAdd(&bar[XB_TMO], 1u); break; } }
    }
    nloc = mine > 0u ? mine : 1u; nx = cnt > 0u ? cnt : 1u;
}
DEVI void xcd_barrier(const XcdBarrier& b) {
    asm volatile("s_waitcnt vmcnt(0)" ::: "memory");
    __syncthreads();
    if (threadIdx.x == 0) {
        unsigned* bar = b.bar;
        __builtin_amdgcn_s_waitcnt(0);
        unsigned nloc = b.st[0], nx = b.st[1];
        if (nloc == 0u) { xcd_barrier_complete(bar, b.x, nloc, nx); b.st[0] = nloc; b.st[1] = nx; }
        const unsigned old = xb_add(&bar[XB_XSUB(b.x)], 1u);
        const unsigned gen = old / nloc;
        if (old + 1u == (gen + 1u) * nloc) {
            __builtin_amdgcn_fence(__ATOMIC_RELEASE, "agent");
            asm volatile("s_waitcnt vmcnt(0)" ::: "memory");
            const unsigned og = xb_add(&bar[XB_TOP], 1u);
            const unsigned tg = og / nx;
            if (og + 1u == (tg + 1u) * nx) xb_add(&bar[XB_TOPGEN], 1u);
            else XB_SPIN(xb_ld(&bar[XB_TOPGEN]) == tg, bar);
            __builtin_amdgcn_fence(__ATOMIC_ACQUIRE, "agent");
            xb_add(&bar[XB_XGEN(b.x)], 1u);
            asm volatile("s_waitcnt vmcnt(0)" ::: "memory");
        } else {
            XB_SPIN(xb_ld(&bar[XB_XGEN(b.x)]) == gen, bar);
            __builtin_amdgcn_fence(__ATOMIC_ACQUIRE, "agent");
            asm volatile("s_waitcnt vmcnt(0)" ::: "memory");
        }
    }
    __syncthreads();
}

constexpr int LP = 16640;
constexpr int MAXSLOT = 40960;
constexpr int NCHUNK = 257, CP = 272;
constexpr size_t MiB = 1048576;
constexpr size_t WS_CTL = 0;
constexpr size_t CTL_CNT = 16384;
constexpr size_t CTL_CUR = 16384 + 256;
constexpr size_t CTL_BYTES = 32768;
constexpr size_t WS_ROPEC = 32768;
constexpr size_t WS_ROPES = WS_ROPEC + (size_t)LP * 32 * 4;
constexpr size_t WS_EID = WS_ROPES + (size_t)LP * 32 * 4;
constexpr size_t WS_GW = WS_EID + (size_t)NPAIR * 4;
constexpr size_t WS_SLOT = WS_GW + (size_t)NPAIR * 4;
constexpr size_t WS_MTILES = WS_SLOT + (size_t)NPAIR * 4;
constexpr size_t WS_WTA = WS_MTILES + 4096;
constexpr size_t WS_WTX = WS_WTA + (size_t)RNN_NB * 128 * 128 * 2;
constexpr size_t WS_AEND = WS_WTX + (size_t)RNN_NB * 128 * 128 * 2;
constexpr size_t WS_HEND = WS_AEND + (size_t)RNN_W * CP * 4;
constexpr size_t WS_CIN = WS_HEND + (size_t)RNN_W * CP * 4;
constexpr size_t WS_WR = WS_CIN + (size_t)RNN_W * CP * 4;
constexpr size_t WS_BIG = ((WS_WR + (size_t)2 * 64 * 3 * 64 * 16 + 255) / 256) * 256;
constexpr size_t R_WIN0 = 0;
constexpr size_t R_WOUT0 = R_WIN0 + (size_t)3328 * 1024 * 2;
constexpr size_t R_WGU = R_WOUT0 + (size_t)1024 * 1024 * 2;
constexpr size_t R_WD = R_WGU + (size_t)32 * 1024 * 1024 * 2;
constexpr size_t R_WIN1 = R_WD + (size_t)32 * 1024 * 512 * 2;
constexpr size_t R_WOUT1 = R_WIN1 + (size_t)2560 * 1024 * 2;
static_assert(R_WOUT1 + (size_t)1024 * 1280 * 2 <= 112 * MiB, "weights");
constexpr size_t R_A = 112 * MiB;
constexpr size_t R_H1 = 192 * MiB;
constexpr size_t R_H2 = 257 * MiB;
constexpr size_t R_C = 322 * MiB;
constexpr size_t R_GLU = 322 * MiB;
constexpr size_t SZ512 = (size_t)LP * 512 * 2;
constexpr size_t R_Q = R_GLU + SZ512, R_K = R_Q + SZ512, R_V = R_K + SZ512, R_QI = R_V + SZ512, R_KI = R_QI + SZ512, R_WI = R_KI + (size_t)LP * 64 * 2;
static_assert(R_WI + (size_t)LP * 8 * 4 <= 406 * MiB, "in-proj outputs");
constexpr size_t R_GATE = 322 * MiB;
constexpr size_t R_XR = R_GATE + (size_t)LP * 1280 * 2;
static_assert(R_XR + (size_t)LP * 1280 * 2 <= 406 * MiB, "layer-1 in-proj outputs");
constexpr size_t R_HM = 406 * MiB;
constexpr size_t WS_END = WS_BIG + R_HM + (size_t)MAXSLOT * 512 * 2;
static_assert(WS_END <= 512 * MiB, "ws");

struct Args { const float* in[28]; float* out; unsigned char* ws; int ph_lo, ph_hi; };

DEVI int otid() { int v = (int)threadIdx.x; asm volatile("" : "+v"(v)); return v; }
template <int CTRL> DEVI float dpp_f(float v) { return __int_as_float(__builtin_amdgcn_mov_dpp(__float_as_int(v), CTRL, 0xF, 0xF, true)); }
DEVI float wave_sum(float v) {
    v += dpp_f<0xB1>(v); v += dpp_f<0x4E>(v); v += dpp_f<0x141>(v); v += dpp_f<0x140>(v);
    return __int_as_float(__builtin_amdgcn_readlane(__float_as_int(v), 0)) + __int_as_float(__builtin_amdgcn_readlane(__float_as_int(v), 16))
         + __int_as_float(__builtin_amdgcn_readlane(__float_as_int(v), 32)) + __int_as_float(__builtin_amdgcn_readlane(__float_as_int(v), 48));
}
DEVI float wave_max(float v) {
#pragma unroll
    for (int o = 32; o > 0; o >>= 1) v = fmaxf(v, __shfl_xor(v, o));
    return v;
}
DEVI float sigm(float x) { return 1.0f / (1.0f + expf(-x)); }
DEVI float gelu_tanh(float x) { return 0.5f * x * (1.0f + tanhf(0.7978845608028654f * (x + 0.044715f * x * x * x))); }
DEVI unsigned f2key(float f) { unsigned u = __float_as_uint(f); return (u & 0x80000000u) ? ~u : (u | 0x80000000u); }

namespace pg8 {
#define PG8_LAS __attribute__((address_space(3)))
typedef unsigned short bf16_t;
typedef short bf16x8 __attribute__((ext_vector_type(8)));
typedef float f32x4 __attribute__((ext_vector_type(4)));
typedef unsigned u32x4 __attribute__((ext_vector_type(4)));
constexpr int BM = 256, BK = 64, HALF = 128, HTB = HALF * BK * 2  , STAGE_BYTES = 8 * HTB, NXCD = 8, WGM = 8;

__host__ __device__ __forceinline__ int lds_byte(int r, int c) { const int st = (r >> 4) * 2 + (c >> 5), rr = r & 15, cc = c & 31, ob = rr * 64 + cc * 2; return st * 1024 + (ob ^ (((ob >> 9) & 1) << 5)); }
__host__ __device__ __forceinline__ void stage_rc(int b, int& R, int& C) { const int st = b / 1024, sb = b % 1024, swz = sb ^ (((sb >> 9) & 1) << 5); R = (st >> 1) * 16 + swz / 64; C = (st & 1) * 32 + (swz % 64) / 2; }
__host__ __device__ __forceinline__ int perm32(int rho) { const int n = rho >> 4, i = rho & 15; return 8 * (i >> 2) + 4 * n + (i & 3); }

struct Unit { int pm, pn; };
struct Gemm { const bf16_t* A; const bf16_t* Bt; int M, N, K; };

struct StaticOrder {
    int nM, nN, nwg, G, c;
    __host__ __device__ void init(int M, int N, int G_, int c_) { nM = M / BM; nN = N / BM; nwg = nM * nN; G = G_; c = c_; }
    __host__ __device__ bool next(int i, Unit& u) const {
        const long L = (long)i * G + c; if (L >= nwg) return false;
        int wgid = (int)L; { const int q = nwg / NXCD, r = nwg % NXCD, xcd = wgid % NXCD, off = wgid / NXCD; wgid = (xcd < r ? xcd * (q + 1) : r * (q + 1) + (xcd - r) * q) + off; }
        const int nig = WGM * nN, gid = wgid / nig, fm = gid * WGM, gsz = (nM - fm) < WGM ? (nM - fm) : WGM;
        u.pm = fm + ((wgid % nig) % gsz); u.pn = (wgid % nig) / gsz; return true;
    }
    __device__ __forceinline__ void a_ready(const Unit&) const {}
    __device__ __forceinline__ void done(const Unit&) const {}
};

template <class Epi, class Sched>
__device__ __forceinline__ void gemm_phase(PG8_LAS unsigned char* lds, const Gemm g, const Sched& S, const Epi& E) {
    const int tid = threadIdx.x, wid = __builtin_amdgcn_readfirstlane(tid >> 6), lane = tid & 63, wr = wid >> 2, wc = wid & 3, fr = lane & 15, fq = lane >> 4;
    const int K = g.K, nt = K / BK;
    unsigned voffA[2], voffB[2];
#pragma unroll
    for (int i = 0; i < 2; ++i) { int R, C; stage_rc(tid * 16 + i * 8192, R, C); const int Rb = Epi::PERM ? ((R & ~31) + perm32(R & 31)) : R;
        voffA[i] = (unsigned)(R * K + C) * 2u; voffB[i] = (unsigned)(Rb * K + C) * 2u; }
    const size_t kstep = (size_t)(BK * 2);
    const size_t hstep = (size_t)HALF * K * 2;
    const size_t tstep = 2 * hstep;
    const unsigned ldsw = (unsigned)wid * 1024u;
    const int aoff = lds_byte(wr * 64 + fr, fq * 8), boff = lds_byte(wc * 32 + fr, fq * 8);
#define PG8_SA(b, h) (((b) * 2 + (h)) * HTB)
#define PG8_SB(b, h) ((4 + (b) * 2 + (h)) * HTB)
#define PG8_STAGE(bufoff, gbase, voff) do { _Pragma("unroll") for (int _i = 0; _i < 2; ++_i) \
        __builtin_amdgcn_global_load_lds((const unsigned*)((const char*)(gbase) + (voff)[_i]), (PG8_LAS unsigned*)(lds + (bufoff) + ldsw + _i * 8192), 16, 0, 0); } while (0)
#define PG8_LDA(dst, b, h) do { _Pragma("unroll") for (int m = 0; m < 4; ++m) _Pragma("unroll") for (int k = 0; k < 2; ++k) dst[m][k] = *(const PG8_LAS bf16x8*)(lds + PG8_SA(b, h) + aoff + m * 2048 + k * 1024); } while (0)
#define PG8_LDB(dst, b, h) do { _Pragma("unroll") for (int n = 0; n < 2; ++n) _Pragma("unroll") for (int k = 0; k < 2; ++k) dst[n][k] = *(const PG8_LAS bf16x8*)(lds + PG8_SB(b, h) + boff + n * 2048 + k * 1024); } while (0)
#define PG8_MMA(ai, bj, At, Bt) do { __builtin_amdgcn_s_setprio(1); _Pragma("unroll") for (int m = 0; m < 4; ++m) _Pragma("unroll") for (int n = 0; n < 2; ++n) _Pragma("unroll") for (int k = 0; k < 2; ++k) \
        acc[ai][bj][m][n] = __builtin_amdgcn_mfma_f32_16x16x32_bf16(Bt[n][k], At[m][k], acc[ai][bj][m][n], 0, 0, 0); __builtin_amdgcn_s_setprio(0); } while (0)
#define PG8_WAIT_V(n) asm volatile("s_waitcnt vmcnt(" #n ")" ::: "memory")
#define PG8_WAIT_L(n) asm volatile("s_waitcnt lgkmcnt(" #n ")" ::: "memory")
#define PG8_BAR __builtin_amdgcn_s_barrier()
#define PG8_SCHED __builtin_amdgcn_sched_barrier(0)
    Unit cur, nxt; int ui = 0;
    if (!S.next(0, cur)) return;
    f32x4 acc[2][2][4][2];
#pragma unroll
    for (int a = 0; a < 2; ++a)
#pragma unroll
        for (int b = 0; b < 2; ++b)
#pragma unroll
            for (int m = 0; m < 4; ++m)
#pragma unroll
                for (int n = 0; n < 2; ++n) acc[a][b][m][n] = (f32x4){0.f, 0.f, 0.f, 0.f};
    bf16x8 At[4][2], B0[2][2], B1[2][2];
    const char* cA = (const char*)g.A + (size_t)cur.pm * tstep; const char* cB = (const char*)g.Bt + (size_t)cur.pn * tstep;
    S.a_ready(cur);
    PG8_STAGE(PG8_SB(0, 0), cB, voffB); PG8_STAGE(PG8_SA(0, 0), cA, voffA); PG8_STAGE(PG8_SB(0, 1), cB + hstep, voffB); PG8_STAGE(PG8_SA(0, 1), cA + hstep, voffA);
    if (wr == 1) PG8_BAR;
    PG8_WAIT_V(4); PG8_BAR;
    PG8_STAGE(PG8_SB(1, 0), cB + kstep, voffB); PG8_STAGE(PG8_SA(1, 0), cA + kstep, voffA); PG8_STAGE(PG8_SB(1, 1), cB + hstep + kstep, voffB);
    PG8_WAIT_V(6); PG8_BAR;
    for (;;) {
        const bool has_next = S.next(ui + 1, nxt);
        const char* nA = has_next ? (const char*)g.A + (size_t)nxt.pm * tstep : cA; const char* nB = has_next ? (const char*)g.Bt + (size_t)nxt.pn * tstep : cB;
        for (int t = 0; t < nt; t += 2) {
            const bool last = (t == nt - 2);
            const char* a1 = cA + (size_t)(t + 1) * kstep;
            const char* a2 = last ? nA : cA + (size_t)(t + 2) * kstep; const char* b2 = last ? nB : cB + (size_t)(t + 2) * kstep;
            const char* a3 = a2 + kstep; const char* b3 = b2 + kstep;
            if (last && has_next) S.a_ready(nxt);
            PG8_LDB(B0, 0, 0); PG8_SCHED; PG8_LDA(At, 0, 0); PG8_STAGE(PG8_SA(1, 1), a1 + hstep, voffA);
            PG8_WAIT_L(8); PG8_BAR; PG8_WAIT_L(0); PG8_MMA(0, 0, At, B0); PG8_BAR; PG8_SCHED;
            PG8_LDB(B1, 0, 1); PG8_STAGE(PG8_SB(0, 0), b2, voffB);
            PG8_BAR; PG8_WAIT_L(0); PG8_MMA(0, 1, At, B1); PG8_BAR;
            PG8_LDA(At, 0, 1); PG8_STAGE(PG8_SA(0, 0), a2, voffA);
            PG8_BAR; PG8_WAIT_L(0); PG8_MMA(1, 0, At, B0); PG8_BAR; PG8_SCHED;
            PG8_STAGE(PG8_SB(0, 1), b2 + hstep, voffB);
            PG8_WAIT_V(6); PG8_BAR; PG8_MMA(1, 1, At, B1); PG8_BAR;
            PG8_LDB(B0, 1, 0); PG8_SCHED; PG8_LDA(At, 1, 0); PG8_STAGE(PG8_SA(0, 1), a2 + hstep, voffA);
            PG8_WAIT_L(8); PG8_BAR; PG8_WAIT_L(0); PG8_MMA(0, 0, At, B0); PG8_BAR; PG8_SCHED;
            PG8_LDB(B1, 1, 1); PG8_STAGE(PG8_SB(1, 0), b3, voffB);
            PG8_BAR; PG8_WAIT_L(0); PG8_MMA(0, 1, At, B1); PG8_BAR;
            PG8_LDA(At, 1, 1); PG8_STAGE(PG8_SA(1, 0), a3, voffA);
            PG8_BAR; PG8_WAIT_L(0); PG8_MMA(1, 0, At, B0); PG8_BAR; PG8_SCHED;
            PG8_STAGE(PG8_SB(1, 1), b3 + hstep, voffB);
            PG8_WAIT_V(6); PG8_BAR; PG8_MMA(1, 1, At, B1); PG8_BAR;
        }
        if constexpr (!Epi::AFTER_DRAIN) { E(acc, cur, wr, wc, fr, fq); S.done(cur); }
        if (!has_next) break;
#pragma unroll
        for (int a = 0; a < 2; ++a)
#pragma unroll
            for (int b = 0; b < 2; ++b)
#pragma unroll
                for (int m = 0; m < 4; ++m)
#pragma unroll
                    for (int n = 0; n < 2; ++n) acc[a][b][m][n] = (f32x4){0.f, 0.f, 0.f, 0.f};
        cur = nxt; cA = nA; cB = nB; ++ui;
    }
    PG8_WAIT_V(0);
    if (wr == 0) PG8_BAR;
    PG8_BAR;
    if constexpr (Epi::AFTER_DRAIN) { E.fused(acc, cur, wr, wc, fr, fq, lds, wid, lane); S.done(cur); }
#undef PG8_SA
#undef PG8_SB
#undef PG8_STAGE
#undef PG8_LDA
#undef PG8_LDB
#undef PG8_MMA
#undef PG8_WAIT_V
#undef PG8_WAIT_L
#undef PG8_BAR
#undef PG8_SCHED
}
}

DEVI void ln_row1024(float (&y)[16], const float* g, const float* b, int lane) {
    float s = 0.f;
#pragma unroll
    for (int i = 0; i < 16; ++i) s += y[i];
    const float mu = wave_sum(s) * (1.0f / 1024.0f);
    float q = 0.f;
#pragma unroll
    for (int i = 0; i < 16; ++i) { const float d = y[i] - mu; q += d * d; }
    const float rstd = 1.0f / sqrtf(wave_sum(q) * (1.0f / 1024.0f) + LN_EPS);
#pragma unroll
    for (int i = 0; i < 16; ++i) y[i] = (y[i] - mu) * rstd * g[lane + 64 * i] + b[lane + 64 * i];
}

DEVI void route_token(const float (&y)[16], float* ys, int t, int lane, const float* wg, const float* bg, const float* we, const float* be, int* eid, float* gw, unsigned* counts) {
    float lg[36];
#pragma unroll
    for (int j = 0; j < 36; ++j) lg[j] = 0.f;
#pragma unroll
    for (int i = 0; i < 16; ++i) ys[lane + 64 * i] = y[i];
#pragma unroll 1
    for (int i = 0; i < 16; ++i) {
        const int c = lane + 64 * i;
        const float yv = ys[c];
        const float4 g4 = *(const float4*)(wg + (size_t)c * 4);
        lg[0] += yv * g4.x; lg[1] += yv * g4.y; lg[2] += yv * g4.z; lg[3] += yv * g4.w;
#pragma unroll
        for (int j = 0; j < 8; ++j) { const float4 e4 = *(const float4*)(we + (size_t)c * 32 + j * 4);
            lg[4 + j * 4 + 0] += yv * e4.x; lg[4 + j * 4 + 1] += yv * e4.y; lg[4 + j * 4 + 2] += yv * e4.z; lg[4 + j * 4 + 3] += yv * e4.w; }
    }
#pragma unroll
    for (int j = 0; j < 36; ++j) lg[j] = wave_sum(lg[j]);
    if (lane == 0) {
        float gl[4]; int g = 0;
#pragma unroll
        for (int j = 0; j < 4; ++j) gl[j] = lg[j] + bg[j];
#pragma unroll
        for (int j = 1; j < 4; ++j) if (gl[j] > gl[g]) g = j;
        float den = 0.f;
#pragma unroll
        for (int j = 0; j < 4; ++j) den += expf(gl[j] - gl[g]);
        const float gp = 1.0f / den;
        float el[8];
#pragma unroll
        for (int j = 0; j < 8; ++j) { float v = 0.f;
#pragma unroll
            for (int gg = 0; gg < 4; ++gg) v = (gg == g) ? lg[4 + gg * 8 + j] + be[gg * 8 + j] : v;
            el[j] = v; }
        int i1 = 0;
#pragma unroll
        for (int j = 1; j < 8; ++j) if (el[j] > el[i1]) i1 = j;
        int i2 = (i1 == 0) ? 1 : 0;
#pragma unroll
        for (int j = 0; j < 8; ++j) if (j != i1 && el[j] > el[i2]) i2 = j;
        const float ex = expf(el[i2] - el[i1]);
        const float p1 = 1.0f / (1.0f + ex), p2 = ex / (1.0f + ex);
        const int e1 = g * 8 + i1, e2 = g * 8 + i2;
        eid[2 * t] = e1; eid[2 * t + 1] = e2; gw[2 * t] = gp * p1; gw[2 * t + 1] = gp * p2;
        atomicAdd(&counts[e1], 1u); atomicAdd(&counts[e2], 1u);
    }
}


DEVI void ln_row1024v(float (&y)[16], const float* g, const float* b, int lane) {
    float s = 0.f;
#pragma unroll
    for (int i = 0; i < 16; ++i) s += y[i];
    const float mu = wave_sum(s) * (1.0f / 1024.0f);
    float q = 0.f;
#pragma unroll
    for (int i = 0; i < 16; ++i) { const float d = y[i] - mu; q += d * d; }
    const float rstd = 1.0f / sqrtf(wave_sum(q) * (1.0f / 1024.0f) + LN_EPS);
#pragma unroll
    for (int i4 = 0; i4 < 4; ++i4) { const float4 g4 = *(const float4*)(g + 16 * lane + 4 * i4), b4 = *(const float4*)(b + 16 * lane + 4 * i4);
        y[4 * i4] = (y[4 * i4] - mu) * rstd * g4.x + b4.x; y[4 * i4 + 1] = (y[4 * i4 + 1] - mu) * rstd * g4.y + b4.y; y[4 * i4 + 2] = (y[4 * i4 + 2] - mu) * rstd * g4.z + b4.z; y[4 * i4 + 3] = (y[4 * i4 + 3] - mu) * rstd * g4.w + b4.w; }
}
DEVI void combine_row(float (&y)[16], const float* h, const unsigned short* Y0, const unsigned short* Y1, float g0, float g1, int lane) {
    const uint4 a0 = *(const uint4*)(Y0 + 16 * lane), a1 = *(const uint4*)(Y0 + 16 * lane + 8), b0 = *(const uint4*)(Y1 + 16 * lane), b1 = *(const uint4*)(Y1 + 16 * lane + 8);
    const unsigned aw[8] = {a0.x, a0.y, a0.z, a0.w, a1.x, a1.y, a1.z, a1.w}, bw[8] = {b0.x, b0.y, b0.z, b0.w, b1.x, b1.y, b1.z, b1.w};
#pragma unroll
    for (int i4 = 0; i4 < 4; ++i4) { const float4 hv = *(const float4*)(h + 16 * lane + 4 * i4);
        y[4 * i4]     = DN_ALPHA * hv.x + (g0 * __uint_as_float(aw[2 * i4] << 16) + g1 * __uint_as_float(bw[2 * i4] << 16));
        y[4 * i4 + 1] = DN_ALPHA * hv.y + (g0 * __uint_as_float(aw[2 * i4] & 0xFFFF0000u) + g1 * __uint_as_float(bw[2 * i4] & 0xFFFF0000u));
        y[4 * i4 + 2] = DN_ALPHA * hv.z + (g0 * __uint_as_float(aw[2 * i4 + 1] << 16) + g1 * __uint_as_float(bw[2 * i4 + 1] << 16));
        y[4 * i4 + 3] = DN_ALPHA * hv.w + (g0 * __uint_as_float(aw[2 * i4 + 1] & 0xFFFF0000u) + g1 * __uint_as_float(bw[2 * i4 + 1] & 0xFFFF0000u)); }
}
typedef float f32x4v __attribute__((ext_vector_type(4)));
DEVI void ln_route_block(int tb, int ntok, const float* Zsrc, float* Hdst, const float* g, const float* b, const float4* __restrict__ Wr, const float* bg, const float* be,
                         int* eid, float* gw, unsigned* counts, float* sm) {
    const int tid = otid(), lane = tid & 63, wave = tid >> 6;
    for (int i = 0; i < 8; ++i) { const int tl = wave * 8 + i;
        if (tl < ntok) { const size_t t = (size_t)(tb + tl); float y[16];
#pragma unroll
            for (int i4 = 0; i4 < 4; ++i4) { const float4 v = *(const float4*)(Zsrc + t * D + 16 * lane + 4 * i4); y[4 * i4] = v.x; y[4 * i4 + 1] = v.y; y[4 * i4 + 2] = v.z; y[4 * i4 + 3] = v.w; }
            ln_row1024v(y, g, b, lane);
#pragma unroll
            for (int i4 = 0; i4 < 4; ++i4) *(float4*)(Hdst + t * D + 16 * lane + 4 * i4) = make_float4(y[4 * i4], y[4 * i4 + 1], y[4 * i4 + 2], y[4 * i4 + 3]); } }
    asm volatile("s_waitcnt vmcnt(0)" ::: "memory");
    __syncthreads();
    if (wave * 16 < ntok) {
        const int t0 = tb + 16 * wave, row = lane & 15, kg = lane >> 4;
        f32x4v acc[3];
#pragma unroll
        for (int ct = 0; ct < 3; ++ct) acc[ct] = (f32x4v){0.f, 0.f, 0.f, 0.f};
        const float* arow = Hdst + (size_t)(t0 + row) * D + 4 * kg;
#pragma unroll 4
        for (int sstep = 0; sstep < 64; ++sstep) {
            const float4 a4 = *(const float4*)(arow + 16 * sstep);
#pragma unroll
            for (int ct = 0; ct < 3; ++ct) { const float4 b4 = Wr[(sstep * 3 + ct) * 64 + lane];
                acc[ct] = __builtin_amdgcn_mfma_f32_16x16x4f32(a4.x, b4.x, acc[ct], 0, 0, 0); acc[ct] = __builtin_amdgcn_mfma_f32_16x16x4f32(a4.y, b4.y, acc[ct], 0, 0, 0);
                acc[ct] = __builtin_amdgcn_mfma_f32_16x16x4f32(a4.z, b4.z, acc[ct], 0, 0, 0); acc[ct] = __builtin_amdgcn_mfma_f32_16x16x4f32(a4.w, b4.w, acc[ct], 0, 0, 0); }
        }
        float* Lg = sm + wave * 16 * 48;
#pragma unroll
        for (int ct = 0; ct < 3; ++ct)
#pragma unroll
            for (int j = 0; j < 4; ++j) Lg[(4 * kg + j) * 48 + 16 * ct + row] = acc[ct][j];
        asm volatile("s_waitcnt lgkmcnt(0)" ::: "memory");
        if (lane < 16) {
            const int t = t0 + lane; const float* lg = Lg + lane * 48;
            float gl[4]; int gsel = 0;
#pragma unroll
            for (int j = 0; j < 4; ++j) gl[j] = lg[j] + bg[j];
#pragma unroll
            for (int j = 1; j < 4; ++j) if (gl[j] > gl[gsel]) gsel = j;
            float den = 0.f;
#pragma unroll
            for (int j = 0; j < 4; ++j) den += expf(gl[j] - gl[gsel]);
            const float gp = 1.0f / den;
            float el[8];
#pragma unroll
            for (int j = 0; j < 8; ++j) el[j] = lg[4 + gsel * 8 + j] + be[gsel * 8 + j];
            int i1 = 0;
#pragma unroll
            for (int j = 1; j < 8; ++j) if (el[j] > el[i1]) i1 = j;
            int i2 = (i1 == 0) ? 1 : 0;
#pragma unroll
            for (int j = 0; j < 8; ++j) if (j != i1 && el[j] > el[i2]) i2 = j;
            float e1v = el[0], e2v = el[0];
#pragma unroll
            for (int j = 0; j < 8; ++j) { e1v = (j == i1) ? el[j] : e1v; e2v = (j == i2) ? el[j] : e2v; }
            const float ex = expf(e2v - e1v);
            const float p1 = 1.0f / (1.0f + ex), p2 = ex / (1.0f + ex);
            const int e1 = gsel * 8 + i1, e2 = gsel * 8 + i2;
            eid[2 * t] = e1; eid[2 * t + 1] = e2; gw[2 * t] = gp * p1; gw[2 * t + 1] = gp * p2;
            atomicAdd(&counts[e1], 1u); atomicAdd(&counts[e2], 1u);
        }
    }
    __syncthreads();
}

using pg8::f32x4; using pg8::Unit; typedef unsigned short bf16_t;
DEVI float bf2f(unsigned short b) { return __uint_as_float(((unsigned)b) << 16); }
DEVI float bflo(unsigned w) { return __uint_as_float(w << 16); }
DEVI float bfhi(unsigned w) { return __uint_as_float(w & 0xFFFF0000u); }
DEVI unsigned cvt_pk_bf16(float lo, float hi) { unsigned r; asm volatile("v_cvt_pk_bf16_f32 %0, %1, %2" : "=v"(r) : "v"(lo), "v"(hi)); return r; }
DEVI uint2 pack4(const f32x4 v) { return make_uint2(cvt_pk_bf16(v[0], v[1]), cvt_pk_bf16(v[2], v[3])); }
DEVI float fsigm(float x) { return __builtin_amdgcn_rcpf(1.0f + __expf(-x)); }
DEVI unsigned pack4_fp8(const f32x4 v) { int w = __builtin_amdgcn_cvt_pk_fp8_f32(v[0], v[1], 0, false); w = __builtin_amdgcn_cvt_pk_fp8_f32(v[2], v[3], w, true); return (unsigned)w; }

DEVI int in0_srccol(int n) {
    if (n < 1024) { const int G = n >> 5, nn = (n >> 4) & 1, i = n & 15; return (nn ? OFF_AGATE : OFF_AVAL) + 16 * G + i; }
    if (n < 2048 || (n >= 2560 && n < 3072)) {
        const int base = n < 1536 ? OFF_Q : n < 2048 ? OFF_K : OFF_QI; const int loc = n & 511;
        const int G = loc >> 5, nn = (loc >> 4) & 1, i = loc & 15; return base + 64 * (G >> 1) + 32 * nn + 16 * (G & 1) + i; }
    if (n < 2560) return OFF_V + (n - 2048);
    if (n < 3136) { const int loc = n - 3072; const int G = loc >> 5, nn = (loc >> 4) & 1, i = loc & 15; return OFF_KI + 32 * nn + 16 * G + i; }
    if (n < 3144) return OFF_WI + (n - 3136);
    return -1;
}
struct EpiIn0 {
    static constexpr bool PERM = false, AFTER_DRAIN = false;
    bf16_t* GLU; bf16_t* KI; float* WI; const float* ropeC; const float* ropeS; unsigned char* KV8;
    DEVI void operator()(const f32x4 (&acc)[2][2][4][2], const Unit& u, int wr, int wc, int fr, int fq) const {
        const int pn = u.pn; const int rbase = u.pm * 256 + wr * 64 + fr;
        if (pn < 4) {
#pragma unroll
            for (int ai = 0; ai < 2; ++ai)
#pragma unroll
                for (int m = 0; m < 4; ++m) { const size_t row = rbase + ai * 128 + m * 16;
#pragma unroll
                    for (int bj = 0; bj < 2; ++bj) { const int G = 8 * pn + 4 * bj + wc; const f32x4 v = acc[ai][bj][m][0], g = acc[ai][bj][m][1]; f32x4 o;
#pragma unroll
                        for (int j = 0; j < 4; ++j) o[j] = v[j] * fsigm(g[j]);
                        *(uint2*)(GLU + row * 512 + 16 * G + 4 * fq) = pack4(o); } }
        } else if (pn == 8 || pn == 9) {
#pragma unroll
            for (int ai = 0; ai < 2; ++ai)
#pragma unroll
                for (int m = 0; m < 4; ++m) { const size_t row = rbase + ai * 128 + m * 16;
#pragma unroll
                    for (int bj = 0; bj < 2; ++bj)
#pragma unroll
                        for (int n = 0; n < 2; ++n) { const int col = 256 * (pn - 8) + 128 * bj + 32 * wc + 16 * n + 4 * fq;
                            *(unsigned*)(KV8 + row * 1024 + (size_t)(col >> 3) * 16 + 8 + (col & 7)) = pack4_fp8(acc[ai][bj][m][n]); } }
        } else if (pn == 12) {
            if (wc < 2) { const int d0 = 16 * wc + 4 * fq;
#pragma unroll
                for (int ai = 0; ai < 2; ++ai)
#pragma unroll
                    for (int m = 0; m < 4; ++m) { const size_t row = rbase + ai * 128 + m * 16;
                        const f32x4 c = *(const f32x4*)(ropeC + row * 32 + d0), s = *(const f32x4*)(ropeS + row * 32 + d0);
                        const f32x4 t1 = acc[ai][0][m][0], t2 = acc[ai][0][m][1];
                        *(uint2*)(KI + row * 64 + d0) = pack4(t1 * c - t2 * s); *(uint2*)(KI + row * 64 + 32 + d0) = pack4(t1 * s + t2 * c); }
            } else if (wc == 2 && fq < 2) {
#pragma unroll
                for (int ai = 0; ai < 2; ++ai)
#pragma unroll
                    for (int m = 0; m < 4; ++m) { const size_t row = rbase + ai * 128 + m * 16; *(f32x4*)(WI + row * 8 + 4 * fq) = acc[ai][0][m][0] * 0.35355339059327373f; }
            }
        } else {
            bf16_t* dst = GLU + (size_t)(pn < 6 ? 1 : pn < 8 ? 2 : 4) * LP * 512; const int pl = pn & 1; const int d0 = 16 * (wc & 1) + 4 * fq;
#pragma unroll
            for (int ai = 0; ai < 2; ++ai)
#pragma unroll
                for (int m = 0; m < 4; ++m) { const size_t row = rbase + ai * 128 + m * 16;
                    const f32x4 c = *(const f32x4*)(ropeC + row * 32 + d0), s = *(const f32x4*)(ropeS + row * 32 + d0);
#pragma unroll
                    for (int bj = 0; bj < 2; ++bj) { const int hh = 4 * pl + 2 * bj + (wc >> 1); const f32x4 t1 = acc[ai][bj][m][0], t2 = acc[ai][bj][m][1];
                        if (pn == 6 || pn == 7) { const int da = 64 * hh + d0, db = da + 32;
                            *(unsigned*)(KV8 + row * 1024 + (size_t)(da >> 3) * 16 + (da & 7)) = pack4_fp8(t1 * c - t2 * s); *(unsigned*)(KV8 + row * 1024 + (size_t)(db >> 3) * 16 + (db & 7)) = pack4_fp8(t1 * s + t2 * c);
                        } else { *(uint2*)(dst + row * 512 + 64 * hh + d0) = pack4(t1 * c - t2 * s); *(uint2*)(dst + row * 512 + 64 * hh + 32 + d0) = pack4(t1 * s + t2 * c); } } }
        }
    }
};
struct EpiRes0 {
    static constexpr bool PERM = false, AFTER_DRAIN = false;
    const float* x; const float* meta; float* Z;
    DEVI void operator()(const f32x4 (&acc)[2][2][4][2], const Unit& u, int wr, int wc, int fr, int fq) const {
        const int rbase = u.pm * 256 + wr * 64 + fr, cbase = u.pn * 256 + wc * 32 + 4 * fq;
#pragma unroll
        for (int ai = 0; ai < 2; ++ai)
#pragma unroll
            for (int m = 0; m < 4; ++m) { const int row = rbase + ai * 128 + m * 16;
                if (row < L) { const float* rs = row < NMETA ? meta + (size_t)row * D : x + (size_t)(row - NMETA) * D;
#pragma unroll
                    for (int bj = 0; bj < 2; ++bj)
#pragma unroll
                        for (int n = 0; n < 2; ++n) { const int col = cbase + 128 * bj + 16 * n; const f32x4 r4 = *(const f32x4*)(rs + col); *(f32x4*)(Z + (size_t)row * D + col) = r4 * DN_ALPHA + acc[ai][bj][m][n]; } } }
    }
};
struct EpiGateUp {
    static constexpr bool PERM = false, AFTER_DRAIN = false;
    bf16_t* Hm;
    DEVI void operator()(const f32x4 (&acc)[2][2][4][2], const Unit& u, int wr, int wc, int fr, int fq) const {
        const int pl = u.pn & 3; const int rbase = u.pm * 256 + wr * 64 + fr;
#pragma unroll
        for (int ai = 0; ai < 2; ++ai)
#pragma unroll
            for (int m = 0; m < 4; ++m) { const size_t row = rbase + ai * 128 + m * 16;
#pragma unroll
                for (int bj = 0; bj < 2; ++bj) { const int G = 8 * pl + 4 * bj + wc; const f32x4 g = acc[ai][bj][m][0], up = acc[ai][bj][m][1]; f32x4 o;
#pragma unroll
                    for (int j = 0; j < 4; ++j) o[j] = g[j] * fsigm(g[j]) * up[j];
                    *(uint2*)(Hm + row * 512 + 16 * G + 4 * fq) = pack4(o); } }
    }
};
struct EpiDown {
    static constexpr bool PERM = false, AFTER_DRAIN = false;
    bf16_t* Y;
    DEVI void operator()(const f32x4 (&acc)[2][2][4][2], const Unit& u, int wr, int wc, int fr, int fq) const {
        const int pl = u.pn & 3; const int rbase = u.pm * 256 + wr * 64 + fr, cbase = pl * 256 + wc * 32 + 4 * fq;
#pragma unroll
        for (int ai = 0; ai < 2; ++ai)
#pragma unroll
            for (int m = 0; m < 4; ++m) { const size_t row = rbase + ai * 128 + m * 16;
#pragma unroll
                for (int bj = 0; bj < 2; ++bj)
#pragma unroll
                    for (int n = 0; n < 2; ++n) *(uint2*)(Y + row * 1024 + cbase + 128 * bj + 16 * n) = pack4(acc[ai][bj][m][n]); }
    }
};
struct MoeOrder {
    const int* mt; int nunits, G, c;
    DEVI void init(const int* t, int G_, int c_) { mt = t; nunits = t[0] * 4; G = G_; c = c_; }
    DEVI bool next(int i, Unit& u) const { const int li = i * G + c; if (li >= nunits) return false; const int ti = li >> 2; u.pm = ti; u.pn = mt[4 + ti] * 4 + (li & 3); return true; }
    DEVI void a_ready(const Unit&) const {}
    DEVI void done(const Unit&) const {}
};

template <class F> DEVI void tr_tile(bf16_t* dst, int K, int n0, int k0, F src, float* sm) {
    const int tid = otid();
    __syncthreads();
    { const int nn = tid & 63, kb = tid >> 6;
#pragma unroll
      for (int p = 0; p < 8; ++p) { const int kk = kb + 8 * p; sm[kk * 65 + nn] = src(n0 + nn, k0 + kk); } }
    __syncthreads();
    { const int nn = tid >> 3, kq = (tid & 7) * 8; float v[8];
#pragma unroll
      for (int j = 0; j < 8; ++j) v[j] = sm[(kq + j) * 65 + nn];
      uint4 w; w.x = cvt_pk_bf16(v[0], v[1]); w.y = cvt_pk_bf16(v[2], v[3]); w.z = cvt_pk_bf16(v[4], v[5]); w.w = cvt_pk_bf16(v[6], v[7]);
      *(uint4*)(dst + (size_t)(n0 + nn) * K + k0 + kq) = w; }
}

struct TrJob { bf16_t* dst; const float* s0; const float* s1; int K, n0, k0, ld, mode; };
DEVI float tr_src(const TrJob& J, int n, int k) {
    if (J.mode == 0) return __builtin_nontemporal_load(J.s0 + (size_t)k * J.ld + n);
    if (J.mode == 1) { const int sc = in0_srccol(n); return sc < 0 ? 0.f : __builtin_nontemporal_load(J.s0 + (size_t)k * IN_AB + sc); }
    const int ch = (n >> 5) * 16 + (n & 15); return ((n >> 4) & 1) ? __builtin_nontemporal_load(J.s1 + (size_t)k * DE + ch) : __builtin_nontemporal_load(J.s0 + (size_t)k * DE + ch);
}
DEVI void tr_fetch(const TrJob& J, float (&v)[8]) {
    const int tid = otid(), nn = tid & 63, kb = tid >> 6;
#pragma unroll
    for (int p = 0; p < 8; ++p) v[p] = tr_src(J, J.n0 + nn, J.k0 + kb + 8 * p);
}
DEVI void tr_commit(const TrJob& J, const float (&v)[8], float* sm) {
    const int tid = otid();
    __syncthreads();
    { const int nn = tid & 63, kb = tid >> 6;
#pragma unroll
      for (int p = 0; p < 8; ++p) sm[(kb + 8 * p) * 65 + nn] = v[p]; }
    __syncthreads();
    { const int nn = tid >> 3, kq = (tid & 7) * 8; float x[8];
#pragma unroll
      for (int j = 0; j < 8; ++j) x[j] = sm[(kq + j) * 65 + nn];
      uint4 w; w.x = cvt_pk_bf16(x[0], x[1]); w.y = cvt_pk_bf16(x[2], x[3]); w.z = cvt_pk_bf16(x[4], x[5]); w.w = cvt_pk_bf16(x[6], x[7]);
      *(uint4*)(J.dst + (size_t)(J.n0 + nn) * J.K + J.k0 + kq) = w; }
}
template <class Dec> DEVI void tr_run(int njobs, Dec dec, float* sm) {
    int j = blockIdx.x; const int G = gridDim.x;
    TrJob Ja{}, Jb{}; float va[8], vb[8];
    if (j < njobs) { Ja = dec(j); tr_fetch(Ja, va); }
    while (j < njobs) {
        int jn = j + G; if (jn < njobs) { Jb = dec(jn); tr_fetch(Jb, vb); }
        tr_commit(Ja, va, sm);
        j = jn; if (j >= njobs) break;
        jn = j + G; if (jn < njobs) { Ja = dec(jn); tr_fetch(Ja, va); }
        tr_commit(Jb, vb, sm);
        j = jn;
    }
    __syncthreads();
}

DEVI void moe_dispatch_mfma(const float* H, const int* eid, const unsigned* counts, unsigned* cursor, int* slot, int* mtiles, bf16_t* Xperm, int* sm_i, int gwave, int nwaves, int lane, int p_begin) {
    if (otid() == 0) { int o = 0; for (int e = 0; e < NE; ++e) { sm_i[e] = o; o += (((int)counts[e] + 255) >> 8) << 8; } }
    __syncthreads();
    for (int pb = p_begin + gwave * 16; pb < NPAIR; pb += nwaves * 16) {
        int sl = 0;
        if (lane < 16 && pb + lane < NPAIR) { const int e = eid[pb + lane]; sl = sm_i[e] + (int)atomicAdd(&cursor[e], 1u); slot[pb + lane] = sl; }
#pragma unroll 4
        for (int k = 0; k < 16; ++k) { const int p = pb + k; if (p >= NPAIR) break;
            const int s = __shfl(sl, k);
            const float4* src = (const float4*)(H + (size_t)(p >> 1) * D); uint2* dst = (uint2*)(Xperm + (size_t)s * D);
#pragma unroll
            for (int r = 0; r < 4; ++r) { const float4 v = src[lane + 64 * r]; dst[lane + 64 * r] = make_uint2(cvt_pk_bf16(v.x, v.y), cvt_pk_bf16(v.z, v.w)); } }
    }
    if (blockIdx.x == 0 && otid() == 0) { int n = 0; for (int e = 0; e < NE; ++e) { const int nt = ((int)counts[e] + 255) >> 8; for (int i = 0; i < nt; ++i) mtiles[4 + n++] = e; } mtiles[0] = n; }
    __syncthreads();
}

DEVI float gelu_fast(float x) { return x * fsigm(1.5957691216057308f * (x + 0.044715f * x * x * x)); }
struct EpiIn1 {
    static constexpr bool PERM = false, AFTER_DRAIN = false;
    bf16_t* G;
    DEVI void operator()(const f32x4 (&acc)[2][2][4][2], const Unit& u, int wr, int wc, int fr, int fq) const {
        const int pn = u.pn; const bool is_gate = pn < 5; const int rbase = u.pm * 256 + wr * 64 + fr;
        bf16_t* dst = G + (is_gate ? (size_t)0 : (size_t)LP * RNN_W) + (size_t)((is_gate ? pn : pn - 5) * 256 + wc * 32 + 4 * fq);
#pragma unroll
        for (int ai = 0; ai < 2; ++ai)
#pragma unroll
            for (int m = 0; m < 4; ++m) { const size_t row = rbase + ai * 128 + m * 16;
#pragma unroll
                for (int bj = 0; bj < 2; ++bj)
#pragma unroll
                    for (int n = 0; n < 2; ++n) { f32x4 v = acc[ai][bj][m][n];
                        if (is_gate) {
#pragma unroll
                            for (int j = 0; j < 4; ++j) v[j] = gelu_fast(v[j]); }
                        *(uint2*)(dst + row * RNN_W + 128 * bj + 16 * n) = pack4(v); } }
    }
};
struct EpiRes1 {
    static constexpr bool PERM = false, AFTER_DRAIN = false;
    const float* R; float* Z;
    DEVI void operator()(const f32x4 (&acc)[2][2][4][2], const Unit& u, int wr, int wc, int fr, int fq) const {
        const int rbase = u.pm * 256 + wr * 64 + fr, cbase = u.pn * 256 + wc * 32 + 4 * fq;
#pragma unroll
        for (int ai = 0; ai < 2; ++ai)
#pragma unroll
            for (int m = 0; m < 4; ++m) { const size_t row = rbase + ai * 128 + m * 16;
#pragma unroll
                for (int bj = 0; bj < 2; ++bj)
#pragma unroll
                    for (int n = 0; n < 2; ++n) { const int col = cbase + 128 * bj + 16 * n; const f32x4 r4 = *(const f32x4*)(R + row * D + col); *(f32x4*)(Z + row * D + col) = r4 * DN_ALPHA + acc[ai][bj][m][n]; } }
    }
};

typedef short bf16x8_t __attribute__((ext_vector_type(8)));
template <bool FINAL>
DEVI void rglru_unit(int c, int nb, const bf16_t* __restrict__ XR, const bf16_t* __restrict__ GATEg, const bf16_t* __restrict__ Wta, const bf16_t* __restrict__ Wtx,
                     const float* __restrict__ cw, const float* __restrict__ cb, const float* __restrict__ ba, const float* __restrict__ bx, const float* __restrict__ lam,
                     float* __restrict__ Aend, float* __restrict__ Hend, const float* __restrict__ CIN, bf16_t* __restrict__ YY, unsigned char* lds) {
    const int tid = otid(), lane = tid & 63, w = tid >> 6, col = lane & 15, quad = lane >> 4;
    bf16_t* xcb = (bf16_t*)lds;
    float* xcf = (float*)(lds + 64 * 136 * 2);
    const int t0 = c * 64, ch0 = nb * RNN_BW;
    bf16x8_t fa[4], fx[4];
    { const size_t wrow = ((size_t)nb * 128 + 16 * w + col) * 128 + 8 * quad;
#pragma unroll
      for (int ks = 0; ks < 4; ++ks) { fa[ks] = *(const bf16x8_t*)(Wta + wrow + 32 * ks); fx[ks] = *(const bf16x8_t*)(Wtx + wrow + 32 * ks); } }
    const int ch = ch0 + 16 * w + col;
    const float bav = ba[ch], bxv = bx[ch], lamv = lam[ch];
    const float cinv = FINAL ? CIN[(size_t)ch * CP + c] : 0.f;
    __syncthreads();
    {
        const int c8 = tid & 15, tr = tid >> 4;
        float wv[4][8], bv[8];
#pragma unroll
        for (int j = 0; j < 4; ++j) { const float4 w0 = *(const float4*)(cw + j * RNN_W + ch0 + 8 * c8), w1 = *(const float4*)(cw + j * RNN_W + ch0 + 8 * c8 + 4);
            wv[j][0] = w0.x; wv[j][1] = w0.y; wv[j][2] = w0.z; wv[j][3] = w0.w; wv[j][4] = w1.x; wv[j][5] = w1.y; wv[j][6] = w1.z; wv[j][7] = w1.w; }
        { const float4 b0 = *(const float4*)(cb + ch0 + 8 * c8), b1 = *(const float4*)(cb + ch0 + 8 * c8 + 4); bv[0] = b0.x; bv[1] = b0.y; bv[2] = b0.z; bv[3] = b0.w; bv[4] = b1.x; bv[5] = b1.y; bv[6] = b1.z; bv[7] = b1.w; }
#pragma unroll
        for (int half = 0; half < 2; ++half) { const int tl = tr + 32 * half, t = t0 + tl;
            float v[8];
#pragma unroll
            for (int i = 0; i < 8; ++i) v[i] = bv[i];
#pragma unroll
            for (int j = 0; j < 4; ++j) { const int tt = t - 3 + j;
                if (tt >= 0) { const uint4 xv = *(const uint4*)(XR + (size_t)tt * RNN_W + ch0 + 8 * c8);
                    v[0] += wv[j][0] * bflo(xv.x); v[1] += wv[j][1] * bfhi(xv.x); v[2] += wv[j][2] * bflo(xv.y); v[3] += wv[j][3] * bfhi(xv.y);
                    v[4] += wv[j][4] * bflo(xv.z); v[5] += wv[j][5] * bfhi(xv.z); v[6] += wv[j][6] * bflo(xv.w); v[7] += wv[j][7] * bfhi(xv.w); } }
            *(float4*)(xcf + tl * 132 + 8 * c8) = make_float4(v[0], v[1], v[2], v[3]); *(float4*)(xcf + tl * 132 + 8 * c8 + 4) = make_float4(v[4], v[5], v[6], v[7]);
            uint4 pk; pk.x = cvt_pk_bf16(v[0], v[1]); pk.y = cvt_pk_bf16(v[2], v[3]); pk.z = cvt_pk_bf16(v[4], v[5]); pk.w = cvt_pk_bf16(v[6], v[7]);
            *(uint4*)(xcb + (16 * ((tl >> 2) & 3) + 4 * (tl >> 4) + (tl & 3)) * 136 + 8 * c8) = pk; }
    }
    __syncthreads();
    f32x4 ca[4], cx[4];
    {
#pragma unroll
        for (int mt = 0; mt < 4; ++mt) { ca[mt] = (f32x4){0.f, 0.f, 0.f, 0.f}; cx[mt] = (f32x4){0.f, 0.f, 0.f, 0.f};
#pragma unroll
            for (int ks = 0; ks < 4; ++ks) { const bf16x8_t af = *(const bf16x8_t*)(xcb + (16 * mt + col) * 136 + 32 * ks + 8 * quad);
                ca[mt] = __builtin_amdgcn_mfma_f32_16x16x32_bf16(af, fa[ks], ca[mt], 0, 0, 0);
                cx[mt] = __builtin_amdgcn_mfma_f32_16x16x32_bf16(af, fx[ks], cx[mt], 0, 0, 0); } }
    }
    const float sp = log1pf(expf(-lamv));
    float av[4][4], uv[4][4]; float A = 1.f, H = 0.f;
#pragma unroll
    for (int mt = 0; mt < 4; ++mt) {
#pragma unroll
        for (int j = 0; j < 4; ++j) { const int tl = 16 * quad + 4 * mt + j;
            const float xcv = xcf[tl * 132 + 16 * w + col];
            const float r = fsigm(ca[mt][j] + bav), ig = fsigm(cx[mt][j] + bxv);
            const float la = -8.0f * r * sp;
            const float x2 = 2.0f * la;
            float em1 = x2 * (1.0f + x2 * (0.5f + x2 * (0.16666667f + x2 * (0.041666668f + x2 * (0.0083333338f + x2 * (0.0013888889f + x2 * 0.0001984127f))))));
            if (x2 < -0.5f) em1 = expm1f(x2);
            float a_ = __expf(la), u_ = __builtin_amdgcn_sqrtf(-em1) * (ig * xcv);
            if (t0 + tl >= L) { a_ = 1.f; u_ = 0.f; }
            av[mt][j] = a_; uv[mt][j] = u_; H = a_ * H + u_; A *= a_; } }
    float carry = cinv, prod = 1.f, hin = 0.f;
#pragma unroll
    for (int q = 0; q < 4; ++q) {
        if (quad == q) hin = carry;
        const float nw = A * carry + H, np = A * prod;
        carry = __shfl(nw, q * 16 + col); prod = __shfl(np, q * 16 + col); }
    if (!FINAL) {
        if (quad == 0) { Aend[(size_t)ch * CP + c] = prod; Hend[(size_t)ch * CP + c] = carry; }
    } else {
        float h = hin;
#pragma unroll
        for (int mt = 0; mt < 4; ++mt)
#pragma unroll
            for (int j = 0; j < 4; ++j) { h = av[mt][j] * h + uv[mt][j]; xcf[(16 * quad + 4 * mt + j) * 132 + 16 * w + col] = h; }
        __syncthreads();
        const int c8 = tid & 15, tr = tid >> 4;
#pragma unroll
        for (int half = 0; half < 2; ++half) { const int tl = tr + 32 * half, t = t0 + tl;
            if (t >= NMETA && t < L) {
                const float4 h0 = *(const float4*)(xcf + tl * 132 + 8 * c8), h1 = *(const float4*)(xcf + tl * 132 + 8 * c8 + 4);
                const uint4 g = *(const uint4*)(GATEg + (size_t)t * RNN_W + ch0 + 8 * c8);
                uint4 pk; pk.x = cvt_pk_bf16(bflo(g.x) * h0.x, bfhi(g.x) * h0.y); pk.y = cvt_pk_bf16(bflo(g.y) * h0.z, bfhi(g.y) * h0.w);
                pk.z = cvt_pk_bf16(bflo(g.z) * h1.x, bfhi(g.z) * h1.y); pk.w = cvt_pk_bf16(bflo(g.w) * h1.z, bfhi(g.w) * h1.w);
                *(uint4*)(YY + (size_t)t * RNN_W + ch0 + 8 * c8) = pk; } }
    }
}

constexpr int SW = 544;
constexpr int CB = 512;
constexpr int NTILE = L / 16;
typedef float f32x16 __attribute__((ext_vector_type(16)));
typedef float f32x2v __attribute__((ext_vector_type(2)));
constexpr int HROW = 2112;
constexpr int IL_HIST = 0, IL_CKEY = 0, IL_CIDX = 16 * CB * 4, IL_HIST2 = 2 * 16 * CB * 4, IL_ROWS = IL_HIST2 + 16 * 256 * 4, IL_WI = 16 * HROW * 4, IL_QST = IL_WI + 512, IL_QST2 = IL_QST + 256, IL_CCNT = IL_QST2 + 256, IL_FLAG = IL_CCNT + 64;
static_assert(IL_ROWS + 16 * SW * 4 <= IL_WI && IL_FLAG + 64 <= LDS_BYTES - 16, "indexer LDS");

DEVI float relu_i(float x) { const int v = __float_as_int(x); return __int_as_float(v > 0 ? v : 0); }
DEVI int hpos(unsigned w) { return (int)(w + (w >> 5)); }
template <int PASS, bool L0>
DEVI void idx_sweep(int q0, int nkb, int wave, int lane, const bf16x8_t (&Af)[4][4], const bf16_t* __restrict__ KI, unsigned char* lds, unsigned* __restrict__ SELM) {
    const int l31 = lane & 31, h2 = lane >> 5;
    unsigned* hist = (unsigned*)(lds + IL_HIST);
    const float* wiL = (const float*)(lds + IL_WI);
    const uint4* qst = (const uint4*)(lds + IL_QST);
    const uint4* qst2 = (const uint4*)(lds + IL_QST2);
    unsigned* ckey = (unsigned*)(lds + IL_CKEY); unsigned* cidx = (unsigned*)(lds + IL_CIDX); unsigned* ccnt = (unsigned*)(lds + IL_CCNT); unsigned* rows = (unsigned*)(lds + IL_ROWS);
    const bf16_t* kp = KI + (size_t)l31 * 64 + 8 * h2;
    bf16x8_t Bn[4];
    if (wave < nkb) {
#pragma unroll
        for (int ks = 0; ks < 4; ++ks) Bn[ks] = *(const bf16x8_t*)(kp + (size_t)wave * 2048 + 16 * ks); }
    for (int kb = wave; kb < nkb; kb += 8) {
        const int s = kb * 32 + l31;
        bf16x8_t Bf[4];
#pragma unroll
        for (int ks = 0; ks < 4; ++ks) Bf[ks] = Bn[ks];
        if (kb + 8 < nkb) {
#pragma unroll
            for (int ks = 0; ks < 4; ++ks) Bn[ks] = *(const bf16x8_t*)(kp + (size_t)(kb + 8) * 2048 + 16 * ks); }
        f32x16 acc[4];
#pragma unroll
        for (int rb = 0; rb < 4; ++rb) {
#pragma unroll
            for (int i = 0; i < 16; ++i) acc[rb][i] = 0.f; }
#pragma unroll
        for (int ks = 0; ks < 4; ++ks)
#pragma unroll
            for (int rb = 0; rb < 4; ++rb) acc[rb] = __builtin_amdgcn_mfma_f32_32x32x16_bf16(Af[rb][ks], Bf[ks], acc[rb], 0, 0, 0);
        const bool edge = kb * 32 + 31 > q0;
#pragma unroll
        for (int rb = 0; rb < 4; ++rb) {
            const int qa = 4 * rb + 2 * h2;
            float4 w[2][2]; uint4 st[2];
#pragma unroll
            for (int e = 0; e < 2; ++e) { w[e][0] = *(const float4*)(wiL + (qa + e) * 8); w[e][1] = *(const float4*)(wiL + (qa + e) * 8 + 4);
                if (PASS == 2) st[e] = qst2[qa + e]; else if (!L0) st[e] = qst[qa + e]; }
#pragma unroll
            for (int e = 0; e < 2; ++e) {
                const int qs = qa + e;
                f32x2v s2 = (f32x2v){relu_i(acc[rb][8 * e + 0]), relu_i(acc[rb][8 * e + 1])} * (f32x2v){w[e][0].x, w[e][0].y};
                s2 = (f32x2v){relu_i(acc[rb][8 * e + 2]), relu_i(acc[rb][8 * e + 3])} * (f32x2v){w[e][0].z, w[e][0].w} + s2;
                s2 = (f32x2v){relu_i(acc[rb][8 * e + 4]), relu_i(acc[rb][8 * e + 5])} * (f32x2v){w[e][1].x, w[e][1].y} + s2;
                s2 = (f32x2v){relu_i(acc[rb][8 * e + 6]), relu_i(acc[rb][8 * e + 7])} * (f32x2v){w[e][1].z, w[e][1].w} + s2;
                const float sc = s2[0] + s2[1];
                const bool valid = !edge || s <= q0 + qs;
                const unsigned key = f2key(sc);
                if (PASS == 1) {
                    if (L0) { if (valid) { const unsigned bin = key >> 20; atomicAdd(&hist[qs * HROW + hpos(bin >> 1)], (bin & 1u) ? 0x10000u : 1u); } }
                    else if (valid && (key & st[e].x) == st[e].y) { const unsigned bin = (key >> st[e].z) & st[e].w; atomicAdd(&hist[qs * HROW + hpos(bin >> 1)], (bin & 1u) ? 0x10000u : 1u); }
                } else {
                    const bool all = st[e].z == 0xFFFFFFFFu;
                    const bool sel = valid && (all || key >= st[e].y);
                    const bool cnd = valid && !all && key >= st[e].x && key < st[e].y;
                    const unsigned long long bal = __ballot(sel);
                    if (l31 == 0) rows[qs * SW + kb] = h2 ? (unsigned)(bal >> 32) : (unsigned)bal;
                    if (cnd) { const unsigned n = atomicAdd(&ccnt[qs], 1u); if (n < (unsigned)CB) { ckey[qs * CB + n] = key; cidx[qs * CB + n] = (unsigned)s; } }
                }
            }
        }
    }
}

DEVI void indexer_tile(int q0, const bf16_t* __restrict__ QI, const bf16_t* __restrict__ KI, const float* __restrict__ WI, unsigned* __restrict__ SELM, unsigned* __restrict__ SELM2, unsigned char* lds) {
    const int tid = otid(), lane = tid & 63, wave = tid >> 6;
    unsigned* hist = (unsigned*)(lds + IL_HIST);
    float* wiL = (float*)(lds + IL_WI);
    uint4* qst = (uint4*)(lds + IL_QST); uint4* qst2 = (uint4*)(lds + IL_QST2);
    unsigned* ckey = (unsigned*)(lds + IL_CKEY); unsigned* cidx = (unsigned*)(lds + IL_CIDX); unsigned* hist2 = (unsigned*)(lds + IL_HIST2); unsigned* ccnt = (unsigned*)(lds + IL_CCNT);
    volatile unsigned* flag = (volatile unsigned*)(lds + IL_FLAG);
    const int nkb = (q0 + 16 + 31) >> 5;
    bf16x8_t Af[4][4];
    { const int rho = lane & 31, hq = lane >> 5; const int qq = 2 * ((rho >> 2) & 1) + (rho >> 4), head = 4 * ((rho >> 3) & 1) + (rho & 3);
#pragma unroll
      for (int rb = 0; rb < 4; ++rb)
#pragma unroll
          for (int ks = 0; ks < 4; ++ks) Af[rb][ks] = *(const bf16x8_t*)(QI + (size_t)(q0 + 4 * rb + qq) * 512 + head * 64 + 16 * ks + 8 * hq); }
    __syncthreads();
    if (tid < 128) wiL[tid] = WI[(size_t)q0 * 8 + tid] * 0.125f;
    if (tid < 16) { qst[tid] = make_uint4(0u, 0u, 20u, 4095u); qst2[tid] = make_uint4(0u, 0u, (unsigned)TOPK, 0u); ccnt[tid] = 0u; }
    for (int level = 0; level < 3; ++level) {
        for (int i = tid; i < 16 * HROW / 4; i += NTHREADS) ((uint4*)hist)[i] = make_uint4(0u, 0u, 0u, 0u);
        if (tid == 0) flag[0] = 0u;
        __syncthreads();
        if (level == 0) idx_sweep<1, true>(q0, nkb, wave, lane, Af, KI, lds, SELM); else idx_sweep<1, false>(q0, nkb, wave, lane, Af, KI, lds, SELM);
        __syncthreads();
#pragma unroll 1
        for (int qi = 0; qi < 2; ++qi) {
            const int qs = 2 * wave + qi;
            const uint4 st = qst[qs]; const uint4 b = qst2[qs];
            if (st.x == 0xFFFFFFFFu && st.y == 0u && st.w == 0u) continue;
            unsigned wv[32]; unsigned loc = 0u;
#pragma unroll
            for (int i = 0; i < 32; ++i) { wv[i] = hist[qs * HROW + 33 * lane + i]; loc += (wv[i] & 0xFFFFu) + (wv[i] >> 16); }
            unsigned suf = loc;
#pragma unroll
            for (int off = 1; off < 64; off <<= 1) { const unsigned o = __shfl_down(suf, off); if (lane + off < 64) suf += o; }
            const unsigned total = __shfl(suf, 0), above = suf - loc, need = b.z;
            if (level == 0 && total <= need) { if (lane == 0) { qst[qs] = make_uint4(0xFFFFFFFFu, 0u, 0u, 0u); qst2[qs] = make_uint4(0u, 0u, 0xFFFFFFFFu, 0u); } continue; }
            const bool mine = above < need && need <= above + loc;
            unsigned cum = above, c = 0u; int d = 0; bool found = false;
#pragma unroll
            for (int i = 31; i >= 0; --i) {
                const unsigned chi = wv[i] >> 16, clo = wv[i] & 0xFFFFu;
                if (!found && cum + chi >= need) { found = true; d = 64 * lane + 2 * i + 1; c = chi; } if (!found) cum += chi;
                if (!found && cum + clo >= need) { found = true; d = 64 * lane + 2 * i; c = clo; } if (!found) cum += clo; }
            if (mine) {
                const unsigned pval = st.y | ((unsigned)d << st.z), pmask = st.x | (st.w << st.z);
                const unsigned nneed = need - cum;
                const unsigned long long hi64 = (unsigned long long)pval + (1ull << st.z);
                const unsigned hi = hi64 > 0xFFFFFFFFull ? 0xFFFFFFFFu : (unsigned)hi64;
                if (c <= (unsigned)CB || level == 2) { qst[qs] = make_uint4(0xFFFFFFFFu, 0u, 0u, 0u); qst2[qs] = make_uint4(pval, hi, nneed, st.z); }
                else { const unsigned nsh = (level == 0) ? 8u : 0u, ndm = (level == 0) ? 4095u : 255u; qst[qs] = make_uint4(pmask, pval, nsh, ndm); qst2[qs] = make_uint4(pval, hi, nneed, st.z); flag[0] = 1u; }
            }
        }
        __syncthreads();
        if (flag[0] == 0u) break;
        __syncthreads();
    }
    __syncthreads();
    idx_sweep<2, false>(q0, nkb, wave, lane, Af, KI, lds, SELM);
    asm volatile("s_waitcnt vmcnt(0)" ::: "memory");
    __syncthreads();
    unsigned* rows = (unsigned*)(lds + IL_ROWS);
#pragma unroll 1
    for (int qi = 0; qi < 2; ++qi) {
        const int qs = 2 * wave + qi;
        const uint4 b = qst2[qs];
        unsigned* row = rows + qs * SW;
        if (b.z != 0xFFFFFFFFu) {
            const unsigned need = b.z; const unsigned cn = ccnt[qs]; const int n = (int)(cn < (unsigned)CB ? cn : (unsigned)CB);
            const unsigned rem = b.w;
            const unsigned sh8 = rem > 8u ? rem - 8u : 0u; const unsigned m8 = rem >= 8u ? 255u : ((1u << rem) - 1u);
#pragma unroll
            for (int i = 0; i < 4; ++i) hist2[qs * 256 + 4 * lane + i] = 0u;
            asm volatile("s_waitcnt lgkmcnt(0)" ::: "memory");
            for (int i = lane; i < n; i += 64) atomicAdd(&hist2[qs * 256 + ((ckey[qs * CB + i] >> sh8) & m8)], 1u);
            asm volatile("s_waitcnt lgkmcnt(0)" ::: "memory");
            unsigned c4[4]; unsigned loc = 0u;
#pragma unroll
            for (int i = 0; i < 4; ++i) { c4[i] = hist2[qs * 256 + 4 * lane + i]; loc += c4[i]; }
            unsigned suf = loc;
#pragma unroll
            for (int off = 1; off < 64; off <<= 1) { const unsigned o = __shfl_down(suf, off); if (lane + off < 64) suf += o; }
            const unsigned above = suf - loc;
            const bool mine = above < need && need <= above + loc;
            unsigned b2 = 0u, need2 = 0u;
            if (mine) { unsigned cum = above; int i = 3; for (; i > 0; --i) { if (cum + c4[i] >= need) break; cum += c4[i]; } b2 = 4u * lane + i; need2 = need - cum; }
            const unsigned long long mb = __ballot(mine);
            if (mb == 0ull) {
                for (int i = lane; i < n; i += 64) if ((unsigned)i < need) { const unsigned ii = cidx[qs * CB + i]; atomicOr(&row[ii >> 5], 1u << (ii & 31u)); }
            } else {
                const int src = __ffsll((long long)mb) - 1;
                b2 = __shfl(b2, src); need2 = __shfl(need2, src);
                for (int i0 = 0; i0 < n; i0 += 64) {
                    const int i = i0 + lane; const bool act = i < n;
                    const unsigned ki = act ? ckey[qs * CB + i] : 0u, ii = act ? cidx[qs * CB + i] : 0u; const unsigned d8 = (ki >> sh8) & m8;
                    if (act && d8 > b2) atomicOr(&row[ii >> 5], 1u << (ii & 31u));
                    unsigned long long tie = __ballot(act && d8 == b2);
                    while (tie) {
                        const int ml = __ffsll((long long)tie) - 1; tie &= tie - 1ull;
                        const unsigned km = __shfl(ki, ml), im = __shfl(ii, ml);
                        unsigned rank = 0u;
                        for (int j0 = 0; j0 < n; j0 += 64) { const int j = j0 + lane; bool beats = false;
                            if (j < n) { const unsigned kj = ckey[qs * CB + j], ij = cidx[qs * CB + j]; beats = ((kj >> sh8) & m8) == b2 && (kj > km || (kj == km && ij < im)); }
                            rank += (unsigned)__popcll(__ballot(beats)); }
                        if (rank < need2 && lane == ml) atomicOr(&row[im >> 5], 1u << (im & 31u));
                    }
                }
            }
        }
    }
    asm volatile("s_waitcnt lgkmcnt(0)" ::: "memory");
    __syncthreads();
    { const int nq4 = (nkb + 3) >> 2;
      for (int i = tid; i < 16 * nq4; i += NTHREADS) { const int r = i / nq4, c4i = i - r * nq4;
          *(uint4*)(SELM + (size_t)(q0 + r) * SW + 4 * c4i) = *(const uint4*)(rows + r * SW + 4 * c4i); } }
}

constexpr int AW_BYTES = 512;
typedef short s16x2 __attribute__((ext_vector_type(2)));
DEVI float dot2bf(unsigned a, unsigned b, float c) { return __builtin_amdgcn_fdot2_f32_bf16(__builtin_bit_cast(s16x2, a), __builtin_bit_cast(s16x2, b), c, false); }
#define LDS_FENCE() asm volatile("s_waitcnt lgkmcnt(0)" ::: "memory")

struct AttnQ { float m, l, o[8]; };

DEVI void attn_issue(int b0, int n, const unsigned short* lst, const unsigned char* __restrict__ KV8, int lane, uint4 (&kv)[8]) {
    const int last = n - 1;
#pragma unroll
    for (int kk = 0; kk < 8; ++kk) { const int ii = b0 + kk; const int key = lst[ii < last ? ii : last]; kv[kk] = *(const uint4*)(KV8 + (size_t)key * 1024 + lane * 16); }
}
DEVI void attn_compute(AttnQ& S, int b0, int n, const float (&q)[8], const uint4 (&kv)[8]) {
    float sc[8]; float mx = S.m;
#pragma unroll
    for (int u = 0; u < 8; ++u) {
        const f32x2v k0 = __builtin_amdgcn_cvt_pk_f32_fp8((int)kv[u].x, false), k1 = __builtin_amdgcn_cvt_pk_f32_fp8((int)kv[u].x, true),
                     k2 = __builtin_amdgcn_cvt_pk_f32_fp8((int)kv[u].y, false), k3 = __builtin_amdgcn_cvt_pk_f32_fp8((int)kv[u].y, true);
        f32x2v d2 = k0 * (f32x2v){q[0], q[1]}; d2 = k1 * (f32x2v){q[2], q[3]} + d2; d2 = k2 * (f32x2v){q[4], q[5]} + d2; d2 = k3 * (f32x2v){q[6], q[7]} + d2;
        float d = d2[0] + d2[1];
        d += dpp_f<0xB1>(d); d += dpp_f<0x4E>(d); d += dpp_f<0x141>(d);
        sc[u] = (b0 + u < n) ? d : -INFINITY;
        mx = fmaxf(mx, sc[u]); }
    const float scale = __builtin_amdgcn_exp2f(S.m - mx);
    float ls = S.l * scale;
#pragma unroll
    for (int i = 0; i < 8; ++i) S.o[i] *= scale;
#pragma unroll
    for (int u = 0; u < 8; ++u) {
        const float p = __builtin_amdgcn_exp2f(sc[u] - mx); ls += p;
        const f32x2v v0 = __builtin_amdgcn_cvt_pk_f32_fp8((int)kv[u].z, false), v1 = __builtin_amdgcn_cvt_pk_f32_fp8((int)kv[u].z, true),
                     v2 = __builtin_amdgcn_cvt_pk_f32_fp8((int)kv[u].w, false), v3 = __builtin_amdgcn_cvt_pk_f32_fp8((int)kv[u].w, true);
        S.o[0] += p * v0[0]; S.o[1] += p * v0[1]; S.o[2] += p * v1[0]; S.o[3] += p * v1[1]; S.o[4] += p * v2[0]; S.o[5] += p * v2[1]; S.o[6] += p * v3[0]; S.o[7] += p * v3[1]; }
    S.l = ls; S.m = mx;
}

DEVI void attn_query(int t, const bf16_t* __restrict__ Qb, const unsigned char* __restrict__ KV8,
                     const unsigned* __restrict__ SELM, const unsigned* __restrict__ SELM2, bf16_t* __restrict__ AO, unsigned char* wl, int lane) {
    unsigned short* lst = (unsigned short*)wl;
    const unsigned* SR = SELM + (size_t)t * SW;
    LDS_FENCE();
    const int nw = (t >> 5) + 1; int base = 0;
    for (int w0 = 0; w0 < nw; w0 += 64) {
        const int wi = w0 + lane; const unsigned wv = wi < nw ? SR[wi] : 0u;
        const int pc = __popc(wv); int pre = pc;
#pragma unroll
        for (int off = 1; off < 64; off <<= 1) { const int o_ = __shfl_up(pre, off); if (lane >= off) pre += o_; }
        int pos = base + pre - pc; unsigned mm = wv;
        while (mm) { const int bpos = __ffs((int)mm) - 1; mm &= mm - 1u; if (pos < TOPK) lst[pos] = (unsigned short)(wi * 32 + bpos); ++pos; }
        base += __shfl(pre, 63);
    }
    const int n = base < TOPK ? base : TOPK;
    float q[8];
    { const uint4 qv = ((const uint4*)(Qb + (size_t)t * 512))[lane]; const float qs = 0.18033688011112042f;
      q[0] = bflo(qv.x) * qs; q[1] = bfhi(qv.x) * qs; q[2] = bflo(qv.y) * qs; q[3] = bfhi(qv.y) * qs; q[4] = bflo(qv.z) * qs; q[5] = bfhi(qv.z) * qs; q[6] = bflo(qv.w) * qs; q[7] = bfhi(qv.w) * qs; }
    LDS_FENCE();
    AttnQ S; S.m = -INFINITY; S.l = 0.f;
#pragma unroll
    for (int d = 0; d < 8; ++d) S.o[d] = 0.f;
    uint4 ka[8], kb_[8], kc[8];
    attn_issue(0, n, lst, KV8, lane, ka);
    if (8 < n) attn_issue(8, n, lst, KV8, lane, kb_);
    for (int b0 = 0; b0 < n; b0 += 24) {
        if (b0 + 16 < n) attn_issue(b0 + 16, n, lst, KV8, lane, kc);
        attn_compute(S, b0, n, q, ka);
        if (b0 + 8 < n) {
            if (b0 + 24 < n) attn_issue(b0 + 24, n, lst, KV8, lane, ka);
            attn_compute(S, b0 + 8, n, q, kb_);
            if (b0 + 16 < n) {
                if (b0 + 32 < n) attn_issue(b0 + 32, n, lst, KV8, lane, kb_);
                attn_compute(S, b0 + 16, n, q, kc);
            }
        }
    }
    const int hd = lane >> 3, ch = lane & 7;
    const float inv = 1.0f / S.l;
    uint4 pk; pk.x = cvt_pk_bf16(S.o[0] * inv, S.o[1] * inv); pk.y = cvt_pk_bf16(S.o[2] * inv, S.o[3] * inv); pk.z = cvt_pk_bf16(S.o[4] * inv, S.o[5] * inv); pk.w = cvt_pk_bf16(S.o[6] * inv, S.o[7] * inv);
    *(uint4*)(AO + (size_t)t * 1024 + 512 + hd * 64 + ch * 8) = pk;
}

__global__ void __launch_bounds__(NTHREADS, 2) fwd(Args a) {
    extern __shared__ __attribute__((aligned(16))) unsigned char lds_raw[];
    float* smf = (float*)lds_raw;
    PG8_LAS unsigned char* ldsp = (PG8_LAS unsigned char*)lds_raw;
    const int nwaves = gridDim.x * 8;
#define PHASE_VARS const int tid = otid(); const int lane = tid & 63, wave = tid >> 6; const int gwave = blockIdx.x * 8 + wave; (void)lane; (void)wave; (void)gwave;
    unsigned char* ws = a.ws;
    unsigned* ctl = (unsigned*)(ws + WS_CTL);
    const int lo = a.ph_lo, hi = a.ph_hi;

    volatile LAS unsigned* bst = (volatile LAS unsigned*)((LAS unsigned char*)lds_raw + (LDS_BYTES - 16));
    if (threadIdx.x == 0) { bst[0] = 0u; bst[1] = 0u; bst[2] = 0u; bst[3] = 0u; }
    __syncthreads();
    XcdBarrier bar; bar.bar = ctl; bar.x = 0; bar.st = bst;
    if (hi - lo > 1) bar = xcd_barrier_post(ctl, bst);
#define IN(k) (lo <= (k) && (k) < hi)
#define SEAM(k) do { if (IN(k) && IN((k) + 1)) xcd_barrier(bar); } while (0)

    const float* x = a.in[0]; const float* meta = a.in[1];
    float* ropeC = (float*)(ws + WS_ROPEC); float* ropeS = (float*)(ws + WS_ROPES);
    int* eid = (int*)(ws + WS_EID); float* gw = (float*)(ws + WS_GW); int* slot = (int*)(ws + WS_SLOT); int* mtiles = (int*)(ws + WS_MTILES);
    unsigned* counts0 = (unsigned*)(ws + CTL_CNT); unsigned* counts1 = counts0 + 32;
    unsigned* cursor0 = (unsigned*)(ws + CTL_CUR); unsigned* cursor1 = cursor0 + 32;
    bf16_t* Wta = (bf16_t*)(ws + WS_WTA); bf16_t* Wtx = (bf16_t*)(ws + WS_WTX);
    float* Aend = (float*)(ws + WS_AEND); float* Hend = (float*)(ws + WS_HEND); float* CIN = (float*)(ws + WS_CIN);
    unsigned char* big = ws + WS_BIG;
    bf16_t* WIN0 = (bf16_t*)(big + R_WIN0); bf16_t* WOUT0 = (bf16_t*)(big + R_WOUT0); bf16_t* WGU = (bf16_t*)(big + R_WGU); bf16_t* WD = (bf16_t*)(big + R_WD);
    bf16_t* WIN1 = (bf16_t*)(big + R_WIN1); bf16_t* WOUT1 = (bf16_t*)(big + R_WOUT1);
    bf16_t* X0b = (bf16_t*)(big + R_A); bf16_t* AO = (bf16_t*)(big + R_A); bf16_t* Xperm = (bf16_t*)(big + R_A); bf16_t* X2b = (bf16_t*)(big + R_A); bf16_t* YY = (bf16_t*)(big + R_A);
    float* H1 = (float*)(big + R_H1); float* H3 = (float*)(big + R_H1); float* H2 = (float*)(big + R_H2); unsigned* SELM = (unsigned*)(big + R_H1); unsigned* SELM2 = (unsigned*)(big + R_H1 + 36 * MiB);
    float* Z = (float*)(big + R_C); bf16_t* Yb = (bf16_t*)(big + R_C); float* Z1 = (float*)(big + R_C);
    unsigned char* KV8 = big + R_K;
    bf16_t* GLU = (bf16_t*)(big + R_GLU); bf16_t* Qb = (bf16_t*)(big + R_Q); bf16_t* Kb = (bf16_t*)(big + R_K); bf16_t* Vb = (bf16_t*)(big + R_V);
    bf16_t* QIb = (bf16_t*)(big + R_QI); bf16_t* KIb = (bf16_t*)(big + R_KI); float* WIf = (float*)(big + R_WI);
    bf16_t* GATEg = (bf16_t*)(big + R_GATE); bf16_t* XRb = (bf16_t*)(big + R_XR);
    bf16_t* Hm = (bf16_t*)(big + R_HM);

    if (IN(0)) { PHASE_VARS;
        const float* w_in = a.in[2]; const float* w_out = a.in[7]; const float* wg = a.in[21]; const float* wu = a.in[22]; const float* wd = a.in[23];
        constexpr int J_IN0 = 52 * 16, J_OUT0 = 16 * 16, J_GU = 32 * 256, J_D = 32 * 128, J_IN1 = 40 * 16, J_OUT1 = 16 * 20, J_GT = 80;
        const float* w_in1 = a.in[8]; const float* w_out1 = a.in[16]; const float* wga = a.in[11]; const float* wgx = a.in[13];
        tr_run(J_IN0 + J_OUT0 + J_GU + J_D + J_IN1 + J_OUT1 + J_GT, [&](int j) -> TrJob {
            TrJob J{};
            if (j < J_IN0) { J.dst = WIN0; J.s0 = w_in; J.K = 1024; J.n0 = (j >> 4) * 64; J.k0 = (j & 15) * 64; J.mode = 1; return J; }
            j -= J_IN0;
            if (j < J_OUT0) { J.dst = WOUT0; J.s0 = w_out; J.ld = D; J.K = 1024; J.n0 = (j >> 4) * 64; J.k0 = (j & 15) * 64; J.mode = 0; return J; }
            j -= J_OUT0;
            if (j < J_GU) { const int e = j >> 8, t = j & 255; J.dst = WGU + (size_t)e * 1024 * 1024; J.s0 = wg + (size_t)e * D * DE; J.s1 = wu + (size_t)e * D * DE; J.K = 1024; J.n0 = (t >> 4) * 64; J.k0 = (t & 15) * 64; J.mode = 2; return J; }
            j -= J_GU;
            if (j < J_D) { const int e = j >> 7, t = j & 127; J.dst = WD + (size_t)e * 1024 * 512; J.s0 = wd + (size_t)e * DE * D; J.ld = D; J.K = 512; J.n0 = (t >> 3) * 64; J.k0 = (t & 7) * 64; J.mode = 0; return J; }
            j -= J_D;
            if (j < J_IN1) { J.dst = WIN1; J.s0 = w_in1; J.ld = 2 * RNN_W; J.K = 1024; J.n0 = (j >> 4) * 64; J.k0 = (j & 15) * 64; J.mode = 0; return J; }
            j -= J_IN1;
            if (j < J_OUT1) { J.dst = WOUT1; J.s0 = w_out1; J.ld = D; J.K = RNN_W; J.n0 = (j / 20) * 64; J.k0 = (j % 20) * 64; J.mode = 0; return J; }
            j -= J_OUT1;
            { const int which = j / 40, r = j % 40; const int nb = r >> 2;
              J.dst = (which ? Wtx : Wta) + (size_t)nb * 128 * 128; J.s0 = (which ? wgx : wga) + (size_t)nb * 128 * 128; J.ld = 128; J.K = 128; J.n0 = ((r >> 1) & 1) * 64; J.k0 = (r & 1) * 64; J.mode = 0; return J; }
        }, smf);
        for (size_t i = (size_t)blockIdx.x * NTHREADS + tid; i < (size_t)LP * 256; i += (size_t)gridDim.x * NTHREADS) {
            const size_t r = i >> 8, c4 = i & 255;
            float4 v = make_float4(0.f, 0.f, 0.f, 0.f);
            if (r < NMETA) v = ((const float4*)meta)[r * 256 + c4]; else if (r < L) v = ((const float4*)x)[(r - NMETA) * 256 + c4];
            ((uint2*)X0b)[i] = make_uint2(cvt_pk_bf16(v.x, v.y), cvt_pk_bf16(v.z, v.w));
        }
        for (int i = blockIdx.x * NTHREADS + tid; i < 2 * 64 * 3 * 64; i += gridDim.x * NTHREADS) {
            const int ln = i & 63, ct = (i >> 6) % 3, ss = (i / 192) & 63, ly = i / (192 * 64);
            const int col = 16 * ct + (ln & 15), k0 = 16 * ss + 4 * (ln >> 4);
            float v[4];
#pragma unroll
            for (int j = 0; j < 4; ++j) v[j] = col < 4 ? a.in[17][(size_t)ly * D * NGRP + (size_t)(k0 + j) * NGRP + col] : col < 36 ? a.in[19][(size_t)ly * D * NE + (size_t)(k0 + j) * NE + (col - 4)] : 0.f;
            ((float4*)(ws + WS_WR))[i] = make_float4(v[0], v[1], v[2], v[3]);
        }
        for (int i = blockIdx.x * NTHREADS + tid; i < LP * 32; i += gridDim.x * NTHREADS) {
            const int p = i >> 5, f = i & 31;
            const float inv = (float)pow(10000.0, -(double)f / 32.0);
            const float ang = (float)p * inv;
            ropeC[i] = (float)cos((double)ang); ropeS[i] = (float)sin((double)ang);
        }
    }
    SEAM(0);
    if (IN(1)) { PHASE_VARS;
        pg8::Gemm g{X0b, WIN0, LP, 3328, 1024}; pg8::StaticOrder S; S.init(LP, 3328, (int)gridDim.x, (int)blockIdx.x);
        EpiIn0 E{GLU, KIb, WIf, ropeC, ropeS, KV8};
        pg8::gemm_phase<EpiIn0, pg8::StaticOrder>(ldsp, g, S, E);
    }
    SEAM(1);
    if (IN(2)) { PHASE_VARS;
        const float* cw = a.in[3]; const float* cb = a.in[4]; const float* lg = a.in[5]; const float* lb = a.in[6];
        for (int g4 = gwave; g4 < L / 4; g4 += nwaves) {
            const int t0 = g4 * 4, c0 = lane * 8;
            float acc[4][8], wwin[4][8];
            { const float4 b0 = *(const float4*)(cb + c0), b1 = *(const float4*)(cb + c0 + 4);
#pragma unroll
              for (int q = 0; q < 4; ++q) { acc[q][0] = b0.x; acc[q][1] = b0.y; acc[q][2] = b0.z; acc[q][3] = b0.w; acc[q][4] = b1.x; acc[q][5] = b1.y; acc[q][6] = b1.z; acc[q][7] = b1.w; } }
#pragma unroll
            for (int r = 0; r < CONV_K + 3; ++r) {
                const int tt = t0 - (CONV_K - 1) + r;
                if (r < CONV_K) { const float4 w0 = *(const float4*)(cw + r * CONV_CH + c0), w1 = *(const float4*)(cw + r * CONV_CH + c0 + 4);
                    wwin[r & 3][0] = w0.x; wwin[r & 3][1] = w0.y; wwin[r & 3][2] = w0.z; wwin[r & 3][3] = w0.w; wwin[r & 3][4] = w1.x; wwin[r & 3][5] = w1.y; wwin[r & 3][6] = w1.z; wwin[r & 3][7] = w1.w; }
                if (tt >= 0) {
                    const uint4 xv = *(const uint4*)(GLU + (size_t)tt * 512 + c0);
                    const float x[8] = {bflo(xv.x), bfhi(xv.x), bflo(xv.y), bfhi(xv.y), bflo(xv.z), bfhi(xv.z), bflo(xv.w), bfhi(xv.w)};
#pragma unroll
                    for (int q = 0; q < 4; ++q) { const int j = r - q;
                        if (j >= 0 && j < CONV_K) {
#pragma unroll
                            for (int i = 0; i < 8; ++i) acc[q][i] += wwin[j & 3][i] * x[i]; } }
                }
            }
            float gv[8], bvv[8];
            { const float4 g0 = *(const float4*)(lg + c0), g1 = *(const float4*)(lg + c0 + 4), b0 = *(const float4*)(lb + c0), b1 = *(const float4*)(lb + c0 + 4);
              gv[0] = g0.x; gv[1] = g0.y; gv[2] = g0.z; gv[3] = g0.w; gv[4] = g1.x; gv[5] = g1.y; gv[6] = g1.z; gv[7] = g1.w; bvv[0] = b0.x; bvv[1] = b0.y; bvv[2] = b0.z; bvv[3] = b0.w; bvv[4] = b1.x; bvv[5] = b1.y; bvv[6] = b1.z; bvv[7] = b1.w; }
#pragma unroll
            for (int q = 0; q < 4; ++q) {
                float s_ = 0.f;
#pragma unroll
                for (int i = 0; i < 8; ++i) s_ += acc[q][i];
                const float mu = wave_sum(s_) * (1.0f / 512.0f);
                float qq = 0.f;
#pragma unroll
                for (int i = 0; i < 8; ++i) { const float d = acc[q][i] - mu; qq += d * d; }
                const float rstd = 1.0f / sqrtf(wave_sum(qq) * (1.0f / 512.0f) + LN_EPS);
                float o[8];
#pragma unroll
                for (int i = 0; i < 8; ++i) { const float yv = (acc[q][i] - mu) * rstd * gv[i] + bvv[i]; o[i] = yv * fsigm(yv); }
                uint4 w; w.x = cvt_pk_bf16(o[0], o[1]); w.y = cvt_pk_bf16(o[2], o[3]); w.z = cvt_pk_bf16(o[4], o[5]); w.w = cvt_pk_bf16(o[6], o[7]);
                *(uint4*)(AO + (size_t)(t0 + q) * 1024 + c0) = w;
            }
        }
        for (int r = 0; ; ++r) {
            const int idx = r * (int)gridDim.x + ((r & 1) ? (int)gridDim.x - 1 - (int)blockIdx.x : (int)blockIdx.x);
            if (idx >= NTILE) break;
            indexer_tile((NTILE - 1 - idx) * 16, QIb, KIb, WIf, SELM, SELM2, lds_raw);
        }
    }
    SEAM(2);
    if (IN(3)) { PHASE_VARS;
        unsigned char* wl = lds_raw + wave * AW_BYTES;
        for (int t = gwave; t < L; t += nwaves) attn_query(t, Qb, KV8, SELM, SELM2, AO, wl, lane);
    }
    SEAM(3);
    if (IN(4)) { PHASE_VARS;
        pg8::Gemm g{AO, WOUT0, LP, 1024, 1024}; pg8::StaticOrder S; S.init(LP, 1024, (int)gridDim.x, (int)blockIdx.x);
        EpiRes0 E{x, meta, Z};
        pg8::gemm_phase<EpiRes0, pg8::StaticOrder>(ldsp, g, S, E);
    }
    SEAM(4);
    if (IN(5)) {
        for (int tb = blockIdx.x * 64; tb < L; tb += gridDim.x * 64)
            ln_route_block(tb, (L - tb) < 64 ? (L - tb) : 64, Z, H1, a.in[24], a.in[25], (const float4*)(ws + WS_WR), a.in[18], a.in[20], eid, gw, counts0, smf);
    }
    SEAM(5);
    if (IN(6)) { PHASE_VARS; moe_dispatch_mfma(H1, eid, counts0, cursor0, slot, mtiles, Xperm, (int*)lds_raw, gwave, nwaves, lane, 0); }
    SEAM(6);
    if (IN(7)) { PHASE_VARS;
        pg8::Gemm g{Xperm, WGU, MAXSLOT, 1024, 1024}; MoeOrder S; S.init(mtiles, (int)gridDim.x, (int)blockIdx.x);
        EpiGateUp E{Hm};
        pg8::gemm_phase<EpiGateUp, MoeOrder>(ldsp, g, S, E);
    }
    SEAM(7);
    if (IN(8)) { PHASE_VARS;
        pg8::Gemm g{Hm, WD, MAXSLOT, 1024, 512}; MoeOrder S; S.init(mtiles, (int)gridDim.x, (int)blockIdx.x);
        EpiDown E{Yb};
        pg8::gemm_phase<EpiDown, MoeOrder>(ldsp, g, S, E);
    }
    SEAM(8);
    if (IN(9)) { PHASE_VARS;
        for (int t = gwave; t < L; t += nwaves) {
            const int s0 = slot[2 * t], s1 = slot[2 * t + 1]; const float g0 = gw[2 * t], g1 = gw[2 * t + 1];
            float y[16];
            combine_row(y, H1 + (size_t)t * D, Yb + (size_t)s0 * D, Yb + (size_t)s1 * D, g0, g1, lane);
            ln_row1024v(y, a.in[26], a.in[27], lane);
#pragma unroll
            for (int i4 = 0; i4 < 4; ++i4) *(float4*)(H2 + (size_t)t * D + 16 * lane + 4 * i4) = make_float4(y[4 * i4], y[4 * i4 + 1], y[4 * i4 + 2], y[4 * i4 + 3]);
            uint4 p0, p1; p0.x = cvt_pk_bf16(y[0], y[1]); p0.y = cvt_pk_bf16(y[2], y[3]); p0.z = cvt_pk_bf16(y[4], y[5]); p0.w = cvt_pk_bf16(y[6], y[7]);
            p1.x = cvt_pk_bf16(y[8], y[9]); p1.y = cvt_pk_bf16(y[10], y[11]); p1.z = cvt_pk_bf16(y[12], y[13]); p1.w = cvt_pk_bf16(y[14], y[15]);
            *(uint4*)(X2b + (size_t)t * D + 16 * lane) = p0; *(uint4*)(X2b + (size_t)t * D + 16 * lane + 8) = p1;
        }
        for (int i = blockIdx.x * NTHREADS + tid; i < (LP - L) * D / 8; i += gridDim.x * NTHREADS) ((uint4*)(X2b + (size_t)L * D))[i] = make_uint4(0u, 0u, 0u, 0u);
    }
    SEAM(9);
    if (IN(10)) {
        pg8::Gemm g{X2b, WIN1, LP, 2 * RNN_W, 1024}; pg8::StaticOrder S; S.init(LP, 2 * RNN_W, (int)gridDim.x, (int)blockIdx.x);
        EpiIn1 E{GATEg};
        pg8::gemm_phase<EpiIn1, pg8::StaticOrder>(ldsp, g, S, E);
    }
    SEAM(10);
    if (IN(11)) {
        for (int u = blockIdx.x; u < NCHUNK * RNN_NB; u += gridDim.x)
            rglru_unit<false>(u / RNN_NB, u % RNN_NB, XRb, GATEg, Wta, Wtx, a.in[9], a.in[10], a.in[12], a.in[14], a.in[15], Aend, Hend, CIN, YY, lds_raw);
    }
    SEAM(11);
    if (IN(12)) { PHASE_VARS;
        for (int ch = gwave; ch < RNN_W; ch += nwaves) {
            float A[5], H[5];
#pragma unroll
            for (int i = 0; i < 5; ++i) { const int c = 5 * lane + i; const bool ok = c < NCHUNK; A[i] = ok ? Aend[(size_t)ch * CP + c] : 1.f; H[i] = ok ? Hend[(size_t)ch * CP + c] : 0.f; }
            float Al = 1.f, Hl = 0.f;
#pragma unroll
            for (int i = 0; i < 5; ++i) { Hl = A[i] * Hl + H[i]; Al *= A[i]; }
#pragma unroll
            for (int off = 1; off < 64; off <<= 1) { const float Ap = __shfl_up(Al, off), Hp = __shfl_up(Hl, off); if (lane >= off) { Hl = Al * Hp + Hl; Al = Al * Ap; } }
            float cin = __shfl_up(Hl, 1); if (lane == 0) cin = 0.f;
#pragma unroll
            for (int i = 0; i < 5; ++i) { const int c = 5 * lane + i; if (c < NCHUNK) { CIN[(size_t)ch * CP + c] = cin; cin = A[i] * cin + H[i]; } }
        }
    }
    SEAM(12);
    if (IN(13)) {
        for (int u = blockIdx.x; u < NCHUNK * RNN_NB; u += gridDim.x)
            rglru_unit<true>(u / RNN_NB, u % RNN_NB, XRb, GATEg, Wta, Wtx, a.in[9], a.in[10], a.in[12], a.in[14], a.in[15], Aend, Hend, CIN, YY, lds_raw);
    }
    SEAM(13);
    if (IN(14)) {
        pg8::Gemm g{YY + (size_t)NMETA * RNN_W, WOUT1, SEQ, 1024, RNN_W}; pg8::StaticOrder S; S.init(SEQ, 1024, (int)gridDim.x, (int)blockIdx.x);
        EpiRes1 E{H2 + (size_t)NMETA * D, Z1 + (size_t)NMETA * D};
        pg8::gemm_phase<EpiRes1, pg8::StaticOrder>(ldsp, g, S, E);
    }
    SEAM(14);
    if (IN(15)) { PHASE_VARS;
        const float* wg = a.in[21] + (size_t)NE * D * DE; const float* wu = a.in[22] + (size_t)NE * D * DE; const float* wd = a.in[23] + (size_t)NE * DE * D;
        constexpr int J_GU = 32 * 256, J_D = 32 * 128;
        tr_run(J_GU + J_D, [&](int j) -> TrJob {
            TrJob J{};
            if (j < J_GU) { const int e = j >> 8, t = j & 255; J.dst = WGU + (size_t)e * 1024 * 1024; J.s0 = wg + (size_t)e * D * DE; J.s1 = wu + (size_t)e * D * DE; J.K = 1024; J.n0 = (t >> 4) * 64; J.k0 = (t & 15) * 64; J.mode = 2; return J; }
            j -= J_GU;
            { const int e = j >> 7, t = j & 127; J.dst = WD + (size_t)e * 1024 * 512; J.s0 = wd + (size_t)e * DE * D; J.ld = D; J.K = 512; J.n0 = (t >> 3) * 64; J.k0 = (t & 7) * 64; J.mode = 0; return J; }
        }, smf);
        __syncthreads();
        for (int tb = NMETA + blockIdx.x * 64; tb < L; tb += gridDim.x * 64)
            ln_route_block(tb, (L - tb) < 64 ? (L - tb) : 64, Z1, H3, a.in[24] + D, a.in[25] + D, (const float4*)(ws + WS_WR) + 64 * 3 * 64, a.in[18] + NGRP, a.in[20] + NE, eid, gw, counts1, smf);
    }
    SEAM(15);
    if (IN(16)) { PHASE_VARS; moe_dispatch_mfma(H3, eid, counts1, cursor1, slot, mtiles, Xperm, (int*)lds_raw, gwave, nwaves, lane, 2 * NMETA); }
    SEAM(16);
    if (IN(17)) {
        pg8::Gemm g{Xperm, WGU, MAXSLOT, 1024, 1024}; MoeOrder S; S.init(mtiles, (int)gridDim.x, (int)blockIdx.x);
        EpiGateUp E{Hm};
        pg8::gemm_phase<EpiGateUp, MoeOrder>(ldsp, g, S, E);
    }
    SEAM(17);
    if (IN(18)) {
        pg8::Gemm g{Hm, WD, MAXSLOT, 1024, 512}; MoeOrder S; S.init(mtiles, (int)gridDim.x, (int)blockIdx.x);
        EpiDown E{Yb};
        pg8::gemm_phase<EpiDown, MoeOrder>(ldsp, g, S, E);
    }
    SEAM(18);
    if (IN(19)) { PHASE_VARS;
        for (int t = NMETA + gwave; t < L; t += nwaves) {
            const int s0 = slot[2 * t], s1 = slot[2 * t + 1]; const float g0 = gw[2 * t], g1 = gw[2 * t + 1];
            float y[16];
            combine_row(y, H3 + (size_t)t * D, Yb + (size_t)s0 * D, Yb + (size_t)s1 * D, g0, g1, lane);
            ln_row1024v(y, a.in[26] + D, a.in[27] + D, lane);
#pragma unroll
            for (int i4 = 0; i4 < 4; ++i4) *(float4*)(a.out + (size_t)(t - NMETA) * D + 16 * lane + 4 * i4) = make_float4(y[4 * i4], y[4 * i4 + 1], y[4 * i4 + 2], y[4 * i4 + 3]);
        }
    }
#undef IN
#undef SEAM
}
constexpr int N_PHASES = 20;

extern "C" void kernel_launch(void* const* d_in, const int* in_sizes, int n_in, void* d_out, int out_size, void* d_ws, size_t ws_size, hipStream_t stream) {
    static int grid = 0;
    if (grid == 0) {
        if (n_in != 28 || out_size != SEQ * D || ws_size < WS_END) { fprintf(stderr, "kernel_launch: unexpected shapes n_in %d out %d ws %zu (need %zu)\n", n_in, out_size, ws_size, (size_t)WS_END); grid = -1; return; }
        int dev = 0, cus = 0;
        if (hipGetDevice(&dev) != hipSuccess || hipDeviceGetAttribute(&cus, hipDeviceAttributeMultiprocessorCount, dev) != hipSuccess) { grid = -1; return; }
        if (hipFuncSetAttribute((const void*)fwd, hipFuncAttributeMaxDynamicSharedMemorySize, LDS_BYTES) != hipSuccess) { fprintf(stderr, "kernel_launch: hipFuncSetAttribute failed\n"); grid = -1; return; }
        int per_cu = 0;
        if (hipOccupancyMaxActiveBlocksPerMultiprocessor(&per_cu, (const void*)fwd, NTHREADS, LDS_BYTES) != hipSuccess || per_cu < 1) fprintf(stderr, "kernel_launch: occupancy query says %d\n", per_cu);
        (void)hipGetLastError();
        grid = cus;
    }
    if (grid < 0) return;
    (void)hipMemsetAsync((char*)d_ws + WS_CTL, 0, CTL_BYTES, stream);
    Args a{};
    for (int i = 0; i < 28; ++i) a.in[i] = (const float*)d_in[i];
    a.out = (float*)d_out; a.ws = (unsigned char*)d_ws;
#if N_LAUNCH_MODE == 1
    a.ph_lo = 0; a.ph_hi = N_PHASES;
    hipLaunchKernelGGL(fwd, dim3(grid), dim3(NTHREADS), LDS_BYTES, stream, a);
#else
    for (int p = 0; p < N_PHASES; ++p) { a.ph_lo = p; a.ph_hi = p + 1; hipLaunchKernelGGL(fwd, dim3(grid), dim3(NTHREADS), LDS_BYTES, stream, a); }
#endif
}
```

```cpp
#include <hip/hip_runtime.h>
#include <cstdio>
#include <cstdint>
#include <cmath>

#ifndef N_LAUNCH_MODE
#define N_LAUNCH_MODE 1
#endif

#define DEVI __device__ __forceinline__
#define LAS __attribute__((address_space(3)))

constexpr int D = 1024, SEQ = 16384, NMETA = 16, L = SEQ + NMETA;
constexpr int CONV_CH = 512, CONV_K = 31, HD = 64, TOPK = 256;
constexpr int IN_AB = 3144;
constexpr int OFF_AVAL = 0, OFF_AGATE = 512, OFF_Q = 1024, OFF_K = 1536, OFF_V = 2048, OFF_QI = 2560, OFF_KI = 3072, OFF_WI = 3136;
constexpr int RNN_W = 1280, RNN_NB = 10, RNN_BW = 128, RNN_K = 4;
constexpr int NGRP = 4, EPG = 8, NE = 32, DE = 512;
constexpr int NPAIR = 2 * L;
constexpr float LN_EPS = 1e-5f;
constexpr float DN_ALPHA = 1.41421356237f;
constexpr int NTHREADS = 512;
constexpr int LDS_BYTES = 147456;

#define XB_TMO      128
#define XB_XCNT(j)  (256  + 64 * (j))
#define XB_XSUB(j)  (1280 + 64 * (j))
#define XB_XGEN(j)  (2304 + 64 * (j))
#define XB_TOP      3328
#define XB_TOPGEN   3392
#define XCD_BAR_WORDS 3456
#define XB_SPIN_CAP (1u << 22)
DEVI unsigned xb_ld(unsigned* p)              { return __hip_atomic_load(p, __ATOMIC_RELAXED, __HIP_MEMORY_SCOPE_AGENT); }
DEVI unsigned xb_add(unsigned* p, unsigned v) { return __hip_atomic_fetch_add(p, v, __ATOMIC_RELAXED, __HIP_MEMORY_SCOPE_AGENT); }
DEVI unsigned xb_xcc_id() { return (unsigned)__builtin_amdgcn_s_getreg((3 << 11) | 20) & 0xFu; }
#define XB_SPIN(cond, bar) do { unsigned _sp = 0; while (cond) { __builtin_amdgcn_s_sleep(1); \
    if ((++_sp & 255u) == 0u) { if (xb_ld(&(bar)[XB_TMO])) break; if (_sp > XB_SPIN_CAP) { atomicAdd(&(bar)[XB_TMO], 1u); break; } } } } while (0)
struct XcdBarrier { unsigned* bar; unsigned x; volatile LAS unsigned* st; };
DEVI XcdBarrier xcd_barrier_post(unsigned* bar, volatile LAS unsigned* st) {
    XcdBarrier b; b.bar = bar; b.x = xb_xcc_id(); b.st = st;
    if (threadIdx.x == 0) (void)xb_add(&bar[XB_XCNT(b.x)], 1u);
    return b;
}
DEVI void xcd_barrier_complete(unsigned* bar, unsigned x, unsigned& nloc, unsigned& nx) {
    const unsigned G = gridDim.x * gridDim.y * gridDim.z;
    unsigned sum, cnt, mine, sp = 0u;
    for (;;) {
        sum = 0u; cnt = 0u; mine = 0u;
#pragma unroll
        for (unsigned j = 0; j < 16; ++j) { const unsigned c = xb_ld(&bar[XB_XCNT(j)]); sum += c; cnt += (c > 0u) ? 1u : 0u; mine = (j == x) ? c : mine; }
        if (sum == G) break;
        __builtin_amdgcn_s_sleep(1);
        if ((++sp & 255u) == 0u) { if (xb_ld(&bar[XB_TMO])) break; if (sp > XB_SPIN_CAP) { atomicAdd(&bar[XB_TMO], 1u); break; } }
    }
    nloc = mine > 0u ? mine : 1u; nx = cnt > 0u ? cnt : 1u;
}
DEVI void xcd_barrier(const XcdBarrier& b) {
    asm volatile("s_waitcnt vmcnt(0)" ::: "memory");
    __syncthreads();
    if (threadIdx.x == 0) {
        unsigned* bar = b.bar;
        __builtin_amdgcn_s_waitcnt(0);
        unsigned nloc = b.st[0], nx = b.st[1];
        if (nloc == 0u) { xcd_barrier_complete(bar, b.x, nloc, nx); b.st[0] = nloc; b.st[1] = nx; }
        const unsigned old = xb_add(&bar[XB_XSUB(b.x)], 1u);
        const unsigned gen = old / nloc;
        if (old + 1u == (gen + 1u) * nloc) {
            __builtin_amdgcn_fence(__ATOMIC_RELEASE, "agent");
            asm volatile("s_waitcnt vmcnt(0)" ::: "memory");
            const unsigned og = xb_add(&bar[XB_TOP], 1u);
            const unsigned tg = og / nx;
            if (og + 1u == (tg + 1u) * nx) xb_add(&bar[XB_TOPGEN], 1u);
            else XB_SPIN(xb_ld(&bar[XB_TOPGEN]) == tg, bar);
            __builtin_amdgcn_fence(__ATOMIC_ACQUIRE, "agent");
            xb_add(&bar[XB_XGEN(b.x)], 1u);
            asm volatile("s_waitcnt vmcnt(0)" ::: "memory");
        } else {
            XB_SPIN(xb_ld(&bar[XB_XGEN(b.x)]) == gen, bar);
            __builtin_amdgcn_fence(__ATOMIC_ACQUIRE, "agent");
            asm volatile("s_waitcnt vmcnt(0)" ::: "memory");
        }
    }
    __syncthreads();
}

constexpr int LP = 16640;
constexpr int MAXSLOT = 40960;
constexpr int NCHUNK = 257, CP = 272;
constexpr size_t MiB = 1048576;
constexpr size_t WS_CTL = 0;
constexpr size_t CTL_CNT = 16384;
constexpr size_t CTL_CUR = 16384 + 256;
constexpr size_t CTL_BYTES = 32768;
constexpr size_t WS_ROPEC = 32768;
constexpr size_t WS_ROPES = WS_ROPEC + (size_t)LP * 32 * 4;
constexpr size_t WS_EID = WS_ROPES + (size_t)LP * 32 * 4;
constexpr size_t WS_GW = WS_EID + (size_t)NPAIR * 4;
constexpr size_t WS_SLOT = WS_GW + (size_t)NPAIR * 4;
constexpr size_t WS_MTILES = WS_SLOT + (size_t)NPAIR * 4;
constexpr size_t WS_WTA = WS_MTILES + 4096;
constexpr size_t WS_WTX = WS_WTA + (size_t)RNN_NB * 128 * 128 * 2;
constexpr size_t WS_AEND = WS_WTX + (size_t)RNN_NB * 128 * 128 * 2;
constexpr size_t WS_HEND = WS_AEND + (size_t)RNN_W * CP * 4;
constexpr size_t WS_CIN = WS_HEND + (size_t)RNN_W * CP * 4;
constexpr size_t WS_WR = WS_CIN + (size_t)RNN_W * CP * 4;
constexpr size_t WS_BIG = ((WS_WR + (size_t)2 * 64 * 3 * 64 * 16 + 255) / 256) * 256;
constexpr size_t R_WIN0 = 0;
constexpr size_t R_WOUT0 = R_WIN0 + (size_t)3328 * 1024 * 2;
constexpr size_t R_WGU = R_WOUT0 + (size_t)1024 * 1024 * 2;
constexpr size_t R_WD = R_WGU + (size_t)32 * 1024 * 1024 * 2;
constexpr size_t R_WIN1 = R_WD + (size_t)32 * 1024 * 512 * 2;
constexpr size_t R_WOUT1 = R_WIN1 + (size_t)2560 * 1024 * 2;
static_assert(R_WOUT1 + (size_t)1024 * 1280 * 2 <= 112 * MiB, "weights");
constexpr size_t R_A = 112 * MiB;
constexpr size_t R_H1 = 192 * MiB;
constexpr size_t R_H2 = 257 * MiB;
constexpr size_t R_C = 322 * MiB;
constexpr size_t R_GLU = 322 * MiB;
constexpr size_t SZ512 = (size_t)LP * 512 * 2;
constexpr size_t R_Q = R_GLU + SZ512, R_K = R_Q + SZ512, R_V = R_K + SZ512, R_QI = R_V + SZ512, R_KI = R_QI + SZ512, R_WI = R_KI + (size_t)LP * 64 * 2;
static_assert(R_WI + (size_t)LP * 8 * 4 <= 406 * MiB, "in-proj outputs");
constexpr size_t R_GATE = 322 * MiB;
constexpr size_t R_XR = R_GATE + (size_t)LP * 1280 * 2;
static_assert(R_XR + (size_t)LP * 1280 * 2 <= 406 * MiB, "layer-1 in-proj outputs");
constexpr size_t R_HM = 406 * MiB;
constexpr size_t WS_END = WS_BIG + R_HM + (size_t)MAXSLOT * 512 * 2;
static_assert(WS_END <= 512 * MiB, "ws");

struct Args { const float* in[28]; float* out; unsigned char* ws; int ph_lo, ph_hi; };

DEVI int otid() { int v = (int)threadIdx.x; asm volatile("" : "+v"(v)); return v; }
template <int CTRL> DEVI float dpp_f(float v) { return __int_as_float(__builtin_amdgcn_mov_dpp(__float_as_int(v), CTRL, 0xF, 0xF, true)); }
DEVI float wave_sum(float v) {
    v += dpp_f<0xB1>(v); v += dpp_f<0x4E>(v); v += dpp_f<0x141>(v); v += dpp_f<0x140>(v);
    return __int_as_float(__builtin_amdgcn_readlane(__float_as_int(v), 0)) + __int_as_float(__builtin_amdgcn_readlane(__float_as_int(v), 16))
         + __int_as_float(__builtin_amdgcn_readlane(__float_as_int(v), 32)) + __int_as_float(__builtin_amdgcn_readlane(__float_as_int(v), 48));
}
DEVI float wave_max(float v) {
#pragma unroll
    for (int o = 32; o > 0; o >>= 1) v = fmaxf(v, __shfl_xor(v, o));
    return v;
}
DEVI float sigm(float x) { return 1.0f / (1.0f + expf(-x)); }
DEVI float gelu_tanh(float x) { return 0.5f * x * (1.0f + tanhf(0.7978845608028654f * (x + 0.044715f * x * x * x))); }
DEVI unsigned f2key(float f) { unsigned u = __float_as_uint(f); return (u & 0x80000000u) ? ~u : (u | 0x80000000u); }

namespace pg8 {
#define PG8_LAS __attribute__((address_space(3)))
typedef unsigned short bf16_t;
typedef short bf16x8 __attribute__((ext_vector_type(8)));
typedef float f32x4 __attribute__((ext_vector_type(4)));
typedef unsigned u32x4 __attribute__((ext_vector_type(4)));
constexpr int BM = 256, BK = 64, HALF = 128, HTB = HALF * BK * 2  , STAGE_BYTES = 8 * HTB, NXCD = 8, WGM = 8;

__host__ __device__ __forceinline__ int lds_byte(int r, int c) { const int st = (r >> 4) * 2 + (c >> 5), rr = r & 15, cc = c & 31, ob = rr * 64 + cc * 2; return st * 1024 + (ob ^ (((ob >> 9) & 1) << 5)); }
__host__ __device__ __forceinline__ void stage_rc(int b, int& R, int& C) { const int st = b / 1024, sb = b % 1024, swz = sb ^ (((sb >> 9) & 1) << 5); R = (st >> 1) * 16 + swz / 64; C = (st & 1) * 32 + (swz % 64) / 2; }
__host__ __device__ __forceinline__ int perm32(int rho) { const int n = rho >> 4, i = rho & 15; return 8 * (i >> 2) + 4 * n + (i & 3); }

struct Unit { int pm, pn; };
struct Gemm { const bf16_t* A; const bf16_t* Bt; int M, N, K; };

struct StaticOrder {
    int nM, nN, nwg, G, c;
    __host__ __device__ void init(int M, int N, int G_, int c_) { nM = M / BM; nN = N / BM; nwg = nM * nN; G = G_; c = c_; }
    __host__ __device__ bool next(int i, Unit& u) const {
        const long L = (long)i * G + c; if (L >= nwg) return false;
        int wgid = (int)L; { const int q = nwg / NXCD, r = nwg % NXCD, xcd = wgid % NXCD, off = wgid / NXCD; wgid = (xcd < r ? xcd * (q + 1) : r * (q + 1) + (xcd - r) * q) + off; }
        const int nig = WGM * nN, gid = wgid / nig, fm = gid * WGM, gsz = (nM - fm) < WGM ? (nM - fm) : WGM;
        u.pm = fm + ((wgid % nig) % gsz); u.pn = (wgid % nig) / gsz; return true;
    }
    __device__ __forceinline__ void a_ready(const Unit&) const {}
    __device__ __forceinline__ void done(const Unit&) const {}
};

template <class Epi, class Sched>
__device__ __forceinline__ void gemm_phase(PG8_LAS unsigned char* lds, const Gemm g, const Sched& S, const Epi& E) {
    const int tid = threadIdx.x, wid = __builtin_amdgcn_readfirstlane(tid >> 6), lane = tid & 63, wr = wid >> 2, wc = wid & 3, fr = lane & 15, fq = lane >> 4;
    const int K = g.K, nt = K / BK;
    unsigned voffA[2], voffB[2];
#pragma unroll
    for (int i = 0; i < 2; ++i) { int R, C; stage_rc(tid * 16 + i * 8192, R, C); const int Rb = Epi::PERM ? ((R & ~31) + perm32(R & 31)) : R;
        voffA[i] = (unsigned)(R * K + C) * 2u; voffB[i] = (unsigned)(Rb * K + C) * 2u; }
    const size_t kstep = (size_t)(BK * 2);
    const size_t hstep = (size_t)HALF * K * 2;
    const size_t tstep = 2 * hstep;
    const unsigned ldsw = (unsigned)wid * 1024u;
    const int aoff = lds_byte(wr * 64 + fr, fq * 8), boff = lds_byte(wc * 32 + fr, fq * 8);
#define PG8_SA(b, h) (((b) * 2 + (h)) * HTB)
#define PG8_SB(b, h) ((4 + (b) * 2 + (h)) * HTB)
#define PG8_STAGE(bufoff, gbase, voff) do { _Pragma("unroll") for (int _i = 0; _i < 2; ++_i) \
        __builtin_amdgcn_global_load_lds((const unsigned*)((const char*)(gbase) + (voff)[_i]), (PG8_LAS unsigned*)(lds + (bufoff) + ldsw + _i * 8192), 16, 0, 0); } while (0)
#define PG8_LDA(dst, b, h) do { _Pragma("unroll") for (int m = 0; m < 4; ++m) _Pragma("unroll") for (int k = 0; k < 2; ++k) dst[m][k] = *(const PG8_LAS bf16x8*)(lds + PG8_SA(b, h) + aoff + m * 2048 + k * 1024); } while (0)
#define PG8_LDB(dst, b, h) do { _Pragma("unroll") for (int n = 0; n < 2; ++n) _Pragma("unroll") for (int k = 0; k < 2; ++k) dst[n][k] = *(const PG8_LAS bf16x8*)(lds + PG8_SB(b, h) + boff + n * 2048 + k * 1024); } while (0)
#define PG8_MMA(ai, bj, At, Bt) do { __builtin_amdgcn_s_setprio(1); _Pragma("unroll") for (int m = 0; m < 4; ++m) _Pragma("unroll") for (int n = 0; n < 2; ++n) _Pragma("unroll") for (int k = 0; k < 2; ++k) \
        acc[ai][bj][m][n] = __builtin_amdgcn_mfma_f32_16x16x32_bf16(Bt[n][k], At[m][k], acc[ai][bj][m][n], 0, 0, 0); __builtin_amdgcn_s_setprio(0); } while (0)
#define PG8_WAIT_V(n) asm volatile("s_waitcnt vmcnt(" #n ")" ::: "memory")
#define PG8_WAIT_L(n) asm volatile("s_waitcnt lgkmcnt(" #n ")" ::: "memory")
#define PG8_BAR __builtin_amdgcn_s_barrier()
#define PG8_SCHED __builtin_amdgcn_sched_barrier(0)
    Unit cur, nxt; int ui = 0;
    if (!S.next(0, cur)) return;
    f32x4 acc[2][2][4][2];
#pragma unroll
    for (int a = 0; a < 2; ++a)
#pragma unroll
        for (int b = 0; b < 2; ++b)
#pragma unroll
            for (int m = 0; m < 4; ++m)
#pragma unroll
                for (int n = 0; n < 2; ++n) acc[a][b][m][n] = (f32x4){0.f, 0.f, 0.f, 0.f};
    bf16x8 At[4][2], B0[2][2], B1[2][2];
    const char* cA = (const char*)g.A + (size_t)cur.pm * tstep; const char* cB = (const char*)g.Bt + (size_t)cur.pn * tstep;
    S.a_ready(cur);
    PG8_STAGE(PG8_SB(0, 0), cB, voffB); PG8_STAGE(PG8_SA(0, 0), cA, voffA); PG8_STAGE(PG8_SB(0, 1), cB + hstep, voffB); PG8_STAGE(PG8_SA(0, 1), cA + hstep, voffA);
    if (wr == 1) PG8_BAR;
    PG8_WAIT_V(4); PG8_BAR;
    PG8_STAGE(PG8_SB(1, 0), cB + kstep, voffB); PG8_STAGE(PG8_SA(1, 0), cA + kstep, voffA); PG8_STAGE(PG8_SB(1, 1), cB + hstep + kstep, voffB);
    PG8_WAIT_V(6); PG8_BAR;
    for (;;) {
        const bool has_next = S.next(ui + 1, nxt);
        const char* nA = has_next ? (const char*)g.A + (size_t)nxt.pm * tstep : cA; const char* nB = has_next ? (const char*)g.Bt + (size_t)nxt.pn * tstep : cB;
        for (int t = 0; t < nt; t += 2) {
            const bool last = (t == nt - 2);
            const char* a1 = cA + (size_t)(t + 1) * kstep;
            const char* a2 = last ? nA : cA + (size_t)(t + 2) * kstep; const char* b2 = last ? nB : cB + (size_t)(t + 2) * kstep;
            const char* a3 = a2 + kstep; const char* b3 = b2 + kstep;
            if (last && has_next) S.a_ready(nxt);
            PG8_LDB(B0, 0, 0); PG8_SCHED; PG8_LDA(At, 0, 0); PG8_STAGE(PG8_SA(1, 1), a1 + hstep, voffA);
            PG8_WAIT_L(8); PG8_BAR; PG8_WAIT_L(0); PG8_MMA(0, 0, At, B0); PG8_BAR; PG8_SCHED;
            PG8_LDB(B1, 0, 1); PG8_STAGE(PG8_SB(0, 0), b2, voffB);
            PG8_BAR; PG8_WAIT_L(0); PG8_MMA(0, 1, At, B1); PG8_BAR;
            PG8_LDA(At, 0, 1); PG8_STAGE(PG8_SA(0, 0), a2, voffA);
            PG8_BAR; PG8_WAIT_L(0); PG8_MMA(1, 0, At, B0); PG8_BAR; PG8_SCHED;
            PG8_STAGE(PG8_SB(0, 1), b2 + hstep, voffB);
            PG8_WAIT_V(6); PG8_BAR; PG8_MMA(1, 1, At, B1); PG8_BAR;
            PG8_LDB(B0, 1, 0); PG8_SCHED; PG8_LDA(At, 1, 0); PG8_STAGE(PG8_SA(0, 1), a2 + hstep, voffA);
            PG8_WAIT_L(8); PG8_BAR; PG8_WAIT_L(0); PG8_MMA(0, 0, At, B0); PG8_BAR; PG8_SCHED;
            PG8_LDB(B1, 1, 1); PG8_STAGE(PG8_SB(1, 0), b3, voffB);
            PG8_BAR; PG8_WAIT_L(0); PG8_MMA(0, 1, At, B1); PG8_BAR;
            PG8_LDA(At, 1, 1); PG8_STAGE(PG8_SA(1, 0), a3, voffA);
            PG8_BAR; PG8_WAIT_L(0); PG8_MMA(1, 0, At, B0); PG8_BAR; PG8_SCHED;
            PG8_STAGE(PG8_SB(1, 1), b3 + hstep, voffB);
            PG8_WAIT_V(6); PG8_BAR; PG8_MMA(1, 1, At, B1); PG8_BAR;
        }
        if constexpr (!Epi::AFTER_DRAIN) { E(acc, cur, wr, wc, fr, fq); S.done(cur); }
        if (!has_next) break;
#pragma unroll
        for (int a = 0; a < 2; ++a)
#pragma unroll
            for (int b = 0; b < 2; ++b)
#pragma unroll
                for (int m = 0; m < 4; ++m)
#pragma unroll
                    for (int n = 0; n < 2; ++n) acc[a][b][m][n] = (f32x4){0.f, 0.f, 0.f, 0.f};
        cur = nxt; cA = nA; cB = nB; ++ui;
    }
    PG8_WAIT_V(0);
    if (wr == 0) PG8_BAR;
    PG8_BAR;
    if constexpr (Epi::AFTER_DRAIN) { E.fused(acc, cur, wr, wc, fr, fq, lds, wid, lane); S.done(cur); }
#undef PG8_SA
#undef PG8_SB
#undef PG8_STAGE
#undef PG8_LDA
#undef PG8_LDB
#undef PG8_MMA
#undef PG8_WAIT_V
#undef PG8_WAIT_L
#undef PG8_BAR
#undef PG8_SCHED
}
}

DEVI void ln_row1024(float (&y)[16], const float* g, const float* b, int lane) {
    float s = 0.f;
#pragma unroll
    for (int i = 0; i < 16; ++i) s += y[i];
    const float mu = wave_sum(s) * (1.0f / 1024.0f);
    float q = 0.f;
#pragma unroll
    for (int i = 0; i < 16; ++i) { const float d = y[i] - mu; q += d * d; }
    const float rstd = 1.0f / sqrtf(wave_sum(q) * (1.0f / 1024.0f) + LN_EPS);
#pragma unroll
    for (int i = 0; i < 16; ++i) y[i] = (y[i] - mu) * rstd * g[lane + 64 * i] + b[lane + 64 * i];
}

DEVI void route_token(const float (&y)[16], float* ys, int t, int lane, const float* wg, const float* bg, const float* we, const float* be, int* eid, float* gw, unsigned* counts) {
    float lg[36];
#pragma unroll
    for (int j = 0; j < 36; ++j) lg[j] = 0.f;
#pragma unroll
    for (int i = 0; i < 16; ++i) ys[lane + 64 * i] = y[i];
#pragma unroll 1
    for (int i = 0; i < 16; ++i) {
        const int c = lane + 64 * i;
        const float yv = ys[c];
        const float4 g4 = *(const float4*)(wg + (size_t)c * 4);
        lg[0] += yv * g4.x; lg[1] += yv * g4.y; lg[2] += yv * g4.z; lg[3] += yv * g4.w;
#pragma unroll
        for (int j = 0; j < 8; ++j) { const float4 e4 = *(const float4*)(we + (size_t)c * 32 + j * 4);
            lg[4 + j * 4 + 0] += yv * e4.x; lg[4 + j * 4 + 1] += yv * e4.y; lg[4 + j * 4 + 2] += yv * e4.z; lg[4 + j * 4 + 3] += yv * e4.w; }
    }
#pragma unroll
    for (int j = 0; j < 36; ++j) lg[j] = wave_sum(lg[j]);
    if (lane == 0) {
        float gl[4]; int g = 0;
#pragma unroll
        for (int j = 0; j < 4; ++j) gl[j] = lg[j] + bg[j];
#pragma unroll
        for (int j = 1; j < 4; ++j) if (gl[j] > gl[g]) g = j;
        float den = 0.f;
#pragma unroll
        for (int j = 0; j < 4; ++j) den += expf(gl[j] - gl[g]);
        const float gp = 1.0f / den;
        float el[8];
#pragma unroll
        for (int j = 0; j < 8; ++j) { float v = 0.f;
#pragma unroll
            for (int gg = 0; gg < 4; ++gg) v = (gg == g) ? lg[4 + gg * 8 + j] + be[gg * 8 + j] : v;
            el[j] = v; }
        int i1 = 0;
#pragma unroll
        for (int j = 1; j < 8; ++j) if (el[j] > el[i1]) i1 = j;
        int i2 = (i1 == 0) ? 1 : 0;
#pragma unroll
        for (int j = 0; j < 8; ++j) if (j != i1 && el[j] > el[i2]) i2 = j;
        const float ex = expf(el[i2] - el[i1]);
        const float p1 = 1.0f / (1.0f + ex), p2 = ex / (1.0f + ex);
        const int e1 = g * 8 + i1, e2 = g * 8 + i2;
        eid[2 * t] = e1; eid[2 * t + 1] = e2; gw[2 * t] = gp * p1; gw[2 * t + 1] = gp * p2;
        atomicAdd(&counts[e1], 1u); atomicAdd(&counts[e2], 1u);
    }
}


DEVI void ln_row1024v(float (&y)[16], const float* g, const float* b, int lane) {
    float s = 0.f;
#pragma unroll
    for (int i = 0; i < 16; ++i) s += y[i];
    const float mu = wave_sum(s) * (1.0f / 1024.0f);
    float q = 0.f;
#pragma unroll
    for (int i = 0; i < 16; ++i) { const float d = y[i] - mu; q += d * d; }
    const float rstd = 1.0f / sqrtf(wave_sum(q) * (1.0f / 1024.0f) + LN_EPS);
#pragma unroll
    for (int i4 = 0; i4 < 4; ++i4) { const float4 g4 = *(const float4*)(g + 16 * lane + 4 * i4), b4 = *(const float4*)(b + 16 * lane + 4 * i4);
        y[4 * i4] = (y[4 * i4] - mu) * rstd * g4.x + b4.x; y[4 * i4 + 1] = (y[4 * i4 + 1] - mu) * rstd * g4.y + b4.y; y[4 * i4 + 2] = (y[4 * i4 + 2] - mu) * rstd * g4.z + b4.z; y[4 * i4 + 3] = (y[4 * i4 + 3] - mu) * rstd * g4.w + b4.w; }
}
DEVI void combine_row(float (&y)[16], const float* h, const unsigned short* Y0, const unsigned short* Y1, float g0, float g1, int lane) {
    const uint4 a0 = *(const uint4*)(Y0 + 16 * lane), a1 = *(const uint4*)(Y0 + 16 * lane + 8), b0 = *(const uint4*)(Y1 + 16 * lane), b1 = *(const uint4*)(Y1 + 16 * lane + 8);
    const unsigned aw[8] = {a0.x, a0.y, a0.z, a0.w, a1.x, a1.y, a1.z, a1.w}, bw[8] = {b0.x, b0.y, b0.z, b0.w, b1.x, b1.y, b1.z, b1.w};
#pragma unroll
    for (int i4 = 0; i4 < 4; ++i4) { const float4 hv = *(const float4*)(h + 16 * lane + 4 * i4);
        y[4 * i4]     = DN_ALPHA * hv.x + (g0 * __uint_as_float(aw[2 * i4] << 16) + g1 * __uint_as_float(bw[2 * i4] << 16));
        y[4 * i4 + 1] = DN_ALPHA * hv.y + (g0 * __uint_as_float(aw[2 * i4] & 0xFFFF0000u) + g1 * __uint_as_float(bw[2 * i4] & 0xFFFF0000u));
        y[4 * i4 + 2] = DN_ALPHA * hv.z + (g0 * __uint_as_float(aw[2 * i4 + 1] << 16) + g1 * __uint_as_float(bw[2 * i4 + 1] << 16));
        y[4 * i4 + 3] = DN_ALPHA * hv.w + (g0 * __uint_as_float(aw[2 * i4 + 1] & 0xFFFF0000u) + g1 * __uint_as_float(bw[2 * i4 + 1] & 0xFFFF0000u)); }
}
typedef float f32x4v __attribute__((ext_vector_type(4)));
DEVI void ln_route_block(int tb, int ntok, const float* Zsrc, float* Hdst, const float* g, const float* b, const float4* __restrict__ Wr, const float* bg, const float* be,
                         int* eid, float* gw, unsigned* counts, float* sm) {
    const int tid = otid(), lane = tid & 63, wave = tid >> 6;
    for (int i = 0; i < 8; ++i) { const int tl = wave * 8 + i;
        if (tl < ntok) { const size_t t = (size_t)(tb + tl); float y[16];
#pragma unroll
            for (int i4 = 0; i4 < 4; ++i4) { const float4 v = *(const float4*)(Zsrc + t * D + 16 * lane + 4 * i4); y[4 * i4] = v.x; y[4 * i4 + 1] = v.y; y[4 * i4 + 2] = v.z; y[4 * i4 + 3] = v.w; }
            ln_row1024v(y, g, b, lane);
#pragma unroll
            for (int i4 = 0; i4 < 4; ++i4) *(float4*)(Hdst + t * D + 16 * lane + 4 * i4) = make_float4(y[4 * i4], y[4 * i4 + 1], y[4 * i4 + 2], y[4 * i4 + 3]); } }
    asm volatile("s_waitcnt vmcnt(0)" ::: "memory");
    __syncthreads();
    const int grp = wave & 3, khalf = wave >> 2;
    if (grp * 16 < ntok) {
        const int t0 = tb + 16 * grp, row = lane & 15, kg = lane >> 4;
        f32x4v acc[3];
#pragma unroll
        for (int ct = 0; ct < 3; ++ct) acc[ct] = (f32x4v){0.f, 0.f, 0.f, 0.f};
        const float* arow = Hdst + (size_t)(t0 + row) * D + 4 * kg;
#pragma unroll 4
        for (int sstep = 32 * khalf; sstep < 32 * khalf + 32; ++sstep) {
            const float4 a4 = *(const float4*)(arow + 16 * sstep);
#pragma unroll
            for (int ct = 0; ct < 3; ++ct) { const float4 b4 = Wr[(sstep * 3 + ct) * 64 + lane];
                acc[ct] = __builtin_amdgcn_mfma_f32_16x16x4f32(a4.x, b4.x, acc[ct], 0, 0, 0); acc[ct] = __builtin_amdgcn_mfma_f32_16x16x4f32(a4.y, b4.y, acc[ct], 0, 0, 0);
                acc[ct] = __builtin_amdgcn_mfma_f32_16x16x4f32(a4.z, b4.z, acc[ct], 0, 0, 0); acc[ct] = __builtin_amdgcn_mfma_f32_16x16x4f32(a4.w, b4.w, acc[ct], 0, 0, 0); }
        }
        float* Lg = sm + (khalf * 4 + grp) * 16 * 48;
#pragma unroll
        for (int ct = 0; ct < 3; ++ct)
#pragma unroll
            for (int j = 0; j < 4; ++j) Lg[(4 * kg + j) * 48 + 16 * ct + row] = acc[ct][j];
    }
    __syncthreads();
    if (wave < 4 && wave * 16 < ntok) {
        const int t0 = tb + 16 * wave;
        if (lane < 16) {
            const int t = t0 + lane; const float* lgA = sm + wave * 16 * 48 + lane * 48; const float* lgB = lgA + 4 * 16 * 48;
            float lg[36];
#pragma unroll
            for (int j = 0; j < 36; ++j) lg[j] = lgA[j] + lgB[j];
            float gl[4]; int gsel = 0;
#pragma unroll
            for (int j = 0; j < 4; ++j) gl[j] = lg[j] + bg[j];
#pragma unroll
            for (int j = 1; j < 4; ++j) if (gl[j] > gl[gsel]) gsel = j;
            float den = 0.f;
#pragma unroll
            for (int j = 0; j < 4; ++j) den += expf(gl[j] - gl[gsel]);
            const float gp = 1.0f / den;
            float el[8];
#pragma unroll
            for (int j = 0; j < 8; ++j) { float v = lg[4 + j];
#pragma unroll
                for (int gg = 1; gg < 4; ++gg) v = (gg == gsel) ? lg[4 + gg * 8 + j] : v;
                el[j] = v + be[gsel * 8 + j]; }
            int i1 = 0;
#pragma unroll
            for (int j = 1; j < 8; ++j) if (el[j] > el[i1]) i1 = j;
            int i2 = (i1 == 0) ? 1 : 0;
#pragma unroll
            for (int j = 0; j < 8; ++j) if (j != i1 && el[j] > el[i2]) i2 = j;
            float e1v = el[0], e2v = el[0];
#pragma unroll
            for (int j = 0; j < 8; ++j) { e1v = (j == i1) ? el[j] : e1v; e2v = (j == i2) ? el[j] : e2v; }
            const float ex = expf(e2v - e1v);
            const float p1 = 1.0f / (1.0f + ex), p2 = ex / (1.0f + ex);
            const int e1 = gsel * 8 + i1, e2 = gsel * 8 + i2;
            eid[2 * t] = e1; eid[2 * t + 1] = e2; gw[2 * t] = gp * p1; gw[2 * t + 1] = gp * p2;
            atomicAdd(&counts[e1], 1u); atomicAdd(&counts[e2], 1u);
        }
    }
    __syncthreads();
}

using pg8::f32x4; using pg8::Unit; typedef unsigned short bf16_t;
DEVI float bf2f(unsigned short b) { return __uint_as_float(((unsigned)b) << 16); }
DEVI float bflo(unsigned w) { return __uint_as_float(w << 16); }
DEVI float bfhi(unsigned w) { return __uint_as_float(w & 0xFFFF0000u); }
DEVI unsigned cvt_pk_bf16(float lo, float hi) { unsigned r; asm volatile("v_cvt_pk_bf16_f32 %0, %1, %2" : "=v"(r) : "v"(lo), "v"(hi)); return r; }
DEVI uint2 pack4(const f32x4 v) { return make_uint2(cvt_pk_bf16(v[0], v[1]), cvt_pk_bf16(v[2], v[3])); }
DEVI float fsigm(float x) { return __builtin_amdgcn_rcpf(1.0f + __expf(-x)); }
DEVI unsigned pack4_fp8(const f32x4 v) { int w = __builtin_amdgcn_cvt_pk_fp8_f32(v[0], v[1], 0, false); w = __builtin_amdgcn_cvt_pk_fp8_f32(v[2], v[3], w, true); return (unsigned)w; }

DEVI int in0_srccol(int n) {
    if (n < 1024) { const int G = n >> 5, nn = (n >> 4) & 1, i = n & 15; return (nn ? OFF_AGATE : OFF_AVAL) + 16 * G + i; }
    if (n < 2048 || (n >= 2560 && n < 3072)) {
        const int base = n < 1536 ? OFF_Q : n < 2048 ? OFF_K : OFF_QI; const int loc = n & 511;
        const int G = loc >> 5, nn = (loc >> 4) & 1, i = loc & 15; return base + 64 * (G >> 1) + 32 * nn + 16 * (G & 1) + i; }
    if (n < 2560) return OFF_V + (n - 2048);
    if (n < 3136) { const int loc = n - 3072; const int G = loc >> 5, nn = (loc >> 4) & 1, i = loc & 15; return OFF_KI + 32 * nn + 16 * G + i; }
    if (n < 3144) return OFF_WI + (n - 3136);
    return -1;
}
struct EpiIn0 {
    static constexpr bool PERM = false, AFTER_DRAIN = false;
    bf16_t* GLU; bf16_t* KI; float* WI; const float* ropeC; const float* ropeS; unsigned char* KV8;
    DEVI void operator()(const f32x4 (&acc)[2][2][4][2], const Unit& u, int wr, int wc, int fr, int fq) const {
        const int pn = u.pn; const int rbase = u.pm * 256 + wr * 64 + fr;
        if (pn < 4) {
#pragma unroll
            for (int ai = 0; ai < 2; ++ai)
#pragma unroll
                for (int m = 0; m < 4; ++m) { const size_t row = rbase + ai * 128 + m * 16;
#pragma unroll
                    for (int bj = 0; bj < 2; ++bj) { const int G = 8 * pn + 4 * bj + wc; const f32x4 v = acc[ai][bj][m][0], g = acc[ai][bj][m][1]; f32x4 o;
#pragma unroll
                        for (int j = 0; j < 4; ++j) o[j] = v[j] * fsigm(g[j]);
                        *(uint2*)(GLU + row * 512 + 16 * G + 4 * fq) = pack4(o); } }
        } else if (pn == 8 || pn == 9) {
#pragma unroll
            for (int ai = 0; ai < 2; ++ai)
#pragma unroll
                for (int m = 0; m < 4; ++m) { const size_t row = rbase + ai * 128 + m * 16;
#pragma unroll
                    for (int bj = 0; bj < 2; ++bj)
#pragma unroll
                        for (int n = 0; n < 2; ++n) { const int col = 256 * (pn - 8) + 128 * bj + 32 * wc + 16 * n + 4 * fq;
                            *(unsigned*)(KV8 + row * 1024 + (size_t)(col >> 3) * 16 + 8 + (col & 7)) = pack4_fp8(acc[ai][bj][m][n]); } }
        } else if (pn == 12) {
            if (wc < 2) { const int d0 = 16 * wc + 4 * fq;
#pragma unroll
                for (int ai = 0; ai < 2; ++ai)
#pragma unroll
                    for (int m = 0; m < 4; ++m) { const size_t row = rbase + ai * 128 + m * 16;
                        const f32x4 c = *(const f32x4*)(ropeC + row * 32 + d0), s = *(const f32x4*)(ropeS + row * 32 + d0);
                        const f32x4 t1 = acc[ai][0][m][0], t2 = acc[ai][0][m][1];
                        *(uint2*)(KI + row * 64 + d0) = pack4(t1 * c - t2 * s); *(uint2*)(KI + row * 64 + 32 + d0) = pack4(t1 * s + t2 * c); }
            } else if (wc == 2 && fq < 2) {
#pragma unroll
                for (int ai = 0; ai < 2; ++ai)
#pragma unroll
                    for (int m = 0; m < 4; ++m) { const size_t row = rbase + ai * 128 + m * 16; *(f32x4*)(WI + row * 8 + 4 * fq) = acc[ai][0][m][0] * 0.35355339059327373f; }
            }
        } else {
            bf16_t* dst = GLU + (size_t)(pn < 6 ? 1 : pn < 8 ? 2 : 4) * LP * 512; const int pl = pn & 1; const int d0 = 16 * (wc & 1) + 4 * fq;
#pragma unroll
            for (int ai = 0; ai < 2; ++ai)
#pragma unroll
                for (int m = 0; m < 4; ++m) { const size_t row = rbase + ai * 128 + m * 16;
                    const f32x4 c = *(const f32x4*)(ropeC + row * 32 + d0), s = *(const f32x4*)(ropeS + row * 32 + d0);
#pragma unroll
                    for (int bj = 0; bj < 2; ++bj) { const int hh = 4 * pl + 2 * bj + (wc >> 1); const f32x4 t1 = acc[ai][bj][m][0], t2 = acc[ai][bj][m][1];
                        if (pn == 6 || pn == 7) { const int da = 64 * hh + d0, db = da + 32;
                            *(unsigned*)(KV8 + row * 1024 + (size_t)(da >> 3) * 16 + (da & 7)) = pack4_fp8(t1 * c - t2 * s); *(unsigned*)(KV8 + row * 1024 + (size_t)(db >> 3) * 16 + (db & 7)) = pack4_fp8(t1 * s + t2 * c);
                        } else { *(uint2*)(dst + row * 512 + 64 * hh + d0) = pack4(t1 * c - t2 * s); *(uint2*)(dst + row * 512 + 64 * hh + 32 + d0) = pack4(t1 * s + t2 * c); } } }
        }
    }
};
struct EpiRes0 {
    static constexpr bool PERM = false, AFTER_DRAIN = false;
    const float* x; const float* meta; float* Z;
    DEVI void operator()(const f32x4 (&acc)[2][2][4][2], const Unit& u, int wr, int wc, int fr, int fq) const {
        const int rbase = u.pm * 256 + wr * 64 + fr, cbase = u.pn * 256 + wc * 32 + 4 * fq;
#pragma unroll
        for (int ai = 0; ai < 2; ++ai)
#pragma unroll
            for (int m = 0; m < 4; ++m) { const int row = rbase + ai * 128 + m * 16;
                if (row < L) { const float* rs = row < NMETA ? meta + (size_t)row * D : x + (size_t)(row - NMETA) * D;
#pragma unroll
                    for (int bj = 0; bj < 2; ++bj)
#pragma unroll
                        for (int n = 0; n < 2; ++n) { const int col = cbase + 128 * bj + 16 * n; const f32x4 r4 = *(const f32x4*)(rs + col); *(f32x4*)(Z + (size_t)row * D + col) = r4 * DN_ALPHA + acc[ai][bj][m][n]; } } }
    }
};
struct EpiGateUp {
    static constexpr bool PERM = false, AFTER_DRAIN = false;
    bf16_t* Hm;
    DEVI void operator()(const f32x4 (&acc)[2][2][4][2], const Unit& u, int wr, int wc, int fr, int fq) const {
        const int pl = u.pn & 3; const int rbase = u.pm * 256 + wr * 64 + fr;
#pragma unroll
        for (int ai = 0; ai < 2; ++ai)
#pragma unroll
            for (int m = 0; m < 4; ++m) { const size_t row = rbase + ai * 128 + m * 16;
#pragma unroll
                for (int bj = 0; bj < 2; ++bj) { const int G = 8 * pl + 4 * bj + wc; const f32x4 g = acc[ai][bj][m][0], up = acc[ai][bj][m][1]; f32x4 o;
#pragma unroll
                    for (int j = 0; j < 4; ++j) o[j] = g[j] * fsigm(g[j]) * up[j];
                    *(uint2*)(Hm + row * 512 + 16 * G + 4 * fq) = pack4(o); } }
    }
};
struct EpiDown {
    static constexpr bool PERM = false, AFTER_DRAIN = false;
    bf16_t* Y;
    DEVI void operator()(const f32x4 (&acc)[2][2][4][2], const Unit& u, int wr, int wc, int fr, int fq) const {
        const int pl = u.pn & 3; const int rbase = u.pm * 256 + wr * 64 + fr, cbase = pl * 256 + wc * 32 + 4 * fq;
#pragma unroll
        for (int ai = 0; ai < 2; ++ai)
#pragma unroll
            for (int m = 0; m < 4; ++m) { const size_t row = rbase + ai * 128 + m * 16;
#pragma unroll
                for (int bj = 0; bj < 2; ++bj)
#pragma unroll
                    for (int n = 0; n < 2; ++n) *(uint2*)(Y + row * 1024 + cbase + 128 * bj + 16 * n) = pack4(acc[ai][bj][m][n]); }
    }
};
struct MoeOrder {
    const int* mt; int nunits, G, c;
    DEVI void init(const int* t, int G_, int c_) { mt = t; nunits = t[0] * 4; G = G_; c = c_; }
    DEVI bool next(int i, Unit& u) const { const int li = i * G + c; if (li >= nunits) return false; const int ti = li >> 2; u.pm = ti; u.pn = mt[4 + ti] * 4 + (li & 3); return true; }
    DEVI void a_ready(const Unit&) const {}
    DEVI void done(const Unit&) const {}
};

template <class F> DEVI void tr_tile(bf16_t* dst, int K, int n0, int k0, F src, float* sm) {
    const int tid = otid();
    __syncthreads();
    { const int nn = tid & 63, kb = tid >> 6;
#pragma unroll
      for (int p = 0; p < 8; ++p) { const int kk = kb + 8 * p; sm[kk * 65 + nn] = src(n0 + nn, k0 + kk); } }
    __syncthreads();
    { const int nn = tid >> 3, kq = (tid & 7) * 8; float v[8];
#pragma unroll
      for (int j = 0; j < 8; ++j) v[j] = sm[(kq + j) * 65 + nn];
      uint4 w; w.x = cvt_pk_bf16(v[0], v[1]); w.y = cvt_pk_bf16(v[2], v[3]); w.z = cvt_pk_bf16(v[4], v[5]); w.w = cvt_pk_bf16(v[6], v[7]);
      *(uint4*)(dst + (size_t)(n0 + nn) * K + k0 + kq) = w; }
}

struct TrJob { bf16_t* dst; const float* s0; const float* s1; int K, n0, k0, ld, mode; };
DEVI float tr_src(const TrJob& J, int n, int k) {
    if (J.mode == 0) return __builtin_nontemporal_load(J.s0 + (size_t)k * J.ld + n);
    if (J.mode == 1) { const int sc = in0_srccol(n); return sc < 0 ? 0.f : __builtin_nontemporal_load(J.s0 + (size_t)k * IN_AB + sc); }
    const int ch = (n >> 5) * 16 + (n & 15); return ((n >> 4) & 1) ? __builtin_nontemporal_load(J.s1 + (size_t)k * DE + ch) : __builtin_nontemporal_load(J.s0 + (size_t)k * DE + ch);
}
DEVI void tr_fetch(const TrJob& J, float (&v)[8]) {
    const int tid = otid(), nn = tid & 63, kb = tid >> 6;
#pragma unroll
    for (int p = 0; p < 8; ++p) v[p] = tr_src(J, J.n0 + nn, J.k0 + kb + 8 * p);
}
DEVI void tr_commit(const TrJob& J, const float (&v)[8], float* sm) {
    const int tid = otid();
    __syncthreads();
    { const int nn = tid & 63, kb = tid >> 6;
#pragma unroll
      for (int p = 0; p < 8; ++p) sm[(kb + 8 * p) * 65 + nn] = v[p]; }
    __syncthreads();
    { const int nn = tid >> 3, kq = (tid & 7) * 8; float x[8];
#pragma unroll
      for (int j = 0; j < 8; ++j) x[j] = sm[(kq + j) * 65 + nn];
      uint4 w; w.x = cvt_pk_bf16(x[0], x[1]); w.y = cvt_pk_bf16(x[2], x[3]); w.z = cvt_pk_bf16(x[4], x[5]); w.w = cvt_pk_bf16(x[6], x[7]);
      *(uint4*)(J.dst + (size_t)(J.n0 + nn) * J.K + J.k0 + kq) = w; }
}
template <class Dec> DEVI void tr_run(int njobs, Dec dec, float* sm) {
    int j = blockIdx.x; const int G = gridDim.x;
    TrJob Ja{}, Jb{}; float va[8], vb[8];
    if (j < njobs) { Ja = dec(j); tr_fetch(Ja, va); }
    while (j < njobs) {
        int jn = j + G; if (jn < njobs) { Jb = dec(jn); tr_fetch(Jb, vb); }
        tr_commit(Ja, va, sm);
        j = jn; if (j >= njobs) break;
        jn = j + G; if (jn < njobs) { Ja = dec(jn); tr_fetch(Ja, va); }
        tr_commit(Jb, vb, sm);
        j = jn;
    }
    __syncthreads();
}

DEVI void moe_dispatch_mfma(const float* H, const int* eid, const unsigned* counts, unsigned* cursor, int* slot, int* mtiles, bf16_t* Xperm, int* sm_i, int gwave, int nwaves, int lane, int p_begin) {
    if (otid() == 0) { int o = 0; for (int e = 0; e < NE; ++e) { sm_i[e] = o; o += (((int)counts[e] + 255) >> 8) << 8; } }
    __syncthreads();
    for (int pb = p_begin + gwave * 16; pb < NPAIR; pb += nwaves * 16) {
        int sl = 0;
        if (lane < 16 && pb + lane < NPAIR) { const int e = eid[pb + lane]; sl = sm_i[e] + (int)atomicAdd(&cursor[e], 1u); slot[pb + lane] = sl; }
#pragma unroll 4
        for (int k = 0; k < 16; ++k) { const int p = pb + k; if (p >= NPAIR) break;
            const int s = __shfl(sl, k);
            const float4* src = (const float4*)(H + (size_t)(p >> 1) * D); uint2* dst = (uint2*)(Xperm + (size_t)s * D);
#pragma unroll
            for (int r = 0; r < 4; ++r) { const float4 v = src[lane + 64 * r]; dst[lane + 64 * r] = make_uint2(cvt_pk_bf16(v.x, v.y), cvt_pk_bf16(v.z, v.w)); } }
    }
    if (blockIdx.x == 0 && otid() == 0) { int n = 0; for (int e = 0; e < NE; ++e) { const int nt = ((int)counts[e] + 255) >> 8; for (int i = 0; i < nt; ++i) mtiles[4 + n++] = e; } mtiles[0] = n; }
    __syncthreads();
}

DEVI float gelu_fast(float x) { return x * fsigm(1.5957691216057308f * (x + 0.044715f * x * x * x)); }
struct EpiIn1 {
    static constexpr bool PERM = false, AFTER_DRAIN = false;
    bf16_t* G;
    DEVI void operator()(const f32x4 (&acc)[2][2][4][2], const Unit& u, int wr, int wc, int fr, int fq) const {
        const int pn = u.pn; const bool is_gate = pn < 5; const int rbase = u.pm * 256 + wr * 64 + fr;
        bf16_t* dst = G + (is_gate ? (size_t)0 : (size_t)LP * RNN_W) + (size_t)((is_gate ? pn : pn - 5) * 256 + wc * 32 + 4 * fq);
#pragma unroll
        for (int ai = 0; ai < 2; ++ai)
#pragma unroll
            for (int m = 0; m < 4; ++m) { const size_t row = rbase + ai * 128 + m * 16;
#pragma unroll
                for (int bj = 0; bj < 2; ++bj)
#pragma unroll
                    for (int n = 0; n < 2; ++n) { f32x4 v = acc[ai][bj][m][n];
                        if (is_gate) {
#pragma unroll
                            for (int j = 0; j < 4; ++j) v[j] = gelu_fast(v[j]); }
                        *(uint2*)(dst + row * RNN_W + 128 * bj + 16 * n) = pack4(v); } }
    }
};
struct EpiRes1 {
    static constexpr bool PERM = false, AFTER_DRAIN = false;
    const float* R; float* Z;
    DEVI void operator()(const f32x4 (&acc)[2][2][4][2], const Unit& u, int wr, int wc, int fr, int fq) const {
        const int rbase = u.pm * 256 + wr * 64 + fr, cbase = u.pn * 256 + wc * 32 + 4 * fq;
#pragma unroll
        for (int ai = 0; ai < 2; ++ai)
#pragma unroll
            for (int m = 0; m < 4; ++m) { const size_t row = rbase + ai * 128 + m * 16;
#pragma unroll
                for (int bj = 0; bj < 2; ++bj)
#pragma unroll
                    for (int n = 0; n < 2; ++n) { const int col = cbase + 128 * bj + 16 * n; const f32x4 r4 = *(const f32x4*)(R + row * D + col); *(f32x4*)(Z + row * D + col) = r4 * DN_ALPHA + acc[ai][bj][m][n]; } }
    }
};

typedef short bf16x8_t __attribute__((ext_vector_type(8)));
struct RgIn { uint4 x[2][4]; };
DEVI void rglru_fetch(int c, int ch0, const bf16_t* __restrict__ XR, int tid, RgIn& R) {
    const int c8 = tid & 15, tr = tid >> 4;
#pragma unroll
    for (int half = 0; half < 2; ++half) { const int t = c * 64 + tr + 32 * half;
#pragma unroll
        for (int j = 0; j < 4; ++j) { const int tt = t - 3 + j; R.x[half][j] = tt >= 0 ? *(const uint4*)(XR + (size_t)tt * RNN_W + ch0 + 8 * c8) : make_uint4(0u, 0u, 0u, 0u); } }
}
template <bool FINAL>
DEVI void rglru_unit(int c, int nb, const RgIn& R, const bf16x8_t (&fa)[4], const bf16x8_t (&fx)[4], float bav, float bxv, float sp,
                     const bf16_t* __restrict__ GATEg, float* __restrict__ Aend, float* __restrict__ Hend, const float* __restrict__ CIN, bf16_t* __restrict__ YY,
                     unsigned char* lds, int tid) {
    const int lane = tid & 63, w = tid >> 6, col = lane & 15, quad = lane >> 4;
    bf16_t* xcb = (bf16_t*)lds;
    float* xcf = (float*)(lds + 64 * 136 * 2);
    const float* cwl = (const float*)(lds + 64 * 136 * 2 + 64 * 132 * 4);
    const int t0 = c * 64, ch0 = nb * RNN_BW, ch = ch0 + 16 * w + col;
    const float cinv = FINAL ? CIN[(size_t)ch * CP + c] : 0.f;
    const int c8 = tid & 15, tr = tid >> 4;
    uint4 g[2];
    if (FINAL) {
#pragma unroll
        for (int half = 0; half < 2; ++half) { const int t = t0 + tr + 32 * half; g[half] = (t < L) ? *(const uint4*)(GATEg + (size_t)t * RNN_W + ch0 + 8 * c8) : make_uint4(0u, 0u, 0u, 0u); } }
    __syncthreads();
    {
        float bv[8];
        { const float4 b0 = *(const float4*)(cwl + 512 + 8 * c8), b1 = *(const float4*)(cwl + 512 + 8 * c8 + 4); bv[0] = b0.x; bv[1] = b0.y; bv[2] = b0.z; bv[3] = b0.w; bv[4] = b1.x; bv[5] = b1.y; bv[6] = b1.z; bv[7] = b1.w; }
#pragma unroll
        for (int half = 0; half < 2; ++half) { const int tl = tr + 32 * half;
            float v[8];
#pragma unroll
            for (int i = 0; i < 8; ++i) v[i] = bv[i];
#pragma unroll
            for (int j = 0; j < 4; ++j) { const uint4 xv = R.x[half][j];
                const float4 w0 = *(const float4*)(cwl + j * 128 + 8 * c8), w1 = *(const float4*)(cwl + j * 128 + 8 * c8 + 4);
                v[0] += w0.x * bflo(xv.x); v[1] += w0.y * bfhi(xv.x); v[2] += w0.z * bflo(xv.y); v[3] += w0.w * bfhi(xv.y);
                v[4] += w1.x * bflo(xv.z); v[5] += w1.y * bfhi(xv.z); v[6] += w1.z * bflo(xv.w); v[7] += w1.w * bfhi(xv.w); }
            *(float4*)(xcf + tl * 132 + 8 * c8) = make_float4(v[0], v[1], v[2], v[3]); *(float4*)(xcf + tl * 132 + 8 * c8 + 4) = make_float4(v[4], v[5], v[6], v[7]);
            uint4 pk; pk.x = cvt_pk_bf16(v[0], v[1]); pk.y = cvt_pk_bf16(v[2], v[3]); pk.z = cvt_pk_bf16(v[4], v[5]); pk.w = cvt_pk_bf16(v[6], v[7]);
            *(uint4*)(xcb + (16 * ((tl >> 2) & 3) + 4 * (tl >> 4) + (tl & 3)) * 136 + 8 * c8) = pk; }
    }
    __syncthreads();
    f32x4 ca[4], cx[4];
#pragma unroll
    for (int mt = 0; mt < 4; ++mt) { ca[mt] = (f32x4){0.f, 0.f, 0.f, 0.f}; cx[mt] = (f32x4){0.f, 0.f, 0.f, 0.f};
#pragma unroll
        for (int ks = 0; ks < 4; ++ks) { const bf16x8_t af = *(const bf16x8_t*)(xcb + (16 * mt + col) * 136 + 32 * ks + 8 * quad);
            ca[mt] = __builtin_amdgcn_mfma_f32_16x16x32_bf16(af, fa[ks], ca[mt], 0, 0, 0);
            cx[mt] = __builtin_amdgcn_mfma_f32_16x16x32_bf16(af, fx[ks], cx[mt], 0, 0, 0); } }
    float av[4][4], uv[4][4]; float A = 1.f, H = 0.f;
#pragma unroll
    for (int mt = 0; mt < 4; ++mt) {
#pragma unroll
        for (int j = 0; j < 4; ++j) { const int tl = 16 * quad + 4 * mt + j;
            const float xcv = xcf[tl * 132 + 16 * w + col];
            const float r = fsigm(ca[mt][j] + bav), ig = fsigm(cx[mt][j] + bxv);
            const float la = -8.0f * r * sp;
            const float x2 = 2.0f * la;
            float em1 = x2 * (1.0f + x2 * (0.5f + x2 * (0.16666667f + x2 * (0.041666668f + x2 * (0.0083333338f + x2 * (0.0013888889f + x2 * 0.0001984127f))))));
            if (x2 < -0.5f) em1 = expm1f(x2);
            float a_ = __expf(la), u_ = __builtin_amdgcn_sqrtf(-em1) * (ig * xcv);
            if (t0 + tl >= L) { a_ = 1.f; u_ = 0.f; }
            av[mt][j] = a_; uv[mt][j] = u_; H = a_ * H + u_; A *= a_; } }
    float carry = cinv, prod = 1.f, hin = 0.f;
#pragma unroll
    for (int q = 0; q < 4; ++q) {
        if (quad == q) hin = carry;
        const float nw = A * carry + H, np = A * prod;
        carry = __shfl(nw, q * 16 + col); prod = __shfl(np, q * 16 + col); }
    if (!FINAL) {
        if (quad == 0) { Aend[(size_t)ch * CP + c] = prod; Hend[(size_t)ch * CP + c] = carry; }
    } else {
        float h = hin;
#pragma unroll
        for (int mt = 0; mt < 4; ++mt)
#pragma unroll
            for (int j = 0; j < 4; ++j) { h = av[mt][j] * h + uv[mt][j]; xcf[(16 * quad + 4 * mt + j) * 132 + 16 * w + col] = h; }
        __syncthreads();
#pragma unroll
        for (int half = 0; half < 2; ++half) { const int tl = tr + 32 * half, t = t0 + tl;
            if (t >= NMETA && t < L) {
                const float4 h0 = *(const float4*)(xcf + tl * 132 + 8 * c8), h1 = *(const float4*)(xcf + tl * 132 + 8 * c8 + 4);
                const uint4 gg = g[half];
                uint4 pk; pk.x = cvt_pk_bf16(bflo(gg.x) * h0.x, bfhi(gg.x) * h0.y); pk.y = cvt_pk_bf16(bflo(gg.y) * h0.z, bfhi(gg.y) * h0.w);
                pk.z = cvt_pk_bf16(bflo(gg.z) * h1.x, bfhi(gg.z) * h1.y); pk.w = cvt_pk_bf16(bflo(gg.w) * h1.z, bfhi(gg.w) * h1.w);
                *(uint4*)(YY + (size_t)t * RNN_W + ch0 + 8 * c8) = pk; } }
    }
}
template <bool FINAL>
DEVI void rglru_phase(const bf16_t* __restrict__ XR, const bf16_t* __restrict__ GATEg, const bf16_t* __restrict__ Wta, const bf16_t* __restrict__ Wtx,
                      const float* __restrict__ cw, const float* __restrict__ cb, const float* __restrict__ ba, const float* __restrict__ bx, const float* __restrict__ lam,
                      float* __restrict__ Aend, float* __restrict__ Hend, const float* __restrict__ CIN, bf16_t* __restrict__ YY, unsigned char* lds) {
    const int tid = otid(), lane = tid & 63, w = tid >> 6, col = lane & 15, quad = lane >> 4;
    const int G = gridDim.x, nb = blockIdx.x % RNN_NB, rank = blockIdx.x / RNN_NB, nblk = (G - nb + RNN_NB - 1) / RNN_NB;
    const int ch0 = nb * RNN_BW, ch = ch0 + 16 * w + col;
    float* cwl = (float*)(lds + 64 * 136 * 2 + 64 * 132 * 4);
    __syncthreads();
    for (int i = tid; i < 640; i += NTHREADS) cwl[i] = i < 512 ? cw[(i >> 7) * RNN_W + ch0 + (i & 127)] : cb[ch0 + (i - 512)];
    bf16x8_t fa[4], fx[4];
    { const size_t wrow = ((size_t)nb * 128 + 16 * w + col) * 128 + 8 * quad;
#pragma unroll
      for (int ks = 0; ks < 4; ++ks) { fa[ks] = *(const bf16x8_t*)(Wta + wrow + 32 * ks); fx[ks] = *(const bf16x8_t*)(Wtx + wrow + 32 * ks); } }
    const float bav = ba[ch], bxv = bx[ch], sp = log1pf(expf(-lam[ch]));
    RgIn Ra, Rb;
    int c = rank;
    if (c < NCHUNK) rglru_fetch(c, ch0, XR, tid, Ra);
    while (c < NCHUNK) {
        int cn = c + nblk;
        if (cn < NCHUNK) rglru_fetch(cn, ch0, XR, tid, Rb);
        rglru_unit<FINAL>(c, nb, Ra, fa, fx, bav, bxv, sp, GATEg, Aend, Hend, CIN, YY, lds, tid);
        c = cn; if (c >= NCHUNK) break;
        cn = c + nblk;
        if (cn < NCHUNK) rglru_fetch(cn, ch0, XR, tid, Ra);
        rglru_unit<FINAL>(c, nb, Rb, fa, fx, bav, bxv, sp, GATEg, Aend, Hend, CIN, YY, lds, tid);
        c = cn;
    }
    __syncthreads();
}

constexpr int SW = 544;
constexpr int CB = 512;
constexpr int NTILE = L / 16;
typedef float f32x16 __attribute__((ext_vector_type(16)));
typedef float f32x2v __attribute__((ext_vector_type(2)));
constexpr int HROW = 2112;
constexpr int IL_HIST = 0, IL_CKEY = 0, IL_CIDX = 16 * CB * 4, IL_HIST2 = 2 * 16 * CB * 4, IL_ROWS = IL_HIST2 + 16 * 256 * 4, IL_WI = 16 * HROW * 4, IL_QST = IL_WI + 512, IL_QST2 = IL_QST + 256, IL_CCNT = IL_QST2 + 256, IL_FLAG = IL_CCNT + 64;
static_assert(IL_ROWS + 16 * SW * 4 <= IL_WI && IL_FLAG + 64 <= LDS_BYTES - 16, "indexer LDS");

DEVI float relu_i(float x) { const int v = __float_as_int(x); return __int_as_float(v > 0 ? v : 0); }
DEVI int hpos(unsigned w) { return (int)(w + (w >> 5)); }
template <int PASS, bool L0>
DEVI void idx_sweep(int q0, int nkb, int wave, int lane, const bf16x8_t (&Af)[4][4], const bf16_t* __restrict__ KI, unsigned char* lds, unsigned* __restrict__ SELM) {
    const int l31 = lane & 31, h2 = lane >> 5;
    unsigned* hist = (unsigned*)(lds + IL_HIST);
    const float* wiL = (const float*)(lds + IL_WI);
    const uint4* qst = (const uint4*)(lds + IL_QST);
    const uint4* qst2 = (const uint4*)(lds + IL_QST2);
    unsigned* ckey = (unsigned*)(lds + IL_CKEY); unsigned* cidx = (unsigned*)(lds + IL_CIDX); unsigned* ccnt = (unsigned*)(lds + IL_CCNT); unsigned* rows = (unsigned*)(lds + IL_ROWS);
    const bf16_t* kp = KI + (size_t)l31 * 64 + 8 * h2;
    bf16x8_t Bn[4];
    if (wave < nkb) {
#pragma unroll
        for (int ks = 0; ks < 4; ++ks) Bn[ks] = *(const bf16x8_t*)(kp + (size_t)wave * 2048 + 16 * ks); }
    for (int kb = wave; kb < nkb; kb += 8) {
        const int s = kb * 32 + l31;
        bf16x8_t Bf[4];
#pragma unroll
        for (int ks = 0; ks < 4; ++ks) Bf[ks] = Bn[ks];
        if (kb + 8 < nkb) {
#pragma unroll
            for (int ks = 0; ks < 4; ++ks) Bn[ks] = *(const bf16x8_t*)(kp + (size_t)(kb + 8) * 2048 + 16 * ks); }
        f32x16 acc[4];
#pragma unroll
        for (int rb = 0; rb < 4; ++rb) {
#pragma unroll
            for (int i = 0; i < 16; ++i) acc[rb][i] = 0.f; }
#pragma unroll
        for (int ks = 0; ks < 4; ++ks)
#pragma unroll
            for (int rb = 0; rb < 4; ++rb) acc[rb] = __builtin_amdgcn_mfma_f32_32x32x16_bf16(Af[rb][ks], Bf[ks], acc[rb], 0, 0, 0);
        const bool edge = kb * 32 + 31 > q0;
#pragma unroll
        for (int rb = 0; rb < 4; ++rb) {
            const int qa = 4 * rb + 2 * h2;
            float4 w[2][2]; uint4 st[2];
#pragma unroll
            for (int e = 0; e < 2; ++e) { w[e][0] = *(const float4*)(wiL + (qa + e) * 8); w[e][1] = *(const float4*)(wiL + (qa + e) * 8 + 4);
                if (PASS == 2) st[e] = qst2[qa + e]; else if (!L0) st[e] = qst[qa + e]; }
#pragma unroll
            for (int e = 0; e < 2; ++e) {
                const int qs = qa + e;
                f32x2v s2 = (f32x2v){relu_i(acc[rb][8 * e + 0]), relu_i(acc[rb][8 * e + 1])} * (f32x2v){w[e][0].x, w[e][0].y};
                s2 = (f32x2v){relu_i(acc[rb][8 * e + 2]), relu_i(acc[rb][8 * e + 3])} * (f32x2v){w[e][0].z, w[e][0].w} + s2;
                s2 = (f32x2v){relu_i(acc[rb][8 * e + 4]), relu_i(acc[rb][8 * e + 5])} * (f32x2v){w[e][1].x, w[e][1].y} + s2;
                s2 = (f32x2v){relu_i(acc[rb][8 * e + 6]), relu_i(acc[rb][8 * e + 7])} * (f32x2v){w[e][1].z, w[e][1].w} + s2;
                const float sc = s2[0] + s2[1];
                const bool valid = !edge || s <= q0 + qs;
                const unsigned key = f2key(sc);
                if (PASS == 1) {
                    if (L0) { if (valid) { const unsigned bin = key >> 20; atomicAdd(&hist[qs * HROW + hpos(bin >> 1)], (bin & 1u) ? 0x10000u : 1u); } }
                    else if (valid && (key & st[e].x) == st[e].y) { const unsigned bin = (key >> st[e].z) & st[e].w; atomicAdd(&hist[qs * HROW + hpos(bin >> 1)], (bin & 1u) ? 0x10000u : 1u); }
                } else {
                    const bool all = st[e].z == 0xFFFFFFFFu;
                    const bool sel = valid && (all || key >= st[e].y);
                    const bool cnd = valid && !all && key >= st[e].x && key < st[e].y;
                    const unsigned long long bal = __ballot(sel);
                    if (l31 == 0) rows[qs * SW + kb] = h2 ? (unsigned)(bal >> 32) : (unsigned)bal;
                    if (cnd) { const unsigned n = atomicAdd(&ccnt[qs], 1u); if (n < (unsigned)CB) { ckey[qs * CB + n] = key; cidx[qs * CB + n] = (unsigned)s; } }
                }
            }
        }
    }
}

DEVI void indexer_tile(int q0, const bf16_t* __restrict__ QI, const bf16_t* __restrict__ KI, const float* __restrict__ WI, unsigned* __restrict__ SELM, unsigned* __restrict__ SELM2, unsigned char* lds) {
    const int tid = otid(), lane = tid & 63, wave = tid >> 6;
    unsigned* hist = (unsigned*)(lds + IL_HIST);
    float* wiL = (float*)(lds + IL_WI);
    uint4* qst = (uint4*)(lds + IL_QST); uint4* qst2 = (uint4*)(lds + IL_QST2);
    unsigned* ckey = (unsigned*)(lds + IL_CKEY); unsigned* cidx = (unsigned*)(lds + IL_CIDX); unsigned* hist2 = (unsigned*)(lds + IL_HIST2); unsigned* ccnt = (unsigned*)(lds + IL_CCNT);
    volatile unsigned* flag = (volatile unsigned*)(lds + IL_FLAG);
    const int nkb = (q0 + 16 + 31) >> 5;
    bf16x8_t Af[4][4];
    { const int rho = lane & 31, hq = lane >> 5; const int qq = 2 * ((rho >> 2) & 1) + (rho >> 4), head = 4 * ((rho >> 3) & 1) + (rho & 3);
#pragma unroll
      for (int rb = 0; rb < 4; ++rb)
#pragma unroll
          for (int ks = 0; ks < 4; ++ks) Af[rb][ks] = *(const bf16x8_t*)(QI + (size_t)(q0 + 4 * rb + qq) * 512 + head * 64 + 16 * ks + 8 * hq); }
    __syncthreads();
    if (tid < 128) wiL[tid] = WI[(size_t)q0 * 8 + tid] * 0.125f;
    if (tid < 16) { qst[tid] = make_uint4(0u, 0u, 20u, 4095u); qst2[tid] = make_uint4(0u, 0u, (unsigned)TOPK, 0u); ccnt[tid] = 0u; }
    for (int level = 0; level < 3; ++level) {
        for (int i = tid; i < 16 * HROW / 4; i += NTHREADS) ((uint4*)hist)[i] = make_uint4(0u, 0u, 0u, 0u);
        if (tid == 0) flag[0] = 0u;
        __syncthreads();
        if (level == 0) idx_sweep<1, true>(q0, nkb, wave, lane, Af, KI, lds, SELM); else idx_sweep<1, false>(q0, nkb, wave, lane, Af, KI, lds, SELM);
        __syncthreads();
#pragma unroll 1
        for (int qi = 0; qi < 2; ++qi) {
            const int qs = 2 * wave + qi;
            const uint4 st = qst[qs]; const uint4 b = qst2[qs];
            if (st.x == 0xFFFFFFFFu && st.y == 0u && st.w == 0u) continue;
            unsigned wv[32]; unsigned loc = 0u;
#pragma unroll
            for (int i = 0; i < 32; ++i) { wv[i] = hist[qs * HROW + 33 * lane + i]; loc += (wv[i] & 0xFFFFu) + (wv[i] >> 16); }
            unsigned suf = loc;
#pragma unroll
            for (int off = 1; off < 64; off <<= 1) { const unsigned o = __shfl_down(suf, off); if (lane + off < 64) suf += o; }
            const unsigned total = __shfl(suf, 0), above = suf - loc, need = b.z;
            if (level == 0 && total <= need) { if (lane == 0) { qst[qs] = make_uint4(0xFFFFFFFFu, 0u, 0u, 0u); qst2[qs] = make_uint4(0u, 0u, 0xFFFFFFFFu, 0u); } continue; }
            const bool mine = above < need && need <= above + loc;
            unsigned cum = above, c = 0u; int d = 0; bool found = false;
#pragma unroll
            for (int i = 31; i >= 0; --i) {
                const unsigned chi = wv[i] >> 16, clo = wv[i] & 0xFFFFu;
                if (!found && cum + chi >= need) { found = true; d = 64 * lane + 2 * i + 1; c = chi; } if (!found) cum += chi;
                if (!found && cum + clo >= need) { found = true; d = 64 * lane + 2 * i; c = clo; } if (!found) cum += clo; }
            if (mine) {
                const unsigned pval = st.y | ((unsigned)d << st.z), pmask = st.x | (st.w << st.z);
                const unsigned nneed = need - cum;
                const unsigned long long hi64 = (unsigned long long)pval + (1ull << st.z);
                const unsigned hi = hi64 > 0xFFFFFFFFull ? 0xFFFFFFFFu : (unsigned)hi64;
                if (c <= (unsigned)CB || level == 2) { qst[qs] = make_uint4(0xFFFFFFFFu, 0u, 0u, 0u); qst2[qs] = make_uint4(pval, hi, nneed, st.z); }
                else { const unsigned nsh = (level == 0) ? 8u : 0u, ndm = (level == 0) ? 4095u : 255u; qst[qs] = make_uint4(pmask, pval, nsh, ndm); qst2[qs] = make_uint4(pval, hi, nneed, st.z); flag[0] = 1u; }
            }
        }
        __syncthreads();
        if (flag[0] == 0u) break;
        __syncthreads();
    }
    __syncthreads();
    idx_sweep<2, false>(q0, nkb, wave, lane, Af, KI, lds, SELM);
    asm volatile("s_waitcnt vmcnt(0)" ::: "memory");
    __syncthreads();
    unsigned* rows = (unsigned*)(lds + IL_ROWS);
#pragma unroll 1
    for (int qi = 0; qi < 2; ++qi) {
        const int qs = 2 * wave + qi;
        const uint4 b = qst2[qs];
        unsigned* row = rows + qs * SW;
        if (b.z != 0xFFFFFFFFu) {
            const unsigned need = b.z; const unsigned cn = ccnt[qs]; const int n = (int)(cn < (unsigned)CB ? cn : (unsigned)CB);
            const unsigned rem = b.w;
            const unsigned sh8 = rem > 8u ? rem - 8u : 0u; const unsigned m8 = rem >= 8u ? 255u : ((1u << rem) - 1u);
#pragma unroll
            for (int i = 0; i < 4; ++i) hist2[qs * 256 + 4 * lane + i] = 0u;
            asm volatile("s_waitcnt lgkmcnt(0)" ::: "memory");
            for (int i = lane; i < n; i += 64) atomicAdd(&hist2[qs * 256 + ((ckey[qs * CB + i] >> sh8) & m8)], 1u);
            asm volatile("s_waitcnt lgkmcnt(0)" ::: "memory");
            unsigned c4[4]; unsigned loc = 0u;
#pragma unroll
            for (int i = 0; i < 4; ++i) { c4[i] = hist2[qs * 256 + 4 * lane + i]; loc += c4[i]; }
            unsigned suf = loc;
#pragma unroll
            for (int off = 1; off < 64; off <<= 1) { const unsigned o = __shfl_down(suf, off); if (lane + off < 64) suf += o; }
            const unsigned above = suf - loc;
            const bool mine = above < need && need <= above + loc;
            unsigned b2 = 0u, need2 = 0u;
            if (mine) { unsigned cum = above; int i = 3; for (; i > 0; --i) { if (cum + c4[i] >= need) break; cum += c4[i]; } b2 = 4u * lane + i; need2 = need - cum; }
            const unsigned long long mb = __ballot(mine);
            if (mb == 0ull) {
                for (int i = lane; i < n; i += 64) if ((unsigned)i < need) { const unsigned ii = cidx[qs * CB + i]; atomicOr(&row[ii >> 5], 1u << (ii & 31u)); }
            } else {
                const int src = __ffsll((long long)mb) - 1;
                b2 = __shfl(b2, src); need2 = __shfl(need2, src);
                for (int i0 = 0; i0 < n; i0 += 64) {
                    const int i = i0 + lane; const bool act = i < n;
                    const unsigned ki = act ? ckey[qs * CB + i] : 0u, ii = act ? cidx[qs * CB + i] : 0u; const unsigned d8 = (ki >> sh8) & m8;
                    if (act && d8 > b2) atomicOr(&row[ii >> 5], 1u << (ii & 31u));
                    unsigned long long tie = __ballot(act && d8 == b2);
                    while (tie) {
                        const int ml = __ffsll((long long)tie) - 1; tie &= tie - 1ull;
                        const unsigned km = __shfl(ki, ml), im = __shfl(ii, ml);
                        unsigned rank = 0u;
                        for (int j0 = 0; j0 < n; j0 += 64) { const int j = j0 + lane; bool beats = false;
                            if (j < n) { const unsigned kj = ckey[qs * CB + j], ij = cidx[qs * CB + j]; beats = ((kj >> sh8) & m8) == b2 && (kj > km || (kj == km && ij < im)); }
                            rank += (unsigned)__popcll(__ballot(beats)); }
                        if (rank < need2 && lane == ml) atomicOr(&row[im >> 5], 1u << (im & 31u));
                    }
                }
            }
        }
    }
    asm volatile("s_waitcnt lgkmcnt(0)" ::: "memory");
    __syncthreads();
    { const int nq4 = (nkb + 3) >> 2;
      for (int i = tid; i < 16 * nq4; i += NTHREADS) { const int r = i / nq4, c4i = i - r * nq4;
          *(uint4*)(SELM + (size_t)(q0 + r) * SW + 4 * c4i) = *(const uint4*)(rows + r * SW + 4 * c4i); } }
}

constexpr int AW_BYTES = 512;
typedef short s16x2 __attribute__((ext_vector_type(2)));
DEVI float dot2bf(unsigned a, unsigned b, float c) { return __builtin_amdgcn_fdot2_f32_bf16(__builtin_bit_cast(s16x2, a), __builtin_bit_cast(s16x2, b), c, false); }
#define LDS_FENCE() asm volatile("s_waitcnt lgkmcnt(0)" ::: "memory")

struct AttnQ { float m, l, o[8]; };

DEVI void attn_issue(int b0, int n, const unsigned short* lst, const unsigned char* __restrict__ KV8, int lane, uint4 (&kv)[8]) {
    const int last = n - 1;
#pragma unroll
    for (int kk = 0; kk < 8; ++kk) { const int ii = b0 + kk; const int key = lst[ii < last ? ii : last]; kv[kk] = *(const uint4*)(KV8 + (size_t)key * 1024 + lane * 16); }
}
DEVI void attn_compute(AttnQ& S, int b0, int n, const float (&q)[8], const uint4 (&kv)[8]) {
    float sc[8]; float mx = S.m;
#pragma unroll
    for (int u = 0; u < 8; ++u) {
        const f32x2v k0 = __builtin_amdgcn_cvt_pk_f32_fp8((int)kv[u].x, false), k1 = __builtin_amdgcn_cvt_pk_f32_fp8((int)kv[u].x, true),
                     k2 = __builtin_amdgcn_cvt_pk_f32_fp8((int)kv[u].y, false), k3 = __builtin_amdgcn_cvt_pk_f32_fp8((int)kv[u].y, true);
        f32x2v d2 = k0 * (f32x2v){q[0], q[1]}; d2 = k1 * (f32x2v){q[2], q[3]} + d2; d2 = k2 * (f32x2v){q[4], q[5]} + d2; d2 = k3 * (f32x2v){q[6], q[7]} + d2;
        float d = d2[0] + d2[1];
        d += dpp_f<0xB1>(d); d += dpp_f<0x4E>(d); d += dpp_f<0x141>(d);
        sc[u] = (b0 + u < n) ? d : -INFINITY;
        mx = fmaxf(mx, sc[u]); }
    const float scale = __builtin_amdgcn_exp2f(S.m - mx);
    float ls = S.l * scale;
#pragma unroll
    for (int i = 0; i < 8; ++i) S.o[i] *= scale;
#pragma unroll
    for (int u = 0; u < 8; ++u) {
        const float p = __builtin_amdgcn_exp2f(sc[u] - mx); ls += p;
        const f32x2v v0 = __builtin_amdgcn_cvt_pk_f32_fp8((int)kv[u].z, false), v1 = __builtin_amdgcn_cvt_pk_f32_fp8((int)kv[u].z, true),
                     v2 = __builtin_amdgcn_cvt_pk_f32_fp8((int)kv[u].w, false), v3 = __builtin_amdgcn_cvt_pk_f32_fp8((int)kv[u].w, true);
        S.o[0] += p * v0[0]; S.o[1] += p * v0[1]; S.o[2] += p * v1[0]; S.o[3] += p * v1[1]; S.o[4] += p * v2[0]; S.o[5] += p * v2[1]; S.o[6] += p * v3[0]; S.o[7] += p * v3[1]; }
    S.l = ls; S.m = mx;
}

DEVI void attn_query(int t, const bf16_t* __restrict__ Qb, const unsigned char* __restrict__ KV8,
                     const unsigned* __restrict__ SELM, const unsigned* __restrict__ SELM2, bf16_t* __restrict__ AO, unsigned char* wl, int lane) {
    unsigned short* lst = (unsigned short*)wl;
    const unsigned* SR = SELM + (size_t)t * SW;
    LDS_FENCE();
    const int nw = (t >> 5) + 1; int base = 0;
    for (int w0 = 0; w0 < nw; w0 += 64) {
        const int wi = w0 + lane; const unsigned wv = wi < nw ? SR[wi] : 0u;
        const int pc = __popc(wv); int pre = pc;
#pragma unroll
        for (int off = 1; off < 64; off <<= 1) { const int o_ = __shfl_up(pre, off); if (lane >= off) pre += o_; }
        int pos = base + pre - pc; unsigned mm = wv;
        while (mm) { const int bpos = __ffs((int)mm) - 1; mm &= mm - 1u; if (pos < TOPK) lst[pos] = (unsigned short)(wi * 32 + bpos); ++pos; }
        base += __shfl(pre, 63);
    }
    const int n = base < TOPK ? base : TOPK;
    float q[8];
    { const uint4 qv = ((const uint4*)(Qb + (size_t)t * 512))[lane]; const float qs = 0.18033688011112042f;
      q[0] = bflo(qv.x) * qs; q[1] = bfhi(qv.x) * qs; q[2] = bflo(qv.y) * qs; q[3] = bfhi(qv.y) * qs; q[4] = bflo(qv.z) * qs; q[5] = bfhi(qv.z) * qs; q[6] = bflo(qv.w) * qs; q[7] = bfhi(qv.w) * qs; }
    LDS_FENCE();
    AttnQ S; S.m = -INFINITY; S.l = 0.f;
#pragma unroll
    for (int d = 0; d < 8; ++d) S.o[d] = 0.f;
    uint4 ka[8], kb_[8], kc[8];
    attn_issue(0, n, lst, KV8, lane, ka);
    if (8 < n) attn_issue(8, n, lst, KV8, lane, kb_);
    for (int b0 = 0; b0 < n; b0 += 24) {
        if (b0 + 16 < n) attn_issue(b0 + 16, n, lst, KV8, lane, kc);
        attn_compute(S, b0, n, q, ka);
        if (b0 + 8 < n) {
            if (b0 + 24 < n) attn_issue(b0 + 24, n, lst, KV8, lane, ka);
            attn_compute(S, b0 + 8, n, q, kb_);
            if (b0 + 16 < n) {
                if (b0 + 32 < n) attn_issue(b0 + 32, n, lst, KV8, lane, kb_);
                attn_compute(S, b0 + 16, n, q, kc);
            }
        }
    }
    const int hd = lane >> 3, ch = lane & 7;
    const float inv = 1.0f / S.l;
    uint4 pk; pk.x = cvt_pk_bf16(S.o[0] * inv, S.o[1] * inv); pk.y = cvt_pk_bf16(S.o[2] * inv, S.o[3] * inv); pk.z = cvt_pk_bf16(S.o[4] * inv, S.o[5] * inv); pk.w = cvt_pk_bf16(S.o[6] * inv, S.o[7] * inv);
    *(uint4*)(AO + (size_t)t * 1024 + 512 + hd * 64 + ch * 8) = pk;
}

__global__ void __launch_bounds__(NTHREADS, 2) fwd(Args a) {
    extern __shared__ __attribute__((aligned(16))) unsigned char lds_raw[];
    float* smf = (float*)lds_raw;
    PG8_LAS unsigned char* ldsp = (PG8_LAS unsigned char*)lds_raw;
    const int nwaves = gridDim.x * 8;
#define PHASE_VARS const int tid = otid(); const int lane = tid & 63, wave = tid >> 6; const int gwave = blockIdx.x * 8 + wave; (void)lane; (void)wave; (void)gwave;
    unsigned char* ws = a.ws;
    unsigned* ctl = (unsigned*)(ws + WS_CTL);
    const int lo = a.ph_lo, hi = a.ph_hi;

    volatile LAS unsigned* bst = (volatile LAS unsigned*)((LAS unsigned char*)lds_raw + (LDS_BYTES - 16));
    if (threadIdx.x == 0) { bst[0] = 0u; bst[1] = 0u; bst[2] = 0u; bst[3] = 0u; }
    __syncthreads();
    XcdBarrier bar; bar.bar = ctl; bar.x = 0; bar.st = bst;
    if (hi - lo > 1) bar = xcd_barrier_post(ctl, bst);
#define IN(k) (lo <= (k) && (k) < hi)
#define SEAM(k) do { if (IN(k) && IN((k) + 1)) xcd_barrier(bar); } while (0)

    const float* x = a.in[0]; const float* meta = a.in[1];
    float* ropeC = (float*)(ws + WS_ROPEC); float* ropeS = (float*)(ws + WS_ROPES);
    int* eid = (int*)(ws + WS_EID); float* gw = (float*)(ws + WS_GW); int* slot = (int*)(ws + WS_SLOT); int* mtiles = (int*)(ws + WS_MTILES);
    unsigned* counts0 = (unsigned*)(ws + CTL_CNT); unsigned* counts1 = counts0 + 32;
    unsigned* cursor0 = (unsigned*)(ws + CTL_CUR); unsigned* cursor1 = cursor0 + 32;
    bf16_t* Wta = (bf16_t*)(ws + WS_WTA); bf16_t* Wtx = (bf16_t*)(ws + WS_WTX);
    float* Aend = (float*)(ws + WS_AEND); float* Hend = (float*)(ws + WS_HEND); float* CIN = (float*)(ws + WS_CIN);
    unsigned char* big = ws + WS_BIG;
    bf16_t* WIN0 = (bf16_t*)(big + R_WIN0); bf16_t* WOUT0 = (bf16_t*)(big + R_WOUT0); bf16_t* WGU = (bf16_t*)(big + R_WGU); bf16_t* WD = (bf16_t*)(big + R_WD);
    bf16_t* WIN1 = (bf16_t*)(big + R_WIN1); bf16_t* WOUT1 = (bf16_t*)(big + R_WOUT1);
    bf16_t* X0b = (bf16_t*)(big + R_A); bf16_t* AO = (bf16_t*)(big + R_A); bf16_t* Xperm = (bf16_t*)(big + R_A); bf16_t* X2b = (bf16_t*)(big + R_A); bf16_t* YY = (bf16_t*)(big + R_A);
    float* H1 = (float*)(big + R_H1); float* H3 = (float*)(big + R_H1); float* H2 = (float*)(big + R_H2); unsigned* SELM = (unsigned*)(big + R_H1); unsigned* SELM2 = (unsigned*)(big + R_H1 + 36 * MiB);
    float* Z = (float*)(big + R_C); bf16_t* Yb = (bf16_t*)(big + R_C); float* Z1 = (float*)(big + R_C);
    unsigned char* KV8 = big + R_K;
    bf16_t* GLU = (bf16_t*)(big + R_GLU); bf16_t* Qb = (bf16_t*)(big + R_Q); bf16_t* Kb = (bf16_t*)(big + R_K); bf16_t* Vb = (bf16_t*)(big + R_V);
    bf16_t* QIb = (bf16_t*)(big + R_QI); bf16_t* KIb = (bf16_t*)(big + R_KI); float* WIf = (float*)(big + R_WI);
    bf16_t* GATEg = (bf16_t*)(big + R_GATE); bf16_t* XRb = (bf16_t*)(big + R_XR);
    bf16_t* Hm = (bf16_t*)(big + R_HM);

    if (IN(0)) { PHASE_VARS;
        const float* w_in = a.in[2]; const float* w_out = a.in[7]; const float* wg = a.in[21]; const float* wu = a.in[22]; const float* wd = a.in[23];
        constexpr int J_IN0 = 52 * 16, J_OUT0 = 16 * 16, J_GU = 32 * 256, J_D = 32 * 128, J_IN1 = 40 * 16, J_OUT1 = 16 * 20, J_GT = 80;
        const float* w_in1 = a.in[8]; const float* w_out1 = a.in[16]; const float* wga = a.in[11]; const float* wgx = a.in[13];
        tr_run(J_IN0 + J_OUT0 + J_GU + J_D + J_IN1 + J_OUT1 + J_GT, [&](int j) -> TrJob {
            TrJob J{};
            if (j < J_IN0) { J.dst = WIN0; J.s0 = w_in; J.K = 1024; J.n0 = (j >> 4) * 64; J.k0 = (j & 15) * 64; J.mode = 1; return J; }
            j -= J_IN0;
            if (j < J_OUT0) { J.dst = WOUT0; J.s0 = w_out; J.ld = D; J.K = 1024; J.n0 = (j >> 4) * 64; J.k0 = (j & 15) * 64; J.mode = 0; return J; }
            j -= J_OUT0;
            if (j < J_GU) { const int e = j >> 8, t = j & 255; J.dst = WGU + (size_t)e * 1024 * 1024; J.s0 = wg + (size_t)e * D * DE; J.s1 = wu + (size_t)e * D * DE; J.K = 1024; J.n0 = (t >> 4) * 64; J.k0 = (t & 15) * 64; J.mode = 2; return J; }
            j -= J_GU;
            if (j < J_D) { const int e = j >> 7, t = j & 127; J.dst = WD + (size_t)e * 1024 * 512; J.s0 = wd + (size_t)e * DE * D; J.ld = D; J.K = 512; J.n0 = (t >> 3) * 64; J.k0 = (t & 7) * 64; J.mode = 0; return J; }
            j -= J_D;
            if (j < J_IN1) { J.dst = WIN1; J.s0 = w_in1; J.ld = 2 * RNN_W; J.K = 1024; J.n0 = (j >> 4) * 64; J.k0 = (j & 15) * 64; J.mode = 0; return J; }
            j -= J_IN1;
            if (j < J_OUT1) { J.dst = WOUT1; J.s0 = w_out1; J.ld = D; J.K = RNN_W; J.n0 = (j / 20) * 64; J.k0 = (j % 20) * 64; J.mode = 0; return J; }
            j -= J_OUT1;
            { const int which = j / 40, r = j % 40; const int nb = r >> 2;
              J.dst = (which ? Wtx : Wta) + (size_t)nb * 128 * 128; J.s0 = (which ? wgx : wga) + (size_t)nb * 128 * 128; J.ld = 128; J.K = 128; J.n0 = ((r >> 1) & 1) * 64; J.k0 = (r & 1) * 64; J.mode = 0; return J; }
        }, smf);
        for (size_t i = (size_t)blockIdx.x * NTHREADS + tid; i < (size_t)LP * 256; i += (size_t)gridDim.x * NTHREADS) {
            const size_t r = i >> 8, c4 = i & 255;
            float4 v = make_float4(0.f, 0.f, 0.f, 0.f);
            if (r < NMETA) v = ((const float4*)meta)[r * 256 + c4]; else if (r < L) v = ((const float4*)x)[(r - NMETA) * 256 + c4];
            ((uint2*)X0b)[i] = make_uint2(cvt_pk_bf16(v.x, v.y), cvt_pk_bf16(v.z, v.w));
        }
        for (int i = blockIdx.x * NTHREADS + tid; i < 2 * 64 * 3 * 64; i += gridDim.x * NTHREADS) {
            const int ln = i & 63, ct = (i >> 6) % 3, ss = (i / 192) & 63, ly = i / (192 * 64);
            const int col = 16 * ct + (ln & 15), k0 = 16 * ss + 4 * (ln >> 4);
            float v[4];
#pragma unroll
            for (int j = 0; j < 4; ++j) v[j] = col < 4 ? a.in[17][(size_t)ly * D * NGRP + (size_t)(k0 + j) * NGRP + col] : col < 36 ? a.in[19][(size_t)ly * D * NE + (size_t)(k0 + j) * NE + (col - 4)] : 0.f;
            ((float4*)(ws + WS_WR))[i] = make_float4(v[0], v[1], v[2], v[3]);
        }
        for (int i = blockIdx.x * NTHREADS + tid; i < LP * 32; i += gridDim.x * NTHREADS) {
            const int p = i >> 5, f = i & 31;
            const float inv = (float)pow(10000.0, -(double)f / 32.0);
            const float ang = (float)p * inv;
            ropeC[i] = (float)cos((double)ang); ropeS[i] = (float)sin((double)ang);
        }
    }
    SEAM(0);
    if (IN(1)) { PHASE_VARS;
        pg8::Gemm g{X0b, WIN0, LP, 3328, 1024}; pg8::StaticOrder S; S.init(LP, 3328, (int)gridDim.x, (int)blockIdx.x);
        EpiIn0 E{GLU, KIb, WIf, ropeC, ropeS, KV8};
        pg8::gemm_phase<EpiIn0, pg8::StaticOrder>(ldsp, g, S, E);
    }
    SEAM(1);
    if (IN(2)) { PHASE_VARS;
        const float* cw = a.in[3]; const float* cb = a.in[4]; const float* lg = a.in[5]; const float* lb = a.in[6];
        for (int g4 = gwave; g4 < L / 4; g4 += nwaves) {
            const int t0 = g4 * 4, c0 = lane * 8;
            float acc[4][8], wwin[4][8];
            { const float4 b0 = *(const float4*)(cb + c0), b1 = *(const float4*)(cb + c0 + 4);
#pragma unroll
              for (int q = 0; q < 4; ++q) { acc[q][0] = b0.x; acc[q][1] = b0.y; acc[q][2] = b0.z; acc[q][3] = b0.w; acc[q][4] = b1.x; acc[q][5] = b1.y; acc[q][6] = b1.z; acc[q][7] = b1.w; } }
#pragma unroll
            for (int r = 0; r < CONV_K + 3; ++r) {
                const int tt = t0 - (CONV_K - 1) + r;
                if (r < CONV_K) { const float4 w0 = *(const float4*)(cw + r * CONV_CH + c0), w1 = *(const float4*)(cw + r * CONV_CH + c0 + 4);
                    wwin[r & 3][0] = w0.x; wwin[r & 3][1] = w0.y; wwin[r & 3][2] = w0.z; wwin[r & 3][3] = w0.w; wwin[r & 3][4] = w1.x; wwin[r & 3][5] = w1.y; wwin[r & 3][6] = w1.z; wwin[r & 3][7] = w1.w; }
                if (tt >= 0) {
                    const uint4 xv = *(const uint4*)(GLU + (size_t)tt * 512 + c0);
                    const float x[8] = {bflo(xv.x), bfhi(xv.x), bflo(xv.y), bfhi(xv.y), bflo(xv.z), bfhi(xv.z), bflo(xv.w), bfhi(xv.w)};
#pragma unroll
                    for (int q = 0; q < 4; ++q) { const int j = r - q;
                        if (j >= 0 && j < CONV_K) {
#pragma unroll
                            for (int i = 0; i < 8; ++i) acc[q][i] += wwin[j & 3][i] * x[i]; } }
                }
            }
            float gv[8], bvv[8];
            { const float4 g0 = *(const float4*)(lg + c0), g1 = *(const float4*)(lg + c0 + 4), b0 = *(const float4*)(lb + c0), b1 = *(const float4*)(lb + c0 + 4);
              gv[0] = g0.x; gv[1] = g0.y; gv[2] = g0.z; gv[3] = g0.w; gv[4] = g1.x; gv[5] = g1.y; gv[6] = g1.z; gv[7] = g1.w; bvv[0] = b0.x; bvv[1] = b0.y; bvv[2] = b0.z; bvv[3] = b0.w; bvv[4] = b1.x; bvv[5] = b1.y; bvv[6] = b1.z; bvv[7] = b1.w; }
#pragma unroll
            for (int q = 0; q < 4; ++q) {
                float s_ = 0.f;
#pragma unroll
                for (int i = 0; i < 8; ++i) s_ += acc[q][i];
                const float mu = wave_sum(s_) * (1.0f / 512.0f);
                float qq = 0.f;
#pragma unroll
                for (int i = 0; i < 8; ++i) { const float d = acc[q][i] - mu; qq += d * d; }
                const float rstd = 1.0f / sqrtf(wave_sum(qq) * (1.0f / 512.0f) + LN_EPS);
                float o[8];
#pragma unroll
                for (int i = 0; i < 8; ++i) { const float yv = (acc[q][i] - mu) * rstd * gv[i] + bvv[i]; o[i] = yv * fsigm(yv); }
                uint4 w; w.x = cvt_pk_bf16(o[0], o[1]); w.y = cvt_pk_bf16(o[2], o[3]); w.z = cvt_pk_bf16(o[4], o[5]); w.w = cvt_pk_bf16(o[6], o[7]);
                *(uint4*)(AO + (size_t)(t0 + q) * 1024 + c0) = w;
            }
        }
        for (int r = 0; ; ++r) {
            const int idx = r * (int)gridDim.x + ((r & 1) ? (int)gridDim.x - 1 - (int)blockIdx.x : (int)blockIdx.x);
            if (idx >= NTILE) break;
            indexer_tile((NTILE - 1 - idx) * 16, QIb, KIb, WIf, SELM, SELM2, lds_raw);
        }
    }
    SEAM(2);
    if (IN(3)) { PHASE_VARS;
        unsigned char* wl = lds_raw + wave * AW_BYTES;
        for (int t = gwave; t < L; t += nwaves) attn_query(t, Qb, KV8, SELM, SELM2, AO, wl, lane);
    }
    SEAM(3);
    if (IN(4)) { PHASE_VARS;
        pg8::Gemm g{AO, WOUT0, LP, 1024, 1024}; pg8::StaticOrder S; S.init(LP, 1024, (int)gridDim.x, (int)blockIdx.x);
        EpiRes0 E{x, meta, Z};
        pg8::gemm_phase<EpiRes0, pg8::StaticOrder>(ldsp, g, S, E);
    }
    SEAM(4);
    if (IN(5)) {
        for (int tb = blockIdx.x * 64; tb < L; tb += gridDim.x * 64)
            ln_route_block(tb, (L - tb) < 64 ? (L - tb) : 64, Z, H1, a.in[24], a.in[25], (const float4*)(ws + WS_WR), a.in[18], a.in[20], eid, gw, counts0, smf);
    }
    SEAM(5);
    if (IN(6)) { PHASE_VARS; moe_dispatch_mfma(H1, eid, counts0, cursor0, slot, mtiles, Xperm, (int*)lds_raw, gwave, nwaves, lane, 0); }
    SEAM(6);
    if (IN(7)) { PHASE_VARS;
        pg8::Gemm g{Xperm, WGU, MAXSLOT, 1024, 1024}; MoeOrder S; S.init(mtiles, (int)gridDim.x, (int)blockIdx.x);
        EpiGateUp E{Hm};
        pg8::gemm_phase<EpiGateUp, MoeOrder>(ldsp, g, S, E);
    }
    SEAM(7);
    if (IN(8)) { PHASE_VARS;
        pg8::Gemm g{Hm, WD, MAXSLOT, 1024, 512}; MoeOrder S; S.init(mtiles, (int)gridDim.x, (int)blockIdx.x);
        EpiDown E{Yb};
        pg8::gemm_phase<EpiDown, MoeOrder>(ldsp, g, S, E);
    }
    SEAM(8);
    if (IN(9)) { PHASE_VARS;
#pragma unroll 2
        for (int t = gwave; t < L; t += nwaves) {
            const int s0 = slot[2 * t], s1 = slot[2 * t + 1]; const float g0 = gw[2 * t], g1 = gw[2 * t + 1];
            float y[16];
            combine_row(y, H1 + (size_t)t * D, Yb + (size_t)s0 * D, Yb + (size_t)s1 * D, g0, g1, lane);
            ln_row1024v(y, a.in[26], a.in[27], lane);
#pragma unroll
            for (int i4 = 0; i4 < 4; ++i4) *(float4*)(H2 + (size_t)t * D + 16 * lane + 4 * i4) = make_float4(y[4 * i4], y[4 * i4 + 1], y[4 * i4 + 2], y[4 * i4 + 3]);
            uint4 p0, p1; p0.x = cvt_pk_bf16(y[0], y[1]); p0.y = cvt_pk_bf16(y[2], y[3]); p0.z = cvt_pk_bf16(y[4], y[5]); p0.w = cvt_pk_bf16(y[6], y[7]);
            p1.x = cvt_pk_bf16(y[8], y[9]); p1.y = cvt_pk_bf16(y[10], y[11]); p1.z = cvt_pk_bf16(y[12], y[13]); p1.w = cvt_pk_bf16(y[14], y[15]);
            *(uint4*)(X2b + (size_t)t * D + 16 * lane) = p0; *(uint4*)(X2b + (size_t)t * D + 16 * lane + 8) = p1;
        }
        for (int i = blockIdx.x * NTHREADS + tid; i < (LP - L) * D / 8; i += gridDim.x * NTHREADS) ((uint4*)(X2b + (size_t)L * D))[i] = make_uint4(0u, 0u, 0u, 0u);
    }
    SEAM(9);
    if (IN(10)) {
        pg8::Gemm g{X2b, WIN1, LP, 2 * RNN_W, 1024}; pg8::StaticOrder S; S.init(LP, 2 * RNN_W, (int)gridDim.x, (int)blockIdx.x);
        EpiIn1 E{GATEg};
        pg8::gemm_phase<EpiIn1, pg8::StaticOrder>(ldsp, g, S, E);
    }
    SEAM(10);
    if (IN(11)) rglru_phase<false>(XRb, GATEg, Wta, Wtx, a.in[9], a.in[10], a.in[12], a.in[14], a.in[15], Aend, Hend, CIN, YY, lds_raw);
    SEAM(11);
    if (IN(12)) { PHASE_VARS;
        for (int ch = gwave; ch < RNN_W; ch += nwaves) {
            float A[5], H[5];
#pragma unroll
            for (int i = 0; i < 5; ++i) { const int c = 5 * lane + i; const bool ok = c < NCHUNK; A[i] = ok ? Aend[(size_t)ch * CP + c] : 1.f; H[i] = ok ? Hend[(size_t)ch * CP + c] : 0.f; }
            float Al = 1.f, Hl = 0.f;
#pragma unroll
            for (int i = 0; i < 5; ++i) { Hl = A[i] * Hl + H[i]; Al *= A[i]; }
#pragma unroll
            for (int off = 1; off < 64; off <<= 1) { const float Ap = __shfl_up(Al, off), Hp = __shfl_up(Hl, off); if (lane >= off) { Hl = Al * Hp + Hl; Al = Al * Ap; } }
            float cin = __shfl_up(Hl, 1); if (lane == 0) cin = 0.f;
#pragma unroll
            for (int i = 0; i < 5; ++i) { const int c = 5 * lane + i; if (c < NCHUNK) { CIN[(size_t)ch * CP + c] = cin; cin = A[i] * cin + H[i]; } }
        }
    }
    SEAM(12);
    if (IN(13)) rglru_phase<true>(XRb, GATEg, Wta, Wtx, a.in[9], a.in[10], a.in[12], a.in[14], a.in[15], Aend, Hend, CIN, YY, lds_raw);
    SEAM(13);
    if (IN(14)) {
        pg8::Gemm g{YY + (size_t)NMETA * RNN_W, WOUT1, SEQ, 1024, RNN_W}; pg8::StaticOrder S; S.init(SEQ, 1024, (int)gridDim.x, (int)blockIdx.x);
        EpiRes1 E{H2 + (size_t)NMETA * D, Z1 + (size_t)NMETA * D};
        pg8::gemm_phase<EpiRes1, pg8::StaticOrder>(ldsp, g, S, E);
    }
    SEAM(14);
    if (IN(15)) { PHASE_VARS;
        const float* wg = a.in[21] + (size_t)NE * D * DE; const float* wu = a.in[22] + (size_t)NE * D * DE; const float* wd = a.in[23] + (size_t)NE * DE * D;
        constexpr int J_GU = 32 * 256, J_D = 32 * 128;
        tr_run(J_GU + J_D, [&](int j) -> TrJob {
            TrJob J{};
            if (j < J_GU) { const int e = j >> 8, t = j & 255; J.dst = WGU + (size_t)e * 1024 * 1024; J.s0 = wg + (size_t)e * D * DE; J.s1 = wu + (size_t)e * D * DE; J.K = 1024; J.n0 = (t >> 4) * 64; J.k0 = (t & 15) * 64; J.mode = 2; return J; }
            j -= J_GU;
            { const int e = j >> 7, t = j & 127; J.dst = WD + (size_t)e * 1024 * 512; J.s0 = wd + (size_t)e * DE * D; J.ld = D; J.K = 512; J.n0 = (t >> 3) * 64; J.k0 = (t & 7) * 64; J.mode = 0; return J; }
        }, smf);
        __syncthreads();
        for (int tb = NMETA + blockIdx.x * 64; tb < L; tb += gridDim.x * 64)
            ln_route_block(tb, (L - tb) < 64 ? (L - tb) : 64, Z1, H3, a.in[24] + D, a.in[25] + D, (const float4*)(ws + WS_WR) + 64 * 3 * 64, a.in[18] + NGRP, a.in[20] + NE, eid, gw, counts1, smf);
    }
    SEAM(15);
    if (IN(16)) { PHASE_VARS; moe_dispatch_mfma(H3, eid, counts1, cursor1, slot, mtiles, Xperm, (int*)lds_raw, gwave, nwaves, lane, 2 * NMETA); }
    SEAM(16);
    if (IN(17)) {
        pg8::Gemm g{Xperm, WGU, MAXSLOT, 1024, 1024}; MoeOrder S; S.init(mtiles, (int)gridDim.x, (int)blockIdx.x);
        EpiGateUp E{Hm};
        pg8::gemm_phase<EpiGateUp, MoeOrder>(ldsp, g, S, E);
    }
    SEAM(17);
    if (IN(18)) {
        pg8::Gemm g{Hm, WD, MAXSLOT, 1024, 512}; MoeOrder S; S.init(mtiles, (int)gridDim.x, (int)blockIdx.x);
        EpiDown E{Yb};
        pg8::gemm_phase<EpiDown, MoeOrder>(ldsp, g, S, E);
    }
    SEAM(18);
    if (IN(19)) { PHASE_VARS;
#pragma unroll 2
        for (int t = NMETA + gwave; t < L; t += nwaves) {
            const int s0 = slot[2 * t], s1 = slot[2 * t + 1]; const float g0 = gw[2 * t], g1 = gw[2 * t + 1];
            float y[16];
            combine_row(y, H3 + (size_t)t * D, Yb + (size_t)s0 * D, Yb + (size_t)s1 * D, g0, g1, lane);
            ln_row1024v(y, a.in[26] + D, a.in[27] + D, lane);
#pragma unroll
            for (int i4 = 0; i4 < 4; ++i4) *(float4*)(a.out + (size_t)(t - NMETA) * D + 16 * lane + 4 * i4) = make_float4(y[4 * i4], y[4 * i4 + 1], y[4 * i4 + 2], y[4 * i4 + 3]);
        }
    }
#undef IN
#undef SEAM
}
constexpr int N_PHASES = 20;

extern "C" void kernel_launch(void* const* d_in, const int* in_sizes, int n_in, void* d_out, int out_size, void* d_ws, size_t ws_size, hipStream_t stream) {
    static int grid = 0;
    if (grid == 0) {
        if (n_in != 28 || out_size != SEQ * D || ws_size < WS_END) { fprintf(stderr, "kernel_launch: unexpected shapes n_in %d out %d ws %zu (need %zu)\n", n_in, out_size, ws_size, (size_t)WS_END); grid = -1; return; }
        int dev = 0, cus = 0;
        if (hipGetDevice(&dev) != hipSuccess || hipDeviceGetAttribute(&cus, hipDeviceAttributeMultiprocessorCount, dev) != hipSuccess) { grid = -1; return; }
        if (hipFuncSetAttribute((const void*)fwd, hipFuncAttributeMaxDynamicSharedMemorySize, LDS_BYTES) != hipSuccess) { fprintf(stderr, "kernel_launch: hipFuncSetAttribute failed\n"); grid = -1; return; }
        int per_cu = 0;
        if (hipOccupancyMaxActiveBlocksPerMultiprocessor(&per_cu, (const void*)fwd, NTHREADS, LDS_BYTES) != hipSuccess || per_cu < 1) fprintf(stderr, "kernel_launch: occupancy query says %d\n", per_cu);
        (void)hipGetLastError();
        grid = cus;
    }
    if (grid < 0) return;
    (void)hipMemsetAsync((char*)d_ws + WS_CTL, 0, CTL_BYTES, stream);
    Args a{};
    for (int i = 0; i < 28; ++i) a.in[i] = (const float*)d_in[i];
    a.out = (float*)d_out; a.ws = (unsigned char*)d_ws;
#if N_LAUNCH_MODE == 1
    a.ph_lo = 0; a.ph_hi = N_PHASES;
    hipLaunchKernelGGL(fwd, dim3(grid), dim3(NTHREADS), LDS_BYTES, stream, a);
#else
    for (int p = 0; p < N_PHASES; ++p) { a.ph_lo = p; a.ph_hi = p + 1; hipLaunchKernelGGL(fwd, dim3(grid), dim3(NTHREADS), LDS_BYTES, stream, a); }
#endif
}
```

```cpp
#include <hip/hip_runtime.h>
#include <cstdio>
#include <cstdint>
#include <cmath>

#ifndef GEMM_ALIGN
#define GEMM_ALIGN true
#endif
#ifndef GEMM_SP2
#define GEMM_SP2 true
#endif
#ifndef N_LAUNCH_MODE
#define N_LAUNCH_MODE 1
#endif

#define DEVI __device__ __forceinline__
#define LAS __attribute__((address_space(3)))

constexpr int D = 1024, SEQ = 16384, NMETA = 16, L = SEQ + NMETA;
constexpr int CONV_CH = 512, CONV_K = 31, HD = 64, TOPK = 256;
constexpr int IN_AB = 3144;
constexpr int OFF_AVAL = 0, OFF_AGATE = 512, OFF_Q = 1024, OFF_K = 1536, OFF_V = 2048, OFF_QI = 2560, OFF_KI = 3072, OFF_WI = 3136;
constexpr int RNN_W = 1280, RNN_NB = 10, RNN_BW = 128, RNN_K = 4;
constexpr int NGRP = 4, EPG = 8, NE = 32, DE = 512;
constexpr int NPAIR = 2 * L;
constexpr float LN_EPS = 1e-5f;
constexpr float DN_ALPHA = 1.41421356237f;
constexpr int NTHREADS = 512;
constexpr int LDS_BYTES = 147456;

#define XB_TMO      128
#define XB_XCNT(j)  (256  + 64 * (j))
#define XB_XSUB(j)  (1280 + 64 * (j))
#define XB_XGEN(j)  (2304 + 64 * (j))
#define XB_TOP      3328
#define XB_TOPGEN   3392
#define XCD_BAR_WORDS 3456
#define XB_SPIN_CAP (1u << 22)
DEVI unsigned xb_ld(unsigned* p)              { return __hip_atomic_load(p, __ATOMIC_RELAXED, __HIP_MEMORY_SCOPE_AGENT); }
DEVI unsigned xb_add(unsigned* p, unsigned v) { return __hip_atomic_fetch_add(p, v, __ATOMIC_RELAXED, __HIP_MEMORY_SCOPE_AGENT); }
DEVI unsigned xb_xcc_id() { return (unsigned)__builtin_amdgcn_s_getreg((3 << 11) | 20) & 0xFu; }
#define XB_SPIN(cond, bar) do { unsigned _sp = 0; while (cond) { __builtin_amdgcn_s_sleep(1); \
    if ((++_sp & 255u) == 0u) { if (xb_ld(&(bar)[XB_TMO])) break; if (_sp > XB_SPIN_CAP) { atomicAdd(&(bar)[XB_TMO], 1u); break; } } } } while (0)
struct XcdBarrier { unsigned* bar; unsigned x; volatile LAS unsigned* st; };
DEVI XcdBarrier xcd_barrier_post(unsigned* bar, volatile LAS unsigned* st) {
    XcdBarrier b; b.bar = bar; b.x = xb_xcc_id(); b.st = st;
    if (threadIdx.x == 0) (void)xb_add(&bar[XB_XCNT(b.x)], 1u);
    return b;
}
DEVI void xcd_barrier_complete(unsigned* bar, unsigned x, unsigned& nloc, unsigned& nx) {
    const unsigned G = gridDim.x * gridDim.y * gridDim.z;
    unsigned sum, cnt, mine, sp = 0u;
    for (;;) {
        sum = 0u; cnt = 0u; mine = 0u;
#pragma unroll
        for (unsigned j = 0; j < 16; ++j) { const unsigned c = xb_ld(&bar[XB_XCNT(j)]); sum += c; cnt += (c > 0u) ? 1u : 0u; mine = (j == x) ? c : mine; }
        if (sum == G) break;
        __builtin_amdgcn_s_sleep(1);
        if ((++sp & 255u) == 0u) { if (xb_ld(&bar[XB_TMO])) break; if (sp > XB_SPIN_CAP) { atomicAdd(&bar[XB_TMO], 1u); break; } }
    }
    nloc = mine > 0u ? mine : 1u; nx = cnt > 0u ? cnt : 1u;
}
DEVI void xcd_barrier(const XcdBarrier& b) {
    asm volatile("s_waitcnt vmcnt(0)" ::: "memory");
    __syncthreads();
    if (threadIdx.x == 0) {
        unsigned* bar = b.bar;
        __builtin_amdgcn_s_waitcnt(0);
        unsigned nloc = b.st[0], nx = b.st[1];
        if (nloc == 0u) { xcd_barrier_complete(bar, b.x, nloc, nx); b.st[0] = nloc; b.st[1] = nx; }
        const unsigned old = xb_add(&bar[XB_XSUB(b.x)], 1u);
        const unsigned gen = old / nloc;
        if (old + 1u == (gen + 1u) * nloc) {
            __builtin_amdgcn_fence(__ATOMIC_RELEASE, "agent");
            asm volatile("s_waitcnt vmcnt(0)" ::: "memory");
            const unsigned og = xb_add(&bar[XB_TOP], 1u);
            const unsigned tg = og / nx;
            if (og + 1u == (tg + 1u) * nx) xb_add(&bar[XB_TOPGEN], 1u);
            else XB_SPIN(xb_ld(&bar[XB_TOPGEN]) == tg, bar);
            __builtin_amdgcn_fence(__ATOMIC_ACQUIRE, "agent");
            xb_add(&bar[XB_XGEN(b.x)], 1u);
            asm volatile("s_waitcnt vmcnt(0)" ::: "memory");
        } else {
            XB_SPIN(xb_ld(&bar[XB_XGEN(b.x)]) == gen, bar);
            __builtin_amdgcn_fence(__ATOMIC_ACQUIRE, "agent");
            asm volatile("s_waitcnt vmcnt(0)" ::: "memory");
        }
    }
    __syncthreads();
}

constexpr int LP = 16640;
constexpr int MAXSLOT = 40960;
constexpr int NCHUNK = 257, CP = 272;
constexpr size_t MiB = 1048576;
constexpr size_t WS_CTL = 0;
constexpr size_t CTL_CNT = 16384;
constexpr size_t CTL_CUR = 16384 + 256;
constexpr size_t CTL_BYTES = 32768;
constexpr size_t WS_ROPEC = 32768;
constexpr size_t WS_ROPES = WS_ROPEC + (size_t)LP * 32 * 4;
constexpr size_t WS_EID = WS_ROPES + (size_t)LP * 32 * 4;
constexpr size_t WS_GW = WS_EID + (size_t)NPAIR * 4;
constexpr size_t WS_SLOT = WS_GW + (size_t)NPAIR * 4;
constexpr size_t WS_MTILES = WS_SLOT + (size_t)NPAIR * 4;
constexpr size_t WS_WTA = WS_MTILES + 4096;
constexpr size_t WS_WTX = WS_WTA + (size_t)RNN_NB * 128 * 128 * 2;
constexpr size_t WS_AEND = WS_WTX + (size_t)RNN_NB * 128 * 128 * 2;
constexpr size_t WS_HEND = WS_AEND + (size_t)RNN_W * CP * 4;
constexpr size_t WS_CIN = WS_HEND + (size_t)RNN_W * CP * 4;
constexpr size_t WS_WR = WS_CIN + (size_t)RNN_W * CP * 4;
constexpr size_t WS_BIG = ((WS_WR + (size_t)2 * 64 * 3 * 64 * 16 + 255) / 256) * 256;
constexpr size_t R_WIN0 = 0;
constexpr size_t R_WOUT0 = R_WIN0 + (size_t)3328 * 1024 * 2;
constexpr size_t R_WGU = R_WOUT0 + (size_t)1024 * 1024 * 2;
constexpr size_t R_WD = R_WGU + (size_t)32 * 1024 * 1024 * 2;
constexpr size_t R_WIN1 = R_WD + (size_t)32 * 1024 * 512 * 2;
constexpr size_t R_WOUT1 = R_WIN1 + (size_t)2560 * 1024 * 2;
static_assert(R_WOUT1 + (size_t)1024 * 1280 * 2 <= 112 * MiB, "weights");
constexpr size_t R_A = 112 * MiB;
constexpr size_t R_H1 = 192 * MiB;
constexpr size_t R_H2 = 257 * MiB;
constexpr size_t R_C = 322 * MiB;
constexpr size_t R_GLU = 322 * MiB;
constexpr size_t SZ512 = (size_t)LP * 512 * 2;
constexpr size_t R_Q = R_GLU + SZ512, R_K = R_Q + SZ512, R_V = R_K + SZ512, R_QI = R_V + SZ512, R_KI = R_QI + SZ512, R_WI = R_KI + (size_t)LP * 64 * 2;
static_assert(R_WI + (size_t)LP * 8 * 4 <= 406 * MiB, "in-proj outputs");
constexpr size_t R_GATE = 322 * MiB;
constexpr size_t R_XR = R_GATE + (size_t)LP * 1280 * 2;
static_assert(R_XR + (size_t)LP * 1280 * 2 <= 406 * MiB, "layer-1 in-proj outputs");
constexpr size_t R_HM = 406 * MiB;
constexpr size_t WS_END = WS_BIG + R_HM + (size_t)MAXSLOT * 512 * 2;
static_assert(WS_END <= 512 * MiB, "ws");

struct Args { const float* in[28]; float* out; unsigned char* ws; int ph_lo, ph_hi; };

DEVI int otid() { int v = (int)threadIdx.x; asm volatile("" : "+v"(v)); return v; }
template <int CTRL> DEVI float dpp_f(float v) { return __int_as_float(__builtin_amdgcn_mov_dpp(__float_as_int(v), CTRL, 0xF, 0xF, true)); }
DEVI float wave_sum(float v) {
    v += dpp_f<0xB1>(v); v += dpp_f<0x4E>(v); v += dpp_f<0x141>(v); v += dpp_f<0x140>(v);
    return __int_as_float(__builtin_amdgcn_readlane(__float_as_int(v), 0)) + __int_as_float(__builtin_amdgcn_readlane(__float_as_int(v), 16))
         + __int_as_float(__builtin_amdgcn_readlane(__float_as_int(v), 32)) + __int_as_float(__builtin_amdgcn_readlane(__float_as_int(v), 48));
}
DEVI float wave_max(float v) {
#pragma unroll
    for (int o = 32; o > 0; o >>= 1) v = fmaxf(v, __shfl_xor(v, o));
    return v;
}
DEVI float sigm(float x) { return 1.0f / (1.0f + expf(-x)); }
DEVI float gelu_tanh(float x) { return 0.5f * x * (1.0f + tanhf(0.7978845608028654f * (x + 0.044715f * x * x * x))); }
DEVI unsigned f2key(float f) { unsigned u = __float_as_uint(f); return (u & 0x80000000u) ? ~u : (u | 0x80000000u); }

namespace pg8 {
#define PG8_LAS __attribute__((address_space(3)))
typedef unsigned short bf16_t;
typedef short bf16x8 __attribute__((ext_vector_type(8)));
typedef float f32x4 __attribute__((ext_vector_type(4)));
typedef unsigned u32x4 __attribute__((ext_vector_type(4)));
constexpr int BM = 256, BK = 64, HALF = 128, HTB = HALF * BK * 2  , STAGE_BYTES = 8 * HTB, NXCD = 8, WGM = 8;

__host__ __device__ __forceinline__ int lds_byte(int r, int c) { const int st = (r >> 4) * 2 + (c >> 5), rr = r & 15, cc = c & 31, ob = rr * 64 + cc * 2; return st * 1024 + (ob ^ (((ob >> 9) & 1) << 5)); }
__host__ __device__ __forceinline__ void stage_rc(int b, int& R, int& C) { const int st = b / 1024, sb = b % 1024, swz = sb ^ (((sb >> 9) & 1) << 5); R = (st >> 1) * 16 + swz / 64; C = (st & 1) * 32 + (swz % 64) / 2; }
__host__ __device__ __forceinline__ int perm32(int rho) { const int n = rho >> 4, i = rho & 15; return 8 * (i >> 2) + 4 * n + (i & 3); }

struct Unit { int pm, pn; };
struct Gemm { const bf16_t* A; const bf16_t* Bt; int M, N, K; };

struct StaticOrder {
    int nM, nN, nwg, G, c;
    __host__ __device__ void init(int M, int N, int G_, int c_) { nM = M / BM; nN = N / BM; nwg = nM * nN; G = G_; c = c_; }
    __host__ __device__ bool next(int i, Unit& u) const {
        const long L = (long)i * G + c; if (L >= nwg) return false;
        int wgid = (int)L; { const int q = nwg / NXCD, r = nwg % NXCD, xcd = wgid % NXCD, off = wgid / NXCD; wgid = (xcd < r ? xcd * (q + 1) : r * (q + 1) + (xcd - r) * q) + off; }
        const int nig = WGM * nN, gid = wgid / nig, fm = gid * WGM, gsz = (nM - fm) < WGM ? (nM - fm) : WGM;
        u.pm = fm + ((wgid % nig) % gsz); u.pn = (wgid % nig) / gsz; return true;
    }
    __device__ __forceinline__ void a_ready(const Unit&) const {}
    __device__ __forceinline__ void done(const Unit&) const {}
};

template <class Epi, class Sched, bool ALIGN_EPI = false, bool SP2 = false>
__device__ __forceinline__ void gemm_phase(PG8_LAS unsigned char* lds, const Gemm g, const Sched& S, const Epi& E) {
    const int tid = threadIdx.x, wid = __builtin_amdgcn_readfirstlane(tid >> 6), lane = tid & 63, wr = wid >> 2, wc = wid & 3, fr = lane & 15, fq = lane >> 4;
    const int K = g.K, nt = K / BK;
    unsigned voffA[2], voffB[2];
#pragma unroll
    for (int i = 0; i < 2; ++i) { int R, C; stage_rc(tid * 16 + i * 8192, R, C); const int Rb = Epi::PERM ? ((R & ~31) + perm32(R & 31)) : R;
        voffA[i] = (unsigned)(R * K + C) * 2u; voffB[i] = (unsigned)(Rb * K + C) * 2u; }
    const size_t kstep = (size_t)(BK * 2);
    const size_t hstep = (size_t)HALF * K * 2;
    const size_t tstep = 2 * hstep;
    const unsigned ldsw = (unsigned)wid * 1024u;
    const int aoff = lds_byte(wr * 64 + fr, fq * 8), boff = lds_byte(wc * 32 + fr, fq * 8);
#define PG8_SA(b, h) (((b) * 2 + (h)) * HTB)
#define PG8_SB(b, h) ((4 + (b) * 2 + (h)) * HTB)
#define PG8_STAGE(bufoff, gbase, voff) do { _Pragma("unroll") for (int _i = 0; _i < 2; ++_i) \
        __builtin_amdgcn_global_load_lds((const unsigned*)((const char*)(gbase) + (voff)[_i]), (PG8_LAS unsigned*)(lds + (bufoff) + ldsw + _i * 8192), 16, 0, 0); } while (0)
#define PG8_LDA(dst, b, h) do { _Pragma("unroll") for (int m = 0; m < 4; ++m) _Pragma("unroll") for (int k = 0; k < 2; ++k) dst[m][k] = *(const PG8_LAS bf16x8*)(lds + PG8_SA(b, h) + aoff + m * 2048 + k * 1024); } while (0)
#define PG8_LDB(dst, b, h) do { _Pragma("unroll") for (int n = 0; n < 2; ++n) _Pragma("unroll") for (int k = 0; k < 2; ++k) dst[n][k] = *(const PG8_LAS bf16x8*)(lds + PG8_SB(b, h) + boff + n * 2048 + k * 1024); } while (0)
#define PG8_MMA(ai, bj, At, Bt) do { __builtin_amdgcn_s_setprio(1); _Pragma("unroll") for (int m = 0; m < 4; ++m) _Pragma("unroll") for (int n = 0; n < 2; ++n) _Pragma("unroll") for (int k = 0; k < 2; ++k) \
        acc[ai][bj][m][n] = __builtin_amdgcn_mfma_f32_16x16x32_bf16(Bt[n][k], At[m][k], acc[ai][bj][m][n], 0, 0, 0); __builtin_amdgcn_s_setprio(0); } while (0)
#define PG8_WAIT_V(n) asm volatile("s_waitcnt vmcnt(" #n ")" ::: "memory")
#define PG8_WAIT_L(n) asm volatile("s_waitcnt lgkmcnt(" #n ")" ::: "memory")
#define PG8_BAR __builtin_amdgcn_s_barrier()
#define PG8_SCHED __builtin_amdgcn_sched_barrier(0)
    Unit cur, nxt; int ui = 0;
    if (!S.next(0, cur)) return;
    f32x4 acc[2][2][4][2];
#pragma unroll
    for (int a = 0; a < 2; ++a)
#pragma unroll
        for (int b = 0; b < 2; ++b)
#pragma unroll
            for (int m = 0; m < 4; ++m)
#pragma unroll
                for (int n = 0; n < 2; ++n) acc[a][b][m][n] = (f32x4){0.f, 0.f, 0.f, 0.f};
    bf16x8 At[4][2], B0[2][2], B1[2][2];
    const char* cA = (const char*)g.A + (size_t)cur.pm * tstep; const char* cB = (const char*)g.Bt + (size_t)cur.pn * tstep;
    S.a_ready(cur);
    if constexpr (SP2) {
        PG8_STAGE(PG8_SB(0, 0), cB, voffB); PG8_STAGE(PG8_SB(0, 1), cB + hstep, voffB); PG8_STAGE(PG8_SA(0, 0), cA, voffA); PG8_STAGE(PG8_SA(0, 1), cA + hstep, voffA);
        if (wr == 1) PG8_BAR;
        PG8_WAIT_V(2); PG8_BAR;
        PG8_STAGE(PG8_SB(1, 0), cB + kstep, voffB); PG8_STAGE(PG8_SA(1, 0), cA + kstep, voffA); PG8_STAGE(PG8_SB(1, 1), cB + hstep + kstep, voffB);
        PG8_WAIT_V(6); PG8_BAR;
    } else {
        PG8_STAGE(PG8_SB(0, 0), cB, voffB); PG8_STAGE(PG8_SA(0, 0), cA, voffA); PG8_STAGE(PG8_SB(0, 1), cB + hstep, voffB); PG8_STAGE(PG8_SA(0, 1), cA + hstep, voffA);
        if (wr == 1) PG8_BAR;
        PG8_WAIT_V(4); PG8_BAR;
        PG8_STAGE(PG8_SB(1, 0), cB + kstep, voffB); PG8_STAGE(PG8_SA(1, 0), cA + kstep, voffA); PG8_STAGE(PG8_SB(1, 1), cB + hstep + kstep, voffB);
        PG8_WAIT_V(6); PG8_BAR;
    }
    for (;;) {
        const bool has_next = S.next(ui + 1, nxt);
        const char* nA = has_next ? (const char*)g.A + (size_t)nxt.pm * tstep : cA; const char* nB = has_next ? (const char*)g.Bt + (size_t)nxt.pn * tstep : cB;
        for (int t = 0; t < nt; t += 2) {
            const bool last = (t == nt - 2);
            const char* a1 = cA + (size_t)(t + 1) * kstep;
            const char* a2 = last ? nA : cA + (size_t)(t + 2) * kstep; const char* b2 = last ? nB : cB + (size_t)(t + 2) * kstep;
            const char* a3 = a2 + kstep; const char* b3 = b2 + kstep;
            if (last && has_next) S.a_ready(nxt);
            if constexpr (SP2) {
            PG8_LDB(B0, 0, 0); PG8_LDB(B1, 0, 1); PG8_SCHED; PG8_LDA(At, 0, 0); PG8_STAGE(PG8_SA(1, 1), a1 + hstep, voffA);
            PG8_WAIT_V(8); PG8_WAIT_L(0); PG8_BAR; PG8_MMA(0, 0, At, B0); PG8_MMA(0, 1, At, B1); PG8_BAR; PG8_SCHED;
            PG8_LDA(At, 0, 1); PG8_STAGE(PG8_SB(0, 0), b2, voffB); PG8_STAGE(PG8_SB(0, 1), b2 + hstep, voffB); PG8_STAGE(PG8_SA(0, 0), a2, voffA);
            PG8_WAIT_V(8); PG8_WAIT_L(0); PG8_BAR; PG8_MMA(1, 0, At, B0); PG8_MMA(1, 1, At, B1); PG8_BAR; PG8_SCHED;
            PG8_LDB(B0, 1, 0); PG8_LDB(B1, 1, 1); PG8_SCHED; PG8_LDA(At, 1, 0); PG8_STAGE(PG8_SA(0, 1), a2 + hstep, voffA);
            PG8_WAIT_V(8); PG8_WAIT_L(0); PG8_BAR; PG8_MMA(0, 0, At, B0); PG8_MMA(0, 1, At, B1); PG8_BAR; PG8_SCHED;
            PG8_LDA(At, 1, 1); PG8_STAGE(PG8_SB(1, 0), b3, voffB); PG8_STAGE(PG8_SB(1, 1), b3 + hstep, voffB); PG8_STAGE(PG8_SA(1, 0), a3, voffA);
            PG8_WAIT_V(8); PG8_WAIT_L(0); PG8_BAR; PG8_MMA(1, 0, At, B0); PG8_MMA(1, 1, At, B1); PG8_BAR; PG8_SCHED;
            } else {
            PG8_LDB(B0, 0, 0); PG8_SCHED; PG8_LDA(At, 0, 0); PG8_STAGE(PG8_SA(1, 1), a1 + hstep, voffA);
            PG8_WAIT_L(8); PG8_BAR; PG8_WAIT_L(0); PG8_MMA(0, 0, At, B0); PG8_BAR; PG8_SCHED;
            PG8_LDB(B1, 0, 1); PG8_STAGE(PG8_SB(0, 0), b2, voffB);
            PG8_BAR; PG8_WAIT_L(0); PG8_MMA(0, 1, At, B1); PG8_BAR;
            PG8_LDA(At, 0, 1); PG8_STAGE(PG8_SA(0, 0), a2, voffA);
            PG8_BAR; PG8_WAIT_L(0); PG8_MMA(1, 0, At, B0); PG8_BAR; PG8_SCHED;
            PG8_STAGE(PG8_SB(0, 1), b2 + hstep, voffB);
            PG8_WAIT_V(6); PG8_BAR; PG8_MMA(1, 1, At, B1); PG8_BAR;
            PG8_LDB(B0, 1, 0); PG8_SCHED; PG8_LDA(At, 1, 0); PG8_STAGE(PG8_SA(0, 1), a2 + hstep, voffA);
            PG8_WAIT_L(8); PG8_BAR; PG8_WAIT_L(0); PG8_MMA(0, 0, At, B0); PG8_BAR; PG8_SCHED;
            PG8_LDB(B1, 1, 1); PG8_STAGE(PG8_SB(1, 0), b3, voffB);
            PG8_BAR; PG8_WAIT_L(0); PG8_MMA(0, 1, At, B1); PG8_BAR;
            PG8_LDA(At, 1, 1); PG8_STAGE(PG8_SA(1, 0), a3, voffA);
            PG8_BAR; PG8_WAIT_L(0); PG8_MMA(1, 0, At, B0); PG8_BAR; PG8_SCHED;
            PG8_STAGE(PG8_SB(1, 1), b3 + hstep, voffB);
            PG8_WAIT_V(6); PG8_BAR; PG8_MMA(1, 1, At, B1); PG8_BAR;
            }
        }
        if constexpr (ALIGN_EPI) { if (wr == 0) PG8_BAR; }
        if constexpr (!Epi::AFTER_DRAIN) { E(acc, cur, wr, wc, fr, fq); S.done(cur); }
        if (!has_next) break;
#pragma unroll
        for (int a = 0; a < 2; ++a)
#pragma unroll
            for (int b = 0; b < 2; ++b)
#pragma unroll
                for (int m = 0; m < 4; ++m)
#pragma unroll
                    for (int n = 0; n < 2; ++n) acc[a][b][m][n] = (f32x4){0.f, 0.f, 0.f, 0.f};
        cur = nxt; cA = nA; cB = nB; ++ui;
        if constexpr (ALIGN_EPI) { if (wr == 1) PG8_BAR; }
    }
    PG8_WAIT_V(0);
    if constexpr (!ALIGN_EPI) { if (wr == 0) PG8_BAR; }
    PG8_BAR;
    if constexpr (Epi::AFTER_DRAIN) { E.fused(acc, cur, wr, wc, fr, fq, lds, wid, lane); S.done(cur); }
#undef PG8_SA
#undef PG8_SB
#undef PG8_STAGE
#undef PG8_LDA
#undef PG8_LDB
#undef PG8_MMA
#undef PG8_WAIT_V
#undef PG8_WAIT_L
#undef PG8_BAR
#undef PG8_SCHED
}
}

DEVI void ln_row1024(float (&y)[16], const float* g, const float* b, int lane) {
    float s = 0.f;
#pragma unroll
    for (int i = 0; i < 16; ++i) s += y[i];
    const float mu = wave_sum(s) * (1.0f / 1024.0f);
    float q = 0.f;
#pragma unroll
    for (int i = 0; i < 16; ++i) { const float d = y[i] - mu; q += d * d; }
    const float rstd = 1.0f / sqrtf(wave_sum(q) * (1.0f / 1024.0f) + LN_EPS);
#pragma unroll
    for (int i = 0; i < 16; ++i) y[i] = (y[i] - mu) * rstd * g[lane + 64 * i] + b[lane + 64 * i];
}

DEVI void route_token(const float (&y)[16], float* ys, int t, int lane, const float* wg, const float* bg, const float* we, const float* be, int* eid, float* gw, unsigned* counts) {
    float lg[36];
#pragma unroll
    for (int j = 0; j < 36; ++j) lg[j] = 0.f;
#pragma unroll
    for (int i = 0; i < 16; ++i) ys[lane + 64 * i] = y[i];
#pragma unroll 1
    for (int i = 0; i < 16; ++i) {
        const int c = lane + 64 * i;
        const float yv = ys[c];
        const float4 g4 = *(const float4*)(wg + (size_t)c * 4);
        lg[0] += yv * g4.x; lg[1] += yv * g4.y; lg[2] += yv * g4.z; lg[3] += yv * g4.w;
#pragma unroll
        for (int j = 0; j < 8; ++j) { const float4 e4 = *(const float4*)(we + (size_t)c * 32 + j * 4);
            lg[4 + j * 4 + 0] += yv * e4.x; lg[4 + j * 4 + 1] += yv * e4.y; lg[4 + j * 4 + 2] += yv * e4.z; lg[4 + j * 4 + 3] += yv * e4.w; }
    }
#pragma unroll
    for (int j = 0; j < 36; ++j) lg[j] = wave_sum(lg[j]);
    if (lane == 0) {
        float gl[4]; int g = 0;
#pragma unroll
        for (int j = 0; j < 4; ++j) gl[j] = lg[j] + bg[j];
#pragma unroll
        for (int j = 1; j < 4; ++j) if (gl[j] > gl[g]) g = j;
        float den = 0.f;
#pragma unroll
        for (int j = 0; j < 4; ++j) den += expf(gl[j] - gl[g]);
        const float gp = 1.0f / den;
        float el[8];
#pragma unroll
        for (int j = 0; j < 8; ++j) { float v = 0.f;
#pragma unroll
            for (int gg = 0; gg < 4; ++gg) v = (gg == g) ? lg[4 + gg * 8 + j] + be[gg * 8 + j] : v;
            el[j] = v; }
        int i1 = 0;
#pragma unroll
        for (int j = 1; j < 8; ++j) if (el[j] > el[i1]) i1 = j;
        int i2 = (i1 == 0) ? 1 : 0;
#pragma unroll
        for (int j = 0; j < 8; ++j) if (j != i1 && el[j] > el[i2]) i2 = j;
        const float ex = expf(el[i2] - el[i1]);
        const float p1 = 1.0f / (1.0f + ex), p2 = ex / (1.0f + ex);
        const int e1 = g * 8 + i1, e2 = g * 8 + i2;
        eid[2 * t] = e1; eid[2 * t + 1] = e2; gw[2 * t] = gp * p1; gw[2 * t + 1] = gp * p2;
        atomicAdd(&counts[e1], 1u); atomicAdd(&counts[e2], 1u);
    }
}


DEVI void ln_row1024v(float (&y)[16], const float* g, const float* b, int lane) {
    float s = 0.f;
#pragma unroll
    for (int i = 0; i < 16; ++i) s += y[i];
    const float mu = wave_sum(s) * (1.0f / 1024.0f);
    float q = 0.f;
#pragma unroll
    for (int i = 0; i < 16; ++i) { const float d = y[i] - mu; q += d * d; }
    const float rstd = 1.0f / sqrtf(wave_sum(q) * (1.0f / 1024.0f) + LN_EPS);
#pragma unroll
    for (int i4 = 0; i4 < 4; ++i4) { const float4 g4 = *(const float4*)(g + 16 * lane + 4 * i4), b4 = *(const float4*)(b + 16 * lane + 4 * i4);
        y[4 * i4] = (y[4 * i4] - mu) * rstd * g4.x + b4.x; y[4 * i4 + 1] = (y[4 * i4 + 1] - mu) * rstd * g4.y + b4.y; y[4 * i4 + 2] = (y[4 * i4 + 2] - mu) * rstd * g4.z + b4.z; y[4 * i4 + 3] = (y[4 * i4 + 3] - mu) * rstd * g4.w + b4.w; }
}
DEVI void combine_row(float (&y)[16], const float* h, const unsigned short* Y0, const unsigned short* Y1, float g0, float g1, int lane) {
    const uint4 a0 = *(const uint4*)(Y0 + 16 * lane), a1 = *(const uint4*)(Y0 + 16 * lane + 8), b0 = *(const uint4*)(Y1 + 16 * lane), b1 = *(const uint4*)(Y1 + 16 * lane + 8);
    const unsigned aw[8] = {a0.x, a0.y, a0.z, a0.w, a1.x, a1.y, a1.z, a1.w}, bw[8] = {b0.x, b0.y, b0.z, b0.w, b1.x, b1.y, b1.z, b1.w};
#pragma unroll
    for (int i4 = 0; i4 < 4; ++i4) { const float4 hv = *(const float4*)(h + 16 * lane + 4 * i4);
        y[4 * i4]     = DN_ALPHA * hv.x + (g0 * __uint_as_float(aw[2 * i4] << 16) + g1 * __uint_as_float(bw[2 * i4] << 16));
        y[4 * i4 + 1] = DN_ALPHA * hv.y + (g0 * __uint_as_float(aw[2 * i4] & 0xFFFF0000u) + g1 * __uint_as_float(bw[2 * i4] & 0xFFFF0000u));
        y[4 * i4 + 2] = DN_ALPHA * hv.z + (g0 * __uint_as_float(aw[2 * i4 + 1] << 16) + g1 * __uint_as_float(bw[2 * i4 + 1] << 16));
        y[4 * i4 + 3] = DN_ALPHA * hv.w + (g0 * __uint_as_float(aw[2 * i4 + 1] & 0xFFFF0000u) + g1 * __uint_as_float(bw[2 * i4 + 1] & 0xFFFF0000u)); }
}
typedef float f32x4v __attribute__((ext_vector_type(4)));
DEVI void ln_route_block(int tb, int ntok, const float* Zsrc, float* Hdst, const float* g, const float* b, const float4* __restrict__ Wr, const float* bg, const float* be,
                         int* eid, float* gw, unsigned* counts, float* sm) {
    const int tid = otid(), lane = tid & 63, wave = tid >> 6;
    for (int i = 0; i < 8; ++i) { const int tl = wave * 8 + i;
        if (tl < ntok) { const size_t t = (size_t)(tb + tl); float y[16];
#pragma unroll
            for (int i4 = 0; i4 < 4; ++i4) { const float4 v = *(const float4*)(Zsrc + t * D + 16 * lane + 4 * i4); y[4 * i4] = v.x; y[4 * i4 + 1] = v.y; y[4 * i4 + 2] = v.z; y[4 * i4 + 3] = v.w; }
            ln_row1024v(y, g, b, lane);
#pragma unroll
            for (int i4 = 0; i4 < 4; ++i4) *(float4*)(Hdst + t * D + 16 * lane + 4 * i4) = make_float4(y[4 * i4], y[4 * i4 + 1], y[4 * i4 + 2], y[4 * i4 + 3]); } }
    asm volatile("s_waitcnt vmcnt(0)" ::: "memory");
    __syncthreads();
    const int grp = wave & 3, khalf = wave >> 2;
    if (grp * 16 < ntok) {
        const int t0 = tb + 16 * grp, row = lane & 15, kg = lane >> 4;
        f32x4v acc[3];
#pragma unroll
        for (int ct = 0; ct < 3; ++ct) acc[ct] = (f32x4v){0.f, 0.f, 0.f, 0.f};
        const float* arow = Hdst + (size_t)(t0 + row) * D + 4 * kg;
#pragma unroll 4
        for (int sstep = 32 * khalf; sstep < 32 * khalf + 32; ++sstep) {
            const float4 a4 = *(const float4*)(arow + 16 * sstep);
#pragma unroll
            for (int ct = 0; ct < 3; ++ct) { const float4 b4 = Wr[(sstep * 3 + ct) * 64 + lane];
                acc[ct] = __builtin_amdgcn_mfma_f32_16x16x4f32(a4.x, b4.x, acc[ct], 0, 0, 0); acc[ct] = __builtin_amdgcn_mfma_f32_16x16x4f32(a4.y, b4.y, acc[ct], 0, 0, 0);
                acc[ct] = __builtin_amdgcn_mfma_f32_16x16x4f32(a4.z, b4.z, acc[ct], 0, 0, 0); acc[ct] = __builtin_amdgcn_mfma_f32_16x16x4f32(a4.w, b4.w, acc[ct], 0, 0, 0); }
        }
        float* Lg = sm + (khalf * 4 + grp) * 16 * 48;
#pragma unroll
        for (int ct = 0; ct < 3; ++ct)
#pragma unroll
            for (int j = 0; j < 4; ++j) Lg[(4 * kg + j) * 48 + 16 * ct + row] = acc[ct][j];
    }
    __syncthreads();
    if (wave < 4 && wave * 16 < ntok) {
        const int t0 = tb + 16 * wave;
        if (lane < 16) {
            const int t = t0 + lane; const float* lgA = sm + wave * 16 * 48 + lane * 48; const float* lgB = lgA + 4 * 16 * 48;
            float lg[36];
#pragma unroll
            for (int j = 0; j < 36; ++j) lg[j] = lgA[j] + lgB[j];
            float gl[4]; int gsel = 0;
#pragma unroll
            for (int j = 0; j < 4; ++j) gl[j] = lg[j] + bg[j];
#pragma unroll
            for (int j = 1; j < 4; ++j) if (gl[j] > gl[gsel]) gsel = j;
            float den = 0.f;
#pragma unroll
            for (int j = 0; j < 4; ++j) den += expf(gl[j] - gl[gsel]);
            const float gp = 1.0f / den;
            float el[8];
#pragma unroll
            for (int j = 0; j < 8; ++j) { float v = lg[4 + j];
#pragma unroll
                for (int gg = 1; gg < 4; ++gg) v = (gg == gsel) ? lg[4 + gg * 8 + j] : v;
                el[j] = v + be[gsel * 8 + j]; }
            int i1 = 0;
#pragma unroll
            for (int j = 1; j < 8; ++j) if (el[j] > el[i1]) i1 = j;
            int i2 = (i1 == 0) ? 1 : 0;
#pragma unroll
            for (int j = 0; j < 8; ++j) if (j != i1 && el[j] > el[i2]) i2 = j;
            float e1v = el[0], e2v = el[0];
#pragma unroll
            for (int j = 0; j < 8; ++j) { e1v = (j == i1) ? el[j] : e1v; e2v = (j == i2) ? el[j] : e2v; }
            const float ex = expf(e2v - e1v);
            const float p1 = 1.0f / (1.0f + ex), p2 = ex / (1.0f + ex);
            const int e1 = gsel * 8 + i1, e2 = gsel * 8 + i2;
            eid[2 * t] = e1; eid[2 * t + 1] = e2; gw[2 * t] = gp * p1; gw[2 * t + 1] = gp * p2;
            atomicAdd(&counts[e1], 1u); atomicAdd(&counts[e2], 1u);
        }
    }
    __syncthreads();
}

using pg8::f32x4; using pg8::Unit; typedef unsigned short bf16_t;
DEVI float bf2f(unsigned short b) { return __uint_as_float(((unsigned)b) << 16); }
DEVI float bflo(unsigned w) { return __uint_as_float(w << 16); }
DEVI float bfhi(unsigned w) { return __uint_as_float(w & 0xFFFF0000u); }
DEVI unsigned cvt_pk_bf16(float lo, float hi) { unsigned r; asm volatile("v_cvt_pk_bf16_f32 %0, %1, %2" : "=v"(r) : "v"(lo), "v"(hi)); return r; }
DEVI uint2 pack4(const f32x4 v) { return make_uint2(cvt_pk_bf16(v[0], v[1]), cvt_pk_bf16(v[2], v[3])); }
DEVI float fsigm(float x) { return __builtin_amdgcn_rcpf(1.0f + __expf(-x)); }
DEVI unsigned pack4_fp8(const f32x4 v) { int w = __builtin_amdgcn_cvt_pk_fp8_f32(v[0], v[1], 0, false); w = __builtin_amdgcn_cvt_pk_fp8_f32(v[2], v[3], w, true); return (unsigned)w; }

DEVI int in0_srccol(int n) {
    if (n < 1024) { const int G = n >> 5, nn = (n >> 4) & 1, i = n & 15; return (nn ? OFF_AGATE : OFF_AVAL) + 16 * G + i; }
    if (n < 2048 || (n >= 2560 && n < 3072)) {
        const int base = n < 1536 ? OFF_Q : n < 2048 ? OFF_K : OFF_QI; const int loc = n & 511;
        const int G = loc >> 5, nn = (loc >> 4) & 1, i = loc & 15; return base + 64 * (G >> 1) + 32 * nn + 16 * (G & 1) + i; }
    if (n < 2560) return OFF_V + (n - 2048);
    if (n < 3136) { const int loc = n - 3072; const int G = loc >> 5, nn = (loc >> 4) & 1, i = loc & 15; return OFF_KI + 32 * nn + 16 * G + i; }
    if (n < 3144) return OFF_WI + (n - 3136);
    return -1;
}
struct EpiIn0 {
    static constexpr bool PERM = false, AFTER_DRAIN = false;
    bf16_t* GLU; bf16_t* KI; float* WI; const float* ropeC; const float* ropeS; unsigned char* KV8;
    DEVI void operator()(const f32x4 (&acc)[2][2][4][2], const Unit& u, int wr, int wc, int fr, int fq) const {
        const int pn = u.pn; const int rbase = u.pm * 256 + wr * 64 + fr;
        if (pn < 4) {
#pragma unroll
            for (int ai = 0; ai < 2; ++ai)
#pragma unroll
                for (int m = 0; m < 4; ++m) { const size_t row = rbase + ai * 128 + m * 16;
#pragma unroll
                    for (int bj = 0; bj < 2; ++bj) { const int G = 8 * pn + 4 * bj + wc; const f32x4 v = acc[ai][bj][m][0], g = acc[ai][bj][m][1]; f32x4 o;
#pragma unroll
                        for (int j = 0; j < 4; ++j) o[j] = v[j] * fsigm(g[j]);
                        *(uint2*)(GLU + row * 512 + 16 * G + 4 * fq) = pack4(o); } }
        } else if (pn == 8 || pn == 9) {
#pragma unroll
            for (int ai = 0; ai < 2; ++ai)
#pragma unroll
                for (int m = 0; m < 4; ++m) { const size_t row = rbase + ai * 128 + m * 16;
#pragma unroll
                    for (int bj = 0; bj < 2; ++bj)
#pragma unroll
                        for (int n = 0; n < 2; ++n) { const int col = 256 * (pn - 8) + 128 * bj + 32 * wc + 16 * n + 4 * fq;
                            *(unsigned*)(KV8 + row * 1024 + (size_t)(col >> 3) * 16 + 8 + (col & 7)) = pack4_fp8(acc[ai][bj][m][n]); } }
        } else if (pn == 12) {
            if (wc < 2) { const int d0 = 16 * wc + 4 * fq;
#pragma unroll
                for (int ai = 0; ai < 2; ++ai)
#pragma unroll
                    for (int m = 0; m < 4; ++m) { const size_t row = rbase + ai * 128 + m * 16;
                        const f32x4 c = *(const f32x4*)(ropeC + row * 32 + d0), s = *(const f32x4*)(ropeS + row * 32 + d0);
                        const f32x4 t1 = acc[ai][0][m][0], t2 = acc[ai][0][m][1];
                        *(uint2*)(KI + row * 64 + d0) = pack4(t1 * c - t2 * s); *(uint2*)(KI + row * 64 + 32 + d0) = pack4(t1 * s + t2 * c); }
            } else if (wc == 2 && fq < 2) {
#pragma unroll
                for (int ai = 0; ai < 2; ++ai)
#pragma unroll
                    for (int m = 0; m < 4; ++m) { const size_t row = rbase + ai * 128 + m * 16; *(f32x4*)(WI + row * 8 + 4 * fq) = acc[ai][0][m][0] * 0.35355339059327373f; }
            }
        } else {
            bf16_t* dst = GLU + (size_t)(pn < 6 ? 1 : pn < 8 ? 2 : 4) * LP * 512; const int pl = pn & 1; const int d0 = 16 * (wc & 1) + 4 * fq;
#pragma unroll
            for (int ai = 0; ai < 2; ++ai)
#pragma unroll
                for (int m = 0; m < 4; ++m) { const size_t row = rbase + ai * 128 + m * 16;
                    const f32x4 c = *(const f32x4*)(ropeC + row * 32 + d0), s = *(const f32x4*)(ropeS + row * 32 + d0);
#pragma unroll
                    for (int bj = 0; bj < 2; ++bj) { const int hh = 4 * pl + 2 * bj + (wc >> 1); const f32x4 t1 = acc[ai][bj][m][0], t2 = acc[ai][bj][m][1];
                        if (pn == 6 || pn == 7) { const int da = 64 * hh + d0, db = da + 32;
                            *(unsigned*)(KV8 + row * 1024 + (size_t)(da >> 3) * 16 + (da & 7)) = pack4_fp8(t1 * c - t2 * s); *(unsigned*)(KV8 + row * 1024 + (size_t)(db >> 3) * 16 + (db & 7)) = pack4_fp8(t1 * s + t2 * c);
                        } else { *(uint2*)(dst + row * 512 + 64 * hh + d0) = pack4(t1 * c - t2 * s); *(uint2*)(dst + row * 512 + 64 * hh + 32 + d0) = pack4(t1 * s + t2 * c); } } }
        }
    }
};
struct EpiRes0 {
    static constexpr bool PERM = false, AFTER_DRAIN = false;
    const float* x; const float* meta; float* Z;
    DEVI void operator()(const f32x4 (&acc)[2][2][4][2], const Unit& u, int wr, int wc, int fr, int fq) const {
        const int rbase = u.pm * 256 + wr * 64 + fr, cbase = u.pn * 256 + wc * 32 + 4 * fq;
#pragma unroll
        for (int ai = 0; ai < 2; ++ai)
#pragma unroll
            for (int m = 0; m < 4; ++m) { const int row = rbase + ai * 128 + m * 16;
                if (row < L) { const float* rs = row < NMETA ? meta + (size_t)row * D : x + (size_t)(row - NMETA) * D;
#pragma unroll
                    for (int bj = 0; bj < 2; ++bj)
#pragma unroll
                        for (int n = 0; n < 2; ++n) { const int col = cbase + 128 * bj + 16 * n; const f32x4 r4 = *(const f32x4*)(rs + col); *(f32x4*)(Z + (size_t)row * D + col) = r4 * DN_ALPHA + acc[ai][bj][m][n]; } } }
    }
};
struct EpiGateUp {
    static constexpr bool PERM = false, AFTER_DRAIN = false;
    bf16_t* Hm;
    DEVI void operator()(const f32x4 (&acc)[2][2][4][2], const Unit& u, int wr, int wc, int fr, int fq) const {
        const int pl = u.pn & 3; const int rbase = u.pm * 256 + wr * 64 + fr;
#pragma unroll
        for (int ai = 0; ai < 2; ++ai)
#pragma unroll
            for (int m = 0; m < 4; ++m) { const size_t row = rbase + ai * 128 + m * 16;
#pragma unroll
                for (int bj = 0; bj < 2; ++bj) { const int G = 8 * pl + 4 * bj + wc; const f32x4 g = acc[ai][bj][m][0], up = acc[ai][bj][m][1]; f32x4 o;
#pragma unroll
                    for (int j = 0; j < 4; ++j) o[j] = g[j] * fsigm(g[j]) * up[j];
                    *(uint2*)(Hm + row * 512 + 16 * G + 4 * fq) = pack4(o); } }
    }
};
struct EpiDown {
    static constexpr bool PERM = false, AFTER_DRAIN = false;
    bf16_t* Y;
    DEVI void operator()(const f32x4 (&acc)[2][2][4][2], const Unit& u, int wr, int wc, int fr, int fq) const {
        const int pl = u.pn & 3; const int rbase = u.pm * 256 + wr * 64 + fr, cbase = pl * 256 + wc * 32 + 4 * fq;
#pragma unroll
        for (int ai = 0; ai < 2; ++ai)
#pragma unroll
            for (int m = 0; m < 4; ++m) { const size_t row = rbase + ai * 128 + m * 16;
#pragma unroll
                for (int bj = 0; bj < 2; ++bj)
#pragma unroll
                    for (int n = 0; n < 2; ++n) *(uint2*)(Y + row * 1024 + cbase + 128 * bj + 16 * n) = pack4(acc[ai][bj][m][n]); }
    }
};
struct MoeOrder {
    const int* mt; int nunits, G, c;
    DEVI void init(const int* t, int G_, int c_) { mt = t; nunits = t[0] * 4; G = G_; c = c_; }
    DEVI bool next(int i, Unit& u) const { const int li = i * G + c; if (li >= nunits) return false; const int ti = li >> 2; u.pm = ti; u.pn = mt[4 + ti] * 4 + (li & 3); return true; }
    DEVI void a_ready(const Unit&) const {}
    DEVI void done(const Unit&) const {}
};

template <class F> DEVI void tr_tile(bf16_t* dst, int K, int n0, int k0, F src, float* sm) {
    const int tid = otid();
    __syncthreads();
    { const int nn = tid & 63, kb = tid >> 6;
#pragma unroll
      for (int p = 0; p < 8; ++p) { const int kk = kb + 8 * p; sm[kk * 65 + nn] = src(n0 + nn, k0 + kk); } }
    __syncthreads();
    { const int nn = tid >> 3, kq = (tid & 7) * 8; float v[8];
#pragma unroll
      for (int j = 0; j < 8; ++j) v[j] = sm[(kq + j) * 65 + nn];
      uint4 w; w.x = cvt_pk_bf16(v[0], v[1]); w.y = cvt_pk_bf16(v[2], v[3]); w.z = cvt_pk_bf16(v[4], v[5]); w.w = cvt_pk_bf16(v[6], v[7]);
      *(uint4*)(dst + (size_t)(n0 + nn) * K + k0 + kq) = w; }
}

struct TrJob { bf16_t* dst; const float* s0; const float* s1; int K, n0, k0, ld, mode; };
DEVI float tr_src(const TrJob& J, int n, int k) {
    if (J.mode == 0) return __builtin_nontemporal_load(J.s0 + (size_t)k * J.ld + n);
    if (J.mode == 1) { const int sc = in0_srccol(n); return sc < 0 ? 0.f : __builtin_nontemporal_load(J.s0 + (size_t)k * IN_AB + sc); }
    const int ch = (n >> 5) * 16 + (n & 15); return ((n >> 4) & 1) ? __builtin_nontemporal_load(J.s1 + (size_t)k * DE + ch) : __builtin_nontemporal_load(J.s0 + (size_t)k * DE + ch);
}
DEVI void tr_fetch(const TrJob& J, float (&v)[8]) {
    const int tid = otid(), nn = tid & 63, kb = tid >> 6;
#pragma unroll
    for (int p = 0; p < 8; ++p) v[p] = tr_src(J, J.n0 + nn, J.k0 + kb + 8 * p);
}
DEVI void tr_commit(const TrJob& J, const float (&v)[8], float* sm) {
    const int tid = otid();
    __syncthreads();
    { const int nn = tid & 63, kb = tid >> 6;
#pragma unroll
      for (int p = 0; p < 8; ++p) sm[(kb + 8 * p) * 65 + nn] = v[p]; }
    __syncthreads();
    { const int nn = tid >> 3, kq = (tid & 7) * 8; float x[8];
#pragma unroll
      for (int j = 0; j < 8; ++j) x[j] = sm[(kq + j) * 65 + nn];
      uint4 w; w.x = cvt_pk_bf16(x[0], x[1]); w.y = cvt_pk_bf16(x[2], x[3]); w.z = cvt_pk_bf16(x[4], x[5]); w.w = cvt_pk_bf16(x[6], x[7]);
      *(uint4*)(J.dst + (size_t)(J.n0 + nn) * J.K + J.k0 + kq) = w; }
}
template <class Dec> DEVI void tr_run(int njobs, Dec dec, float* sm) {
    int j = blockIdx.x; const int G = gridDim.x;
    TrJob Ja{}, Jb{}; float va[8], vb[8];
    if (j < njobs) { Ja = dec(j); tr_fetch(Ja, va); }
    while (j < njobs) {
        int jn = j + G; if (jn < njobs) { Jb = dec(jn); tr_fetch(Jb, vb); }
        tr_commit(Ja, va, sm);
        j = jn; if (j >= njobs) break;
        jn = j + G; if (jn < njobs) { Ja = dec(jn); tr_fetch(Ja, va); }
        tr_commit(Jb, vb, sm);
        j = jn;
    }
    __syncthreads();
}

DEVI void moe_dispatch_mfma(const float* H, const int* eid, const unsigned* counts, unsigned* cursor, int* slot, int* mtiles, bf16_t* Xperm, int* sm_i, int gwave, int nwaves, int lane, int p_begin) {
    if (otid() == 0) { int o = 0; for (int e = 0; e < NE; ++e) { sm_i[e] = o; o += (((int)counts[e] + 255) >> 8) << 8; } }
    __syncthreads();
    for (int pb = p_begin + gwave * 16; pb < NPAIR; pb += nwaves * 16) {
        int sl = 0;
        if (lane < 16 && pb + lane < NPAIR) { const int e = eid[pb + lane]; sl = sm_i[e] + (int)atomicAdd(&cursor[e], 1u); slot[pb + lane] = sl; }
#pragma unroll 4
        for (int k = 0; k < 16; ++k) { const int p = pb + k; if (p >= NPAIR) break;
            const int s = __shfl(sl, k);
            const float4* src = (const float4*)(H + (size_t)(p >> 1) * D); uint2* dst = (uint2*)(Xperm + (size_t)s * D);
#pragma unroll
            for (int r = 0; r < 4; ++r) { const float4 v = src[lane + 64 * r]; dst[lane + 64 * r] = make_uint2(cvt_pk_bf16(v.x, v.y), cvt_pk_bf16(v.z, v.w)); } }
    }
    if (blockIdx.x == 0 && otid() == 0) { int n = 0; for (int e = 0; e < NE; ++e) { const int nt = ((int)counts[e] + 255) >> 8; for (int i = 0; i < nt; ++i) mtiles[4 + n++] = e; } mtiles[0] = n; }
    __syncthreads();
}

DEVI float gelu_fast(float x) { return x * fsigm(1.5957691216057308f * (x + 0.044715f * x * x * x)); }
struct EpiIn1 {
    static constexpr bool PERM = false, AFTER_DRAIN = false;
    bf16_t* G;
    DEVI void operator()(const f32x4 (&acc)[2][2][4][2], const Unit& u, int wr, int wc, int fr, int fq) const {
        const int pn = u.pn; const bool is_gate = pn < 5; const int rbase = u.pm * 256 + wr * 64 + fr;
        bf16_t* dst = G + (is_gate ? (size_t)0 : (size_t)LP * RNN_W) + (size_t)((is_gate ? pn : pn - 5) * 256 + wc * 32 + 4 * fq);
#pragma unroll
        for (int ai = 0; ai < 2; ++ai)
#pragma unroll
            for (int m = 0; m < 4; ++m) { const size_t row = rbase + ai * 128 + m * 16;
#pragma unroll
                for (int bj = 0; bj < 2; ++bj)
#pragma unroll
                    for (int n = 0; n < 2; ++n) { f32x4 v = acc[ai][bj][m][n];
                        if (is_gate) {
#pragma unroll
                            for (int j = 0; j < 4; ++j) v[j] = gelu_fast(v[j]); }
                        *(uint2*)(dst + row * RNN_W + 128 * bj + 16 * n) = pack4(v); } }
    }
};
struct EpiRes1 {
    static constexpr bool PERM = false, AFTER_DRAIN = false;
    const float* R; float* Z;
    DEVI void operator()(const f32x4 (&acc)[2][2][4][2], const Unit& u, int wr, int wc, int fr, int fq) const {
        const int rbase = u.pm * 256 + wr * 64 + fr, cbase = u.pn * 256 + wc * 32 + 4 * fq;
#pragma unroll
        for (int ai = 0; ai < 2; ++ai)
#pragma unroll
            for (int m = 0; m < 4; ++m) { const size_t row = rbase + ai * 128 + m * 16;
#pragma unroll
                for (int bj = 0; bj < 2; ++bj)
#pragma unroll
                    for (int n = 0; n < 2; ++n) { const int col = cbase + 128 * bj + 16 * n; const f32x4 r4 = *(const f32x4*)(R + row * D + col); *(f32x4*)(Z + row * D + col) = r4 * DN_ALPHA + acc[ai][bj][m][n]; } }
    }
};

typedef short bf16x8_t __attribute__((ext_vector_type(8)));
struct RgIn { uint4 x[2][4]; };
DEVI void rglru_fetch(int c, int ch0, const bf16_t* __restrict__ XR, int tid, RgIn& R) {
    const int c8 = tid & 15, tr = tid >> 4;
#pragma unroll
    for (int half = 0; half < 2; ++half) { const int t = c * 64 + tr + 32 * half;
#pragma unroll
        for (int j = 0; j < 4; ++j) { const int tt = t - 3 + j; R.x[half][j] = tt >= 0 ? *(const uint4*)(XR + (size_t)tt * RNN_W + ch0 + 8 * c8) : make_uint4(0u, 0u, 0u, 0u); } }
}
template <bool FINAL>
DEVI void rglru_unit(int c, int nb, const RgIn& R, const bf16x8_t (&fa)[4], const bf16x8_t (&fx)[4], float bav, float bxv, float sp,
                     const bf16_t* __restrict__ GATEg, float* __restrict__ Aend, float* __restrict__ Hend, const float* __restrict__ CIN, bf16_t* __restrict__ YY,
                     unsigned char* lds, int tid) {
    const int lane = tid & 63, w = tid >> 6, col = lane & 15, quad = lane >> 4;
    bf16_t* xcb = (bf16_t*)lds;
    float* xcf = (float*)(lds + 64 * 136 * 2);
    const float* cwl = (const float*)(lds + 64 * 136 * 2 + 64 * 132 * 4);
    const int t0 = c * 64, ch0 = nb * RNN_BW, ch = ch0 + 16 * w + col;
    const float cinv = FINAL ? CIN[(size_t)ch * CP + c] : 0.f;
    const int c8 = tid & 15, tr = tid >> 4;
    uint4 g[2];
    if (FINAL) {
#pragma unroll
        for (int half = 0; half < 2; ++half) { const int t = t0 + tr + 32 * half; g[half] = (t < L) ? *(const uint4*)(GATEg + (size_t)t * RNN_W + ch0 + 8 * c8) : make_uint4(0u, 0u, 0u, 0u); } }
    __syncthreads();
    {
        float bv[8];
        { const float4 b0 = *(const float4*)(cwl + 512 + 8 * c8), b1 = *(const float4*)(cwl + 512 + 8 * c8 + 4); bv[0] = b0.x; bv[1] = b0.y; bv[2] = b0.z; bv[3] = b0.w; bv[4] = b1.x; bv[5] = b1.y; bv[6] = b1.z; bv[7] = b1.w; }
#pragma unroll
        for (int half = 0; half < 2; ++half) { const int tl = tr + 32 * half;
            float v[8];
#pragma unroll
            for (int i = 0; i < 8; ++i) v[i] = bv[i];
#pragma unroll
            for (int j = 0; j < 4; ++j) { const uint4 xv = R.x[half][j];
                const float4 w0 = *(const float4*)(cwl + j * 128 + 8 * c8), w1 = *(const float4*)(cwl + j * 128 + 8 * c8 + 4);
                v[0] += w0.x * bflo(xv.x); v[1] += w0.y * bfhi(xv.x); v[2] += w0.z * bflo(xv.y); v[3] += w0.w * bfhi(xv.y);
                v[4] += w1.x * bflo(xv.z); v[5] += w1.y * bfhi(xv.z); v[6] += w1.z * bflo(xv.w); v[7] += w1.w * bfhi(xv.w); }
            *(float4*)(xcf + tl * 132 + 8 * c8) = make_float4(v[0], v[1], v[2], v[3]); *(float4*)(xcf + tl * 132 + 8 * c8 + 4) = make_float4(v[4], v[5], v[6], v[7]);
            uint4 pk; pk.x = cvt_pk_bf16(v[0], v[1]); pk.y = cvt_pk_bf16(v[2], v[3]); pk.z = cvt_pk_bf16(v[4], v[5]); pk.w = cvt_pk_bf16(v[6], v[7]);
            *(uint4*)(xcb + (16 * ((tl >> 2) & 3) + 4 * (tl >> 4) + (tl & 3)) * 136 + 8 * c8) = pk; }
    }
    __syncthreads();
    f32x4 ca[4], cx[4];
#pragma unroll
    for (int mt = 0; mt < 4; ++mt) { ca[mt] = (f32x4){0.f, 0.f, 0.f, 0.f}; cx[mt] = (f32x4){0.f, 0.f, 0.f, 0.f};
#pragma unroll
        for (int ks = 0; ks < 4; ++ks) { const bf16x8_t af = *(const bf16x8_t*)(xcb + (16 * mt + col) * 136 + 32 * ks + 8 * quad);
            ca[mt] = __builtin_amdgcn_mfma_f32_16x16x32_bf16(af, fa[ks], ca[mt], 0, 0, 0);
            cx[mt] = __builtin_amdgcn_mfma_f32_16x16x32_bf16(af, fx[ks], cx[mt], 0, 0, 0); } }
    float av[4][4], uv[4][4]; float A = 1.f, H = 0.f;
#pragma unroll
    for (int mt = 0; mt < 4; ++mt) {
#pragma unroll
        for (int j = 0; j < 4; ++j) { const int tl = 16 * quad + 4 * mt + j;
            const float xcv = xcf[tl * 132 + 16 * w + col];
            const float r = fsigm(ca[mt][j] + bav), ig = fsigm(cx[mt][j] + bxv);
            const float la = -8.0f * r * sp;
            const float x2 = 2.0f * la;
            float em1 = x2 * (1.0f + x2 * (0.5f + x2 * (0.16666667f + x2 * (0.041666668f + x2 * (0.0083333338f + x2 * (0.0013888889f + x2 * 0.0001984127f))))));
            if (x2 < -0.5f) em1 = expm1f(x2);
            float a_ = __expf(la), u_ = __builtin_amdgcn_sqrtf(-em1) * (ig * xcv);
            if (t0 + tl >= L) { a_ = 1.f; u_ = 0.f; }
            av[mt][j] = a_; uv[mt][j] = u_; H = a_ * H + u_; A *= a_; } }
    float carry = cinv, prod = 1.f, hin = 0.f;
#pragma unroll
    for (int q = 0; q < 4; ++q) {
        if (quad == q) hin = carry;
        const float nw = A * carry + H, np = A * prod;
        carry = __shfl(nw, q * 16 + col); prod = __shfl(np, q * 16 + col); }
    if (!FINAL) {
        if (quad == 0) { Aend[(size_t)ch * CP + c] = prod; Hend[(size_t)ch * CP + c] = carry; }
    } else {
        float h = hin;
#pragma unroll
        for (int mt = 0; mt < 4; ++mt)
#pragma unroll
            for (int j = 0; j < 4; ++j) { h = av[mt][j] * h + uv[mt][j]; xcf[(16 * quad + 4 * mt + j) * 132 + 16 * w + col] = h; }
        __syncthreads();
#pragma unroll
        for (int half = 0; half < 2; ++half) { const int tl = tr + 32 * half, t = t0 + tl;
            if (t >= NMETA && t < L) {
                const float4 h0 = *(const float4*)(xcf + tl * 132 + 8 * c8), h1 = *(const float4*)(xcf + tl * 132 + 8 * c8 + 4);
                const uint4 gg = g[half];
                uint4 pk; pk.x = cvt_pk_bf16(bflo(gg.x) * h0.x, bfhi(gg.x) * h0.y); pk.y = cvt_pk_bf16(bflo(gg.y) * h0.z, bfhi(gg.y) * h0.w);
                pk.z = cvt_pk_bf16(bflo(gg.z) * h1.x, bfhi(gg.z) * h1.y); pk.w = cvt_pk_bf16(bflo(gg.w) * h1.z, bfhi(gg.w) * h1.w);
                *(uint4*)(YY + (size_t)t * RNN_W + ch0 + 8 * c8) = pk; } }
    }
}
template <bool FINAL>
DEVI void rglru_phase(const bf16_t* __restrict__ XR, const bf16_t* __restrict__ GATEg, const bf16_t* __restrict__ Wta, const bf16_t* __restrict__ Wtx,
                      const float* __restrict__ cw, const float* __restrict__ cb, const float* __restrict__ ba, const float* __restrict__ bx, const float* __restrict__ lam,
                      float* __restrict__ Aend, float* __restrict__ Hend, const float* __restrict__ CIN, bf16_t* __restrict__ YY, unsigned char* lds) {
    const int tid = otid(), lane = tid & 63, w = tid >> 6, col = lane & 15, quad = lane >> 4;
    const int G = gridDim.x, nb = blockIdx.x % RNN_NB, rank = blockIdx.x / RNN_NB, nblk = (G - nb + RNN_NB - 1) / RNN_NB;
    const int ch0 = nb * RNN_BW, ch = ch0 + 16 * w + col;
    float* cwl = (float*)(lds + 64 * 136 * 2 + 64 * 132 * 4);
    __syncthreads();
    for (int i = tid; i < 640; i += NTHREADS) cwl[i] = i < 512 ? cw[(i >> 7) * RNN_W + ch0 + (i & 127)] : cb[ch0 + (i - 512)];
    bf16x8_t fa[4], fx[4];
    { const size_t wrow = ((size_t)nb * 128 + 16 * w + col) * 128 + 8 * quad;
#pragma unroll
      for (int ks = 0; ks < 4; ++ks) { fa[ks] = *(const bf16x8_t*)(Wta + wrow + 32 * ks); fx[ks] = *(const bf16x8_t*)(Wtx + wrow + 32 * ks); } }
    const float bav = ba[ch], bxv = bx[ch], sp = log1pf(expf(-lam[ch]));
    RgIn Ra, Rb;
    int c = rank;
    if (c < NCHUNK) rglru_fetch(c, ch0, XR, tid, Ra);
    while (c < NCHUNK) {
        int cn = c + nblk;
        if (cn < NCHUNK) rglru_fetch(cn, ch0, XR, tid, Rb);
        rglru_unit<FINAL>(c, nb, Ra, fa, fx, bav, bxv, sp, GATEg, Aend, Hend, CIN, YY, lds, tid);
        c = cn; if (c >= NCHUNK) break;
        cn = c + nblk;
        if (cn < NCHUNK) rglru_fetch(cn, ch0, XR, tid, Ra);
        rglru_unit<FINAL>(c, nb, Rb, fa, fx, bav, bxv, sp, GATEg, Aend, Hend, CIN, YY, lds, tid);
        c = cn;
    }
    __syncthreads();
}

constexpr int SW = 544;
constexpr int CB = 512;
constexpr int NTILE = L / 16;
typedef float f32x16 __attribute__((ext_vector_type(16)));
typedef float f32x2v __attribute__((ext_vector_type(2)));
constexpr int HROW = 2112;
constexpr int IL_HIST = 0, IL_CKEY = 0, IL_CIDX = 16 * CB * 4, IL_HIST2 = 2 * 16 * CB * 4, IL_ROWS = IL_HIST2 + 16 * 256 * 4, IL_WI = 16 * HROW * 4, IL_QST = IL_WI + 512, IL_QST2 = IL_QST + 256, IL_CCNT = IL_QST2 + 256, IL_FLAG = IL_CCNT + 64;
static_assert(IL_ROWS + 16 * SW * 4 <= IL_WI && IL_FLAG + 64 <= LDS_BYTES - 16, "indexer LDS");

DEVI float relu_i(float x) { const int v = __float_as_int(x); return __int_as_float(v > 0 ? v : 0); }
DEVI int hpos(unsigned w) { return (int)(w + (w >> 5)); }
template <int PASS, bool L0>
DEVI void idx_sweep(int q0, int nkb, int wave, int lane, const bf16x8_t (&Af)[4][4], const bf16_t* __restrict__ KI, unsigned char* lds, unsigned* __restrict__ SELM) {
    const int l31 = lane & 31, h2 = lane >> 5;
    unsigned* hist = (unsigned*)(lds + IL_HIST);
    const float* wiL = (const float*)(lds + IL_WI);
    const uint4* qst = (const uint4*)(lds + IL_QST);
    const uint4* qst2 = (const uint4*)(lds + IL_QST2);
    unsigned* ckey = (unsigned*)(lds + IL_CKEY); unsigned* cidx = (unsigned*)(lds + IL_CIDX); unsigned* ccnt = (unsigned*)(lds + IL_CCNT); unsigned* rows = (unsigned*)(lds + IL_ROWS);
    const bf16_t* kp = KI + (size_t)l31 * 64 + 8 * h2;
    bf16x8_t Bn[4];
    if (wave < nkb) {
#pragma unroll
        for (int ks = 0; ks < 4; ++ks) Bn[ks] = *(const bf16x8_t*)(kp + (size_t)wave * 2048 + 16 * ks); }
    for (int kb = wave; kb < nkb; kb += 8) {
        const int s = kb * 32 + l31;
        bf16x8_t Bf[4];
#pragma unroll
        for (int ks = 0; ks < 4; ++ks) Bf[ks] = Bn[ks];
        if (kb + 8 < nkb) {
#pragma unroll
            for (int ks = 0; ks < 4; ++ks) Bn[ks] = *(const bf16x8_t*)(kp + (size_t)(kb + 8) * 2048 + 16 * ks); }
        f32x16 acc[4];
#pragma unroll
        for (int rb = 0; rb < 4; ++rb) {
#pragma unroll
            for (int i = 0; i < 16; ++i) acc[rb][i] = 0.f; }
#pragma unroll
        for (int ks = 0; ks < 4; ++ks)
#pragma unroll
            for (int rb = 0; rb < 4; ++rb) acc[rb] = __builtin_amdgcn_mfma_f32_32x32x16_bf16(Af[rb][ks], Bf[ks], acc[rb], 0, 0, 0);
        const bool edge = kb * 32 + 31 > q0;
#pragma unroll
        for (int rb = 0; rb < 4; ++rb) {
            const int qa = 4 * rb + 2 * h2;
            float4 w[2][2]; uint4 st[2];
#pragma unroll
            for (int e = 0; e < 2; ++e) { w[e][0] = *(const float4*)(wiL + (qa + e) * 8); w[e][1] = *(const float4*)(wiL + (qa + e) * 8 + 4);
                if (PASS == 2) st[e] = qst2[qa + e]; else if (!L0) st[e] = qst[qa + e]; }
#pragma unroll
            for (int e = 0; e < 2; ++e) {
                const int qs = qa + e;
                f32x2v s2 = (f32x2v){relu_i(acc[rb][8 * e + 0]), relu_i(acc[rb][8 * e + 1])} * (f32x2v){w[e][0].x, w[e][0].y};
                s2 = (f32x2v){relu_i(acc[rb][8 * e + 2]), relu_i(acc[rb][8 * e + 3])} * (f32x2v){w[e][0].z, w[e][0].w} + s2;
                s2 = (f32x2v){relu_i(acc[rb][8 * e + 4]), relu_i(acc[rb][8 * e + 5])} * (f32x2v){w[e][1].x, w[e][1].y} + s2;
                s2 = (f32x2v){relu_i(acc[rb][8 * e + 6]), relu_i(acc[rb][8 * e + 7])} * (f32x2v){w[e][1].z, w[e][1].w} + s2;
                const float sc = s2[0] + s2[1];
                const bool valid = !edge || s <= q0 + qs;
                const unsigned key = f2key(sc);
                if (PASS == 1) {
                    if (L0) { if (valid) { const unsigned bin = key >> 20; atomicAdd(&hist[qs * HROW + hpos(bin >> 1)], (bin & 1u) ? 0x10000u : 1u); } }
                    else if (valid && (key & st[e].x) == st[e].y) { const unsigned bin = (key >> st[e].z) & st[e].w; atomicAdd(&hist[qs * HROW + hpos(bin >> 1)], (bin & 1u) ? 0x10000u : 1u); }
                } else {
                    const bool all = st[e].z == 0xFFFFFFFFu;
                    const bool sel = valid && (all || key >= st[e].y);
                    const bool cnd = valid && !all && key >= st[e].x && key < st[e].y;
                    const unsigned long long bal = __ballot(sel);
                    if (l31 == 0) rows[qs * SW + kb] = h2 ? (unsigned)(bal >> 32) : (unsigned)bal;
                    if (cnd) { const unsigned n = atomicAdd(&ccnt[qs], 1u); if (n < (unsigned)CB) { ckey[qs * CB + n] = key; cidx[qs * CB + n] = (unsigned)s; } }
                }
            }
        }
    }
}

DEVI void indexer_tile(int q0, const bf16_t* __restrict__ QI, const bf16_t* __restrict__ KI, const float* __restrict__ WI, unsigned* __restrict__ SELM, unsigned* __restrict__ SELM2, unsigned char* lds) {
    const int tid = otid(), lane = tid & 63, wave = tid >> 6;
    unsigned* hist = (unsigned*)(lds + IL_HIST);
    float* wiL = (float*)(lds + IL_WI);
    uint4* qst = (uint4*)(lds + IL_QST); uint4* qst2 = (uint4*)(lds + IL_QST2);
    unsigned* ckey = (unsigned*)(lds + IL_CKEY); unsigned* cidx = (unsigned*)(lds + IL_CIDX); unsigned* hist2 = (unsigned*)(lds + IL_HIST2); unsigned* ccnt = (unsigned*)(lds + IL_CCNT);
    volatile unsigned* flag = (volatile unsigned*)(lds + IL_FLAG);
    const int nkb = (q0 + 16 + 31) >> 5;
    bf16x8_t Af[4][4];
    { const int rho = lane & 31, hq = lane >> 5; const int qq = 2 * ((rho >> 2) & 1) + (rho >> 4), head = 4 * ((rho >> 3) & 1) + (rho & 3);
#pragma unroll
      for (int rb = 0; rb < 4; ++rb)
#pragma unroll
          for (int ks = 0; ks < 4; ++ks) Af[rb][ks] = *(const bf16x8_t*)(QI + (size_t)(q0 + 4 * rb + qq) * 512 + head * 64 + 16 * ks + 8 * hq); }
    __syncthreads();
    if (tid < 128) wiL[tid] = WI[(size_t)q0 * 8 + tid] * 0.125f;
    if (tid < 16) { qst[tid] = make_uint4(0u, 0u, 20u, 4095u); qst2[tid] = make_uint4(0u, 0u, (unsigned)TOPK, 0u); ccnt[tid] = 0u; }
    for (int level = 0; level < 3; ++level) {
        for (int i = tid; i < 16 * HROW / 4; i += NTHREADS) ((uint4*)hist)[i] = make_uint4(0u, 0u, 0u, 0u);
        if (tid == 0) flag[0] = 0u;
        __syncthreads();
        if (level == 0) idx_sweep<1, true>(q0, nkb, wave, lane, Af, KI, lds, SELM); else idx_sweep<1, false>(q0, nkb, wave, lane, Af, KI, lds, SELM);
        __syncthreads();
#pragma unroll 1
        for (int qi = 0; qi < 2; ++qi) {
            const int qs = 2 * wave + qi;
            const uint4 st = qst[qs]; const uint4 b = qst2[qs];
            if (st.x == 0xFFFFFFFFu && st.y == 0u && st.w == 0u) continue;
            unsigned wv[32]; unsigned loc = 0u;
#pragma unroll
            for (int i = 0; i < 32; ++i) { wv[i] = hist[qs * HROW + 33 * lane + i]; loc += (wv[i] & 0xFFFFu) + (wv[i] >> 16); }
            unsigned suf = loc;
#pragma unroll
            for (int off = 1; off < 64; off <<= 1) { const unsigned o = __shfl_down(suf, off); if (lane + off < 64) suf += o; }
            const unsigned total = __shfl(suf, 0), above = suf - loc, need = b.z;
            if (level == 0 && total <= need) { if (lane == 0) { qst[qs] = make_uint4(0xFFFFFFFFu, 0u, 0u, 0u); qst2[qs] = make_uint4(0u, 0u, 0xFFFFFFFFu, 0u); } continue; }
            const bool mine = above < need && need <= above + loc;
            unsigned cum = above, c = 0u; int d = 0; bool found = false;
#pragma unroll
            for (int i = 31; i >= 0; --i) {
                const unsigned chi = wv[i] >> 16, clo = wv[i] & 0xFFFFu;
                if (!found && cum + chi >= need) { found = true; d = 64 * lane + 2 * i + 1; c = chi; } if (!found) cum += chi;
                if (!found && cum + clo >= need) { found = true; d = 64 * lane + 2 * i; c = clo; } if (!found) cum += clo; }
            if (mine) {
                const unsigned pval = st.y | ((unsigned)d << st.z), pmask = st.x | (st.w << st.z);
                const unsigned nneed = need - cum;
                const unsigned long long hi64 = (unsigned long long)pval + (1ull << st.z);
                const unsigned hi = hi64 > 0xFFFFFFFFull ? 0xFFFFFFFFu : (unsigned)hi64;
                if (c <= (unsigned)CB || level == 2) { qst[qs] = make_uint4(0xFFFFFFFFu, 0u, 0u, 0u); qst2[qs] = make_uint4(pval, hi, nneed, st.z); }
                else { const unsigned nsh = (level == 0) ? 8u : 0u, ndm = (level == 0) ? 4095u : 255u; qst[qs] = make_uint4(pmask, pval, nsh, ndm); qst2[qs] = make_uint4(pval, hi, nneed, st.z); flag[0] = 1u; }
            }
        }
        __syncthreads();
        if (flag[0] == 0u) break;
        __syncthreads();
    }
    __syncthreads();
    idx_sweep<2, false>(q0, nkb, wave, lane, Af, KI, lds, SELM);
    asm volatile("s_waitcnt vmcnt(0)" ::: "memory");
    __syncthreads();
    unsigned* rows = (unsigned*)(lds + IL_ROWS);
#pragma unroll 1
    for (int qi = 0; qi < 2; ++qi) {
        const int qs = 2 * wave + qi;
        const uint4 b = qst2[qs];
        unsigned* row = rows + qs * SW;
        if (b.z != 0xFFFFFFFFu) {
            const unsigned need = b.z; const unsigned cn = ccnt[qs]; const int n = (int)(cn < (unsigned)CB ? cn : (unsigned)CB);
            const unsigned rem = b.w;
            const unsigned sh8 = rem > 8u ? rem - 8u : 0u; const unsigned m8 = rem >= 8u ? 255u : ((1u << rem) - 1u);
#pragma unroll
            for (int i = 0; i < 4; ++i) hist2[qs * 256 + 4 * lane + i] = 0u;
            asm volatile("s_waitcnt lgkmcnt(0)" ::: "memory");
            for (int i = lane; i < n; i += 64) atomicAdd(&hist2[qs * 256 + ((ckey[qs * CB + i] >> sh8) & m8)], 1u);
            asm volatile("s_waitcnt lgkmcnt(0)" ::: "memory");
            unsigned c4[4]; unsigned loc = 0u;
#pragma unroll
            for (int i = 0; i < 4; ++i) { c4[i] = hist2[qs * 256 + 4 * lane + i]; loc += c4[i]; }
            unsigned suf = loc;
#pragma unroll
            for (int off = 1; off < 64; off <<= 1) { const unsigned o = __shfl_down(suf, off); if (lane + off < 64) suf += o; }
            const unsigned above = suf - loc;
            const bool mine = above < need && need <= above + loc;
            unsigned b2 = 0u, need2 = 0u;
            if (mine) { unsigned cum = above; int i = 3; for (; i > 0; --i) { if (cum + c4[i] >= need) break; cum += c4[i]; } b2 = 4u * lane + i; need2 = need - cum; }
            const unsigned long long mb = __ballot(mine);
            if (mb == 0ull) {
                for (int i = lane; i < n; i += 64) if ((unsigned)i < need) { const unsigned ii = cidx[qs * CB + i]; atomicOr(&row[ii >> 5], 1u << (ii & 31u)); }
            } else {
                const int src = __ffsll((long long)mb) - 1;
                b2 = __shfl(b2, src); need2 = __shfl(need2, src);
                for (int i0 = 0; i0 < n; i0 += 64) {
                    const int i = i0 + lane; const bool act = i < n;
                    const unsigned ki = act ? ckey[qs * CB + i] : 0u, ii = act ? cidx[qs * CB + i] : 0u; const unsigned d8 = (ki >> sh8) & m8;
                    if (act && d8 > b2) atomicOr(&row[ii >> 5], 1u << (ii & 31u));
                    unsigned long long tie = __ballot(act && d8 == b2);
                    while (tie) {
                        const int ml = __ffsll((long long)tie) - 1; tie &= tie - 1ull;
                        const unsigned km = __shfl(ki, ml), im = __shfl(ii, ml);
                        unsigned rank = 0u;
                        for (int j0 = 0; j0 < n; j0 += 64) { const int j = j0 + lane; bool beats = false;
                            if (j < n) { const unsigned kj = ckey[qs * CB + j], ij = cidx[qs * CB + j]; beats = ((kj >> sh8) & m8) == b2 && (kj > km || (kj == km && ij < im)); }
                            rank += (unsigned)__popcll(__ballot(beats)); }
                        if (rank < need2 && lane == ml) atomicOr(&row[im >> 5], 1u << (im & 31u));
                    }
                }
            }
        }
    }
    asm volatile("s_waitcnt lgkmcnt(0)" ::: "memory");
    __syncthreads();
    { const int nq4 = (nkb + 3) >> 2;
      for (int i = tid; i < 16 * nq4; i += NTHREADS) { const int r = i / nq4, c4i = i - r * nq4;
          *(uint4*)(SELM + (size_t)(q0 + r) * SW + 4 * c4i) = *(const uint4*)(rows + r * SW + 4 * c4i); } }
}

constexpr int AW_BYTES = 512;
typedef short s16x2 __attribute__((ext_vector_type(2)));
DEVI float dot2bf(unsigned a, unsigned b, float c) { return __builtin_amdgcn_fdot2_f32_bf16(__builtin_bit_cast(s16x2, a), __builtin_bit_cast(s16x2, b), c, false); }
#define LDS_FENCE() asm volatile("s_waitcnt lgkmcnt(0)" ::: "memory")

struct AttnQ { float m, l, o[8]; };

DEVI void attn_issue(int b0, int n, const unsigned short* lst, const unsigned char* __restrict__ KV8, int lane, uint4 (&kv)[8]) {
    const int last = n - 1;
#pragma unroll
    for (int kk = 0; kk < 8; ++kk) { const int ii = b0 + kk; const int key = lst[ii < last ? ii : last]; kv[kk] = *(const uint4*)(KV8 + (size_t)key * 1024 + lane * 16); }
}
DEVI void attn_compute(AttnQ& S, int b0, int n, const float (&q)[8], const uint4 (&kv)[8]) {
    float sc[8]; float mx = S.m;
#pragma unroll
    for (int u = 0; u < 8; ++u) {
        const f32x2v k0 = __builtin_amdgcn_cvt_pk_f32_fp8((int)kv[u].x, false), k1 = __builtin_amdgcn_cvt_pk_f32_fp8((int)kv[u].x, true),
                     k2 = __builtin_amdgcn_cvt_pk_f32_fp8((int)kv[u].y, false), k3 = __builtin_amdgcn_cvt_pk_f32_fp8((int)kv[u].y, true);
        f32x2v d2 = k0 * (f32x2v){q[0], q[1]}; d2 = k1 * (f32x2v){q[2], q[3]} + d2; d2 = k2 * (f32x2v){q[4], q[5]} + d2; d2 = k3 * (f32x2v){q[6], q[7]} + d2;
        float d = d2[0] + d2[1];
        d += dpp_f<0xB1>(d); d += dpp_f<0x4E>(d); d += dpp_f<0x141>(d);
        sc[u] = (b0 + u < n) ? d : -INFINITY;
        mx = fmaxf(mx, sc[u]); }
    const float scale = __builtin_amdgcn_exp2f(S.m - mx);
    float ls = S.l * scale;
#pragma unroll
    for (int i = 0; i < 8; ++i) S.o[i] *= scale;
#pragma unroll
    for (int u = 0; u < 8; ++u) {
        const float p = __builtin_amdgcn_exp2f(sc[u] - mx); ls += p;
        const f32x2v v0 = __builtin_amdgcn_cvt_pk_f32_fp8((int)kv[u].z, false), v1 = __builtin_amdgcn_cvt_pk_f32_fp8((int)kv[u].z, true),
                     v2 = __builtin_amdgcn_cvt_pk_f32_fp8((int)kv[u].w, false), v3 = __builtin_amdgcn_cvt_pk_f32_fp8((int)kv[u].w, true);
        S.o[0] += p * v0[0]; S.o[1] += p * v0[1]; S.o[2] += p * v1[0]; S.o[3] += p * v1[1]; S.o[4] += p * v2[0]; S.o[5] += p * v2[1]; S.o[6] += p * v3[0]; S.o[7] += p * v3[1]; }
    S.l = ls; S.m = mx;
}

DEVI void attn_query(int t, const bf16_t* __restrict__ Qb, const unsigned char* __restrict__ KV8,
                     const unsigned* __restrict__ SELM, const unsigned* __restrict__ SELM2, bf16_t* __restrict__ AO, unsigned char* wl, int lane) {
    unsigned short* lst = (unsigned short*)wl;
    const unsigned* SR = SELM + (size_t)t * SW;
    LDS_FENCE();
    const int nw = (t >> 5) + 1; int base = 0;
    for (int w0 = 0; w0 < nw; w0 += 64) {
        const int wi = w0 + lane; const unsigned wv = wi < nw ? SR[wi] : 0u;
        const int pc = __popc(wv); int pre = pc;
#pragma unroll
        for (int off = 1; off < 64; off <<= 1) { const int o_ = __shfl_up(pre, off); if (lane >= off) pre += o_; }
        int pos = base + pre - pc; unsigned mm = wv;
        while (mm) { const int bpos = __ffs((int)mm) - 1; mm &= mm - 1u; if (pos < TOPK) lst[pos] = (unsigned short)(wi * 32 + bpos); ++pos; }
        base += __shfl(pre, 63);
    }
    const int n = base < TOPK ? base : TOPK;
    float q[8];
    { const uint4 qv = ((const uint4*)(Qb + (size_t)t * 512))[lane]; const float qs = 0.18033688011112042f;
      q[0] = bflo(qv.x) * qs; q[1] = bfhi(qv.x) * qs; q[2] = bflo(qv.y) * qs; q[3] = bfhi(qv.y) * qs; q[4] = bflo(qv.z) * qs; q[5] = bfhi(qv.z) * qs; q[6] = bflo(qv.w) * qs; q[7] = bfhi(qv.w) * qs; }
    LDS_FENCE();
    AttnQ S; S.m = -INFINITY; S.l = 0.f;
#pragma unroll
    for (int d = 0; d < 8; ++d) S.o[d] = 0.f;
    uint4 ka[8], kb_[8], kc[8];
    attn_issue(0, n, lst, KV8, lane, ka);
    if (8 < n) attn_issue(8, n, lst, KV8, lane, kb_);
    for (int b0 = 0; b0 < n; b0 += 24) {
        if (b0 + 16 < n) attn_issue(b0 + 16, n, lst, KV8, lane, kc);
        attn_compute(S, b0, n, q, ka);
        if (b0 + 8 < n) {
            if (b0 + 24 < n) attn_issue(b0 + 24, n, lst, KV8, lane, ka);
            attn_compute(S, b0 + 8, n, q, kb_);
            if (b0 + 16 < n) {
                if (b0 + 32 < n) attn_issue(b0 + 32, n, lst, KV8, lane, kb_);
                attn_compute(S, b0 + 16, n, q, kc);
            }
        }
    }
    const int hd = lane >> 3, ch = lane & 7;
    const float inv = 1.0f / S.l;
    uint4 pk; pk.x = cvt_pk_bf16(S.o[0] * inv, S.o[1] * inv); pk.y = cvt_pk_bf16(S.o[2] * inv, S.o[3] * inv); pk.z = cvt_pk_bf16(S.o[4] * inv, S.o[5] * inv); pk.w = cvt_pk_bf16(S.o[6] * inv, S.o[7] * inv);
    *(uint4*)(AO + (size_t)t * 1024 + 512 + hd * 64 + ch * 8) = pk;
}

__global__ void __launch_bounds__(NTHREADS, 2) fwd(Args a) {
    extern __shared__ __attribute__((aligned(16))) unsigned char lds_raw[];
    float* smf = (float*)lds_raw;
    PG8_LAS unsigned char* ldsp = (PG8_LAS unsigned char*)lds_raw;
    const int nwaves = gridDim.x * 8;
#define PHASE_VARS const int tid = otid(); const int lane = tid & 63, wave = tid >> 6; const int gwave = blockIdx.x * 8 + wave; (void)lane; (void)wave; (void)gwave;
    unsigned char* ws = a.ws;
    unsigned* ctl = (unsigned*)(ws + WS_CTL);
    const int lo = a.ph_lo, hi = a.ph_hi;

    volatile LAS unsigned* bst = (volatile LAS unsigned*)((LAS unsigned char*)lds_raw + (LDS_BYTES - 16));
    if (threadIdx.x == 0) { bst[0] = 0u; bst[1] = 0u; bst[2] = 0u; bst[3] = 0u; }
    __syncthreads();
    XcdBarrier bar; bar.bar = ctl; bar.x = 0; bar.st = bst;
    if (hi - lo > 1) bar = xcd_barrier_post(ctl, bst);
#define IN(k) (lo <= (k) && (k) < hi)
#define SEAM(k) do { if (IN(k) && IN((k) + 1)) xcd_barrier(bar); } while (0)

    const float* x = a.in[0]; const float* meta = a.in[1];
    float* ropeC = (float*)(ws + WS_ROPEC); float* ropeS = (float*)(ws + WS_ROPES);
    int* eid = (int*)(ws + WS_EID); float* gw = (float*)(ws + WS_GW); int* slot = (int*)(ws + WS_SLOT); int* mtiles = (int*)(ws + WS_MTILES);
    unsigned* counts0 = (unsigned*)(ws + CTL_CNT); unsigned* counts1 = counts0 + 32;
    unsigned* cursor0 = (unsigned*)(ws + CTL_CUR); unsigned* cursor1 = cursor0 + 32;
    bf16_t* Wta = (bf16_t*)(ws + WS_WTA); bf16_t* Wtx = (bf16_t*)(ws + WS_WTX);
    float* Aend = (float*)(ws + WS_AEND); float* Hend = (float*)(ws + WS_HEND); float* CIN = (float*)(ws + WS_CIN);
    unsigned char* big = ws + WS_BIG;
    bf16_t* WIN0 = (bf16_t*)(big + R_WIN0); bf16_t* WOUT0 = (bf16_t*)(big + R_WOUT0); bf16_t* WGU = (bf16_t*)(big + R_WGU); bf16_t* WD = (bf16_t*)(big + R_WD);
    bf16_t* WIN1 = (bf16_t*)(big + R_WIN1); bf16_t* WOUT1 = (bf16_t*)(big + R_WOUT1);
    bf16_t* X0b = (bf16_t*)(big + R_A); bf16_t* AO = (bf16_t*)(big + R_A); bf16_t* Xperm = (bf16_t*)(big + R_A); bf16_t* X2b = (bf16_t*)(big + R_A); bf16_t* YY = (bf16_t*)(big + R_A);
    float* H1 = (float*)(big + R_H1); float* H3 = (float*)(big + R_H1); float* H2 = (float*)(big + R_H2); unsigned* SELM = (unsigned*)(big + R_H1); unsigned* SELM2 = (unsigned*)(big + R_H1 + 36 * MiB);
    float* Z = (float*)(big + R_C); bf16_t* Yb = (bf16_t*)(big + R_C); float* Z1 = (float*)(big + R_C);
    unsigned char* KV8 = big + R_K;
    bf16_t* GLU = (bf16_t*)(big + R_GLU); bf16_t* Qb = (bf16_t*)(big + R_Q); bf16_t* Kb = (bf16_t*)(big + R_K); bf16_t* Vb = (bf16_t*)(big + R_V);
    bf16_t* QIb = (bf16_t*)(big + R_QI); bf16_t* KIb = (bf16_t*)(big + R_KI); float* WIf = (float*)(big + R_WI);
    bf16_t* GATEg = (bf16_t*)(big + R_GATE); bf16_t* XRb = (bf16_t*)(big + R_XR);
    bf16_t* Hm = (bf16_t*)(big + R_HM);

    if (IN(0)) { PHASE_VARS;
        const float* w_in = a.in[2]; const float* w_out = a.in[7]; const float* wg = a.in[21]; const float* wu = a.in[22]; const float* wd = a.in[23];
        constexpr int J_IN0 = 52 * 16, J_OUT0 = 16 * 16, J_GU = 32 * 256, J_D = 32 * 128, J_IN1 = 40 * 16, J_OUT1 = 16 * 20, J_GT = 80;
        const float* w_in1 = a.in[8]; const float* w_out1 = a.in[16]; const float* wga = a.in[11]; const float* wgx = a.in[13];
        tr_run(J_IN0 + J_OUT0 + J_GU + J_D + J_IN1 + J_OUT1 + J_GT, [&](int j) -> TrJob {
            TrJob J{};
            if (j < J_IN0) { J.dst = WIN0; J.s0 = w_in; J.K = 1024; J.n0 = (j >> 4) * 64; J.k0 = (j & 15) * 64; J.mode = 1; return J; }
            j -= J_IN0;
            if (j < J_OUT0) { J.dst = WOUT0; J.s0 = w_out; J.ld = D; J.K = 1024; J.n0 = (j >> 4) * 64; J.k0 = (j & 15) * 64; J.mode = 0; return J; }
            j -= J_OUT0;
            if (j < J_GU) { const int e = j >> 8, t = j & 255; J.dst = WGU + (size_t)e * 1024 * 1024; J.s0 = wg + (size_t)e * D * DE; J.s1 = wu + (size_t)e * D * DE; J.K = 1024; J.n0 = (t >> 4) * 64; J.k0 = (t & 15) * 64; J.mode = 2; return J; }
            j -= J_GU;
            if (j < J_D) { const int e = j >> 7, t = j & 127; J.dst = WD + (size_t)e * 1024 * 512; J.s0 = wd + (size_t)e * DE * D; J.ld = D; J.K = 512; J.n0 = (t >> 3) * 64; J.k0 = (t & 7) * 64; J.mode = 0; return J; }
            j -= J_D;
            if (j < J_IN1) { J.dst = WIN1; J.s0 = w_in1; J.ld = 2 * RNN_W; J.K = 1024; J.n0 = (j >> 4) * 64; J.k0 = (j & 15) * 64; J.mode = 0; return J; }
            j -= J_IN1;
            if (j < J_OUT1) { J.dst = WOUT1; J.s0 = w_out1; J.ld = D; J.K = RNN_W; J.n0 = (j / 20) * 64; J.k0 = (j % 20) * 64; J.mode = 0; return J; }
            j -= J_OUT1;
            { const int which = j / 40, r = j % 40; const int nb = r >> 2;
              J.dst = (which ? Wtx : Wta) + (size_t)nb * 128 * 128; J.s0 = (which ? wgx : wga) + (size_t)nb * 128 * 128; J.ld = 128; J.K = 128; J.n0 = ((r >> 1) & 1) * 64; J.k0 = (r & 1) * 64; J.mode = 0; return J; }
        }, smf);
        for (size_t i = (size_t)blockIdx.x * NTHREADS + tid; i < (size_t)LP * 256; i += (size_t)gridDim.x * NTHREADS) {
            const size_t r = i >> 8, c4 = i & 255;
            float4 v = make_float4(0.f, 0.f, 0.f, 0.f);
            if (r < NMETA) v = ((const float4*)meta)[r * 256 + c4]; else if (r < L) v = ((const float4*)x)[(r - NMETA) * 256 + c4];
            ((uint2*)X0b)[i] = make_uint2(cvt_pk_bf16(v.x, v.y), cvt_pk_bf16(v.z, v.w));
        }
        for (int i = blockIdx.x * NTHREADS + tid; i < 2 * 64 * 3 * 64; i += gridDim.x * NTHREADS) {
            const int ln = i & 63, ct = (i >> 6) % 3, ss = (i / 192) & 63, ly = i / (192 * 64);
            const int col = 16 * ct + (ln & 15), k0 = 16 * ss + 4 * (ln >> 4);
            float v[4];
#pragma unroll
            for (int j = 0; j < 4; ++j) v[j] = col < 4 ? a.in[17][(size_t)ly * D * NGRP + (size_t)(k0 + j) * NGRP + col] : col < 36 ? a.in[19][(size_t)ly * D * NE + (size_t)(k0 + j) * NE + (col - 4)] : 0.f;
            ((float4*)(ws + WS_WR))[i] = make_float4(v[0], v[1], v[2], v[3]);
        }
        for (int i = blockIdx.x * NTHREADS + tid; i < LP * 32; i += gridDim.x * NTHREADS) {
            const int p = i >> 5, f = i & 31;
            const float inv = (float)pow(10000.0, -(double)f / 32.0);
            const float ang = (float)p * inv;
            ropeC[i] = (float)cos((double)ang); ropeS[i] = (float)sin((double)ang);
        }
    }
    SEAM(0);
    if (IN(1)) { PHASE_VARS;
        pg8::Gemm g{X0b, WIN0, LP, 3328, 1024}; pg8::StaticOrder S; S.init(LP, 3328, (int)gridDim.x, (int)blockIdx.x);
        EpiIn0 E{GLU, KIb, WIf, ropeC, ropeS, KV8};
        pg8::gemm_phase<EpiIn0, pg8::StaticOrder, GEMM_ALIGN, GEMM_SP2>(ldsp, g, S, E);
    }
    SEAM(1);
    if (IN(2)) { PHASE_VARS;
        const float* cw = a.in[3]; const float* cb = a.in[4]; const float* lg = a.in[5]; const float* lb = a.in[6];
        for (int g4 = gwave; g4 < L / 4; g4 += nwaves) {
            const int t0 = g4 * 4, c0 = lane * 8;
            float acc[4][8], wwin[4][8];
            { const float4 b0 = *(const float4*)(cb + c0), b1 = *(const float4*)(cb + c0 + 4);
#pragma unroll
              for (int q = 0; q < 4; ++q) { acc[q][0] = b0.x; acc[q][1] = b0.y; acc[q][2] = b0.z; acc[q][3] = b0.w; acc[q][4] = b1.x; acc[q][5] = b1.y; acc[q][6] = b1.z; acc[q][7] = b1.w; } }
#pragma unroll
            for (int r = 0; r < CONV_K + 3; ++r) {
                const int tt = t0 - (CONV_K - 1) + r;
                if (r < CONV_K) { const float4 w0 = *(const float4*)(cw + r * CONV_CH + c0), w1 = *(const float4*)(cw + r * CONV_CH + c0 + 4);
                    wwin[r & 3][0] = w0.x; wwin[r & 3][1] = w0.y; wwin[r & 3][2] = w0.z; wwin[r & 3][3] = w0.w; wwin[r & 3][4] = w1.x; wwin[r & 3][5] = w1.y; wwin[r & 3][6] = w1.z; wwin[r & 3][7] = w1.w; }
                if (tt >= 0) {
                    const uint4 xv = *(const uint4*)(GLU + (size_t)tt * 512 + c0);
                    const float x[8] = {bflo(xv.x), bfhi(xv.x), bflo(xv.y), bfhi(xv.y), bflo(xv.z), bfhi(xv.z), bflo(xv.w), bfhi(xv.w)};
#pragma unroll
                    for (int q = 0; q < 4; ++q) { const int j = r - q;
                        if (j >= 0 && j < CONV_K) {
#pragma unroll
                            for (int i = 0; i < 8; ++i) acc[q][i] += wwin[j & 3][i] * x[i]; } }
                }
            }
            float gv[8], bvv[8];
            { const float4 g0 = *(const float4*)(lg + c0), g1 = *(const float4*)(lg + c0 + 4), b0 = *(const float4*)(lb + c0), b1 = *(const float4*)(lb + c0 + 4);
              gv[0] = g0.x; gv[1] = g0.y; gv[2] = g0.z; gv[3] = g0.w; gv[4] = g1.x; gv[5] = g1.y; gv[6] = g1.z; gv[7] = g1.w; bvv[0] = b0.x; bvv[1] = b0.y; bvv[2] = b0.z; bvv[3] = b0.w; bvv[4] = b1.x; bvv[5] = b1.y; bvv[6] = b1.z; bvv[7] = b1.w; }
#pragma unroll
            for (int q = 0; q < 4; ++q) {
                float s_ = 0.f;
#pragma unroll
                for (int i = 0; i < 8; ++i) s_ += acc[q][i];
                const float mu = wave_sum(s_) * (1.0f / 512.0f);
                float qq = 0.f;
#pragma unroll
                for (int i = 0; i < 8; ++i) { const float d = acc[q][i] - mu; qq += d * d; }
                const float rstd = 1.0f / sqrtf(wave_sum(qq) * (1.0f / 512.0f) + LN_EPS);
                float o[8];
#pragma unroll
                for (int i = 0; i < 8; ++i) { const float yv = (acc[q][i] - mu) * rstd * gv[i] + bvv[i]; o[i] = yv * fsigm(yv); }
                uint4 w; w.x = cvt_pk_bf16(o[0], o[1]); w.y = cvt_pk_bf16(o[2], o[3]); w.z = cvt_pk_bf16(o[4], o[5]); w.w = cvt_pk_bf16(o[6], o[7]);
                *(uint4*)(AO + (size_t)(t0 + q) * 1024 + c0) = w;
            }
        }
        for (int r = 0; ; ++r) {
            const int idx = r * (int)gridDim.x + ((r & 1) ? (int)gridDim.x - 1 - (int)blockIdx.x : (int)blockIdx.x);
            if (idx >= NTILE) break;
            indexer_tile((NTILE - 1 - idx) * 16, QIb, KIb, WIf, SELM, SELM2, lds_raw);
        }
    }
    SEAM(2);
    if (IN(3)) { PHASE_VARS;
        unsigned char* wl = lds_raw + wave * AW_BYTES;
        for (int t = gwave; t < L; t += nwaves) attn_query(t, Qb, KV8, SELM, SELM2, AO, wl, lane);
    }
    SEAM(3);
    if (IN(4)) { PHASE_VARS;
        pg8::Gemm g{AO, WOUT0, LP, 1024, 1024}; pg8::StaticOrder S; S.init(LP, 1024, (int)gridDim.x, (int)blockIdx.x);
        EpiRes0 E{x, meta, Z};
        pg8::gemm_phase<EpiRes0, pg8::StaticOrder, GEMM_ALIGN, GEMM_SP2>(ldsp, g, S, E);
    }
    SEAM(4);
    if (IN(5)) {
        for (int tb = blockIdx.x * 64; tb < L; tb += gridDim.x * 64)
            ln_route_block(tb, (L - tb) < 64 ? (L - tb) : 64, Z, H1, a.in[24], a.in[25], (const float4*)(ws + WS_WR), a.in[18], a.in[20], eid, gw, counts0, smf);
    }
    SEAM(5);
    if (IN(6)) { PHASE_VARS; moe_dispatch_mfma(H1, eid, counts0, cursor0, slot, mtiles, Xperm, (int*)lds_raw, gwave, nwaves, lane, 0); }
    SEAM(6);
    if (IN(7)) { PHASE_VARS;
        pg8::Gemm g{Xperm, WGU, MAXSLOT, 1024, 1024}; MoeOrder S; S.init(mtiles, (int)gridDim.x, (int)blockIdx.x);
        EpiGateUp E{Hm};
        pg8::gemm_phase<EpiGateUp, MoeOrder, GEMM_ALIGN, GEMM_SP2>(ldsp, g, S, E);
    }
    SEAM(7);
    if (IN(8)) { PHASE_VARS;
        pg8::Gemm g{Hm, WD, MAXSLOT, 1024, 512}; MoeOrder S; S.init(mtiles, (int)gridDim.x, (int)blockIdx.x);
        EpiDown E{Yb};
        pg8::gemm_phase<EpiDown, MoeOrder, GEMM_ALIGN, GEMM_SP2>(ldsp, g, S, E);
    }
    SEAM(8);
    if (IN(9)) { PHASE_VARS;
#pragma unroll 2
        for (int t = gwave; t < L; t += nwaves) {
            const int s0 = slot[2 * t], s1 = slot[2 * t + 1]; const float g0 = gw[2 * t], g1 = gw[2 * t + 1];
            float y[16];
            combine_row(y, H1 + (size_t)t * D, Yb + (size_t)s0 * D, Yb + (size_t)s1 * D, g0, g1, lane);
            ln_row1024v(y, a.in[26], a.in[27], lane);
#pragma unroll
            for (int i4 = 0; i4 < 4; ++i4) *(float4*)(H2 + (size_t)t * D + 16 * lane + 4 * i4) = make_float4(y[4 * i4], y[4 * i4 + 1], y[4 * i4 + 2], y[4 * i4 + 3]);
            uint4 p0, p1; p0.x = cvt_pk_bf16(y[0], y[1]); p0.y = cvt_pk_bf16(y[2], y[3]); p0.z = cvt_pk_bf16(y[4], y[5]); p0.w = cvt_pk_bf16(y[6], y[7]);
            p1.x = cvt_pk_bf16(y[8], y[9]); p1.y = cvt_pk_bf16(y[10], y[11]); p1.z = cvt_pk_bf16(y[12], y[13]); p1.w = cvt_pk_bf16(y[14], y[15]);
            *(uint4*)(X2b + (size_t)t * D + 16 * lane) = p0; *(uint4*)(X2b + (size_t)t * D + 16 * lane + 8) = p1;
        }
        for (int i = blockIdx.x * NTHREADS + tid; i < (LP - L) * D / 8; i += gridDim.x * NTHREADS) ((uint4*)(X2b + (size_t)L * D))[i] = make_uint4(0u, 0u, 0u, 0u);
    }
    SEAM(9);
    if (IN(10)) {
        pg8::Gemm g{X2b, WIN1, LP, 2 * RNN_W, 1024}; pg8::StaticOrder S; S.init(LP, 2 * RNN_W, (int)gridDim.x, (int)blockIdx.x);
        EpiIn1 E{GATEg};
        pg8::gemm_phase<EpiIn1, pg8::StaticOrder, GEMM_ALIGN, GEMM_SP2>(ldsp, g, S, E);
    }
    SEAM(10);
    if (IN(11)) rglru_phase<false>(XRb, GATEg, Wta, Wtx, a.in[9], a.in[10], a.in[12], a.in[14], a.in[15], Aend, Hend, CIN, YY, lds_raw);
    SEAM(11);
    if (IN(12)) { PHASE_VARS;
        for (int ch = gwave; ch < RNN_W; ch += nwaves) {
            float A[5], H[5];
#pragma unroll
            for (int i = 0; i < 5; ++i) { const int c = 5 * lane + i; const bool ok = c < NCHUNK; A[i] = ok ? Aend[(size_t)ch * CP + c] : 1.f; H[i] = ok ? Hend[(size_t)ch * CP + c] : 0.f; }
            float Al = 1.f, Hl = 0.f;
#pragma unroll
            for (int i = 0; i < 5; ++i) { Hl = A[i] * Hl + H[i]; Al *= A[i]; }
#pragma unroll
            for (int off = 1; off < 64; off <<= 1) { const float Ap = __shfl_up(Al, off), Hp = __shfl_up(Hl, off); if (lane >= off) { Hl = Al * Hp + Hl; Al = Al * Ap; } }
            float cin = __shfl_up(Hl, 1); if (lane == 0) cin = 0.f;
#pragma unroll
            for (int i = 0; i < 5; ++i) { const int c = 5 * lane + i; if (c < NCHUNK) { CIN[(size_t)ch * CP + c] = cin; cin = A[i] * cin + H[i]; } }
        }
    }
    SEAM(12);
    if (IN(13)) rglru_phase<true>(XRb, GATEg, Wta, Wtx, a.in[9], a.in[10], a.in[12], a.in[14], a.in[15], Aend, Hend, CIN, YY, lds_raw);
    SEAM(13);
    if (IN(14)) {
        pg8::Gemm g{YY + (size_t)NMETA * RNN_W, WOUT1, SEQ, 1024, RNN_W}; pg8::StaticOrder S; S.init(SEQ, 1024, (int)gridDim.x, (int)blockIdx.x);
        EpiRes1 E{H2 + (size_t)NMETA * D, Z1 + (size_t)NMETA * D};
        pg8::gemm_phase<EpiRes1, pg8::StaticOrder, GEMM_ALIGN, GEMM_SP2>(ldsp, g, S, E);
    }
    SEAM(14);
    if (IN(15)) { PHASE_VARS;
        const float* wg = a.in[21] + (size_t)NE * D * DE; const float* wu = a.in[22] + (size_t)NE * D * DE; const float* wd = a.in[23] + (size_t)NE * DE * D;
        constexpr int J_GU = 32 * 256, J_D = 32 * 128;
        tr_run(J_GU + J_D, [&](int j) -> TrJob {
            TrJob J{};
            if (j < J_GU) { const int e = j >> 8, t = j & 255; J.dst = WGU + (size_t)e * 1024 * 1024; J.s0 = wg + (size_t)e * D * DE; J.s1 = wu + (size_t)e * D * DE; J.K = 1024; J.n0 = (t >> 4) * 64; J.k0 = (t & 15) * 64; J.mode = 2; return J; }
            j -= J_GU;
            { const int e = j >> 7, t = j & 127; J.dst = WD + (size_t)e * 1024 * 512; J.s0 = wd + (size_t)e * DE * D; J.ld = D; J.K = 512; J.n0 = (t >> 3) * 64; J.k0 = (t & 7) * 64; J.mode = 0; return J; }
        }, smf);
        __syncthreads();
        for (int tb = NMETA + blockIdx.x * 64; tb < L; tb += gridDim.x * 64)
            ln_route_block(tb, (L - tb) < 64 ? (L - tb) : 64, Z1, H3, a.in[24] + D, a.in[25] + D, (const float4*)(ws + WS_WR) + 64 * 3 * 64, a.in[18] + NGRP, a.in[20] + NE, eid, gw, counts1, smf);
    }
    SEAM(15);
    if (IN(16)) { PHASE_VARS; moe_dispatch_mfma(H3, eid, counts1, cursor1, slot, mtiles, Xperm, (int*)lds_raw, gwave, nwaves, lane, 2 * NMETA); }
    SEAM(16);
    if (IN(17)) {
        pg8::Gemm g{Xperm, WGU, MAXSLOT, 1024, 1024}; MoeOrder S; S.init(mtiles, (int)gridDim.x, (int)blockIdx.x);
        EpiGateUp E{Hm};
        pg8::gemm_phase<EpiGateUp, MoeOrder, GEMM_ALIGN, GEMM_SP2>(ldsp, g, S, E);
    }
    SEAM(17);
    if (IN(18)) {
        pg8::Gemm g{Hm, WD, MAXSLOT, 1024, 512}; MoeOrder S; S.init(mtiles, (int)gridDim.x, (int)blockIdx.x);
        EpiDown E{Yb};
        pg8::gemm_phase<EpiDown, MoeOrder, GEMM_ALIGN, GEMM_SP2>(ldsp, g, S, E);
    }
    SEAM(18);
    if (IN(19)) { PHASE_VARS;
#pragma unroll 2
        for (int t = NMETA + gwave; t < L; t += nwaves) {
            const int s0 = slot[2 * t], s1 = slot[2 * t + 1]; const float g0 = gw[2 * t], g1 = gw[2 * t + 1];
            float y[16];
            combine_row(y, H3 + (size_t)t * D, Yb + (size_t)s0 * D, Yb + (size_t)s1 * D, g0, g1, lane);
            ln_row1024v(y, a.in[26] + D, a.in[27] + D, lane);
#pragma unroll
            for (int i4 = 0; i4 < 4; ++i4) *(float4*)(a.out + (size_t)(t - NMETA) * D + 16 * lane + 4 * i4) = make_float4(y[4 * i4], y[4 * i4 + 1], y[4 * i4 + 2], y[4 * i4 + 3]);
        }
    }
#undef IN
#undef SEAM
}
constexpr int N_PHASES = 20;

extern "C" void kernel_launch(void* const* d_in, const int* in_sizes, int n_in, void* d_out, int out_size, void* d_ws, size_t ws_size, hipStream_t stream) {
    static int grid = 0;
    if (grid == 0) {
        if (n_in != 28 || out_size != SEQ * D || ws_size < WS_END) { fprintf(stderr, "kernel_launch: unexpected shapes n_in %d out %d ws %zu (need %zu)\n", n_in, out_size, ws_size, (size_t)WS_END); grid = -1; return; }
        int dev = 0, cus = 0;
        if (hipGetDevice(&dev) != hipSuccess || hipDeviceGetAttribute(&cus, hipDeviceAttributeMultiprocessorCount, dev) != hipSuccess) { grid = -1; return; }
        if (hipFuncSetAttribute((const void*)fwd, hipFuncAttributeMaxDynamicSharedMemorySize, LDS_BYTES) != hipSuccess) { fprintf(stderr, "kernel_launch: hipFuncSetAttribute failed\n"); grid = -1; return; }
        int per_cu = 0;
        if (hipOccupancyMaxActiveBlocksPerMultiprocessor(&per_cu, (const void*)fwd, NTHREADS, LDS_BYTES) != hipSuccess || per_cu < 1) fprintf(stderr, "kernel_launch: occupancy query says %d\n", per_cu);
        (void)hipGetLastError();
        grid = cus;
    }
    if (grid < 0) return;
    (void)hipMemsetAsync((char*)d_ws + WS_CTL, 0, CTL_BYTES, stream);
    Args a{};
    for (int i = 0; i < 28; ++i) a.in[i] = (const float*)d_in[i];
    a.out = (float*)d_out; a.ws = (unsigned char*)d_ws;
#if N_LAUNCH_MODE == 1
    a.ph_lo = 0; a.ph_hi = N_PHASES;
    hipLaunchKernelGGL(fwd, dim3(grid), dim3(NTHREADS), LDS_BYTES, stream, a);
#else
    for (int p = 0; p < N_PHASES; ++p) { a.ph_lo = p; a.ph_hi = p + 1; hipLaunchKernelGGL(fwd, dim3(grid), dim3(NTHREADS), LDS_BYTES, stream, a); }
#endif
}
```

```cpp
#include <hip/hip_runtime.h>
#include <cstdio>
#include <cstdint>
#include <cmath>

#ifndef GEMM_ALIGN
#define GEMM_ALIGN true
#endif
#ifndef GEMM_SP2
#define GEMM_SP2 true
#endif
#ifndef N_LAUNCH_MODE
#define N_LAUNCH_MODE 1
#endif

#define DEVI __device__ __forceinline__
#define LAS __attribute__((address_space(3)))

constexpr int D = 1024, SEQ = 16384, NMETA = 16, L = SEQ + NMETA;
constexpr int CONV_CH = 512, CONV_K = 31, HD = 64, TOPK = 256;
constexpr int IN_AB = 3144;
constexpr int OFF_AVAL = 0, OFF_AGATE = 512, OFF_Q = 1024, OFF_K = 1536, OFF_V = 2048, OFF_QI = 2560, OFF_KI = 3072, OFF_WI = 3136;
constexpr int RNN_W = 1280, RNN_NB = 10, RNN_BW = 128, RNN_K = 4;
constexpr int NGRP = 4, EPG = 8, NE = 32, DE = 512;
constexpr int NPAIR = 2 * L;
constexpr float LN_EPS = 1e-5f;
constexpr float DN_ALPHA = 1.41421356237f;
constexpr int NTHREADS = 512;
constexpr int LDS_BYTES = 147456;

#define XB_TMO      128
#define XB_XCNT(j)  (256  + 64 * (j))
#define XB_XSUB(j)  (1280 + 64 * (j))
#define XB_XGEN(j)  (2304 + 64 * (j))
#define XB_TOP      3328
#define XB_TOPGEN   3392
#define XCD_BAR_WORDS 3456
#define XB_SPIN_CAP (1u << 22)
DEVI unsigned xb_ld(unsigned* p)              { return __hip_atomic_load(p, __ATOMIC_RELAXED, __HIP_MEMORY_SCOPE_AGENT); }
DEVI unsigned xb_add(unsigned* p, unsigned v) { return __hip_atomic_fetch_add(p, v, __ATOMIC_RELAXED, __HIP_MEMORY_SCOPE_AGENT); }
DEVI unsigned xb_xcc_id() { return (unsigned)__builtin_amdgcn_s_getreg((3 << 11) | 20) & 0xFu; }
#define XB_SPIN(cond, bar) do { unsigned _sp = 0; while (cond) { __builtin_amdgcn_s_sleep(1); \
    if ((++_sp & 255u) == 0u) { if (xb_ld(&(bar)[XB_TMO])) break; if (_sp > XB_SPIN_CAP) { atomicAdd(&(bar)[XB_TMO], 1u); break; } } } } while (0)
struct XcdBarrier { unsigned* bar; unsigned x; volatile LAS unsigned* st; };
DEVI XcdBarrier xcd_barrier_post(unsigned* bar, volatile LAS unsigned* st) {
    XcdBarrier b; b.bar = bar; b.x = xb_xcc_id(); b.st = st;
    if (threadIdx.x == 0) (void)xb_add(&bar[XB_XCNT(b.x)], 1u);
    return b;
}
DEVI void xcd_barrier_complete(unsigned* bar, unsigned x, unsigned& nloc, unsigned& nx) {
    const unsigned G = gridDim.x * gridDim.y * gridDim.z;
    unsigned sum, cnt, mine, sp = 0u;
    for (;;) {
        sum = 0u; cnt = 0u; mine = 0u;
#pragma unroll
        for (unsigned j = 0; j < 16; ++j) { const unsigned c = xb_ld(&bar[XB_XCNT(j)]); sum += c; cnt += (c > 0u) ? 1u : 0u; mine = (j == x) ? c : mine; }
        if (sum == G) break;
        __builtin_amdgcn_s_sleep(1);
        if ((++sp & 255u) == 0u) { if (xb_ld(&bar[XB_TMO])) break; if (sp > XB_SPIN_CAP) { atomicAdd(&bar[XB_TMO], 1u); break; } }
    }
    nloc = mine > 0u ? mine : 1u; nx = cnt > 0u ? cnt : 1u;
}
DEVI void xcd_barrier(const XcdBarrier& b) {
    asm volatile("s_waitcnt vmcnt(0)" ::: "memory");
    __syncthreads();
    if (threadIdx.x == 0) {
        unsigned* bar = b.bar;
        __builtin_amdgcn_s_waitcnt(0);
        unsigned nloc = b.st[0], nx = b.st[1];
        if (nloc == 0u) { xcd_barrier_complete(bar, b.x, nloc, nx); b.st[0] = nloc; b.st[1] = nx; }
        const unsigned old = xb_add(&bar[XB_XSUB(b.x)], 1u);
        const unsigned gen = old / nloc;
        if (old + 1u == (gen + 1u) * nloc) {
            __builtin_amdgcn_fence(__ATOMIC_RELEASE, "agent");
            asm volatile("s_waitcnt vmcnt(0)" ::: "memory");
            const unsigned og = xb_add(&bar[XB_TOP], 1u);
            const unsigned tg = og / nx;
            if (og + 1u == (tg + 1u) * nx) xb_add(&bar[XB_TOPGEN], 1u);
            else XB_SPIN(xb_ld(&bar[XB_TOPGEN]) == tg, bar);
            __builtin_amdgcn_fence(__ATOMIC_ACQUIRE, "agent");
            xb_add(&bar[XB_XGEN(b.x)], 1u);
            asm volatile("s_waitcnt vmcnt(0)" ::: "memory");
        } else {
            XB_SPIN(xb_ld(&bar[XB_XGEN(b.x)]) == gen, bar);
            __builtin_amdgcn_fence(__ATOMIC_ACQUIRE, "agent");
            asm volatile("s_waitcnt vmcnt(0)" ::: "memory");
        }
    }
    __syncthreads();
}

constexpr int LP = 16640;
constexpr int MAXSLOT = 40960;
constexpr int NCHUNK = 257, CP = 272;
constexpr size_t MiB = 1048576;
constexpr size_t WS_CTL = 0;
constexpr size_t CTL_CNT = 16384;
constexpr size_t CTL_CUR = 16384 + 256;
constexpr size_t CTL_BYTES = 32768;
constexpr size_t WS_ROPEC = 32768;
constexpr size_t WS_ROPES = WS_ROPEC + (size_t)LP * 32 * 4;
constexpr size_t WS_EID = WS_ROPES + (size_t)LP * 32 * 4;
constexpr size_t WS_GW = WS_EID + (size_t)NPAIR * 4;
constexpr size_t WS_SLOT = WS_GW + (size_t)NPAIR * 4;
constexpr size_t WS_MTILES = WS_SLOT + (size_t)NPAIR * 4;
constexpr size_t WS_WTA = WS_MTILES + 4096;
constexpr size_t WS_WTX = WS_WTA + (size_t)RNN_NB * 128 * 128 * 2;
constexpr size_t WS_AEND = WS_WTX + (size_t)RNN_NB * 128 * 128 * 2;
constexpr size_t WS_HEND = WS_AEND + (size_t)RNN_W * CP * 4;
constexpr size_t WS_CIN = WS_HEND + (size_t)RNN_W * CP * 4;
constexpr size_t WS_WR = WS_CIN + (size_t)RNN_W * CP * 4;
constexpr size_t WS_BIG = ((WS_WR + (size_t)2 * 64 * 3 * 64 * 16 + 255) / 256) * 256;
constexpr size_t R_WIN0 = 0;
constexpr size_t R_WOUT0 = R_WIN0 + (size_t)3328 * 1024 * 2;
constexpr size_t R_WGU = R_WOUT0 + (size_t)1024 * 1024 * 2;
constexpr size_t R_WD = R_WGU + (size_t)32 * 1024 * 1024 * 2;
constexpr size_t R_WIN1 = R_WD + (size_t)32 * 1024 * 512 * 2;
constexpr size_t R_WOUT1 = R_WIN1 + (size_t)2560 * 1024 * 2;
static_assert(R_WOUT1 + (size_t)1024 * 1280 * 2 <= 112 * MiB, "weights");
constexpr size_t R_A = 112 * MiB;
constexpr size_t R_H1 = 192 * MiB;
constexpr size_t R_H2 = 257 * MiB;
constexpr size_t R_C = 322 * MiB;
constexpr size_t R_GLU = 322 * MiB;
constexpr size_t SZ512 = (size_t)LP * 512 * 2;
constexpr size_t R_Q = R_GLU + SZ512, R_K = R_Q + SZ512, R_V = R_K + SZ512, R_QI = R_V + SZ512, R_KI = R_QI + SZ512, R_WI = R_KI + (size_t)LP * 64 * 2;
static_assert(R_WI + (size_t)LP * 8 * 4 <= 406 * MiB, "in-proj outputs");
constexpr size_t R_GATE = 322 * MiB;
constexpr size_t R_XR = R_GATE + (size_t)LP * 1280 * 2;
static_assert(R_XR + (size_t)LP * 1280 * 2 <= 406 * MiB, "layer-1 in-proj outputs");
constexpr size_t R_HM = 406 * MiB;
constexpr size_t WS_END = WS_BIG + R_HM + (size_t)MAXSLOT * 512 * 2;
static_assert(WS_END <= 512 * MiB, "ws");

struct Args { const float* in[28]; float* out; unsigned char* ws; int ph_lo, ph_hi; };

DEVI int otid() { int v = (int)threadIdx.x; asm volatile("" : "+v"(v)); return v; }
template <int CTRL> DEVI float dpp_f(float v) { return __int_as_float(__builtin_amdgcn_mov_dpp(__float_as_int(v), CTRL, 0xF, 0xF, true)); }
DEVI float wave_sum(float v) {
    v += dpp_f<0xB1>(v); v += dpp_f<0x4E>(v); v += dpp_f<0x141>(v); v += dpp_f<0x140>(v);
    return __int_as_float(__builtin_amdgcn_readlane(__float_as_int(v), 0)) + __int_as_float(__builtin_amdgcn_readlane(__float_as_int(v), 16))
         + __int_as_float(__builtin_amdgcn_readlane(__float_as_int(v), 32)) + __int_as_float(__builtin_amdgcn_readlane(__float_as_int(v), 48));
}
DEVI float wave_max(float v) {
#pragma unroll
    for (int o = 32; o > 0; o >>= 1) v = fmaxf(v, __shfl_xor(v, o));
    return v;
}
DEVI float sigm(float x) { return 1.0f / (1.0f + expf(-x)); }
DEVI float gelu_tanh(float x) { return 0.5f * x * (1.0f + tanhf(0.7978845608028654f * (x + 0.044715f * x * x * x))); }
DEVI unsigned f2key(float f) { unsigned u = __float_as_uint(f); return (u & 0x80000000u) ? ~u : (u | 0x80000000u); }

namespace pg8 {
#define PG8_LAS __attribute__((address_space(3)))
typedef unsigned short bf16_t;
typedef short bf16x8 __attribute__((ext_vector_type(8)));
typedef float f32x4 __attribute__((ext_vector_type(4)));
typedef unsigned u32x4 __attribute__((ext_vector_type(4)));
constexpr int BM = 256, BK = 64, HALF = 128, HTB = HALF * BK * 2  , STAGE_BYTES = 8 * HTB, NXCD = 8, WGM = 8;

__host__ __device__ __forceinline__ int lds_byte(int r, int c) { const int st = (r >> 4) * 2 + (c >> 5), rr = r & 15, cc = c & 31, ob = rr * 64 + cc * 2; return st * 1024 + (ob ^ (((ob >> 9) & 1) << 5)); }
__host__ __device__ __forceinline__ void stage_rc(int b, int& R, int& C) { const int st = b / 1024, sb = b % 1024, swz = sb ^ (((sb >> 9) & 1) << 5); R = (st >> 1) * 16 + swz / 64; C = (st & 1) * 32 + (swz % 64) / 2; }
__host__ __device__ __forceinline__ int perm32(int rho) { const int n = rho >> 4, i = rho & 15; return 8 * (i >> 2) + 4 * n + (i & 3); }

struct Unit { int pm, pn; };
struct Gemm { const bf16_t* A; const bf16_t* Bt; int M, N, K; };

struct StaticOrder {
    int nM, nN, nwg, G, c;
    __host__ __device__ void init(int M, int N, int G_, int c_) { nM = M / BM; nN = N / BM; nwg = nM * nN; G = G_; c = c_; }
    __host__ __device__ bool next(int i, Unit& u) const {
        const long L = (long)i * G + c; if (L >= nwg) return false;
        int wgid = (int)L; { const int q = nwg / NXCD, r = nwg % NXCD, xcd = wgid % NXCD, off = wgid / NXCD; wgid = (xcd < r ? xcd * (q + 1) : r * (q + 1) + (xcd - r) * q) + off; }
        const int nig = WGM * nN, gid = wgid / nig, fm = gid * WGM, gsz = (nM - fm) < WGM ? (nM - fm) : WGM;
        u.pm = fm + ((wgid % nig) % gsz); u.pn = (wgid % nig) / gsz; return true;
    }
    __device__ __forceinline__ void a_ready(const Unit&) const {}
    __device__ __forceinline__ void done(const Unit&) const {}
};

template <class Epi, class Sched, bool ALIGN_EPI = false, bool SP2 = false>
__device__ __forceinline__ void gemm_phase(PG8_LAS unsigned char* lds, const Gemm g, const Sched& S, const Epi& E) {
    const int tid = threadIdx.x, wid = __builtin_amdgcn_readfirstlane(tid >> 6), lane = tid & 63, wr = wid >> 2, wc = wid & 3, fr = lane & 15, fq = lane >> 4;
    const int K = g.K, nt = K / BK;
    unsigned voffA[2], voffB[2];
#pragma unroll
    for (int i = 0; i < 2; ++i) { int R, C; stage_rc(tid * 16 + i * 8192, R, C); const int Rb = Epi::PERM ? ((R & ~31) + perm32(R & 31)) : R;
        voffA[i] = (unsigned)(R * K + C) * 2u; voffB[i] = (unsigned)(Rb * K + C) * 2u; }
    const size_t kstep = (size_t)(BK * 2);
    const size_t hstep = (size_t)HALF * K * 2;
    const size_t tstep = 2 * hstep;
    const unsigned ldsw = (unsigned)wid * 1024u;
    const int aoff = lds_byte(wr * 64 + fr, fq * 8), boff = lds_byte(wc * 32 + fr, fq * 8);
#define PG8_SA(b, h) (((b) * 2 + (h)) * HTB)
#define PG8_SB(b, h) ((4 + (b) * 2 + (h)) * HTB)
#define PG8_STAGE(bufoff, gbase, voff) do { _Pragma("unroll") for (int _i = 0; _i < 2; ++_i) \
        __builtin_amdgcn_global_load_lds((const unsigned*)((const char*)(gbase) + (voff)[_i]), (PG8_LAS unsigned*)(lds + (bufoff) + ldsw + _i * 8192), 16, 0, 0); } while (0)
#define PG8_LDA(dst, b, h) do { _Pragma("unroll") for (int m = 0; m < 4; ++m) _Pragma("unroll") for (int k = 0; k < 2; ++k) dst[m][k] = *(const PG8_LAS bf16x8*)(lds + PG8_SA(b, h) + aoff + m * 2048 + k * 1024); } while (0)
#define PG8_LDB(dst, b, h) do { _Pragma("unroll") for (int n = 0; n < 2; ++n) _Pragma("unroll") for (int k = 0; k < 2; ++k) dst[n][k] = *(const PG8_LAS bf16x8*)(lds + PG8_SB(b, h) + boff + n * 2048 + k * 1024); } while (0)
#define PG8_MMA(ai, bj, At, Bt) do { __builtin_amdgcn_s_setprio(1); _Pragma("unroll") for (int m = 0; m < 4; ++m) _Pragma("unroll") for (int n = 0; n < 2; ++n) _Pragma("unroll") for (int k = 0; k < 2; ++k) \
        acc[ai][bj][m][n] = __builtin_amdgcn_mfma_f32_16x16x32_bf16(Bt[n][k], At[m][k], acc[ai][bj][m][n], 0, 0, 0); __builtin_amdgcn_s_setprio(0); } while (0)
#define PG8_WAIT_V(n) asm volatile("s_waitcnt vmcnt(" #n ")" ::: "memory")
#define PG8_WAIT_L(n) asm volatile("s_waitcnt lgkmcnt(" #n ")" ::: "memory")
#define PG8_BAR __builtin_amdgcn_s_barrier()
#define PG8_SCHED __builtin_amdgcn_sched_barrier(0)
    Unit cur, nxt; int ui = 0;
    if (!S.next(0, cur)) return;
    f32x4 acc[2][2][4][2];
#pragma unroll
    for (int a = 0; a < 2; ++a)
#pragma unroll
        for (int b = 0; b < 2; ++b)
#pragma unroll
            for (int m = 0; m < 4; ++m)
#pragma unroll
                for (int n = 0; n < 2; ++n) acc[a][b][m][n] = (f32x4){0.f, 0.f, 0.f, 0.f};
    bf16x8 At[4][2], B0[2][2], B1[2][2];
    const char* cA = (const char*)g.A + (size_t)cur.pm * tstep; const char* cB = (const char*)g.Bt + (size_t)cur.pn * tstep;
    S.a_ready(cur);
    if constexpr (SP2) {
        PG8_STAGE(PG8_SB(0, 0), cB, voffB); PG8_STAGE(PG8_SB(0, 1), cB + hstep, voffB); PG8_STAGE(PG8_SA(0, 0), cA, voffA); PG8_STAGE(PG8_SA(0, 1), cA + hstep, voffA);
        if (wr == 1) PG8_BAR;
        PG8_WAIT_V(2); PG8_BAR;
        PG8_STAGE(PG8_SB(1, 0), cB + kstep, voffB); PG8_STAGE(PG8_SA(1, 0), cA + kstep, voffA); PG8_STAGE(PG8_SB(1, 1), cB + hstep + kstep, voffB);
        PG8_WAIT_V(6); PG8_BAR;
    } else {
        PG8_STAGE(PG8_SB(0, 0), cB, voffB); PG8_STAGE(PG8_SA(0, 0), cA, voffA); PG8_STAGE(PG8_SB(0, 1), cB + hstep, voffB); PG8_STAGE(PG8_SA(0, 1), cA + hstep, voffA);
        if (wr == 1) PG8_BAR;
        PG8_WAIT_V(4); PG8_BAR;
        PG8_STAGE(PG8_SB(1, 0), cB + kstep, voffB); PG8_STAGE(PG8_SA(1, 0), cA + kstep, voffA); PG8_STAGE(PG8_SB(1, 1), cB + hstep + kstep, voffB);
        PG8_WAIT_V(6); PG8_BAR;
    }
    for (;;) {
        const bool has_next = S.next(ui + 1, nxt);
        const char* nA = has_next ? (const char*)g.A + (size_t)nxt.pm * tstep : cA; const char* nB = has_next ? (const char*)g.Bt + (size_t)nxt.pn * tstep : cB;
        for (int t = 0; t < nt; t += 2) {
            const bool last = (t == nt - 2);
            const char* a1 = cA + (size_t)(t + 1) * kstep;
            const char* a2 = last ? nA : cA + (size_t)(t + 2) * kstep; const char* b2 = last ? nB : cB + (size_t)(t + 2) * kstep;
            const char* a3 = a2 + kstep; const char* b3 = b2 + kstep;
            if (last && has_next) S.a_ready(nxt);
            if constexpr (SP2) {
            PG8_LDB(B0, 0, 0); PG8_LDB(B1, 0, 1); PG8_SCHED; PG8_LDA(At, 0, 0); PG8_STAGE(PG8_SA(1, 1), a1 + hstep, voffA);
            PG8_WAIT_V(8); PG8_WAIT_L(0); PG8_BAR; PG8_MMA(0, 0, At, B0); PG8_MMA(0, 1, At, B1); PG8_BAR; PG8_SCHED;
            PG8_LDA(At, 0, 1); PG8_STAGE(PG8_SB(0, 0), b2, voffB); PG8_STAGE(PG8_SB(0, 1), b2 + hstep, voffB); PG8_STAGE(PG8_SA(0, 0), a2, voffA);
            PG8_WAIT_V(8); PG8_WAIT_L(0); PG8_BAR; PG8_MMA(1, 0, At, B0); PG8_MMA(1, 1, At, B1); PG8_BAR; PG8_SCHED;
            PG8_LDB(B0, 1, 0); PG8_LDB(B1, 1, 1); PG8_SCHED; PG8_LDA(At, 1, 0); PG8_STAGE(PG8_SA(0, 1), a2 + hstep, voffA);
            PG8_WAIT_V(8); PG8_WAIT_L(0); PG8_BAR; PG8_MMA(0, 0, At, B0); PG8_MMA(0, 1, At, B1); PG8_BAR; PG8_SCHED;
            PG8_LDA(At, 1, 1); PG8_STAGE(PG8_SB(1, 0), b3, voffB); PG8_STAGE(PG8_SB(1, 1), b3 + hstep, voffB); PG8_STAGE(PG8_SA(1, 0), a3, voffA);
            PG8_WAIT_V(8); PG8_WAIT_L(0); PG8_BAR; PG8_MMA(1, 0, At, B0); PG8_MMA(1, 1, At, B1); PG8_BAR; PG8_SCHED;
            } else {
            PG8_LDB(B0, 0, 0); PG8_SCHED; PG8_LDA(At, 0, 0); PG8_STAGE(PG8_SA(1, 1), a1 + hstep, voffA);
            PG8_WAIT_L(8); PG8_BAR; PG8_WAIT_L(0); PG8_MMA(0, 0, At, B0); PG8_BAR; PG8_SCHED;
            PG8_LDB(B1, 0, 1); PG8_STAGE(PG8_SB(0, 0), b2, voffB);
            PG8_BAR; PG8_WAIT_L(0); PG8_MMA(0, 1, At, B1); PG8_BAR;
            PG8_LDA(At, 0, 1); PG8_STAGE(PG8_SA(0, 0), a2, voffA);
            PG8_BAR; PG8_WAIT_L(0); PG8_MMA(1, 0, At, B0); PG8_BAR; PG8_SCHED;
            PG8_STAGE(PG8_SB(0, 1), b2 + hstep, voffB);
            PG8_WAIT_V(6); PG8_BAR; PG8_MMA(1, 1, At, B1); PG8_BAR;
            PG8_LDB(B0, 1, 0); PG8_SCHED; PG8_LDA(At, 1, 0); PG8_STAGE(PG8_SA(0, 1), a2 + hstep, voffA);
            PG8_WAIT_L(8); PG8_BAR; PG8_WAIT_L(0); PG8_MMA(0, 0, At, B0); PG8_BAR; PG8_SCHED;
            PG8_LDB(B1, 1, 1); PG8_STAGE(PG8_SB(1, 0), b3, voffB);
            PG8_BAR; PG8_WAIT_L(0); PG8_MMA(0, 1, At, B1); PG8_BAR;
            PG8_LDA(At, 1, 1); PG8_STAGE(PG8_SA(1, 0), a3, voffA);
            PG8_BAR; PG8_WAIT_L(0); PG8_MMA(1, 0, At, B0); PG8_BAR; PG8_SCHED;
            PG8_STAGE(PG8_SB(1, 1), b3 + hstep, voffB);
            PG8_WAIT_V(6); PG8_BAR; PG8_MMA(1, 1, At, B1); PG8_BAR;
            }
        }
        if constexpr (ALIGN_EPI) { if (wr == 0) PG8_BAR; }
        if constexpr (!Epi::AFTER_DRAIN) { E(acc, cur, wr, wc, fr, fq); S.done(cur); }
        if (!has_next) break;
#pragma unroll
        for (int a = 0; a < 2; ++a)
#pragma unroll
            for (int b = 0; b < 2; ++b)
#pragma unroll
                for (int m = 0; m < 4; ++m)
#pragma unroll
                    for (int n = 0; n < 2; ++n) acc[a][b][m][n] = (f32x4){0.f, 0.f, 0.f, 0.f};
        cur = nxt; cA = nA; cB = nB; ++ui;
        if constexpr (ALIGN_EPI) { if (wr == 1) PG8_BAR; }
    }
    PG8_WAIT_V(0);
    if constexpr (!ALIGN_EPI) { if (wr == 0) PG8_BAR; }
    PG8_BAR;
    if constexpr (Epi::AFTER_DRAIN) { E.fused(acc, cur, wr, wc, fr, fq, lds, wid, lane); S.done(cur); }
#undef PG8_SA
#undef PG8_SB
#undef PG8_STAGE
#undef PG8_LDA
#undef PG8_LDB
#undef PG8_MMA
#undef PG8_WAIT_V
#undef PG8_WAIT_L
#undef PG8_BAR
#undef PG8_SCHED
}
}

DEVI void ln_row1024(float (&y)[16], const float* g, const float* b, int lane) {
    float s = 0.f;
#pragma unroll
    for (int i = 0; i < 16; ++i) s += y[i];
    const float mu = wave_sum(s) * (1.0f / 1024.0f);
    float q = 0.f;
#pragma unroll
    for (int i = 0; i < 16; ++i) { const float d = y[i] - mu; q += d * d; }
    const float rstd = 1.0f / sqrtf(wave_sum(q) * (1.0f / 1024.0f) + LN_EPS);
#pragma unroll
    for (int i = 0; i < 16; ++i) y[i] = (y[i] - mu) * rstd * g[lane + 64 * i] + b[lane + 64 * i];
}

DEVI void route_token(const float (&y)[16], float* ys, int t, int lane, const float* wg, const float* bg, const float* we, const float* be, int* eid, float* gw, unsigned* counts) {
    float lg[36];
#pragma unroll
    for (int j = 0; j < 36; ++j) lg[j] = 0.f;
#pragma unroll
    for (int i = 0; i < 16; ++i) ys[lane + 64 * i] = y[i];
#pragma unroll 1
    for (int i = 0; i < 16; ++i) {
        const int c = lane + 64 * i;
        const float yv = ys[c];
        const float4 g4 = *(const float4*)(wg + (size_t)c * 4);
        lg[0] += yv * g4.x; lg[1] += yv * g4.y; lg[2] += yv * g4.z; lg[3] += yv * g4.w;
#pragma unroll
        for (int j = 0; j < 8; ++j) { const float4 e4 = *(const float4*)(we + (size_t)c * 32 + j * 4);
            lg[4 + j * 4 + 0] += yv * e4.x; lg[4 + j * 4 + 1] += yv * e4.y; lg[4 + j * 4 + 2] += yv * e4.z; lg[4 + j * 4 + 3] += yv * e4.w; }
    }
#pragma unroll
    for (int j = 0; j < 36; ++j) lg[j] = wave_sum(lg[j]);
    if (lane == 0) {
        float gl[4]; int g = 0;
#pragma unroll
        for (int j = 0; j < 4; ++j) gl[j] = lg[j] + bg[j];
#pragma unroll
        for (int j = 1; j < 4; ++j) if (gl[j] > gl[g]) g = j;
        float den = 0.f;
#pragma unroll
        for (int j = 0; j < 4; ++j) den += expf(gl[j] - gl[g]);
        const float gp = 1.0f / den;
        float el[8];
#pragma unroll
        for (int j = 0; j < 8; ++j) { float v = 0.f;
#pragma unroll
            for (int gg = 0; gg < 4; ++gg) v = (gg == g) ? lg[4 + gg * 8 + j] + be[gg * 8 + j] : v;
            el[j] = v; }
        int i1 = 0;
#pragma unroll
        for (int j = 1; j < 8; ++j) if (el[j] > el[i1]) i1 = j;
        int i2 = (i1 == 0) ? 1 : 0;
#pragma unroll
        for (int j = 0; j < 8; ++j) if (j != i1 && el[j] > el[i2]) i2 = j;
        const float ex = expf(el[i2] - el[i1]);
        const float p1 = 1.0f / (1.0f + ex), p2 = ex / (1.0f + ex);
        const int e1 = g * 8 + i1, e2 = g * 8 + i2;
        eid[2 * t] = e1; eid[2 * t + 1] = e2; gw[2 * t] = gp * p1; gw[2 * t + 1] = gp * p2;
        atomicAdd(&counts[e1], 1u); atomicAdd(&counts[e2], 1u);
    }
}


DEVI void ln_row1024v(float (&y)[16], const float* g, const float* b, int lane) {
    float s = 0.f;
#pragma unroll
    for (int i = 0; i < 16; ++i) s += y[i];
    const float mu = wave_sum(s) * (1.0f / 1024.0f);
    float q = 0.f;
#pragma unroll
    for (int i = 0; i < 16; ++i) { const float d = y[i] - mu; q += d * d; }
    const float rstd = 1.0f / sqrtf(wave_sum(q) * (1.0f / 1024.0f) + LN_EPS);
#pragma unroll
    for (int i4 = 0; i4 < 4; ++i4) { const float4 g4 = *(const float4*)(g + 16 * lane + 4 * i4), b4 = *(const float4*)(b + 16 * lane + 4 * i4);
        y[4 * i4] = (y[4 * i4] - mu) * rstd * g4.x + b4.x; y[4 * i4 + 1] = (y[4 * i4 + 1] - mu) * rstd * g4.y + b4.y; y[4 * i4 + 2] = (y[4 * i4 + 2] - mu) * rstd * g4.z + b4.z; y[4 * i4 + 3] = (y[4 * i4 + 3] - mu) * rstd * g4.w + b4.w; }
}
DEVI void combine_row(float (&y)[16], const float* h, const unsigned short* Y0, const unsigned short* Y1, float g0, float g1, int lane) {
    const uint4 a0 = *(const uint4*)(Y0 + 16 * lane), a1 = *(const uint4*)(Y0 + 16 * lane + 8), b0 = *(const uint4*)(Y1 + 16 * lane), b1 = *(const uint4*)(Y1 + 16 * lane + 8);
    const unsigned aw[8] = {a0.x, a0.y, a0.z, a0.w, a1.x, a1.y, a1.z, a1.w}, bw[8] = {b0.x, b0.y, b0.z, b0.w, b1.x, b1.y, b1.z, b1.w};
#pragma unroll
    for (int i4 = 0; i4 < 4; ++i4) { const float4 hv = *(const float4*)(h + 16 * lane + 4 * i4);
        y[4 * i4]     = DN_ALPHA * hv.x + (g0 * __uint_as_float(aw[2 * i4] << 16) + g1 * __uint_as_float(bw[2 * i4] << 16));
        y[4 * i4 + 1] = DN_ALPHA * hv.y + (g0 * __uint_as_float(aw[2 * i4] & 0xFFFF0000u) + g1 * __uint_as_float(bw[2 * i4] & 0xFFFF0000u));
        y[4 * i4 + 2] = DN_ALPHA * hv.z + (g0 * __uint_as_float(aw[2 * i4 + 1] << 16) + g1 * __uint_as_float(bw[2 * i4 + 1] << 16));
        y[4 * i4 + 3] = DN_ALPHA * hv.w + (g0 * __uint_as_float(aw[2 * i4 + 1] & 0xFFFF0000u) + g1 * __uint_as_float(bw[2 * i4 + 1] & 0xFFFF0000u)); }
}
typedef float f32x4v __attribute__((ext_vector_type(4)));
DEVI void ln_route_block(int tb, int ntok, const float* Zsrc, float* Hdst, const float* g, const float* b, const float4* __restrict__ Wr, const float* bg, const float* be,
                         int* eid, float* gw, unsigned* counts, float* sm) {
    const int tid = otid(), lane = tid & 63, wave = tid >> 6;
    for (int i = 0; i < 8; ++i) { const int tl = wave * 8 + i;
        if (tl < ntok) { const size_t t = (size_t)(tb + tl); float y[16];
#pragma unroll
            for (int i4 = 0; i4 < 4; ++i4) { const float4 v = *(const float4*)(Zsrc + t * D + 16 * lane + 4 * i4); y[4 * i4] = v.x; y[4 * i4 + 1] = v.y; y[4 * i4 + 2] = v.z; y[4 * i4 + 3] = v.w; }
            ln_row1024v(y, g, b, lane);
#pragma unroll
            for (int i4 = 0; i4 < 4; ++i4) *(float4*)(Hdst + t * D + 16 * lane + 4 * i4) = make_float4(y[4 * i4], y[4 * i4 + 1], y[4 * i4 + 2], y[4 * i4 + 3]); } }
    asm volatile("s_waitcnt vmcnt(0)" ::: "memory");
    __syncthreads();
    const int grp = wave & 3, khalf = wave >> 2;
    if (grp * 16 < ntok) {
        const int t0 = tb + 16 * grp, row = lane & 15, kg = lane >> 4;
        f32x4v acc[3];
#pragma unroll
        for (int ct = 0; ct < 3; ++ct) acc[ct] = (f32x4v){0.f, 0.f, 0.f, 0.f};
        const float* arow = Hdst + (size_t)(t0 + row) * D + 4 * kg;
#pragma unroll 4
        for (int sstep = 32 * khalf; sstep < 32 * khalf + 32; ++sstep) {
            const float4 a4 = *(const float4*)(arow + 16 * sstep);
#pragma unroll
            for (int ct = 0; ct < 3; ++ct) { const float4 b4 = Wr[(sstep * 3 + ct) * 64 + lane];
                acc[ct] = __builtin_amdgcn_mfma_f32_16x16x4f32(a4.x, b4.x, acc[ct], 0, 0, 0); acc[ct] = __builtin_amdgcn_mfma_f32_16x16x4f32(a4.y, b4.y, acc[ct], 0, 0, 0);
                acc[ct] = __builtin_amdgcn_mfma_f32_16x16x4f32(a4.z, b4.z, acc[ct], 0, 0, 0); acc[ct] = __builtin_amdgcn_mfma_f32_16x16x4f32(a4.w, b4.w, acc[ct], 0, 0, 0); }
        }
        float* Lg = sm + (khalf * 4 + grp) * 16 * 48;
#pragma unroll
        for (int ct = 0; ct < 3; ++ct)
#pragma unroll
            for (int j = 0; j < 4; ++j) Lg[(4 * kg + j) * 48 + 16 * ct + row] = acc[ct][j];
    }
    __syncthreads();
    if (wave < 4 && wave * 16 < ntok) {
        const int t0 = tb + 16 * wave;
        if (lane < 16) {
            const int t = t0 + lane; const float* lgA = sm + wave * 16 * 48 + lane * 48; const float* lgB = lgA + 4 * 16 * 48;
            float lg[36];
#pragma unroll
            for (int j = 0; j < 36; ++j) lg[j] = lgA[j] + lgB[j];
            float gl[4]; int gsel = 0;
#pragma unroll
            for (int j = 0; j < 4; ++j) gl[j] = lg[j] + bg[j];
#pragma unroll
            for (int j = 1; j < 4; ++j) if (gl[j] > gl[gsel]) gsel = j;
            float den = 0.f;
#pragma unroll
            for (int j = 0; j < 4; ++j) den += expf(gl[j] - gl[gsel]);
            const float gp = 1.0f / den;
            float el[8];
#pragma unroll
            for (int j = 0; j < 8; ++j) { float v = lg[4 + j];
#pragma unroll
                for (int gg = 1; gg < 4; ++gg) v = (gg == gsel) ? lg[4 + gg * 8 + j] : v;
                el[j] = v + be[gsel * 8 + j]; }
            int i1 = 0;
#pragma unroll
            for (int j = 1; j < 8; ++j) if (el[j] > el[i1]) i1 = j;
            int i2 = (i1 == 0) ? 1 : 0;
#pragma unroll
            for (int j = 0; j < 8; ++j) if (j != i1 && el[j] > el[i2]) i2 = j;
            float e1v = el[0], e2v = el[0];
#pragma unroll
            for (int j = 0; j < 8; ++j) { e1v = (j == i1) ? el[j] : e1v; e2v = (j == i2) ? el[j] : e2v; }
            const float ex = expf(e2v - e1v);
            const float p1 = 1.0f / (1.0f + ex), p2 = ex / (1.0f + ex);
            const int e1 = gsel * 8 + i1, e2 = gsel * 8 + i2;
            eid[2 * t] = e1; eid[2 * t + 1] = e2; gw[2 * t] = gp * p1; gw[2 * t + 1] = gp * p2;
            atomicAdd(&counts[e1], 1u); atomicAdd(&counts[e2], 1u);
        }
    }
    __syncthreads();
}

using pg8::f32x4; using pg8::Unit; typedef unsigned short bf16_t;
DEVI float bf2f(unsigned short b) { return __uint_as_float(((unsigned)b) << 16); }
DEVI float bflo(unsigned w) { return __uint_as_float(w << 16); }
DEVI float bfhi(unsigned w) { return __uint_as_float(w & 0xFFFF0000u); }
DEVI unsigned cvt_pk_bf16(float lo, float hi) { unsigned r; asm volatile("v_cvt_pk_bf16_f32 %0, %1, %2" : "=v"(r) : "v"(lo), "v"(hi)); return r; }
DEVI uint2 pack4(const f32x4 v) { return make_uint2(cvt_pk_bf16(v[0], v[1]), cvt_pk_bf16(v[2], v[3])); }
DEVI float fsigm(float x) { return __builtin_amdgcn_rcpf(1.0f + __expf(-x)); }
DEVI unsigned pack4_fp8(const f32x4 v) { int w = __builtin_amdgcn_cvt_pk_fp8_f32(v[0], v[1], 0, false); w = __builtin_amdgcn_cvt_pk_fp8_f32(v[2], v[3], w, true); return (unsigned)w; }

DEVI int in0_srccol(int n) {
    if (n < 1024) { const int G = n >> 5, nn = (n >> 4) & 1, i = n & 15; return (nn ? OFF_AGATE : OFF_AVAL) + 16 * G + i; }
    if (n < 2048 || (n >= 2560 && n < 3072)) {
        const int base = n < 1536 ? OFF_Q : n < 2048 ? OFF_K : OFF_QI; const int loc = n & 511;
        const int G = loc >> 5, nn = (loc >> 4) & 1, i = loc & 15; return base + 64 * (G >> 1) + 32 * nn + 16 * (G & 1) + i; }
    if (n < 2560) return OFF_V + (n - 2048);
    if (n < 3136) { const int loc = n - 3072; const int G = loc >> 5, nn = (loc >> 4) & 1, i = loc & 15; return OFF_KI + 32 * nn + 16 * G + i; }
    if (n < 3144) return OFF_WI + (n - 3136);
    return -1;
}
struct EpiIn0 {
    static constexpr bool PERM = false, AFTER_DRAIN = false;
    bf16_t* GLU; bf16_t* KI; float* WI; const float* ropeC; const float* ropeS; unsigned char* KV8;
    DEVI void operator()(const f32x4 (&acc)[2][2][4][2], const Unit& u, int wr, int wc, int fr, int fq) const {
        const int pn = u.pn; const int rbase = u.pm * 256 + wr * 64 + fr;
        if (pn < 4) {
#pragma unroll
            for (int ai = 0; ai < 2; ++ai)
#pragma unroll
                for (int m = 0; m < 4; ++m) { const size_t row = rbase + ai * 128 + m * 16;
#pragma unroll
                    for (int bj = 0; bj < 2; ++bj) { const int G = 8 * pn + 4 * bj + wc; const f32x4 v = acc[ai][bj][m][0], g = acc[ai][bj][m][1]; f32x4 o;
#pragma unroll
                        for (int j = 0; j < 4; ++j) o[j] = v[j] * fsigm(g[j]);
                        *(uint2*)(GLU + row * 512 + 16 * G + 4 * fq) = pack4(o); } }
        } else if (pn == 8 || pn == 9) {
#pragma unroll
            for (int ai = 0; ai < 2; ++ai)
#pragma unroll
                for (int m = 0; m < 4; ++m) { const size_t row = rbase + ai * 128 + m * 16;
#pragma unroll
                    for (int bj = 0; bj < 2; ++bj)
#pragma unroll
                        for (int n = 0; n < 2; ++n) { const int col = 256 * (pn - 8) + 128 * bj + 32 * wc + 16 * n + 4 * fq;
                            *(unsigned*)(KV8 + row * 1024 + (size_t)(col >> 3) * 16 + 8 + (col & 7)) = pack4_fp8(acc[ai][bj][m][n]); } }
        } else if (pn == 12) {
            if (wc < 2) { const int d0 = 16 * wc + 4 * fq;
#pragma unroll
                for (int ai = 0; ai < 2; ++ai)
#pragma unroll
                    for (int m = 0; m < 4; ++m) { const size_t row = rbase + ai * 128 + m * 16;
                        const f32x4 c = *(const f32x4*)(ropeC + row * 32 + d0), s = *(const f32x4*)(ropeS + row * 32 + d0);
                        const f32x4 t1 = acc[ai][0][m][0], t2 = acc[ai][0][m][1];
                        *(uint2*)(KI + row * 64 + d0) = pack4(t1 * c - t2 * s); *(uint2*)(KI + row * 64 + 32 + d0) = pack4(t1 * s + t2 * c); }
            } else if (wc == 2 && fq < 2) {
#pragma unroll
                for (int ai = 0; ai < 2; ++ai)
#pragma unroll
                    for (int m = 0; m < 4; ++m) { const size_t row = rbase + ai * 128 + m * 16; *(f32x4*)(WI + row * 8 + 4 * fq) = acc[ai][0][m][0] * 0.35355339059327373f; }
            }
        } else {
            bf16_t* dst = GLU + (size_t)(pn < 6 ? 1 : pn < 8 ? 2 : 4) * LP * 512; const int pl = pn & 1; const int d0 = 16 * (wc & 1) + 4 * fq;
#pragma unroll
            for (int ai = 0; ai < 2; ++ai)
#pragma unroll
                for (int m = 0; m < 4; ++m) { const size_t row = rbase + ai * 128 + m * 16;
                    const f32x4 c = *(const f32x4*)(ropeC + row * 32 + d0), s = *(const f32x4*)(ropeS + row * 32 + d0);
#pragma unroll
                    for (int bj = 0; bj < 2; ++bj) { const int hh = 4 * pl + 2 * bj + (wc >> 1); const f32x4 t1 = acc[ai][bj][m][0], t2 = acc[ai][bj][m][1];
                        if (pn == 6 || pn == 7) { const int da = 64 * hh + d0, db = da + 32;
                            *(unsigned*)(KV8 + row * 1024 + (size_t)(da >> 3) * 16 + (da & 7)) = pack4_fp8(t1 * c - t2 * s); *(unsigned*)(KV8 + row * 1024 + (size_t)(db >> 3) * 16 + (db & 7)) = pack4_fp8(t1 * s + t2 * c);
                        } else { *(uint2*)(dst + row * 512 + 64 * hh + d0) = pack4(t1 * c - t2 * s); *(uint2*)(dst + row * 512 + 64 * hh + 32 + d0) = pack4(t1 * s + t2 * c); } } }
        }
    }
};
struct EpiRes0 {
    static constexpr bool PERM = false, AFTER_DRAIN = false;
    const float* x; const float* meta; float* Z;
    DEVI void operator()(const f32x4 (&acc)[2][2][4][2], const Unit& u, int wr, int wc, int fr, int fq) const {
        const int rbase = u.pm * 256 + wr * 64 + fr, cbase = u.pn * 256 + wc * 32 + 4 * fq;
#pragma unroll
        for (int ai = 0; ai < 2; ++ai)
#pragma unroll
            for (int m = 0; m < 4; ++m) { const int row = rbase + ai * 128 + m * 16;
                if (row < L) { const float* rs = row < NMETA ? meta + (size_t)row * D : x + (size_t)(row - NMETA) * D;
#pragma unroll
                    for (int bj = 0; bj < 2; ++bj)
#pragma unroll
                        for (int n = 0; n < 2; ++n) { const int col = cbase + 128 * bj + 16 * n; const f32x4 r4 = *(const f32x4*)(rs + col); *(f32x4*)(Z + (size_t)row * D + col) = r4 * DN_ALPHA + acc[ai][bj][m][n]; } } }
    }
};
struct EpiGateUp {
    static constexpr bool PERM = false, AFTER_DRAIN = false;
    bf16_t* Hm;
    DEVI void operator()(const f32x4 (&acc)[2][2][4][2], const Unit& u, int wr, int wc, int fr, int fq) const {
        const int pl = u.pn & 3; const int rbase = u.pm * 256 + wr * 64 + fr;
#pragma unroll
        for (int ai = 0; ai < 2; ++ai)
#pragma unroll
            for (int m = 0; m < 4; ++m) { const size_t row = rbase + ai * 128 + m * 16;
#pragma unroll
                for (int bj = 0; bj < 2; ++bj) { const int G = 8 * pl + 4 * bj + wc; const f32x4 g = acc[ai][bj][m][0], up = acc[ai][bj][m][1]; f32x4 o;
#pragma unroll
                    for (int j = 0; j < 4; ++j) o[j] = g[j] * fsigm(g[j]) * up[j];
                    *(uint2*)(Hm + row * 512 + 16 * G + 4 * fq) = pack4(o); } }
    }
};
struct EpiDown {
    static constexpr bool PERM = false, AFTER_DRAIN = false;
    bf16_t* Y;
    DEVI void operator()(const f32x4 (&acc)[2][2][4][2], const Unit& u, int wr, int wc, int fr, int fq) const {
        const int pl = u.pn & 3; const int rbase = u.pm * 256 + wr * 64 + fr, cbase = pl * 256 + wc * 32 + 4 * fq;
#pragma unroll
        for (int ai = 0; ai < 2; ++ai)
#pragma unroll
            for (int m = 0; m < 4; ++m) { const size_t row = rbase + ai * 128 + m * 16;
#pragma unroll
                for (int bj = 0; bj < 2; ++bj)
#pragma unroll
                    for (int n = 0; n < 2; ++n) *(uint2*)(Y + row * 1024 + cbase + 128 * bj + 16 * n) = pack4(acc[ai][bj][m][n]); }
    }
};
struct MoeOrder {
    const int* mt; int nunits, G, c;
    DEVI void init(const int* t, int G_, int c_) { mt = t; nunits = t[0] * 4; G = G_; c = c_; }
    DEVI bool next(int i, Unit& u) const { const int li = i * G + c; if (li >= nunits) return false; const int ti = li >> 2; u.pm = ti; u.pn = mt[4 + ti] * 4 + (li & 3); return true; }
    DEVI void a_ready(const Unit&) const {}
    DEVI void done(const Unit&) const {}
};

template <class F> DEVI void tr_tile(bf16_t* dst, int K, int n0, int k0, F src, float* sm) {
    const int tid = otid();
    __syncthreads();
    { const int nn = tid & 63, kb = tid >> 6;
#pragma unroll
      for (int p = 0; p < 8; ++p) { const int kk = kb + 8 * p; sm[kk * 65 + nn] = src(n0 + nn, k0 + kk); } }
    __syncthreads();
    { const int nn = tid >> 3, kq = (tid & 7) * 8; float v[8];
#pragma unroll
      for (int j = 0; j < 8; ++j) v[j] = sm[(kq + j) * 65 + nn];
      uint4 w; w.x = cvt_pk_bf16(v[0], v[1]); w.y = cvt_pk_bf16(v[2], v[3]); w.z = cvt_pk_bf16(v[4], v[5]); w.w = cvt_pk_bf16(v[6], v[7]);
      *(uint4*)(dst + (size_t)(n0 + nn) * K + k0 + kq) = w; }
}

struct TrJob { bf16_t* dst; const float* s0; const float* s1; int K, n0, k0, ld, mode; };
DEVI float tr_src(const TrJob& J, int n, int k) {
    if (J.mode == 0) return __builtin_nontemporal_load(J.s0 + (size_t)k * J.ld + n);
    if (J.mode == 1) { const int sc = in0_srccol(n); return sc < 0 ? 0.f : __builtin_nontemporal_load(J.s0 + (size_t)k * IN_AB + sc); }
    const int ch = (n >> 5) * 16 + (n & 15); return ((n >> 4) & 1) ? __builtin_nontemporal_load(J.s1 + (size_t)k * DE + ch) : __builtin_nontemporal_load(J.s0 + (size_t)k * DE + ch);
}
DEVI void tr_fetch(const TrJob& J, float (&v)[8]) {
    const int tid = otid(), nn = tid & 63, kb = tid >> 6;
#pragma unroll
    for (int p = 0; p < 8; ++p) v[p] = tr_src(J, J.n0 + nn, J.k0 + kb + 8 * p);
}
DEVI void tr_commit(const TrJob& J, const float (&v)[8], float* sm) {
    const int tid = otid();
    __syncthreads();
    { const int nn = tid & 63, kb = tid >> 6;
#pragma unroll
      for (int p = 0; p < 8; ++p) sm[(kb + 8 * p) * 65 + nn] = v[p]; }
    __syncthreads();
    { const int nn = tid >> 3, kq = (tid & 7) * 8; float x[8];
#pragma unroll
      for (int j = 0; j < 8; ++j) x[j] = sm[(kq + j) * 65 + nn];
      uint4 w; w.x = cvt_pk_bf16(x[0], x[1]); w.y = cvt_pk_bf16(x[2], x[3]); w.z = cvt_pk_bf16(x[4], x[5]); w.w = cvt_pk_bf16(x[6], x[7]);
      *(uint4*)(J.dst + (size_t)(J.n0 + nn) * J.K + J.k0 + kq) = w; }
}
template <class Dec> DEVI void tr_run(int njobs, Dec dec, float* sm) {
    int j = blockIdx.x; const int G = gridDim.x;
    TrJob Ja{}, Jb{}; float va[8], vb[8];
    if (j < njobs) { Ja = dec(j); tr_fetch(Ja, va); }
    while (j < njobs) {
        int jn = j + G; if (jn < njobs) { Jb = dec(jn); tr_fetch(Jb, vb); }
        tr_commit(Ja, va, sm);
        j = jn; if (j >= njobs) break;
        jn = j + G; if (jn < njobs) { Ja = dec(jn); tr_fetch(Ja, va); }
        tr_commit(Jb, vb, sm);
        j = jn;
    }
    __syncthreads();
}

DEVI void moe_dispatch_mfma(const float* H, const int* eid, const unsigned* counts, unsigned* cursor, int* slot, int* mtiles, bf16_t* Xperm, int* sm_i, int gwave, int nwaves, int lane, int p_begin) {
    if (otid() == 0) { int o = 0; for (int e = 0; e < NE; ++e) { sm_i[e] = o; o += (((int)counts[e] + 255) >> 8) << 8; } }
    __syncthreads();
    for (int pb = p_begin + gwave * 16; pb < NPAIR; pb += nwaves * 16) {
        int sl = 0;
        if (lane < 16 && pb + lane < NPAIR) { const int e = eid[pb + lane]; sl = sm_i[e] + (int)atomicAdd(&cursor[e], 1u); slot[pb + lane] = sl; }
#pragma unroll 4
        for (int k = 0; k < 16; ++k) { const int p = pb + k; if (p >= NPAIR) break;
            const int s = __shfl(sl, k);
            const float4* src = (const float4*)(H + (size_t)(p >> 1) * D); uint2* dst = (uint2*)(Xperm + (size_t)s * D);
#pragma unroll
            for (int r = 0; r < 4; ++r) { const float4 v = src[lane + 64 * r]; dst[lane + 64 * r] = make_uint2(cvt_pk_bf16(v.x, v.y), cvt_pk_bf16(v.z, v.w)); } }
    }
    if (blockIdx.x == 0 && otid() == 0) { int n = 0; for (int e = 0; e < NE; ++e) { const int nt = ((int)counts[e] + 255) >> 8; for (int i = 0; i < nt; ++i) mtiles[4 + n++] = e; } mtiles[0] = n; }
    __syncthreads();
}

DEVI float gelu_fast(float x) { return x * fsigm(1.5957691216057308f * (x + 0.044715f * x * x * x)); }
struct EpiIn1 {
    static constexpr bool PERM = false, AFTER_DRAIN = false;
    bf16_t* G;
    DEVI void operator()(const f32x4 (&acc)[2][2][4][2], const Unit& u, int wr, int wc, int fr, int fq) const {
        const int pn = u.pn; const bool is_gate = pn < 5; const int rbase = u.pm * 256 + wr * 64 + fr;
        bf16_t* dst = G + (is_gate ? (size_t)0 : (size_t)LP * RNN_W) + (size_t)((is_gate ? pn : pn - 5) * 256 + wc * 32 + 4 * fq);
#pragma unroll
        for (int ai = 0; ai < 2; ++ai)
#pragma unroll
            for (int m = 0; m < 4; ++m) { const size_t row = rbase + ai * 128 + m * 16;
#pragma unroll
                for (int bj = 0; bj < 2; ++bj)
#pragma unroll
                    for (int n = 0; n < 2; ++n) { f32x4 v = acc[ai][bj][m][n];
                        if (is_gate) {
#pragma unroll
                            for (int j = 0; j < 4; ++j) v[j] = gelu_fast(v[j]); }
                        *(uint2*)(dst + row * RNN_W + 128 * bj + 16 * n) = pack4(v); } }
    }
};
struct EpiRes1 {
    static constexpr bool PERM = false, AFTER_DRAIN = false;
    const float* R; float* Z;
    DEVI void operator()(const f32x4 (&acc)[2][2][4][2], const Unit& u, int wr, int wc, int fr, int fq) const {
        const int rbase = u.pm * 256 + wr * 64 + fr, cbase = u.pn * 256 + wc * 32 + 4 * fq;
#pragma unroll
        for (int ai = 0; ai < 2; ++ai)
#pragma unroll
            for (int m = 0; m < 4; ++m) { const size_t row = rbase + ai * 128 + m * 16;
#pragma unroll
                for (int bj = 0; bj < 2; ++bj)
#pragma unroll
                    for (int n = 0; n < 2; ++n) { const int col = cbase + 128 * bj + 16 * n; const f32x4 r4 = *(const f32x4*)(R + row * D + col); *(f32x4*)(Z + row * D + col) = r4 * DN_ALPHA + acc[ai][bj][m][n]; } }
    }
};

typedef short bf16x8_t __attribute__((ext_vector_type(8)));
struct RgIn { uint4 x[2][4]; };
DEVI void rglru_fetch(int c, int ch0, const bf16_t* __restrict__ XR, int tid, RgIn& R) {
    const int c8 = tid & 15, tr = tid >> 4;
#pragma unroll
    for (int half = 0; half < 2; ++half) { const int t = c * 64 + tr + 32 * half;
#pragma unroll
        for (int j = 0; j < 4; ++j) { const int tt = t - 3 + j; R.x[half][j] = tt >= 0 ? *(const uint4*)(XR + (size_t)tt * RNN_W + ch0 + 8 * c8) : make_uint4(0u, 0u, 0u, 0u); } }
}
template <bool FINAL>
DEVI void rglru_unit(int c, int nb, const RgIn& R, const bf16x8_t (&fa)[4], const bf16x8_t (&fx)[4], float bav, float bxv, float sp,
                     const bf16_t* __restrict__ GATEg, float* __restrict__ Aend, float* __restrict__ Hend, const float* __restrict__ CIN, bf16_t* __restrict__ YY,
                     unsigned char* lds, int tid) {
    const int lane = tid & 63, w = tid >> 6, col = lane & 15, quad = lane >> 4;
    bf16_t* xcb = (bf16_t*)lds;
    float* xcf = (float*)(lds + 64 * 136 * 2);
    const float* cwl = (const float*)(lds + 64 * 136 * 2 + 64 * 132 * 4);
    const int t0 = c * 64, ch0 = nb * RNN_BW, ch = ch0 + 16 * w + col;
    const float cinv = FINAL ? CIN[(size_t)ch * CP + c] : 0.f;
    const int c8 = tid & 15, tr = tid >> 4;
    uint4 g[2];
    if (FINAL) {
#pragma unroll
        for (int half = 0; half < 2; ++half) { const int t = t0 + tr + 32 * half; g[half] = (t < L) ? *(const uint4*)(GATEg + (size_t)t * RNN_W + ch0 + 8 * c8) : make_uint4(0u, 0u, 0u, 0u); } }
    __syncthreads();
    {
        float bv[8];
        { const float4 b0 = *(const float4*)(cwl + 512 + 8 * c8), b1 = *(const float4*)(cwl + 512 + 8 * c8 + 4); bv[0] = b0.x; bv[1] = b0.y; bv[2] = b0.z; bv[3] = b0.w; bv[4] = b1.x; bv[5] = b1.y; bv[6] = b1.z; bv[7] = b1.w; }
#pragma unroll
        for (int half = 0; half < 2; ++half) { const int tl = tr + 32 * half;
            float v[8];
#pragma unroll
            for (int i = 0; i < 8; ++i) v[i] = bv[i];
#pragma unroll
            for (int j = 0; j < 4; ++j) { const uint4 xv = R.x[half][j];
                const float4 w0 = *(const float4*)(cwl + j * 128 + 8 * c8), w1 = *(const float4*)(cwl + j * 128 + 8 * c8 + 4);
                v[0] += w0.x * bflo(xv.x); v[1] += w0.y * bfhi(xv.x); v[2] += w0.z * bflo(xv.y); v[3] += w0.w * bfhi(xv.y);
                v[4] += w1.x * bflo(xv.z); v[5] += w1.y * bfhi(xv.z); v[6] += w1.z * bflo(xv.w); v[7] += w1.w * bfhi(xv.w); }
            *(float4*)(xcf + tl * 132 + 8 * c8) = make_float4(v[0], v[1], v[2], v[3]); *(float4*)(xcf + tl * 132 + 8 * c8 + 4) = make_float4(v[4], v[5], v[6], v[7]);
            uint4 pk; pk.x = cvt_pk_bf16(v[0], v[1]); pk.y = cvt_pk_bf16(v[2], v[3]); pk.z = cvt_pk_bf16(v[4], v[5]); pk.w = cvt_pk_bf16(v[6], v[7]);
            *(uint4*)(xcb + (16 * ((tl >> 2) & 3) + 4 * (tl >> 4) + (tl & 3)) * 136 + 8 * c8) = pk; }
    }
    __syncthreads();
    f32x4 ca[4], cx[4];
#pragma unroll
    for (int mt = 0; mt < 4; ++mt) { ca[mt] = (f32x4){0.f, 0.f, 0.f, 0.f}; cx[mt] = (f32x4){0.f, 0.f, 0.f, 0.f};
#pragma unroll
        for (int ks = 0; ks < 4; ++ks) { const bf16x8_t af = *(const bf16x8_t*)(xcb + (16 * mt + col) * 136 + 32 * ks + 8 * quad);
            ca[mt] = __builtin_amdgcn_mfma_f32_16x16x32_bf16(af, fa[ks], ca[mt], 0, 0, 0);
            cx[mt] = __builtin_amdgcn_mfma_f32_16x16x32_bf16(af, fx[ks], cx[mt], 0, 0, 0); } }
    float av[4][4], uv[4][4]; float A = 1.f, H = 0.f;
#pragma unroll
    for (int mt = 0; mt < 4; ++mt) {
#pragma unroll
        for (int j = 0; j < 4; ++j) { const int tl = 16 * quad + 4 * mt + j;
            const float xcv = xcf[tl * 132 + 16 * w + col];
            const float r = fsigm(ca[mt][j] + bav), ig = fsigm(cx[mt][j] + bxv);
            const float la = -8.0f * r * sp;
            const float x2 = 2.0f * la;
            float em1 = x2 * (1.0f + x2 * (0.5f + x2 * (0.16666667f + x2 * (0.041666668f + x2 * (0.0083333338f + x2 * (0.0013888889f + x2 * 0.0001984127f))))));
            if (x2 < -0.5f) em1 = expm1f(x2);
            float a_ = __expf(la), u_ = __builtin_amdgcn_sqrtf(-em1) * (ig * xcv);
            if (t0 + tl >= L) { a_ = 1.f; u_ = 0.f; }
            av[mt][j] = a_; uv[mt][j] = u_; H = a_ * H + u_; A *= a_; } }
    float carry = cinv, prod = 1.f, hin = 0.f;
#pragma unroll
    for (int q = 0; q < 4; ++q) {
        if (quad == q) hin = carry;
        const float nw = A * carry + H, np = A * prod;
        carry = __shfl(nw, q * 16 + col); prod = __shfl(np, q * 16 + col); }
    if (!FINAL) {
        if (quad == 0) { Aend[(size_t)ch * CP + c] = prod; Hend[(size_t)ch * CP + c] = carry; }
    } else {
        float h = hin;
#pragma unroll
        for (int mt = 0; mt < 4; ++mt)
#pragma unroll
            for (int j = 0; j < 4; ++j) { h = av[mt][j] * h + uv[mt][j]; xcf[(16 * quad + 4 * mt + j) * 132 + 16 * w + col] = h; }
        __syncthreads();
#pragma unroll
        for (int half = 0; half < 2; ++half) { const int tl = tr + 32 * half, t = t0 + tl;
            if (t >= NMETA && t < L) {
                const float4 h0 = *(const float4*)(xcf + tl * 132 + 8 * c8), h1 = *(const float4*)(xcf + tl * 132 + 8 * c8 + 4);
                const uint4 gg = g[half];
                uint4 pk; pk.x = cvt_pk_bf16(bflo(gg.x) * h0.x, bfhi(gg.x) * h0.y); pk.y = cvt_pk_bf16(bflo(gg.y) * h0.z, bfhi(gg.y) * h0.w);
                pk.z = cvt_pk_bf16(bflo(gg.z) * h1.x, bfhi(gg.z) * h1.y); pk.w = cvt_pk_bf16(bflo(gg.w) * h1.z, bfhi(gg.w) * h1.w);
                *(uint4*)(YY + (size_t)t * RNN_W + ch0 + 8 * c8) = pk; } }
    }
}
template <bool FINAL>
DEVI void rglru_phase(const bf16_t* __restrict__ XR, const bf16_t* __restrict__ GATEg, const bf16_t* __restrict__ Wta, const bf16_t* __restrict__ Wtx,
                      const float* __restrict__ cw, const float* __restrict__ cb, const float* __restrict__ ba, const float* __restrict__ bx, const float* __restrict__ lam,
                      float* __restrict__ Aend, float* __restrict__ Hend, const float* __restrict__ CIN, bf16_t* __restrict__ YY, unsigned char* lds) {
    const int tid = otid(), lane = tid & 63, w = tid >> 6, col = lane & 15, quad = lane >> 4;
    const int G = gridDim.x, nb = blockIdx.x % RNN_NB, rank = blockIdx.x / RNN_NB, nblk = (G - nb + RNN_NB - 1) / RNN_NB;
    const int ch0 = nb * RNN_BW, ch = ch0 + 16 * w + col;
    float* cwl = (float*)(lds + 64 * 136 * 2 + 64 * 132 * 4);
    __syncthreads();
    for (int i = tid; i < 640; i += NTHREADS) cwl[i] = i < 512 ? cw[(i >> 7) * RNN_W + ch0 + (i & 127)] : cb[ch0 + (i - 512)];
    bf16x8_t fa[4], fx[4];
    { const size_t wrow = ((size_t)nb * 128 + 16 * w + col) * 128 + 8 * quad;
#pragma unroll
      for (int ks = 0; ks < 4; ++ks) { fa[ks] = *(const bf16x8_t*)(Wta + wrow + 32 * ks); fx[ks] = *(const bf16x8_t*)(Wtx + wrow + 32 * ks); } }
    const float bav = ba[ch], bxv = bx[ch], sp = log1pf(expf(-lam[ch]));
    RgIn Ra, Rb;
    int c = rank;
    if (c < NCHUNK) rglru_fetch(c, ch0, XR, tid, Ra);
    while (c < NCHUNK) {
        int cn = c + nblk;
        if (cn < NCHUNK) rglru_fetch(cn, ch0, XR, tid, Rb);
        rglru_unit<FINAL>(c, nb, Ra, fa, fx, bav, bxv, sp, GATEg, Aend, Hend, CIN, YY, lds, tid);
        c = cn; if (c >= NCHUNK) break;
        cn = c + nblk;
        if (cn < NCHUNK) rglru_fetch(cn, ch0, XR, tid, Ra);
        rglru_unit<FINAL>(c, nb, Rb, fa, fx, bav, bxv, sp, GATEg, Aend, Hend, CIN, YY, lds, tid);
        c = cn;
    }
    __syncthreads();
}

constexpr int SW = 544;
constexpr int CB = 512;
constexpr int NTILE = L / 16;
typedef float f32x16 __attribute__((ext_vector_type(16)));
typedef float f32x2v __attribute__((ext_vector_type(2)));
constexpr int HROW = 2112;
constexpr int IL_HIST = 0, IL_CKEY = 0, IL_CIDX = 16 * CB * 4, IL_HIST2 = 2 * 16 * CB * 4, IL_ROWS = IL_HIST2 + 16 * 256 * 4, IL_WI = 16 * HROW * 4, IL_QST = IL_WI + 512, IL_QST2 = IL_QST + 256, IL_CCNT = IL_QST2 + 256, IL_FLAG = IL_CCNT + 64;
constexpr int IL_QF = IL_ROWS + 16 * SW * 4;
static_assert(IL_QF + 8 * 512 <= IL_WI && IL_FLAG + 64 <= LDS_BYTES - 16, "indexer LDS");

constexpr int AW_BYTES = 512;
typedef short s16x2 __attribute__((ext_vector_type(2)));
DEVI float dot2bf(unsigned a, unsigned b, float c) { return __builtin_amdgcn_fdot2_f32_bf16(__builtin_bit_cast(s16x2, a), __builtin_bit_cast(s16x2, b), c, false); }
#define LDS_FENCE() asm volatile("s_waitcnt lgkmcnt(0)" ::: "memory")

struct AttnQ { float m, l, o[8]; };

DEVI void attn_issue(int b0, int n, const unsigned short* lst, const unsigned char* __restrict__ KV8, int lane, uint4 (&kv)[8]) {
    const int last = n - 1;
#pragma unroll
    for (int kk = 0; kk < 8; ++kk) { const int ii = b0 + kk; const int key = lst[ii < last ? ii : last]; kv[kk] = *(const uint4*)(KV8 + (size_t)key * 1024 + lane * 16); }
}
DEVI void attn_compute(AttnQ& S, int b0, int n, const float (&q)[8], const uint4 (&kv)[8]) {
    float sc[8]; float mx = S.m;
#pragma unroll
    for (int u = 0; u < 8; ++u) {
        const f32x2v k0 = __builtin_amdgcn_cvt_pk_f32_fp8((int)kv[u].x, false), k1 = __builtin_amdgcn_cvt_pk_f32_fp8((int)kv[u].x, true),
                     k2 = __builtin_amdgcn_cvt_pk_f32_fp8((int)kv[u].y, false), k3 = __builtin_amdgcn_cvt_pk_f32_fp8((int)kv[u].y, true);
        f32x2v d2 = k0 * (f32x2v){q[0], q[1]}; d2 = k1 * (f32x2v){q[2], q[3]} + d2; d2 = k2 * (f32x2v){q[4], q[5]} + d2; d2 = k3 * (f32x2v){q[6], q[7]} + d2;
        float d = d2[0] + d2[1];
        d += dpp_f<0xB1>(d); d += dpp_f<0x4E>(d); d += dpp_f<0x141>(d);
        sc[u] = (b0 + u < n) ? d : -INFINITY;
        mx = fmaxf(mx, sc[u]); }
    const float scale = __builtin_amdgcn_exp2f(S.m - mx);
    float ls = S.l * scale;
#pragma unroll
    for (int i = 0; i < 8; ++i) S.o[i] *= scale;
#pragma unroll
    for (int u = 0; u < 8; ++u) {
        const float p = __builtin_amdgcn_exp2f(sc[u] - mx); ls += p;
        const f32x2v v0 = __builtin_amdgcn_cvt_pk_f32_fp8((int)kv[u].z, false), v1 = __builtin_amdgcn_cvt_pk_f32_fp8((int)kv[u].z, true),
                     v2 = __builtin_amdgcn_cvt_pk_f32_fp8((int)kv[u].w, false), v3 = __builtin_amdgcn_cvt_pk_f32_fp8((int)kv[u].w, true);
        S.o[0] += p * v0[0]; S.o[1] += p * v0[1]; S.o[2] += p * v1[0]; S.o[3] += p * v1[1]; S.o[4] += p * v2[0]; S.o[5] += p * v2[1]; S.o[6] += p * v3[0]; S.o[7] += p * v3[1]; }
    S.l = ls; S.m = mx;
}

DEVI void attn_query(int t, const bf16_t* __restrict__ Qb, const unsigned char* __restrict__ KV8,
                     const unsigned* SR  , bf16_t* __restrict__ AO, unsigned char* wl, int lane) {
    unsigned short* lst = (unsigned short*)wl;
    LDS_FENCE();
    const int nw = (t >> 5) + 1; int base = 0;
    for (int w0 = 0; w0 < nw; w0 += 64) {
        const int wi = w0 + lane; const unsigned wv = wi < nw ? SR[wi] : 0u;
        const int pc = __popc(wv); int pre = pc;
#pragma unroll
        for (int off = 1; off < 64; off <<= 1) { const int o_ = __shfl_up(pre, off); if (lane >= off) pre += o_; }
        int pos = base + pre - pc; unsigned mm = wv;
        while (mm) { const int bpos = __ffs((int)mm) - 1; mm &= mm - 1u; if (pos < TOPK) lst[pos] = (unsigned short)(wi * 32 + bpos); ++pos; }
        base += __shfl(pre, 63);
    }
    const int n = base < TOPK ? base : TOPK;
    float q[8];
    { const uint4 qv = ((const uint4*)(Qb + (size_t)t * 512))[lane]; const float qs = 0.18033688011112042f;
      q[0] = bflo(qv.x) * qs; q[1] = bfhi(qv.x) * qs; q[2] = bflo(qv.y) * qs; q[3] = bfhi(qv.y) * qs; q[4] = bflo(qv.z) * qs; q[5] = bfhi(qv.z) * qs; q[6] = bflo(qv.w) * qs; q[7] = bfhi(qv.w) * qs; }
    LDS_FENCE();
    AttnQ S; S.m = -INFINITY; S.l = 0.f;
#pragma unroll
    for (int d = 0; d < 8; ++d) S.o[d] = 0.f;
    uint4 ka[8], kb_[8], kc[8];
    attn_issue(0, n, lst, KV8, lane, ka);
    if (8 < n) attn_issue(8, n, lst, KV8, lane, kb_);
    for (int b0 = 0; b0 < n; b0 += 24) {
        if (b0 + 16 < n) attn_issue(b0 + 16, n, lst, KV8, lane, kc);
        attn_compute(S, b0, n, q, ka);
        if (b0 + 8 < n) {
            if (b0 + 24 < n) attn_issue(b0 + 24, n, lst, KV8, lane, ka);
            attn_compute(S, b0 + 8, n, q, kb_);
            if (b0 + 16 < n) {
                if (b0 + 32 < n) attn_issue(b0 + 32, n, lst, KV8, lane, kb_);
                attn_compute(S, b0 + 16, n, q, kc);
            }
        }
    }
    const int hd = lane >> 3, ch = lane & 7;
    const float inv = 1.0f / S.l;
    uint4 pk; pk.x = cvt_pk_bf16(S.o[0] * inv, S.o[1] * inv); pk.y = cvt_pk_bf16(S.o[2] * inv, S.o[3] * inv); pk.z = cvt_pk_bf16(S.o[4] * inv, S.o[5] * inv); pk.w = cvt_pk_bf16(S.o[6] * inv, S.o[7] * inv);
    *(uint4*)(AO + (size_t)t * 1024 + 512 + hd * 64 + ch * 8) = pk;
}

DEVI float relu_i(float x) { const int v = __float_as_int(x); return __int_as_float(v > 0 ? v : 0); }
DEVI int hpos(unsigned w) { return (int)(w + (w >> 5)); }
template <int PASS, bool L0>
DEVI void idx_sweep(int q0, int nkb, int wave, int lane, const bf16x8_t (&Af)[4][4], const bf16_t* __restrict__ KI, unsigned char* lds, unsigned* __restrict__ SELM) {
    const int l31 = lane & 31, h2 = lane >> 5;
    unsigned* hist = (unsigned*)(lds + IL_HIST);
    const float* wiL = (const float*)(lds + IL_WI);
    const uint4* qst = (const uint4*)(lds + IL_QST);
    const uint4* qst2 = (const uint4*)(lds + IL_QST2);
    unsigned* ckey = (unsigned*)(lds + IL_CKEY); unsigned* cidx = (unsigned*)(lds + IL_CIDX); unsigned* ccnt = (unsigned*)(lds + IL_CCNT); unsigned* rows = (unsigned*)(lds + IL_ROWS);
    const bf16_t* kp = KI + (size_t)l31 * 64 + 8 * h2;
    bf16x8_t Bn[4];
    if (wave < nkb) {
#pragma unroll
        for (int ks = 0; ks < 4; ++ks) Bn[ks] = *(const bf16x8_t*)(kp + (size_t)wave * 2048 + 16 * ks); }
    for (int kb = wave; kb < nkb; kb += 8) {
        const int s = kb * 32 + l31;
        bf16x8_t Bf[4];
#pragma unroll
        for (int ks = 0; ks < 4; ++ks) Bf[ks] = Bn[ks];
        if (kb + 8 < nkb) {
#pragma unroll
            for (int ks = 0; ks < 4; ++ks) Bn[ks] = *(const bf16x8_t*)(kp + (size_t)(kb + 8) * 2048 + 16 * ks); }
        f32x16 acc[4];
#pragma unroll
        for (int rb = 0; rb < 4; ++rb) {
#pragma unroll
            for (int i = 0; i < 16; ++i) acc[rb][i] = 0.f; }
#pragma unroll
        for (int ks = 0; ks < 4; ++ks)
#pragma unroll
            for (int rb = 0; rb < 4; ++rb) acc[rb] = __builtin_amdgcn_mfma_f32_32x32x16_bf16(Af[rb][ks], Bf[ks], acc[rb], 0, 0, 0);
        const bool edge = kb * 32 + 31 > q0;
#pragma unroll
        for (int rb = 0; rb < 4; ++rb) {
            const int qa = 4 * rb + 2 * h2;
            float4 w[2][2]; uint4 st[2];
#pragma unroll
            for (int e = 0; e < 2; ++e) { w[e][0] = *(const float4*)(wiL + (qa + e) * 8); w[e][1] = *(const float4*)(wiL + (qa + e) * 8 + 4);
                if (PASS == 2) st[e] = qst2[qa + e]; else if (!L0) st[e] = qst[qa + e]; }
#pragma unroll
            for (int e = 0; e < 2; ++e) {
                const int qs = qa + e;
                f32x2v s2 = (f32x2v){relu_i(acc[rb][8 * e + 0]), relu_i(acc[rb][8 * e + 1])} * (f32x2v){w[e][0].x, w[e][0].y};
                s2 = (f32x2v){relu_i(acc[rb][8 * e + 2]), relu_i(acc[rb][8 * e + 3])} * (f32x2v){w[e][0].z, w[e][0].w} + s2;
                s2 = (f32x2v){relu_i(acc[rb][8 * e + 4]), relu_i(acc[rb][8 * e + 5])} * (f32x2v){w[e][1].x, w[e][1].y} + s2;
                s2 = (f32x2v){relu_i(acc[rb][8 * e + 6]), relu_i(acc[rb][8 * e + 7])} * (f32x2v){w[e][1].z, w[e][1].w} + s2;
                const float sc = s2[0] + s2[1];
                const bool valid = !edge || s <= q0 + qs;
                const unsigned key = f2key(sc);
                if (PASS == 1) {
                    if (L0) { if (valid) { const unsigned bin = key >> 20; atomicAdd(&hist[qs * HROW + hpos(bin >> 1)], (bin & 1u) ? 0x10000u : 1u); } }
                    else if (valid && (key & st[e].x) == st[e].y) { const unsigned bin = (key >> st[e].z) & st[e].w; atomicAdd(&hist[qs * HROW + hpos(bin >> 1)], (bin & 1u) ? 0x10000u : 1u); }
                } else {
                    const bool all = st[e].z == 0xFFFFFFFFu;
                    const bool sel = valid && (all || key >= st[e].y);
                    const bool cnd = valid && !all && key >= st[e].x && key < st[e].y;
                    const unsigned long long bal = __ballot(sel);
                    if (l31 == 0) rows[qs * SW + kb] = h2 ? (unsigned)(bal >> 32) : (unsigned)bal;
                    if (cnd) { const unsigned n = atomicAdd(&ccnt[qs], 1u); if (n < (unsigned)CB) { ckey[qs * CB + n] = key; cidx[qs * CB + n] = (unsigned)s; } }
                }
            }
        }
    }
}

DEVI void indexer_tile(int q0, const bf16_t* __restrict__ QI, const bf16_t* __restrict__ KI, const float* __restrict__ WI, const bf16_t* __restrict__ Qb, const unsigned char* __restrict__ KV8, bf16_t* __restrict__ AO, unsigned char* lds) {
    const int tid = otid(), lane = tid & 63, wave = tid >> 6;
    unsigned* hist = (unsigned*)(lds + IL_HIST);
    float* wiL = (float*)(lds + IL_WI);
    uint4* qst = (uint4*)(lds + IL_QST); uint4* qst2 = (uint4*)(lds + IL_QST2);
    unsigned* ckey = (unsigned*)(lds + IL_CKEY); unsigned* cidx = (unsigned*)(lds + IL_CIDX); unsigned* hist2 = (unsigned*)(lds + IL_HIST2); unsigned* ccnt = (unsigned*)(lds + IL_CCNT);
    volatile unsigned* flag = (volatile unsigned*)(lds + IL_FLAG);
    const int nkb = (q0 + 16 + 31) >> 5;
    bf16x8_t Af[4][4];
    { const int rho = lane & 31, hq = lane >> 5; const int qq = 2 * ((rho >> 2) & 1) + (rho >> 4), head = 4 * ((rho >> 3) & 1) + (rho & 3);
#pragma unroll
      for (int rb = 0; rb < 4; ++rb)
#pragma unroll
          for (int ks = 0; ks < 4; ++ks) Af[rb][ks] = *(const bf16x8_t*)(QI + (size_t)(q0 + 4 * rb + qq) * 512 + head * 64 + 16 * ks + 8 * hq); }
    __syncthreads();
    if (tid < 128) wiL[tid] = WI[(size_t)q0 * 8 + tid] * 0.125f;
    if (tid < 16) { qst[tid] = make_uint4(0u, 0u, 20u, 4095u); qst2[tid] = make_uint4(0u, 0u, (unsigned)TOPK, 0u); ccnt[tid] = 0u; }
    for (int level = 0; level < 3; ++level) {
        for (int i = tid; i < 16 * HROW / 4; i += NTHREADS) ((uint4*)hist)[i] = make_uint4(0u, 0u, 0u, 0u);
        if (tid == 0) flag[0] = 0u;
        __syncthreads();
        if (level == 0) idx_sweep<1, true>(q0, nkb, wave, lane, Af, KI, lds, nullptr); else idx_sweep<1, false>(q0, nkb, wave, lane, Af, KI, lds, nullptr);
        __syncthreads();
#pragma unroll 1
        for (int qi = 0; qi < 2; ++qi) {
            const int qs = 2 * wave + qi;
            const uint4 st = qst[qs]; const uint4 b = qst2[qs];
            if (st.x == 0xFFFFFFFFu && st.y == 0u && st.w == 0u) continue;
            unsigned wv[32]; unsigned loc = 0u;
#pragma unroll
            for (int i = 0; i < 32; ++i) { wv[i] = hist[qs * HROW + 33 * lane + i]; loc += (wv[i] & 0xFFFFu) + (wv[i] >> 16); }
            unsigned suf = loc;
#pragma unroll
            for (int off = 1; off < 64; off <<= 1) { const unsigned o = __shfl_down(suf, off); if (lane + off < 64) suf += o; }
            const unsigned total = __shfl(suf, 0), above = suf - loc, need = b.z;
            if (level == 0 && total <= need) { if (lane == 0) { qst[qs] = make_uint4(0xFFFFFFFFu, 0u, 0u, 0u); qst2[qs] = make_uint4(0u, 0u, 0xFFFFFFFFu, 0u); } continue; }
            const bool mine = above < need && need <= above + loc;
            unsigned cum = above, c = 0u; int d = 0; bool found = false;
#pragma unroll
            for (int i = 31; i >= 0; --i) {
                const unsigned chi = wv[i] >> 16, clo = wv[i] & 0xFFFFu;
                if (!found && cum + chi >= need) { found = true; d = 64 * lane + 2 * i + 1; c = chi; } if (!found) cum += chi;
                if (!found && cum + clo >= need) { found = true; d = 64 * lane + 2 * i; c = clo; } if (!found) cum += clo; }
            if (mine) {
                const unsigned pval = st.y | ((unsigned)d << st.z), pmask = st.x | (st.w << st.z);
                const unsigned nneed = need - cum;
                const unsigned long long hi64 = (unsigned long long)pval + (1ull << st.z);
                const unsigned hi = hi64 > 0xFFFFFFFFull ? 0xFFFFFFFFu : (unsigned)hi64;
                if (c <= (unsigned)CB || level == 2) { qst[qs] = make_uint4(0xFFFFFFFFu, 0u, 0u, 0u); qst2[qs] = make_uint4(pval, hi, nneed, st.z); }
                else { const unsigned nsh = (level == 0) ? 8u : 0u, ndm = (level == 0) ? 4095u : 255u; qst[qs] = make_uint4(pmask, pval, nsh, ndm); qst2[qs] = make_uint4(pval, hi, nneed, st.z); flag[0] = 1u; }
            }
        }
        __syncthreads();
        if (flag[0] == 0u) break;
        __syncthreads();
    }
    __syncthreads();
    idx_sweep<2, false>(q0, nkb, wave, lane, Af, KI, lds, nullptr);
    asm volatile("s_waitcnt vmcnt(0)" ::: "memory");
    __syncthreads();
    unsigned* rows = (unsigned*)(lds + IL_ROWS);
#pragma unroll 1
    for (int qi = 0; qi < 2; ++qi) {
        const int qs = 2 * wave + qi;
        const uint4 b = qst2[qs];
        unsigned* row = rows + qs * SW;
        if (b.z != 0xFFFFFFFFu) {
            const unsigned need = b.z; const unsigned cn = ccnt[qs]; const int n = (int)(cn < (unsigned)CB ? cn : (unsigned)CB);
            const unsigned rem = b.w;
            const unsigned sh8 = rem > 8u ? rem - 8u : 0u; const unsigned m8 = rem >= 8u ? 255u : ((1u << rem) - 1u);
#pragma unroll
            for (int i = 0; i < 4; ++i) hist2[qs * 256 + 4 * lane + i] = 0u;
            asm volatile("s_waitcnt lgkmcnt(0)" ::: "memory");
            for (int i = lane; i < n; i += 64) atomicAdd(&hist2[qs * 256 + ((ckey[qs * CB + i] >> sh8) & m8)], 1u);
            asm volatile("s_waitcnt lgkmcnt(0)" ::: "memory");
            unsigned c4[4]; unsigned loc = 0u;
#pragma unroll
            for (int i = 0; i < 4; ++i) { c4[i] = hist2[qs * 256 + 4 * lane + i]; loc += c4[i]; }
            unsigned suf = loc;
#pragma unroll
            for (int off = 1; off < 64; off <<= 1) { const unsigned o = __shfl_down(suf, off); if (lane + off < 64) suf += o; }
            const unsigned above = suf - loc;
            const bool mine = above < need && need <= above + loc;
            unsigned b2 = 0u, need2 = 0u;
            if (mine) { unsigned cum = above; int i = 3; for (; i > 0; --i) { if (cum + c4[i] >= need) break; cum += c4[i]; } b2 = 4u * lane + i; need2 = need - cum; }
            const unsigned long long mb = __ballot(mine);
            if (mb == 0ull) {
                for (int i = lane; i < n; i += 64) if ((unsigned)i < need) { const unsigned ii = cidx[qs * CB + i]; atomicOr(&row[ii >> 5], 1u << (ii & 31u)); }
            } else {
                const int src = __ffsll((long long)mb) - 1;
                b2 = __shfl(b2, src); need2 = __shfl(need2, src);
                for (int i0 = 0; i0 < n; i0 += 64) {
                    const int i = i0 + lane; const bool act = i < n;
                    const unsigned ki = act ? ckey[qs * CB + i] : 0u, ii = act ? cidx[qs * CB + i] : 0u; const unsigned d8 = (ki >> sh8) & m8;
                    if (act && d8 > b2) atomicOr(&row[ii >> 5], 1u << (ii & 31u));
                    unsigned long long tie = __ballot(act && d8 == b2);
                    while (tie) {
                        const int ml = __ffsll((long long)tie) - 1; tie &= tie - 1ull;
                        const unsigned km = __shfl(ki, ml), im = __shfl(ii, ml);
                        unsigned rank = 0u;
                        for (int j0 = 0; j0 < n; j0 += 64) { const int j = j0 + lane; bool beats = false;
                            if (j < n) { const unsigned kj = ckey[qs * CB + j], ij = cidx[qs * CB + j]; beats = ((kj >> sh8) & m8) == b2 && (kj > km || (kj == km && ij < im)); }
                            rank += (unsigned)__popcll(__ballot(beats)); }
                        if (rank < need2 && lane == ml) atomicOr(&row[im >> 5], 1u << (im & 31u));
                    }
                }
            }
        }
    }
    asm volatile("s_waitcnt lgkmcnt(0)" ::: "memory");
    __syncthreads();
    for (int qi = 0; qi < 2; ++qi) { const int qs = 2 * wave + qi;
        attn_query(q0 + qs, Qb, KV8, rows + qs * SW, AO, lds + IL_QF + wave * 512, lane); }
}

__global__ void __launch_bounds__(NTHREADS, 2) fwd(Args a) {
    extern __shared__ __attribute__((aligned(16))) unsigned char lds_raw[];
    float* smf = (float*)lds_raw;
    PG8_LAS unsigned char* ldsp = (PG8_LAS unsigned char*)lds_raw;
    const int nwaves = gridDim.x * 8;
#define PHASE_VARS const int tid = otid(); const int lane = tid & 63, wave = tid >> 6; const int gwave = blockIdx.x * 8 + wave; (void)lane; (void)wave; (void)gwave;
    unsigned char* ws = a.ws;
    unsigned* ctl = (unsigned*)(ws + WS_CTL);
    const int lo = a.ph_lo, hi = a.ph_hi;

    volatile LAS unsigned* bst = (volatile LAS unsigned*)((LAS unsigned char*)lds_raw + (LDS_BYTES - 16));
    if (threadIdx.x == 0) { bst[0] = 0u; bst[1] = 0u; bst[2] = 0u; bst[3] = 0u; }
    __syncthreads();
    XcdBarrier bar; bar.bar = ctl; bar.x = 0; bar.st = bst;
    if (hi - lo > 1) bar = xcd_barrier_post(ctl, bst);
#define IN(k) (lo <= (k) && (k) < hi)
#define SEAM(k) do { if (IN(k) && IN((k) + 1)) xcd_barrier(bar); } while (0)

    const float* x = a.in[0]; const float* meta = a.in[1];
    float* ropeC = (float*)(ws + WS_ROPEC); float* ropeS = (float*)(ws + WS_ROPES);
    int* eid = (int*)(ws + WS_EID); float* gw = (float*)(ws + WS_GW); int* slot = (int*)(ws + WS_SLOT); int* mtiles = (int*)(ws + WS_MTILES);
    unsigned* counts0 = (unsigned*)(ws + CTL_CNT); unsigned* counts1 = counts0 + 32;
    unsigned* cursor0 = (unsigned*)(ws + CTL_CUR); unsigned* cursor1 = cursor0 + 32;
    bf16_t* Wta = (bf16_t*)(ws + WS_WTA); bf16_t* Wtx = (bf16_t*)(ws + WS_WTX);
    float* Aend = (float*)(ws + WS_AEND); float* Hend = (float*)(ws + WS_HEND); float* CIN = (float*)(ws + WS_CIN);
    unsigned char* big = ws + WS_BIG;
    bf16_t* WIN0 = (bf16_t*)(big + R_WIN0); bf16_t* WOUT0 = (bf16_t*)(big + R_WOUT0); bf16_t* WGU = (bf16_t*)(big + R_WGU); bf16_t* WD = (bf16_t*)(big + R_WD);
    bf16_t* WIN1 = (bf16_t*)(big + R_WIN1); bf16_t* WOUT1 = (bf16_t*)(big + R_WOUT1);
    bf16_t* X0b = (bf16_t*)(big + R_A); bf16_t* AO = (bf16_t*)(big + R_A); bf16_t* Xperm = (bf16_t*)(big + R_A); bf16_t* X2b = (bf16_t*)(big + R_A); bf16_t* YY = (bf16_t*)(big + R_A);
    float* H1 = (float*)(big + R_H1); float* H3 = (float*)(big + R_H1); float* H2 = (float*)(big + R_H2); unsigned* SELM = (unsigned*)(big + R_H1); unsigned* SELM2 = (unsigned*)(big + R_H1 + 36 * MiB);
    float* Z = (float*)(big + R_C); bf16_t* Yb = (bf16_t*)(big + R_C); float* Z1 = (float*)(big + R_C);
    unsigned char* KV8 = big + R_K;
    bf16_t* GLU = (bf16_t*)(big + R_GLU); bf16_t* Qb = (bf16_t*)(big + R_Q); bf16_t* Kb = (bf16_t*)(big + R_K); bf16_t* Vb = (bf16_t*)(big + R_V);
    bf16_t* QIb = (bf16_t*)(big + R_QI); bf16_t* KIb = (bf16_t*)(big + R_KI); float* WIf = (float*)(big + R_WI);
    bf16_t* GATEg = (bf16_t*)(big + R_GATE); bf16_t* XRb = (bf16_t*)(big + R_XR);
    bf16_t* Hm = (bf16_t*)(big + R_HM);

    if (IN(0)) { PHASE_VARS;
        const float* w_in = a.in[2]; const float* w_out = a.in[7]; const float* wg = a.in[21]; const float* wu = a.in[22]; const float* wd = a.in[23];
        constexpr int J_IN0 = 52 * 16, J_OUT0 = 16 * 16, J_GU = 32 * 256, J_D = 32 * 128, J_IN1 = 40 * 16, J_OUT1 = 16 * 20, J_GT = 80;
        const float* w_in1 = a.in[8]; const float* w_out1 = a.in[16]; const float* wga = a.in[11]; const float* wgx = a.in[13];
        tr_run(J_IN0 + J_OUT0 + J_GU + J_D + J_IN1 + J_OUT1 + J_GT, [&](int j) -> TrJob {
            TrJob J{};
            if (j < J_IN0) { J.dst = WIN0; J.s0 = w_in; J.K = 1024; J.n0 = (j >> 4) * 64; J.k0 = (j & 15) * 64; J.mode = 1; return J; }
            j -= J_IN0;
            if (j < J_OUT0) { J.dst = WOUT0; J.s0 = w_out; J.ld = D; J.K = 1024; J.n0 = (j >> 4) * 64; J.k0 = (j & 15) * 64; J.mode = 0; return J; }
            j -= J_OUT0;
            if (j < J_GU) { const int e = j >> 8, t = j & 255; J.dst = WGU + (size_t)e * 1024 * 1024; J.s0 = wg + (size_t)e * D * DE; J.s1 = wu + (size_t)e * D * DE; J.K = 1024; J.n0 = (t >> 4) * 64; J.k0 = (t & 15) * 64; J.mode = 2; return J; }
            j -= J_GU;
            if (j < J_D) { const int e = j >> 7, t = j & 127; J.dst = WD + (size_t)e * 1024 * 512; J.s0 = wd + (size_t)e * DE * D; J.ld = D; J.K = 512; J.n0 = (t >> 3) * 64; J.k0 = (t & 7) * 64; J.mode = 0; return J; }
            j -= J_D;
            if (j < J_IN1) { J.dst = WIN1; J.s0 = w_in1; J.ld = 2 * RNN_W; J.K = 1024; J.n0 = (j >> 4) * 64; J.k0 = (j & 15) * 64; J.mode = 0; return J; }
            j -= J_IN1;
            if (j < J_OUT1) { J.dst = WOUT1; J.s0 = w_out1; J.ld = D; J.K = RNN_W; J.n0 = (j / 20) * 64; J.k0 = (j % 20) * 64; J.mode = 0; return J; }
            j -= J_OUT1;
            { const int which = j / 40, r = j % 40; const int nb = r >> 2;
              J.dst = (which ? Wtx : Wta) + (size_t)nb * 128 * 128; J.s0 = (which ? wgx : wga) + (size_t)nb * 128 * 128; J.ld = 128; J.K = 128; J.n0 = ((r >> 1) & 1) * 64; J.k0 = (r & 1) * 64; J.mode = 0; return J; }
        }, smf);
        for (size_t i = (size_t)blockIdx.x * NTHREADS + tid; i < (size_t)LP * 256; i += (size_t)gridDim.x * NTHREADS) {
            const size_t r = i >> 8, c4 = i & 255;
            float4 v = make_float4(0.f, 0.f, 0.f, 0.f);
            if (r < NMETA) v = ((const float4*)meta)[r * 256 + c4]; else if (r < L) v = ((const float4*)x)[(r - NMETA) * 256 + c4];
            ((uint2*)X0b)[i] = make_uint2(cvt_pk_bf16(v.x, v.y), cvt_pk_bf16(v.z, v.w));
        }
        for (int i = blockIdx.x * NTHREADS + tid; i < 2 * 64 * 3 * 64; i += gridDim.x * NTHREADS) {
            const int ln = i & 63, ct = (i >> 6) % 3, ss = (i / 192) & 63, ly = i / (192 * 64);
            const int col = 16 * ct + (ln & 15), k0 = 16 * ss + 4 * (ln >> 4);
            float v[4];
#pragma unroll
            for (int j = 0; j < 4; ++j) v[j] = col < 4 ? a.in[17][(size_t)ly * D * NGRP + (size_t)(k0 + j) * NGRP + col] : col < 36 ? a.in[19][(size_t)ly * D * NE + (size_t)(k0 + j) * NE + (col - 4)] : 0.f;
            ((float4*)(ws + WS_WR))[i] = make_float4(v[0], v[1], v[2], v[3]);
        }
        for (int i = blockIdx.x * NTHREADS + tid; i < LP * 32; i += gridDim.x * NTHREADS) {
            const int p = i >> 5, f = i & 31;
            const float inv = (float)pow(10000.0, -(double)f / 32.0);
            const float ang = (float)p * inv;
            ropeC[i] = (float)cos((double)ang); ropeS[i] = (float)sin((double)ang);
        }
    }
    SEAM(0);
    if (IN(1)) { PHASE_VARS;
        pg8::Gemm g{X0b, WIN0, LP, 3328, 1024}; pg8::StaticOrder S; S.init(LP, 3328, (int)gridDim.x, (int)blockIdx.x);
        EpiIn0 E{GLU, KIb, WIf, ropeC, ropeS, KV8};
        pg8::gemm_phase<EpiIn0, pg8::StaticOrder, GEMM_ALIGN, GEMM_SP2>(ldsp, g, S, E);
    }
    SEAM(1);
    if (IN(2)) { PHASE_VARS;
        const float* cw = a.in[3]; const float* cb = a.in[4]; const float* lg = a.in[5]; const float* lb = a.in[6];
        for (int g4 = gwave; g4 < L / 4; g4 += nwaves) {
            const int t0 = g4 * 4, c0 = lane * 8;
            float acc[4][8], wwin[4][8];
            { const float4 b0 = *(const float4*)(cb + c0), b1 = *(const float4*)(cb + c0 + 4);
#pragma unroll
              for (int q = 0; q < 4; ++q) { acc[q][0] = b0.x; acc[q][1] = b0.y; acc[q][2] = b0.z; acc[q][3] = b0.w; acc[q][4] = b1.x; acc[q][5] = b1.y; acc[q][6] = b1.z; acc[q][7] = b1.w; } }
#pragma unroll
            for (int r = 0; r < CONV_K + 3; ++r) {
                const int tt = t0 - (CONV_K - 1) + r;
                if (r < CONV_K) { const float4 w0 = *(const float4*)(cw + r * CONV_CH + c0), w1 = *(const float4*)(cw + r * CONV_CH + c0 + 4);
                    wwin[r & 3][0] = w0.x; wwin[r & 3][1] = w0.y; wwin[r & 3][2] = w0.z; wwin[r & 3][3] = w0.w; wwin[r & 3][4] = w1.x; wwin[r & 3][5] = w1.y; wwin[r & 3][6] = w1.z; wwin[r & 3][7] = w1.w; }
                if (tt >= 0) {
                    const uint4 xv = *(const uint4*)(GLU + (size_t)tt * 512 + c0);
                    const float x[8] = {bflo(xv.x), bfhi(xv.x), bflo(xv.y), bfhi(xv.y), bflo(xv.z), bfhi(xv.z), bflo(xv.w), bfhi(xv.w)};
#pragma unroll
                    for (int q = 0; q < 4; ++q) { const int j = r - q;
                        if (j >= 0 && j < CONV_K) {
#pragma unroll
                            for (int i = 0; i < 8; ++i) acc[q][i] += wwin[j & 3][i] * x[i]; } }
                }
            }
            float gv[8], bvv[8];
            { const float4 g0 = *(const float4*)(lg + c0), g1 = *(const float4*)(lg + c0 + 4), b0 = *(const float4*)(lb + c0), b1 = *(const float4*)(lb + c0 + 4);
              gv[0] = g0.x; gv[1] = g0.y; gv[2] = g0.z; gv[3] = g0.w; gv[4] = g1.x; gv[5] = g1.y; gv[6] = g1.z; gv[7] = g1.w; bvv[0] = b0.x; bvv[1] = b0.y; bvv[2] = b0.z; bvv[3] = b0.w; bvv[4] = b1.x; bvv[5] = b1.y; bvv[6] = b1.z; bvv[7] = b1.w; }
#pragma unroll
            for (int q = 0; q < 4; ++q) {
                float s_ = 0.f;
#pragma unroll
                for (int i = 0; i < 8; ++i) s_ += acc[q][i];
                const float mu = wave_sum(s_) * (1.0f / 512.0f);
                float qq = 0.f;
#pragma unroll
                for (int i = 0; i < 8; ++i) { const float d = acc[q][i] - mu; qq += d * d; }
                const float rstd = 1.0f / sqrtf(wave_sum(qq) * (1.0f / 512.0f) + LN_EPS);
                float o[8];
#pragma unroll
                for (int i = 0; i < 8; ++i) { const float yv = (acc[q][i] - mu) * rstd * gv[i] + bvv[i]; o[i] = yv * fsigm(yv); }
                uint4 w; w.x = cvt_pk_bf16(o[0], o[1]); w.y = cvt_pk_bf16(o[2], o[3]); w.z = cvt_pk_bf16(o[4], o[5]); w.w = cvt_pk_bf16(o[6], o[7]);
                *(uint4*)(AO + (size_t)(t0 + q) * 1024 + c0) = w;
            }
        }
        { const int b = (int)blockIdx.x, G = (int)gridDim.x; const int p = b & 3; const bool rev = (b >> 2) & 1;
          const int nfull = NTILE / G;
          for (int k = 0; k < nfull; ++k) {
              const int r = (nfull == 4) ? ((rev ? p - k : p + k) & 3) : k;
              const int idx = r * G + ((r & 1) ? G - 1 - b : b);
              indexer_tile((NTILE - 1 - idx) * 16, QIb, KIb, WIf, Qb, KV8, AO, lds_raw);
          }
          for (int idx = nfull * G + b; idx < NTILE; idx += G) indexer_tile((NTILE - 1 - idx) * 16, QIb, KIb, WIf, Qb, KV8, AO, lds_raw);
        }
    }
    SEAM(2);
    SEAM(3);
    if (IN(4)) { PHASE_VARS;
        pg8::Gemm g{AO, WOUT0, LP, 1024, 1024}; pg8::StaticOrder S; S.init(LP, 1024, (int)gridDim.x, (int)blockIdx.x);
        EpiRes0 E{x, meta, Z};
        pg8::gemm_phase<EpiRes0, pg8::StaticOrder, GEMM_ALIGN, GEMM_SP2>(ldsp, g, S, E);
    }
    SEAM(4);
    if (IN(5)) {
        for (int tb = blockIdx.x * 64; tb < L; tb += gridDim.x * 64)
            ln_route_block(tb, (L - tb) < 64 ? (L - tb) : 64, Z, H1, a.in[24], a.in[25], (const float4*)(ws + WS_WR), a.in[18], a.in[20], eid, gw, counts0, smf);
    }
    SEAM(5);
    if (IN(6)) { PHASE_VARS; moe_dispatch_mfma(H1, eid, counts0, cursor0, slot, mtiles, Xperm, (int*)lds_raw, gwave, nwaves, lane, 0); }
    SEAM(6);
    if (IN(7)) { PHASE_VARS;
        pg8::Gemm g{Xperm, WGU, MAXSLOT, 1024, 1024}; MoeOrder S; S.init(mtiles, (int)gridDim.x, (int)blockIdx.x);
        EpiGateUp E{Hm};
        pg8::gemm_phase<EpiGateUp, MoeOrder, GEMM_ALIGN, GEMM_SP2>(ldsp, g, S, E);
    }
    SEAM(7);
    if (IN(8)) { PHASE_VARS;
        pg8::Gemm g{Hm, WD, MAXSLOT, 1024, 512}; MoeOrder S; S.init(mtiles, (int)gridDim.x, (int)blockIdx.x);
        EpiDown E{Yb};
        pg8::gemm_phase<EpiDown, MoeOrder, GEMM_ALIGN, GEMM_SP2>(ldsp, g, S, E);
    }
    SEAM(8);
    if (IN(9)) { PHASE_VARS;
#pragma unroll 2
        for (int t = gwave; t < L; t += nwaves) {
            const int s0 = slot[2 * t], s1 = slot[2 * t + 1]; const float g0 = gw[2 * t], g1 = gw[2 * t + 1];
            float y[16];
            combine_row(y, H1 + (size_t)t * D, Yb + (size_t)s0 * D, Yb + (size_t)s1 * D, g0, g1, lane);
            ln_row1024v(y, a.in[26], a.in[27], lane);
#pragma unroll
            for (int i4 = 0; i4 < 4; ++i4) *(float4*)(H2 + (size_t)t * D + 16 * lane + 4 * i4) = make_float4(y[4 * i4], y[4 * i4 + 1], y[4 * i4 + 2], y[4 * i4 + 3]);
            uint4 p0, p1; p0.x = cvt_pk_bf16(y[0], y[1]); p0.y = cvt_pk_bf16(y[2], y[3]); p0.z = cvt_pk_bf16(y[4], y[5]); p0.w = cvt_pk_bf16(y[6], y[7]);
            p1.x = cvt_pk_bf16(y[8], y[9]); p1.y = cvt_pk_bf16(y[10], y[11]); p1.z = cvt_pk_bf16(y[12], y[13]); p1.w = cvt_pk_bf16(y[14], y[15]);
            *(uint4*)(X2b + (size_t)t * D + 16 * lane) = p0; *(uint4*)(X2b + (size_t)t * D + 16 * lane + 8) = p1;
        }
        for (int i = blockIdx.x * NTHREADS + tid; i < (LP - L) * D / 8; i += gridDim.x * NTHREADS) ((uint4*)(X2b + (size_t)L * D))[i] = make_uint4(0u, 0u, 0u, 0u);
    }
    SEAM(9);
    if (IN(10)) {
        pg8::Gemm g{X2b, WIN1, LP, 2 * RNN_W, 1024}; pg8::StaticOrder S; S.init(LP, 2 * RNN_W, (int)gridDim.x, (int)blockIdx.x);
        EpiIn1 E{GATEg};
        pg8::gemm_phase<EpiIn1, pg8::StaticOrder, GEMM_ALIGN, GEMM_SP2>(ldsp, g, S, E);
    }
    SEAM(10);
    if (IN(11)) rglru_phase<false>(XRb, GATEg, Wta, Wtx, a.in[9], a.in[10], a.in[12], a.in[14], a.in[15], Aend, Hend, CIN, YY, lds_raw);
    SEAM(11);
    if (IN(12)) { PHASE_VARS;
        for (int ch = gwave; ch < RNN_W; ch += nwaves) {
            float A[5], H[5];
#pragma unroll
            for (int i = 0; i < 5; ++i) { const int c = 5 * lane + i; const bool ok = c < NCHUNK; A[i] = ok ? Aend[(size_t)ch * CP + c] : 1.f; H[i] = ok ? Hend[(size_t)ch * CP + c] : 0.f; }
            float Al = 1.f, Hl = 0.f;
#pragma unroll
            for (int i = 0; i < 5; ++i) { Hl = A[i] * Hl + H[i]; Al *= A[i]; }
#pragma unroll
            for (int off = 1; off < 64; off <<= 1) { const float Ap = __shfl_up(Al, off), Hp = __shfl_up(Hl, off); if (lane >= off) { Hl = Al * Hp + Hl; Al = Al * Ap; } }
            float cin = __shfl_up(Hl, 1); if (lane == 0) cin = 0.f;
#pragma unroll
            for (int i = 0; i < 5; ++i) { const int c = 5 * lane + i; if (c < NCHUNK) { CIN[(size_t)ch * CP + c] = cin; cin = A[i] * cin + H[i]; } }
        }
    }
    SEAM(12);
    if (IN(13)) rglru_phase<true>(XRb, GATEg, Wta, Wtx, a.in[9], a.in[10], a.in[12], a.in[14], a.in[15], Aend, Hend, CIN, YY, lds_raw);
    SEAM(13);
    if (IN(14)) {
        pg8::Gemm g{YY + (size_t)NMETA * RNN_W, WOUT1, SEQ, 1024, RNN_W}; pg8::StaticOrder S; S.init(SEQ, 1024, (int)gridDim.x, (int)blockIdx.x);
        EpiRes1 E{H2 + (size_t)NMETA * D, Z1 + (size_t)NMETA * D};
        pg8::gemm_phase<EpiRes1, pg8::StaticOrder, GEMM_ALIGN, GEMM_SP2>(ldsp, g, S, E);
    }
    SEAM(14);
    if (IN(15)) { PHASE_VARS;
        const float* wg = a.in[21] + (size_t)NE * D * DE; const float* wu = a.in[22] + (size_t)NE * D * DE; const float* wd = a.in[23] + (size_t)NE * DE * D;
        constexpr int J_GU = 32 * 256, J_D = 32 * 128;
        tr_run(J_GU + J_D, [&](int j) -> TrJob {
            TrJob J{};
            if (j < J_GU) { const int e = j >> 8, t = j & 255; J.dst = WGU + (size_t)e * 1024 * 1024; J.s0 = wg + (size_t)e * D * DE; J.s1 = wu + (size_t)e * D * DE; J.K = 1024; J.n0 = (t >> 4) * 64; J.k0 = (t & 15) * 64; J.mode = 2; return J; }
            j -= J_GU;
            { const int e = j >> 7, t = j & 127; J.dst = WD + (size_t)e * 1024 * 512; J.s0 = wd + (size_t)e * DE * D; J.ld = D; J.K = 512; J.n0 = (t >> 3) * 64; J.k0 = (t & 7) * 64; J.mode = 0; return J; }
        }, smf);
        __syncthreads();
        for (int tb = NMETA + blockIdx.x * 64; tb < L; tb += gridDim.x * 64)
            ln_route_block(tb, (L - tb) < 64 ? (L - tb) : 64, Z1, H3, a.in[24] + D, a.in[25] + D, (const float4*)(ws + WS_WR) + 64 * 3 * 64, a.in[18] + NGRP, a.in[20] + NE, eid, gw, counts1, smf);
    }
    SEAM(15);
    if (IN(16)) { PHASE_VARS; moe_dispatch_mfma(H3, eid, counts1, cursor1, slot, mtiles, Xperm, (int*)lds_raw, gwave, nwaves, lane, 2 * NMETA); }
    SEAM(16);
    if (IN(17)) {
        pg8::Gemm g{Xperm, WGU, MAXSLOT, 1024, 1024}; MoeOrder S; S.init(mtiles, (int)gridDim.x, (int)blockIdx.x);
        EpiGateUp E{Hm};
        pg8::gemm_phase<EpiGateUp, MoeOrder, GEMM_ALIGN, GEMM_SP2>(ldsp, g, S, E);
    }
    SEAM(17);
    if (IN(18)) {
        pg8::Gemm g{Hm, WD, MAXSLOT, 1024, 512}; MoeOrder S; S.init(mtiles, (int)gridDim.x, (int)blockIdx.x);
        EpiDown E{Yb};
        pg8::gemm_phase<EpiDown, MoeOrder, GEMM_ALIGN, GEMM_SP2>(ldsp, g, S, E);
    }
    SEAM(18);
    if (IN(19)) { PHASE_VARS;
#pragma unroll 2
        for (int t = NMETA + gwave; t < L; t += nwaves) {
            const int s0 = slot[2 * t], s1 = slot[2 * t + 1]; const float g0 = gw[2 * t], g1 = gw[2 * t + 1];
            float y[16];
            combine_row(y, H3 + (size_t)t * D, Yb + (size_t)s0 * D, Yb + (size_t)s1 * D, g0, g1, lane);
            ln_row1024v(y, a.in[26] + D, a.in[27] + D, lane);
#pragma unroll
            for (int i4 = 0; i4 < 4; ++i4) *(float4*)(a.out + (size_t)(t - NMETA) * D + 16 * lane + 4 * i4) = make_float4(y[4 * i4], y[4 * i4 + 1], y[4 * i4 + 2], y[4 * i4 + 3]);
        }
    }
#undef IN
#undef SEAM
}
constexpr int N_PHASES = 20;

extern "C" void kernel_launch(void* const* d_in, const int* in_sizes, int n_in, void* d_out, int out_size, void* d_ws, size_t ws_size, hipStream_t stream) {
    static int grid = 0;
    if (grid == 0) {
        if (n_in != 28 || out_size != SEQ * D || ws_size < WS_END) { fprintf(stderr, "kernel_launch: unexpected shapes n_in %d out %d ws %zu (need %zu)\n", n_in, out_size, ws_size, (size_t)WS_END); grid = -1; return; }
        int dev = 0, cus = 0;
        if (hipGetDevice(&dev) != hipSuccess || hipDeviceGetAttribute(&cus, hipDeviceAttributeMultiprocessorCount, dev) != hipSuccess) { grid = -1; return; }
        if (hipFuncSetAttribute((const void*)fwd, hipFuncAttributeMaxDynamicSharedMemorySize, LDS_BYTES) != hipSuccess) { fprintf(stderr, "kernel_launch: hipFuncSetAttribute failed\n"); grid = -1; return; }
        int per_cu = 0;
        if (hipOccupancyMaxActiveBlocksPerMultiprocessor(&per_cu, (const void*)fwd, NTHREADS, LDS_BYTES) != hipSuccess || per_cu < 1) fprintf(stderr, "kernel_launch: occupancy query says %d\n", per_cu);
        (void)hipGetLastError();
        grid = cus;
    }
    if (grid < 0) return;
    (void)hipMemsetAsync((char*)d_ws + WS_CTL, 0, CTL_BYTES, stream);
    Args a{};
    for (int i = 0; i < 28; ++i) a.in[i] = (const float*)d_in[i];
    a.out = (float*)d_out; a.ws = (unsigned char*)d_ws;
#if N_LAUNCH_MODE == 1
    a.ph_lo = 0; a.ph_hi = N_PHASES;
    hipLaunchKernelGGL(fwd, dim3(grid), dim3(NTHREADS), LDS_BYTES, stream, a);
#else
    for (int p = 0; p < N_PHASES; ++p) { a.ph_lo = p; a.ph_hi = p + 1; hipLaunchKernelGGL(fwd, dim3(grid), dim3(NTHREADS), LDS_BYTES, stream, a); }
#endif
}
```

```cpp
#include <hip/hip_runtime.h>
#include <cstdio>
#include <cstdint>
#include <cmath>

#ifndef GEMM_ALIGN
#define GEMM_ALIGN true
#endif
#ifndef GEMM_SP2
#define GEMM_SP2 true
#endif
#ifndef N_LAUNCH_MODE
#define N_LAUNCH_MODE 1
#endif

#define DEVI __device__ __forceinline__
#define LAS __attribute__((address_space(3)))

constexpr int D = 1024, SEQ = 16384, NMETA = 16, L = SEQ + NMETA;
constexpr int CONV_CH = 512, CONV_K = 31, HD = 64, TOPK = 256;
constexpr int IN_AB = 3144;
constexpr int OFF_AVAL = 0, OFF_AGATE = 512, OFF_Q = 1024, OFF_K = 1536, OFF_V = 2048, OFF_QI = 2560, OFF_KI = 3072, OFF_WI = 3136;
constexpr int RNN_W = 1280, RNN_NB = 10, RNN_BW = 128, RNN_K = 4;
constexpr int NGRP = 4, EPG = 8, NE = 32, DE = 512;
constexpr int NPAIR = 2 * L;
constexpr float LN_EPS = 1e-5f;
constexpr float DN_ALPHA = 1.41421356237f;
constexpr int NTHREADS = 512;
constexpr int LDS_BYTES = 147456;

#define XB_TMO      128
#define XB_XCNT(j)  (256  + 64 * (j))
#define XB_XSUB(j)  (1280 + 64 * (j))
#define XB_XGEN(j)  (2304 + 64 * (j))
#define XB_TOP      3328
#define XB_TOPGEN   3392
#define XCD_BAR_WORDS 3456
#define XB_SPIN_CAP (1u << 22)
DEVI unsigned xb_ld(unsigned* p)              { return __hip_atomic_load(p, __ATOMIC_RELAXED, __HIP_MEMORY_SCOPE_AGENT); }
DEVI unsigned xb_add(unsigned* p, unsigned v) { return __hip_atomic_fetch_add(p, v, __ATOMIC_RELAXED, __HIP_MEMORY_SCOPE_AGENT); }
DEVI unsigned xb_xcc_id() { return (unsigned)__builtin_amdgcn_s_getreg((3 << 11) | 20) & 0xFu; }
#define XB_SPIN(cond, bar) do { unsigned _sp = 0; while (cond) { __builtin_amdgcn_s_sleep(1); \
    if ((++_sp & 255u) == 0u) { if (xb_ld(&(bar)[XB_TMO])) break; if (_sp > XB_SPIN_CAP) { atomicAdd(&(bar)[XB_TMO], 1u); break; } } } } while (0)
struct XcdBarrier { unsigned* bar; unsigned x; volatile LAS unsigned* st; };
DEVI XcdBarrier xcd_barrier_post(unsigned* bar, volatile LAS unsigned* st) {
    XcdBarrier b; b.bar = bar; b.x = xb_xcc_id(); b.st = st;
    if (threadIdx.x == 0) (void)xb_add(&bar[XB_XCNT(b.x)], 1u);
    return b;
}
DEVI void xcd_barrier_complete(unsigned* bar, unsigned x, unsigned& nloc, unsigned& nx) {
    const unsigned G = gridDim.x * gridDim.y * gridDim.z;
    unsigned sum, cnt, mine, sp = 0u;
    for (;;) {
        sum = 0u; cnt = 0u; mine = 0u;
#pragma unroll
        for (unsigned j = 0; j < 16; ++j) { const unsigned c = xb_ld(&bar[XB_XCNT(j)]); sum += c; cnt += (c > 0u) ? 1u : 0u; mine = (j == x) ? c : mine; }
        if (sum == G) break;
        __builtin_amdgcn_s_sleep(1);
        if ((++sp & 255u) == 0u) { if (xb_ld(&bar[XB_TMO])) break; if (sp > XB_SPIN_CAP) { atomicAdd(&bar[XB_TMO], 1u); break; } }
    }
    nloc = mine > 0u ? mine : 1u; nx = cnt > 0u ? cnt : 1u;
}
DEVI void xcd_barrier(const XcdBarrier& b) {
    asm volatile("s_waitcnt vmcnt(0)" ::: "memory");
    __syncthreads();
    if (threadIdx.x == 0) {
        unsigned* bar = b.bar;
        __builtin_amdgcn_s_waitcnt(0);
        unsigned nloc = b.st[0], nx = b.st[1];
        if (nloc == 0u) { xcd_barrier_complete(bar, b.x, nloc, nx); b.st[0] = nloc; b.st[1] = nx; }
        const unsigned old = xb_add(&bar[XB_XSUB(b.x)], 1u);
        const unsigned gen = old / nloc;
        if (old + 1u == (gen + 1u) * nloc) {
            __builtin_amdgcn_fence(__ATOMIC_RELEASE, "agent");
            asm volatile("s_waitcnt vmcnt(0)" ::: "memory");
            const unsigned og = xb_add(&bar[XB_TOP], 1u);
            const unsigned tg = og / nx;
            if (og + 1u == (tg + 1u) * nx) xb_add(&bar[XB_TOPGEN], 1u);
            else XB_SPIN(xb_ld(&bar[XB_TOPGEN]) == tg, bar);
            __builtin_amdgcn_fence(__ATOMIC_ACQUIRE, "agent");
            xb_add(&bar[XB_XGEN(b.x)], 1u);
            asm volatile("s_waitcnt vmcnt(0)" ::: "memory");
        } else {
            XB_SPIN(xb_ld(&bar[XB_XGEN(b.x)]) == gen, bar);
            __builtin_amdgcn_fence(__ATOMIC_ACQUIRE, "agent");
            asm volatile("s_waitcnt vmcnt(0)" ::: "memory");
        }
    }
    __syncthreads();
}

constexpr int LP = 16640;
constexpr int MAXSLOT = 40960;
constexpr int NCHUNK = 257, CP = 272;
constexpr size_t MiB = 1048576;
constexpr size_t WS_CTL = 0;
constexpr size_t CTL_CNT = 16384;
constexpr size_t CTL_CUR = 16384 + 256;
constexpr size_t CTL_BYTES = 32768;
constexpr size_t WS_ROPEC = 32768;
constexpr size_t WS_ROPES = WS_ROPEC + (size_t)LP * 32 * 4;
constexpr size_t WS_EID = WS_ROPES + (size_t)LP * 32 * 4;
constexpr size_t WS_GW = WS_EID + (size_t)NPAIR * 4;
constexpr size_t WS_SLOT = WS_GW + (size_t)NPAIR * 4;
constexpr size_t WS_MTILES = WS_SLOT + (size_t)NPAIR * 4;
constexpr size_t WS_WTA = WS_MTILES + 4096;
constexpr size_t WS_WTX = WS_WTA + (size_t)RNN_NB * 128 * 128 * 2;
constexpr size_t WS_AEND = WS_WTX + (size_t)RNN_NB * 128 * 128 * 2;
constexpr size_t WS_HEND = WS_AEND + (size_t)RNN_W * CP * 4;
constexpr size_t WS_CIN = WS_HEND + (size_t)RNN_W * CP * 4;
constexpr size_t WS_WR = WS_CIN + (size_t)RNN_W * CP * 4;
constexpr size_t WS_BIG = ((WS_WR + (size_t)2 * 64 * 3 * 64 * 16 + 255) / 256) * 256;
constexpr size_t R_WIN0 = 0;
constexpr size_t R_WOUT0 = R_WIN0 + (size_t)3328 * 1024 * 2;
constexpr size_t R_WGU = R_WOUT0 + (size_t)1024 * 1024 * 2;
constexpr size_t R_WD = R_WGU + (size_t)32 * 1024 * 1024 * 2;
constexpr size_t R_WIN1 = R_WD + (size_t)32 * 1024 * 512 * 2;
constexpr size_t R_WOUT1 = R_WIN1 + (size_t)2560 * 1024 * 2;
static_assert(R_WOUT1 + (size_t)1024 * 1280 * 2 <= 112 * MiB, "weights");
constexpr size_t R_A = 112 * MiB;
constexpr size_t R_H1 = 192 * MiB;
constexpr size_t R_H2 = 257 * MiB;
constexpr size_t R_C = 322 * MiB;
constexpr size_t R_GLU = 322 * MiB;
constexpr size_t SZ512 = (size_t)LP * 512 * 2;
constexpr size_t R_Q = R_GLU + SZ512, R_K = R_Q + SZ512, R_V = R_K + SZ512, R_QI = R_V + SZ512, R_KI = R_QI + SZ512, R_WI = R_KI + (size_t)LP * 64 * 2;
static_assert(R_WI + (size_t)LP * 8 * 4 <= 406 * MiB, "in-proj outputs");
constexpr size_t R_GATE = 322 * MiB;
constexpr size_t R_XR = R_GATE + (size_t)LP * 1280 * 2;
static_assert(R_XR + (size_t)LP * 1280 * 2 <= 406 * MiB, "layer-1 in-proj outputs");
constexpr size_t R_HM = 406 * MiB;
constexpr size_t WS_END = WS_BIG + R_HM + (size_t)MAXSLOT * 512 * 2;
static_assert(WS_END <= 512 * MiB, "ws");

struct Args { const float* in[28]; float* out; unsigned char* ws; int ph_lo, ph_hi; };

DEVI int otid() { int v = (int)threadIdx.x; asm volatile("" : "+v"(v)); return v; }
template <int CTRL> DEVI float dpp_f(float v) { return __int_as_float(__builtin_amdgcn_mov_dpp(__float_as_int(v), CTRL, 0xF, 0xF, true)); }
DEVI float wave_sum(float v) {
    v += dpp_f<0xB1>(v); v += dpp_f<0x4E>(v); v += dpp_f<0x141>(v); v += dpp_f<0x140>(v);
    return __int_as_float(__builtin_amdgcn_readlane(__float_as_int(v), 0)) + __int_as_float(__builtin_amdgcn_readlane(__float_as_int(v), 16))
         + __int_as_float(__builtin_amdgcn_readlane(__float_as_int(v), 32)) + __int_as_float(__builtin_amdgcn_readlane(__float_as_int(v), 48));
}
DEVI float wave_max(float v) {
#pragma unroll
    for (int o = 32; o > 0; o >>= 1) v = fmaxf(v, __shfl_xor(v, o));
    return v;
}
DEVI float sigm(float x) { return 1.0f / (1.0f + expf(-x)); }
DEVI float gelu_tanh(float x) { return 0.5f * x * (1.0f + tanhf(0.7978845608028654f * (x + 0.044715f * x * x * x))); }
DEVI unsigned f2key(float f) { unsigned u = __float_as_uint(f); return (u & 0x80000000u) ? ~u : (u | 0x80000000u); }

namespace pg8 {
#define PG8_LAS __attribute__((address_space(3)))
typedef unsigned short bf16_t;
typedef short bf16x8 __attribute__((ext_vector_type(8)));
typedef float f32x4 __attribute__((ext_vector_type(4)));
typedef unsigned u32x4 __attribute__((ext_vector_type(4)));
constexpr int BM = 256, BK = 64, HALF = 128, HTB = HALF * BK * 2  , STAGE_BYTES = 8 * HTB, NXCD = 8, WGM = 8;

__host__ __device__ __forceinline__ int lds_byte(int r, int c) { const int st = (r >> 4) * 2 + (c >> 5), rr = r & 15, cc = c & 31, ob = rr * 64 + cc * 2; return st * 1024 + (ob ^ (((ob >> 9) & 1) << 5)); }
__host__ __device__ __forceinline__ void stage_rc(int b, int& R, int& C) { const int st = b / 1024, sb = b % 1024, swz = sb ^ (((sb >> 9) & 1) << 5); R = (st >> 1) * 16 + swz / 64; C = (st & 1) * 32 + (swz % 64) / 2; }
__host__ __device__ __forceinline__ int perm32(int rho) { const int n = rho >> 4, i = rho & 15; return 8 * (i >> 2) + 4 * n + (i & 3); }

struct Unit { int pm, pn; };
struct Gemm { const bf16_t* A; const bf16_t* Bt; int M, N, K; };

struct StaticOrder {
    int nM, nN, nwg, G, c;
    __host__ __device__ void init(int M, int N, int G_, int c_) { nM = M / BM; nN = N / BM; nwg = nM * nN; G = G_; c = c_; }
    __host__ __device__ bool next(int i, Unit& u) const {
        const long L = (long)i * G + c; if (L >= nwg) return false;
        int wgid = (int)L; { const int q = nwg / NXCD, r = nwg % NXCD, xcd = wgid % NXCD, off = wgid / NXCD; wgid = (xcd < r ? xcd * (q + 1) : r * (q + 1) + (xcd - r) * q) + off; }
        const int nig = WGM * nN, gid = wgid / nig, fm = gid * WGM, gsz = (nM - fm) < WGM ? (nM - fm) : WGM;
        u.pm = fm + ((wgid % nig) % gsz); u.pn = (wgid % nig) / gsz; return true;
    }
    __device__ __forceinline__ void a_ready(const Unit&) const {}
    __device__ __forceinline__ void done(const Unit&) const {}
};

template <class Epi, class Sched, bool ALIGN_EPI = false, bool SP2 = false>
__device__ __forceinline__ void gemm_phase(PG8_LAS unsigned char* lds, const Gemm g, const Sched& S, const Epi& E) {
    const int tid = threadIdx.x, wid = __builtin_amdgcn_readfirstlane(tid >> 6), lane = tid & 63, wr = wid >> 2, wc = wid & 3, fr = lane & 15, fq = lane >> 4;
    const int K = g.K, nt = K / BK;
    unsigned voffA[2], voffB[2];
#pragma unroll
    for (int i = 0; i < 2; ++i) { int R, C; stage_rc(tid * 16 + i * 8192, R, C); const int Rb = Epi::PERM ? ((R & ~31) + perm32(R & 31)) : R;
        voffA[i] = (unsigned)(R * K + C) * 2u; voffB[i] = (unsigned)(Rb * K + C) * 2u; }
    const size_t kstep = (size_t)(BK * 2);
    const size_t hstep = (size_t)HALF * K * 2;
    const size_t tstep = 2 * hstep;
    const unsigned ldsw = (unsigned)wid * 1024u;
    const int aoff = lds_byte(wr * 64 + fr, fq * 8), boff = lds_byte(wc * 32 + fr, fq * 8);
#define PG8_SA(b, h) (((b) * 2 + (h)) * HTB)
#define PG8_SB(b, h) ((4 + (b) * 2 + (h)) * HTB)
#define PG8_STAGE(bufoff, gbase, voff) do { _Pragma("unroll") for (int _i = 0; _i < 2; ++_i) \
        __builtin_amdgcn_global_load_lds((const unsigned*)((const char*)(gbase) + (voff)[_i]), (PG8_LAS unsigned*)(lds + (bufoff) + ldsw + _i * 8192), 16, 0, 0); } while (0)
#define PG8_LDA(dst, b, h) do { _Pragma("unroll") for (int m = 0; m < 4; ++m) _Pragma("unroll") for (int k = 0; k < 2; ++k) dst[m][k] = *(const PG8_LAS bf16x8*)(lds + PG8_SA(b, h) + aoff + m * 2048 + k * 1024); } while (0)
#define PG8_LDB(dst, b, h) do { _Pragma("unroll") for (int n = 0; n < 2; ++n) _Pragma("unroll") for (int k = 0; k < 2; ++k) dst[n][k] = *(const PG8_LAS bf16x8*)(lds + PG8_SB(b, h) + boff + n * 2048 + k * 1024); } while (0)
#define PG8_MMA(ai, bj, At, Bt) do { __builtin_amdgcn_s_setprio(1); _Pragma("unroll") for (int m = 0; m < 4; ++m) _Pragma("unroll") for (int n = 0; n < 2; ++n) _Pragma("unroll") for (int k = 0; k < 2; ++k) \
        acc[ai][bj][m][n] = __builtin_amdgcn_mfma_f32_16x16x32_bf16(Bt[n][k], At[m][k], acc[ai][bj][m][n], 0, 0, 0); __builtin_amdgcn_s_setprio(0); } while (0)
#define PG8_WAIT_V(n) asm volatile("s_waitcnt vmcnt(" #n ")" ::: "memory")
#define PG8_WAIT_L(n) asm volatile("s_waitcnt lgkmcnt(" #n ")" ::: "memory")
#define PG8_BAR __builtin_amdgcn_s_barrier()
#define PG8_SCHED __builtin_amdgcn_sched_barrier(0)
    Unit cur, nxt; int ui = 0;
    if (!S.next(0, cur)) return;
    f32x4 acc[2][2][4][2];
#pragma unroll
    for (int a = 0; a < 2; ++a)
#pragma unroll
        for (int b = 0; b < 2; ++b)
#pragma unroll
            for (int m = 0; m < 4; ++m)
#pragma unroll
                for (int n = 0; n < 2; ++n) acc[a][b][m][n] = (f32x4){0.f, 0.f, 0.f, 0.f};
    bf16x8 At[4][2], B0[2][2], B1[2][2];
    const char* cA = (const char*)g.A + (size_t)cur.pm * tstep; const char* cB = (const char*)g.Bt + (size_t)cur.pn * tstep;
    S.a_ready(cur);
    if constexpr (SP2) {
        PG8_STAGE(PG8_SB(0, 0), cB, voffB); PG8_STAGE(PG8_SB(0, 1), cB + hstep, voffB); PG8_STAGE(PG8_SA(0, 0), cA, voffA); PG8_STAGE(PG8_SA(0, 1), cA + hstep, voffA);
        if (wr == 1) PG8_BAR;
        PG8_WAIT_V(2); PG8_BAR;
        PG8_STAGE(PG8_SB(1, 0), cB + kstep, voffB); PG8_STAGE(PG8_SA(1, 0), cA + kstep, voffA); PG8_STAGE(PG8_SB(1, 1), cB + hstep + kstep, voffB);
        PG8_WAIT_V(6); PG8_BAR;
    } else {
        PG8_STAGE(PG8_SB(0, 0), cB, voffB); PG8_STAGE(PG8_SA(0, 0), cA, voffA); PG8_STAGE(PG8_SB(0, 1), cB + hstep, voffB); PG8_STAGE(PG8_SA(0, 1), cA + hstep, voffA);
        if (wr == 1) PG8_BAR;
        PG8_WAIT_V(4); PG8_BAR;
        PG8_STAGE(PG8_SB(1, 0), cB + kstep, voffB); PG8_STAGE(PG8_SA(1, 0), cA + kstep, voffA); PG8_STAGE(PG8_SB(1, 1), cB + hstep + kstep, voffB);
        PG8_WAIT_V(6); PG8_BAR;
    }
    for (;;) {
        const bool has_next = S.next(ui + 1, nxt);
        const char* nA = has_next ? (const char*)g.A + (size_t)nxt.pm * tstep : cA; const char* nB = has_next ? (const char*)g.Bt + (size_t)nxt.pn * tstep : cB;
        for (int t = 0; t < nt; t += 2) {
            const bool last = (t == nt - 2);
            const char* a1 = cA + (size_t)(t + 1) * kstep;
            const char* a2 = last ? nA : cA + (size_t)(t + 2) * kstep; const char* b2 = last ? nB : cB + (size_t)(t + 2) * kstep;
            const char* a3 = a2 + kstep; const char* b3 = b2 + kstep;
            if (last && has_next) S.a_ready(nxt);
            if constexpr (SP2) {
            PG8_LDB(B0, 0, 0); PG8_LDB(B1, 0, 1); PG8_SCHED; PG8_LDA(At, 0, 0); PG8_STAGE(PG8_SA(1, 1), a1 + hstep, voffA);
            PG8_WAIT_V(8); PG8_WAIT_L(0); PG8_BAR; PG8_MMA(0, 0, At, B0); PG8_MMA(0, 1, At, B1); PG8_BAR; PG8_SCHED;
            PG8_LDA(At, 0, 1); PG8_STAGE(PG8_SB(0, 0), b2, voffB); PG8_STAGE(PG8_SB(0, 1), b2 + hstep, voffB); PG8_STAGE(PG8_SA(0, 0), a2, voffA);
            PG8_WAIT_V(8); PG8_WAIT_L(0); PG8_BAR; PG8_MMA(1, 0, At, B0); PG8_MMA(1, 1, At, B1); PG8_BAR; PG8_SCHED;
            PG8_LDB(B0, 1, 0); PG8_LDB(B1, 1, 1); PG8_SCHED; PG8_LDA(At, 1, 0); PG8_STAGE(PG8_SA(0, 1), a2 + hstep, voffA);
            PG8_WAIT_V(8); PG8_WAIT_L(0); PG8_BAR; PG8_MMA(0, 0, At, B0); PG8_MMA(0, 1, At, B1); PG8_BAR; PG8_SCHED;
            PG8_LDA(At, 1, 1); PG8_STAGE(PG8_SB(1, 0), b3, voffB); PG8_STAGE(PG8_SB(1, 1), b3 + hstep, voffB); PG8_STAGE(PG8_SA(1, 0), a3, voffA);
            PG8_WAIT_V(8); PG8_WAIT_L(0); PG8_BAR; PG8_MMA(1, 0, At, B0); PG8_MMA(1, 1, At, B1); PG8_BAR; PG8_SCHED;
            } else {
            PG8_LDB(B0, 0, 0); PG8_SCHED; PG8_LDA(At, 0, 0); PG8_STAGE(PG8_SA(1, 1), a1 + hstep, voffA);
            PG8_WAIT_L(8); PG8_BAR; PG8_WAIT_L(0); PG8_MMA(0, 0, At, B0); PG8_BAR; PG8_SCHED;
            PG8_LDB(B1, 0, 1); PG8_STAGE(PG8_SB(0, 0), b2, voffB);
            PG8_BAR; PG8_WAIT_L(0); PG8_MMA(0, 1, At, B1); PG8_BAR;
            PG8_LDA(At, 0, 1); PG8_STAGE(PG8_SA(0, 0), a2, voffA);
            PG8_BAR; PG8_WAIT_L(0); PG8_MMA(1, 0, At, B0); PG8_BAR; PG8_SCHED;
            PG8_STAGE(PG8_SB(0, 1), b2 + hstep, voffB);
            PG8_WAIT_V(6); PG8_BAR; PG8_MMA(1, 1, At, B1); PG8_BAR;
            PG8_LDB(B0, 1, 0); PG8_SCHED; PG8_LDA(At, 1, 0); PG8_STAGE(PG8_SA(0, 1), a2 + hstep, voffA);
            PG8_WAIT_L(8); PG8_BAR; PG8_WAIT_L(0); PG8_MMA(0, 0, At, B0); PG8_BAR; PG8_SCHED;
            PG8_LDB(B1, 1, 1); PG8_STAGE(PG8_SB(1, 0), b3, voffB);
            PG8_BAR; PG8_WAIT_L(0); PG8_MMA(0, 1, At, B1); PG8_BAR;
            PG8_LDA(At, 1, 1); PG8_STAGE(PG8_SA(1, 0), a3, voffA);
            PG8_BAR; PG8_WAIT_L(0); PG8_MMA(1, 0, At, B0); PG8_BAR; PG8_SCHED;
            PG8_STAGE(PG8_SB(1, 1), b3 + hstep, voffB);
            PG8_WAIT_V(6); PG8_BAR; PG8_MMA(1, 1, At, B1); PG8_BAR;
            }
        }
        if constexpr (ALIGN_EPI) { if (wr == 0) PG8_BAR; }
        if constexpr (!Epi::AFTER_DRAIN) { E(acc, cur, wr, wc, fr, fq); S.done(cur); }
        if (!has_next) break;
#pragma unroll
        for (int a = 0; a < 2; ++a)
#pragma unroll
            for (int b = 0; b < 2; ++b)
#pragma unroll
                for (int m = 0; m < 4; ++m)
#pragma unroll
                    for (int n = 0; n < 2; ++n) acc[a][b][m][n] = (f32x4){0.f, 0.f, 0.f, 0.f};
        cur = nxt; cA = nA; cB = nB; ++ui;
        if constexpr (ALIGN_EPI) { if (wr == 1) PG8_BAR; }
    }
    PG8_WAIT_V(0);
    if constexpr (!ALIGN_EPI) { if (wr == 0) PG8_BAR; }
    PG8_BAR;
    if constexpr (Epi::AFTER_DRAIN) { E.fused(acc, cur, wr, wc, fr, fq, lds, wid, lane); S.done(cur); }
#undef PG8_SA
#undef PG8_SB
#undef PG8_STAGE
#undef PG8_LDA
#undef PG8_LDB
#undef PG8_MMA
#undef PG8_WAIT_V
#undef PG8_WAIT_L
#undef PG8_BAR
#undef PG8_SCHED
}
}

DEVI void ln_row1024(float (&y)[16], const float* g, const float* b, int lane) {
    float s = 0.f;
#pragma unroll
    for (int i = 0; i < 16; ++i) s += y[i];
    const float mu = wave_sum(s) * (1.0f / 1024.0f);
    float q = 0.f;
#pragma unroll
    for (int i = 0; i < 16; ++i) { const float d = y[i] - mu; q += d * d; }
    const float rstd = 1.0f / sqrtf(wave_sum(q) * (1.0f / 1024.0f) + LN_EPS);
#pragma unroll
    for (int i = 0; i < 16; ++i) y[i] = (y[i] - mu) * rstd * g[lane + 64 * i] + b[lane + 64 * i];
}

DEVI void route_token(const float (&y)[16], float* ys, int t, int lane, const float* wg, const float* bg, const float* we, const float* be, int* eid, float* gw, unsigned* counts) {
    float lg[36];
#pragma unroll
    for (int j = 0; j < 36; ++j) lg[j] = 0.f;
#pragma unroll
    for (int i = 0; i < 16; ++i) ys[lane + 64 * i] = y[i];
#pragma unroll 1
    for (int i = 0; i < 16; ++i) {
        const int c = lane + 64 * i;
        const float yv = ys[c];
        const float4 g4 = *(const float4*)(wg + (size_t)c * 4);
        lg[0] += yv * g4.x; lg[1] += yv * g4.y; lg[2] += yv * g4.z; lg[3] += yv * g4.w;
#pragma unroll
        for (int j = 0; j < 8; ++j) { const float4 e4 = *(const float4*)(we + (size_t)c * 32 + j * 4);
            lg[4 + j * 4 + 0] += yv * e4.x; lg[4 + j * 4 + 1] += yv * e4.y; lg[4 + j * 4 + 2] += yv * e4.z; lg[4 + j * 4 + 3] += yv * e4.w; }
    }
#pragma unroll
    for (int j = 0; j < 36; ++j) lg[j] = wave_sum(lg[j]);
    if (lane == 0) {
        float gl[4]; int g = 0;
#pragma unroll
        for (int j = 0; j < 4; ++j) gl[j] = lg[j] + bg[j];
#pragma unroll
        for (int j = 1; j < 4; ++j) if (gl[j] > gl[g]) g = j;
        float den = 0.f;
#pragma unroll
        for (int j = 0; j < 4; ++j) den += expf(gl[j] - gl[g]);
        const float gp = 1.0f / den;
        float el[8];
#pragma unroll
        for (int j = 0; j < 8; ++j) { float v = 0.f;
#pragma unroll
            for (int gg = 0; gg < 4; ++gg) v = (gg == g) ? lg[4 + gg * 8 + j] + be[gg * 8 + j] : v;
            el[j] = v; }
        int i1 = 0;
#pragma unroll
        for (int j = 1; j < 8; ++j) if (el[j] > el[i1]) i1 = j;
        int i2 = (i1 == 0) ? 1 : 0;
#pragma unroll
        for (int j = 0; j < 8; ++j) if (j != i1 && el[j] > el[i2]) i2 = j;
        const float ex = expf(el[i2] - el[i1]);
        const float p1 = 1.0f / (1.0f + ex), p2 = ex / (1.0f + ex);
        const int e1 = g * 8 + i1, e2 = g * 8 + i2;
        eid[2 * t] = e1; eid[2 * t + 1] = e2; gw[2 * t] = gp * p1; gw[2 * t + 1] = gp * p2;
        atomicAdd(&counts[e1], 1u); atomicAdd(&counts[e2], 1u);
    }
}


DEVI void ln_row1024v(float (&y)[16], const float* g, const float* b, int lane) {
    float s = 0.f;
#pragma unroll
    for (int i = 0; i < 16; ++i) s += y[i];
    const float mu = wave_sum(s) * (1.0f / 1024.0f);
    float q = 0.f;
#pragma unroll
    for (int i = 0; i < 16; ++i) { const float d = y[i] - mu; q += d * d; }
    const float rstd = 1.0f / sqrtf(wave_sum(q) * (1.0f / 1024.0f) + LN_EPS);
#pragma unroll
    for (int i4 = 0; i4 < 4; ++i4) { const float4 g4 = *(const float4*)(g + 16 * lane + 4 * i4), b4 = *(const float4*)(b + 16 * lane + 4 * i4);
        y[4 * i4] = (y[4 * i4] - mu) * rstd * g4.x + b4.x; y[4 * i4 + 1] = (y[4 * i4 + 1] - mu) * rstd * g4.y + b4.y; y[4 * i4 + 2] = (y[4 * i4 + 2] - mu) * rstd * g4.z + b4.z; y[4 * i4 + 3] = (y[4 * i4 + 3] - mu) * rstd * g4.w + b4.w; }
}
DEVI void combine_row(float (&y)[16], const float* h, const unsigned short* Y0, const unsigned short* Y1, float g0, float g1, int lane) {
    const uint4 a0 = *(const uint4*)(Y0 + 16 * lane), a1 = *(const uint4*)(Y0 + 16 * lane + 8), b0 = *(const uint4*)(Y1 + 16 * lane), b1 = *(const uint4*)(Y1 + 16 * lane + 8);
    const unsigned aw[8] = {a0.x, a0.y, a0.z, a0.w, a1.x, a1.y, a1.z, a1.w}, bw[8] = {b0.x, b0.y, b0.z, b0.w, b1.x, b1.y, b1.z, b1.w};
#pragma unroll
    for (int i4 = 0; i4 < 4; ++i4) { const float4 hv = *(const float4*)(h + 16 * lane + 4 * i4);
        y[4 * i4]     = DN_ALPHA * hv.x + (g0 * __uint_as_float(aw[2 * i4] << 16) + g1 * __uint_as_float(bw[2 * i4] << 16));
        y[4 * i4 + 1] = DN_ALPHA * hv.y + (g0 * __uint_as_float(aw[2 * i4] & 0xFFFF0000u) + g1 * __uint_as_float(bw[2 * i4] & 0xFFFF0000u));
        y[4 * i4 + 2] = DN_ALPHA * hv.z + (g0 * __uint_as_float(aw[2 * i4 + 1] << 16) + g1 * __uint_as_float(bw[2 * i4 + 1] << 16));
        y[4 * i4 + 3] = DN_ALPHA * hv.w + (g0 * __uint_as_float(aw[2 * i4 + 1] & 0xFFFF0000u) + g1 * __uint_as_float(bw[2 * i4 + 1] & 0xFFFF0000u)); }
}
typedef float f32x4v __attribute__((ext_vector_type(4)));
DEVI void ln_route_block(int tb, int ntok, const float* Zsrc, float* Hdst, const float* g, const float* b, const float4* __restrict__ Wr, const float* bg, const float* be,
                         int* eid, float* gw, unsigned* counts, float* sm) {
    const int tid = otid(), lane = tid & 63, wave = tid >> 6;
    unsigned* lcnt = (unsigned*)(sm + 8 * 16 * 48);
    if (tid < NE) lcnt[tid] = 0u;
    { float yy[8][16];
#pragma unroll
      for (int i = 0; i < 8; ++i) { const int tl = wave * 8 + i; const size_t t = (size_t)(tb + (tl < ntok ? tl : ntok - 1));
#pragma unroll
          for (int i4 = 0; i4 < 4; ++i4) { const float4 v = *(const float4*)(Zsrc + t * D + 16 * lane + 4 * i4); yy[i][4 * i4] = v.x; yy[i][4 * i4 + 1] = v.y; yy[i][4 * i4 + 2] = v.z; yy[i][4 * i4 + 3] = v.w; } }
#pragma unroll
      for (int i = 0; i < 8; ++i) { const int tl = wave * 8 + i;
          if (tl < ntok) { const size_t t = (size_t)(tb + tl);
              ln_row1024v(yy[i], g, b, lane);
#pragma unroll
              for (int i4 = 0; i4 < 4; ++i4) *(float4*)(Hdst + t * D + 16 * lane + 4 * i4) = make_float4(yy[i][4 * i4], yy[i][4 * i4 + 1], yy[i][4 * i4 + 2], yy[i][4 * i4 + 3]); } } }
    asm volatile("s_waitcnt vmcnt(0)" ::: "memory");
    __syncthreads();
    const int grp = wave & 3, khalf = wave >> 2;
    if (grp * 16 < ntok) {
        const int t0 = tb + 16 * grp, row = lane & 15, kg = lane >> 4;
        f32x4v acc[3];
#pragma unroll
        for (int ct = 0; ct < 3; ++ct) acc[ct] = (f32x4v){0.f, 0.f, 0.f, 0.f};
        const float* arow = Hdst + (size_t)(t0 + row) * D + 4 * kg;
#pragma unroll 4
        for (int sstep = 32 * khalf; sstep < 32 * khalf + 32; ++sstep) {
            const float4 a4 = *(const float4*)(arow + 16 * sstep);
#pragma unroll
            for (int ct = 0; ct < 3; ++ct) { const float4 b4 = Wr[(sstep * 3 + ct) * 64 + lane];
                acc[ct] = __builtin_amdgcn_mfma_f32_16x16x4f32(a4.x, b4.x, acc[ct], 0, 0, 0); acc[ct] = __builtin_amdgcn_mfma_f32_16x16x4f32(a4.y, b4.y, acc[ct], 0, 0, 0);
                acc[ct] = __builtin_amdgcn_mfma_f32_16x16x4f32(a4.z, b4.z, acc[ct], 0, 0, 0); acc[ct] = __builtin_amdgcn_mfma_f32_16x16x4f32(a4.w, b4.w, acc[ct], 0, 0, 0); }
        }
        float* Lg = sm + (khalf * 4 + grp) * 16 * 48;
#pragma unroll
        for (int ct = 0; ct < 3; ++ct)
#pragma unroll
            for (int j = 0; j < 4; ++j) Lg[(4 * kg + j) * 48 + 16 * ct + row] = acc[ct][j];
    }
    __syncthreads();
    if (wave < 4 && wave * 16 < ntok) {
        const int t0 = tb + 16 * wave;
        if (lane < 16) {
            const int t = t0 + lane; const float* lgA = sm + wave * 16 * 48 + lane * 48; const float* lgB = lgA + 4 * 16 * 48;
            float lg[36];
#pragma unroll
            for (int j = 0; j < 36; ++j) lg[j] = lgA[j] + lgB[j];
            float gl[4]; int gsel = 0;
#pragma unroll
            for (int j = 0; j < 4; ++j) gl[j] = lg[j] + bg[j];
#pragma unroll
            for (int j = 1; j < 4; ++j) if (gl[j] > gl[gsel]) gsel = j;
            float den = 0.f;
#pragma unroll
            for (int j = 0; j < 4; ++j) den += expf(gl[j] - gl[gsel]);
            const float gp = 1.0f / den;
            float el[8];
#pragma unroll
            for (int j = 0; j < 8; ++j) { float v = lg[4 + j];
#pragma unroll
                for (int gg = 1; gg < 4; ++gg) v = (gg == gsel) ? lg[4 + gg * 8 + j] : v;
                el[j] = v + be[gsel * 8 + j]; }
            int i1 = 0;
#pragma unroll
            for (int j = 1; j < 8; ++j) if (el[j] > el[i1]) i1 = j;
            int i2 = (i1 == 0) ? 1 : 0;
#pragma unroll
            for (int j = 0; j < 8; ++j) if (j != i1 && el[j] > el[i2]) i2 = j;
            float e1v = el[0], e2v = el[0];
#pragma unroll
            for (int j = 0; j < 8; ++j) { e1v = (j == i1) ? el[j] : e1v; e2v = (j == i2) ? el[j] : e2v; }
            const float ex = expf(e2v - e1v);
            const float p1 = 1.0f / (1.0f + ex), p2 = ex / (1.0f + ex);
            const int e1 = gsel * 8 + i1, e2 = gsel * 8 + i2;
            eid[2 * t] = e1; eid[2 * t + 1] = e2; gw[2 * t] = gp * p1; gw[2 * t + 1] = gp * p2;
            atomicAdd(&lcnt[e1], 1u); atomicAdd(&lcnt[e2], 1u);
        }
    }
    __syncthreads();
    if (tid < NE) { const unsigned c = lcnt[tid]; if (c) atomicAdd(&counts[tid], c); }
    __syncthreads();
}

using pg8::f32x4; using pg8::Unit; typedef unsigned short bf16_t;
DEVI float bf2f(unsigned short b) { return __uint_as_float(((unsigned)b) << 16); }
DEVI float bflo(unsigned w) { return __uint_as_float(w << 16); }
DEVI float bfhi(unsigned w) { return __uint_as_float(w & 0xFFFF0000u); }
DEVI unsigned cvt_pk_bf16(float lo, float hi) { unsigned r; asm volatile("v_cvt_pk_bf16_f32 %0, %1, %2" : "=v"(r) : "v"(lo), "v"(hi)); return r; }
DEVI uint2 pack4(const f32x4 v) { return make_uint2(cvt_pk_bf16(v[0], v[1]), cvt_pk_bf16(v[2], v[3])); }
DEVI float fsigm(float x) { return __builtin_amdgcn_rcpf(1.0f + __expf(-x)); }
DEVI unsigned pack4_fp8(const f32x4 v) { int w = __builtin_amdgcn_cvt_pk_fp8_f32(v[0], v[1], 0, false); w = __builtin_amdgcn_cvt_pk_fp8_f32(v[2], v[3], w, true); return (unsigned)w; }

DEVI int in0_srccol(int n) {
    if (n < 1024) { const int G = n >> 5, nn = (n >> 4) & 1, i = n & 15; return (nn ? OFF_AGATE : OFF_AVAL) + 16 * G + i; }
    if (n < 2048 || (n >= 2560 && n < 3072)) {
        const int base = n < 1536 ? OFF_Q : n < 2048 ? OFF_K : OFF_QI; const int loc = n & 511;
        const int G = loc >> 5, nn = (loc >> 4) & 1, i = loc & 15; return base + 64 * (G >> 1) + 32 * nn + 16 * (G & 1) + i; }
    if (n < 2560) return OFF_V + (n - 2048);
    if (n < 3136) { const int loc = n - 3072; const int G = loc >> 5, nn = (loc >> 4) & 1, i = loc & 15; return OFF_KI + 32 * nn + 16 * G + i; }
    if (n < 3144) return OFF_WI + (n - 3136);
    return -1;
}
struct EpiIn0 {
    static constexpr bool PERM = false, AFTER_DRAIN = false;
    bf16_t* GLU; bf16_t* KI; float* WI; const float* ropeC; const float* ropeS; unsigned char* KV8;
    DEVI void operator()(const f32x4 (&acc)[2][2][4][2], const Unit& u, int wr, int wc, int fr, int fq) const {
        const int pn = u.pn; const int rbase = u.pm * 256 + wr * 64 + fr;
        if (pn < 4) {
#pragma unroll
            for (int ai = 0; ai < 2; ++ai)
#pragma unroll
                for (int m = 0; m < 4; ++m) { const size_t row = rbase + ai * 128 + m * 16;
#pragma unroll
                    for (int bj = 0; bj < 2; ++bj) { const int G = 8 * pn + 4 * bj + wc; const f32x4 v = acc[ai][bj][m][0], g = acc[ai][bj][m][1]; f32x4 o;
#pragma unroll
                        for (int j = 0; j < 4; ++j) o[j] = v[j] * fsigm(g[j]);
                        *(uint2*)(GLU + row * 512 + 16 * G + 4 * fq) = pack4(o); } }
        } else if (pn == 8 || pn == 9) {
#pragma unroll
            for (int ai = 0; ai < 2; ++ai)
#pragma unroll
                for (int m = 0; m < 4; ++m) { const size_t row = rbase + ai * 128 + m * 16;
#pragma unroll
                    for (int bj = 0; bj < 2; ++bj)
#pragma unroll
                        for (int n = 0; n < 2; ++n) { const int col = 256 * (pn - 8) + 128 * bj + 32 * wc + 16 * n + 4 * fq;
                            *(unsigned*)(KV8 + row * 1024 + (size_t)(col >> 3) * 16 + 8 + (col & 7)) = pack4_fp8(acc[ai][bj][m][n]); } }
        } else if (pn == 12) {
            if (wc < 2) { const int d0 = 16 * wc + 4 * fq;
#pragma unroll
                for (int ai = 0; ai < 2; ++ai)
#pragma unroll
                    for (int m = 0; m < 4; ++m) { const size_t row = rbase + ai * 128 + m * 16;
                        const f32x4 c = *(const f32x4*)(ropeC + row * 32 + d0), s = *(const f32x4*)(ropeS + row * 32 + d0);
                        const f32x4 t1 = acc[ai][0][m][0], t2 = acc[ai][0][m][1];
                        *(uint2*)(KI + row * 64 + d0) = pack4(t1 * c - t2 * s); *(uint2*)(KI + row * 64 + 32 + d0) = pack4(t1 * s + t2 * c); }
            } else if (wc == 2 && fq < 2) {
#pragma unroll
                for (int ai = 0; ai < 2; ++ai)
#pragma unroll
                    for (int m = 0; m < 4; ++m) { const size_t row = rbase + ai * 128 + m * 16; *(f32x4*)(WI + row * 8 + 4 * fq) = acc[ai][0][m][0] * 0.35355339059327373f; }
            }
        } else {
            bf16_t* dst = GLU + (size_t)(pn < 6 ? 1 : pn < 8 ? 2 : 4) * LP * 512; const int pl = pn & 1; const int d0 = 16 * (wc & 1) + 4 * fq;
#pragma unroll
            for (int ai = 0; ai < 2; ++ai)
#pragma unroll
                for (int m = 0; m < 4; ++m) { const size_t row = rbase + ai * 128 + m * 16;
                    const f32x4 c = *(const f32x4*)(ropeC + row * 32 + d0), s = *(const f32x4*)(ropeS + row * 32 + d0);
#pragma unroll
                    for (int bj = 0; bj < 2; ++bj) { const int hh = 4 * pl + 2 * bj + (wc >> 1); const f32x4 t1 = acc[ai][bj][m][0], t2 = acc[ai][bj][m][1];
                        if (pn == 6 || pn == 7) { const int da = 64 * hh + d0, db = da + 32;
                            *(unsigned*)(KV8 + row * 1024 + (size_t)(da >> 3) * 16 + (da & 7)) = pack4_fp8(t1 * c - t2 * s); *(unsigned*)(KV8 + row * 1024 + (size_t)(db >> 3) * 16 + (db & 7)) = pack4_fp8(t1 * s + t2 * c);
                        } else { *(uint2*)(dst + row * 512 + 64 * hh + d0) = pack4(t1 * c - t2 * s); *(uint2*)(dst + row * 512 + 64 * hh + 32 + d0) = pack4(t1 * s + t2 * c); } } }
        }
    }
};
struct EpiRes0 {
    static constexpr bool PERM = false, AFTER_DRAIN = false;
    const float* x; const float* meta; float* Z;
    DEVI void operator()(const f32x4 (&acc)[2][2][4][2], const Unit& u, int wr, int wc, int fr, int fq) const {
        const int rbase = u.pm * 256 + wr * 64 + fr, cbase = u.pn * 256 + wc * 32 + 4 * fq;
#pragma unroll
        for (int ai = 0; ai < 2; ++ai)
#pragma unroll
            for (int m = 0; m < 4; ++m) { const int row = rbase + ai * 128 + m * 16;
                if (row < L) { const float* rs = row < NMETA ? meta + (size_t)row * D : x + (size_t)(row - NMETA) * D;
#pragma unroll
                    for (int bj = 0; bj < 2; ++bj)
#pragma unroll
                        for (int n = 0; n < 2; ++n) { const int col = cbase + 128 * bj + 16 * n; const f32x4 r4 = *(const f32x4*)(rs + col); *(f32x4*)(Z + (size_t)row * D + col) = r4 * DN_ALPHA + acc[ai][bj][m][n]; } } }
    }
};
struct EpiGateUp {
    static constexpr bool PERM = false, AFTER_DRAIN = false;
    bf16_t* Hm;
    DEVI void operator()(const f32x4 (&acc)[2][2][4][2], const Unit& u, int wr, int wc, int fr, int fq) const {
        const int pl = u.pn & 3; const int rbase = u.pm * 256 + wr * 64 + fr;
#pragma unroll
        for (int ai = 0; ai < 2; ++ai)
#pragma unroll
            for (int m = 0; m < 4; ++m) { const size_t row = rbase + ai * 128 + m * 16;
#pragma unroll
                for (int bj = 0; bj < 2; ++bj) { const int G = 8 * pl + 4 * bj + wc; const f32x4 g = acc[ai][bj][m][0], up = acc[ai][bj][m][1]; f32x4 o;
#pragma unroll
                    for (int j = 0; j < 4; ++j) o[j] = g[j] * fsigm(g[j]) * up[j];
                    *(uint2*)(Hm + row * 512 + 16 * G + 4 * fq) = pack4(o); } }
    }
};
struct EpiDown {
    static constexpr bool PERM = false, AFTER_DRAIN = false;
    bf16_t* Y;
    DEVI void operator()(const f32x4 (&acc)[2][2][4][2], const Unit& u, int wr, int wc, int fr, int fq) const {
        const int pl = u.pn & 3; const int rbase = u.pm * 256 + wr * 64 + fr, cbase = pl * 256 + wc * 32 + 4 * fq;
#pragma unroll
        for (int ai = 0; ai < 2; ++ai)
#pragma unroll
            for (int m = 0; m < 4; ++m) { const size_t row = rbase + ai * 128 + m * 16;
#pragma unroll
                for (int bj = 0; bj < 2; ++bj)
#pragma unroll
                    for (int n = 0; n < 2; ++n) *(uint2*)(Y + row * 1024 + cbase + 128 * bj + 16 * n) = pack4(acc[ai][bj][m][n]); }
    }
};
struct MoeOrder {
    const int* mt; int nunits, G, c;
    DEVI void init(const int* t, int G_, int c_) { mt = t; nunits = t[0] * 4; G = G_; c = c_; }
    DEVI bool next(int i, Unit& u) const { const int li = i * G + c; if (li >= nunits) return false; const int ti = li >> 2; u.pm = ti; u.pn = mt[4 + ti] * 4 + (li & 3); return true; }
    DEVI void a_ready(const Unit&) const {}
    DEVI void done(const Unit&) const {}
};

template <class F> DEVI void tr_tile(bf16_t* dst, int K, int n0, int k0, F src, float* sm) {
    const int tid = otid();
    __syncthreads();
    { const int nn = tid & 63, kb = tid >> 6;
#pragma unroll
      for (int p = 0; p < 8; ++p) { const int kk = kb + 8 * p; sm[kk * 65 + nn] = src(n0 + nn, k0 + kk); } }
    __syncthreads();
    { const int nn = tid >> 3, kq = (tid & 7) * 8; float v[8];
#pragma unroll
      for (int j = 0; j < 8; ++j) v[j] = sm[(kq + j) * 65 + nn];
      uint4 w; w.x = cvt_pk_bf16(v[0], v[1]); w.y = cvt_pk_bf16(v[2], v[3]); w.z = cvt_pk_bf16(v[4], v[5]); w.w = cvt_pk_bf16(v[6], v[7]);
      *(uint4*)(dst + (size_t)(n0 + nn) * K + k0 + kq) = w; }
}

struct TrJob { bf16_t* dst; const float* s0; const float* s1; int K, n0, k0, ld, mode; };
DEVI float tr_src(const TrJob& J, int n, int k) {
    if (J.mode == 0) return __builtin_nontemporal_load(J.s0 + (size_t)k * J.ld + n);
    if (J.mode == 1) { const int sc = in0_srccol(n); return sc < 0 ? 0.f : __builtin_nontemporal_load(J.s0 + (size_t)k * IN_AB + sc); }
    const int ch = (n >> 5) * 16 + (n & 15); return ((n >> 4) & 1) ? __builtin_nontemporal_load(J.s1 + (size_t)k * DE + ch) : __builtin_nontemporal_load(J.s0 + (size_t)k * DE + ch);
}
DEVI void tr_fetch(const TrJob& J, float (&v)[8]) {
    const int tid = otid(), nn = tid & 63, kb = tid >> 6;
#pragma unroll
    for (int p = 0; p < 8; ++p) v[p] = tr_src(J, J.n0 + nn, J.k0 + kb + 8 * p);
}
DEVI void tr_commit(const TrJob& J, const float (&v)[8], float* sm) {
    const int tid = otid();
    __syncthreads();
    { const int nn = tid & 63, kb = tid >> 6;
#pragma unroll
      for (int p = 0; p < 8; ++p) sm[(kb + 8 * p) * 65 + nn] = v[p]; }
    __syncthreads();
    { const int nn = tid >> 3, kq = (tid & 7) * 8; float x[8];
#pragma unroll
      for (int j = 0; j < 8; ++j) x[j] = sm[(kq + j) * 65 + nn];
      uint4 w; w.x = cvt_pk_bf16(x[0], x[1]); w.y = cvt_pk_bf16(x[2], x[3]); w.z = cvt_pk_bf16(x[4], x[5]); w.w = cvt_pk_bf16(x[6], x[7]);
      *(uint4*)(J.dst + (size_t)(J.n0 + nn) * J.K + J.k0 + kq) = w; }
}
template <class Dec> DEVI void tr_run(int njobs, Dec dec, float* sm) {
    int j = blockIdx.x; const int G = gridDim.x;
    TrJob Ja{}, Jb{}; float va[8], vb[8];
    if (j < njobs) { Ja = dec(j); tr_fetch(Ja, va); }
    while (j < njobs) {
        int jn = j + G; if (jn < njobs) { Jb = dec(jn); tr_fetch(Jb, vb); }
        tr_commit(Ja, va, sm);
        j = jn; if (j >= njobs) break;
        jn = j + G; if (jn < njobs) { Ja = dec(jn); tr_fetch(Ja, va); }
        tr_commit(Jb, vb, sm);
        j = jn;
    }
    __syncthreads();
}

DEVI void moe_dispatch_mfma(const float* H, const int* eid, const unsigned* counts, unsigned* cursor, int* slot, int* mtiles, bf16_t* Xperm, int* sm_i, int gwave, int nwaves, int lane, int p_begin) {
    { const int tid = otid();
      if (tid == 0) { int o = 0; for (int e = 0; e < NE; ++e) { sm_i[e] = o; o += (((int)counts[e] + 255) >> 8) << 8; } }
      if (tid < NE) sm_i[32 + tid] = 0; }
    __syncthreads();
    { const int ppw = (NPAIR - p_begin + nwaves - 1) / nwaves; const int pb = p_begin + gwave * ppw; const int pe = pb + ppw < NPAIR ? pb + ppw : NPAIR;
      int e_ = 0, rk = 0; const bool act = lane < ppw && pb + lane < pe;
      if (act) { e_ = eid[pb + lane]; rk = atomicAdd(&sm_i[32 + e_], 1); }
      __syncthreads();
      { const int tid = otid(); if (tid < NE) { const int c = sm_i[32 + tid]; if (c) sm_i[64 + tid] = sm_i[tid] + (int)atomicAdd(&cursor[tid], (unsigned)c); } }
      __syncthreads();
      if (pb < pe) {
        int sl = 0;
        if (act) { sl = sm_i[64 + e_] + rk; slot[pb + lane] = sl; }
        for (int k0 = 0; pb + k0 < pe; k0 += 8) {
            float4 v[8][4];
#pragma unroll
            for (int k = 0; k < 8; ++k) { const int p = pb + k0 + k < pe ? pb + k0 + k : pe - 1; const float4* src = (const float4*)(H + (size_t)(p >> 1) * D);
#pragma unroll
                for (int r = 0; r < 4; ++r) v[k][r] = src[lane + 64 * r]; }
#pragma unroll
            for (int k = 0; k < 8; ++k) { const int s = __shfl(sl, k0 + k);
                if (pb + k0 + k < pe) { uint2* dst = (uint2*)(Xperm + (size_t)s * D);
#pragma unroll
                    for (int r = 0; r < 4; ++r) dst[lane + 64 * r] = make_uint2(cvt_pk_bf16(v[k][r].x, v[k][r].y), cvt_pk_bf16(v[k][r].z, v[k][r].w)); } }
        }
      } }
    if (blockIdx.x == 0 && otid() == 0) { int n = 0; for (int e = 0; e < NE; ++e) { const int nt = ((int)counts[e] + 255) >> 8; for (int i = 0; i < nt; ++i) mtiles[4 + n++] = e; } mtiles[0] = n; }
    __syncthreads();
}

DEVI float gelu_fast(float x) { return x * fsigm(1.5957691216057308f * (x + 0.044715f * x * x * x)); }
struct EpiIn1 {
    static constexpr bool PERM = false, AFTER_DRAIN = false;
    bf16_t* G;
    DEVI void operator()(const f32x4 (&acc)[2][2][4][2], const Unit& u, int wr, int wc, int fr, int fq) const {
        const int pn = u.pn; const bool is_gate = pn < 5; const int rbase = u.pm * 256 + wr * 64 + fr;
        bf16_t* dst = G + (is_gate ? (size_t)0 : (size_t)LP * RNN_W) + (size_t)((is_gate ? pn : pn - 5) * 256 + wc * 32 + 4 * fq);
#pragma unroll
        for (int ai = 0; ai < 2; ++ai)
#pragma unroll
            for (int m = 0; m < 4; ++m) { const size_t row = rbase + ai * 128 + m * 16;
#pragma unroll
                for (int bj = 0; bj < 2; ++bj)
#pragma unroll
                    for (int n = 0; n < 2; ++n) { f32x4 v = acc[ai][bj][m][n];
                        if (is_gate) {
#pragma unroll
                            for (int j = 0; j < 4; ++j) v[j] = gelu_fast(v[j]); }
                        *(uint2*)(dst + row * RNN_W + 128 * bj + 16 * n) = pack4(v); } }
    }
};
struct EpiRes1 {
    static constexpr bool PERM = false, AFTER_DRAIN = false;
    const float* R; float* Z;
    DEVI void operator()(const f32x4 (&acc)[2][2][4][2], const Unit& u, int wr, int wc, int fr, int fq) const {
        const int rbase = u.pm * 256 + wr * 64 + fr, cbase = u.pn * 256 + wc * 32 + 4 * fq;
#pragma unroll
        for (int ai = 0; ai < 2; ++ai)
#pragma unroll
            for (int m = 0; m < 4; ++m) { const size_t row = rbase + ai * 128 + m * 16;
#pragma unroll
                for (int bj = 0; bj < 2; ++bj)
#pragma unroll
                    for (int n = 0; n < 2; ++n) { const int col = cbase + 128 * bj + 16 * n; const f32x4 r4 = *(const f32x4*)(R + row * D + col); *(f32x4*)(Z + row * D + col) = r4 * DN_ALPHA + acc[ai][bj][m][n]; } }
    }
};

typedef short bf16x8_t __attribute__((ext_vector_type(8)));
struct RgIn { uint4 x[2][4]; };
DEVI void rglru_fetch(int c, int ch0, const bf16_t* __restrict__ XR, int tid, RgIn& R) {
    const int c8 = tid & 15, tr = tid >> 4;
#pragma unroll
    for (int half = 0; half < 2; ++half) { const int t = c * 64 + tr + 32 * half;
#pragma unroll
        for (int j = 0; j < 4; ++j) { const int tt = t - 3 + j; R.x[half][j] = tt >= 0 ? *(const uint4*)(XR + (size_t)tt * RNN_W + ch0 + 8 * c8) : make_uint4(0u, 0u, 0u, 0u); } }
}
template <bool FINAL>
DEVI void rglru_unit(int c, int nb, const RgIn& R, const bf16x8_t (&fa)[4], const bf16x8_t (&fx)[4], float bav, float bxv, float sp,
                     const bf16_t* __restrict__ GATEg, float* __restrict__ Aend, float* __restrict__ Hend, const float* __restrict__ CIN, bf16_t* __restrict__ YY,
                     unsigned char* lds, int tid) {
    const int lane = tid & 63, w = tid >> 6, col = lane & 15, quad = lane >> 4;
    bf16_t* xcb = (bf16_t*)lds;
    float* xcf = (float*)(lds + 64 * 136 * 2);
    const float* cwl = (const float*)(lds + 64 * 136 * 2 + 64 * 132 * 4);
    const int t0 = c * 64, ch0 = nb * RNN_BW, ch = ch0 + 16 * w + col;
    const float cinv = FINAL ? CIN[(size_t)ch * CP + c] : 0.f;
    const int c8 = tid & 15, tr = tid >> 4;
    uint4 g[2];
    if (FINAL) {
#pragma unroll
        for (int half = 0; half < 2; ++half) { const int t = t0 + tr + 32 * half; g[half] = (t < L) ? *(const uint4*)(GATEg + (size_t)t * RNN_W + ch0 + 8 * c8) : make_uint4(0u, 0u, 0u, 0u); } }
    __syncthreads();
    {
        float bv[8];
        { const float4 b0 = *(const float4*)(cwl + 512 + 8 * c8), b1 = *(const float4*)(cwl + 512 + 8 * c8 + 4); bv[0] = b0.x; bv[1] = b0.y; bv[2] = b0.z; bv[3] = b0.w; bv[4] = b1.x; bv[5] = b1.y; bv[6] = b1.z; bv[7] = b1.w; }
#pragma unroll
        for (int half = 0; half < 2; ++half) { const int tl = tr + 32 * half;
            float v[8];
#pragma unroll
            for (int i = 0; i < 8; ++i) v[i] = bv[i];
#pragma unroll
            for (int j = 0; j < 4; ++j) { const uint4 xv = R.x[half][j];
                const float4 w0 = *(const float4*)(cwl + j * 128 + 8 * c8), w1 = *(const float4*)(cwl + j * 128 + 8 * c8 + 4);
                v[0] += w0.x * bflo(xv.x); v[1] += w0.y * bfhi(xv.x); v[2] += w0.z * bflo(xv.y); v[3] += w0.w * bfhi(xv.y);
                v[4] += w1.x * bflo(xv.z); v[5] += w1.y * bfhi(xv.z); v[6] += w1.z * bflo(xv.w); v[7] += w1.w * bfhi(xv.w); }
            *(float4*)(xcf + tl * 132 + 8 * c8) = make_float4(v[0], v[1], v[2], v[3]); *(float4*)(xcf + tl * 132 + 8 * c8 + 4) = make_float4(v[4], v[5], v[6], v[7]);
            uint4 pk; pk.x = cvt_pk_bf16(v[0], v[1]); pk.y = cvt_pk_bf16(v[2], v[3]); pk.z = cvt_pk_bf16(v[4], v[5]); pk.w = cvt_pk_bf16(v[6], v[7]);
            *(uint4*)(xcb + (16 * ((tl >> 2) & 3) + 4 * (tl >> 4) + (tl & 3)) * 136 + 8 * c8) = pk; }
    }
    __syncthreads();
    f32x4 ca[4], cx[4];
#pragma unroll
    for (int mt = 0; mt < 4; ++mt) { ca[mt] = (f32x4){0.f, 0.f, 0.f, 0.f}; cx[mt] = (f32x4){0.f, 0.f, 0.f, 0.f};
#pragma unroll
        for (int ks = 0; ks < 4; ++ks) { const bf16x8_t af = *(const bf16x8_t*)(xcb + (16 * mt + col) * 136 + 32 * ks + 8 * quad);
            ca[mt] = __builtin_amdgcn_mfma_f32_16x16x32_bf16(af, fa[ks], ca[mt], 0, 0, 0);
            cx[mt] = __builtin_amdgcn_mfma_f32_16x16x32_bf16(af, fx[ks], cx[mt], 0, 0, 0); } }
    float av[4][4], uv[4][4]; float A = 1.f, H = 0.f;
#pragma unroll
    for (int mt = 0; mt < 4; ++mt) {
#pragma unroll
        for (int j = 0; j < 4; ++j) { const int tl = 16 * quad + 4 * mt + j;
            const float xcv = xcf[tl * 132 + 16 * w + col];
            const float r = fsigm(ca[mt][j] + bav), ig = fsigm(cx[mt][j] + bxv);
            const float la = -8.0f * r * sp;
            const float x2 = 2.0f * la;
            float em1 = x2 * (1.0f + x2 * (0.5f + x2 * (0.16666667f + x2 * (0.041666668f + x2 * (0.0083333338f + x2 * (0.0013888889f + x2 * 0.0001984127f))))));
            if (x2 < -0.5f) em1 = expm1f(x2);
            float a_ = __expf(la), u_ = __builtin_amdgcn_sqrtf(-em1) * (ig * xcv);
            if (t0 + tl >= L) { a_ = 1.f; u_ = 0.f; }
            av[mt][j] = a_; uv[mt][j] = u_; H = a_ * H + u_; A *= a_; } }
    float carry = cinv, prod = 1.f, hin = 0.f;
#pragma unroll
    for (int q = 0; q < 4; ++q) {
        if (quad == q) hin = carry;
        const float nw = A * carry + H, np = A * prod;
        carry = __shfl(nw, q * 16 + col); prod = __shfl(np, q * 16 + col); }
    if (!FINAL) {
        if (quad == 0) { Aend[(size_t)ch * CP + c] = prod; Hend[(size_t)ch * CP + c] = carry; }
    } else {
        float h = hin;
#pragma unroll
        for (int mt = 0; mt < 4; ++mt)
#pragma unroll
            for (int j = 0; j < 4; ++j) { h = av[mt][j] * h + uv[mt][j]; xcf[(16 * quad + 4 * mt + j) * 132 + 16 * w + col] = h; }
        __syncthreads();
#pragma unroll
        for (int half = 0; half < 2; ++half) { const int tl = tr + 32 * half, t = t0 + tl;
            if (t >= NMETA && t < L) {
                const float4 h0 = *(const float4*)(xcf + tl * 132 + 8 * c8), h1 = *(const float4*)(xcf + tl * 132 + 8 * c8 + 4);
                const uint4 gg = g[half];
                uint4 pk; pk.x = cvt_pk_bf16(bflo(gg.x) * h0.x, bfhi(gg.x) * h0.y); pk.y = cvt_pk_bf16(bflo(gg.y) * h0.z, bfhi(gg.y) * h0.w);
                pk.z = cvt_pk_bf16(bflo(gg.z) * h1.x, bfhi(gg.z) * h1.y); pk.w = cvt_pk_bf16(bflo(gg.w) * h1.z, bfhi(gg.w) * h1.w);
                *(uint4*)(YY + (size_t)t * RNN_W + ch0 + 8 * c8) = pk; } }
    }
}
template <bool FINAL>
DEVI void rglru_phase(const bf16_t* __restrict__ XR, const bf16_t* __restrict__ GATEg, const bf16_t* __restrict__ Wta, const bf16_t* __restrict__ Wtx,
                      const float* __restrict__ cw, const float* __restrict__ cb, const float* __restrict__ ba, const float* __restrict__ bx, const float* __restrict__ lam,
                      float* __restrict__ Aend, float* __restrict__ Hend, const float* __restrict__ CIN, bf16_t* __restrict__ YY, unsigned char* lds) {
    const int tid = otid(), lane = tid & 63, w = tid >> 6, col = lane & 15, quad = lane >> 4;
    const int G = gridDim.x, nb = blockIdx.x % RNN_NB, rank = blockIdx.x / RNN_NB, nblk = (G - nb + RNN_NB - 1) / RNN_NB;
    const int ch0 = nb * RNN_BW, ch = ch0 + 16 * w + col;
    float* cwl = (float*)(lds + 64 * 136 * 2 + 64 * 132 * 4);
    __syncthreads();
    for (int i = tid; i < 640; i += NTHREADS) cwl[i] = i < 512 ? cw[(i >> 7) * RNN_W + ch0 + (i & 127)] : cb[ch0 + (i - 512)];
    bf16x8_t fa[4], fx[4];
    { const size_t wrow = ((size_t)nb * 128 + 16 * w + col) * 128 + 8 * quad;
#pragma unroll
      for (int ks = 0; ks < 4; ++ks) { fa[ks] = *(const bf16x8_t*)(Wta + wrow + 32 * ks); fx[ks] = *(const bf16x8_t*)(Wtx + wrow + 32 * ks); } }
    const float bav = ba[ch], bxv = bx[ch], sp = log1pf(expf(-lam[ch]));
    RgIn Ra, Rb;
    int c = rank;
    if (c < NCHUNK) rglru_fetch(c, ch0, XR, tid, Ra);
    while (c < NCHUNK) {
        int cn = c + nblk;
        if (cn < NCHUNK) rglru_fetch(cn, ch0, XR, tid, Rb);
        rglru_unit<FINAL>(c, nb, Ra, fa, fx, bav, bxv, sp, GATEg, Aend, Hend, CIN, YY, lds, tid);
        c = cn; if (c >= NCHUNK) break;
        cn = c + nblk;
        if (cn < NCHUNK) rglru_fetch(cn, ch0, XR, tid, Ra);
        rglru_unit<FINAL>(c, nb, Rb, fa, fx, bav, bxv, sp, GATEg, Aend, Hend, CIN, YY, lds, tid);
        c = cn;
    }
    __syncthreads();
}

constexpr int SW = 544;
constexpr int CB = 512;
constexpr int NTILE = L / 16;
typedef float f32x16 __attribute__((ext_vector_type(16)));
typedef float f32x2v __attribute__((ext_vector_type(2)));
constexpr int HROW = 2112;
constexpr int IL_HIST = 0, IL_CKEY = 0, IL_CIDX = 16 * CB * 4, IL_HIST2 = 2 * 16 * CB * 4, IL_ROWS = IL_HIST2 + 16 * 256 * 4, IL_WI = 16 * HROW * 4, IL_QST = IL_WI + 512, IL_QST2 = IL_QST + 256, IL_CCNT = IL_QST2 + 256, IL_FLAG = IL_CCNT + 64;
constexpr int IL_QF = IL_ROWS + 16 * SW * 4;
static_assert(IL_QF + 8 * 512 <= IL_WI && IL_FLAG + 64 <= LDS_BYTES - 16, "indexer LDS");

constexpr int AW_BYTES = 512;
typedef short s16x2 __attribute__((ext_vector_type(2)));
DEVI float dot2bf(unsigned a, unsigned b, float c) { return __builtin_amdgcn_fdot2_f32_bf16(__builtin_bit_cast(s16x2, a), __builtin_bit_cast(s16x2, b), c, false); }
#define LDS_FENCE() asm volatile("s_waitcnt lgkmcnt(0)" ::: "memory")

struct AttnQ { float m, l, o[8]; };

DEVI void attn_issue(int b0, int n, const unsigned short* lst, const unsigned char* __restrict__ KV8, int lane, uint4 (&kv)[8]) {
    const int last = n - 1;
#pragma unroll
    for (int kk = 0; kk < 8; ++kk) { const int ii = b0 + kk; const int key = lst[ii < last ? ii : last]; kv[kk] = *(const uint4*)(KV8 + (size_t)key * 1024 + lane * 16); }
}
DEVI void attn_compute(AttnQ& S, int b0, int n, const float (&q)[8], const uint4 (&kv)[8]) {
    float sc[8]; float mx = S.m;
#pragma unroll
    for (int u = 0; u < 8; ++u) {
        const f32x2v k0 = __builtin_amdgcn_cvt_pk_f32_fp8((int)kv[u].x, false), k1 = __builtin_amdgcn_cvt_pk_f32_fp8((int)kv[u].x, true),
                     k2 = __builtin_amdgcn_cvt_pk_f32_fp8((int)kv[u].y, false), k3 = __builtin_amdgcn_cvt_pk_f32_fp8((int)kv[u].y, true);
        f32x2v d2 = k0 * (f32x2v){q[0], q[1]}; d2 = k1 * (f32x2v){q[2], q[3]} + d2; d2 = k2 * (f32x2v){q[4], q[5]} + d2; d2 = k3 * (f32x2v){q[6], q[7]} + d2;
        float d = d2[0] + d2[1];
        d += dpp_f<0xB1>(d); d += dpp_f<0x4E>(d); d += dpp_f<0x141>(d);
        sc[u] = (b0 + u < n) ? d : -INFINITY;
        mx = fmaxf(mx, sc[u]); }
    const float scale = __builtin_amdgcn_exp2f(S.m - mx);
    float ls = S.l * scale;
#pragma unroll
    for (int i = 0; i < 8; ++i) S.o[i] *= scale;
#pragma unroll
    for (int u = 0; u < 8; ++u) {
        const float p = __builtin_amdgcn_exp2f(sc[u] - mx); ls += p;
        const f32x2v v0 = __builtin_amdgcn_cvt_pk_f32_fp8((int)kv[u].z, false), v1 = __builtin_amdgcn_cvt_pk_f32_fp8((int)kv[u].z, true),
                     v2 = __builtin_amdgcn_cvt_pk_f32_fp8((int)kv[u].w, false), v3 = __builtin_amdgcn_cvt_pk_f32_fp8((int)kv[u].w, true);
        S.o[0] += p * v0[0]; S.o[1] += p * v0[1]; S.o[2] += p * v1[0]; S.o[3] += p * v1[1]; S.o[4] += p * v2[0]; S.o[5] += p * v2[1]; S.o[6] += p * v3[0]; S.o[7] += p * v3[1]; }
    S.l = ls; S.m = mx;
}

DEVI void attn_query(int t, const bf16_t* __restrict__ Qb, const unsigned char* __restrict__ KV8,
                     const unsigned* SR  , bf16_t* __restrict__ AO, unsigned char* wl, int lane) {
    unsigned short* lst = (unsigned short*)wl;
    LDS_FENCE();
    const int nw = (t >> 5) + 1; int base = 0;
    for (int w0 = 0; w0 < nw; w0 += 64) {
        const int wi = w0 + lane; const unsigned wv = wi < nw ? SR[wi] : 0u;
        const int pc = __popc(wv); int pre = pc;
#pragma unroll
        for (int off = 1; off < 64; off <<= 1) { const int o_ = __shfl_up(pre, off); if (lane >= off) pre += o_; }
        int pos = base + pre - pc; unsigned mm = wv;
        while (mm) { const int bpos = __ffs((int)mm) - 1; mm &= mm - 1u; if (pos < TOPK) lst[pos] = (unsigned short)(wi * 32 + bpos); ++pos; }
        base += __shfl(pre, 63);
    }
    const int n = base < TOPK ? base : TOPK;
    float q[8];
    { const uint4 qv = ((const uint4*)(Qb + (size_t)t * 512))[lane]; const float qs = 0.18033688011112042f;
      q[0] = bflo(qv.x) * qs; q[1] = bfhi(qv.x) * qs; q[2] = bflo(qv.y) * qs; q[3] = bfhi(qv.y) * qs; q[4] = bflo(qv.z) * qs; q[5] = bfhi(qv.z) * qs; q[6] = bflo(qv.w) * qs; q[7] = bfhi(qv.w) * qs; }
    LDS_FENCE();
    AttnQ S; S.m = -INFINITY; S.l = 0.f;
#pragma unroll
    for (int d = 0; d < 8; ++d) S.o[d] = 0.f;
    uint4 ka[8], kb_[8], kc[8];
    attn_issue(0, n, lst, KV8, lane, ka);
    if (8 < n) attn_issue(8, n, lst, KV8, lane, kb_);
    for (int b0 = 0; b0 < n; b0 += 24) {
        if (b0 + 16 < n) attn_issue(b0 + 16, n, lst, KV8, lane, kc);
        attn_compute(S, b0, n, q, ka);
        if (b0 + 8 < n) {
            if (b0 + 24 < n) attn_issue(b0 + 24, n, lst, KV8, lane, ka);
            attn_compute(S, b0 + 8, n, q, kb_);
            if (b0 + 16 < n) {
                if (b0 + 32 < n) attn_issue(b0 + 32, n, lst, KV8, lane, kb_);
                attn_compute(S, b0 + 16, n, q, kc);
            }
        }
    }
    const int hd = lane >> 3, ch = lane & 7;
    const float inv = 1.0f / S.l;
    uint4 pk; pk.x = cvt_pk_bf16(S.o[0] * inv, S.o[1] * inv); pk.y = cvt_pk_bf16(S.o[2] * inv, S.o[3] * inv); pk.z = cvt_pk_bf16(S.o[4] * inv, S.o[5] * inv); pk.w = cvt_pk_bf16(S.o[6] * inv, S.o[7] * inv);
    *(uint4*)(AO + (size_t)t * 1024 + 512 + hd * 64 + ch * 8) = pk;
}

DEVI float relu_i(float x) { const int v = __float_as_int(x); return __int_as_float(v > 0 ? v : 0); }
DEVI int hpos(unsigned w) { return (int)(w + (w >> 5)); }
template <int PASS, bool L0>
DEVI void idx_sweep(int q0, int nkb, int wave, int lane, const bf16x8_t (&Af)[4][4], const bf16_t* __restrict__ KI, unsigned char* lds, unsigned* __restrict__ SELM) {
    const int l31 = lane & 31, h2 = lane >> 5;
    unsigned* hist = (unsigned*)(lds + IL_HIST);
    const float* wiL = (const float*)(lds + IL_WI);
    const uint4* qst = (const uint4*)(lds + IL_QST);
    const uint4* qst2 = (const uint4*)(lds + IL_QST2);
    unsigned* ckey = (unsigned*)(lds + IL_CKEY); unsigned* cidx = (unsigned*)(lds + IL_CIDX); unsigned* ccnt = (unsigned*)(lds + IL_CCNT); unsigned* rows = (unsigned*)(lds + IL_ROWS);
    const bf16_t* kp = KI + (size_t)l31 * 64 + 8 * h2;
    bf16x8_t Bn[4];
    if (wave < nkb) {
#pragma unroll
        for (int ks = 0; ks < 4; ++ks) Bn[ks] = *(const bf16x8_t*)(kp + (size_t)wave * 2048 + 16 * ks); }
    for (int kb = wave; kb < nkb; kb += 8) {
        const int s = kb * 32 + l31;
        bf16x8_t Bf[4];
#pragma unroll
        for (int ks = 0; ks < 4; ++ks) Bf[ks] = Bn[ks];
        if (kb + 8 < nkb) {
#pragma unroll
            for (int ks = 0; ks < 4; ++ks) Bn[ks] = *(const bf16x8_t*)(kp + (size_t)(kb + 8) * 2048 + 16 * ks); }
        f32x16 acc[4];
#pragma unroll
        for (int rb = 0; rb < 4; ++rb) {
#pragma unroll
            for (int i = 0; i < 16; ++i) acc[rb][i] = 0.f; }
#pragma unroll
        for (int ks = 0; ks < 4; ++ks)
#pragma unroll
            for (int rb = 0; rb < 4; ++rb) acc[rb] = __builtin_amdgcn_mfma_f32_32x32x16_bf16(Af[rb][ks], Bf[ks], acc[rb], 0, 0, 0);
        const bool edge = kb * 32 + 31 > q0;
#pragma unroll
        for (int rb = 0; rb < 4; ++rb) {
            const int qa = 4 * rb + 2 * h2;
            float4 w[2][2]; uint4 st[2];
#pragma unroll
            for (int e = 0; e < 2; ++e) { w[e][0] = *(const float4*)(wiL + (qa + e) * 8); w[e][1] = *(const float4*)(wiL + (qa + e) * 8 + 4);
                if (PASS == 2) st[e] = qst2[qa + e]; else if (!L0) st[e] = qst[qa + e]; }
#pragma unroll
            for (int e = 0; e < 2; ++e) {
                const int qs = qa + e;
                f32x2v s2 = (f32x2v){relu_i(acc[rb][8 * e + 0]), relu_i(acc[rb][8 * e + 1])} * (f32x2v){w[e][0].x, w[e][0].y};
                s2 = (f32x2v){relu_i(acc[rb][8 * e + 2]), relu_i(acc[rb][8 * e + 3])} * (f32x2v){w[e][0].z, w[e][0].w} + s2;
                s2 = (f32x2v){relu_i(acc[rb][8 * e + 4]), relu_i(acc[rb][8 * e + 5])} * (f32x2v){w[e][1].x, w[e][1].y} + s2;
                s2 = (f32x2v){relu_i(acc[rb][8 * e + 6]), relu_i(acc[rb][8 * e + 7])} * (f32x2v){w[e][1].z, w[e][1].w} + s2;
                const float sc = s2[0] + s2[1];
                const bool valid = !edge || s <= q0 + qs;
                const unsigned key = f2key(sc);
                if (PASS == 1) {
                    if (L0) { if (valid) { const unsigned bin = key >> 20; atomicAdd(&hist[qs * HROW + hpos(bin >> 1)], (bin & 1u) ? 0x10000u : 1u); } }
                    else if (valid && (key & st[e].x) == st[e].y) { const unsigned bin = (key >> st[e].z) & st[e].w; atomicAdd(&hist[qs * HROW + hpos(bin >> 1)], (bin & 1u) ? 0x10000u : 1u); }
                } else {
                    const bool all = st[e].z == 0xFFFFFFFFu;
                    const bool sel = valid && (all || key >= st[e].y);
                    const bool cnd = valid && !all && key >= st[e].x && key < st[e].y;
                    const unsigned long long bal = __ballot(sel);
                    if (l31 == 0) rows[qs * SW + kb] = h2 ? (unsigned)(bal >> 32) : (unsigned)bal;
                    if (cnd) { const unsigned n = atomicAdd(&ccnt[qs], 1u); if (n < (unsigned)CB) { ckey[qs * CB + n] = key; cidx[qs * CB + n] = (unsigned)s; } }
                }
            }
        }
    }
}

DEVI void indexer_tile(int q0, const bf16_t* __restrict__ QI, const bf16_t* __restrict__ KI, const float* __restrict__ WI, const bf16_t* __restrict__ Qb, const unsigned char* __restrict__ KV8, bf16_t* __restrict__ AO, unsigned char* lds) {
    const int tid = otid(), lane = tid & 63, wave = tid >> 6;
    unsigned* hist = (unsigned*)(lds + IL_HIST);
    float* wiL = (float*)(lds + IL_WI);
    uint4* qst = (uint4*)(lds + IL_QST); uint4* qst2 = (uint4*)(lds + IL_QST2);
    unsigned* ckey = (unsigned*)(lds + IL_CKEY); unsigned* cidx = (unsigned*)(lds + IL_CIDX); unsigned* hist2 = (unsigned*)(lds + IL_HIST2); unsigned* ccnt = (unsigned*)(lds + IL_CCNT);
    volatile unsigned* flag = (volatile unsigned*)(lds + IL_FLAG);
    const int nkb = (q0 + 16 + 31) >> 5;
    bf16x8_t Af[4][4];
    { const int rho = lane & 31, hq = lane >> 5; const int qq = 2 * ((rho >> 2) & 1) + (rho >> 4), head = 4 * ((rho >> 3) & 1) + (rho & 3);
#pragma unroll
      for (int rb = 0; rb < 4; ++rb)
#pragma unroll
          for (int ks = 0; ks < 4; ++ks) Af[rb][ks] = *(const bf16x8_t*)(QI + (size_t)(q0 + 4 * rb + qq) * 512 + head * 64 + 16 * ks + 8 * hq); }
    __syncthreads();
    if (tid < 128) wiL[tid] = WI[(size_t)q0 * 8 + tid] * 0.125f;
    if (tid < 16) { qst[tid] = make_uint4(0u, 0u, 20u, 4095u); qst2[tid] = make_uint4(0u, 0u, (unsigned)TOPK, 0u); ccnt[tid] = 0u; }
    for (int level = 0; level < 3; ++level) {
        for (int i = tid; i < 16 * HROW / 4; i += NTHREADS) ((uint4*)hist)[i] = make_uint4(0u, 0u, 0u, 0u);
        if (tid == 0) flag[0] = 0u;
        __syncthreads();
        if (level == 0) idx_sweep<1, true>(q0, nkb, wave, lane, Af, KI, lds, nullptr); else idx_sweep<1, false>(q0, nkb, wave, lane, Af, KI, lds, nullptr);
        __syncthreads();
#pragma unroll 1
        for (int qi = 0; qi < 2; ++qi) {
            const int qs = 2 * wave + qi;
            const uint4 st = qst[qs]; const uint4 b = qst2[qs];
            if (st.x == 0xFFFFFFFFu && st.y == 0u && st.w == 0u) continue;
            unsigned wv[32]; unsigned loc = 0u;
#pragma unroll
            for (int i = 0; i < 32; ++i) { wv[i] = hist[qs * HROW + 33 * lane + i]; loc += (wv[i] & 0xFFFFu) + (wv[i] >> 16); }
            unsigned suf = loc;
#pragma unroll
            for (int off = 1; off < 64; off <<= 1) { const unsigned o = __shfl_down(suf, off); if (lane + off < 64) suf += o; }
            const unsigned total = __shfl(suf, 0), above = suf - loc, need = b.z;
            if (level == 0 && total <= need) { if (lane == 0) { qst[qs] = make_uint4(0xFFFFFFFFu, 0u, 0u, 0u); qst2[qs] = make_uint4(0u, 0u, 0xFFFFFFFFu, 0u); } continue; }
            const bool mine = above < need && need <= above + loc;
            unsigned cum = above, c = 0u; int d = 0; bool found = false;
#pragma unroll
            for (int i = 31; i >= 0; --i) {
                const unsigned chi = wv[i] >> 16, clo = wv[i] & 0xFFFFu;
                if (!found && cum + chi >= need) { found = true; d = 64 * lane + 2 * i + 1; c = chi; } if (!found) cum += chi;
                if (!found && cum + clo >= need) { found = true; d = 64 * lane + 2 * i; c = clo; } if (!found) cum += clo; }
            if (mine) {
                const unsigned pval = st.y | ((unsigned)d << st.z), pmask = st.x | (st.w << st.z);
                const unsigned nneed = need - cum;
                const unsigned long long hi64 = (unsigned long long)pval + (1ull << st.z);
                const unsigned hi = hi64 > 0xFFFFFFFFull ? 0xFFFFFFFFu : (unsigned)hi64;
                if (c <= (unsigned)CB || level == 2) { qst[qs] = make_uint4(0xFFFFFFFFu, 0u, 0u, 0u); qst2[qs] = make_uint4(pval, hi, nneed, st.z); }
                else { const unsigned nsh = (level == 0) ? 8u : 0u, ndm = (level == 0) ? 4095u : 255u; qst[qs] = make_uint4(pmask, pval, nsh, ndm); qst2[qs] = make_uint4(pval, hi, nneed, st.z); flag[0] = 1u; }
            }
        }
        __syncthreads();
        if (flag[0] == 0u) break;
        __syncthreads();
    }
    __syncthreads();
    idx_sweep<2, false>(q0, nkb, wave, lane, Af, KI, lds, nullptr);
    asm volatile("s_waitcnt vmcnt(0)" ::: "memory");
    __syncthreads();
    unsigned* rows = (unsigned*)(lds + IL_ROWS);
#pragma unroll 1
    for (int qi = 0; qi < 2; ++qi) {
        const int qs = 2 * wave + qi;
        const uint4 b = qst2[qs];
        unsigned* row = rows + qs * SW;
        if (b.z != 0xFFFFFFFFu) {
            const unsigned need = b.z; const unsigned cn = ccnt[qs]; const int n = (int)(cn < (unsigned)CB ? cn : (unsigned)CB);
            const unsigned rem = b.w;
            const unsigned sh8 = rem > 8u ? rem - 8u : 0u; const unsigned m8 = rem >= 8u ? 255u : ((1u << rem) - 1u);
#pragma unroll
            for (int i = 0; i < 4; ++i) hist2[qs * 256 + 4 * lane + i] = 0u;
            asm volatile("s_waitcnt lgkmcnt(0)" ::: "memory");
            for (int i = lane; i < n; i += 64) atomicAdd(&hist2[qs * 256 + ((ckey[qs * CB + i] >> sh8) & m8)], 1u);
            asm volatile("s_waitcnt lgkmcnt(0)" ::: "memory");
            unsigned c4[4]; unsigned loc = 0u;
#pragma unroll
            for (int i = 0; i < 4; ++i) { c4[i] = hist2[qs * 256 + 4 * lane + i]; loc += c4[i]; }
            unsigned suf = loc;
#pragma unroll
            for (int off = 1; off < 64; off <<= 1) { const unsigned o = __shfl_down(suf, off); if (lane + off < 64) suf += o; }
            const unsigned above = suf - loc;
            const bool mine = above < need && need <= above + loc;
            unsigned b2 = 0u, need2 = 0u;
            if (mine) { unsigned cum = above; int i = 3; for (; i > 0; --i) { if (cum + c4[i] >= need) break; cum += c4[i]; } b2 = 4u * lane + i; need2 = need - cum; }
            const unsigned long long mb = __ballot(mine);
            if (mb == 0ull) {
                for (int i = lane; i < n; i += 64) if ((unsigned)i < need) { const unsigned ii = cidx[qs * CB + i]; atomicOr(&row[ii >> 5], 1u << (ii & 31u)); }
            } else {
                const int src = __ffsll((long long)mb) - 1;
                b2 = __shfl(b2, src); need2 = __shfl(need2, src);
                for (int i0 = 0; i0 < n; i0 += 64) {
                    const int i = i0 + lane; const bool act = i < n;
                    const unsigned ki = act ? ckey[qs * CB + i] : 0u, ii = act ? cidx[qs * CB + i] : 0u; const unsigned d8 = (ki >> sh8) & m8;
                    if (act && d8 > b2) atomicOr(&row[ii >> 5], 1u << (ii & 31u));
                    unsigned long long tie = __ballot(act && d8 == b2);
                    while (tie) {
                        const int ml = __ffsll((long long)tie) - 1; tie &= tie - 1ull;
                        const unsigned km = __shfl(ki, ml), im = __shfl(ii, ml);
                        unsigned rank = 0u;
                        for (int j0 = 0; j0 < n; j0 += 64) { const int j = j0 + lane; bool beats = false;
                            if (j < n) { const unsigned kj = ckey[qs * CB + j], ij = cidx[qs * CB + j]; beats = ((kj >> sh8) & m8) == b2 && (kj > km || (kj == km && ij < im)); }
                            rank += (unsigned)__popcll(__ballot(beats)); }
                        if (rank < need2 && lane == ml) atomicOr(&row[im >> 5], 1u << (im & 31u));
                    }
                }
            }
        }
    }
    asm volatile("s_waitcnt lgkmcnt(0)" ::: "memory");
    __syncthreads();
    for (int qi = 0; qi < 2; ++qi) { const int qs = 2 * wave + qi;
        attn_query(q0 + qs, Qb, KV8, rows + qs * SW, AO, lds + IL_QF + wave * 512, lane); }
}

__global__ void __launch_bounds__(NTHREADS, 2) fwd(Args a) {
    extern __shared__ __attribute__((aligned(16))) unsigned char lds_raw[];
    float* smf = (float*)lds_raw;
    PG8_LAS unsigned char* ldsp = (PG8_LAS unsigned char*)lds_raw;
    const int nwaves = gridDim.x * 8;
#define PHASE_VARS const int tid = otid(); const int lane = tid & 63, wave = tid >> 6; const int gwave = blockIdx.x * 8 + wave; (void)lane; (void)wave; (void)gwave;
    unsigned char* ws = a.ws;
    unsigned* ctl = (unsigned*)(ws + WS_CTL);
    const int lo = a.ph_lo, hi = a.ph_hi;

    volatile LAS unsigned* bst = (volatile LAS unsigned*)((LAS unsigned char*)lds_raw + (LDS_BYTES - 16));
    if (threadIdx.x == 0) { bst[0] = 0u; bst[1] = 0u; bst[2] = 0u; bst[3] = 0u; }
    __syncthreads();
    XcdBarrier bar; bar.bar = ctl; bar.x = 0; bar.st = bst;
    if (hi - lo > 1) bar = xcd_barrier_post(ctl, bst);
#define IN(k) (lo <= (k) && (k) < hi)
#define SEAM(k) do { if (IN(k) && IN((k) + 1)) xcd_barrier(bar); } while (0)

    const float* x = a.in[0]; const float* meta = a.in[1];
    float* ropeC = (float*)(ws + WS_ROPEC); float* ropeS = (float*)(ws + WS_ROPES);
    int* eid = (int*)(ws + WS_EID); float* gw = (float*)(ws + WS_GW); int* slot = (int*)(ws + WS_SLOT); int* mtiles = (int*)(ws + WS_MTILES);
    unsigned* counts0 = (unsigned*)(ws + CTL_CNT); unsigned* counts1 = counts0 + 32;
    unsigned* cursor0 = (unsigned*)(ws + CTL_CUR); unsigned* cursor1 = cursor0 + 32;
    bf16_t* Wta = (bf16_t*)(ws + WS_WTA); bf16_t* Wtx = (bf16_t*)(ws + WS_WTX);
    float* Aend = (float*)(ws + WS_AEND); float* Hend = (float*)(ws + WS_HEND); float* CIN = (float*)(ws + WS_CIN);
    unsigned char* big = ws + WS_BIG;
    bf16_t* WIN0 = (bf16_t*)(big + R_WIN0); bf16_t* WOUT0 = (bf16_t*)(big + R_WOUT0); bf16_t* WGU = (bf16_t*)(big + R_WGU); bf16_t* WD = (bf16_t*)(big + R_WD);
    bf16_t* WIN1 = (bf16_t*)(big + R_WIN1); bf16_t* WOUT1 = (bf16_t*)(big + R_WOUT1);
    bf16_t* X0b = (bf16_t*)(big + R_A); bf16_t* AO = (bf16_t*)(big + R_A); bf16_t* Xperm = (bf16_t*)(big + R_A); bf16_t* X2b = (bf16_t*)(big + R_A); bf16_t* YY = (bf16_t*)(big + R_A);
    float* H1 = (float*)(big + R_H1); float* H3 = (float*)(big + R_H1); float* H2 = (float*)(big + R_H2); unsigned* SELM = (unsigned*)(big + R_H1); unsigned* SELM2 = (unsigned*)(big + R_H1 + 36 * MiB);
    float* Z = (float*)(big + R_C); bf16_t* Yb = (bf16_t*)(big + R_C); float* Z1 = (float*)(big + R_C);
    unsigned char* KV8 = big + R_K;
    bf16_t* GLU = (bf16_t*)(big + R_GLU); bf16_t* Qb = (bf16_t*)(big + R_Q); bf16_t* Kb = (bf16_t*)(big + R_K); bf16_t* Vb = (bf16_t*)(big + R_V);
    bf16_t* QIb = (bf16_t*)(big + R_QI); bf16_t* KIb = (bf16_t*)(big + R_KI); float* WIf = (float*)(big + R_WI);
    bf16_t* GATEg = (bf16_t*)(big + R_GATE); bf16_t* XRb = (bf16_t*)(big + R_XR);
    bf16_t* Hm = (bf16_t*)(big + R_HM);

    if (IN(0)) { PHASE_VARS;
        const float* w_in = a.in[2]; const float* w_out = a.in[7]; const float* wg = a.in[21]; const float* wu = a.in[22]; const float* wd = a.in[23];
        constexpr int J_IN0 = 52 * 16, J_OUT0 = 16 * 16, J_GU = 32 * 256, J_D = 32 * 128, J_IN1 = 40 * 16, J_OUT1 = 16 * 20, J_GT = 80;
        const float* w_in1 = a.in[8]; const float* w_out1 = a.in[16]; const float* wga = a.in[11]; const float* wgx = a.in[13];
        tr_run(J_IN0 + J_OUT0 + J_GU + J_D + J_IN1 + J_OUT1 + J_GT, [&](int j) -> TrJob {
            TrJob J{};
            if (j < J_IN0) { J.dst = WIN0; J.s0 = w_in; J.K = 1024; J.n0 = (j >> 4) * 64; J.k0 = (j & 15) * 64; J.mode = 1; return J; }
            j -= J_IN0;
            if (j < J_OUT0) { J.dst = WOUT0; J.s0 = w_out; J.ld = D; J.K = 1024; J.n0 = (j >> 4) * 64; J.k0 = (j & 15) * 64; J.mode = 0; return J; }
            j -= J_OUT0;
            if (j < J_GU) { const int e = j >> 8, t = j & 255; J.dst = WGU + (size_t)e * 1024 * 1024; J.s0 = wg + (size_t)e * D * DE; J.s1 = wu + (size_t)e * D * DE; J.K = 1024; J.n0 = (t >> 4) * 64; J.k0 = (t & 15) * 64; J.mode = 2; return J; }
            j -= J_GU;
            if (j < J_D) { const int e = j >> 7, t = j & 127; J.dst = WD + (size_t)e * 1024 * 512; J.s0 = wd + (size_t)e * DE * D; J.ld = D; J.K = 512; J.n0 = (t >> 3) * 64; J.k0 = (t & 7) * 64; J.mode = 0; return J; }
            j -= J_D;
            if (j < J_IN1) { J.dst = WIN1; J.s0 = w_in1; J.ld = 2 * RNN_W; J.K = 1024; J.n0 = (j >> 4) * 64; J.k0 = (j & 15) * 64; J.mode = 0; return J; }
            j -= J_IN1;
            if (j < J_OUT1) { J.dst = WOUT1; J.s0 = w_out1; J.ld = D; J.K = RNN_W; J.n0 = (j / 20) * 64; J.k0 = (j % 20) * 64; J.mode = 0; return J; }
            j -= J_OUT1;
            { const int which = j / 40, r = j % 40; const int nb = r >> 2;
              J.dst = (which ? Wtx : Wta) + (size_t)nb * 128 * 128; J.s0 = (which ? wgx : wga) + (size_t)nb * 128 * 128; J.ld = 128; J.K = 128; J.n0 = ((r >> 1) & 1) * 64; J.k0 = (r & 1) * 64; J.mode = 0; return J; }
        }, smf);
        for (size_t i = (size_t)blockIdx.x * NTHREADS + tid; i < (size_t)LP * 256; i += (size_t)gridDim.x * NTHREADS) {
            const size_t r = i >> 8, c4 = i & 255;
            float4 v = make_float4(0.f, 0.f, 0.f, 0.f);
            if (r < NMETA) v = ((const float4*)meta)[r * 256 + c4]; else if (r < L) v = ((const float4*)x)[(r - NMETA) * 256 + c4];
            ((uint2*)X0b)[i] = make_uint2(cvt_pk_bf16(v.x, v.y), cvt_pk_bf16(v.z, v.w));
        }
        for (int i = blockIdx.x * NTHREADS + tid; i < 2 * 64 * 3 * 64; i += gridDim.x * NTHREADS) {
            const int ln = i & 63, ct = (i >> 6) % 3, ss = (i / 192) & 63, ly = i / (192 * 64);
            const int col = 16 * ct + (ln & 15), k0 = 16 * ss + 4 * (ln >> 4);
            float v[4];
#pragma unroll
            for (int j = 0; j < 4; ++j) v[j] = col < 4 ? a.in[17][(size_t)ly * D * NGRP + (size_t)(k0 + j) * NGRP + col] : col < 36 ? a.in[19][(size_t)ly * D * NE + (size_t)(k0 + j) * NE + (col - 4)] : 0.f;
            ((float4*)(ws + WS_WR))[i] = make_float4(v[0], v[1], v[2], v[3]);
        }
        for (int i = blockIdx.x * NTHREADS + tid; i < LP * 32; i += gridDim.x * NTHREADS) {
            const int p = i >> 5, f = i & 31;
            const float inv = (float)pow(10000.0, -(double)f / 32.0);
            const float ang = (float)p * inv;
            ropeC[i] = (float)cos((double)ang); ropeS[i] = (float)sin((double)ang);
        }
    }
    SEAM(0);
    if (IN(1)) { PHASE_VARS;
        pg8::Gemm g{X0b, WIN0, LP, 3328, 1024}; pg8::StaticOrder S; S.init(LP, 3328, (int)gridDim.x, (int)blockIdx.x);
        EpiIn0 E{GLU, KIb, WIf, ropeC, ropeS, KV8};
        pg8::gemm_phase<EpiIn0, pg8::StaticOrder, GEMM_ALIGN, GEMM_SP2>(ldsp, g, S, E);
    }
    SEAM(1);
    if (IN(2)) { PHASE_VARS;
        const float* cw = a.in[3]; const float* cb = a.in[4]; const float* lg = a.in[5]; const float* lb = a.in[6];
        for (int g4 = gwave; g4 < L / 4; g4 += nwaves) {
            const int t0 = g4 * 4, c0 = lane * 8;
            float acc[4][8], wwin[4][8];
            { const float4 b0 = *(const float4*)(cb + c0), b1 = *(const float4*)(cb + c0 + 4);
#pragma unroll
              for (int q = 0; q < 4; ++q) { acc[q][0] = b0.x; acc[q][1] = b0.y; acc[q][2] = b0.z; acc[q][3] = b0.w; acc[q][4] = b1.x; acc[q][5] = b1.y; acc[q][6] = b1.z; acc[q][7] = b1.w; } }
#pragma unroll
            for (int r = 0; r < CONV_K + 3; ++r) {
                const int tt = t0 - (CONV_K - 1) + r;
                if (r < CONV_K) { const float4 w0 = *(const float4*)(cw + r * CONV_CH + c0), w1 = *(const float4*)(cw + r * CONV_CH + c0 + 4);
                    wwin[r & 3][0] = w0.x; wwin[r & 3][1] = w0.y; wwin[r & 3][2] = w0.z; wwin[r & 3][3] = w0.w; wwin[r & 3][4] = w1.x; wwin[r & 3][5] = w1.y; wwin[r & 3][6] = w1.z; wwin[r & 3][7] = w1.w; }
                if (tt >= 0) {
                    const uint4 xv = *(const uint4*)(GLU + (size_t)tt * 512 + c0);
                    const float x[8] = {bflo(xv.x), bfhi(xv.x), bflo(xv.y), bfhi(xv.y), bflo(xv.z), bfhi(xv.z), bflo(xv.w), bfhi(xv.w)};
#pragma unroll
                    for (int q = 0; q < 4; ++q) { const int j = r - q;
                        if (j >= 0 && j < CONV_K) {
#pragma unroll
                            for (int i = 0; i < 8; ++i) acc[q][i] += wwin[j & 3][i] * x[i]; } }
                }
            }
            float gv[8], bvv[8];
            { const float4 g0 = *(const float4*)(lg + c0), g1 = *(const float4*)(lg + c0 + 4), b0 = *(const float4*)(lb + c0), b1 = *(const float4*)(lb + c0 + 4);
              gv[0] = g0.x; gv[1] = g0.y; gv[2] = g0.z; gv[3] = g0.w; gv[4] = g1.x; gv[5] = g1.y; gv[6] = g1.z; gv[7] = g1.w; bvv[0] = b0.x; bvv[1] = b0.y; bvv[2] = b0.z; bvv[3] = b0.w; bvv[4] = b1.x; bvv[5] = b1.y; bvv[6] = b1.z; bvv[7] = b1.w; }
#pragma unroll
            for (int q = 0; q < 4; ++q) {
                float s_ = 0.f;
#pragma unroll
                for (int i = 0; i < 8; ++i) s_ += acc[q][i];
                const float mu = wave_sum(s_) * (1.0f / 512.0f);
                float qq = 0.f;
#pragma unroll
                for (int i = 0; i < 8; ++i) { const float d = acc[q][i] - mu; qq += d * d; }
                const float rstd = 1.0f / sqrtf(wave_sum(qq) * (1.0f / 512.0f) + LN_EPS);
                float o[8];
#pragma unroll
                for (int i = 0; i < 8; ++i) { const float yv = (acc[q][i] - mu) * rstd * gv[i] + bvv[i]; o[i] = yv * fsigm(yv); }
                uint4 w; w.x = cvt_pk_bf16(o[0], o[1]); w.y = cvt_pk_bf16(o[2], o[3]); w.z = cvt_pk_bf16(o[4], o[5]); w.w = cvt_pk_bf16(o[6], o[7]);
                *(uint4*)(AO + (size_t)(t0 + q) * 1024 + c0) = w;
            }
        }
        { const int b = (int)blockIdx.x, G = (int)gridDim.x; const int p = b & 3; const bool rev = (b >> 2) & 1;
          const int nfull = NTILE / G;
          for (int k = 0; k < nfull; ++k) {
              const int r = (nfull == 4) ? ((rev ? p - k : p + k) & 3) : k;
              const int idx = r * G + ((r & 1) ? G - 1 - b : b);
              indexer_tile((NTILE - 1 - idx) * 16, QIb, KIb, WIf, Qb, KV8, AO, lds_raw);
          }
          for (int idx = nfull * G + b; idx < NTILE; idx += G) indexer_tile((NTILE - 1 - idx) * 16, QIb, KIb, WIf, Qb, KV8, AO, lds_raw);
        }
    }
    SEAM(2);
    SEAM(3);
    if (IN(4)) { PHASE_VARS;
        pg8::Gemm g{AO, WOUT0, LP, 1024, 1024}; pg8::StaticOrder S; S.init(LP, 1024, (int)gridDim.x, (int)blockIdx.x);
        EpiRes0 E{x, meta, Z};
        pg8::gemm_phase<EpiRes0, pg8::StaticOrder, GEMM_ALIGN, GEMM_SP2>(ldsp, g, S, E);
    }
    SEAM(4);
    if (IN(5)) {
        for (int blk = blockIdx.x; blk < SEQ / 64; blk += gridDim.x)
            ln_route_block(NMETA + 64 * blk, 64, Z, H1, a.in[24], a.in[25], (const float4*)(ws + WS_WR), a.in[18], a.in[20], eid, gw, counts0, smf);
        if (blockIdx.x == gridDim.x - 1)
            ln_route_block(0, NMETA, Z, H1, a.in[24], a.in[25], (const float4*)(ws + WS_WR), a.in[18], a.in[20], eid, gw, counts0, smf);
    }
    SEAM(5);
    if (IN(6)) { PHASE_VARS; moe_dispatch_mfma(H1, eid, counts0, cursor0, slot, mtiles, Xperm, (int*)lds_raw, gwave, nwaves, lane, 0); }
    SEAM(6);
    if (IN(7)) { PHASE_VARS;
        pg8::Gemm g{Xperm, WGU, MAXSLOT, 1024, 1024}; MoeOrder S; S.init(mtiles, (int)gridDim.x, (int)blockIdx.x);
        EpiGateUp E{Hm};
        pg8::gemm_phase<EpiGateUp, MoeOrder, GEMM_ALIGN, GEMM_SP2>(ldsp, g, S, E);
    }
    SEAM(7);
    if (IN(8)) { PHASE_VARS;
        pg8::Gemm g{Hm, WD, MAXSLOT, 1024, 512}; MoeOrder S; S.init(mtiles, (int)gridDim.x, (int)blockIdx.x);
        EpiDown E{Yb};
        pg8::gemm_phase<EpiDown, MoeOrder, GEMM_ALIGN, GEMM_SP2>(ldsp, g, S, E);
    }
    SEAM(8);
    if (IN(9)) { PHASE_VARS;
#pragma unroll 2
        for (int t = gwave; t < L; t += nwaves) {
            const int s0 = slot[2 * t], s1 = slot[2 * t + 1]; const float g0 = gw[2 * t], g1 = gw[2 * t + 1];
            float y[16];
            combine_row(y, H1 + (size_t)t * D, Yb + (size_t)s0 * D, Yb + (size_t)s1 * D, g0, g1, lane);
            ln_row1024v(y, a.in[26], a.in[27], lane);
#pragma unroll
            for (int i4 = 0; i4 < 4; ++i4) *(float4*)(H2 + (size_t)t * D + 16 * lane + 4 * i4) = make_float4(y[4 * i4], y[4 * i4 + 1], y[4 * i4 + 2], y[4 * i4 + 3]);
            uint4 p0, p1; p0.x = cvt_pk_bf16(y[0], y[1]); p0.y = cvt_pk_bf16(y[2], y[3]); p0.z = cvt_pk_bf16(y[4], y[5]); p0.w = cvt_pk_bf16(y[6], y[7]);
            p1.x = cvt_pk_bf16(y[8], y[9]); p1.y = cvt_pk_bf16(y[10], y[11]); p1.z = cvt_pk_bf16(y[12], y[13]); p1.w = cvt_pk_bf16(y[14], y[15]);
            *(uint4*)(X2b + (size_t)t * D + 16 * lane) = p0; *(uint4*)(X2b + (size_t)t * D + 16 * lane + 8) = p1;
        }
        for (int i = blockIdx.x * NTHREADS + tid; i < (LP - L) * D / 8; i += gridDim.x * NTHREADS) ((uint4*)(X2b + (size_t)L * D))[i] = make_uint4(0u, 0u, 0u, 0u);
    }
    SEAM(9);
    if (IN(10)) {
        pg8::Gemm g{X2b, WIN1, LP, 2 * RNN_W, 1024}; pg8::StaticOrder S; S.init(LP, 2 * RNN_W, (int)gridDim.x, (int)blockIdx.x);
        EpiIn1 E{GATEg};
        pg8::gemm_phase<EpiIn1, pg8::StaticOrder, GEMM_ALIGN, GEMM_SP2>(ldsp, g, S, E);
    }
    SEAM(10);
    if (IN(11)) rglru_phase<false>(XRb, GATEg, Wta, Wtx, a.in[9], a.in[10], a.in[12], a.in[14], a.in[15], Aend, Hend, CIN, YY, lds_raw);
    SEAM(11);
    if (IN(12)) { PHASE_VARS;
        for (int ch = gwave; ch < RNN_W; ch += nwaves) {
            float A[5], H[5];
#pragma unroll
            for (int i = 0; i < 5; ++i) { const int c = 5 * lane + i; const bool ok = c < NCHUNK; A[i] = ok ? Aend[(size_t)ch * CP + c] : 1.f; H[i] = ok ? Hend[(size_t)ch * CP + c] : 0.f; }
            float Al = 1.f, Hl = 0.f;
#pragma unroll
            for (int i = 0; i < 5; ++i) { Hl = A[i] * Hl + H[i]; Al *= A[i]; }
#pragma unroll
            for (int off = 1; off < 64; off <<= 1) { const float Ap = __shfl_up(Al, off), Hp = __shfl_up(Hl, off); if (lane >= off) { Hl = Al * Hp + Hl; Al = Al * Ap; } }
            float cin = __shfl_up(Hl, 1); if (lane == 0) cin = 0.f;
#pragma unroll
            for (int i = 0; i < 5; ++i) { const int c = 5 * lane + i; if (c < NCHUNK) { CIN[(size_t)ch * CP + c] = cin; cin = A[i] * cin + H[i]; } }
        }
    }
    SEAM(12);
    if (IN(13)) rglru_phase<true>(XRb, GATEg, Wta, Wtx, a.in[9], a.in[10], a.in[12], a.in[14], a.in[15], Aend, Hend, CIN, YY, lds_raw);
    SEAM(13);
    if (IN(14)) {
        pg8::Gemm g{YY + (size_t)NMETA * RNN_W, WOUT1, SEQ, 1024, RNN_W}; pg8::StaticOrder S; S.init(SEQ, 1024, (int)gridDim.x, (int)blockIdx.x);
        EpiRes1 E{H2 + (size_t)NMETA * D, Z1 + (size_t)NMETA * D};
        pg8::gemm_phase<EpiRes1, pg8::StaticOrder, GEMM_ALIGN, GEMM_SP2>(ldsp, g, S, E);
    }
    SEAM(14);
    if (IN(15)) { PHASE_VARS;
        const float* wg = a.in[21] + (size_t)NE * D * DE; const float* wu = a.in[22] + (size_t)NE * D * DE; const float* wd = a.in[23] + (size_t)NE * DE * D;
        constexpr int J_GU = 32 * 256, J_D = 32 * 128;
        tr_run(J_GU + J_D, [&](int j) -> TrJob {
            TrJob J{};
            if (j < J_GU) { const int e = j >> 8, t = j & 255; J.dst = WGU + (size_t)e * 1024 * 1024; J.s0 = wg + (size_t)e * D * DE; J.s1 = wu + (size_t)e * D * DE; J.K = 1024; J.n0 = (t >> 4) * 64; J.k0 = (t & 15) * 64; J.mode = 2; return J; }
            j -= J_GU;
            { const int e = j >> 7, t = j & 127; J.dst = WD + (size_t)e * 1024 * 512; J.s0 = wd + (size_t)e * DE * D; J.ld = D; J.K = 512; J.n0 = (t >> 3) * 64; J.k0 = (t & 7) * 64; J.mode = 0; return J; }
        }, smf);
        __syncthreads();
        for (int tb = NMETA + blockIdx.x * 64; tb < L; tb += gridDim.x * 64)
            ln_route_block(tb, (L - tb) < 64 ? (L - tb) : 64, Z1, H3, a.in[24] + D, a.in[25] + D, (const float4*)(ws + WS_WR) + 64 * 3 * 64, a.in[18] + NGRP, a.in[20] + NE, eid, gw, counts1, smf);
    }
    SEAM(15);
    if (IN(16)) { PHASE_VARS; moe_dispatch_mfma(H3, eid, counts1, cursor1, slot, mtiles, Xperm, (int*)lds_raw, gwave, nwaves, lane, 2 * NMETA); }
    SEAM(16);
    if (IN(17)) {
        pg8::Gemm g{Xperm, WGU, MAXSLOT, 1024, 1024}; MoeOrder S; S.init(mtiles, (int)gridDim.x, (int)blockIdx.x);
        EpiGateUp E{Hm};
        pg8::gemm_phase<EpiGateUp, MoeOrder, GEMM_ALIGN, GEMM_SP2>(ldsp, g, S, E);
    }
    SEAM(17);
    if (IN(18)) {
        pg8::Gemm g{Hm, WD, MAXSLOT, 1024, 512}; MoeOrder S; S.init(mtiles, (int)gridDim.x, (int)blockIdx.x);
        EpiDown E{Yb};
        pg8::gemm_phase<EpiDown, MoeOrder, GEMM_ALIGN, GEMM_SP2>(ldsp, g, S, E);
    }
    SEAM(18);
    if (IN(19)) { PHASE_VARS;
#pragma unroll 2
        for (int t = NMETA + gwave; t < L; t += nwaves) {
            const int s0 = slot[2 * t], s1 = slot[2 * t + 1]; const float g0 = gw[2 * t], g1 = gw[2 * t + 1];
            float y[16];
            combine_row(y, H3 + (size_t)t * D, Yb + (size_t)s0 * D, Yb + (size_t)s1 * D, g0, g1, lane);
            ln_row1024v(y, a.in[26] + D, a.in[27] + D, lane);
#pragma unroll
            for (int i4 = 0; i4 < 4; ++i4) *(float4*)(a.out + (size_t)(t - NMETA) * D + 16 * lane + 4 * i4) = make_float4(y[4 * i4], y[4 * i4 + 1], y[4 * i4 + 2], y[4 * i4 + 3]);
        }
    }
#undef IN
#undef SEAM
}
constexpr int N_PHASES = 20;

extern "C" void kernel_launch(void* const* d_in, const int* in_sizes, int n_in, void* d_out, int out_size, void* d_ws, size_t ws_size, hipStream_t stream) {
    static int grid = 0;
    if (grid == 0) {
        if (n_in != 28 || out_size != SEQ * D || ws_size < WS_END) { fprintf(stderr, "kernel_launch: unexpected shapes n_in %d out %d ws %zu (need %zu)\n", n_in, out_size, ws_size, (size_t)WS_END); grid = -1; return; }
        int dev = 0, cus = 0;
        if (hipGetDevice(&dev) != hipSuccess || hipDeviceGetAttribute(&cus, hipDeviceAttributeMultiprocessorCount, dev) != hipSuccess) { grid = -1; return; }
        if (hipFuncSetAttribute((const void*)fwd, hipFuncAttributeMaxDynamicSharedMemorySize, LDS_BYTES) != hipSuccess) { fprintf(stderr, "kernel_launch: hipFuncSetAttribute failed\n"); grid = -1; return; }
        int per_cu = 0;
        if (hipOccupancyMaxActiveBlocksPerMultiprocessor(&per_cu, (const void*)fwd, NTHREADS, LDS_BYTES) != hipSuccess || per_cu < 1) fprintf(stderr, "kernel_launch: occupancy query says %d\n", per_cu);
        (void)hipGetLastError();
        grid = cus;
    }
    if (grid < 0) return;
    (void)hipMemsetAsync((char*)d_ws + WS_CTL, 0, CTL_BYTES, stream);
    Args a{};
    for (int i = 0; i < 28; ++i) a.in[i] = (const float*)d_in[i];
    a.out = (float*)d_out; a.ws = (unsigned char*)d_ws;
#if N_LAUNCH_MODE == 1
    a.ph_lo = 0; a.ph_hi = N_PHASES;
    hipLaunchKernelGGL(fwd, dim3(grid), dim3(NTHREADS), LDS_BYTES, stream, a);
#else
    for (int p = 0; p < N_PHASES; ++p) { a.ph_lo = p; a.ph_hi = p + 1; hipLaunchKernelGGL(fwd, dim3(grid), dim3(NTHREADS), LDS_BYTES, stream, a); }
#endif
}
```

```cpp
#include <hip/hip_runtime.h>
#include <cstdio>
#include <cstdint>
#include <cmath>

#ifndef GEMM_ALIGN
#define GEMM_ALIGN true
#endif
#ifndef GEMM_SP2
#define GEMM_SP2 true
#endif
#ifndef N_LAUNCH_MODE
#define N_LAUNCH_MODE 1
#endif

#define DEVI __device__ __forceinline__
#define LAS __attribute__((address_space(3)))

constexpr int D = 1024, SEQ = 16384, NMETA = 16, L = SEQ + NMETA;
constexpr int CONV_CH = 512, CONV_K = 31, HD = 64, TOPK = 256;
constexpr int IN_AB = 3144;
constexpr int OFF_AVAL = 0, OFF_AGATE = 512, OFF_Q = 1024, OFF_K = 1536, OFF_V = 2048, OFF_QI = 2560, OFF_KI = 3072, OFF_WI = 3136;
constexpr int RNN_W = 1280, RNN_NB = 10, RNN_BW = 128, RNN_K = 4;
constexpr int NGRP = 4, EPG = 8, NE = 32, DE = 512;
constexpr int NPAIR = 2 * L;
constexpr float LN_EPS = 1e-5f;
constexpr float DN_ALPHA = 1.41421356237f;
constexpr int NTHREADS = 512;
constexpr int LDS_BYTES = 147456;

#define XB_TMO      128
#define XB_XCNT(j)  (256  + 64 * (j))
#define XB_XSUB(j)  (1280 + 64 * (j))
#define XB_XGEN(j)  (2304 + 64 * (j))
#define XB_TOP      3328
#define XB_TOPGEN   3392
#define XCD_BAR_WORDS 3456
#define XB_SPIN_CAP (1u << 22)
DEVI unsigned xb_ld(unsigned* p)              { return __hip_atomic_load(p, __ATOMIC_RELAXED, __HIP_MEMORY_SCOPE_AGENT); }
DEVI unsigned xb_add(unsigned* p, unsigned v) { return __hip_atomic_fetch_add(p, v, __ATOMIC_RELAXED, __HIP_MEMORY_SCOPE_AGENT); }
DEVI unsigned xb_xcc_id() { return (unsigned)__builtin_amdgcn_s_getreg((3 << 11) | 20) & 0xFu; }
#define XB_SPIN(cond, bar) do { unsigned _sp = 0; while (cond) { __builtin_amdgcn_s_sleep(1); \
    if ((++_sp & 255u) == 0u) { if (xb_ld(&(bar)[XB_TMO])) break; if (_sp > XB_SPIN_CAP) { atomicAdd(&(bar)[XB_TMO], 1u); break; } } } } while (0)
struct XcdBarrier { unsigned* bar; unsigned x; volatile LAS unsigned* st; };
DEVI XcdBarrier xcd_barrier_post(unsigned* bar, volatile LAS unsigned* st) {
    XcdBarrier b; b.bar = bar; b.x = xb_xcc_id(); b.st = st;
    if (threadIdx.x == 0) (void)xb_add(&bar[XB_XCNT(b.x)], 1u);
    return b;
}
DEVI void xcd_barrier_complete(unsigned* bar, unsigned x, unsigned& nloc, unsigned& nx) {
    const unsigned G = gridDim.x * gridDim.y * gridDim.z;
    unsigned sum, cnt, mine, sp = 0u;
    for (;;) {
        sum = 0u; cnt = 0u; mine = 0u;
#pragma unroll
        for (unsigned j = 0; j < 16; ++j) { const unsigned c = xb_ld(&bar[XB_XCNT(j)]); sum += c; cnt += (c > 0u) ? 1u : 0u; mine = (j == x) ? c : mine; }
        if (sum == G) break;
        __builtin_amdgcn_s_sleep(1);
        if ((++sp & 255u) == 0u) { if (xb_ld(&bar[XB_TMO])) break; if (sp > XB_SPIN_CAP) { atomicAdd(&bar[XB_TMO], 1u); break; } }
    }
    nloc = mine > 0u ? mine : 1u; nx = cnt > 0u ? cnt : 1u;
}
DEVI void xcd_barrier(const XcdBarrier& b) {
    asm volatile("s_waitcnt vmcnt(0)" ::: "memory");
    __syncthreads();
    if (threadIdx.x == 0) {
        unsigned* bar = b.bar;
        __builtin_amdgcn_s_waitcnt(0);
        unsigned nloc = b.st[0], nx = b.st[1];
        if (nloc == 0u) { xcd_barrier_complete(bar, b.x, nloc, nx); b.st[0] = nloc; b.st[1] = nx; }
        const unsigned old = xb_add(&bar[XB_XSUB(b.x)], 1u);
        const unsigned gen = old / nloc;
        if (old + 1u == (gen + 1u) * nloc) {
            __builtin_amdgcn_fence(__ATOMIC_RELEASE, "agent");
            asm volatile("s_waitcnt vmcnt(0)" ::: "memory");
            const unsigned og = xb_add(&bar[XB_TOP], 1u);
            const unsigned tg = og / nx;
            if (og + 1u == (tg + 1u) * nx) xb_add(&bar[XB_TOPGEN], 1u);
            else XB_SPIN(xb_ld(&bar[XB_TOPGEN]) == tg, bar);
            __builtin_amdgcn_fence(__ATOMIC_ACQUIRE, "agent");
            xb_add(&bar[XB_XGEN(b.x)], 1u);
            asm volatile("s_waitcnt vmcnt(0)" ::: "memory");
        } else {
            XB_SPIN(xb_ld(&bar[XB_XGEN(b.x)]) == gen, bar);
            __builtin_amdgcn_fence(__ATOMIC_ACQUIRE, "agent");
            asm volatile("s_waitcnt vmcnt(0)" ::: "memory");
        }
    }
    __syncthreads();
}

constexpr int LP = 16640;
constexpr int MAXSLOT = 40960;
constexpr int NCHUNK = 257, CP = 272;
constexpr size_t MiB = 1048576;
constexpr size_t WS_CTL = 0;
constexpr size_t CTL_CNT = 16384;
constexpr size_t CTL_CUR = 16384 + 256;
constexpr size_t CTL_BYTES = 32768;
constexpr size_t WS_ROPEC = 32768;
constexpr size_t WS_ROPES = WS_ROPEC + (size_t)LP * 32 * 4;
constexpr size_t WS_EID = WS_ROPES + (size_t)LP * 32 * 4;
constexpr size_t WS_GW = WS_EID + (size_t)NPAIR * 4;
constexpr size_t WS_SLOT = WS_GW + (size_t)NPAIR * 4;
constexpr size_t WS_MTILES = WS_SLOT + (size_t)NPAIR * 4;
constexpr size_t WS_WTA = WS_MTILES + 4096;
constexpr size_t WS_WTX = WS_WTA + (size_t)RNN_NB * 128 * 128 * 2;
constexpr size_t WS_AEND = WS_WTX + (size_t)RNN_NB * 128 * 128 * 2;
constexpr size_t WS_HEND = WS_AEND + (size_t)RNN_W * CP * 4;
constexpr size_t WS_CIN = WS_HEND + (size_t)RNN_W * CP * 4;
constexpr size_t WS_WR = WS_CIN + (size_t)RNN_W * CP * 4;
constexpr size_t WS_BIG = ((WS_WR + (size_t)2 * 64 * 3 * 64 * 16 + 255) / 256) * 256;
constexpr size_t R_WIN0 = 0;
constexpr size_t R_WOUT0 = R_WIN0 + (size_t)3328 * 1024 * 2;
constexpr size_t R_WGU = R_WOUT0 + (size_t)1024 * 1024 * 2;
constexpr size_t R_WD = R_WGU + (size_t)32 * 1024 * 1024 * 2;
constexpr size_t R_WIN1 = R_WD + (size_t)32 * 1024 * 512 * 2;
constexpr size_t R_WOUT1 = R_WIN1 + (size_t)2560 * 1024 * 2;
static_assert(R_WOUT1 + (size_t)1024 * 1280 * 2 <= 112 * MiB, "weights");
constexpr size_t R_A = 112 * MiB;
constexpr size_t R_H1 = 192 * MiB;
constexpr size_t R_H2 = 257 * MiB;
constexpr size_t R_C = 322 * MiB;
constexpr size_t R_GLU = 322 * MiB;
constexpr size_t SZ512 = (size_t)LP * 512 * 2;
constexpr size_t R_Q = R_GLU + SZ512, R_K = R_Q + SZ512, R_V = R_K + SZ512, R_QI = R_V + SZ512, R_KI = R_QI + SZ512, R_WI = R_KI + (size_t)LP * 64 * 2;
static_assert(R_WI + (size_t)LP * 8 * 4 <= 406 * MiB, "in-proj outputs");
constexpr size_t R_GATE = 322 * MiB;
constexpr size_t R_XR = R_GATE + (size_t)LP * 1280 * 2;
static_assert(R_XR + (size_t)LP * 1280 * 2 <= 406 * MiB, "layer-1 in-proj outputs");
constexpr size_t R_HM = 406 * MiB;
constexpr size_t WS_END = WS_BIG + R_HM + (size_t)MAXSLOT * 512 * 2;
static_assert(WS_END <= 512 * MiB, "ws");

struct Args { const float* in[28]; float* out; unsigned char* ws; int ph_lo, ph_hi; };

DEVI int otid() { int v = (int)threadIdx.x; asm volatile("" : "+v"(v)); return v; }
template <int CTRL> DEVI float dpp_f(float v) { return __int_as_float(__builtin_amdgcn_mov_dpp(__float_as_int(v), CTRL, 0xF, 0xF, true)); }
DEVI float wave_sum(float v) {
    v += dpp_f<0xB1>(v); v += dpp_f<0x4E>(v); v += dpp_f<0x141>(v); v += dpp_f<0x140>(v);
    return __int_as_float(__builtin_amdgcn_readlane(__float_as_int(v), 0)) + __int_as_float(__builtin_amdgcn_readlane(__float_as_int(v), 16))
         + __int_as_float(__builtin_amdgcn_readlane(__float_as_int(v), 32)) + __int_as_float(__builtin_amdgcn_readlane(__float_as_int(v), 48));
}
DEVI float wave_max(float v) {
#pragma unroll
    for (int o = 32; o > 0; o >>= 1) v = fmaxf(v, __shfl_xor(v, o));
    return v;
}
DEVI float sigm(float x) { return 1.0f / (1.0f + expf(-x)); }
DEVI float gelu_tanh(float x) { return 0.5f * x * (1.0f + tanhf(0.7978845608028654f * (x + 0.044715f * x * x * x))); }
DEVI unsigned f2key(float f) { unsigned u = __float_as_uint(f); return (u & 0x80000000u) ? ~u : (u | 0x80000000u); }

namespace pg8 {
#define PG8_LAS __attribute__((address_space(3)))
typedef unsigned short bf16_t;
typedef short bf16x8 __attribute__((ext_vector_type(8)));
typedef float f32x4 __attribute__((ext_vector_type(4)));
typedef unsigned u32x4 __attribute__((ext_vector_type(4)));
constexpr int BM = 256, BK = 64, HALF = 128, HTB = HALF * BK * 2  , STAGE_BYTES = 8 * HTB, NXCD = 8, WGM = 8;

__host__ __device__ __forceinline__ int lds_byte(int r, int c) { const int st = (r >> 4) * 2 + (c >> 5), rr = r & 15, cc = c & 31, ob = rr * 64 + cc * 2; return st * 1024 + (ob ^ (((ob >> 9) & 1) << 5)); }
__host__ __device__ __forceinline__ void stage_rc(int b, int& R, int& C) { const int st = b / 1024, sb = b % 1024, swz = sb ^ (((sb >> 9) & 1) << 5); R = (st >> 1) * 16 + swz / 64; C = (st & 1) * 32 + (swz % 64) / 2; }
__host__ __device__ __forceinline__ int perm32(int rho) { const int n = rho >> 4, i = rho & 15; return 8 * (i >> 2) + 4 * n + (i & 3); }

struct Unit { int pm, pn; };
struct Gemm { const bf16_t* A; const bf16_t* Bt; int M, N, K; };

struct StaticOrder {
    int nM, nN, nwg, G, c;
    __host__ __device__ void init(int M, int N, int G_, int c_) { nM = M / BM; nN = N / BM; nwg = nM * nN; G = G_; c = c_; }
    __host__ __device__ bool next(int i, Unit& u) const {
        const long L = (long)i * G + c; if (L >= nwg) return false;
        int wgid = (int)L; { const int q = nwg / NXCD, r = nwg % NXCD, xcd = wgid % NXCD, off = wgid / NXCD; wgid = (xcd < r ? xcd * (q + 1) : r * (q + 1) + (xcd - r) * q) + off; }
        const int nig = WGM * nN, gid = wgid / nig, fm = gid * WGM, gsz = (nM - fm) < WGM ? (nM - fm) : WGM;
        u.pm = fm + ((wgid % nig) % gsz); u.pn = (wgid % nig) / gsz; return true;
    }
    __device__ __forceinline__ void a_ready(const Unit&) const {}
    __device__ __forceinline__ void done(const Unit&) const {}
};

template <class Epi, class Sched, bool ALIGN_EPI = false, bool SP2 = false>
__device__ __forceinline__ void gemm_phase(PG8_LAS unsigned char* lds, const Gemm g, const Sched& S, const Epi& E) {
    const int tid = threadIdx.x, wid = __builtin_amdgcn_readfirstlane(tid >> 6), lane = tid & 63, wr = wid >> 2, wc = wid & 3, fr = lane & 15, fq = lane >> 4;
    const int K = g.K, nt = K / BK;
    unsigned voffA[2], voffB[2];
#pragma unroll
    for (int i = 0; i < 2; ++i) { int R, C; stage_rc(tid * 16 + i * 8192, R, C); const int Rb = Epi::PERM ? ((R & ~31) + perm32(R & 31)) : R;
        voffA[i] = (unsigned)(R * K + C) * 2u; voffB[i] = (unsigned)(Rb * K + C) * 2u; }
    const size_t kstep = (size_t)(BK * 2);
    const size_t hstep = (size_t)HALF * K * 2;
    const size_t tstep = 2 * hstep;
    const unsigned ldsw = (unsigned)wid * 1024u;
    const int aoff = lds_byte(wr * 64 + fr, fq * 8), boff = lds_byte(wc * 32 + fr, fq * 8);
#define PG8_SA(b, h) (((b) * 2 + (h)) * HTB)
#define PG8_SB(b, h) ((4 + (b) * 2 + (h)) * HTB)
#define PG8_STAGE(bufoff, gbase, voff) do { _Pragma("unroll") for (int _i = 0; _i < 2; ++_i) \
        __builtin_amdgcn_global_load_lds((const unsigned*)((const char*)(gbase) + (voff)[_i]), (PG8_LAS unsigned*)(lds + (bufoff) + ldsw + _i * 8192), 16, 0, 0); } while (0)
#define PG8_LDA(dst, b, h) do { _Pragma("unroll") for (int m = 0; m < 4; ++m) _Pragma("unroll") for (int k = 0; k < 2; ++k) dst[m][k] = *(const PG8_LAS bf16x8*)(lds + PG8_SA(b, h) + aoff + m * 2048 + k * 1024); } while (0)
#define PG8_LDB(dst, b, h) do { _Pragma("unroll") for (int n = 0; n < 2; ++n) _Pragma("unroll") for (int k = 0; k < 2; ++k) dst[n][k] = *(const PG8_LAS bf16x8*)(lds + PG8_SB(b, h) + boff + n * 2048 + k * 1024); } while (0)
#define PG8_MMA(ai, bj, At, Bt) do { __builtin_amdgcn_s_setprio(1); _Pragma("unroll") for (int m = 0; m < 4; ++m) _Pragma("unroll") for (int n = 0; n < 2; ++n) _Pragma("unroll") for (int k = 0; k < 2; ++k) \
        acc[ai][bj][m][n] = __builtin_amdgcn_mfma_f32_16x16x32_bf16(Bt[n][k], At[m][k], acc[ai][bj][m][n], 0, 0, 0); __builtin_amdgcn_s_setprio(0); } while (0)
#define PG8_WAIT_V(n) asm volatile("s_waitcnt vmcnt(" #n ")" ::: "memory")
#define PG8_WAIT_L(n) asm volatile("s_waitcnt lgkmcnt(" #n ")" ::: "memory")
#define PG8_BAR __builtin_amdgcn_s_barrier()
#define PG8_SCHED __builtin_amdgcn_sched_barrier(0)
    Unit cur, nxt; int ui = 0;
    if (!S.next(0, cur)) return;
    f32x4 acc[2][2][4][2];
#pragma unroll
    for (int a = 0; a < 2; ++a)
#pragma unroll
        for (int b = 0; b < 2; ++b)
#pragma unroll
            for (int m = 0; m < 4; ++m)
#pragma unroll
                for (int n = 0; n < 2; ++n) acc[a][b][m][n] = (f32x4){0.f, 0.f, 0.f, 0.f};
    bf16x8 At[4][2], B0[2][2], B1[2][2];
    const char* cA = (const char*)g.A + (size_t)cur.pm * tstep; const char* cB = (const char*)g.Bt + (size_t)cur.pn * tstep;
    S.a_ready(cur);
    if constexpr (SP2) {
        PG8_STAGE(PG8_SB(0, 0), cB, voffB); PG8_STAGE(PG8_SB(0, 1), cB + hstep, voffB); PG8_STAGE(PG8_SA(0, 0), cA, voffA); PG8_STAGE(PG8_SA(0, 1), cA + hstep, voffA);
        if (wr == 1) PG8_BAR;
        PG8_WAIT_V(2); PG8_BAR;
        PG8_STAGE(PG8_SB(1, 0), cB + kstep, voffB); PG8_STAGE(PG8_SA(1, 0), cA + kstep, voffA); PG8_STAGE(PG8_SB(1, 1), cB + hstep + kstep, voffB);
        PG8_WAIT_V(6); PG8_BAR;
    } else {
        PG8_STAGE(PG8_SB(0, 0), cB, voffB); PG8_STAGE(PG8_SA(0, 0), cA, voffA); PG8_STAGE(PG8_SB(0, 1), cB + hstep, voffB); PG8_STAGE(PG8_SA(0, 1), cA + hstep, voffA);
        if (wr == 1) PG8_BAR;
        PG8_WAIT_V(4); PG8_BAR;
        PG8_STAGE(PG8_SB(1, 0), cB + kstep, voffB); PG8_STAGE(PG8_SA(1, 0), cA + kstep, voffA); PG8_STAGE(PG8_SB(1, 1), cB + hstep + kstep, voffB);
        PG8_WAIT_V(6); PG8_BAR;
    }
    for (;;) {
        const bool has_next = S.next(ui + 1, nxt);
        const char* nA = has_next ? (const char*)g.A + (size_t)nxt.pm * tstep : cA; const char* nB = has_next ? (const char*)g.Bt + (size_t)nxt.pn * tstep : cB;
        for (int t = 0; t < nt; t += 2) {
            const bool last = (t == nt - 2);
            const char* a1 = cA + (size_t)(t + 1) * kstep;
            const char* a2 = last ? nA : cA + (size_t)(t + 2) * kstep; const char* b2 = last ? nB : cB + (size_t)(t + 2) * kstep;
            const char* a3 = a2 + kstep; const char* b3 = b2 + kstep;
            if (last && has_next) S.a_ready(nxt);
            if constexpr (SP2) {
            PG8_LDB(B0, 0, 0); PG8_LDB(B1, 0, 1); PG8_SCHED; PG8_LDA(At, 0, 0); PG8_STAGE(PG8_SA(1, 1), a1 + hstep, voffA);
            PG8_WAIT_V(8); PG8_WAIT_L(0); PG8_BAR; PG8_MMA(0, 0, At, B0); PG8_MMA(0, 1, At, B1); PG8_BAR; PG8_SCHED;
            PG8_LDA(At, 0, 1); PG8_STAGE(PG8_SB(0, 0), b2, voffB); PG8_STAGE(PG8_SB(0, 1), b2 + hstep, voffB); PG8_STAGE(PG8_SA(0, 0), a2, voffA);
            PG8_WAIT_V(8); PG8_WAIT_L(0); PG8_BAR; PG8_MMA(1, 0, At, B0); PG8_MMA(1, 1, At, B1); PG8_BAR; PG8_SCHED;
            PG8_LDB(B0, 1, 0); PG8_LDB(B1, 1, 1); PG8_SCHED; PG8_LDA(At, 1, 0); PG8_STAGE(PG8_SA(0, 1), a2 + hstep, voffA);
            PG8_WAIT_V(8); PG8_WAIT_L(0); PG8_BAR; PG8_MMA(0, 0, At, B0); PG8_MMA(0, 1, At, B1); PG8_BAR; PG8_SCHED;
            PG8_LDA(At, 1, 1); PG8_STAGE(PG8_SB(1, 0), b3, voffB); PG8_STAGE(PG8_SB(1, 1), b3 + hstep, voffB); PG8_STAGE(PG8_SA(1, 0), a3, voffA);
            PG8_WAIT_V(8); PG8_WAIT_L(0); PG8_BAR; PG8_MMA(1, 0, At, B0); PG8_MMA(1, 1, At, B1); PG8_BAR; PG8_SCHED;
            } else {
            PG8_LDB(B0, 0, 0); PG8_SCHED; PG8_LDA(At, 0, 0); PG8_STAGE(PG8_SA(1, 1), a1 + hstep, voffA);
            PG8_WAIT_L(8); PG8_BAR; PG8_WAIT_L(0); PG8_MMA(0, 0, At, B0); PG8_BAR; PG8_SCHED;
            PG8_LDB(B1, 0, 1); PG8_STAGE(PG8_SB(0, 0), b2, voffB);
            PG8_BAR; PG8_WAIT_L(0); PG8_MMA(0, 1, At, B1); PG8_BAR;
            PG8_LDA(At, 0, 1); PG8_STAGE(PG8_SA(0, 0), a2, voffA);
            PG8_BAR; PG8_WAIT_L(0); PG8_MMA(1, 0, At, B0); PG8_BAR; PG8_SCHED;
            PG8_STAGE(PG8_SB(0, 1), b2 + hstep, voffB);
            PG8_WAIT_V(6); PG8_BAR; PG8_MMA(1, 1, At, B1); PG8_BAR;
            PG8_LDB(B0, 1, 0); PG8_SCHED; PG8_LDA(At, 1, 0); PG8_STAGE(PG8_SA(0, 1), a2 + hstep, voffA);
            PG8_WAIT_L(8); PG8_BAR; PG8_WAIT_L(0); PG8_MMA(0, 0, At, B0); PG8_BAR; PG8_SCHED;
            PG8_LDB(B1, 1, 1); PG8_STAGE(PG8_SB(1, 0), b3, voffB);
            PG8_BAR; PG8_WAIT_L(0); PG8_MMA(0, 1, At, B1); PG8_BAR;
            PG8_LDA(At, 1, 1); PG8_STAGE(PG8_SA(1, 0), a3, voffA);
            PG8_BAR; PG8_WAIT_L(0); PG8_MMA(1, 0, At, B0); PG8_BAR; PG8_SCHED;
            PG8_STAGE(PG8_SB(1, 1), b3 + hstep, voffB);
            PG8_WAIT_V(6); PG8_BAR; PG8_MMA(1, 1, At, B1); PG8_BAR;
            }
        }
        if constexpr (ALIGN_EPI) { if (wr == 0) PG8_BAR; }
        if constexpr (!Epi::AFTER_DRAIN) { E(acc, cur, wr, wc, fr, fq); S.done(cur); }
        if (!has_next) break;
#pragma unroll
        for (int a = 0; a < 2; ++a)
#pragma unroll
            for (int b = 0; b < 2; ++b)
#pragma unroll
                for (int m = 0; m < 4; ++m)
#pragma unroll
                    for (int n = 0; n < 2; ++n) acc[a][b][m][n] = (f32x4){0.f, 0.f, 0.f, 0.f};
        cur = nxt; cA = nA; cB = nB; ++ui;
        if constexpr (ALIGN_EPI) { if (wr == 1) PG8_BAR; }
    }
    PG8_WAIT_V(0);
    if constexpr (!ALIGN_EPI) { if (wr == 0) PG8_BAR; }
    PG8_BAR;
    if constexpr (Epi::AFTER_DRAIN) { E.fused(acc, cur, wr, wc, fr, fq, lds, wid, lane); S.done(cur); }
#undef PG8_SA
#undef PG8_SB
#undef PG8_STAGE
#undef PG8_LDA
#undef PG8_LDB
#undef PG8_MMA
#undef PG8_WAIT_V
#undef PG8_WAIT_L
#undef PG8_BAR
#undef PG8_SCHED
}
}

DEVI void ln_row1024(float (&y)[16], const float* g, const float* b, int lane) {
    float s = 0.f;
#pragma unroll
    for (int i = 0; i < 16; ++i) s += y[i];
    const float mu = wave_sum(s) * (1.0f / 1024.0f);
    float q = 0.f;
#pragma unroll
    for (int i = 0; i < 16; ++i) { const float d = y[i] - mu; q += d * d; }
    const float rstd = 1.0f / sqrtf(wave_sum(q) * (1.0f / 1024.0f) + LN_EPS);
#pragma unroll
    for (int i = 0; i < 16; ++i) y[i] = (y[i] - mu) * rstd * g[lane + 64 * i] + b[lane + 64 * i];
}

DEVI void route_token(const float (&y)[16], float* ys, int t, int lane, const float* wg, const float* bg, const float* we, const float* be, int* eid, float* gw, unsigned* counts) {
    float lg[36];
#pragma unroll
    for (int j = 0; j < 36; ++j) lg[j] = 0.f;
#pragma unroll
    for (int i = 0; i < 16; ++i) ys[lane + 64 * i] = y[i];
#pragma unroll 1
    for (int i = 0; i < 16; ++i) {
        const int c = lane + 64 * i;
        const float yv = ys[c];
        const float4 g4 = *(const float4*)(wg + (size_t)c * 4);
        lg[0] += yv * g4.x; lg[1] += yv * g4.y; lg[2] += yv * g4.z; lg[3] += yv * g4.w;
#pragma unroll
        for (int j = 0; j < 8; ++j) { const float4 e4 = *(const float4*)(we + (size_t)c * 32 + j * 4);
            lg[4 + j * 4 + 0] += yv * e4.x; lg[4 + j * 4 + 1] += yv * e4.y; lg[4 + j * 4 + 2] += yv * e4.z; lg[4 + j * 4 + 3] += yv * e4.w; }
    }
#pragma unroll
    for (int j = 0; j < 36; ++j) lg[j] = wave_sum(lg[j]);
    if (lane == 0) {
        float gl[4]; int g = 0;
#pragma unroll
        for (int j = 0; j < 4; ++j) gl[j] = lg[j] + bg[j];
#pragma unroll
        for (int j = 1; j < 4; ++j) if (gl[j] > gl[g]) g = j;
        float den = 0.f;
#pragma unroll
        for (int j = 0; j < 4; ++j) den += expf(gl[j] - gl[g]);
        const float gp = 1.0f / den;
        float el[8];
#pragma unroll
        for (int j = 0; j < 8; ++j) { float v = 0.f;
#pragma unroll
            for (int gg = 0; gg < 4; ++gg) v = (gg == g) ? lg[4 + gg * 8 + j] + be[gg * 8 + j] : v;
            el[j] = v; }
        int i1 = 0;
#pragma unroll
        for (int j = 1; j < 8; ++j) if (el[j] > el[i1]) i1 = j;
        int i2 = (i1 == 0) ? 1 : 0;
#pragma unroll
        for (int j = 0; j < 8; ++j) if (j != i1 && el[j] > el[i2]) i2 = j;
        const float ex = expf(el[i2] - el[i1]);
        const float p1 = 1.0f / (1.0f + ex), p2 = ex / (1.0f + ex);
        const int e1 = g * 8 + i1, e2 = g * 8 + i2;
        eid[2 * t] = e1; eid[2 * t + 1] = e2; gw[2 * t] = gp * p1; gw[2 * t + 1] = gp * p2;
        atomicAdd(&counts[e1], 1u); atomicAdd(&counts[e2], 1u);
    }
}


DEVI void ln_row1024v(float (&y)[16], const float* g, const float* b, int lane) {
    float s = 0.f;
#pragma unroll
    for (int i = 0; i < 16; ++i) s += y[i];
    const float mu = wave_sum(s) * (1.0f / 1024.0f);
    float q = 0.f;
#pragma unroll
    for (int i = 0; i < 16; ++i) { const float d = y[i] - mu; q += d * d; }
    const float rstd = 1.0f / sqrtf(wave_sum(q) * (1.0f / 1024.0f) + LN_EPS);
#pragma unroll
    for (int i4 = 0; i4 < 4; ++i4) { const float4 g4 = *(const float4*)(g + 16 * lane + 4 * i4), b4 = *(const float4*)(b + 16 * lane + 4 * i4);
        y[4 * i4] = (y[4 * i4] - mu) * rstd * g4.x + b4.x; y[4 * i4 + 1] = (y[4 * i4 + 1] - mu) * rstd * g4.y + b4.y; y[4 * i4 + 2] = (y[4 * i4 + 2] - mu) * rstd * g4.z + b4.z; y[4 * i4 + 3] = (y[4 * i4 + 3] - mu) * rstd * g4.w + b4.w; }
}
DEVI void combine_row(float (&y)[16], const float* h, const unsigned short* Y0, const unsigned short* Y1, float g0, float g1, int lane) {
    const uint4 a0 = *(const uint4*)(Y0 + 16 * lane), a1 = *(const uint4*)(Y0 + 16 * lane + 8), b0 = *(const uint4*)(Y1 + 16 * lane), b1 = *(const uint4*)(Y1 + 16 * lane + 8);
    const unsigned aw[8] = {a0.x, a0.y, a0.z, a0.w, a1.x, a1.y, a1.z, a1.w}, bw[8] = {b0.x, b0.y, b0.z, b0.w, b1.x, b1.y, b1.z, b1.w};
#pragma unroll
    for (int i4 = 0; i4 < 4; ++i4) { const float4 hv = *(const float4*)(h + 16 * lane + 4 * i4);
        y[4 * i4]     = DN_ALPHA * hv.x + (g0 * __uint_as_float(aw[2 * i4] << 16) + g1 * __uint_as_float(bw[2 * i4] << 16));
        y[4 * i4 + 1] = DN_ALPHA * hv.y + (g0 * __uint_as_float(aw[2 * i4] & 0xFFFF0000u) + g1 * __uint_as_float(bw[2 * i4] & 0xFFFF0000u));
        y[4 * i4 + 2] = DN_ALPHA * hv.z + (g0 * __uint_as_float(aw[2 * i4 + 1] << 16) + g1 * __uint_as_float(bw[2 * i4 + 1] << 16));
        y[4 * i4 + 3] = DN_ALPHA * hv.w + (g0 * __uint_as_float(aw[2 * i4 + 1] & 0xFFFF0000u) + g1 * __uint_as_float(bw[2 * i4 + 1] & 0xFFFF0000u)); }
}
typedef float f32x4v __attribute__((ext_vector_type(4)));
DEVI void ln_route_block(int tb, int ntok, const float* Zsrc, float* Hdst, const float* g, const float* b, const float4* __restrict__ Wr, const float* bg, const float* be,
                         int* eid, float* gw, unsigned* counts, float* sm) {
    const int tid = otid(), lane = tid & 63, wave = tid >> 6;
    unsigned* lcnt = (unsigned*)(sm + 8 * 16 * 48);
    if (tid < NE) lcnt[tid] = 0u;
    { float yy[8][16];
#pragma unroll
      for (int i = 0; i < 8; ++i) { const int tl = wave * 8 + i; const size_t t = (size_t)(tb + (tl < ntok ? tl : ntok - 1));
#pragma unroll
          for (int i4 = 0; i4 < 4; ++i4) { const float4 v = *(const float4*)(Zsrc + t * D + 16 * lane + 4 * i4); yy[i][4 * i4] = v.x; yy[i][4 * i4 + 1] = v.y; yy[i][4 * i4 + 2] = v.z; yy[i][4 * i4 + 3] = v.w; } }
#pragma unroll
      for (int i = 0; i < 8; ++i) { const int tl = wave * 8 + i;
          if (tl < ntok) { const size_t t = (size_t)(tb + tl);
              ln_row1024v(yy[i], g, b, lane);
#pragma unroll
              for (int i4 = 0; i4 < 4; ++i4) *(float4*)(Hdst + t * D + 16 * lane + 4 * i4) = make_float4(yy[i][4 * i4], yy[i][4 * i4 + 1], yy[i][4 * i4 + 2], yy[i][4 * i4 + 3]); } } }
    asm volatile("s_waitcnt vmcnt(0)" ::: "memory");
    __syncthreads();
    const int grp = wave & 3, khalf = wave >> 2;
    if (grp * 16 < ntok) {
        const int t0 = tb + 16 * grp, row = lane & 15, kg = lane >> 4;
        f32x4v acc[3];
#pragma unroll
        for (int ct = 0; ct < 3; ++ct) acc[ct] = (f32x4v){0.f, 0.f, 0.f, 0.f};
        const float* arow = Hdst + (size_t)(t0 + row) * D + 4 * kg;
#pragma unroll 4
        for (int sstep = 32 * khalf; sstep < 32 * khalf + 32; ++sstep) {
            const float4 a4 = *(const float4*)(arow + 16 * sstep);
#pragma unroll
            for (int ct = 0; ct < 3; ++ct) { const float4 b4 = Wr[(sstep * 3 + ct) * 64 + lane];
                acc[ct] = __builtin_amdgcn_mfma_f32_16x16x4f32(a4.x, b4.x, acc[ct], 0, 0, 0); acc[ct] = __builtin_amdgcn_mfma_f32_16x16x4f32(a4.y, b4.y, acc[ct], 0, 0, 0);
                acc[ct] = __builtin_amdgcn_mfma_f32_16x16x4f32(a4.z, b4.z, acc[ct], 0, 0, 0); acc[ct] = __builtin_amdgcn_mfma_f32_16x16x4f32(a4.w, b4.w, acc[ct], 0, 0, 0); }
        }
        float* Lg = sm + (khalf * 4 + grp) * 16 * 48;
#pragma unroll
        for (int ct = 0; ct < 3; ++ct)
#pragma unroll
            for (int j = 0; j < 4; ++j) Lg[(4 * kg + j) * 48 + 16 * ct + row] = acc[ct][j];
    }
    __syncthreads();
    if (wave < 4 && wave * 16 < ntok) {
        const int t0 = tb + 16 * wave;
        if (lane < 16) {
            const int t = t0 + lane; const float* lgA = sm + wave * 16 * 48 + lane * 48; const float* lgB = lgA + 4 * 16 * 48;
            float lg[36];
#pragma unroll
            for (int j = 0; j < 36; ++j) lg[j] = lgA[j] + lgB[j];
            float gl[4]; int gsel = 0;
#pragma unroll
            for (int j = 0; j < 4; ++j) gl[j] = lg[j] + bg[j];
#pragma unroll
            for (int j = 1; j < 4; ++j) if (gl[j] > gl[gsel]) gsel = j;
            float den = 0.f;
#pragma unroll
            for (int j = 0; j < 4; ++j) den += expf(gl[j] - gl[gsel]);
            const float gp = 1.0f / den;
            float el[8];
#pragma unroll
            for (int j = 0; j < 8; ++j) { float v = lg[4 + j];
#pragma unroll
                for (int gg = 1; gg < 4; ++gg) v = (gg == gsel) ? lg[4 + gg * 8 + j] : v;
                el[j] = v + be[gsel * 8 + j]; }
            int i1 = 0;
#pragma unroll
            for (int j = 1; j < 8; ++j) if (el[j] > el[i1]) i1 = j;
            int i2 = (i1 == 0) ? 1 : 0;
#pragma unroll
            for (int j = 0; j < 8; ++j) if (j != i1 && el[j] > el[i2]) i2 = j;
            float e1v = el[0], e2v = el[0];
#pragma unroll
            for (int j = 0; j < 8; ++j) { e1v = (j == i1) ? el[j] : e1v; e2v = (j == i2) ? el[j] : e2v; }
            const float ex = expf(e2v - e1v);
            const float p1 = 1.0f / (1.0f + ex), p2 = ex / (1.0f + ex);
            const int e1 = gsel * 8 + i1, e2 = gsel * 8 + i2;
            eid[2 * t] = e1; eid[2 * t + 1] = e2; gw[2 * t] = gp * p1; gw[2 * t + 1] = gp * p2;
            atomicAdd(&lcnt[e1], 1u); atomicAdd(&lcnt[e2], 1u);
        }
    }
    __syncthreads();
    if (tid < NE) { const unsigned c = lcnt[tid]; if (c) atomicAdd(&counts[tid], c); }
    __syncthreads();
}

using pg8::f32x4; using pg8::Unit; typedef unsigned short bf16_t;
DEVI float bf2f(unsigned short b) { return __uint_as_float(((unsigned)b) << 16); }
DEVI float bflo(unsigned w) { return __uint_as_float(w << 16); }
DEVI float bfhi(unsigned w) { return __uint_as_float(w & 0xFFFF0000u); }
DEVI unsigned cvt_pk_bf16(float lo, float hi) { unsigned r; asm volatile("v_cvt_pk_bf16_f32 %0, %1, %2" : "=v"(r) : "v"(lo), "v"(hi)); return r; }
DEVI uint2 pack4(const f32x4 v) { return make_uint2(cvt_pk_bf16(v[0], v[1]), cvt_pk_bf16(v[2], v[3])); }
DEVI float fsigm(float x) { return __builtin_amdgcn_rcpf(1.0f + __expf(-x)); }
DEVI unsigned pack4_fp8(const f32x4 v) { int w = __builtin_amdgcn_cvt_pk_fp8_f32(v[0], v[1], 0, false); w = __builtin_amdgcn_cvt_pk_fp8_f32(v[2], v[3], w, true); return (unsigned)w; }

DEVI int in0_srccol(int n) {
    if (n < 1024) { const int G = n >> 5, nn = (n >> 4) & 1, i = n & 15; return (nn ? OFF_AGATE : OFF_AVAL) + 16 * G + i; }
    if (n < 2048 || (n >= 2560 && n < 3072)) {
        const int base = n < 1536 ? OFF_Q : n < 2048 ? OFF_K : OFF_QI; const int loc = n & 511;
        const int G = loc >> 5, nn = (loc >> 4) & 1, i = loc & 15; return base + 64 * (G >> 1) + 32 * nn + 16 * (G & 1) + i; }
    if (n < 2560) return OFF_V + (n - 2048);
    if (n < 3136) { const int loc = n - 3072; const int G = loc >> 5, nn = (loc >> 4) & 1, i = loc & 15; return OFF_KI + 32 * nn + 16 * G + i; }
    if (n < 3144) return OFF_WI + (n - 3136);
    return -1;
}
struct EpiIn0 {
    static constexpr bool PERM = false, AFTER_DRAIN = false;
    bf16_t* GLU; bf16_t* KI; float* WI; const float* ropeC; const float* ropeS; unsigned char* KV8;
    DEVI void operator()(const f32x4 (&acc)[2][2][4][2], const Unit& u, int wr, int wc, int fr, int fq) const {
        const int pn = u.pn; const int rbase = u.pm * 256 + wr * 64 + fr;
        if (pn < 4) {
#pragma unroll
            for (int ai = 0; ai < 2; ++ai)
#pragma unroll
                for (int m = 0; m < 4; ++m) { const size_t row = rbase + ai * 128 + m * 16;
#pragma unroll
                    for (int bj = 0; bj < 2; ++bj) { const int G = 8 * pn + 4 * bj + wc; const f32x4 v = acc[ai][bj][m][0], g = acc[ai][bj][m][1]; f32x4 o;
#pragma unroll
                        for (int j = 0; j < 4; ++j) o[j] = v[j] * fsigm(g[j]);
                        *(uint2*)(GLU + row * 512 + 16 * G + 4 * fq) = pack4(o); } }
        } else if (pn == 8 || pn == 9) {
#pragma unroll
            for (int ai = 0; ai < 2; ++ai)
#pragma unroll
                for (int m = 0; m < 4; ++m) { const size_t row = rbase + ai * 128 + m * 16;
#pragma unroll
                    for (int bj = 0; bj < 2; ++bj)
#pragma unroll
                        for (int n = 0; n < 2; ++n) { const int col = 256 * (pn - 8) + 128 * bj + 32 * wc + 16 * n + 4 * fq;
                            *(unsigned*)(KV8 + row * 1024 + (size_t)(col >> 3) * 16 + 8 + (col & 7)) = pack4_fp8(acc[ai][bj][m][n]); } }
        } else if (pn == 12) {
            if (wc < 2) { const int d0 = 16 * wc + 4 * fq;
#pragma unroll
                for (int ai = 0; ai < 2; ++ai)
#pragma unroll
                    for (int m = 0; m < 4; ++m) { const size_t row = rbase + ai * 128 + m * 16;
                        const f32x4 c = *(const f32x4*)(ropeC + row * 32 + d0), s = *(const f32x4*)(ropeS + row * 32 + d0);
                        const f32x4 t1 = acc[ai][0][m][0], t2 = acc[ai][0][m][1];
                        *(uint2*)(KI + row * 64 + d0) = pack4(t1 * c - t2 * s); *(uint2*)(KI + row * 64 + 32 + d0) = pack4(t1 * s + t2 * c); }
            } else if (wc == 2 && fq < 2) {
#pragma unroll
                for (int ai = 0; ai < 2; ++ai)
#pragma unroll
                    for (int m = 0; m < 4; ++m) { const size_t row = rbase + ai * 128 + m * 16; *(f32x4*)(WI + row * 8 + 4 * fq) = acc[ai][0][m][0] * 0.35355339059327373f; }
            }
        } else {
            bf16_t* dst = GLU + (size_t)(pn < 6 ? 1 : pn < 8 ? 2 : 4) * LP * 512; const int pl = pn & 1; const int d0 = 16 * (wc & 1) + 4 * fq;
#pragma unroll
            for (int ai = 0; ai < 2; ++ai)
#pragma unroll
                for (int m = 0; m < 4; ++m) { const size_t row = rbase + ai * 128 + m * 16;
                    const f32x4 c = *(const f32x4*)(ropeC + row * 32 + d0), s = *(const f32x4*)(ropeS + row * 32 + d0);
#pragma unroll
                    for (int bj = 0; bj < 2; ++bj) { const int hh = 4 * pl + 2 * bj + (wc >> 1); const f32x4 t1 = acc[ai][bj][m][0], t2 = acc[ai][bj][m][1];
                        if (pn == 6 || pn == 7) { const int da = 64 * hh + d0, db = da + 32;
                            *(unsigned*)(KV8 + row * 1024 + (size_t)(da >> 3) * 16 + (da & 7)) = pack4_fp8(t1 * c - t2 * s); *(unsigned*)(KV8 + row * 1024 + (size_t)(db >> 3) * 16 + (db & 7)) = pack4_fp8(t1 * s + t2 * c);
                        } else { *(uint2*)(dst + row * 512 + 64 * hh + d0) = pack4(t1 * c - t2 * s); *(uint2*)(dst + row * 512 + 64 * hh + 32 + d0) = pack4(t1 * s + t2 * c); } } }
        }
    }
};
struct EpiRes0 {
    static constexpr bool PERM = false, AFTER_DRAIN = false;
    const float* x; const float* meta; float* Z;
    DEVI void operator()(const f32x4 (&acc)[2][2][4][2], const Unit& u, int wr, int wc, int fr, int fq) const {
        const int rbase = u.pm * 256 + wr * 64 + fr, cbase = u.pn * 256 + wc * 32 + 4 * fq;
#pragma unroll
        for (int ai = 0; ai < 2; ++ai)
#pragma unroll
            for (int m = 0; m < 4; ++m) { const int row = rbase + ai * 128 + m * 16;
                if (row < L) { const float* rs = row < NMETA ? meta + (size_t)row * D : x + (size_t)(row - NMETA) * D;
#pragma unroll
                    for (int bj = 0; bj < 2; ++bj)
#pragma unroll
                        for (int n = 0; n < 2; ++n) { const int col = cbase + 128 * bj + 16 * n; const f32x4 r4 = *(const f32x4*)(rs + col); *(f32x4*)(Z + (size_t)row * D + col) = r4 * DN_ALPHA + acc[ai][bj][m][n]; } } }
    }
};
struct EpiGateUp {
    static constexpr bool PERM = false, AFTER_DRAIN = false;
    bf16_t* Hm;
    DEVI void operator()(const f32x4 (&acc)[2][2][4][2], const Unit& u, int wr, int wc, int fr, int fq) const {
        const int pl = u.pn & 3; const int rbase = u.pm * 256 + wr * 64 + fr;
#pragma unroll
        for (int ai = 0; ai < 2; ++ai)
#pragma unroll
            for (int m = 0; m < 4; ++m) { const size_t row = rbase + ai * 128 + m * 16;
#pragma unroll
                for (int bj = 0; bj < 2; ++bj) { const int G = 8 * pl + 4 * bj + wc; const f32x4 g = acc[ai][bj][m][0], up = acc[ai][bj][m][1]; f32x4 o;
#pragma unroll
                    for (int j = 0; j < 4; ++j) o[j] = g[j] * fsigm(g[j]) * up[j];
                    *(uint2*)(Hm + row * 512 + 16 * G + 4 * fq) = pack4(o); } }
    }
};
struct EpiDown {
    static constexpr bool PERM = false, AFTER_DRAIN = false;
    bf16_t* Y;
    DEVI void operator()(const f32x4 (&acc)[2][2][4][2], const Unit& u, int wr, int wc, int fr, int fq) const {
        const int pl = u.pn & 3; const int rbase = u.pm * 256 + wr * 64 + fr, cbase = pl * 256 + wc * 32 + 4 * fq;
#pragma unroll
        for (int ai = 0; ai < 2; ++ai)
#pragma unroll
            for (int m = 0; m < 4; ++m) { const size_t row = rbase + ai * 128 + m * 16;
#pragma unroll
                for (int bj = 0; bj < 2; ++bj)
#pragma unroll
                    for (int n = 0; n < 2; ++n) *(uint2*)(Y + row * 1024 + cbase + 128 * bj + 16 * n) = pack4(acc[ai][bj][m][n]); }
    }
};
struct MoeOrder {
    const int* mt; int nunits, G, c;
    DEVI void init(const int* t, int G_, int c_) { mt = t; nunits = t[0] * 4; G = G_; c = c_; }
    DEVI bool next(int i, Unit& u) const { const int li = i * G + c; if (li >= nunits) return false; const int ti = li >> 2; u.pm = ti; u.pn = mt[4 + ti] * 4 + (li & 3); return true; }
    DEVI void a_ready(const Unit&) const {}
    DEVI void done(const Unit&) const {}
};

template <class F> DEVI void tr_tile(bf16_t* dst, int K, int n0, int k0, F src, float* sm) {
    const int tid = otid();
    __syncthreads();
    { const int nn = tid & 63, kb = tid >> 6;
#pragma unroll
      for (int p = 0; p < 8; ++p) { const int kk = kb + 8 * p; sm[kk * 65 + nn] = src(n0 + nn, k0 + kk); } }
    __syncthreads();
    { const int nn = tid >> 3, kq = (tid & 7) * 8; float v[8];
#pragma unroll
      for (int j = 0; j < 8; ++j) v[j] = sm[(kq + j) * 65 + nn];
      uint4 w; w.x = cvt_pk_bf16(v[0], v[1]); w.y = cvt_pk_bf16(v[2], v[3]); w.z = cvt_pk_bf16(v[4], v[5]); w.w = cvt_pk_bf16(v[6], v[7]);
      *(uint4*)(dst + (size_t)(n0 + nn) * K + k0 + kq) = w; }
}

struct TrJob { bf16_t* dst; const float* s0; const float* s1; int K, n0, k0, ld, mode; };
DEVI float tr_src(const TrJob& J, int n, int k) {
    if (J.mode == 0) return __builtin_nontemporal_load(J.s0 + (size_t)k * J.ld + n);
    if (J.mode == 1) { const int sc = in0_srccol(n); return sc < 0 ? 0.f : __builtin_nontemporal_load(J.s0 + (size_t)k * IN_AB + sc); }
    const int ch = (n >> 5) * 16 + (n & 15); return ((n >> 4) & 1) ? __builtin_nontemporal_load(J.s1 + (size_t)k * DE + ch) : __builtin_nontemporal_load(J.s0 + (size_t)k * DE + ch);
}
DEVI void tr_fetch(const TrJob& J, float (&v)[8]) {
    const int tid = otid(), nn = tid & 63, kb = tid >> 6;
#pragma unroll
    for (int p = 0; p < 8; ++p) v[p] = tr_src(J, J.n0 + nn, J.k0 + kb + 8 * p);
}
DEVI void tr_commit(const TrJob& J, const float (&v)[8], float* sm) {
    const int tid = otid();
    __syncthreads();
    { const int nn = tid & 63, kb = tid >> 6;
#pragma unroll
      for (int p = 0; p < 8; ++p) sm[(kb + 8 * p) * 65 + nn] = v[p]; }
    __syncthreads();
    { const int nn = tid >> 3, kq = (tid & 7) * 8; float x[8];
#pragma unroll
      for (int j = 0; j < 8; ++j) x[j] = sm[(kq + j) * 65 + nn];
      uint4 w; w.x = cvt_pk_bf16(x[0], x[1]); w.y = cvt_pk_bf16(x[2], x[3]); w.z = cvt_pk_bf16(x[4], x[5]); w.w = cvt_pk_bf16(x[6], x[7]);
      *(uint4*)(J.dst + (size_t)(J.n0 + nn) * J.K + J.k0 + kq) = w; }
}
template <class Dec> DEVI void tr_run(int njobs, Dec dec, float* sm, int rank = (int)blockIdx.x, int G = (int)gridDim.x) {
    int j = rank;
    TrJob Ja{}, Jb{}; float va[8], vb[8];
    if (j < njobs) { Ja = dec(j); tr_fetch(Ja, va); }
    while (j < njobs) {
        int jn = j + G; if (jn < njobs) { Jb = dec(jn); tr_fetch(Jb, vb); }
        tr_commit(Ja, va, sm);
        j = jn; if (j >= njobs) break;
        jn = j + G; if (jn < njobs) { Ja = dec(jn); tr_fetch(Ja, va); }
        tr_commit(Jb, vb, sm);
        j = jn;
    }
    __syncthreads();
}

DEVI void moe_dispatch_mfma(const float* H, const int* eid, const unsigned* counts, unsigned* cursor, int* slot, int* mtiles, bf16_t* Xperm, int* sm_i, int gwave, int nwaves, int lane, int p_begin) {
    { const int tid = otid();
      if (tid == 0) { int o = 0; for (int e = 0; e < NE; ++e) { sm_i[e] = o; o += (((int)counts[e] + 255) >> 8) << 8; } }
      if (tid < NE) sm_i[32 + tid] = 0; }
    __syncthreads();
    { const int ppw = (NPAIR - p_begin + nwaves - 1) / nwaves; const int pb = p_begin + gwave * ppw; const int pe = pb + ppw < NPAIR ? pb + ppw : NPAIR;
      int e_ = 0, rk = 0; const bool act = lane < ppw && pb + lane < pe;
      if (act) { e_ = eid[pb + lane]; rk = atomicAdd(&sm_i[32 + e_], 1); }
      __syncthreads();
      { const int tid = otid(); if (tid < NE) { const int c = sm_i[32 + tid]; if (c) sm_i[64 + tid] = sm_i[tid] + (int)atomicAdd(&cursor[tid], (unsigned)c); } }
      __syncthreads();
      if (pb < pe) {
        int sl = 0;
        if (act) { sl = sm_i[64 + e_] + rk; slot[pb + lane] = sl; }
        for (int k0 = 0; pb + k0 < pe; k0 += 8) {
            float4 v[8][4];
#pragma unroll
            for (int k = 0; k < 8; ++k) { const int p = pb + k0 + k < pe ? pb + k0 + k : pe - 1; const float4* src = (const float4*)(H + (size_t)(p >> 1) * D);
#pragma unroll
                for (int r = 0; r < 4; ++r) v[k][r] = src[lane + 64 * r]; }
#pragma unroll
            for (int k = 0; k < 8; ++k) { const int s = __shfl(sl, k0 + k);
                if (pb + k0 + k < pe) { uint2* dst = (uint2*)(Xperm + (size_t)s * D);
#pragma unroll
                    for (int r = 0; r < 4; ++r) dst[lane + 64 * r] = make_uint2(cvt_pk_bf16(v[k][r].x, v[k][r].y), cvt_pk_bf16(v[k][r].z, v[k][r].w)); } }
        }
      } }
    if (blockIdx.x == 0 && otid() == 0) { int n = 0; for (int e = 0; e < NE; ++e) { const int nt = ((int)counts[e] + 255) >> 8; for (int i = 0; i < nt; ++i) mtiles[4 + n++] = e; } mtiles[0] = n; }
    __syncthreads();
}

DEVI float gelu_fast(float x) { return x * fsigm(1.5957691216057308f * (x + 0.044715f * x * x * x)); }
struct EpiIn1 {
    static constexpr bool PERM = false, AFTER_DRAIN = false;
    bf16_t* G;
    DEVI void operator()(const f32x4 (&acc)[2][2][4][2], const Unit& u, int wr, int wc, int fr, int fq) const {
        const int pn = u.pn; const bool is_gate = pn < 5; const int rbase = u.pm * 256 + wr * 64 + fr;
        bf16_t* dst = G + (is_gate ? (size_t)0 : (size_t)LP * RNN_W) + (size_t)((is_gate ? pn : pn - 5) * 256 + wc * 32 + 4 * fq);
#pragma unroll
        for (int ai = 0; ai < 2; ++ai)
#pragma unroll
            for (int m = 0; m < 4; ++m) { const size_t row = rbase + ai * 128 + m * 16;
#pragma unroll
                for (int bj = 0; bj < 2; ++bj)
#pragma unroll
                    for (int n = 0; n < 2; ++n) { f32x4 v = acc[ai][bj][m][n];
                        if (is_gate) {
#pragma unroll
                            for (int j = 0; j < 4; ++j) v[j] = gelu_fast(v[j]); }
                        *(uint2*)(dst + row * RNN_W + 128 * bj + 16 * n) = pack4(v); } }
    }
};
struct EpiRes1 {
    static constexpr bool PERM = false, AFTER_DRAIN = false;
    const float* R; float* Z;
    DEVI void operator()(const f32x4 (&acc)[2][2][4][2], const Unit& u, int wr, int wc, int fr, int fq) const {
        const int rbase = u.pm * 256 + wr * 64 + fr, cbase = u.pn * 256 + wc * 32 + 4 * fq;
#pragma unroll
        for (int ai = 0; ai < 2; ++ai)
#pragma unroll
            for (int m = 0; m < 4; ++m) { const size_t row = rbase + ai * 128 + m * 16;
#pragma unroll
                for (int bj = 0; bj < 2; ++bj)
#pragma unroll
                    for (int n = 0; n < 2; ++n) { const int col = cbase + 128 * bj + 16 * n; const f32x4 r4 = *(const f32x4*)(R + row * D + col); *(f32x4*)(Z + row * D + col) = r4 * DN_ALPHA + acc[ai][bj][m][n]; } }
    }
};

typedef short bf16x8_t __attribute__((ext_vector_type(8)));
struct RgIn { uint4 x[2][4]; };
DEVI void rglru_fetch(int c, int ch0, const bf16_t* __restrict__ XR, int tid, RgIn& R) {
    const int c8 = tid & 15, tr = tid >> 4;
#pragma unroll
    for (int half = 0; half < 2; ++half) { const int t = c * 64 + tr + 32 * half;
#pragma unroll
        for (int j = 0; j < 4; ++j) { const int tt = t - 3 + j; R.x[half][j] = tt >= 0 ? *(const uint4*)(XR + (size_t)tt * RNN_W + ch0 + 8 * c8) : make_uint4(0u, 0u, 0u, 0u); } }
}
template <bool FINAL>
DEVI void rglru_unit(int c, int nb, const RgIn& R, const bf16x8_t (&fa)[4], const bf16x8_t (&fx)[4], float bav, float bxv, float sp,
                     const bf16_t* __restrict__ GATEg, float* __restrict__ Aend, float* __restrict__ Hend, const float* __restrict__ CIN, bf16_t* __restrict__ YY,
                     unsigned char* lds, int tid) {
    const int lane = tid & 63, w = tid >> 6, col = lane & 15, quad = lane >> 4;
    bf16_t* xcb = (bf16_t*)lds;
    float* xcf = (float*)(lds + 64 * 136 * 2);
    const float* cwl = (const float*)(lds + 64 * 136 * 2 + 64 * 132 * 4);
    const int t0 = c * 64, ch0 = nb * RNN_BW, ch = ch0 + 16 * w + col;
    const float cinv = FINAL ? CIN[(size_t)ch * CP + c] : 0.f;
    const int c8 = tid & 15, tr = tid >> 4;
    uint4 g[2];
    if (FINAL) {
#pragma unroll
        for (int half = 0; half < 2; ++half) { const int t = t0 + tr + 32 * half; g[half] = (t < L) ? *(const uint4*)(GATEg + (size_t)t * RNN_W + ch0 + 8 * c8) : make_uint4(0u, 0u, 0u, 0u); } }
    __syncthreads();
    {
        float bv[8];
        { const float4 b0 = *(const float4*)(cwl + 512 + 8 * c8), b1 = *(const float4*)(cwl + 512 + 8 * c8 + 4); bv[0] = b0.x; bv[1] = b0.y; bv[2] = b0.z; bv[3] = b0.w; bv[4] = b1.x; bv[5] = b1.y; bv[6] = b1.z; bv[7] = b1.w; }
#pragma unroll
        for (int half = 0; half < 2; ++half) { const int tl = tr + 32 * half;
            float v[8];
#pragma unroll
            for (int i = 0; i < 8; ++i) v[i] = bv[i];
#pragma unroll
            for (int j = 0; j < 4; ++j) { const uint4 xv = R.x[half][j];
                const float4 w0 = *(const float4*)(cwl + j * 128 + 8 * c8), w1 = *(const float4*)(cwl + j * 128 + 8 * c8 + 4);
                v[0] += w0.x * bflo(xv.x); v[1] += w0.y * bfhi(xv.x); v[2] += w0.z * bflo(xv.y); v[3] += w0.w * bfhi(xv.y);
                v[4] += w1.x * bflo(xv.z); v[5] += w1.y * bfhi(xv.z); v[6] += w1.z * bflo(xv.w); v[7] += w1.w * bfhi(xv.w); }
            *(float4*)(xcf + tl * 132 + 8 * c8) = make_float4(v[0], v[1], v[2], v[3]); *(float4*)(xcf + tl * 132 + 8 * c8 + 4) = make_float4(v[4], v[5], v[6], v[7]);
            uint4 pk; pk.x = cvt_pk_bf16(v[0], v[1]); pk.y = cvt_pk_bf16(v[2], v[3]); pk.z = cvt_pk_bf16(v[4], v[5]); pk.w = cvt_pk_bf16(v[6], v[7]);
            *(uint4*)(xcb + (16 * ((tl >> 2) & 3) + 4 * (tl >> 4) + (tl & 3)) * 136 + 8 * c8) = pk; }
    }
    __syncthreads();
    f32x4 ca[4], cx[4];
#pragma unroll
    for (int mt = 0; mt < 4; ++mt) { ca[mt] = (f32x4){0.f, 0.f, 0.f, 0.f}; cx[mt] = (f32x4){0.f, 0.f, 0.f, 0.f};
#pragma unroll
        for (int ks = 0; ks < 4; ++ks) { const bf16x8_t af = *(const bf16x8_t*)(xcb + (16 * mt + col) * 136 + 32 * ks + 8 * quad);
            ca[mt] = __builtin_amdgcn_mfma_f32_16x16x32_bf16(af, fa[ks], ca[mt], 0, 0, 0);
            cx[mt] = __builtin_amdgcn_mfma_f32_16x16x32_bf16(af, fx[ks], cx[mt], 0, 0, 0); } }
    float av[4][4], uv[4][4]; float A = 1.f, H = 0.f;
#pragma unroll
    for (int mt = 0; mt < 4; ++mt) {
#pragma unroll
        for (int j = 0; j < 4; ++j) { const int tl = 16 * quad + 4 * mt + j;
            const float xcv = xcf[tl * 132 + 16 * w + col];
            const float r = fsigm(ca[mt][j] + bav), ig = fsigm(cx[mt][j] + bxv);
            const float la = -8.0f * r * sp;
            const float x2 = 2.0f * la;
            float em1 = x2 * (1.0f + x2 * (0.5f + x2 * (0.16666667f + x2 * (0.041666668f + x2 * (0.0083333338f + x2 * (0.0013888889f + x2 * 0.0001984127f))))));
            if (x2 < -0.5f) em1 = expm1f(x2);
            float a_ = __expf(la), u_ = __builtin_amdgcn_sqrtf(-em1) * (ig * xcv);
            if (t0 + tl >= L) { a_ = 1.f; u_ = 0.f; }
            av[mt][j] = a_; uv[mt][j] = u_; H = a_ * H + u_; A *= a_; } }
    float carry = cinv, prod = 1.f, hin = 0.f;
#pragma unroll
    for (int q = 0; q < 4; ++q) {
        if (quad == q) hin = carry;
        const float nw = A * carry + H, np = A * prod;
        carry = __shfl(nw, q * 16 + col); prod = __shfl(np, q * 16 + col); }
    if (!FINAL) {
        if (quad == 0) { Aend[(size_t)ch * CP + c] = prod; Hend[(size_t)ch * CP + c] = carry; }
    } else {
        float h = hin;
#pragma unroll
        for (int mt = 0; mt < 4; ++mt)
#pragma unroll
            for (int j = 0; j < 4; ++j) { h = av[mt][j] * h + uv[mt][j]; xcf[(16 * quad + 4 * mt + j) * 132 + 16 * w + col] = h; }
        __syncthreads();
#pragma unroll
        for (int half = 0; half < 2; ++half) { const int tl = tr + 32 * half, t = t0 + tl;
            if (t >= NMETA && t < L) {
                const float4 h0 = *(const float4*)(xcf + tl * 132 + 8 * c8), h1 = *(const float4*)(xcf + tl * 132 + 8 * c8 + 4);
                const uint4 gg = g[half];
                uint4 pk; pk.x = cvt_pk_bf16(bflo(gg.x) * h0.x, bfhi(gg.x) * h0.y); pk.y = cvt_pk_bf16(bflo(gg.y) * h0.z, bfhi(gg.y) * h0.w);
                pk.z = cvt_pk_bf16(bflo(gg.z) * h1.x, bfhi(gg.z) * h1.y); pk.w = cvt_pk_bf16(bflo(gg.w) * h1.z, bfhi(gg.w) * h1.w);
                *(uint4*)(YY + (size_t)t * RNN_W + ch0 + 8 * c8) = pk; } }
    }
}
template <bool FINAL>
DEVI void rglru_phase(const bf16_t* __restrict__ XR, const bf16_t* __restrict__ GATEg, const bf16_t* __restrict__ Wta, const bf16_t* __restrict__ Wtx,
                      const float* __restrict__ cw, const float* __restrict__ cb, const float* __restrict__ ba, const float* __restrict__ bx, const float* __restrict__ lam,
                      float* __restrict__ Aend, float* __restrict__ Hend, const float* __restrict__ CIN, bf16_t* __restrict__ YY, unsigned char* lds) {
    const int tid = otid(), lane = tid & 63, w = tid >> 6, col = lane & 15, quad = lane >> 4;
    const int G = gridDim.x, nb = blockIdx.x % RNN_NB, rank = blockIdx.x / RNN_NB, nblk = (G - nb + RNN_NB - 1) / RNN_NB;
    const int ch0 = nb * RNN_BW, ch = ch0 + 16 * w + col;
    float* cwl = (float*)(lds + 64 * 136 * 2 + 64 * 132 * 4);
    __syncthreads();
    for (int i = tid; i < 640; i += NTHREADS) cwl[i] = i < 512 ? cw[(i >> 7) * RNN_W + ch0 + (i & 127)] : cb[ch0 + (i - 512)];
    bf16x8_t fa[4], fx[4];
    { const size_t wrow = ((size_t)nb * 128 + 16 * w + col) * 128 + 8 * quad;
#pragma unroll
      for (int ks = 0; ks < 4; ++ks) { fa[ks] = *(const bf16x8_t*)(Wta + wrow + 32 * ks); fx[ks] = *(const bf16x8_t*)(Wtx + wrow + 32 * ks); } }
    const float bav = ba[ch], bxv = bx[ch], sp = log1pf(expf(-lam[ch]));
    RgIn Ra, Rb;
    int c = rank;
    if (c < NCHUNK) rglru_fetch(c, ch0, XR, tid, Ra);
    while (c < NCHUNK) {
        int cn = c + nblk;
        if (cn < NCHUNK) rglru_fetch(cn, ch0, XR, tid, Rb);
        rglru_unit<FINAL>(c, nb, Ra, fa, fx, bav, bxv, sp, GATEg, Aend, Hend, CIN, YY, lds, tid);
        c = cn; if (c >= NCHUNK) break;
        cn = c + nblk;
        if (cn < NCHUNK) rglru_fetch(cn, ch0, XR, tid, Ra);
        rglru_unit<FINAL>(c, nb, Rb, fa, fx, bav, bxv, sp, GATEg, Aend, Hend, CIN, YY, lds, tid);
        c = cn;
    }
    __syncthreads();
}

constexpr int SW = 544;
constexpr int CB = 512;
constexpr int NTILE = L / 16;
typedef float f32x16 __attribute__((ext_vector_type(16)));
typedef float f32x2v __attribute__((ext_vector_type(2)));
constexpr int HROW = 2112;
constexpr int IL_HIST = 0, IL_CKEY = 0, IL_CIDX = 16 * CB * 4, IL_HIST2 = 2 * 16 * CB * 4, IL_ROWS = IL_HIST2 + 16 * 256 * 4, IL_WI = 16 * HROW * 4, IL_QST = IL_WI + 512, IL_QST2 = IL_QST + 256, IL_CCNT = IL_QST2 + 256, IL_FLAG = IL_CCNT + 64;
constexpr int IL_QF = IL_ROWS + 16 * SW * 4;
static_assert(IL_QF + 8 * 512 <= IL_WI && IL_FLAG + 64 <= LDS_BYTES - 16, "indexer LDS");

constexpr int AW_BYTES = 512;
typedef short s16x2 __attribute__((ext_vector_type(2)));
DEVI float dot2bf(unsigned a, unsigned b, float c) { return __builtin_amdgcn_fdot2_f32_bf16(__builtin_bit_cast(s16x2, a), __builtin_bit_cast(s16x2, b), c, false); }
#define LDS_FENCE() asm volatile("s_waitcnt lgkmcnt(0)" ::: "memory")

struct AttnQ { float m, l, o[8]; };

DEVI void attn_issue(int b0, int n, const unsigned short* lst, const unsigned char* __restrict__ KV8, int lane, uint4 (&kv)[8]) {
    const int last = n - 1;
#pragma unroll
    for (int kk = 0; kk < 8; ++kk) { const int ii = b0 + kk; const int key = lst[ii < last ? ii : last]; kv[kk] = *(const uint4*)(KV8 + (size_t)key * 1024 + lane * 16); }
}
DEVI void attn_compute(AttnQ& S, int b0, int n, const float (&q)[8], const uint4 (&kv)[8]) {
    float sc[8]; float mx = S.m;
#pragma unroll
    for (int u = 0; u < 8; ++u) {
        const f32x2v k0 = __builtin_amdgcn_cvt_pk_f32_fp8((int)kv[u].x, false), k1 = __builtin_amdgcn_cvt_pk_f32_fp8((int)kv[u].x, true),
                     k2 = __builtin_amdgcn_cvt_pk_f32_fp8((int)kv[u].y, false), k3 = __builtin_amdgcn_cvt_pk_f32_fp8((int)kv[u].y, true);
        f32x2v d2 = k0 * (f32x2v){q[0], q[1]}; d2 = k1 * (f32x2v){q[2], q[3]} + d2; d2 = k2 * (f32x2v){q[4], q[5]} + d2; d2 = k3 * (f32x2v){q[6], q[7]} + d2;
        float d = d2[0] + d2[1];
        d += dpp_f<0xB1>(d); d += dpp_f<0x4E>(d); d += dpp_f<0x141>(d);
        sc[u] = (b0 + u < n) ? d : -INFINITY;
        mx = fmaxf(mx, sc[u]); }
    const float scale = __builtin_amdgcn_exp2f(S.m - mx);
    float ls = S.l * scale;
#pragma unroll
    for (int i = 0; i < 8; ++i) S.o[i] *= scale;
#pragma unroll
    for (int u = 0; u < 8; ++u) {
        const float p = __builtin_amdgcn_exp2f(sc[u] - mx); ls += p;
        const f32x2v v0 = __builtin_amdgcn_cvt_pk_f32_fp8((int)kv[u].z, false), v1 = __builtin_amdgcn_cvt_pk_f32_fp8((int)kv[u].z, true),
                     v2 = __builtin_amdgcn_cvt_pk_f32_fp8((int)kv[u].w, false), v3 = __builtin_amdgcn_cvt_pk_f32_fp8((int)kv[u].w, true);
        S.o[0] += p * v0[0]; S.o[1] += p * v0[1]; S.o[2] += p * v1[0]; S.o[3] += p * v1[1]; S.o[4] += p * v2[0]; S.o[5] += p * v2[1]; S.o[6] += p * v3[0]; S.o[7] += p * v3[1]; }
    S.l = ls; S.m = mx;
}

DEVI void attn_query(int t, const bf16_t* __restrict__ Qb, const unsigned char* __restrict__ KV8,
                     const unsigned* SR  , bf16_t* __restrict__ AO, unsigned char* wl, int lane) {
    unsigned short* lst = (unsigned short*)wl;
    LDS_FENCE();
    const int nw = (t >> 5) + 1; int base = 0;
    for (int w0 = 0; w0 < nw; w0 += 64) {
        const int wi = w0 + lane; const unsigned wv = wi < nw ? SR[wi] : 0u;
        const int pc = __popc(wv); int pre = pc;
#pragma unroll
        for (int off = 1; off < 64; off <<= 1) { const int o_ = __shfl_up(pre, off); if (lane >= off) pre += o_; }
        int pos = base + pre - pc; unsigned mm = wv;
        while (mm) { const int bpos = __ffs((int)mm) - 1; mm &= mm - 1u; if (pos < TOPK) lst[pos] = (unsigned short)(wi * 32 + bpos); ++pos; }
        base += __shfl(pre, 63);
    }
    const int n = base < TOPK ? base : TOPK;
    float q[8];
    { const uint4 qv = ((const uint4*)(Qb + (size_t)t * 512))[lane]; const float qs = 0.18033688011112042f;
      q[0] = bflo(qv.x) * qs; q[1] = bfhi(qv.x) * qs; q[2] = bflo(qv.y) * qs; q[3] = bfhi(qv.y) * qs; q[4] = bflo(qv.z) * qs; q[5] = bfhi(qv.z) * qs; q[6] = bflo(qv.w) * qs; q[7] = bfhi(qv.w) * qs; }
    LDS_FENCE();
    AttnQ S; S.m = -INFINITY; S.l = 0.f;
#pragma unroll
    for (int d = 0; d < 8; ++d) S.o[d] = 0.f;
    uint4 ka[8], kb_[8], kc[8];
    attn_issue(0, n, lst, KV8, lane, ka);
    if (8 < n) attn_issue(8, n, lst, KV8, lane, kb_);
    for (int b0 = 0; b0 < n; b0 += 24) {
        if (b0 + 16 < n) attn_issue(b0 + 16, n, lst, KV8, lane, kc);
        attn_compute(S, b0, n, q, ka);
        if (b0 + 8 < n) {
            if (b0 + 24 < n) attn_issue(b0 + 24, n, lst, KV8, lane, ka);
            attn_compute(S, b0 + 8, n, q, kb_);
            if (b0 + 16 < n) {
                if (b0 + 32 < n) attn_issue(b0 + 32, n, lst, KV8, lane, kb_);
                attn_compute(S, b0 + 16, n, q, kc);
            }
        }
    }
    const int hd = lane >> 3, ch = lane & 7;
    const float inv = 1.0f / S.l;
    uint4 pk; pk.x = cvt_pk_bf16(S.o[0] * inv, S.o[1] * inv); pk.y = cvt_pk_bf16(S.o[2] * inv, S.o[3] * inv); pk.z = cvt_pk_bf16(S.o[4] * inv, S.o[5] * inv); pk.w = cvt_pk_bf16(S.o[6] * inv, S.o[7] * inv);
    *(uint4*)(AO + (size_t)t * 1024 + 512 + hd * 64 + ch * 8) = pk;
}

DEVI float relu_i(float x) { const int v = __float_as_int(x); return __int_as_float(v > 0 ? v : 0); }
DEVI int hpos(unsigned w) { return (int)(w + (w >> 5)); }
template <int PASS, bool L0>
DEVI void idx_sweep(int q0, int nkb, int wave, int lane, const bf16x8_t (&Af)[4][4], const bf16_t* __restrict__ KI, unsigned char* lds, unsigned* __restrict__ SELM) {
    const int l31 = lane & 31, h2 = lane >> 5;
    unsigned* hist = (unsigned*)(lds + IL_HIST);
    const float* wiL = (const float*)(lds + IL_WI);
    const uint4* qst = (const uint4*)(lds + IL_QST);
    const uint4* qst2 = (const uint4*)(lds + IL_QST2);
    unsigned* ckey = (unsigned*)(lds + IL_CKEY); unsigned* cidx = (unsigned*)(lds + IL_CIDX); unsigned* ccnt = (unsigned*)(lds + IL_CCNT); unsigned* rows = (unsigned*)(lds + IL_ROWS);
    const bf16_t* kp = KI + (size_t)l31 * 64 + 8 * h2;
    bf16x8_t Bn[4];
    if (wave < nkb) {
#pragma unroll
        for (int ks = 0; ks < 4; ++ks) Bn[ks] = *(const bf16x8_t*)(kp + (size_t)wave * 2048 + 16 * ks); }
    for (int kb = wave; kb < nkb; kb += 8) {
        const int s = kb * 32 + l31;
        bf16x8_t Bf[4];
#pragma unroll
        for (int ks = 0; ks < 4; ++ks) Bf[ks] = Bn[ks];
        if (kb + 8 < nkb) {
#pragma unroll
            for (int ks = 0; ks < 4; ++ks) Bn[ks] = *(const bf16x8_t*)(kp + (size_t)(kb + 8) * 2048 + 16 * ks); }
        f32x16 acc[4];
#pragma unroll
        for (int rb = 0; rb < 4; ++rb) {
#pragma unroll
            for (int i = 0; i < 16; ++i) acc[rb][i] = 0.f; }
#pragma unroll
        for (int ks = 0; ks < 4; ++ks)
#pragma unroll
            for (int rb = 0; rb < 4; ++rb) acc[rb] = __builtin_amdgcn_mfma_f32_32x32x16_bf16(Af[rb][ks], Bf[ks], acc[rb], 0, 0, 0);
        const bool edge = kb * 32 + 31 > q0;
#pragma unroll
        for (int rb = 0; rb < 4; ++rb) {
            const int qa = 4 * rb + 2 * h2;
            float4 w[2][2]; uint4 st[2];
#pragma unroll
            for (int e = 0; e < 2; ++e) { w[e][0] = *(const float4*)(wiL + (qa + e) * 8); w[e][1] = *(const float4*)(wiL + (qa + e) * 8 + 4);
                if (PASS == 2) st[e] = qst2[qa + e]; else if (!L0) st[e] = qst[qa + e]; }
#pragma unroll
            for (int e = 0; e < 2; ++e) {
                const int qs = qa + e;
                f32x2v s2 = (f32x2v){relu_i(acc[rb][8 * e + 0]), relu_i(acc[rb][8 * e + 1])} * (f32x2v){w[e][0].x, w[e][0].y};
                s2 = (f32x2v){relu_i(acc[rb][8 * e + 2]), relu_i(acc[rb][8 * e + 3])} * (f32x2v){w[e][0].z, w[e][0].w} + s2;
                s2 = (f32x2v){relu_i(acc[rb][8 * e + 4]), relu_i(acc[rb][8 * e + 5])} * (f32x2v){w[e][1].x, w[e][1].y} + s2;
                s2 = (f32x2v){relu_i(acc[rb][8 * e + 6]), relu_i(acc[rb][8 * e + 7])} * (f32x2v){w[e][1].z, w[e][1].w} + s2;
                const float sc = s2[0] + s2[1];
                const bool valid = !edge || s <= q0 + qs;
                const unsigned key = f2key(sc);
                if (PASS == 1) {
                    if (L0) { if (valid) { const unsigned bin = key >> 20; atomicAdd(&hist[qs * HROW + hpos(bin >> 1)], (bin & 1u) ? 0x10000u : 1u); } }
                    else if (valid && (key & st[e].x) == st[e].y) { const unsigned bin = (key >> st[e].z) & st[e].w; atomicAdd(&hist[qs * HROW + hpos(bin >> 1)], (bin & 1u) ? 0x10000u : 1u); }
                } else {
                    const bool all = st[e].z == 0xFFFFFFFFu;
                    const bool sel = valid && (all || key >= st[e].y);
                    const bool cnd = valid && !all && key >= st[e].x && key < st[e].y;
                    const unsigned long long bal = __ballot(sel);
                    if (l31 == 0) rows[qs * SW + kb] = h2 ? (unsigned)(bal >> 32) : (unsigned)bal;
                    if (cnd) { const unsigned n = atomicAdd(&ccnt[qs], 1u); if (n < (unsigned)CB) { ckey[qs * CB + n] = key; cidx[qs * CB + n] = (unsigned)s; } }
                }
            }
        }
    }
}

DEVI void indexer_tile(int q0, const bf16_t* __restrict__ QI, const bf16_t* __restrict__ KI, const float* __restrict__ WI, const bf16_t* __restrict__ Qb, const unsigned char* __restrict__ KV8, bf16_t* __restrict__ AO, unsigned char* lds) {
    const int tid = otid(), lane = tid & 63, wave = tid >> 6;
    unsigned* hist = (unsigned*)(lds + IL_HIST);
    float* wiL = (float*)(lds + IL_WI);
    uint4* qst = (uint4*)(lds + IL_QST); uint4* qst2 = (uint4*)(lds + IL_QST2);
    unsigned* ckey = (unsigned*)(lds + IL_CKEY); unsigned* cidx = (unsigned*)(lds + IL_CIDX); unsigned* hist2 = (unsigned*)(lds + IL_HIST2); unsigned* ccnt = (unsigned*)(lds + IL_CCNT);
    volatile unsigned* flag = (volatile unsigned*)(lds + IL_FLAG);
    const int nkb = (q0 + 16 + 31) >> 5;
    bf16x8_t Af[4][4];
    { const int rho = lane & 31, hq = lane >> 5; const int qq = 2 * ((rho >> 2) & 1) + (rho >> 4), head = 4 * ((rho >> 3) & 1) + (rho & 3);
#pragma unroll
      for (int rb = 0; rb < 4; ++rb)
#pragma unroll
          for (int ks = 0; ks < 4; ++ks) Af[rb][ks] = *(const bf16x8_t*)(QI + (size_t)(q0 + 4 * rb + qq) * 512 + head * 64 + 16 * ks + 8 * hq); }
    __syncthreads();
    if (tid < 128) wiL[tid] = WI[(size_t)q0 * 8 + tid] * 0.125f;
    if (tid < 16) { qst[tid] = make_uint4(0u, 0u, 20u, 4095u); qst2[tid] = make_uint4(0u, 0u, (unsigned)TOPK, 0u); ccnt[tid] = 0u; }
    for (int level = 0; level < 3; ++level) {
        for (int i = tid; i < 16 * HROW / 4; i += NTHREADS) ((uint4*)hist)[i] = make_uint4(0u, 0u, 0u, 0u);
        if (tid == 0) flag[0] = 0u;
        __syncthreads();
        if (level == 0) idx_sweep<1, true>(q0, nkb, wave, lane, Af, KI, lds, nullptr); else idx_sweep<1, false>(q0, nkb, wave, lane, Af, KI, lds, nullptr);
        __syncthreads();
#pragma unroll 1
        for (int qi = 0; qi < 2; ++qi) {
            const int qs = 2 * wave + qi;
            const uint4 st = qst[qs]; const uint4 b = qst2[qs];
            if (st.x == 0xFFFFFFFFu && st.y == 0u && st.w == 0u) continue;
            unsigned wv[32]; unsigned loc = 0u;
#pragma unroll
            for (int i = 0; i < 32; ++i) { wv[i] = hist[qs * HROW + 33 * lane + i]; loc += (wv[i] & 0xFFFFu) + (wv[i] >> 16); }
            unsigned suf = loc;
#pragma unroll
            for (int off = 1; off < 64; off <<= 1) { const unsigned o = __shfl_down(suf, off); if (lane + off < 64) suf += o; }
            const unsigned total = __shfl(suf, 0), above = suf - loc, need = b.z;
            if (level == 0 && total <= need) { if (lane == 0) { qst[qs] = make_uint4(0xFFFFFFFFu, 0u, 0u, 0u); qst2[qs] = make_uint4(0u, 0u, 0xFFFFFFFFu, 0u); } continue; }
            const bool mine = above < need && need <= above + loc;
            unsigned cum = above, c = 0u; int d = 0; bool found = false;
#pragma unroll
            for (int i = 31; i >= 0; --i) {
                const unsigned chi = wv[i] >> 16, clo = wv[i] & 0xFFFFu;
                if (!found && cum + chi >= need) { found = true; d = 64 * lane + 2 * i + 1; c = chi; } if (!found) cum += chi;
                if (!found && cum + clo >= need) { found = true; d = 64 * lane + 2 * i; c = clo; } if (!found) cum += clo; }
            if (mine) {
                const unsigned pval = st.y | ((unsigned)d << st.z), pmask = st.x | (st.w << st.z);
                const unsigned nneed = need - cum;
                const unsigned long long hi64 = (unsigned long long)pval + (1ull << st.z);
                const unsigned hi = hi64 > 0xFFFFFFFFull ? 0xFFFFFFFFu : (unsigned)hi64;
                if (c <= (unsigned)CB || level == 2) { qst[qs] = make_uint4(0xFFFFFFFFu, 0u, 0u, 0u); qst2[qs] = make_uint4(pval, hi, nneed, st.z); }
                else { const unsigned nsh = (level == 0) ? 8u : 0u, ndm = (level == 0) ? 4095u : 255u; qst[qs] = make_uint4(pmask, pval, nsh, ndm); qst2[qs] = make_uint4(pval, hi, nneed, st.z); flag[0] = 1u; }
            }
        }
        __syncthreads();
        if (flag[0] == 0u) break;
        __syncthreads();
    }
    __syncthreads();
    idx_sweep<2, false>(q0, nkb, wave, lane, Af, KI, lds, nullptr);
    asm volatile("s_waitcnt vmcnt(0)" ::: "memory");
    __syncthreads();
    unsigned* rows = (unsigned*)(lds + IL_ROWS);
#pragma unroll 1
    for (int qi = 0; qi < 2; ++qi) {
        const int qs = 2 * wave + qi;
        const uint4 b = qst2[qs];
        unsigned* row = rows + qs * SW;
        if (b.z != 0xFFFFFFFFu) {
            const unsigned need = b.z; const unsigned cn = ccnt[qs]; const int n = (int)(cn < (unsigned)CB ? cn : (unsigned)CB);
            const unsigned rem = b.w;
            const unsigned sh8 = rem > 8u ? rem - 8u : 0u; const unsigned m8 = rem >= 8u ? 255u : ((1u << rem) - 1u);
#pragma unroll
            for (int i = 0; i < 4; ++i) hist2[qs * 256 + 4 * lane + i] = 0u;
            asm volatile("s_waitcnt lgkmcnt(0)" ::: "memory");
            for (int i = lane; i < n; i += 64) atomicAdd(&hist2[qs * 256 + ((ckey[qs * CB + i] >> sh8) & m8)], 1u);
            asm volatile("s_waitcnt lgkmcnt(0)" ::: "memory");
            unsigned c4[4]; unsigned loc = 0u;
#pragma unroll
            for (int i = 0; i < 4; ++i) { c4[i] = hist2[qs * 256 + 4 * lane + i]; loc += c4[i]; }
            unsigned suf = loc;
#pragma unroll
            for (int off = 1; off < 64; off <<= 1) { const unsigned o = __shfl_down(suf, off); if (lane + off < 64) suf += o; }
            const unsigned above = suf - loc;
            const bool mine = above < need && need <= above + loc;
            unsigned b2 = 0u, need2 = 0u;
            if (mine) { unsigned cum = above; int i = 3; for (; i > 0; --i) { if (cum + c4[i] >= need) break; cum += c4[i]; } b2 = 4u * lane + i; need2 = need - cum; }
            const unsigned long long mb = __ballot(mine);
            if (mb == 0ull) {
                for (int i = lane; i < n; i += 64) if ((unsigned)i < need) { const unsigned ii = cidx[qs * CB + i]; atomicOr(&row[ii >> 5], 1u << (ii & 31u)); }
            } else {
                const int src = __ffsll((long long)mb) - 1;
                b2 = __shfl(b2, src); need2 = __shfl(need2, src);
                for (int i0 = 0; i0 < n; i0 += 64) {
                    const int i = i0 + lane; const bool act = i < n;
                    const unsigned ki = act ? ckey[qs * CB + i] : 0u, ii = act ? cidx[qs * CB + i] : 0u; const unsigned d8 = (ki >> sh8) & m8;
                    if (act && d8 > b2) atomicOr(&row[ii >> 5], 1u << (ii & 31u));
                    unsigned long long tie = __ballot(act && d8 == b2);
                    while (tie) {
                        const int ml = __ffsll((long long)tie) - 1; tie &= tie - 1ull;
                        const unsigned km = __shfl(ki, ml), im = __shfl(ii, ml);
                        unsigned rank = 0u;
                        for (int j0 = 0; j0 < n; j0 += 64) { const int j = j0 + lane; bool beats = false;
                            if (j < n) { const unsigned kj = ckey[qs * CB + j], ij = cidx[qs * CB + j]; beats = ((kj >> sh8) & m8) == b2 && (kj > km || (kj == km && ij < im)); }
                            rank += (unsigned)__popcll(__ballot(beats)); }
                        if (rank < need2 && lane == ml) atomicOr(&row[im >> 5], 1u << (im & 31u));
                    }
                }
            }
        }
    }
    asm volatile("s_waitcnt lgkmcnt(0)" ::: "memory");
    __syncthreads();
    for (int qi = 0; qi < 2; ++qi) { const int qs = 2 * wave + qi;
        attn_query(q0 + qs, Qb, KV8, rows + qs * SW, AO, lds + IL_QF + wave * 512, lane); }
}

DEVI TrJob moe_job(int j, const float* wg, const float* wu, const float* wd, bf16_t* WGU, bf16_t* WD) {
    TrJob J{};
    if (j < 32 * 256) { const int e = j >> 8, t = j & 255; J.dst = WGU + (size_t)e * 1024 * 1024; J.s0 = wg + (size_t)e * D * DE; J.s1 = wu + (size_t)e * D * DE; J.K = 1024; J.n0 = (t >> 4) * 64; J.k0 = (t & 15) * 64; J.mode = 2; return J; }
    j -= 32 * 256;
    { const int e = j >> 7, t = j & 127; J.dst = WD + (size_t)e * 1024 * 512; J.s0 = wd + (size_t)e * DE * D; J.ld = D; J.K = 512; J.n0 = (t >> 3) * 64; J.k0 = (t & 7) * 64; J.mode = 0; return J; }
}
constexpr int MOE0_ALL = 32 * 256 + 32 * 128, MOE0_P1W = 28, MOE0_P4W = 10;
constexpr int P1_BUSY = (LP / 256) * 13 - 3 * 256, P4_BUSY = (LP / 256) * 4 - 256;
constexpr int MOE0_P7 = 2688;
constexpr int MOE0_P1 = (256 - P1_BUSY) * MOE0_P1W, MOE0_P4 = (256 - P4_BUSY) * MOE0_P4W, MOE0_P0 = MOE0_ALL - MOE0_P1 - MOE0_P4 - MOE0_P7;
static_assert(MOE0_P0 > 0 && P1_BUSY == 77 && P4_BUSY == 4 && MOE0_P0 + MOE0_P1 + MOE0_P4 >= 32 * 256, "tail split (the P7 tail may only write WD)");
constexpr int P10_BUSY = (LP / 256) * 10 - 2 * 256;
constexpr int MOE1_P8 = 1536, MOE1_P10 = (256 - P10_BUSY) * 25, MOE1_P15 = MOE0_ALL - MOE1_P8 - MOE1_P10;
static_assert(P10_BUSY == 138 && MOE1_P8 <= 32 * 256 && MOE1_P15 > 0, "tail split, layer 1");
DEVI void moe_idle(const int* mtiles, int& rank, int& cnt) { const int G = (int)gridDim.x, nun = mtiles[0] * 4, busy = nun % G;
    if (busy == 0) { rank = (int)blockIdx.x; cnt = G; } else { rank = (int)blockIdx.x - busy; cnt = G - busy; } }

__global__ void __launch_bounds__(NTHREADS, 2) fwd(Args a) {
    extern __shared__ __attribute__((aligned(16))) unsigned char lds_raw[];
    float* smf = (float*)lds_raw;
    PG8_LAS unsigned char* ldsp = (PG8_LAS unsigned char*)lds_raw;
    const int nwaves = gridDim.x * 8;
#define PHASE_VARS const int tid = otid(); const int lane = tid & 63, wave = tid >> 6; const int gwave = blockIdx.x * 8 + wave; (void)lane; (void)wave; (void)gwave;
    unsigned char* ws = a.ws;
    unsigned* ctl = (unsigned*)(ws + WS_CTL);
    const int lo = a.ph_lo, hi = a.ph_hi;

    volatile LAS unsigned* bst = (volatile LAS unsigned*)((LAS unsigned char*)lds_raw + (LDS_BYTES - 16));
    if (threadIdx.x == 0) { bst[0] = 0u; bst[1] = 0u; bst[2] = 0u; bst[3] = 0u; }
    __syncthreads();
    XcdBarrier bar; bar.bar = ctl; bar.x = 0; bar.st = bst;
    if (hi - lo > 1) bar = xcd_barrier_post(ctl, bst);
#define IN(k) (lo <= (k) && (k) < hi)
#define SEAM(k) do { if (IN(k) && IN((k) + 1)) xcd_barrier(bar); } while (0)

    const float* x = a.in[0]; const float* meta = a.in[1];
    float* ropeC = (float*)(ws + WS_ROPEC); float* ropeS = (float*)(ws + WS_ROPES);
    int* eid = (int*)(ws + WS_EID); float* gw = (float*)(ws + WS_GW); int* slot = (int*)(ws + WS_SLOT); int* mtiles = (int*)(ws + WS_MTILES);
    unsigned* counts0 = (unsigned*)(ws + CTL_CNT); unsigned* counts1 = counts0 + 32;
    unsigned* cursor0 = (unsigned*)(ws + CTL_CUR); unsigned* cursor1 = cursor0 + 32;
    bf16_t* Wta = (bf16_t*)(ws + WS_WTA); bf16_t* Wtx = (bf16_t*)(ws + WS_WTX);
    float* Aend = (float*)(ws + WS_AEND); float* Hend = (float*)(ws + WS_HEND); float* CIN = (float*)(ws + WS_CIN);
    unsigned char* big = ws + WS_BIG;
    bf16_t* WIN0 = (bf16_t*)(big + R_WIN0); bf16_t* WOUT0 = (bf16_t*)(big + R_WOUT0); bf16_t* WGU = (bf16_t*)(big + R_WGU); bf16_t* WD = (bf16_t*)(big + R_WD);
    bf16_t* WIN1 = (bf16_t*)(big + R_WIN1); bf16_t* WOUT1 = (bf16_t*)(big + R_WOUT1);
    bf16_t* X0b = (bf16_t*)(big + R_A); bf16_t* AO = (bf16_t*)(big + R_A); bf16_t* Xperm = (bf16_t*)(big + R_A); bf16_t* X2b = (bf16_t*)(big + R_A); bf16_t* YY = (bf16_t*)(big + R_A);
    float* H1 = (float*)(big + R_H1); float* H3 = (float*)(big + R_H1); float* H2 = (float*)(big + R_H2); unsigned* SELM = (unsigned*)(big + R_H1); unsigned* SELM2 = (unsigned*)(big + R_H1 + 36 * MiB);
    float* Z = (float*)(big + R_C); bf16_t* Yb = (bf16_t*)(big + R_C); float* Z1 = (float*)(big + R_C);
    unsigned char* KV8 = big + R_K;
    bf16_t* GLU = (bf16_t*)(big + R_GLU); bf16_t* Qb = (bf16_t*)(big + R_Q); bf16_t* Kb = (bf16_t*)(big + R_K); bf16_t* Vb = (bf16_t*)(big + R_V);
    bf16_t* QIb = (bf16_t*)(big + R_QI); bf16_t* KIb = (bf16_t*)(big + R_KI); float* WIf = (float*)(big + R_WI);
    bf16_t* GATEg = (bf16_t*)(big + R_GATE); bf16_t* XRb = (bf16_t*)(big + R_XR);
    bf16_t* Hm = (bf16_t*)(big + R_HM);

    if (IN(0)) { PHASE_VARS;
        const float* w_in = a.in[2]; const float* w_out = a.in[7]; const float* wg = a.in[21]; const float* wu = a.in[22]; const float* wd = a.in[23];
        constexpr int J_IN0 = 52 * 16, J_OUT0 = 16 * 16, J_GU = 32 * 256, J_D = 32 * 128, J_IN1 = 40 * 16, J_OUT1 = 16 * 20, J_GT = 80;
        const float* w_in1 = a.in[8]; const float* w_out1 = a.in[16]; const float* wga = a.in[11]; const float* wgx = a.in[13];
        const int moe_p0 = gridDim.x == 256 ? MOE0_P0 : MOE0_ALL;
        tr_run(J_IN0 + J_OUT0 + moe_p0 + J_IN1 + J_OUT1 + J_GT, [&](int j) -> TrJob {
            TrJob J{};
            if (j < J_IN0) { J.dst = WIN0; J.s0 = w_in; J.K = 1024; J.n0 = (j >> 4) * 64; J.k0 = (j & 15) * 64; J.mode = 1; return J; }
            j -= J_IN0;
            if (j < J_OUT0) { J.dst = WOUT0; J.s0 = w_out; J.ld = D; J.K = 1024; J.n0 = (j >> 4) * 64; J.k0 = (j & 15) * 64; J.mode = 0; return J; }
            j -= J_OUT0;
            if (j < moe_p0) return moe_job(j, wg, wu, wd, WGU, WD);
            j -= moe_p0;
            if (j < J_IN1) { J.dst = WIN1; J.s0 = w_in1; J.ld = 2 * RNN_W; J.K = 1024; J.n0 = (j >> 4) * 64; J.k0 = (j & 15) * 64; J.mode = 0; return J; }
            j -= J_IN1;
            if (j < J_OUT1) { J.dst = WOUT1; J.s0 = w_out1; J.ld = D; J.K = RNN_W; J.n0 = (j / 20) * 64; J.k0 = (j % 20) * 64; J.mode = 0; return J; }
            j -= J_OUT1;
            { const int which = j / 40, r = j % 40; const int nb = r >> 2;
              J.dst = (which ? Wtx : Wta) + (size_t)nb * 128 * 128; J.s0 = (which ? wgx : wga) + (size_t)nb * 128 * 128; J.ld = 128; J.K = 128; J.n0 = ((r >> 1) & 1) * 64; J.k0 = (r & 1) * 64; J.mode = 0; return J; }
        }, smf);
        for (size_t i = (size_t)blockIdx.x * NTHREADS + tid; i < (size_t)LP * 256; i += (size_t)gridDim.x * NTHREADS) {
            const size_t r = i >> 8, c4 = i & 255;
            float4 v = make_float4(0.f, 0.f, 0.f, 0.f);
            if (r < NMETA) v = ((const float4*)meta)[r * 256 + c4]; else if (r < L) v = ((const float4*)x)[(r - NMETA) * 256 + c4];
            ((uint2*)X0b)[i] = make_uint2(cvt_pk_bf16(v.x, v.y), cvt_pk_bf16(v.z, v.w));
        }
        for (int i = blockIdx.x * NTHREADS + tid; i < 2 * 64 * 3 * 64; i += gridDim.x * NTHREADS) {
            const int ln = i & 63, ct = (i >> 6) % 3, ss = (i / 192) & 63, ly = i / (192 * 64);
            const int col = 16 * ct + (ln & 15), k0 = 16 * ss + 4 * (ln >> 4);
            float v[4];
#pragma unroll
            for (int j = 0; j < 4; ++j) v[j] = col < 4 ? a.in[17][(size_t)ly * D * NGRP + (size_t)(k0 + j) * NGRP + col] : col < 36 ? a.in[19][(size_t)ly * D * NE + (size_t)(k0 + j) * NE + (col - 4)] : 0.f;
            ((float4*)(ws + WS_WR))[i] = make_float4(v[0], v[1], v[2], v[3]);
        }
        for (int i = blockIdx.x * NTHREADS + tid; i < LP * 32; i += gridDim.x * NTHREADS) {
            const int p = i >> 5, f = i & 31;
            const float inv = (float)pow(10000.0, -(double)f / 32.0);
            const float ang = (float)p * inv;
            ropeC[i] = (float)cos((double)ang); ropeS[i] = (float)sin((double)ang);
        }
    }
    SEAM(0);
    if (IN(1)) { PHASE_VARS;
        pg8::Gemm g{X0b, WIN0, LP, 3328, 1024}; pg8::StaticOrder S; S.init(LP, 3328, (int)gridDim.x, (int)blockIdx.x);
        EpiIn0 E{GLU, KIb, WIf, ropeC, ropeS, KV8};
        pg8::gemm_phase<EpiIn0, pg8::StaticOrder, GEMM_ALIGN, GEMM_SP2>(ldsp, g, S, E);
        if (gridDim.x == 256 && (int)blockIdx.x >= P1_BUSY) { __syncthreads();
            tr_run(MOE0_P1, [&](int j) -> TrJob { return moe_job(MOE0_P0 + j, a.in[21], a.in[22], a.in[23], WGU, WD); }, smf, (int)blockIdx.x - P1_BUSY, 256 - P1_BUSY); }
    }
    SEAM(1);
    if (IN(2)) { PHASE_VARS;
        const float* cw = a.in[3]; const float* cb = a.in[4]; const float* lg = a.in[5]; const float* lb = a.in[6];
        for (int g4 = gwave; g4 < L / 4; g4 += nwaves) {
            const int t0 = g4 * 4, c0 = lane * 8;
            float acc[4][8], wwin[4][8];
            { const float4 b0 = *(const float4*)(cb + c0), b1 = *(const float4*)(cb + c0 + 4);
#pragma unroll
              for (int q = 0; q < 4; ++q) { acc[q][0] = b0.x; acc[q][1] = b0.y; acc[q][2] = b0.z; acc[q][3] = b0.w; acc[q][4] = b1.x; acc[q][5] = b1.y; acc[q][6] = b1.z; acc[q][7] = b1.w; } }
#pragma unroll
            for (int r = 0; r < CONV_K + 3; ++r) {
                const int tt = t0 - (CONV_K - 1) + r;
                if (r < CONV_K) { const float4 w0 = *(const float4*)(cw + r * CONV_CH + c0), w1 = *(const float4*)(cw + r * CONV_CH + c0 + 4);
                    wwin[r & 3][0] = w0.x; wwin[r & 3][1] = w0.y; wwin[r & 3][2] = w0.z; wwin[r & 3][3] = w0.w; wwin[r & 3][4] = w1.x; wwin[r & 3][5] = w1.y; wwin[r & 3][6] = w1.z; wwin[r & 3][7] = w1.w; }
                if (tt >= 0) {
                    const uint4 xv = *(const uint4*)(GLU + (size_t)tt * 512 + c0);
                    const float x[8] = {bflo(xv.x), bfhi(xv.x), bflo(xv.y), bfhi(xv.y), bflo(xv.z), bfhi(xv.z), bflo(xv.w), bfhi(xv.w)};
#pragma unroll
                    for (int q = 0; q < 4; ++q) { const int j = r - q;
                        if (j >= 0 && j < CONV_K) {
#pragma unroll
                            for (int i = 0; i < 8; ++i) acc[q][i] += wwin[j & 3][i] * x[i]; } }
                }
            }
            float gv[8], bvv[8];
            { const float4 g0 = *(const float4*)(lg + c0), g1 = *(const float4*)(lg + c0 + 4), b0 = *(const float4*)(lb + c0), b1 = *(const float4*)(lb + c0 + 4);
              gv[0] = g0.x; gv[1] = g0.y; gv[2] = g0.z; gv[3] = g0.w; gv[4] = g1.x; gv[5] = g1.y; gv[6] = g1.z; gv[7] = g1.w; bvv[0] = b0.x; bvv[1] = b0.y; bvv[2] = b0.z; bvv[3] = b0.w; bvv[4] = b1.x; bvv[5] = b1.y; bvv[6] = b1.z; bvv[7] = b1.w; }
#pragma unroll
            for (int q = 0; q < 4; ++q) {
                float s_ = 0.f;
#pragma unroll
                for (int i = 0; i < 8; ++i) s_ += acc[q][i];
                const float mu = wave_sum(s_) * (1.0f / 512.0f);
                float qq = 0.f;
#pragma unroll
                for (int i = 0; i < 8; ++i) { const float d = acc[q][i] - mu; qq += d * d; }
                const float rstd = 1.0f / sqrtf(wave_sum(qq) * (1.0f / 512.0f) + LN_EPS);
                float o[8];
#pragma unroll
                for (int i = 0; i < 8; ++i) { const float yv = (acc[q][i] - mu) * rstd * gv[i] + bvv[i]; o[i] = yv * fsigm(yv); }
                uint4 w; w.x = cvt_pk_bf16(o[0], o[1]); w.y = cvt_pk_bf16(o[2], o[3]); w.z = cvt_pk_bf16(o[4], o[5]); w.w = cvt_pk_bf16(o[6], o[7]);
                *(uint4*)(AO + (size_t)(t0 + q) * 1024 + c0) = w;
            }
        }
        { const int b = (int)blockIdx.x, G = (int)gridDim.x; const int p = b & 3; const bool rev = (b >> 2) & 1;
          const int nfull = NTILE / G;
          for (int k = 0; k < nfull; ++k) {
              const int r = (nfull == 4) ? ((rev ? p - k : p + k) & 3) : k;
              const int idx = r * G + ((r & 1) ? G - 1 - b : b);
              indexer_tile((NTILE - 1 - idx) * 16, QIb, KIb, WIf, Qb, KV8, AO, lds_raw);
          }
          for (int idx = nfull * G + b; idx < NTILE; idx += G) indexer_tile((NTILE - 1 - idx) * 16, QIb, KIb, WIf, Qb, KV8, AO, lds_raw);
        }
    }
    SEAM(2);
    SEAM(3);
    if (IN(4)) { PHASE_VARS;
        pg8::Gemm g{AO, WOUT0, LP, 1024, 1024}; pg8::StaticOrder S; S.init(LP, 1024, (int)gridDim.x, (int)blockIdx.x);
        EpiRes0 E{x, meta, Z};
        pg8::gemm_phase<EpiRes0, pg8::StaticOrder, GEMM_ALIGN, GEMM_SP2>(ldsp, g, S, E);
        if (gridDim.x == 256 && (int)blockIdx.x >= P4_BUSY) { __syncthreads();
            tr_run(MOE0_P4, [&](int j) -> TrJob { return moe_job(MOE0_P0 + MOE0_P1 + j, a.in[21], a.in[22], a.in[23], WGU, WD); }, smf, (int)blockIdx.x - P4_BUSY, 256 - P4_BUSY); }
    }
    SEAM(4);
    if (IN(5)) {
        for (int blk = blockIdx.x; blk < SEQ / 64; blk += gridDim.x)
            ln_route_block(NMETA + 64 * blk, 64, Z, H1, a.in[24], a.in[25], (const float4*)(ws + WS_WR), a.in[18], a.in[20], eid, gw, counts0, smf);
        if (blockIdx.x == gridDim.x - 1)
            ln_route_block(0, NMETA, Z, H1, a.in[24], a.in[25], (const float4*)(ws + WS_WR), a.in[18], a.in[20], eid, gw, counts0, smf);
    }
    SEAM(5);
    if (IN(6)) { PHASE_VARS; moe_dispatch_mfma(H1, eid, counts0, cursor0, slot, mtiles, Xperm, (int*)lds_raw, gwave, nwaves, lane, 0); }
    SEAM(6);
    if (IN(7)) { PHASE_VARS;
        pg8::Gemm g{Xperm, WGU, MAXSLOT, 1024, 1024}; MoeOrder S; S.init(mtiles, (int)gridDim.x, (int)blockIdx.x);
        EpiGateUp E{Hm};
        pg8::gemm_phase<EpiGateUp, MoeOrder, GEMM_ALIGN, GEMM_SP2>(ldsp, g, S, E);
        if (gridDim.x == 256) { int rk, cn; moe_idle(mtiles, rk, cn); if (rk >= 0) { __syncthreads();
            tr_run(MOE0_P7, [&](int j) -> TrJob { return moe_job(MOE0_ALL - MOE0_P7 + j, a.in[21], a.in[22], a.in[23], WGU, WD); }, smf, rk, cn); } }
    }
    SEAM(7);
    if (IN(8)) { PHASE_VARS;
        pg8::Gemm g{Hm, WD, MAXSLOT, 1024, 512}; MoeOrder S; S.init(mtiles, (int)gridDim.x, (int)blockIdx.x);
        EpiDown E{Yb};
        pg8::gemm_phase<EpiDown, MoeOrder, GEMM_ALIGN, GEMM_SP2>(ldsp, g, S, E);
        if (gridDim.x == 256) { int rk, cn; moe_idle(mtiles, rk, cn); if (rk >= 0) { __syncthreads();
            tr_run(MOE1_P8, [&](int j) -> TrJob { return moe_job(j, a.in[21] + (size_t)NE * D * DE, a.in[22] + (size_t)NE * D * DE, a.in[23] + (size_t)NE * DE * D, WGU, WD); }, smf, rk, cn); } }
    }
    SEAM(8);
    if (IN(9)) { PHASE_VARS;
#pragma unroll 2
        for (int t = gwave; t < L; t += nwaves) {
            const int s0 = slot[2 * t], s1 = slot[2 * t + 1]; const float g0 = gw[2 * t], g1 = gw[2 * t + 1];
            float y[16];
            combine_row(y, H1 + (size_t)t * D, Yb + (size_t)s0 * D, Yb + (size_t)s1 * D, g0, g1, lane);
            ln_row1024v(y, a.in[26], a.in[27], lane);
#pragma unroll
            for (int i4 = 0; i4 < 4; ++i4) *(float4*)(H2 + (size_t)t * D + 16 * lane + 4 * i4) = make_float4(y[4 * i4], y[4 * i4 + 1], y[4 * i4 + 2], y[4 * i4 + 3]);
            uint4 p0, p1; p0.x = cvt_pk_bf16(y[0], y[1]); p0.y = cvt_pk_bf16(y[2], y[3]); p0.z = cvt_pk_bf16(y[4], y[5]); p0.w = cvt_pk_bf16(y[6], y[7]);
            p1.x = cvt_pk_bf16(y[8], y[9]); p1.y = cvt_pk_bf16(y[10], y[11]); p1.z = cvt_pk_bf16(y[12], y[13]); p1.w = cvt_pk_bf16(y[14], y[15]);
            *(uint4*)(X2b + (size_t)t * D + 16 * lane) = p0; *(uint4*)(X2b + (size_t)t * D + 16 * lane + 8) = p1;
        }
        for (int i = blockIdx.x * NTHREADS + tid; i < (LP - L) * D / 8; i += gridDim.x * NTHREADS) ((uint4*)(X2b + (size_t)L * D))[i] = make_uint4(0u, 0u, 0u, 0u);
    }
    SEAM(9);
    if (IN(10)) {
        pg8::Gemm g{X2b, WIN1, LP, 2 * RNN_W, 1024}; pg8::StaticOrder S; S.init(LP, 2 * RNN_W, (int)gridDim.x, (int)blockIdx.x);
        EpiIn1 E{GATEg};
        pg8::gemm_phase<EpiIn1, pg8::StaticOrder, GEMM_ALIGN, GEMM_SP2>(ldsp, g, S, E);
        if (gridDim.x == 256 && (int)blockIdx.x >= P10_BUSY) { __syncthreads();
            tr_run(MOE1_P10, [&](int j) -> TrJob { return moe_job(MOE1_P8 + j, a.in[21] + (size_t)NE * D * DE, a.in[22] + (size_t)NE * D * DE, a.in[23] + (size_t)NE * DE * D, WGU, WD); }, smf, (int)blockIdx.x - P10_BUSY, 256 - P10_BUSY); }
    }
    SEAM(10);
    if (IN(11)) rglru_phase<false>(XRb, GATEg, Wta, Wtx, a.in[9], a.in[10], a.in[12], a.in[14], a.in[15], Aend, Hend, CIN, YY, lds_raw);
    SEAM(11);
    if (IN(12)) { PHASE_VARS;
        for (int ch = gwave; ch < RNN_W; ch += nwaves) {
            float A[5], H[5];
#pragma unroll
            for (int i = 0; i < 5; ++i) { const int c = 5 * lane + i; const bool ok = c < NCHUNK; A[i] = ok ? Aend[(size_t)ch * CP + c] : 1.f; H[i] = ok ? Hend[(size_t)ch * CP + c] : 0.f; }
            float Al = 1.f, Hl = 0.f;
#pragma unroll
            for (int i = 0; i < 5; ++i) { Hl = A[i] * Hl + H[i]; Al *= A[i]; }
#pragma unroll
            for (int off = 1; off < 64; off <<= 1) { const float Ap = __shfl_up(Al, off), Hp = __shfl_up(Hl, off); if (lane >= off) { Hl = Al * Hp + Hl; Al = Al * Ap; } }
            float cin = __shfl_up(Hl, 1); if (lane == 0) cin = 0.f;
#pragma unroll
            for (int i = 0; i < 5; ++i) { const int c = 5 * lane + i; if (c < NCHUNK) { CIN[(size_t)ch * CP + c] = cin; cin = A[i] * cin + H[i]; } }
        }
    }
    SEAM(12);
    if (IN(13)) rglru_phase<true>(XRb, GATEg, Wta, Wtx, a.in[9], a.in[10], a.in[12], a.in[14], a.in[15], Aend, Hend, CIN, YY, lds_raw);
    SEAM(13);
    if (IN(14)) {
        pg8::Gemm g{YY + (size_t)NMETA * RNN_W, WOUT1, SEQ, 1024, RNN_W}; pg8::StaticOrder S; S.init(SEQ, 1024, (int)gridDim.x, (int)blockIdx.x);
        EpiRes1 E{H2 + (size_t)NMETA * D, Z1 + (size_t)NMETA * D};
        pg8::gemm_phase<EpiRes1, pg8::StaticOrder, GEMM_ALIGN, GEMM_SP2>(ldsp, g, S, E);
    }
    SEAM(14);
    if (IN(15)) { PHASE_VARS;
        const float* wg = a.in[21] + (size_t)NE * D * DE; const float* wu = a.in[22] + (size_t)NE * D * DE; const float* wd = a.in[23] + (size_t)NE * DE * D;
        { const int done = gridDim.x == 256 ? MOE1_P8 + MOE1_P10 : 0;
          tr_run(MOE0_ALL - done, [&](int j) -> TrJob { return moe_job(done + j, wg, wu, wd, WGU, WD); }, smf); }
        __syncthreads();
        for (int tb = NMETA + blockIdx.x * 64; tb < L; tb += gridDim.x * 64)
            ln_route_block(tb, (L - tb) < 64 ? (L - tb) : 64, Z1, H3, a.in[24] + D, a.in[25] + D, (const float4*)(ws + WS_WR) + 64 * 3 * 64, a.in[18] + NGRP, a.in[20] + NE, eid, gw, counts1, smf);
    }
    SEAM(15);
    if (IN(16)) { PHASE_VARS; moe_dispatch_mfma(H3, eid, counts1, cursor1, slot, mtiles, Xperm, (int*)lds_raw, gwave, nwaves, lane, 2 * NMETA); }
    SEAM(16);
    if (IN(17)) {
        pg8::Gemm g{Xperm, WGU, MAXSLOT, 1024, 1024}; MoeOrder S; S.init(mtiles, (int)gridDim.x, (int)blockIdx.x);
        EpiGateUp E{Hm};
        pg8::gemm_phase<EpiGateUp, MoeOrder, GEMM_ALIGN, GEMM_SP2>(ldsp, g, S, E);
    }
    SEAM(17);
    if (IN(18)) {
        pg8::Gemm g{Hm, WD, MAXSLOT, 1024, 512}; MoeOrder S; S.init(mtiles, (int)gridDim.x, (int)blockIdx.x);
        EpiDown E{Yb};
        pg8::gemm_phase<EpiDown, MoeOrder, GEMM_ALIGN, GEMM_SP2>(ldsp, g, S, E);
    }
    SEAM(18);
    if (IN(19)) { PHASE_VARS;
#pragma unroll 2
        for (int t = NMETA + gwave; t < L; t += nwaves) {
            const int s0 = slot[2 * t], s1 = slot[2 * t + 1]; const float g0 = gw[2 * t], g1 = gw[2 * t + 1];
            float y[16];
            combine_row(y, H3 + (size_t)t * D, Yb + (size_t)s0 * D, Yb + (size_t)s1 * D, g0, g1, lane);
            ln_row1024v(y, a.in[26] + D, a.in[27] + D, lane);
#pragma unroll
            for (int i4 = 0; i4 < 4; ++i4) *(float4*)(a.out + (size_t)(t - NMETA) * D + 16 * lane + 4 * i4) = make_float4(y[4 * i4], y[4 * i4 + 1], y[4 * i4 + 2], y[4 * i4 + 3]);
        }
    }
#undef IN
#undef SEAM
}
constexpr int N_PHASES = 20;

extern "C" void kernel_launch(void* const* d_in, const int* in_sizes, int n_in, void* d_out, int out_size, void* d_ws, size_t ws_size, hipStream_t stream) {
    static int grid = 0;
    if (grid == 0) {
        if (n_in != 28 || out_size != SEQ * D || ws_size < WS_END) { fprintf(stderr, "kernel_launch: unexpected shapes n_in %d out %d ws %zu (need %zu)\n", n_in, out_size, ws_size, (size_t)WS_END); grid = -1; return; }
        int dev = 0, cus = 0;
        if (hipGetDevice(&dev) != hipSuccess || hipDeviceGetAttribute(&cus, hipDeviceAttributeMultiprocessorCount, dev) != hipSuccess) { grid = -1; return; }
        if (hipFuncSetAttribute((const void*)fwd, hipFuncAttributeMaxDynamicSharedMemorySize, LDS_BYTES) != hipSuccess) { fprintf(stderr, "kernel_launch: hipFuncSetAttribute failed\n"); grid = -1; return; }
        int per_cu = 0;
        if (hipOccupancyMaxActiveBlocksPerMultiprocessor(&per_cu, (const void*)fwd, NTHREADS, LDS_BYTES) != hipSuccess || per_cu < 1) fprintf(stderr, "kernel_launch: occupancy query says %d\n", per_cu);
        (void)hipGetLastError();
        grid = cus;
    }
    if (grid < 0) return;
    (void)hipMemsetAsync((char*)d_ws + WS_CTL, 0, CTL_BYTES, stream);
    Args a{};
    for (int i = 0; i < 28; ++i) a.in[i] = (const float*)d_in[i];
    a.out = (float*)d_out; a.ws = (unsigned char*)d_ws;
#if N_LAUNCH_MODE == 1
    a.ph_lo = 0; a.ph_hi = N_PHASES;
    hipLaunchKernelGGL(fwd, dim3(grid), dim3(NTHREADS), LDS_BYTES, stream, a);
#else
    for (int p = 0; p < N_PHASES; ++p) { a.ph_lo = p; a.ph_hi = p + 1; hipLaunchKernelGGL(fwd, dim3(grid), dim3(NTHREADS), LDS_BYTES, stream, a); }
#endif
}
```

```cpp
#include <hip/hip_runtime.h>
#include <cstdio>
#include <cstdint>
#include <cmath>

#ifndef GEMM_ALIGN
#define GEMM_ALIGN true
#endif
#ifndef GEMM_SP2
#define GEMM_SP2 true
#endif
#ifndef N_LAUNCH_MODE
#define N_LAUNCH_MODE 1
#endif

#define DEVI __device__ __forceinline__
#define LAS __attribute__((address_space(3)))

constexpr int D = 1024, SEQ = 16384, NMETA = 16, L = SEQ + NMETA;
constexpr int CONV_CH = 512, CONV_K = 31, HD = 64, TOPK = 256;
constexpr int IN_AB = 3144;
constexpr int OFF_AVAL = 0, OFF_AGATE = 512, OFF_Q = 1024, OFF_K = 1536, OFF_V = 2048, OFF_QI = 2560, OFF_KI = 3072, OFF_WI = 3136;
constexpr int RNN_W = 1280, RNN_NB = 10, RNN_BW = 128, RNN_K = 4;
constexpr int NGRP = 4, EPG = 8, NE = 32, DE = 512;
constexpr int NPAIR = 2 * L;
constexpr float LN_EPS = 1e-5f;
constexpr float DN_ALPHA = 1.41421356237f;
constexpr int NTHREADS = 512;
constexpr int LDS_BYTES = 147456;

#define XB_TMO      128
#define XB_XCNT(j)  (256  + 64 * (j))
#define XB_XSUB(j)  (1280 + 64 * (j))
#define XB_XGEN(j)  (2304 + 64 * (j))
#define XB_TOP      3328
#define XB_TOPGEN   3392
#define XCD_BAR_WORDS 3456
#define XB_SPIN_CAP (1u << 22)
DEVI unsigned xb_ld(unsigned* p)              { return __hip_atomic_load(p, __ATOMIC_RELAXED, __HIP_MEMORY_SCOPE_AGENT); }
DEVI unsigned xb_add(unsigned* p, unsigned v) { return __hip_atomic_fetch_add(p, v, __ATOMIC_RELAXED, __HIP_MEMORY_SCOPE_AGENT); }
DEVI unsigned xb_xcc_id() { return (unsigned)__builtin_amdgcn_s_getreg((3 << 11) | 20) & 0xFu; }
#define XB_SPIN(cond, bar) do { unsigned _sp = 0; while (cond) { __builtin_amdgcn_s_sleep(1); \
    if ((++_sp & 255u) == 0u) { if (xb_ld(&(bar)[XB_TMO])) break; if (_sp > XB_SPIN_CAP) { atomicAdd(&(bar)[XB_TMO], 1u); break; } } } } while (0)
struct XcdBarrier { unsigned* bar; unsigned x; volatile LAS unsigned* st; };
DEVI XcdBarrier xcd_barrier_post(unsigned* bar, volatile LAS unsigned* st) {
    XcdBarrier b; b.bar = bar; b.x = xb_xcc_id(); b.st = st;
    if (threadIdx.x == 0) (void)xb_add(&bar[XB_XCNT(b.x)], 1u);
    return b;
}
DEVI void xcd_barrier_complete(unsigned* bar, unsigned x, unsigned& nloc, unsigned& nx) {
    const unsigned G = gridDim.x * gridDim.y * gridDim.z;
    unsigned sum, cnt, mine, sp = 0u;
    for (;;) {
        sum = 0u; cnt = 0u; mine = 0u;
#pragma unroll
        for (unsigned j = 0; j < 16; ++j) { const unsigned c = xb_ld(&bar[XB_XCNT(j)]); sum += c; cnt += (c > 0u) ? 1u : 0u; mine = (j == x) ? c : mine; }
        if (sum == G) break;
        __builtin_amdgcn_s_sleep(1);
        if ((++sp & 255u) == 0u) { if (xb_ld(&bar[XB_TMO])) break; if (sp > XB_SPIN_CAP) { atomicAdd(&bar[XB_TMO], 1u); break; } }
    }
    nloc = mine > 0u ? mine : 1u; nx = cnt > 0u ? cnt : 1u;
}
DEVI void xcd_barrier(const XcdBarrier& b) {
    asm volatile("s_waitcnt vmcnt(0)" ::: "memory");
    __syncthreads();
    if (threadIdx.x == 0) {
        unsigned* bar = b.bar;
        __builtin_amdgcn_s_waitcnt(0);
        unsigned nloc = b.st[0], nx = b.st[1];
        if (nloc == 0u) { xcd_barrier_complete(bar, b.x, nloc, nx); b.st[0] = nloc; b.st[1] = nx; }
        const unsigned old = xb_add(&bar[XB_XSUB(b.x)], 1u);
        const unsigned gen = old / nloc;
        if (old + 1u == (gen + 1u) * nloc) {
            __builtin_amdgcn_fence(__ATOMIC_RELEASE, "agent");
            asm volatile("s_waitcnt vmcnt(0)" ::: "memory");
            const unsigned og = xb_add(&bar[XB_TOP], 1u);
            const unsigned tg = og / nx;
            if (og + 1u == (tg + 1u) * nx) xb_add(&bar[XB_TOPGEN], 1u);
            else XB_SPIN(xb_ld(&bar[XB_TOPGEN]) == tg, bar);
            __builtin_amdgcn_fence(__ATOMIC_ACQUIRE, "agent");
            xb_add(&bar[XB_XGEN(b.x)], 1u);
            asm volatile("s_waitcnt vmcnt(0)" ::: "memory");
        } else {
            XB_SPIN(xb_ld(&bar[XB_XGEN(b.x)]) == gen, bar);
            __builtin_amdgcn_fence(__ATOMIC_ACQUIRE, "agent");
            asm volatile("s_waitcnt vmcnt(0)" ::: "memory");
        }
    }
    __syncthreads();
}

constexpr int LP = 16640;
constexpr int MAXSLOT = 40960;
constexpr int NCHUNK = 257, CP = 272;
constexpr size_t MiB = 1048576;
constexpr size_t WS_CTL = 0;
constexpr size_t CTL_CNT = 16384;
constexpr size_t CTL_CUR = 16384 + 256;
constexpr size_t CTL_BYTES = 32768;
constexpr size_t WS_ROPEC = 32768;
constexpr size_t WS_ROPES = WS_ROPEC + (size_t)LP * 32 * 4;
constexpr size_t WS_EID = WS_ROPES + (size_t)LP * 32 * 4;
constexpr size_t WS_GW = WS_EID + (size_t)NPAIR * 4;
constexpr size_t WS_SLOT = WS_GW + (size_t)NPAIR * 4;
constexpr size_t WS_MTILES = WS_SLOT + (size_t)NPAIR * 4;
constexpr size_t WS_WTA = WS_MTILES + 4096;
constexpr size_t WS_WTX = WS_WTA + (size_t)RNN_NB * 128 * 128 * 2;
constexpr size_t WS_AEND = WS_WTX + (size_t)RNN_NB * 128 * 128 * 2;
constexpr size_t WS_HEND = WS_AEND + (size_t)RNN_W * CP * 4;
constexpr size_t WS_CIN = WS_HEND + (size_t)RNN_W * CP * 4;
constexpr size_t WS_WR = WS_CIN + (size_t)RNN_W * CP * 4;
constexpr size_t WS_BIG = ((WS_WR + (size_t)2 * 64 * 3 * 64 * 16 + 255) / 256) * 256;
constexpr size_t R_WIN0 = 0;
constexpr size_t R_WOUT0 = R_WIN0 + (size_t)3328 * 1024 * 2;
constexpr size_t R_WGU = R_WOUT0 + (size_t)1024 * 1024 * 2;
constexpr size_t R_WD = R_WGU + (size_t)32 * 1024 * 1024 * 2;
constexpr size_t R_WIN1 = R_WD + (size_t)32 * 1024 * 512 * 2;
constexpr size_t R_WOUT1 = R_WIN1 + (size_t)2560 * 1024 * 2;
static_assert(R_WOUT1 + (size_t)1024 * 1280 * 2 <= 112 * MiB, "weights");
constexpr size_t R_A = 112 * MiB;
constexpr size_t R_H1 = 192 * MiB;
constexpr size_t R_H2 = 257 * MiB;
constexpr size_t R_C = 322 * MiB;
constexpr size_t R_GLU = 322 * MiB;
constexpr size_t SZ512 = (size_t)LP * 512 * 2;
constexpr size_t R_Q = R_GLU + SZ512, R_K = R_Q + SZ512, R_V = R_K + SZ512, R_QI = R_V + SZ512, R_KI = R_QI + SZ512, R_WI = R_KI + (size_t)LP * 64 * 2;
static_assert(R_WI + (size_t)LP * 8 * 4 <= 406 * MiB, "in-proj outputs");
constexpr size_t R_GATE = 322 * MiB;
constexpr size_t R_XR = R_GATE + (size_t)LP * 1280 * 2;
static_assert(R_XR + (size_t)LP * 1280 * 2 <= 406 * MiB, "layer-1 in-proj outputs");
constexpr size_t R_HM = 406 * MiB;
constexpr size_t WS_END = WS_BIG + R_HM + (size_t)MAXSLOT * 512 * 2;
static_assert(WS_END <= 512 * MiB, "ws");

struct Args { const float* in[28]; float* out; unsigned char* ws; int ph_lo, ph_hi; };

DEVI unsigned opq(unsigned v) { asm volatile("" : "+v"(v)); return v; }
DEVI int otid() { int v = (int)threadIdx.x; asm volatile("" : "+v"(v)); return v; }
template <int CTRL> DEVI float dpp_f(float v) { return __int_as_float(__builtin_amdgcn_mov_dpp(__float_as_int(v), CTRL, 0xF, 0xF, true)); }
DEVI float wave_sum(float v) {
    v += dpp_f<0xB1>(v); v += dpp_f<0x4E>(v); v += dpp_f<0x141>(v); v += dpp_f<0x140>(v);
    return __int_as_float(__builtin_amdgcn_readlane(__float_as_int(v), 0)) + __int_as_float(__builtin_amdgcn_readlane(__float_as_int(v), 16))
         + __int_as_float(__builtin_amdgcn_readlane(__float_as_int(v), 32)) + __int_as_float(__builtin_amdgcn_readlane(__float_as_int(v), 48));
}
DEVI float wave_max(float v) {
#pragma unroll
    for (int o = 32; o > 0; o >>= 1) v = fmaxf(v, __shfl_xor(v, o));
    return v;
}
DEVI float sigm(float x) { return 1.0f / (1.0f + expf(-x)); }
DEVI float gelu_tanh(float x) { return 0.5f * x * (1.0f + tanhf(0.7978845608028654f * (x + 0.044715f * x * x * x))); }
DEVI unsigned f2key(float f) { unsigned u = __float_as_uint(f); return (u & 0x80000000u) ? ~u : (u | 0x80000000u); }

namespace pg8 {
#define PG8_LAS __attribute__((address_space(3)))
typedef unsigned short bf16_t;
typedef short bf16x8 __attribute__((ext_vector_type(8)));
typedef float f32x4 __attribute__((ext_vector_type(4)));
typedef unsigned u32x4 __attribute__((ext_vector_type(4)));
constexpr int BM = 256, BK = 64, HALF = 128, HTB = HALF * BK * 2  , STAGE_BYTES = 8 * HTB, NXCD = 8, WGM = 8;

__host__ __device__ __forceinline__ int lds_byte(int r, int c) { const int st = (r >> 4) * 2 + (c >> 5), rr = r & 15, cc = c & 31, ob = rr * 64 + cc * 2; return st * 1024 + (ob ^ (((ob >> 9) & 1) << 5)); }
__host__ __device__ __forceinline__ void stage_rc(int b, int& R, int& C) { const int st = b / 1024, sb = b % 1024, swz = sb ^ (((sb >> 9) & 1) << 5); R = (st >> 1) * 16 + swz / 64; C = (st & 1) * 32 + (swz % 64) / 2; }
__host__ __device__ __forceinline__ int perm32(int rho) { const int n = rho >> 4, i = rho & 15; return 8 * (i >> 2) + 4 * n + (i & 3); }

struct Unit { int pm, pn; };
struct Gemm { const bf16_t* A; const bf16_t* Bt; int M, N, K; };

struct StaticOrder {
    int nM, nN, nwg, G, c;
    __host__ __device__ void init(int M, int N, int G_, int c_) { nM = M / BM; nN = N / BM; nwg = nM * nN; G = G_; c = c_; }
    __host__ __device__ bool next(int i, Unit& u) const {
        const long L = (long)i * G + c; if (L >= nwg) return false;
        int wgid = (int)L; { const int q = nwg / NXCD, r = nwg % NXCD, xcd = wgid % NXCD, off = wgid / NXCD; wgid = (xcd < r ? xcd * (q + 1) : r * (q + 1) + (xcd - r) * q) + off; }
        const int nig = WGM * nN, gid = wgid / nig, fm = gid * WGM, gsz = (nM - fm) < WGM ? (nM - fm) : WGM;
        u.pm = fm + ((wgid % nig) % gsz); u.pn = (wgid % nig) / gsz; return true;
    }
    __device__ __forceinline__ void a_ready(const Unit&) const {}
    __device__ __forceinline__ void done(const Unit&) const {}
};

template <class Epi, class Sched, bool ALIGN_EPI = false, bool SP2 = false>
__device__ __forceinline__ void gemm_phase(PG8_LAS unsigned char* lds, const Gemm g, const Sched& S, const Epi& E) {
    const int tid = threadIdx.x, wid = __builtin_amdgcn_readfirstlane(tid >> 6), lane = tid & 63, wr = wid >> 2, wc = wid & 3, fr = lane & 15, fq = lane >> 4;
    const int K = g.K, nt = K / BK;
    unsigned voffA[2], voffB[2];
#pragma unroll
    for (int i = 0; i < 2; ++i) { int R, C; stage_rc(tid * 16 + i * 8192, R, C); const int Rb = Epi::PERM ? ((R & ~31) + perm32(R & 31)) : R;
        voffA[i] = (unsigned)(R * K + C) * 2u; voffB[i] = (unsigned)(Rb * K + C) * 2u; }
    const size_t kstep = (size_t)(BK * 2);
    const size_t hstep = (size_t)HALF * K * 2;
    const size_t tstep = 2 * hstep;
    const unsigned ldsw = (unsigned)wid * 1024u;
    const int aoff = lds_byte(wr * 64 + fr, fq * 8), boff = lds_byte(wc * 32 + fr, fq * 8);
#define PG8_SA(b, h) (((b) * 2 + (h)) * HTB)
#define PG8_SB(b, h) ((4 + (b) * 2 + (h)) * HTB)
#define PG8_STAGE(bufoff, gbase, voff) do { _Pragma("unroll") for (int _i = 0; _i < 2; ++_i) \
        __builtin_amdgcn_global_load_lds((const unsigned*)((const char*)(gbase) + (voff)[_i]), (PG8_LAS unsigned*)(lds + (bufoff) + ldsw + _i * 8192), 16, 0, 0); } while (0)
#define PG8_LDA(dst, b, h) do { _Pragma("unroll") for (int m = 0; m < 4; ++m) _Pragma("unroll") for (int k = 0; k < 2; ++k) dst[m][k] = *(const PG8_LAS bf16x8*)(lds + PG8_SA(b, h) + aoff + m * 2048 + k * 1024); } while (0)
#define PG8_LDB(dst, b, h) do { _Pragma("unroll") for (int n = 0; n < 2; ++n) _Pragma("unroll") for (int k = 0; k < 2; ++k) dst[n][k] = *(const PG8_LAS bf16x8*)(lds + PG8_SB(b, h) + boff + n * 2048 + k * 1024); } while (0)
#define PG8_MMA(ai, bj, At, Bt) do { __builtin_amdgcn_s_setprio(1); _Pragma("unroll") for (int m = 0; m < 4; ++m) _Pragma("unroll") for (int n = 0; n < 2; ++n) _Pragma("unroll") for (int k = 0; k < 2; ++k) \
        acc[ai][bj][m][n] = __builtin_amdgcn_mfma_f32_16x16x32_bf16(Bt[n][k], At[m][k], acc[ai][bj][m][n], 0, 0, 0); __builtin_amdgcn_s_setprio(0); } while (0)
#define PG8_WAIT_V(n) asm volatile("s_waitcnt vmcnt(" #n ")" ::: "memory")
#define PG8_WAIT_L(n) asm volatile("s_waitcnt lgkmcnt(" #n ")" ::: "memory")
#define PG8_BAR __builtin_amdgcn_s_barrier()
#define PG8_SCHED __builtin_amdgcn_sched_barrier(0)
    Unit cur, nxt; int ui = 0;
    if (!S.next(0, cur)) return;
    f32x4 acc[2][2][4][2];
#pragma unroll
    for (int a = 0; a < 2; ++a)
#pragma unroll
        for (int b = 0; b < 2; ++b)
#pragma unroll
            for (int m = 0; m < 4; ++m)
#pragma unroll
                for (int n = 0; n < 2; ++n) acc[a][b][m][n] = (f32x4){0.f, 0.f, 0.f, 0.f};
    bf16x8 At[4][2], B0[2][2], B1[2][2];
    const char* cA = (const char*)g.A + (size_t)cur.pm * tstep; const char* cB = (const char*)g.Bt + (size_t)cur.pn * tstep;
    S.a_ready(cur);
    if constexpr (SP2) {
        PG8_STAGE(PG8_SB(0, 0), cB, voffB); PG8_STAGE(PG8_SB(0, 1), cB + hstep, voffB); PG8_STAGE(PG8_SA(0, 0), cA, voffA); PG8_STAGE(PG8_SA(0, 1), cA + hstep, voffA);
        if (wr == 1) PG8_BAR;
        PG8_WAIT_V(2); PG8_BAR;
        PG8_STAGE(PG8_SB(1, 0), cB + kstep, voffB); PG8_STAGE(PG8_SA(1, 0), cA + kstep, voffA); PG8_STAGE(PG8_SB(1, 1), cB + hstep + kstep, voffB);
        PG8_WAIT_V(6); PG8_BAR;
    } else {
        PG8_STAGE(PG8_SB(0, 0), cB, voffB); PG8_STAGE(PG8_SA(0, 0), cA, voffA); PG8_STAGE(PG8_SB(0, 1), cB + hstep, voffB); PG8_STAGE(PG8_SA(0, 1), cA + hstep, voffA);
        if (wr == 1) PG8_BAR;
        PG8_WAIT_V(4); PG8_BAR;
        PG8_STAGE(PG8_SB(1, 0), cB + kstep, voffB); PG8_STAGE(PG8_SA(1, 0), cA + kstep, voffA); PG8_STAGE(PG8_SB(1, 1), cB + hstep + kstep, voffB);
        PG8_WAIT_V(6); PG8_BAR;
    }
    for (;;) {
        const bool has_next = S.next(ui + 1, nxt);
        const char* nA = has_next ? (const char*)g.A + (size_t)nxt.pm * tstep : cA; const char* nB = has_next ? (const char*)g.Bt + (size_t)nxt.pn * tstep : cB;
        for (int t = 0; t < nt; t += 2) {
            const bool last = (t == nt - 2);
            const char* a1 = cA + (size_t)(t + 1) * kstep;
            const char* a2 = last ? nA : cA + (size_t)(t + 2) * kstep; const char* b2 = last ? nB : cB + (size_t)(t + 2) * kstep;
            const char* a3 = a2 + kstep; const char* b3 = b2 + kstep;
            if (last && has_next) S.a_ready(nxt);
            if constexpr (SP2) {
            PG8_LDB(B0, 0, 0); PG8_LDB(B1, 0, 1); PG8_SCHED; PG8_LDA(At, 0, 0); PG8_STAGE(PG8_SA(1, 1), a1 + hstep, voffA);
            PG8_WAIT_V(8); PG8_WAIT_L(0); PG8_BAR; PG8_MMA(0, 0, At, B0); PG8_MMA(0, 1, At, B1); PG8_BAR; PG8_SCHED;
            PG8_LDA(At, 0, 1); PG8_STAGE(PG8_SB(0, 0), b2, voffB); PG8_STAGE(PG8_SB(0, 1), b2 + hstep, voffB); PG8_STAGE(PG8_SA(0, 0), a2, voffA);
            PG8_WAIT_V(8); PG8_WAIT_L(0); PG8_BAR; PG8_MMA(1, 0, At, B0); PG8_MMA(1, 1, At, B1); PG8_BAR; PG8_SCHED;
            PG8_LDB(B0, 1, 0); PG8_LDB(B1, 1, 1); PG8_SCHED; PG8_LDA(At, 1, 0); PG8_STAGE(PG8_SA(0, 1), a2 + hstep, voffA);
            PG8_WAIT_V(8); PG8_WAIT_L(0); PG8_BAR; PG8_MMA(0, 0, At, B0); PG8_MMA(0, 1, At, B1); PG8_BAR; PG8_SCHED;
            PG8_LDA(At, 1, 1); PG8_STAGE(PG8_SB(1, 0), b3, voffB); PG8_STAGE(PG8_SB(1, 1), b3 + hstep, voffB); PG8_STAGE(PG8_SA(1, 0), a3, voffA);
            PG8_WAIT_V(8); PG8_WAIT_L(0); PG8_BAR; PG8_MMA(1, 0, At, B0); PG8_MMA(1, 1, At, B1); PG8_BAR; PG8_SCHED;
            } else {
            PG8_LDB(B0, 0, 0); PG8_SCHED; PG8_LDA(At, 0, 0); PG8_STAGE(PG8_SA(1, 1), a1 + hstep, voffA);
            PG8_WAIT_L(8); PG8_BAR; PG8_WAIT_L(0); PG8_MMA(0, 0, At, B0); PG8_BAR; PG8_SCHED;
            PG8_LDB(B1, 0, 1); PG8_STAGE(PG8_SB(0, 0), b2, voffB);
            PG8_BAR; PG8_WAIT_L(0); PG8_MMA(0, 1, At, B1); PG8_BAR;
            PG8_LDA(At, 0, 1); PG8_STAGE(PG8_SA(0, 0), a2, voffA);
            PG8_BAR; PG8_WAIT_L(0); PG8_MMA(1, 0, At, B0); PG8_BAR; PG8_SCHED;
            PG8_STAGE(PG8_SB(0, 1), b2 + hstep, voffB);
            PG8_WAIT_V(6); PG8_BAR; PG8_MMA(1, 1, At, B1); PG8_BAR;
            PG8_LDB(B0, 1, 0); PG8_SCHED; PG8_LDA(At, 1, 0); PG8_STAGE(PG8_SA(0, 1), a2 + hstep, voffA);
            PG8_WAIT_L(8); PG8_BAR; PG8_WAIT_L(0); PG8_MMA(0, 0, At, B0); PG8_BAR; PG8_SCHED;
            PG8_LDB(B1, 1, 1); PG8_STAGE(PG8_SB(1, 0), b3, voffB);
            PG8_BAR; PG8_WAIT_L(0); PG8_MMA(0, 1, At, B1); PG8_BAR;
            PG8_LDA(At, 1, 1); PG8_STAGE(PG8_SA(1, 0), a3, voffA);
            PG8_BAR; PG8_WAIT_L(0); PG8_MMA(1, 0, At, B0); PG8_BAR; PG8_SCHED;
            PG8_STAGE(PG8_SB(1, 1), b3 + hstep, voffB);
            PG8_WAIT_V(6); PG8_BAR; PG8_MMA(1, 1, At, B1); PG8_BAR;
            }
        }
        if constexpr (ALIGN_EPI) { if (wr == 0) PG8_BAR; }
        if constexpr (!Epi::AFTER_DRAIN) { E(acc, cur, wr, wc, fr, fq); S.done(cur); }
        if (!has_next) break;
#pragma unroll
        for (int a = 0; a < 2; ++a)
#pragma unroll
            for (int b = 0; b < 2; ++b)
#pragma unroll
                for (int m = 0; m < 4; ++m)
#pragma unroll
                    for (int n = 0; n < 2; ++n) acc[a][b][m][n] = (f32x4){0.f, 0.f, 0.f, 0.f};
        cur = nxt; cA = nA; cB = nB; ++ui;
        if constexpr (ALIGN_EPI) { if (wr == 1) PG8_BAR; }
    }
    PG8_WAIT_V(0);
    if constexpr (!ALIGN_EPI) { if (wr == 0) PG8_BAR; }
    PG8_BAR;
    if constexpr (Epi::AFTER_DRAIN) { E.fused(acc, cur, wr, wc, fr, fq, lds, wid, lane); S.done(cur); }
#undef PG8_SA
#undef PG8_SB
#undef PG8_STAGE
#undef PG8_LDA
#undef PG8_LDB
#undef PG8_MMA
#undef PG8_WAIT_V
#undef PG8_WAIT_L
#undef PG8_BAR
#undef PG8_SCHED
}
}

DEVI void ln_row1024(float (&y)[16], const float* g, const float* b, int lane) {
    float s = 0.f;
#pragma unroll
    for (int i = 0; i < 16; ++i) s += y[i];
    const float mu = wave_sum(s) * (1.0f / 1024.0f);
    float q = 0.f;
#pragma unroll
    for (int i = 0; i < 16; ++i) { const float d = y[i] - mu; q += d * d; }
    const float rstd = 1.0f / sqrtf(wave_sum(q) * (1.0f / 1024.0f) + LN_EPS);
#pragma unroll
    for (int i = 0; i < 16; ++i) y[i] = (y[i] - mu) * rstd * g[lane + 64 * i] + b[lane + 64 * i];
}

DEVI void route_token(const float (&y)[16], float* ys, int t, int lane, const float* wg, const float* bg, const float* we, const float* be, int* eid, float* gw, unsigned* counts) {
    float lg[36];
#pragma unroll
    for (int j = 0; j < 36; ++j) lg[j] = 0.f;
#pragma unroll
    for (int i = 0; i < 16; ++i) ys[lane + 64 * i] = y[i];
#pragma unroll 1
    for (int i = 0; i < 16; ++i) {
        const int c = lane + 64 * i;
        const float yv = ys[c];
        const float4 g4 = *(const float4*)(wg + (size_t)c * 4);
        lg[0] += yv * g4.x; lg[1] += yv * g4.y; lg[2] += yv * g4.z; lg[3] += yv * g4.w;
#pragma unroll
        for (int j = 0; j < 8; ++j) { const float4 e4 = *(const float4*)(we + (size_t)c * 32 + j * 4);
            lg[4 + j * 4 + 0] += yv * e4.x; lg[4 + j * 4 + 1] += yv * e4.y; lg[4 + j * 4 + 2] += yv * e4.z; lg[4 + j * 4 + 3] += yv * e4.w; }
    }
#pragma unroll
    for (int j = 0; j < 36; ++j) lg[j] = wave_sum(lg[j]);
    if (lane == 0) {
        float gl[4]; int g = 0;
#pragma unroll
        for (int j = 0; j < 4; ++j) gl[j] = lg[j] + bg[j];
#pragma unroll
        for (int j = 1; j < 4; ++j) if (gl[j] > gl[g]) g = j;
        float den = 0.f;
#pragma unroll
        for (int j = 0; j < 4; ++j) den += expf(gl[j] - gl[g]);
        const float gp = 1.0f / den;
        float el[8];
#pragma unroll
        for (int j = 0; j < 8; ++j) { float v = 0.f;
#pragma unroll
            for (int gg = 0; gg < 4; ++gg) v = (gg == g) ? lg[4 + gg * 8 + j] + be[gg * 8 + j] : v;
            el[j] = v; }
        int i1 = 0;
#pragma unroll
        for (int j = 1; j < 8; ++j) if (el[j] > el[i1]) i1 = j;
        int i2 = (i1 == 0) ? 1 : 0;
#pragma unroll
        for (int j = 0; j < 8; ++j) if (j != i1 && el[j] > el[i2]) i2 = j;
        const float ex = expf(el[i2] - el[i1]);
        const float p1 = 1.0f / (1.0f + ex), p2 = ex / (1.0f + ex);
        const int e1 = g * 8 + i1, e2 = g * 8 + i2;
        eid[2 * t] = e1; eid[2 * t + 1] = e2; gw[2 * t] = gp * p1; gw[2 * t + 1] = gp * p2;
        atomicAdd(&counts[e1], 1u); atomicAdd(&counts[e2], 1u);
    }
}


DEVI void ln_row1024v(float (&y)[16], const float* g, const float* b, int lane) {
    float s = 0.f;
#pragma unroll
    for (int i = 0; i < 16; ++i) s += y[i];
    const float mu = wave_sum(s) * (1.0f / 1024.0f);
    float q = 0.f;
#pragma unroll
    for (int i = 0; i < 16; ++i) { const float d = y[i] - mu; q += d * d; }
    const float rstd = 1.0f / sqrtf(wave_sum(q) * (1.0f / 1024.0f) + LN_EPS);
#pragma unroll
    for (int i4 = 0; i4 < 4; ++i4) { const float4 g4 = *(const float4*)(g + 16 * lane + 4 * i4), b4 = *(const float4*)(b + 16 * lane + 4 * i4);
        y[4 * i4] = (y[4 * i4] - mu) * rstd * g4.x + b4.x; y[4 * i4 + 1] = (y[4 * i4 + 1] - mu) * rstd * g4.y + b4.y; y[4 * i4 + 2] = (y[4 * i4 + 2] - mu) * rstd * g4.z + b4.z; y[4 * i4 + 3] = (y[4 * i4 + 3] - mu) * rstd * g4.w + b4.w; }
}
DEVI void combine_row(float (&y)[16], const float* h, const unsigned short* Y0, const unsigned short* Y1, float g0, float g1, int lane) {
    const uint4 a0 = *(const uint4*)(Y0 + 16 * lane), a1 = *(const uint4*)(Y0 + 16 * lane + 8), b0 = *(const uint4*)(Y1 + 16 * lane), b1 = *(const uint4*)(Y1 + 16 * lane + 8);
    const unsigned aw[8] = {a0.x, a0.y, a0.z, a0.w, a1.x, a1.y, a1.z, a1.w}, bw[8] = {b0.x, b0.y, b0.z, b0.w, b1.x, b1.y, b1.z, b1.w};
#pragma unroll
    for (int i4 = 0; i4 < 4; ++i4) { const float4 hv = *(const float4*)(h + 16 * lane + 4 * i4);
        y[4 * i4]     = DN_ALPHA * hv.x + (g0 * __uint_as_float(aw[2 * i4] << 16) + g1 * __uint_as_float(bw[2 * i4] << 16));
        y[4 * i4 + 1] = DN_ALPHA * hv.y + (g0 * __uint_as_float(aw[2 * i4] & 0xFFFF0000u) + g1 * __uint_as_float(bw[2 * i4] & 0xFFFF0000u));
        y[4 * i4 + 2] = DN_ALPHA * hv.z + (g0 * __uint_as_float(aw[2 * i4 + 1] << 16) + g1 * __uint_as_float(bw[2 * i4 + 1] << 16));
        y[4 * i4 + 3] = DN_ALPHA * hv.w + (g0 * __uint_as_float(aw[2 * i4 + 1] & 0xFFFF0000u) + g1 * __uint_as_float(bw[2 * i4 + 1] & 0xFFFF0000u)); }
}
typedef float f32x4v __attribute__((ext_vector_type(4)));
DEVI void ln_route_block(int tb, int ntok, const float* Zsrc, float* Hdst, const float* g, const float* b, const float4* __restrict__ Wr, const float* bg, const float* be,
                         int* eid, float* gw, unsigned* counts, float* sm) {
    const int tid = otid(), lane = tid & 63, wave = tid >> 6;
    unsigned* lcnt = (unsigned*)(sm + 8 * 16 * 48);
    if (tid < NE) lcnt[tid] = 0u;
    { float yy[8][16];
#pragma unroll
      for (int i = 0; i < 8; ++i) { const int tl = wave * 8 + i; const size_t t = (size_t)(tb + (tl < ntok ? tl : ntok - 1));
#pragma unroll
          for (int i4 = 0; i4 < 4; ++i4) { const float4 v = *(const float4*)(Zsrc + t * D + 16 * lane + 4 * i4); yy[i][4 * i4] = v.x; yy[i][4 * i4 + 1] = v.y; yy[i][4 * i4 + 2] = v.z; yy[i][4 * i4 + 3] = v.w; } }
#pragma unroll
      for (int i = 0; i < 8; ++i) { const int tl = wave * 8 + i;
          if (tl < ntok) { const size_t t = (size_t)(tb + tl);
              ln_row1024v(yy[i], g, b, lane);
#pragma unroll
              for (int i4 = 0; i4 < 4; ++i4) *(float4*)(Hdst + t * D + 16 * lane + 4 * i4) = make_float4(yy[i][4 * i4], yy[i][4 * i4 + 1], yy[i][4 * i4 + 2], yy[i][4 * i4 + 3]); } } }
    asm volatile("s_waitcnt vmcnt(0)" ::: "memory");
    __syncthreads();
    const int grp = wave & 3, khalf = wave >> 2;
    if (grp * 16 < ntok) {
        const int t0 = tb + 16 * grp, row = lane & 15, kg = lane >> 4;
        f32x4v acc[3];
#pragma unroll
        for (int ct = 0; ct < 3; ++ct) acc[ct] = (f32x4v){0.f, 0.f, 0.f, 0.f};
        const float* arow = Hdst + (size_t)(t0 + row) * D + 4 * kg;
#pragma unroll 4
        for (int sstep = 32 * khalf; sstep < 32 * khalf + 32; ++sstep) {
            const float4 a4 = *(const float4*)(arow + 16 * sstep);
#pragma unroll
            for (int ct = 0; ct < 3; ++ct) { const float4 b4 = Wr[(sstep * 3 + ct) * 64 + lane];
                acc[ct] = __builtin_amdgcn_mfma_f32_16x16x4f32(a4.x, b4.x, acc[ct], 0, 0, 0); acc[ct] = __builtin_amdgcn_mfma_f32_16x16x4f32(a4.y, b4.y, acc[ct], 0, 0, 0);
                acc[ct] = __builtin_amdgcn_mfma_f32_16x16x4f32(a4.z, b4.z, acc[ct], 0, 0, 0); acc[ct] = __builtin_amdgcn_mfma_f32_16x16x4f32(a4.w, b4.w, acc[ct], 0, 0, 0); }
        }
        float* Lg = sm + (khalf * 4 + grp) * 16 * 48;
#pragma unroll
        for (int ct = 0; ct < 3; ++ct)
#pragma unroll
            for (int j = 0; j < 4; ++j) Lg[(4 * kg + j) * 48 + 16 * ct + row] = acc[ct][j];
    }
    __syncthreads();
    if (wave < 4 && wave * 16 < ntok) {
        const int t0 = tb + 16 * wave;
        if (lane < 16) {
            const int t = t0 + lane; const float* lgA = sm + wave * 16 * 48 + lane * 48; const float* lgB = lgA + 4 * 16 * 48;
            float lg[36];
#pragma unroll
            for (int j = 0; j < 36; ++j) lg[j] = lgA[j] + lgB[j];
            float gl[4]; int gsel = 0;
#pragma unroll
            for (int j = 0; j < 4; ++j) gl[j] = lg[j] + bg[j];
#pragma unroll
            for (int j = 1; j < 4; ++j) if (gl[j] > gl[gsel]) gsel = j;
            float den = 0.f;
#pragma unroll
            for (int j = 0; j < 4; ++j) den += expf(gl[j] - gl[gsel]);
            const float gp = 1.0f / den;
            float el[8];
#pragma unroll
            for (int j = 0; j < 8; ++j) { float v = lg[4 + j];
#pragma unroll
                for (int gg = 1; gg < 4; ++gg) v = (gg == gsel) ? lg[4 + gg * 8 + j] : v;
                el[j] = v + be[gsel * 8 + j]; }
            int i1 = 0;
#pragma unroll
            for (int j = 1; j < 8; ++j) if (el[j] > el[i1]) i1 = j;
            int i2 = (i1 == 0) ? 1 : 0;
#pragma unroll
            for (int j = 0; j < 8; ++j) if (j != i1 && el[j] > el[i2]) i2 = j;
            float e1v = el[0], e2v = el[0];
#pragma unroll
            for (int j = 0; j < 8; ++j) { e1v = (j == i1) ? el[j] : e1v; e2v = (j == i2) ? el[j] : e2v; }
            const float ex = expf(e2v - e1v);
            const float p1 = 1.0f / (1.0f + ex), p2 = ex / (1.0f + ex);
            const int e1 = gsel * 8 + i1, e2 = gsel * 8 + i2;
            eid[2 * t] = e1; eid[2 * t + 1] = e2; gw[2 * t] = gp * p1; gw[2 * t + 1] = gp * p2;
            atomicAdd(&lcnt[e1], 1u); atomicAdd(&lcnt[e2], 1u);
        }
    }
    __syncthreads();
    if (tid < NE) { const unsigned c = lcnt[tid]; if (c) atomicAdd(&counts[tid], c); }
    __syncthreads();
}

using pg8::f32x4; using pg8::Unit; typedef unsigned short bf16_t;
DEVI float bf2f(unsigned short b) { return __uint_as_float(((unsigned)b) << 16); }
DEVI float bflo(unsigned w) { return __uint_as_float(w << 16); }
DEVI float bfhi(unsigned w) { return __uint_as_float(w & 0xFFFF0000u); }
DEVI unsigned cvt_pk_bf16(float lo, float hi) { unsigned r; asm volatile("v_cvt_pk_bf16_f32 %0, %1, %2" : "=v"(r) : "v"(lo), "v"(hi)); return r; }
DEVI uint2 pack4(const f32x4 v) { return make_uint2(cvt_pk_bf16(v[0], v[1]), cvt_pk_bf16(v[2], v[3])); }
DEVI float fsigm(float x) { return __builtin_amdgcn_rcpf(1.0f + __expf(-x)); }
DEVI unsigned pack4_fp8(const f32x4 v) { int w = __builtin_amdgcn_cvt_pk_fp8_f32(v[0], v[1], 0, false); w = __builtin_amdgcn_cvt_pk_fp8_f32(v[2], v[3], w, true); return (unsigned)w; }

DEVI int in0_srccol(int n) {
    if (n < 1024) { const int G = n >> 5, nn = (n >> 4) & 1, i = n & 15; return (nn ? OFF_AGATE : OFF_AVAL) + 16 * G + i; }
    if (n < 2048 || (n >= 2560 && n < 3072)) {
        const int base = n < 1536 ? OFF_Q : n < 2048 ? OFF_K : OFF_QI; const int loc = n & 511;
        const int G = loc >> 5, nn = (loc >> 4) & 1, i = loc & 15; return base + 64 * (G >> 1) + 32 * nn + 16 * (G & 1) + i; }
    if (n < 2560) return OFF_V + (n - 2048);
    if (n < 3136) { const int loc = n - 3072; const int G = loc >> 5, nn = (loc >> 4) & 1, i = loc & 15; return OFF_KI + 32 * nn + 16 * G + i; }
    if (n < 3144) return OFF_WI + (n - 3136);
    return -1;
}
struct EpiIn0 {
    static constexpr bool PERM = false, AFTER_DRAIN = false;
    bf16_t* GLU; bf16_t* KI; float* WI; const float* ropeC; const float* ropeS; unsigned char* KV8;
    DEVI void operator()(const f32x4 (&acc)[2][2][4][2], const Unit& u, int wr, int wc, int fr, int fq) const {
        const int pn = u.pn; const int rbase = u.pm * 256 + wr * 64 + fr;
        if (pn < 4) {
#pragma unroll
            for (int ai = 0; ai < 2; ++ai)
#pragma unroll
                for (int m = 0; m < 4; ++m) { const size_t row = rbase + ai * 128 + m * 16;
#pragma unroll
                    for (int bj = 0; bj < 2; ++bj) { const int G = 8 * pn + 4 * bj + wc; const f32x4 v = acc[ai][bj][m][0], g = acc[ai][bj][m][1]; f32x4 o;
#pragma unroll
                        for (int j = 0; j < 4; ++j) o[j] = v[j] * fsigm(g[j]);
                        *(uint2*)(GLU + row * 512 + 16 * G + 4 * fq) = pack4(o); } }
        } else if (pn == 8 || pn == 9) {
#pragma unroll
            for (int ai = 0; ai < 2; ++ai)
#pragma unroll
                for (int m = 0; m < 4; ++m) { const size_t row = rbase + ai * 128 + m * 16;
#pragma unroll
                    for (int bj = 0; bj < 2; ++bj)
#pragma unroll
                        for (int n = 0; n < 2; ++n) { const int col = 256 * (pn - 8) + 128 * bj + 32 * wc + 16 * n + 4 * fq;
                            *(unsigned*)(KV8 + row * 1024 + (size_t)(col >> 3) * 16 + 8 + (col & 7)) = pack4_fp8(acc[ai][bj][m][n]); } }
        } else if (pn == 12) {
            if (wc < 2) { const int d0 = 16 * wc + 4 * fq;
#pragma unroll
                for (int ai = 0; ai < 2; ++ai)
#pragma unroll
                    for (int m = 0; m < 4; ++m) { const size_t row = rbase + ai * 128 + m * 16;
                        const f32x4 c = *(const f32x4*)(ropeC + row * 32 + d0), s = *(const f32x4*)(ropeS + row * 32 + d0);
                        const f32x4 t1 = acc[ai][0][m][0], t2 = acc[ai][0][m][1];
                        *(uint2*)(KI + row * 64 + d0) = pack4(t1 * c - t2 * s); *(uint2*)(KI + row * 64 + 32 + d0) = pack4(t1 * s + t2 * c); }
            } else if (wc == 2 && fq < 2) {
#pragma unroll
                for (int ai = 0; ai < 2; ++ai)
#pragma unroll
                    for (int m = 0; m < 4; ++m) { const size_t row = rbase + ai * 128 + m * 16; *(f32x4*)(WI + row * 8 + 4 * fq) = acc[ai][0][m][0] * 0.35355339059327373f; }
            }
        } else {
            bf16_t* dst = GLU + (size_t)(pn < 6 ? 1 : pn < 8 ? 2 : 4) * LP * 512; const int pl = pn & 1; const int d0 = 16 * (wc & 1) + 4 * fq;
#pragma unroll
            for (int ai = 0; ai < 2; ++ai)
#pragma unroll
                for (int m = 0; m < 4; ++m) { const size_t row = rbase + ai * 128 + m * 16;
                    const f32x4 c = *(const f32x4*)(ropeC + row * 32 + d0), s = *(const f32x4*)(ropeS + row * 32 + d0);
#pragma unroll
                    for (int bj = 0; bj < 2; ++bj) { const int hh = 4 * pl + 2 * bj + (wc >> 1); const f32x4 t1 = acc[ai][bj][m][0], t2 = acc[ai][bj][m][1];
                        if (pn == 6 || pn == 7) { const int da = 64 * hh + d0, db = da + 32;
                            *(unsigned*)(KV8 + row * 1024 + (size_t)(da >> 3) * 16 + (da & 7)) = pack4_fp8(t1 * c - t2 * s); *(unsigned*)(KV8 + row * 1024 + (size_t)(db >> 3) * 16 + (db & 7)) = pack4_fp8(t1 * s + t2 * c);
                        } else { *(uint2*)(dst + row * 512 + 64 * hh + d0) = pack4(t1 * c - t2 * s); *(uint2*)(dst + row * 512 + 64 * hh + 32 + d0) = pack4(t1 * s + t2 * c); } } }
        }
    }
};
struct EpiRes0 {
    static constexpr bool PERM = false, AFTER_DRAIN = false;
    const float* x; const float* meta; float* Z;
    DEVI void operator()(const f32x4 (&acc)[2][2][4][2], const Unit& u, int wr, int wc, int fr, int fq) const {
        const int rbase = u.pm * 256 + wr * 64 + fr, cbase = u.pn * 256 + wc * 32 + 4 * fq;
#pragma unroll
        for (int ai = 0; ai < 2; ++ai)
#pragma unroll
            for (int m = 0; m < 4; ++m) { const int row = rbase + ai * 128 + m * 16;
                if (row < L) { const float* rs = row < NMETA ? meta + (size_t)row * D : x + (size_t)(row - NMETA) * D;
#pragma unroll
                    for (int bj = 0; bj < 2; ++bj)
#pragma unroll
                        for (int n = 0; n < 2; ++n) { const int col = cbase + 128 * bj + 16 * n; const f32x4 r4 = *(const f32x4*)(rs + col); *(f32x4*)(Z + (size_t)row * D + col) = r4 * DN_ALPHA + acc[ai][bj][m][n]; } } }
    }
};
struct EpiGateUp {
    static constexpr bool PERM = false, AFTER_DRAIN = false;
    bf16_t* Hm;
    DEVI void operator()(const f32x4 (&acc)[2][2][4][2], const Unit& u, int wr, int wc, int fr, int fq) const {
        const int pl = u.pn & 3; const int rbase = u.pm * 256 + wr * 64 + fr;
#pragma unroll
        for (int ai = 0; ai < 2; ++ai)
#pragma unroll
            for (int m = 0; m < 4; ++m) { const size_t row = rbase + ai * 128 + m * 16;
#pragma unroll
                for (int bj = 0; bj < 2; ++bj) { const int G = 8 * pl + 4 * bj + wc; const f32x4 g = acc[ai][bj][m][0], up = acc[ai][bj][m][1]; f32x4 o;
#pragma unroll
                    for (int j = 0; j < 4; ++j) o[j] = g[j] * fsigm(g[j]) * up[j];
                    *(uint2*)(Hm + row * 512 + 16 * G + 4 * fq) = pack4(o); } }
    }
};
struct EpiDown {
    static constexpr bool PERM = false, AFTER_DRAIN = false;
    bf16_t* Y;
    DEVI void operator()(const f32x4 (&acc)[2][2][4][2], const Unit& u, int wr, int wc, int fr, int fq) const {
        const int pl = u.pn & 3; const int rbase = u.pm * 256 + wr * 64 + fr, cbase = pl * 256 + wc * 32 + 4 * fq;
#pragma unroll
        for (int ai = 0; ai < 2; ++ai)
#pragma unroll
            for (int m = 0; m < 4; ++m) { const size_t row = rbase + ai * 128 + m * 16;
#pragma unroll
                for (int bj = 0; bj < 2; ++bj)
#pragma unroll
                    for (int n = 0; n < 2; ++n) *(uint2*)(Y + row * 1024 + cbase + 128 * bj + 16 * n) = pack4(acc[ai][bj][m][n]); }
    }
};
struct MoeOrder {
    const int* mt; int nunits, G, c;
    DEVI void init(const int* t, int G_, int c_) { mt = t; nunits = t[0] * 4; G = G_; c = c_; }
    DEVI bool next(int i, Unit& u) const { const int li = i * G + c; if (li >= nunits) return false; const int ti = li >> 2; u.pm = ti; u.pn = mt[4 + ti] * 4 + (li & 3); return true; }
    DEVI void a_ready(const Unit&) const {}
    DEVI void done(const Unit&) const {}
};

template <class F> DEVI void tr_tile(bf16_t* dst, int K, int n0, int k0, F src, float* sm) {
    const int tid = otid();
    __syncthreads();
    { const int nn = tid & 63, kb = tid >> 6;
#pragma unroll
      for (int p = 0; p < 8; ++p) { const int kk = kb + 8 * p; sm[kk * 65 + nn] = src(n0 + nn, k0 + kk); } }
    __syncthreads();
    { const int nn = tid >> 3, kq = (tid & 7) * 8; float v[8];
#pragma unroll
      for (int j = 0; j < 8; ++j) v[j] = sm[(kq + j) * 65 + nn];
      uint4 w; w.x = cvt_pk_bf16(v[0], v[1]); w.y = cvt_pk_bf16(v[2], v[3]); w.z = cvt_pk_bf16(v[4], v[5]); w.w = cvt_pk_bf16(v[6], v[7]);
      *(uint4*)(dst + (size_t)(n0 + nn) * K + k0 + kq) = w; }
}

struct TrJob { bf16_t* dst; const float* s0; const float* s1; int K, n0, k0, ld, mode; };
DEVI float tr_src(const TrJob& J, int n, int k) {
    if (J.mode == 0) return __builtin_nontemporal_load(J.s0 + (size_t)k * J.ld + n);
    if (J.mode == 1) { const int sc = in0_srccol(n); return sc < 0 ? 0.f : __builtin_nontemporal_load(J.s0 + (size_t)k * IN_AB + sc); }
    const int ch = (n >> 5) * 16 + (n & 15); return ((n >> 4) & 1) ? __builtin_nontemporal_load(J.s1 + (size_t)k * DE + ch) : __builtin_nontemporal_load(J.s0 + (size_t)k * DE + ch);
}
DEVI void tr_fetch(const TrJob& J, float (&v)[8]) {
    const int tid = otid(), nn = tid & 63, kb = tid >> 6;
#pragma unroll
    for (int p = 0; p < 8; ++p) v[p] = tr_src(J, J.n0 + nn, J.k0 + kb + 8 * p);
}
DEVI void tr_commit(const TrJob& J, const float (&v)[8], float* sm) {
    const int tid = otid();
    __syncthreads();
    { const int nn = tid & 63, kb = tid >> 6;
#pragma unroll
      for (int p = 0; p < 8; ++p) sm[(kb + 8 * p) * 65 + nn] = v[p]; }
    __syncthreads();
    { const int nn = tid >> 3, kq = (tid & 7) * 8; float x[8];
#pragma unroll
      for (int j = 0; j < 8; ++j) x[j] = sm[(kq + j) * 65 + nn];
      uint4 w; w.x = cvt_pk_bf16(x[0], x[1]); w.y = cvt_pk_bf16(x[2], x[3]); w.z = cvt_pk_bf16(x[4], x[5]); w.w = cvt_pk_bf16(x[6], x[7]);
      *(uint4*)(J.dst + (size_t)(J.n0 + nn) * J.K + J.k0 + kq) = w; }
}
template <class Dec> DEVI void tr_run(int njobs, Dec dec, float* sm, int rank = (int)blockIdx.x, int G = (int)gridDim.x) {
    int j = rank;
    TrJob Ja{}, Jb{}; float va[8], vb[8];
    if (j < njobs) { Ja = dec(j); tr_fetch(Ja, va); }
    while (j < njobs) {
        int jn = j + G; if (jn < njobs) { Jb = dec(jn); tr_fetch(Jb, vb); }
        tr_commit(Ja, va, sm);
        j = jn; if (j >= njobs) break;
        jn = j + G; if (jn < njobs) { Ja = dec(jn); tr_fetch(Ja, va); }
        tr_commit(Jb, vb, sm);
        j = jn;
    }
    __syncthreads();
}

DEVI void moe_dispatch_mfma(const float* H, const int* eid, const unsigned* counts, unsigned* cursor, int* slot, int* mtiles, bf16_t* Xperm, int* sm_i, int gwave, int nwaves, int lane, int p_begin) {
    { const int tid = otid();
      if (tid == 0) { int o = 0; for (int e = 0; e < NE; ++e) { sm_i[e] = o; o += (((int)counts[e] + 255) >> 8) << 8; } }
      if (tid < NE) sm_i[32 + tid] = 0; }
    __syncthreads();
    { const int ppw = (NPAIR - p_begin + nwaves - 1) / nwaves; const int pb = p_begin + gwave * ppw; const int pe = pb + ppw < NPAIR ? pb + ppw : NPAIR;
      int e_ = 0, rk = 0; const bool act = lane < ppw && pb + lane < pe;
      if (act) { e_ = eid[pb + lane]; rk = atomicAdd(&sm_i[32 + e_], 1); }
      __syncthreads();
      { const int tid = otid(); if (tid < NE) { const int c = sm_i[32 + tid]; if (c) sm_i[64 + tid] = sm_i[tid] + (int)atomicAdd(&cursor[tid], (unsigned)c); } }
      __syncthreads();
      if (pb < pe) {
        int sl = 0;
        if (act) { sl = sm_i[64 + e_] + rk; slot[pb + lane] = sl; }
        for (int k0 = 0; pb + k0 < pe; k0 += 8) {
            float4 v[8][4];
#pragma unroll
            for (int k = 0; k < 8; ++k) { const int p = pb + k0 + k < pe ? pb + k0 + k : pe - 1; const float4* src = (const float4*)(H + (size_t)(p >> 1) * D);
#pragma unroll
                for (int r = 0; r < 4; ++r) v[k][r] = src[lane + 64 * r]; }
#pragma unroll
            for (int k = 0; k < 8; ++k) { const int s = __shfl(sl, k0 + k);
                if (pb + k0 + k < pe) { uint2* dst = (uint2*)(Xperm + (size_t)s * D);
#pragma unroll
                    for (int r = 0; r < 4; ++r) dst[lane + 64 * r] = make_uint2(cvt_pk_bf16(v[k][r].x, v[k][r].y), cvt_pk_bf16(v[k][r].z, v[k][r].w)); } }
        }
      } }
    if (blockIdx.x == 0 && otid() == 0) { int n = 0; for (int e = 0; e < NE; ++e) { const int nt = ((int)counts[e] + 255) >> 8; for (int i = 0; i < nt; ++i) mtiles[4 + n++] = e; } mtiles[0] = n; }
    __syncthreads();
}

DEVI float gelu_fast(float x) { return x * fsigm(1.5957691216057308f * (x + 0.044715f * x * x * x)); }
struct EpiIn1 {
    static constexpr bool PERM = false, AFTER_DRAIN = false;
    bf16_t* G;
    DEVI void operator()(const f32x4 (&acc)[2][2][4][2], const Unit& u, int wr, int wc, int fr, int fq) const {
        const int pn = u.pn; const bool is_gate = pn < 5; const int rbase = u.pm * 256 + wr * 64 + fr;
        bf16_t* dst = G + (is_gate ? (size_t)0 : (size_t)LP * RNN_W) + (size_t)((is_gate ? pn : pn - 5) * 256 + wc * 32 + 4 * fq);
#pragma unroll
        for (int ai = 0; ai < 2; ++ai)
#pragma unroll
            for (int m = 0; m < 4; ++m) { const size_t row = rbase + ai * 128 + m * 16;
#pragma unroll
                for (int bj = 0; bj < 2; ++bj)
#pragma unroll
                    for (int n = 0; n < 2; ++n) { f32x4 v = acc[ai][bj][m][n];
                        if (is_gate) {
#pragma unroll
                            for (int j = 0; j < 4; ++j) v[j] = gelu_fast(v[j]); }
                        *(uint2*)(dst + row * RNN_W + 128 * bj + 16 * n) = pack4(v); } }
    }
};
struct EpiRes1 {
    static constexpr bool PERM = false, AFTER_DRAIN = false;
    const float* R; float* Z;
    DEVI void operator()(const f32x4 (&acc)[2][2][4][2], const Unit& u, int wr, int wc, int fr, int fq) const {
        const int rbase = u.pm * 256 + wr * 64 + fr, cbase = u.pn * 256 + wc * 32 + 4 * fq;
#pragma unroll
        for (int ai = 0; ai < 2; ++ai)
#pragma unroll
            for (int m = 0; m < 4; ++m) { const size_t row = rbase + ai * 128 + m * 16;
#pragma unroll
                for (int bj = 0; bj < 2; ++bj)
#pragma unroll
                    for (int n = 0; n < 2; ++n) { const int col = cbase + 128 * bj + 16 * n; const f32x4 r4 = *(const f32x4*)(R + row * D + col); *(f32x4*)(Z + row * D + col) = r4 * DN_ALPHA + acc[ai][bj][m][n]; } }
    }
};

typedef short bf16x8_t __attribute__((ext_vector_type(8)));
struct RgIn { uint4 x[2][4]; };
DEVI void rglru_fetch(int c, int ch0, const bf16_t* __restrict__ XR, int tid, RgIn& R) {
    const int c8 = tid & 15, tr = tid >> 4;
#pragma unroll
    for (int half = 0; half < 2; ++half) { const int t = c * 64 + tr + 32 * half;
#pragma unroll
        for (int j = 0; j < 4; ++j) { const int tt = t - 3 + j; R.x[half][j] = tt >= 0 ? *(const uint4*)(XR + (size_t)tt * RNN_W + ch0 + 8 * c8) : make_uint4(0u, 0u, 0u, 0u); } }
}
template <bool FINAL>
DEVI void rglru_unit(int c, int nb, const RgIn& R, const bf16x8_t (&fa)[4], const bf16x8_t (&fx)[4], float bav, float bxv, float sp,
                     const bf16_t* __restrict__ GATEg, float* __restrict__ Aend, float* __restrict__ Hend, const float* __restrict__ CIN, bf16_t* __restrict__ YY,
                     unsigned char* lds, int tid) {
    const int lane = tid & 63, w = tid >> 6, col = lane & 15, quad = lane >> 4;
    bf16_t* xcb = (bf16_t*)lds;
    float* xcf = (float*)(lds + 64 * 136 * 2);
    const float* cwl = (const float*)(lds + 64 * 136 * 2 + 64 * 132 * 4);
    const int t0 = c * 64, ch0 = nb * RNN_BW, ch = ch0 + 16 * w + col;
    const float cinv = FINAL ? CIN[(size_t)ch * CP + c] : 0.f;
    const int c8 = tid & 15, tr = tid >> 4;
    uint4 g[2];
    if (FINAL) {
#pragma unroll
        for (int half = 0; half < 2; ++half) { const int t = t0 + tr + 32 * half; g[half] = (t < L) ? *(const uint4*)(GATEg + (size_t)t * RNN_W + ch0 + 8 * c8) : make_uint4(0u, 0u, 0u, 0u); } }
    __syncthreads();
    {
        float bv[8];
        { const float4 b0 = *(const float4*)(cwl + 512 + 8 * c8), b1 = *(const float4*)(cwl + 512 + 8 * c8 + 4); bv[0] = b0.x; bv[1] = b0.y; bv[2] = b0.z; bv[3] = b0.w; bv[4] = b1.x; bv[5] = b1.y; bv[6] = b1.z; bv[7] = b1.w; }
#pragma unroll
        for (int half = 0; half < 2; ++half) { const int tl = tr + 32 * half;
            float v[8];
#pragma unroll
            for (int i = 0; i < 8; ++i) v[i] = bv[i];
#pragma unroll
            for (int j = 0; j < 4; ++j) { const uint4 xv = R.x[half][j];
                const float4 w0 = *(const float4*)(cwl + j * 128 + 8 * c8), w1 = *(const float4*)(cwl + j * 128 + 8 * c8 + 4);
                v[0] += w0.x * bflo(xv.x); v[1] += w0.y * bfhi(xv.x); v[2] += w0.z * bflo(xv.y); v[3] += w0.w * bfhi(xv.y);
                v[4] += w1.x * bflo(xv.z); v[5] += w1.y * bfhi(xv.z); v[6] += w1.z * bflo(xv.w); v[7] += w1.w * bfhi(xv.w); }
            *(float4*)(xcf + tl * 132 + 8 * c8) = make_float4(v[0], v[1], v[2], v[3]); *(float4*)(xcf + tl * 132 + 8 * c8 + 4) = make_float4(v[4], v[5], v[6], v[7]);
            uint4 pk; pk.x = cvt_pk_bf16(v[0], v[1]); pk.y = cvt_pk_bf16(v[2], v[3]); pk.z = cvt_pk_bf16(v[4], v[5]); pk.w = cvt_pk_bf16(v[6], v[7]);
            *(uint4*)(xcb + (16 * ((tl >> 2) & 3) + 4 * (tl >> 4) + (tl & 3)) * 136 + 8 * c8) = pk; }
    }
    __syncthreads();
    f32x4 ca[4], cx[4];
#pragma unroll
    for (int mt = 0; mt < 4; ++mt) { ca[mt] = (f32x4){0.f, 0.f, 0.f, 0.f}; cx[mt] = (f32x4){0.f, 0.f, 0.f, 0.f};
#pragma unroll
        for (int ks = 0; ks < 4; ++ks) { const bf16x8_t af = *(const bf16x8_t*)(xcb + (16 * mt + col) * 136 + 32 * ks + 8 * quad);
            ca[mt] = __builtin_amdgcn_mfma_f32_16x16x32_bf16(af, fa[ks], ca[mt], 0, 0, 0);
            cx[mt] = __builtin_amdgcn_mfma_f32_16x16x32_bf16(af, fx[ks], cx[mt], 0, 0, 0); } }
    float av[4][4], uv[4][4]; float A = 1.f, H = 0.f;
#pragma unroll
    for (int mt = 0; mt < 4; ++mt) {
#pragma unroll
        for (int j = 0; j < 4; ++j) { const int tl = 16 * quad + 4 * mt + j;
            const float xcv = xcf[tl * 132 + 16 * w + col];
            const float r = fsigm(ca[mt][j] + bav), ig = fsigm(cx[mt][j] + bxv);
            const float la = -8.0f * r * sp;
            const float x2 = 2.0f * la;
            float em1 = x2 * (1.0f + x2 * (0.5f + x2 * (0.16666667f + x2 * (0.041666668f + x2 * (0.0083333338f + x2 * (0.0013888889f + x2 * 0.0001984127f))))));
            if (x2 < -0.5f) em1 = expm1f(x2);
            float a_ = __expf(la), u_ = __builtin_amdgcn_sqrtf(-em1) * (ig * xcv);
            if (t0 + tl >= L) { a_ = 1.f; u_ = 0.f; }
            av[mt][j] = a_; uv[mt][j] = u_; H = a_ * H + u_; A *= a_; } }
    float carry = cinv, prod = 1.f, hin = 0.f;
#pragma unroll
    for (int q = 0; q < 4; ++q) {
        if (quad == q) hin = carry;
        const float nw = A * carry + H, np = A * prod;
        carry = __shfl(nw, q * 16 + col); prod = __shfl(np, q * 16 + col); }
    if (!FINAL) {
        if (quad == 0) { Aend[(size_t)ch * CP + c] = prod; Hend[(size_t)ch * CP + c] = carry; }
    } else {
        float h = hin;
#pragma unroll
        for (int mt = 0; mt < 4; ++mt)
#pragma unroll
            for (int j = 0; j < 4; ++j) { h = av[mt][j] * h + uv[mt][j]; xcf[(16 * quad + 4 * mt + j) * 132 + 16 * w + col] = h; }
        __syncthreads();
#pragma unroll
        for (int half = 0; half < 2; ++half) { const int tl = tr + 32 * half, t = t0 + tl;
            if (t >= NMETA && t < L) {
                const float4 h0 = *(const float4*)(xcf + tl * 132 + 8 * c8), h1 = *(const float4*)(xcf + tl * 132 + 8 * c8 + 4);
                const uint4 gg = g[half];
                uint4 pk; pk.x = cvt_pk_bf16(bflo(gg.x) * h0.x, bfhi(gg.x) * h0.y); pk.y = cvt_pk_bf16(bflo(gg.y) * h0.z, bfhi(gg.y) * h0.w);
                pk.z = cvt_pk_bf16(bflo(gg.z) * h1.x, bfhi(gg.z) * h1.y); pk.w = cvt_pk_bf16(bflo(gg.w) * h1.z, bfhi(gg.w) * h1.w);
                *(uint4*)(YY + (size_t)t * RNN_W + ch0 + 8 * c8) = pk; } }
    }
}
template <bool FINAL>
DEVI void rglru_phase(const bf16_t* __restrict__ XR, const bf16_t* __restrict__ GATEg, const bf16_t* __restrict__ Wta, const bf16_t* __restrict__ Wtx,
                      const float* __restrict__ cw, const float* __restrict__ cb, const float* __restrict__ ba, const float* __restrict__ bx, const float* __restrict__ lam,
                      float* __restrict__ Aend, float* __restrict__ Hend, const float* __restrict__ CIN, bf16_t* __restrict__ YY, unsigned char* lds) {
    const int tid = otid(), lane = tid & 63, w = tid >> 6, col = lane & 15, quad = lane >> 4;
    const int G = gridDim.x, nb = blockIdx.x % RNN_NB, rank = blockIdx.x / RNN_NB, nblk = (G - nb + RNN_NB - 1) / RNN_NB;
    const int ch0 = nb * RNN_BW, ch = ch0 + 16 * w + col;
    float* cwl = (float*)(lds + 64 * 136 * 2 + 64 * 132 * 4);
    __syncthreads();
    for (int i = tid; i < 640; i += NTHREADS) cwl[i] = i < 512 ? cw[(i >> 7) * RNN_W + ch0 + (i & 127)] : cb[ch0 + (i - 512)];
    bf16x8_t fa[4], fx[4];
    { const size_t wrow = ((size_t)nb * 128 + 16 * w + col) * 128 + 8 * quad;
#pragma unroll
      for (int ks = 0; ks < 4; ++ks) { fa[ks] = *(const bf16x8_t*)(Wta + wrow + 32 * ks); fx[ks] = *(const bf16x8_t*)(Wtx + wrow + 32 * ks); } }
    const float bav = ba[ch], bxv = bx[ch], sp = log1pf(expf(-lam[ch]));
    RgIn Ra, Rb;
    int c = rank;
    if (c < NCHUNK) rglru_fetch(c, ch0, XR, tid, Ra);
    while (c < NCHUNK) {
        int cn = c + nblk;
        if (cn < NCHUNK) rglru_fetch(cn, ch0, XR, tid, Rb);
        rglru_unit<FINAL>(c, nb, Ra, fa, fx, bav, bxv, sp, GATEg, Aend, Hend, CIN, YY, lds, tid);
        c = cn; if (c >= NCHUNK) break;
        cn = c + nblk;
        if (cn < NCHUNK) rglru_fetch(cn, ch0, XR, tid, Ra);
        rglru_unit<FINAL>(c, nb, Rb, fa, fx, bav, bxv, sp, GATEg, Aend, Hend, CIN, YY, lds, tid);
        c = cn;
    }
    __syncthreads();
}

constexpr int SW = 544;
constexpr int CB = 512;
constexpr int NTILE = L / 16;
typedef float f32x16 __attribute__((ext_vector_type(16)));
typedef float f32x2v __attribute__((ext_vector_type(2)));
constexpr int HROW = 2112;
constexpr int IL_HIST = 0, IL_CKEY = 0, IL_CIDX = 16 * CB * 4, IL_HIST2 = 2 * 16 * CB * 4, IL_ROWS = IL_HIST2 + 16 * 256 * 4, IL_WI = 16 * HROW * 4, IL_QST = IL_WI + 512, IL_QST2 = IL_QST + 256, IL_CCNT = IL_QST2 + 256, IL_FLAG = IL_CCNT + 64;
constexpr int IL_QF = IL_ROWS + 16 * SW * 4;
static_assert(IL_QF + 8 * 512 <= IL_WI && IL_FLAG + 64 <= LDS_BYTES - 16, "indexer LDS");

constexpr int AW_BYTES = 512;
typedef short s16x2 __attribute__((ext_vector_type(2)));
DEVI float dot2bf(unsigned a, unsigned b, float c) { return __builtin_amdgcn_fdot2_f32_bf16(__builtin_bit_cast(s16x2, a), __builtin_bit_cast(s16x2, b), c, false); }
#define LDS_FENCE() asm volatile("s_waitcnt lgkmcnt(0)" ::: "memory")

struct AttnQ { float m, l, o[8]; };

DEVI void attn_issue(int b0, int n, const unsigned short* lst, const unsigned char* __restrict__ KV8, int lane, uint4 (&kv)[8]) {
    const int last = n - 1;
#pragma unroll
    for (int kk = 0; kk < 8; ++kk) { const int ii = b0 + kk; const int key = lst[ii < last ? ii : last]; kv[kk] = *(const uint4*)(KV8 + (size_t)key * 1024 + lane * 16); }
}
DEVI void attn_compute(AttnQ& S, int b0, int n, const float (&q)[8], const uint4 (&kv)[8]) {
    float sc[8]; float mx = S.m;
#pragma unroll
    for (int u = 0; u < 8; ++u) {
        const f32x2v k0 = __builtin_amdgcn_cvt_pk_f32_fp8((int)kv[u].x, false), k1 = __builtin_amdgcn_cvt_pk_f32_fp8((int)kv[u].x, true),
                     k2 = __builtin_amdgcn_cvt_pk_f32_fp8((int)kv[u].y, false), k3 = __builtin_amdgcn_cvt_pk_f32_fp8((int)kv[u].y, true);
        f32x2v d2 = k0 * (f32x2v){q[0], q[1]}; d2 = k1 * (f32x2v){q[2], q[3]} + d2; d2 = k2 * (f32x2v){q[4], q[5]} + d2; d2 = k3 * (f32x2v){q[6], q[7]} + d2;
        float d = d2[0] + d2[1];
        d += dpp_f<0xB1>(d); d += dpp_f<0x4E>(d); d += dpp_f<0x141>(d);
        sc[u] = (b0 + u < n) ? d : -INFINITY;
        mx = fmaxf(mx, sc[u]); }
    const float scale = __builtin_amdgcn_exp2f(S.m - mx);
    float ls = S.l * scale;
#pragma unroll
    for (int i = 0; i < 8; ++i) S.o[i] *= scale;
#pragma unroll
    for (int u = 0; u < 8; ++u) {
        const float p = __builtin_amdgcn_exp2f(sc[u] - mx); ls += p;
        const f32x2v v0 = __builtin_amdgcn_cvt_pk_f32_fp8((int)kv[u].z, false), v1 = __builtin_amdgcn_cvt_pk_f32_fp8((int)kv[u].z, true),
                     v2 = __builtin_amdgcn_cvt_pk_f32_fp8((int)kv[u].w, false), v3 = __builtin_amdgcn_cvt_pk_f32_fp8((int)kv[u].w, true);
        S.o[0] += p * v0[0]; S.o[1] += p * v0[1]; S.o[2] += p * v1[0]; S.o[3] += p * v1[1]; S.o[4] += p * v2[0]; S.o[5] += p * v2[1]; S.o[6] += p * v3[0]; S.o[7] += p * v3[1]; }
    S.l = ls; S.m = mx;
}

DEVI void attn_query(int t, const bf16_t* __restrict__ Qb, const unsigned char* __restrict__ KV8,
                     const unsigned* SR  , bf16_t* __restrict__ AO, unsigned char* wl, int lane) {
    unsigned short* lst = (unsigned short*)wl;
    LDS_FENCE();
    const int nw = (t >> 5) + 1; int base = 0;
    for (int w0 = 0; w0 < nw; w0 += 64) {
        const int wi = w0 + lane; const unsigned wv = wi < nw ? SR[wi] : 0u;
        const int pc = __popc(wv); int pre = pc;
#pragma unroll
        for (int off = 1; off < 64; off <<= 1) { const int o_ = __shfl_up(pre, off); if (lane >= off) pre += o_; }
        int pos = base + pre - pc; unsigned mm = wv;
        while (mm) { const int bpos = __ffs((int)mm) - 1; mm &= mm - 1u; if (pos < TOPK) lst[pos] = (unsigned short)(wi * 32 + bpos); ++pos; }
        base += __shfl(pre, 63);
    }
    const int n = base < TOPK ? base : TOPK;
    float q[8];
    { const uint4 qv = ((const uint4*)(Qb + (size_t)t * 512))[lane]; const float qs = 0.18033688011112042f;
      q[0] = bflo(qv.x) * qs; q[1] = bfhi(qv.x) * qs; q[2] = bflo(qv.y) * qs; q[3] = bfhi(qv.y) * qs; q[4] = bflo(qv.z) * qs; q[5] = bfhi(qv.z) * qs; q[6] = bflo(qv.w) * qs; q[7] = bfhi(qv.w) * qs; }
    LDS_FENCE();
    AttnQ S; S.m = -INFINITY; S.l = 0.f;
#pragma unroll
    for (int d = 0; d < 8; ++d) S.o[d] = 0.f;
    uint4 ka[8], kb_[8], kc[8];
    attn_issue(0, n, lst, KV8, lane, ka);
    if (8 < n) attn_issue(8, n, lst, KV8, lane, kb_);
    for (int b0 = 0; b0 < n; b0 += 24) {
        if (b0 + 16 < n) attn_issue(b0 + 16, n, lst, KV8, lane, kc);
        attn_compute(S, b0, n, q, ka);
        if (b0 + 8 < n) {
            if (b0 + 24 < n) attn_issue(b0 + 24, n, lst, KV8, lane, ka);
            attn_compute(S, b0 + 8, n, q, kb_);
            if (b0 + 16 < n) {
                if (b0 + 32 < n) attn_issue(b0 + 32, n, lst, KV8, lane, kb_);
                attn_compute(S, b0 + 16, n, q, kc);
            }
        }
    }
    const int hd = lane >> 3, ch = lane & 7;
    const float inv = 1.0f / S.l;
    uint4 pk; pk.x = cvt_pk_bf16(S.o[0] * inv, S.o[1] * inv); pk.y = cvt_pk_bf16(S.o[2] * inv, S.o[3] * inv); pk.z = cvt_pk_bf16(S.o[4] * inv, S.o[5] * inv); pk.w = cvt_pk_bf16(S.o[6] * inv, S.o[7] * inv);
    *(uint4*)(AO + (size_t)t * 1024 + 512 + hd * 64 + ch * 8) = pk;
}

DEVI float relu_i(float x) { const int v = __float_as_int(x); return __int_as_float(v > 0 ? v : 0); }
DEVI int hpos(unsigned w) { return (int)(w + (w >> 5)); }
template <int PASS, bool L0>
DEVI void idx_sweep(int q0, int nkb, int wave, int lane, const bf16x8_t (&Af)[4][4], const bf16_t* __restrict__ KI, unsigned char* lds, unsigned* __restrict__ SELM) {
    const int l31 = lane & 31, h2 = lane >> 5;
    unsigned* hist = (unsigned*)(lds + IL_HIST);
    const float* wiL = (const float*)(lds + IL_WI);
    const uint4* qst = (const uint4*)(lds + IL_QST);
    const uint4* qst2 = (const uint4*)(lds + IL_QST2);
    unsigned* ckey = (unsigned*)(lds + IL_CKEY); unsigned* cidx = (unsigned*)(lds + IL_CIDX); unsigned* ccnt = (unsigned*)(lds + IL_CCNT); unsigned* rows = (unsigned*)(lds + IL_ROWS);
    const bf16_t* kp = KI + (size_t)l31 * 64 + 8 * h2;
    bf16x8_t Bn[4];
    if (wave < nkb) {
#pragma unroll
        for (int ks = 0; ks < 4; ++ks) Bn[ks] = *(const bf16x8_t*)(kp + (size_t)wave * 2048 + 16 * ks); }
    for (int kb = wave; kb < nkb; kb += 8) {
        const int s = kb * 32 + l31;
        bf16x8_t Bf[4];
#pragma unroll
        for (int ks = 0; ks < 4; ++ks) Bf[ks] = Bn[ks];
        if (kb + 8 < nkb) {
#pragma unroll
            for (int ks = 0; ks < 4; ++ks) Bn[ks] = *(const bf16x8_t*)(kp + (size_t)(kb + 8) * 2048 + 16 * ks); }
        f32x16 acc[4];
#pragma unroll
        for (int rb = 0; rb < 4; ++rb) {
#pragma unroll
            for (int i = 0; i < 16; ++i) acc[rb][i] = 0.f; }
#pragma unroll
        for (int ks = 0; ks < 4; ++ks) acc[0] = __builtin_amdgcn_mfma_f32_32x32x16_bf16(Af[0][ks], Bf[ks], acc[0], 0, 0, 0);
        const bool edge = kb * 32 + 31 > q0;
        float4 wn[2][2]; uint4 stn[2];
#pragma unroll
        for (int e = 0; e < 2; ++e) { wn[e][0] = *(const float4*)(wiL + (2 * h2 + e) * 8); wn[e][1] = *(const float4*)(wiL + (2 * h2 + e) * 8 + 4);
            if (PASS == 2) stn[e] = qst2[2 * h2 + e]; else if (!L0) stn[e] = qst[2 * h2 + e]; }
#pragma unroll
        for (int rb = 0; rb < 4; ++rb) {
            if (rb + 1 < 4) {
#pragma unroll
                for (int ks = 0; ks < 4; ++ks) acc[rb + 1] = __builtin_amdgcn_mfma_f32_32x32x16_bf16(Af[rb + 1][ks], Bf[ks], acc[rb + 1], 0, 0, 0); }
            const int qa = 4 * rb + 2 * h2;
            float4 w[2][2]; uint4 st[2];
#pragma unroll
            for (int e = 0; e < 2; ++e) { w[e][0] = wn[e][0]; w[e][1] = wn[e][1]; st[e] = stn[e]; }
            if (rb + 1 < 4) {
#pragma unroll
                for (int e = 0; e < 2; ++e) { wn[e][0] = *(const float4*)(wiL + (qa + 4 + e) * 8); wn[e][1] = *(const float4*)(wiL + (qa + 4 + e) * 8 + 4);
                    if (PASS == 2) stn[e] = qst2[qa + 4 + e]; else if (!L0) stn[e] = qst[qa + 4 + e]; } }
#pragma unroll
            for (int e = 0; e < 2; ++e) {
                const int qs = qa + e;
                f32x2v s2 = (f32x2v){relu_i(acc[rb][8 * e + 0]), relu_i(acc[rb][8 * e + 1])} * (f32x2v){w[e][0].x, w[e][0].y};
                s2 = (f32x2v){relu_i(acc[rb][8 * e + 2]), relu_i(acc[rb][8 * e + 3])} * (f32x2v){w[e][0].z, w[e][0].w} + s2;
                s2 = (f32x2v){relu_i(acc[rb][8 * e + 4]), relu_i(acc[rb][8 * e + 5])} * (f32x2v){w[e][1].x, w[e][1].y} + s2;
                s2 = (f32x2v){relu_i(acc[rb][8 * e + 6]), relu_i(acc[rb][8 * e + 7])} * (f32x2v){w[e][1].z, w[e][1].w} + s2;
                const float sc = s2[0] + s2[1];
                const bool valid = !edge || s <= q0 + qs;
                const unsigned key = f2key(sc);
                if (PASS == 1) {
                    if (L0) { if (valid) { const unsigned bin = key >> 20; atomicAdd(&hist[qs * HROW + hpos(bin >> 1)], (bin & 1u) ? 0x10000u : 1u); } }
                    else if (valid && (key & st[e].x) == st[e].y) { const unsigned bin = (key >> st[e].z) & st[e].w; atomicAdd(&hist[qs * HROW + hpos(bin >> 1)], (bin & 1u) ? 0x10000u : 1u); }
                } else {
                    const bool all = st[e].z == 0xFFFFFFFFu;
                    const bool sel = valid && (all || key >= st[e].y);
                    const bool cnd = valid && !all && key >= st[e].x && key < st[e].y;
                    const unsigned long long bal = __ballot(sel);
                    rows[qs * SW + kb] = h2 ? (unsigned)(bal >> 32) : (unsigned)bal;
                    if (cnd) { const unsigned n = atomicAdd(&ccnt[qs], 1u); if (n < (unsigned)CB) { ckey[qs * CB + n] = key; cidx[qs * CB + n] = (unsigned)s; } }
                }
            }
        }
    }
}

DEVI void indexer_tile(int q0, const bf16_t* __restrict__ QI, const bf16_t* __restrict__ KI, const float* __restrict__ WI, const bf16_t* __restrict__ Qb, const unsigned char* __restrict__ KV8, bf16_t* __restrict__ AO, unsigned char* lds) {
    const int tid = otid(), lane = tid & 63, wave = tid >> 6;
    unsigned* hist = (unsigned*)(lds + IL_HIST);
    float* wiL = (float*)(lds + IL_WI);
    uint4* qst = (uint4*)(lds + IL_QST); uint4* qst2 = (uint4*)(lds + IL_QST2);
    unsigned* ckey = (unsigned*)(lds + IL_CKEY); unsigned* cidx = (unsigned*)(lds + IL_CIDX); unsigned* hist2 = (unsigned*)(lds + IL_HIST2); unsigned* ccnt = (unsigned*)(lds + IL_CCNT);
    volatile unsigned* flag = (volatile unsigned*)(lds + IL_FLAG);
    const int nkb = (q0 + 16 + 31) >> 5;
    bf16x8_t Af[4][4];
    { const int rho = lane & 31, hq = lane >> 5; const int qq = 2 * ((rho >> 2) & 1) + (rho >> 4), head = 4 * ((rho >> 3) & 1) + (rho & 3);
#pragma unroll
      for (int rb = 0; rb < 4; ++rb)
#pragma unroll
          for (int ks = 0; ks < 4; ++ks) Af[rb][ks] = *(const bf16x8_t*)(QI + (size_t)(q0 + 4 * rb + qq) * 512 + head * 64 + 16 * ks + 8 * hq); }
    __syncthreads();
    if (tid < 128) wiL[tid] = WI[(size_t)q0 * 8 + tid] * 0.125f;
    if (tid < 16) { const unsigned z = opq(0u); qst[tid] = make_uint4(z, z, opq(20u), opq(4095u)); qst2[tid] = make_uint4(z, z, opq((unsigned)TOPK), z); ccnt[tid] = z; }
    for (int level = 0; level < 3; ++level) {
        for (int i = tid; i < 16 * HROW / 4; i += NTHREADS) ((uint4*)hist)[i] = make_uint4(0u, 0u, 0u, 0u);
        if (tid == 0) flag[0] = 0u;
        __syncthreads();
        if (level == 0) idx_sweep<1, true>(q0, nkb, wave, lane, Af, KI, lds, nullptr); else idx_sweep<1, false>(q0, nkb, wave, lane, Af, KI, lds, nullptr);
        __syncthreads();
#pragma unroll 1
        for (int qi = 0; qi < 2; ++qi) {
            const int qs = 2 * wave + qi;
            const uint4 st = qst[qs]; const uint4 b = qst2[qs];
            if (st.x == 0xFFFFFFFFu && st.y == 0u && st.w == 0u) continue;
            unsigned wv[32]; unsigned loc = 0u;
#pragma unroll
            for (int i = 0; i < 32; ++i) { wv[i] = hist[qs * HROW + 33 * lane + i]; loc += (wv[i] & 0xFFFFu) + (wv[i] >> 16); }
            unsigned suf = loc;
#pragma unroll
            for (int off = 1; off < 64; off <<= 1) { const unsigned o = __shfl_down(suf, off); if (lane + off < 64) suf += o; }
            const unsigned total = __shfl(suf, 0), above = suf - loc, need = b.z;
            if (level == 0 && total <= need) { if (lane == 0) { qst[qs] = make_uint4(0xFFFFFFFFu, 0u, 0u, 0u); qst2[qs] = make_uint4(0u, 0u, 0xFFFFFFFFu, 0u); } continue; }
            const bool mine = above < need && need <= above + loc;
            unsigned cum = above, c = 0u; int d = 0; bool found = false;
#pragma unroll
            for (int i = 31; i >= 0; --i) {
                const unsigned chi = wv[i] >> 16, clo = wv[i] & 0xFFFFu;
                if (!found && cum + chi >= need) { found = true; d = 64 * lane + 2 * i + 1; c = chi; } if (!found) cum += chi;
                if (!found && cum + clo >= need) { found = true; d = 64 * lane + 2 * i; c = clo; } if (!found) cum += clo; }
            if (mine) {
                const unsigned pval = st.y | ((unsigned)d << st.z), pmask = st.x | (st.w << st.z);
                const unsigned nneed = need - cum;
                const unsigned long long hi64 = (unsigned long long)pval + (1ull << st.z);
                const unsigned hi = hi64 > 0xFFFFFFFFull ? 0xFFFFFFFFu : (unsigned)hi64;
                if (c <= (unsigned)CB || level == 2) { qst[qs] = make_uint4(0xFFFFFFFFu, 0u, 0u, 0u); qst2[qs] = make_uint4(pval, hi, nneed, st.z); }
                else { const unsigned nsh = (level == 0) ? 8u : 0u, ndm = (level == 0) ? 4095u : 255u; qst[qs] = make_uint4(pmask, pval, nsh, ndm); qst2[qs] = make_uint4(pval, hi, nneed, st.z); flag[0] = 1u; }
            }
        }
        __syncthreads();
        if (flag[0] == 0u) break;
        __syncthreads();
    }
    __syncthreads();
    idx_sweep<2, false>(q0, nkb, wave, lane, Af, KI, lds, nullptr);
    asm volatile("s_waitcnt vmcnt(0)" ::: "memory");
    __syncthreads();
    unsigned* rows = (unsigned*)(lds + IL_ROWS);
#pragma unroll 1
    for (int qi = 0; qi < 2; ++qi) {
        const int qs = 2 * wave + qi;
        const uint4 b = qst2[qs];
        unsigned* row = rows + qs * SW;
        if (b.z != 0xFFFFFFFFu) {
            const unsigned need = b.z; const unsigned cn = ccnt[qs]; const int n = (int)(cn < (unsigned)CB ? cn : (unsigned)CB);
            const unsigned rem = b.w;
            const unsigned sh8 = rem > 8u ? rem - 8u : 0u; const unsigned m8 = rem >= 8u ? 255u : ((1u << rem) - 1u);
#pragma unroll
            for (int i = 0; i < 4; ++i) hist2[qs * 256 + 4 * lane + i] = 0u;
            asm volatile("s_waitcnt lgkmcnt(0)" ::: "memory");
            for (int i = lane; i < n; i += 64) atomicAdd(&hist2[qs * 256 + ((ckey[qs * CB + i] >> sh8) & m8)], 1u);
            asm volatile("s_waitcnt lgkmcnt(0)" ::: "memory");
            unsigned c4[4]; unsigned loc = 0u;
#pragma unroll
            for (int i = 0; i < 4; ++i) { c4[i] = hist2[qs * 256 + 4 * lane + i]; loc += c4[i]; }
            unsigned suf = loc;
#pragma unroll
            for (int off = 1; off < 64; off <<= 1) { const unsigned o = __shfl_down(suf, off); if (lane + off < 64) suf += o; }
            const unsigned above = suf - loc;
            const bool mine = above < need && need <= above + loc;
            unsigned b2 = 0u, need2 = 0u;
            if (mine) { unsigned cum = above; int i = 3; for (; i > 0; --i) { if (cum + c4[i] >= need) break; cum += c4[i]; } b2 = 4u * lane + i; need2 = need - cum; }
            const unsigned long long mb = __ballot(mine);
            if (mb == 0ull) {
                for (int i = lane; i < n; i += 64) if ((unsigned)i < need) { const unsigned ii = cidx[qs * CB + i]; atomicOr(&row[ii >> 5], 1u << (ii & 31u)); }
            } else {
                const int src = __ffsll((long long)mb) - 1;
                b2 = __shfl(b2, src); need2 = __shfl(need2, src);
                for (int i0 = 0; i0 < n; i0 += 64) {
                    const int i = i0 + lane; const bool act = i < n;
                    const unsigned ki = act ? ckey[qs * CB + i] : 0u, ii = act ? cidx[qs * CB + i] : 0u; const unsigned d8 = (ki >> sh8) & m8;
                    if (act && d8 > b2) atomicOr(&row[ii >> 5], 1u << (ii & 31u));
                    unsigned long long tie = __ballot(act && d8 == b2);
                    while (tie) {
                        const int ml = __ffsll((long long)tie) - 1; tie &= tie - 1ull;
                        const unsigned km = __shfl(ki, ml), im = __shfl(ii, ml);
                        unsigned rank = 0u;
                        for (int j0 = 0; j0 < n; j0 += 64) { const int j = j0 + lane; bool beats = false;
                            if (j < n) { const unsigned kj = ckey[qs * CB + j], ij = cidx[qs * CB + j]; beats = ((kj >> sh8) & m8) == b2 && (kj > km || (kj == km && ij < im)); }
                            rank += (unsigned)__popcll(__ballot(beats)); }
                        if (rank < need2 && lane == ml) atomicOr(&row[im >> 5], 1u << (im & 31u));
                    }
                }
            }
        }
    }
    asm volatile("s_waitcnt lgkmcnt(0)" ::: "memory");
    __syncthreads();
    for (int qi = 0; qi < 2; ++qi) { const int qs = 2 * wave + qi;
        attn_query(q0 + qs, Qb, KV8, rows + qs * SW, AO, lds + IL_QF + wave * 512, lane); }
}

DEVI TrJob moe_job(int j, const float* wg, const float* wu, const float* wd, bf16_t* WGU, bf16_t* WD) {
    TrJob J{};
    if (j < 32 * 256) { const int e = j >> 8, t = j & 255; J.dst = WGU + (size_t)e * 1024 * 1024; J.s0 = wg + (size_t)e * D * DE; J.s1 = wu + (size_t)e * D * DE; J.K = 1024; J.n0 = (t >> 4) * 64; J.k0 = (t & 15) * 64; J.mode = 2; return J; }
    j -= 32 * 256;
    { const int e = j >> 7, t = j & 127; J.dst = WD + (size_t)e * 1024 * 512; J.s0 = wd + (size_t)e * DE * D; J.ld = D; J.K = 512; J.n0 = (t >> 3) * 64; J.k0 = (t & 7) * 64; J.mode = 0; return J; }
}
constexpr int MOE0_ALL = 32 * 256 + 32 * 128, MOE0_P1W = 28, MOE0_P4W = 10;
constexpr int P1_BUSY = (LP / 256) * 13 - 3 * 256, P4_BUSY = (LP / 256) * 4 - 256;
constexpr int MOE0_P7 = 2688;
constexpr int MOE0_P1 = (256 - P1_BUSY) * MOE0_P1W, MOE0_P4 = (256 - P4_BUSY) * MOE0_P4W, MOE0_P0 = MOE0_ALL - MOE0_P1 - MOE0_P4 - MOE0_P7;
static_assert(MOE0_P0 > 0 && P1_BUSY == 77 && P4_BUSY == 4 && MOE0_P0 + MOE0_P1 + MOE0_P4 >= 32 * 256, "tail split (the P7 tail may only write WD)");
constexpr int P10_BUSY = (LP / 256) * 10 - 2 * 256;
constexpr int MOE1_P8 = 1536, MOE1_P10 = (256 - P10_BUSY) * 25, MOE1_P15 = MOE0_ALL - MOE1_P8 - MOE1_P10;
static_assert(P10_BUSY == 138 && MOE1_P8 <= 32 * 256 && MOE1_P15 > 0, "tail split, layer 1");
DEVI void moe_idle(const int* mtiles, int& rank, int& cnt) { const int G = (int)gridDim.x, nun = mtiles[0] * 4, busy = nun % G;
    if (busy == 0) { rank = (int)blockIdx.x; cnt = G; } else { rank = (int)blockIdx.x - busy; cnt = G - busy; } }

__global__ void __launch_bounds__(NTHREADS, 2) fwd(Args a) {
    extern __shared__ __attribute__((aligned(16))) unsigned char lds_raw[];
    float* smf = (float*)lds_raw;
    PG8_LAS unsigned char* ldsp = (PG8_LAS unsigned char*)lds_raw;
    const int nwaves = gridDim.x * 8;
#define PHASE_VARS const int tid = otid(); const int lane = tid & 63, wave = tid >> 6; const int gwave = blockIdx.x * 8 + wave; (void)lane; (void)wave; (void)gwave;
    unsigned char* ws = a.ws;
    unsigned* ctl = (unsigned*)(ws + WS_CTL);
    const int lo = a.ph_lo, hi = a.ph_hi;

    volatile LAS unsigned* bst = (volatile LAS unsigned*)((LAS unsigned char*)lds_raw + (LDS_BYTES - 16));
    if (threadIdx.x == 0) { bst[0] = 0u; bst[1] = 0u; bst[2] = 0u; bst[3] = 0u; }
    __syncthreads();
    XcdBarrier bar; bar.bar = ctl; bar.x = 0; bar.st = bst;
    if (hi - lo > 1) bar = xcd_barrier_post(ctl, bst);
#define IN(k) (lo <= (k) && (k) < hi)
#define SEAM(k) do { if (IN(k) && IN((k) + 1)) xcd_barrier(bar); } while (0)

    const float* x = a.in[0]; const float* meta = a.in[1];
    float* ropeC = (float*)(ws + WS_ROPEC); float* ropeS = (float*)(ws + WS_ROPES);
    int* eid = (int*)(ws + WS_EID); float* gw = (float*)(ws + WS_GW); int* slot = (int*)(ws + WS_SLOT); int* mtiles = (int*)(ws + WS_MTILES);
    unsigned* counts0 = (unsigned*)(ws + CTL_CNT); unsigned* counts1 = counts0 + 32;
    unsigned* cursor0 = (unsigned*)(ws + CTL_CUR); unsigned* cursor1 = cursor0 + 32;
    bf16_t* Wta = (bf16_t*)(ws + WS_WTA); bf16_t* Wtx = (bf16_t*)(ws + WS_WTX);
    float* Aend = (float*)(ws + WS_AEND); float* Hend = (float*)(ws + WS_HEND); float* CIN = (float*)(ws + WS_CIN);
    unsigned char* big = ws + WS_BIG;
    bf16_t* WIN0 = (bf16_t*)(big + R_WIN0); bf16_t* WOUT0 = (bf16_t*)(big + R_WOUT0); bf16_t* WGU = (bf16_t*)(big + R_WGU); bf16_t* WD = (bf16_t*)(big + R_WD);
    bf16_t* WIN1 = (bf16_t*)(big + R_WIN1); bf16_t* WOUT1 = (bf16_t*)(big + R_WOUT1);
    bf16_t* X0b = (bf16_t*)(big + R_A); bf16_t* AO = (bf16_t*)(big + R_A); bf16_t* Xperm = (bf16_t*)(big + R_A); bf16_t* X2b = (bf16_t*)(big + R_A); bf16_t* YY = (bf16_t*)(big + R_A);
    float* H1 = (float*)(big + R_H1); float* H3 = (float*)(big + R_H1); float* H2 = (float*)(big + R_H2); unsigned* SELM = (unsigned*)(big + R_H1); unsigned* SELM2 = (unsigned*)(big + R_H1 + 36 * MiB);
    float* Z = (float*)(big + R_C); bf16_t* Yb = (bf16_t*)(big + R_C); float* Z1 = (float*)(big + R_C);
    unsigned char* KV8 = big + R_K;
    bf16_t* GLU = (bf16_t*)(big + R_GLU); bf16_t* Qb = (bf16_t*)(big + R_Q); bf16_t* Kb = (bf16_t*)(big + R_K); bf16_t* Vb = (bf16_t*)(big + R_V);
    bf16_t* QIb = (bf16_t*)(big + R_QI); bf16_t* KIb = (bf16_t*)(big + R_KI); float* WIf = (float*)(big + R_WI);
    bf16_t* GATEg = (bf16_t*)(big + R_GATE); bf16_t* XRb = (bf16_t*)(big + R_XR);
    bf16_t* Hm = (bf16_t*)(big + R_HM);

    if (IN(0)) { PHASE_VARS;
        const float* w_in = a.in[2]; const float* w_out = a.in[7]; const float* wg = a.in[21]; const float* wu = a.in[22]; const float* wd = a.in[23];
        constexpr int J_IN0 = 52 * 16, J_OUT0 = 16 * 16, J_GU = 32 * 256, J_D = 32 * 128, J_IN1 = 40 * 16, J_OUT1 = 16 * 20, J_GT = 80;
        const float* w_in1 = a.in[8]; const float* w_out1 = a.in[16]; const float* wga = a.in[11]; const float* wgx = a.in[13];
        const int moe_p0 = gridDim.x == 256 ? MOE0_P0 : MOE0_ALL;
        tr_run(J_IN0 + J_OUT0 + moe_p0 + J_IN1 + J_OUT1 + J_GT, [&](int j) -> TrJob {
            TrJob J{};
            if (j < J_IN0) { J.dst = WIN0; J.s0 = w_in; J.K = 1024; J.n0 = (j >> 4) * 64; J.k0 = (j & 15) * 64; J.mode = 1; return J; }
            j -= J_IN0;
            if (j < J_OUT0) { J.dst = WOUT0; J.s0 = w_out; J.ld = D; J.K = 1024; J.n0 = (j >> 4) * 64; J.k0 = (j & 15) * 64; J.mode = 0; return J; }
            j -= J_OUT0;
            if (j < moe_p0) return moe_job(j, wg, wu, wd, WGU, WD);
            j -= moe_p0;
            if (j < J_IN1) { J.dst = WIN1; J.s0 = w_in1; J.ld = 2 * RNN_W; J.K = 1024; J.n0 = (j >> 4) * 64; J.k0 = (j & 15) * 64; J.mode = 0; return J; }
            j -= J_IN1;
            if (j < J_OUT1) { J.dst = WOUT1; J.s0 = w_out1; J.ld = D; J.K = RNN_W; J.n0 = (j / 20) * 64; J.k0 = (j % 20) * 64; J.mode = 0; return J; }
            j -= J_OUT1;
            { const int which = j / 40, r = j % 40; const int nb = r >> 2;
              J.dst = (which ? Wtx : Wta) + (size_t)nb * 128 * 128; J.s0 = (which ? wgx : wga) + (size_t)nb * 128 * 128; J.ld = 128; J.K = 128; J.n0 = ((r >> 1) & 1) * 64; J.k0 = (r & 1) * 64; J.mode = 0; return J; }
        }, smf);
        for (size_t i = (size_t)blockIdx.x * NTHREADS + tid; i < (size_t)LP * 256; i += (size_t)gridDim.x * NTHREADS) {
            const size_t r = i >> 8, c4 = i & 255;
            float4 v = make_float4(0.f, 0.f, 0.f, 0.f);
            if (r < NMETA) v = ((const float4*)meta)[r * 256 + c4]; else if (r < L) v = ((const float4*)x)[(r - NMETA) * 256 + c4];
            ((uint2*)X0b)[i] = make_uint2(cvt_pk_bf16(v.x, v.y), cvt_pk_bf16(v.z, v.w));
        }
        for (int i = blockIdx.x * NTHREADS + tid; i < 2 * 64 * 3 * 64; i += gridDim.x * NTHREADS) {
            const int ln = i & 63, ct = (i >> 6) % 3, ss = (i / 192) & 63, ly = i / (192 * 64);
            const int col = 16 * ct + (ln & 15), k0 = 16 * ss + 4 * (ln >> 4);
            float v[4];
#pragma unroll
            for (int j = 0; j < 4; ++j) v[j] = col < 4 ? a.in[17][(size_t)ly * D * NGRP + (size_t)(k0 + j) * NGRP + col] : col < 36 ? a.in[19][(size_t)ly * D * NE + (size_t)(k0 + j) * NE + (col - 4)] : 0.f;
            ((float4*)(ws + WS_WR))[i] = make_float4(v[0], v[1], v[2], v[3]);
        }
        for (int i = blockIdx.x * NTHREADS + tid; i < LP * 32; i += gridDim.x * NTHREADS) {
            const int p = i >> 5, f = i & 31;
            const float inv = (float)pow(10000.0, -(double)f / 32.0);
            const float ang = (float)p * inv;
            ropeC[i] = (float)cos((double)ang); ropeS[i] = (float)sin((double)ang);
        }
    }
    SEAM(0);
    if (IN(1)) { PHASE_VARS;
        pg8::Gemm g{X0b, WIN0, LP, 3328, 1024}; pg8::StaticOrder S; S.init(LP, 3328, (int)gridDim.x, (int)blockIdx.x);
        EpiIn0 E{GLU, KIb, WIf, ropeC, ropeS, KV8};
        pg8::gemm_phase<EpiIn0, pg8::StaticOrder, GEMM_ALIGN, GEMM_SP2>(ldsp, g, S, E);
        if (gridDim.x == 256 && (int)blockIdx.x >= P1_BUSY) { __syncthreads();
            tr_run(MOE0_P1, [&](int j) -> TrJob { return moe_job(MOE0_P0 + j, a.in[21], a.in[22], a.in[23], WGU, WD); }, smf, (int)blockIdx.x - P1_BUSY, 256 - P1_BUSY); }
    }
    SEAM(1);
    if (IN(2)) { PHASE_VARS;
        const float* cw = a.in[3]; const float* cb = a.in[4]; const float* lg = a.in[5]; const float* lb = a.in[6];
        for (int g4 = gwave; g4 < L / 4; g4 += nwaves) {
            const int t0 = g4 * 4, c0 = lane * 8;
            float acc[4][8], wwin[4][8];
            { const float4 b0 = *(const float4*)(cb + c0), b1 = *(const float4*)(cb + c0 + 4);
#pragma unroll
              for (int q = 0; q < 4; ++q) { acc[q][0] = b0.x; acc[q][1] = b0.y; acc[q][2] = b0.z; acc[q][3] = b0.w; acc[q][4] = b1.x; acc[q][5] = b1.y; acc[q][6] = b1.z; acc[q][7] = b1.w; } }
#pragma unroll
            for (int r = 0; r < CONV_K + 3; ++r) {
                const int tt = t0 - (CONV_K - 1) + r;
                if (r < CONV_K) { const float4 w0 = *(const float4*)(cw + r * CONV_CH + c0), w1 = *(const float4*)(cw + r * CONV_CH + c0 + 4);
                    wwin[r & 3][0] = w0.x; wwin[r & 3][1] = w0.y; wwin[r & 3][2] = w0.z; wwin[r & 3][3] = w0.w; wwin[r & 3][4] = w1.x; wwin[r & 3][5] = w1.y; wwin[r & 3][6] = w1.z; wwin[r & 3][7] = w1.w; }
                if (tt >= 0) {
                    const uint4 xv = *(const uint4*)(GLU + (size_t)tt * 512 + c0);
                    const float x[8] = {bflo(xv.x), bfhi(xv.x), bflo(xv.y), bfhi(xv.y), bflo(xv.z), bfhi(xv.z), bflo(xv.w), bfhi(xv.w)};
#pragma unroll
                    for (int q = 0; q < 4; ++q) { const int j = r - q;
                        if (j >= 0 && j < CONV_K) {
#pragma unroll
                            for (int i = 0; i < 8; ++i) acc[q][i] += wwin[j & 3][i] * x[i]; } }
                }
            }
            float gv[8], bvv[8];
            { const float4 g0 = *(const float4*)(lg + c0), g1 = *(const float4*)(lg + c0 + 4), b0 = *(const float4*)(lb + c0), b1 = *(const float4*)(lb + c0 + 4);
              gv[0] = g0.x; gv[1] = g0.y; gv[2] = g0.z; gv[3] = g0.w; gv[4] = g1.x; gv[5] = g1.y; gv[6] = g1.z; gv[7] = g1.w; bvv[0] = b0.x; bvv[1] = b0.y; bvv[2] = b0.z; bvv[3] = b0.w; bvv[4] = b1.x; bvv[5] = b1.y; bvv[6] = b1.z; bvv[7] = b1.w; }
#pragma unroll
            for (int q = 0; q < 4; ++q) {
                float s_ = 0.f;
#pragma unroll
                for (int i = 0; i < 8; ++i) s_ += acc[q][i];
                const float mu = wave_sum(s_) * (1.0f / 512.0f);
                float qq = 0.f;
#pragma unroll
                for (int i = 0; i < 8; ++i) { const float d = acc[q][i] - mu; qq += d * d; }
                const float rstd = 1.0f / sqrtf(wave_sum(qq) * (1.0f / 512.0f) + LN_EPS);
                float o[8];
#pragma unroll
                for (int i = 0; i < 8; ++i) { const float yv = (acc[q][i] - mu) * rstd * gv[i] + bvv[i]; o[i] = yv * fsigm(yv); }
                uint4 w; w.x = cvt_pk_bf16(o[0], o[1]); w.y = cvt_pk_bf16(o[2], o[3]); w.z = cvt_pk_bf16(o[4], o[5]); w.w = cvt_pk_bf16(o[6], o[7]);
                *(uint4*)(AO + (size_t)(t0 + q) * 1024 + c0) = w;
            }
        }
        { const int b = (int)blockIdx.x, G = (int)gridDim.x; const int p = b & 3; const bool rev = (b >> 2) & 1;
          const int nfull = NTILE / G;
          for (int k = 0; k < nfull; ++k) {
              const int r = (nfull == 4) ? ((rev ? p - k : p + k) & 3) : k;
              const int idx = r * G + ((r & 1) ? G - 1 - b : b);
              indexer_tile((NTILE - 1 - idx) * 16, QIb, KIb, WIf, Qb, KV8, AO, lds_raw);
          }
          for (int idx = nfull * G + b; idx < NTILE; idx += G) indexer_tile((NTILE - 1 - idx) * 16, QIb, KIb, WIf, Qb, KV8, AO, lds_raw);
        }
    }
    SEAM(2);
    SEAM(3);
    if (IN(4)) { PHASE_VARS;
        pg8::Gemm g{AO, WOUT0, LP, 1024, 1024}; pg8::StaticOrder S; S.init(LP, 1024, (int)gridDim.x, (int)blockIdx.x);
        EpiRes0 E{x, meta, Z};
        pg8::gemm_phase<EpiRes0, pg8::StaticOrder, GEMM_ALIGN, GEMM_SP2>(ldsp, g, S, E);
        if (gridDim.x == 256 && (int)blockIdx.x >= P4_BUSY) { __syncthreads();
            tr_run(MOE0_P4, [&](int j) -> TrJob { return moe_job(MOE0_P0 + MOE0_P1 + j, a.in[21], a.in[22], a.in[23], WGU, WD); }, smf, (int)blockIdx.x - P4_BUSY, 256 - P4_BUSY); }
    }
    SEAM(4);
    if (IN(5)) {
        for (int blk = blockIdx.x; blk < SEQ / 64; blk += gridDim.x)
            ln_route_block(NMETA + 64 * blk, 64, Z, H1, a.in[24], a.in[25], (const float4*)(ws + WS_WR), a.in[18], a.in[20], eid, gw, counts0, smf);
        if (blockIdx.x == gridDim.x - 1)
            ln_route_block(0, NMETA, Z, H1, a.in[24], a.in[25], (const float4*)(ws + WS_WR), a.in[18], a.in[20], eid, gw, counts0, smf);
    }
    SEAM(5);
    if (IN(6)) { PHASE_VARS; moe_dispatch_mfma(H1, eid, counts0, cursor0, slot, mtiles, Xperm, (int*)lds_raw, gwave, nwaves, lane, 0); }
    SEAM(6);
    if (IN(7)) { PHASE_VARS;
        pg8::Gemm g{Xperm, WGU, MAXSLOT, 1024, 1024}; MoeOrder S; S.init(mtiles, (int)gridDim.x, (int)blockIdx.x);
        EpiGateUp E{Hm};
        pg8::gemm_phase<EpiGateUp, MoeOrder, GEMM_ALIGN, GEMM_SP2>(ldsp, g, S, E);
        if (gridDim.x == 256) { int rk, cn; moe_idle(mtiles, rk, cn); if (rk >= 0) { __syncthreads();
            tr_run(MOE0_P7, [&](int j) -> TrJob { return moe_job(MOE0_ALL - MOE0_P7 + j, a.in[21], a.in[22], a.in[23], WGU, WD); }, smf, rk, cn); } }
    }
    SEAM(7);
    if (IN(8)) { PHASE_VARS;
        pg8::Gemm g{Hm, WD, MAXSLOT, 1024, 512}; MoeOrder S; S.init(mtiles, (int)gridDim.x, (int)blockIdx.x);
        EpiDown E{Yb};
        pg8::gemm_phase<EpiDown, MoeOrder, GEMM_ALIGN, GEMM_SP2>(ldsp, g, S, E);
        if (gridDim.x == 256) { int rk, cn; moe_idle(mtiles, rk, cn); if (rk >= 0) { __syncthreads();
            tr_run(MOE1_P8, [&](int j) -> TrJob { return moe_job(j, a.in[21] + (size_t)NE * D * DE, a.in[22] + (size_t)NE * D * DE, a.in[23] + (size_t)NE * DE * D, WGU, WD); }, smf, rk, cn); } }
    }
    SEAM(8);
    if (IN(9)) { PHASE_VARS;
#pragma unroll 2
        for (int t = gwave; t < L; t += nwaves) {
            const int s0 = slot[2 * t], s1 = slot[2 * t + 1]; const float g0 = gw[2 * t], g1 = gw[2 * t + 1];
            float y[16];
            combine_row(y, H1 + (size_t)t * D, Yb + (size_t)s0 * D, Yb + (size_t)s1 * D, g0, g1, lane);
            ln_row1024v(y, a.in[26], a.in[27], lane);
#pragma unroll
            for (int i4 = 0; i4 < 4; ++i4) *(float4*)(H2 + (size_t)t * D + 16 * lane + 4 * i4) = make_float4(y[4 * i4], y[4 * i4 + 1], y[4 * i4 + 2], y[4 * i4 + 3]);
            uint4 p0, p1; p0.x = cvt_pk_bf16(y[0], y[1]); p0.y = cvt_pk_bf16(y[2], y[3]); p0.z = cvt_pk_bf16(y[4], y[5]); p0.w = cvt_pk_bf16(y[6], y[7]);
            p1.x = cvt_pk_bf16(y[8], y[9]); p1.y = cvt_pk_bf16(y[10], y[11]); p1.z = cvt_pk_bf16(y[12], y[13]); p1.w = cvt_pk_bf16(y[14], y[15]);
            *(uint4*)(X2b + (size_t)t * D + 16 * lane) = p0; *(uint4*)(X2b + (size_t)t * D + 16 * lane + 8) = p1;
        }
        for (int i = blockIdx.x * NTHREADS + tid; i < (LP - L) * D / 8; i += gridDim.x * NTHREADS) ((uint4*)(X2b + (size_t)L * D))[i] = make_uint4(0u, 0u, 0u, 0u);
    }
    SEAM(9);
    if (IN(10)) {
        pg8::Gemm g{X2b, WIN1, LP, 2 * RNN_W, 1024}; pg8::StaticOrder S; S.init(LP, 2 * RNN_W, (int)gridDim.x, (int)blockIdx.x);
        EpiIn1 E{GATEg};
        pg8::gemm_phase<EpiIn1, pg8::StaticOrder, GEMM_ALIGN, GEMM_SP2>(ldsp, g, S, E);
        if (gridDim.x == 256 && (int)blockIdx.x >= P10_BUSY) { __syncthreads();
            tr_run(MOE1_P10, [&](int j) -> TrJob { return moe_job(MOE1_P8 + j, a.in[21] + (size_t)NE * D * DE, a.in[22] + (size_t)NE * D * DE, a.in[23] + (size_t)NE * DE * D, WGU, WD); }, smf, (int)blockIdx.x - P10_BUSY, 256 - P10_BUSY); }
    }
    SEAM(10);
    if (IN(11)) rglru_phase<false>(XRb, GATEg, Wta, Wtx, a.in[9], a.in[10], a.in[12], a.in[14], a.in[15], Aend, Hend, CIN, YY, lds_raw);
    SEAM(11);
    if (IN(12)) { PHASE_VARS;
        for (int ch = gwave; ch < RNN_W; ch += nwaves) {
            float A[5], H[5];
#pragma unroll
            for (int i = 0; i < 5; ++i) { const int c = 5 * lane + i; const bool ok = c < NCHUNK; A[i] = ok ? Aend[(size_t)ch * CP + c] : 1.f; H[i] = ok ? Hend[(size_t)ch * CP + c] : 0.f; }
            float Al = 1.f, Hl = 0.f;
#pragma unroll
            for (int i = 0; i < 5; ++i) { Hl = A[i] * Hl + H[i]; Al *= A[i]; }
#pragma unroll
            for (int off = 1; off < 64; off <<= 1) { const float Ap = __shfl_up(Al, off), Hp = __shfl_up(Hl, off); if (lane >= off) { Hl = Al * Hp + Hl; Al = Al * Ap; } }
            float cin = __shfl_up(Hl, 1); if (lane == 0) cin = 0.f;
#pragma unroll
            for (int i = 0; i < 5; ++i) { const int c = 5 * lane + i; if (c < NCHUNK) { CIN[(size_t)ch * CP + c] = cin; cin = A[i] * cin + H[i]; } }
        }
    }
    SEAM(12);
    if (IN(13)) rglru_phase<true>(XRb, GATEg, Wta, Wtx, a.in[9], a.in[10], a.in[12], a.in[14], a.in[15], Aend, Hend, CIN, YY, lds_raw);
    SEAM(13);
    if (IN(14)) {
        pg8::Gemm g{YY + (size_t)NMETA * RNN_W, WOUT1, SEQ, 1024, RNN_W}; pg8::StaticOrder S; S.init(SEQ, 1024, (int)gridDim.x, (int)blockIdx.x);
        EpiRes1 E{H2 + (size_t)NMETA * D, Z1 + (size_t)NMETA * D};
        pg8::gemm_phase<EpiRes1, pg8::StaticOrder, GEMM_ALIGN, GEMM_SP2>(ldsp, g, S, E);
    }
    SEAM(14);
    if (IN(15)) { PHASE_VARS;
        const float* wg = a.in[21] + (size_t)NE * D * DE; const float* wu = a.in[22] + (size_t)NE * D * DE; const float* wd = a.in[23] + (size_t)NE * DE * D;
        { const int done = gridDim.x == 256 ? MOE1_P8 + MOE1_P10 : 0;
          tr_run(MOE0_ALL - done, [&](int j) -> TrJob { return moe_job(done + j, wg, wu, wd, WGU, WD); }, smf); }
        __syncthreads();
        for (int tb = NMETA + blockIdx.x * 64; tb < L; tb += gridDim.x * 64)
            ln_route_block(tb, (L - tb) < 64 ? (L - tb) : 64, Z1, H3, a.in[24] + D, a.in[25] + D, (const float4*)(ws + WS_WR) + 64 * 3 * 64, a.in[18] + NGRP, a.in[20] + NE, eid, gw, counts1, smf);
    }
    SEAM(15);
    if (IN(16)) { PHASE_VARS; moe_dispatch_mfma(H3, eid, counts1, cursor1, slot, mtiles, Xperm, (int*)lds_raw, gwave, nwaves, lane, 2 * NMETA); }
    SEAM(16);
    if (IN(17)) {
        pg8::Gemm g{Xperm, WGU, MAXSLOT, 1024, 1024}; MoeOrder S; S.init(mtiles, (int)gridDim.x, (int)blockIdx.x);
        EpiGateUp E{Hm};
        pg8::gemm_phase<EpiGateUp, MoeOrder, GEMM_ALIGN, GEMM_SP2>(ldsp, g, S, E);
    }
    SEAM(17);
    if (IN(18)) {
        pg8::Gemm g{Hm, WD, MAXSLOT, 1024, 512}; MoeOrder S; S.init(mtiles, (int)gridDim.x, (int)blockIdx.x);
        EpiDown E{Yb};
        pg8::gemm_phase<EpiDown, MoeOrder, GEMM_ALIGN, GEMM_SP2>(ldsp, g, S, E);
    }
    SEAM(18);
    if (IN(19)) { PHASE_VARS;
#pragma unroll 2
        for (int t = NMETA + gwave; t < L; t += nwaves) {
            const int s0 = slot[2 * t], s1 = slot[2 * t + 1]; const float g0 = gw[2 * t], g1 = gw[2 * t + 1];
            float y[16];
            combine_row(y, H3 + (size_t)t * D, Yb + (size_t)s0 * D, Yb + (size_t)s1 * D, g0, g1, lane);
            ln_row1024v(y, a.in[26] + D, a.in[27] + D, lane);
#pragma unroll
            for (int i4 = 0; i4 < 4; ++i4) *(float4*)(a.out + (size_t)(t - NMETA) * D + 16 * lane + 4 * i4) = make_float4(y[4 * i4], y[4 * i4 + 1], y[4 * i4 + 2], y[4 * i4 + 3]);
        }
    }
#undef IN
#undef SEAM
}
constexpr int N_PHASES = 20;

extern "C" void kernel_launch(void* const* d_in, const int* in_sizes, int n_in, void* d_out, int out_size, void* d_ws, size_t ws_size, hipStream_t stream) {
    static int grid = 0;
    if (grid == 0) {
        if (n_in != 28 || out_size != SEQ * D || ws_size < WS_END) { fprintf(stderr, "kernel_launch: unexpected shapes n_in %d out %d ws %zu (need %zu)\n", n_in, out_size, ws_size, (size_t)WS_END); grid = -1; return; }
        int dev = 0, cus = 0;
        if (hipGetDevice(&dev) != hipSuccess || hipDeviceGetAttribute(&cus, hipDeviceAttributeMultiprocessorCount, dev) != hipSuccess) { grid = -1; return; }
        if (hipFuncSetAttribute((const void*)fwd, hipFuncAttributeMaxDynamicSharedMemorySize, LDS_BYTES) != hipSuccess) { fprintf(stderr, "kernel_launch: hipFuncSetAttribute failed\n"); grid = -1; return; }
        int per_cu = 0;
        if (hipOccupancyMaxActiveBlocksPerMultiprocessor(&per_cu, (const void*)fwd, NTHREADS, LDS_BYTES) != hipSuccess || per_cu < 1) fprintf(stderr, "kernel_launch: occupancy query says %d\n", per_cu);
        (void)hipGetLastError();
        grid = cus;
    }
    if (grid < 0) return;
    (void)hipMemsetAsync((char*)d_ws + WS_CTL, 0, CTL_BYTES, stream);
    Args a{};
    for (int i = 0; i < 28; ++i) a.in[i] = (const float*)d_in[i];
    a.out = (float*)d_out; a.ws = (unsigned char*)d_ws;
#if N_LAUNCH_MODE == 1
    a.ph_lo = 0; a.ph_hi = N_PHASES;
    hipLaunchKernelGGL(fwd, dim3(grid), dim3(NTHREADS), LDS_BYTES, stream, a);
#else
    for (int p = 0; p < N_PHASES; ++p) { a.ph_lo = p; a.ph_hi = p + 1; hipLaunchKernelGGL(fwd, dim3(grid), dim3(NTHREADS), LDS_BYTES, stream, a); }
#endif
}
```

```cpp
#include <hip/hip_runtime.h>
#include <cstdio>
#include <cstdint>
#include <cmath>

#ifndef GEMM_ALIGN
#define GEMM_ALIGN true
#endif
#ifndef GEMM_SP2
#define GEMM_SP2 true
#endif
#ifndef N_LAUNCH_MODE
#define N_LAUNCH_MODE 1
#endif

#define DEVI __device__ __forceinline__
#define LAS __attribute__((address_space(3)))

constexpr int D = 1024, SEQ = 16384, NMETA = 16, L = SEQ + NMETA;
constexpr int CONV_CH = 512, CONV_K = 31, HD = 64, TOPK = 256;
constexpr int IN_AB = 3144;
constexpr int OFF_AVAL = 0, OFF_AGATE = 512, OFF_Q = 1024, OFF_K = 1536, OFF_V = 2048, OFF_QI = 2560, OFF_KI = 3072, OFF_WI = 3136;
constexpr int RNN_W = 1280, RNN_NB = 10, RNN_BW = 128, RNN_K = 4;
constexpr int NGRP = 4, EPG = 8, NE = 32, DE = 512;
constexpr int NPAIR = 2 * L;
constexpr float LN_EPS = 1e-5f;
constexpr float DN_ALPHA = 1.41421356237f;
constexpr int NTHREADS = 512;
constexpr int LDS_BYTES = 147456;

#define XB_TMO      128
#define XB_XCNT(j)  (256  + 64 * (j))
#define XB_XSUB(j)  (1280 + 64 * (j))
#define XB_XGEN(j)  (2304 + 64 * (j))
#define XB_TOP      3328
#define XB_TOPGEN   3392
#define XCD_BAR_WORDS 3456
#define XB_SPIN_CAP (1u << 22)
DEVI unsigned xb_ld(unsigned* p)              { return __hip_atomic_load(p, __ATOMIC_RELAXED, __HIP_MEMORY_SCOPE_AGENT); }
DEVI unsigned xb_add(unsigned* p, unsigned v) { return __hip_atomic_fetch_add(p, v, __ATOMIC_RELAXED, __HIP_MEMORY_SCOPE_AGENT); }
DEVI unsigned xb_xcc_id() { return (unsigned)__builtin_amdgcn_s_getreg((3 << 11) | 20) & 0xFu; }
#define XB_SPIN(cond, bar) do { unsigned _sp = 0; while (cond) { __builtin_amdgcn_s_sleep(1); \
    if ((++_sp & 255u) == 0u) { if (xb_ld(&(bar)[XB_TMO])) break; if (_sp > XB_SPIN_CAP) { atomicAdd(&(bar)[XB_TMO], 1u); break; } } } } while (0)
struct XcdBarrier { unsigned* bar; unsigned x; volatile LAS unsigned* st; };
DEVI XcdBarrier xcd_barrier_post(unsigned* bar, volatile LAS unsigned* st) {
    XcdBarrier b; b.bar = bar; b.x = xb_xcc_id(); b.st = st;
    if (threadIdx.x == 0) (void)xb_add(&bar[XB_XCNT(b.x)], 1u);
    return b;
}
DEVI void xcd_barrier_complete(unsigned* bar, unsigned x, unsigned& nloc, unsigned& nx) {
    const unsigned G = gridDim.x * gridDim.y * gridDim.z;
    unsigned sum, cnt, mine, sp = 0u;
    for (;;) {
        sum = 0u; cnt = 0u; mine = 0u;
#pragma unroll
        for (unsigned j = 0; j < 16; ++j) { const unsigned c = xb_ld(&bar[XB_XCNT(j)]); sum += c; cnt += (c > 0u) ? 1u : 0u; mine = (j == x) ? c : mine; }
        if (sum == G) break;
        __builtin_amdgcn_s_sleep(1);
        if ((++sp & 255u) == 0u) { if (xb_ld(&bar[XB_TMO])) break; if (sp > XB_SPIN_CAP) { atomicAdd(&bar[XB_TMO], 1u); break; } }
    }
    nloc = mine > 0u ? mine : 1u; nx = cnt > 0u ? cnt : 1u;
}
DEVI void xcd_barrier(const XcdBarrier& b) {
    asm volatile("s_waitcnt vmcnt(0)" ::: "memory");
    __syncthreads();
    if (threadIdx.x == 0) {
        unsigned* bar = b.bar;
        __builtin_amdgcn_s_waitcnt(0);
        unsigned nloc = b.st[0], nx = b.st[1];
        if (nloc == 0u) { xcd_barrier_complete(bar, b.x, nloc, nx); b.st[0] = nloc; b.st[1] = nx; }
        const unsigned old = xb_add(&bar[XB_XSUB(b.x)], 1u);
        const unsigned gen = old / nloc;
        if (old + 1u == (gen + 1u) * nloc) {
            __builtin_amdgcn_fence(__ATOMIC_RELEASE, "agent");
            asm volatile("s_waitcnt vmcnt(0)" ::: "memory");
            const unsigned og = xb_add(&bar[XB_TOP], 1u);
            const unsigned tg = og / nx;
            if (og + 1u == (tg + 1u) * nx) xb_add(&bar[XB_TOPGEN], 1u);
            else XB_SPIN(xb_ld(&bar[XB_TOPGEN]) == tg, bar);
            __builtin_amdgcn_fence(__ATOMIC_ACQUIRE, "agent");
            xb_add(&bar[XB_XGEN(b.x)], 1u);
            asm volatile("s_waitcnt vmcnt(0)" ::: "memory");
        } else {
            XB_SPIN(xb_ld(&bar[XB_XGEN(b.x)]) == gen, bar);
            __builtin_amdgcn_fence(__ATOMIC_ACQUIRE, "agent");
            asm volatile("s_waitcnt vmcnt(0)" ::: "memory");
        }
    }
    __syncthreads();
}

constexpr int LP = 16640;
constexpr int MAXSLOT = 40960;
constexpr int NCHUNK = 257, CP = 272;
constexpr size_t MiB = 1048576;
constexpr size_t WS_CTL = 0;
constexpr size_t CTL_CNT = 16384;
constexpr size_t CTL_CUR = 16384 + 256;
constexpr size_t CTL_BYTES = 32768;
constexpr size_t WS_ROPEC = 32768;
constexpr size_t WS_ROPES = WS_ROPEC + (size_t)LP * 32 * 4;
constexpr size_t WS_EID = WS_ROPES + (size_t)LP * 32 * 4;
constexpr size_t WS_GW = WS_EID + (size_t)NPAIR * 4;
constexpr size_t WS_SLOT = WS_GW + (size_t)NPAIR * 4;
constexpr size_t WS_MTILES = WS_SLOT + (size_t)NPAIR * 4;
constexpr size_t WS_WTA = WS_MTILES + 4096;
constexpr size_t WS_WTX = WS_WTA + (size_t)RNN_NB * 128 * 128 * 2;
constexpr size_t WS_AEND = WS_WTX + (size_t)RNN_NB * 128 * 128 * 2;
constexpr size_t WS_HEND = WS_AEND + (size_t)RNN_W * CP * 4;
constexpr size_t WS_CIN = WS_HEND + (size_t)RNN_W * CP * 4;
constexpr size_t WS_WR = WS_CIN + (size_t)RNN_W * CP * 4;
constexpr size_t WS_BIG = ((WS_WR + (size_t)2 * 64 * 3 * 64 * 16 + 255) / 256) * 256;
constexpr size_t R_WIN0 = 0;
constexpr size_t R_WOUT0 = R_WIN0 + (size_t)3328 * 1024 * 2;
constexpr size_t R_WGU = R_WOUT0 + (size_t)1024 * 1024 * 2;
constexpr size_t R_WD = R_WGU + (size_t)32 * 1024 * 1024 * 2;
constexpr size_t R_WIN1 = R_WD + (size_t)32 * 1024 * 512 * 2;
constexpr size_t R_WOUT1 = R_WIN1 + (size_t)2560 * 1024 * 2;
static_assert(R_WOUT1 + (size_t)1024 * 1280 * 2 <= 112 * MiB, "weights");
constexpr size_t R_A = 112 * MiB;
constexpr size_t R_H1 = 192 * MiB;
constexpr size_t R_H2 = 257 * MiB;
constexpr size_t R_C = 322 * MiB;
constexpr size_t R_GLU = 322 * MiB;
constexpr size_t SZ512 = (size_t)LP * 512 * 2;
constexpr size_t R_Q = R_GLU + SZ512, R_K = R_Q + SZ512, R_V = R_K + SZ512, R_QI = R_V + SZ512, R_KI = R_QI + SZ512, R_WI = R_KI + (size_t)LP * 64 * 2;
static_assert(R_WI + (size_t)LP * 8 * 4 <= 406 * MiB, "in-proj outputs");
constexpr size_t R_GATE = 322 * MiB;
constexpr size_t R_XR = R_GATE + (size_t)LP * 1280 * 2;
static_assert(R_XR + (size_t)LP * 1280 * 2 <= 406 * MiB, "layer-1 in-proj outputs");
constexpr size_t R_HM = 406 * MiB;
constexpr size_t WS_END = WS_BIG + R_HM + (size_t)MAXSLOT * 512 * 2;
static_assert(WS_END <= 512 * MiB, "ws");

struct Args { const float* in[28]; float* out; unsigned char* ws; int ph_lo, ph_hi; };

DEVI unsigned opq(unsigned v) { asm volatile("" : "+v"(v)); return v; }
DEVI int otid() { int v = (int)threadIdx.x; asm volatile("" : "+v"(v)); return v; }
template <int CTRL> DEVI float dpp_f(float v) { return __int_as_float(__builtin_amdgcn_mov_dpp(__float_as_int(v), CTRL, 0xF, 0xF, true)); }
DEVI float wave_sum(float v) {
    v += dpp_f<0xB1>(v); v += dpp_f<0x4E>(v); v += dpp_f<0x141>(v); v += dpp_f<0x140>(v);
    return __int_as_float(__builtin_amdgcn_readlane(__float_as_int(v), 0)) + __int_as_float(__builtin_amdgcn_readlane(__float_as_int(v), 16))
         + __int_as_float(__builtin_amdgcn_readlane(__float_as_int(v), 32)) + __int_as_float(__builtin_amdgcn_readlane(__float_as_int(v), 48));
}
DEVI float wave_max(float v) {
#pragma unroll
    for (int o = 32; o > 0; o >>= 1) v = fmaxf(v, __shfl_xor(v, o));
    return v;
}
DEVI float sigm(float x) { return 1.0f / (1.0f + expf(-x)); }
DEVI float gelu_tanh(float x) { return 0.5f * x * (1.0f + tanhf(0.7978845608028654f * (x + 0.044715f * x * x * x))); }
DEVI unsigned f2key(float f) { unsigned u = __float_as_uint(f); return (u & 0x80000000u) ? ~u : (u | 0x80000000u); }

namespace pg8 {
#define PG8_LAS __attribute__((address_space(3)))
typedef unsigned short bf16_t;
typedef short bf16x8 __attribute__((ext_vector_type(8)));
typedef float f32x4 __attribute__((ext_vector_type(4)));
typedef unsigned u32x4 __attribute__((ext_vector_type(4)));
constexpr int BM = 256, BK = 64, HALF = 128, HTB = HALF * BK * 2  , STAGE_BYTES = 8 * HTB, NXCD = 8, WGM = 8;

__host__ __device__ __forceinline__ int lds_byte(int r, int c) { const int st = (r >> 4) * 2 + (c >> 5), rr = r & 15, cc = c & 31, ob = rr * 64 + cc * 2; return st * 1024 + (ob ^ (((ob >> 9) & 1) << 5)); }
__host__ __device__ __forceinline__ void stage_rc(int b, int& R, int& C) { const int st = b / 1024, sb = b % 1024, swz = sb ^ (((sb >> 9) & 1) << 5); R = (st >> 1) * 16 + swz / 64; C = (st & 1) * 32 + (swz % 64) / 2; }
__host__ __device__ __forceinline__ int perm32(int rho) { const int n = rho >> 4, i = rho & 15; return 8 * (i >> 2) + 4 * n + (i & 3); }

struct Unit { int pm, pn; };
struct Gemm { const bf16_t* A; const bf16_t* Bt; int M, N, K; };

struct StaticOrder {
    int nM, nN, nwg, G, c;
    __host__ __device__ void init(int M, int N, int G_, int c_) { nM = M / BM; nN = N / BM; nwg = nM * nN; G = G_; c = c_; }
    __host__ __device__ bool next(int i, Unit& u) const {
        const long L = (long)i * G + c; if (L >= nwg) return false;
        int wgid = (int)L; { const int q = nwg / NXCD, r = nwg % NXCD, xcd = wgid % NXCD, off = wgid / NXCD; wgid = (xcd < r ? xcd * (q + 1) : r * (q + 1) + (xcd - r) * q) + off; }
        const int nig = WGM * nN, gid = wgid / nig, fm = gid * WGM, gsz = (nM - fm) < WGM ? (nM - fm) : WGM;
        u.pm = fm + ((wgid % nig) % gsz); u.pn = (wgid % nig) / gsz; return true;
    }
    __device__ __forceinline__ void a_ready(const Unit&) const {}
    __device__ __forceinline__ void done(const Unit&) const {}
};

template <class Epi, class Sched, bool ALIGN_EPI = false, bool SP2 = false>
__device__ __forceinline__ void gemm_phase(PG8_LAS unsigned char* lds, const Gemm g, const Sched& S, const Epi& E) {
    const int tid = threadIdx.x, wid = __builtin_amdgcn_readfirstlane(tid >> 6), lane = tid & 63, wr = wid >> 2, wc = wid & 3, fr = lane & 15, fq = lane >> 4;
    const int K = g.K, nt = K / BK;
    unsigned voffA[2], voffB[2];
#pragma unroll
    for (int i = 0; i < 2; ++i) { int R, C; stage_rc(tid * 16 + i * 8192, R, C); const int Rb = Epi::PERM ? ((R & ~31) + perm32(R & 31)) : R;
        voffA[i] = (unsigned)(R * K + C) * 2u; voffB[i] = (unsigned)(Rb * K + C) * 2u; }
    const size_t kstep = (size_t)(BK * 2);
    const size_t hstep = (size_t)HALF * K * 2;
    const size_t tstep = 2 * hstep;
    const unsigned ldsw = (unsigned)wid * 1024u;
    const int aoff = lds_byte(wr * 64 + fr, fq * 8), boff = lds_byte(wc * 32 + fr, fq * 8);
#define PG8_SA(b, h) (((b) * 2 + (h)) * HTB)
#define PG8_SB(b, h) ((4 + (b) * 2 + (h)) * HTB)
#define PG8_STAGE(bufoff, gbase, voff) do { _Pragma("unroll") for (int _i = 0; _i < 2; ++_i) \
        __builtin_amdgcn_global_load_lds((const unsigned*)((const char*)(gbase) + (voff)[_i]), (PG8_LAS unsigned*)(lds + (bufoff) + ldsw + _i * 8192), 16, 0, 0); } while (0)
#define PG8_LDA(dst, b, h) do { _Pragma("unroll") for (int m = 0; m < 4; ++m) _Pragma("unroll") for (int k = 0; k < 2; ++k) dst[m][k] = *(const PG8_LAS bf16x8*)(lds + PG8_SA(b, h) + aoff + m * 2048 + k * 1024); } while (0)
#define PG8_LDB(dst, b, h) do { _Pragma("unroll") for (int n = 0; n < 2; ++n) _Pragma("unroll") for (int k = 0; k < 2; ++k) dst[n][k] = *(const PG8_LAS bf16x8*)(lds + PG8_SB(b, h) + boff + n * 2048 + k * 1024); } while (0)
#define PG8_MMA(ai, bj, At, Bt) do { __builtin_amdgcn_s_setprio(1); _Pragma("unroll") for (int m = 0; m < 4; ++m) _Pragma("unroll") for (int n = 0; n < 2; ++n) _Pragma("unroll") for (int k = 0; k < 2; ++k) \
        acc[ai][bj][m][n] = __builtin_amdgcn_mfma_f32_16x16x32_bf16(Bt[n][k], At[m][k], acc[ai][bj][m][n], 0, 0, 0); __builtin_amdgcn_s_setprio(0); } while (0)
#define PG8_WAIT_V(n) asm volatile("s_waitcnt vmcnt(" #n ")" ::: "memory")
#define PG8_WAIT_L(n) asm volatile("s_waitcnt lgkmcnt(" #n ")" ::: "memory")
#define PG8_BAR __builtin_amdgcn_s_barrier()
#define PG8_SCHED __builtin_amdgcn_sched_barrier(0)
    Unit cur, nxt; int ui = 0;
    if (!S.next(0, cur)) return;
    f32x4 acc[2][2][4][2];
#pragma unroll
    for (int a = 0; a < 2; ++a)
#pragma unroll
        for (int b = 0; b < 2; ++b)
#pragma unroll
            for (int m = 0; m < 4; ++m)
#pragma unroll
                for (int n = 0; n < 2; ++n) acc[a][b][m][n] = (f32x4){0.f, 0.f, 0.f, 0.f};
    bf16x8 At[4][2], B0[2][2], B1[2][2];
    const char* cA = (const char*)g.A + (size_t)cur.pm * tstep; const char* cB = (const char*)g.Bt + (size_t)cur.pn * tstep;
    S.a_ready(cur);
    if constexpr (SP2) {
        PG8_STAGE(PG8_SB(0, 0), cB, voffB); PG8_STAGE(PG8_SB(0, 1), cB + hstep, voffB); PG8_STAGE(PG8_SA(0, 0), cA, voffA); PG8_STAGE(PG8_SA(0, 1), cA + hstep, voffA);
        if (wr == 1) PG8_BAR;
        PG8_WAIT_V(2); PG8_BAR;
        PG8_STAGE(PG8_SB(1, 0), cB + kstep, voffB); PG8_STAGE(PG8_SA(1, 0), cA + kstep, voffA); PG8_STAGE(PG8_SB(1, 1), cB + hstep + kstep, voffB);
        PG8_WAIT_V(6); PG8_BAR;
    } else {
        PG8_STAGE(PG8_SB(0, 0), cB, voffB); PG8_STAGE(PG8_SA(0, 0), cA, voffA); PG8_STAGE(PG8_SB(0, 1), cB + hstep, voffB); PG8_STAGE(PG8_SA(0, 1), cA + hstep, voffA);
        if (wr == 1) PG8_BAR;
        PG8_WAIT_V(4); PG8_BAR;
        PG8_STAGE(PG8_SB(1, 0), cB + kstep, voffB); PG8_STAGE(PG8_SA(1, 0), cA + kstep, voffA); PG8_STAGE(PG8_SB(1, 1), cB + hstep + kstep, voffB);
        PG8_WAIT_V(6); PG8_BAR;
    }
    for (;;) {
        const bool has_next = S.next(ui + 1, nxt);
        const char* nA = has_next ? (const char*)g.A + (size_t)nxt.pm * tstep : cA; const char* nB = has_next ? (const char*)g.Bt + (size_t)nxt.pn * tstep : cB;
        for (int t = 0; t < nt; t += 2) {
            const bool last = (t == nt - 2);
            const char* a1 = cA + (size_t)(t + 1) * kstep;
            const char* a2 = last ? nA : cA + (size_t)(t + 2) * kstep; const char* b2 = last ? nB : cB + (size_t)(t + 2) * kstep;
            const char* a3 = a2 + kstep; const char* b3 = b2 + kstep;
            if (last && has_next) S.a_ready(nxt);
            if constexpr (SP2) {
            PG8_LDB(B0, 0, 0); PG8_LDB(B1, 0, 1); PG8_SCHED; PG8_LDA(At, 0, 0); PG8_STAGE(PG8_SA(1, 1), a1 + hstep, voffA);
            PG8_WAIT_V(8); PG8_WAIT_L(0); PG8_BAR; PG8_MMA(0, 0, At, B0); PG8_MMA(0, 1, At, B1); PG8_BAR; PG8_SCHED;
            PG8_LDA(At, 0, 1); PG8_STAGE(PG8_SB(0, 0), b2, voffB); PG8_STAGE(PG8_SB(0, 1), b2 + hstep, voffB); PG8_STAGE(PG8_SA(0, 0), a2, voffA);
            PG8_WAIT_V(8); PG8_WAIT_L(0); PG8_BAR; PG8_MMA(1, 0, At, B0); PG8_MMA(1, 1, At, B1); PG8_BAR; PG8_SCHED;
            PG8_LDB(B0, 1, 0); PG8_LDB(B1, 1, 1); PG8_SCHED; PG8_LDA(At, 1, 0); PG8_STAGE(PG8_SA(0, 1), a2 + hstep, voffA);
            PG8_WAIT_V(8); PG8_WAIT_L(0); PG8_BAR; PG8_MMA(0, 0, At, B0); PG8_MMA(0, 1, At, B1); PG8_BAR; PG8_SCHED;
            PG8_LDA(At, 1, 1); PG8_STAGE(PG8_SB(1, 0), b3, voffB); PG8_STAGE(PG8_SB(1, 1), b3 + hstep, voffB); PG8_STAGE(PG8_SA(1, 0), a3, voffA);
            PG8_WAIT_V(8); PG8_WAIT_L(0); PG8_BAR; PG8_MMA(1, 0, At, B0); PG8_MMA(1, 1, At, B1); PG8_BAR; PG8_SCHED;
            } else {
            PG8_LDB(B0, 0, 0); PG8_SCHED; PG8_LDA(At, 0, 0); PG8_STAGE(PG8_SA(1, 1), a1 + hstep, voffA);
            PG8_WAIT_L(8); PG8_BAR; PG8_WAIT_L(0); PG8_MMA(0, 0, At, B0); PG8_BAR; PG8_SCHED;
            PG8_LDB(B1, 0, 1); PG8_STAGE(PG8_SB(0, 0), b2, voffB);
            PG8_BAR; PG8_WAIT_L(0); PG8_MMA(0, 1, At, B1); PG8_BAR;
            PG8_LDA(At, 0, 1); PG8_STAGE(PG8_SA(0, 0), a2, voffA);
            PG8_BAR; PG8_WAIT_L(0); PG8_MMA(1, 0, At, B0); PG8_BAR; PG8_SCHED;
            PG8_STAGE(PG8_SB(0, 1), b2 + hstep, voffB);
            PG8_WAIT_V(6); PG8_BAR; PG8_MMA(1, 1, At, B1); PG8_BAR;
            PG8_LDB(B0, 1, 0); PG8_SCHED; PG8_LDA(At, 1, 0); PG8_STAGE(PG8_SA(0, 1), a2 + hstep, voffA);
            PG8_WAIT_L(8); PG8_BAR; PG8_WAIT_L(0); PG8_MMA(0, 0, At, B0); PG8_BAR; PG8_SCHED;
            PG8_LDB(B1, 1, 1); PG8_STAGE(PG8_SB(1, 0), b3, voffB);
            PG8_BAR; PG8_WAIT_L(0); PG8_MMA(0, 1, At, B1); PG8_BAR;
            PG8_LDA(At, 1, 1); PG8_STAGE(PG8_SA(1, 0), a3, voffA);
            PG8_BAR; PG8_WAIT_L(0); PG8_MMA(1, 0, At, B0); PG8_BAR; PG8_SCHED;
            PG8_STAGE(PG8_SB(1, 1), b3 + hstep, voffB);
            PG8_WAIT_V(6); PG8_BAR; PG8_MMA(1, 1, At, B1); PG8_BAR;
            }
        }
        if constexpr (ALIGN_EPI) { if (wr == 0) PG8_BAR; }
        if constexpr (!Epi::AFTER_DRAIN) { E(acc, cur, wr, wc, fr, fq); S.done(cur); }
        if (!has_next) break;
#pragma unroll
        for (int a = 0; a < 2; ++a)
#pragma unroll
            for (int b = 0; b < 2; ++b)
#pragma unroll
                for (int m = 0; m < 4; ++m)
#pragma unroll
                    for (int n = 0; n < 2; ++n) acc[a][b][m][n] = (f32x4){0.f, 0.f, 0.f, 0.f};
        cur = nxt; cA = nA; cB = nB; ++ui;
        if constexpr (ALIGN_EPI) { if (wr == 1) PG8_BAR; }
    }
    PG8_WAIT_V(0);
    if constexpr (!ALIGN_EPI) { if (wr == 0) PG8_BAR; }
    PG8_BAR;
    if constexpr (Epi::AFTER_DRAIN) { E.fused(acc, cur, wr, wc, fr, fq, lds, wid, lane); S.done(cur); }
#undef PG8_SA
#undef PG8_SB
#undef PG8_STAGE
#undef PG8_LDA
#undef PG8_LDB
#undef PG8_MMA
#undef PG8_WAIT_V
#undef PG8_WAIT_L
#undef PG8_BAR
#undef PG8_SCHED
}
}

DEVI void ln_row1024(float (&y)[16], const float* g, const float* b, int lane) {
    float s = 0.f;
#pragma unroll
    for (int i = 0; i < 16; ++i) s += y[i];
    const float mu = wave_sum(s) * (1.0f / 1024.0f);
    float q = 0.f;
#pragma unroll
    for (int i = 0; i < 16; ++i) { const float d = y[i] - mu; q += d * d; }
    const float rstd = 1.0f / sqrtf(wave_sum(q) * (1.0f / 1024.0f) + LN_EPS);
#pragma unroll
    for (int i = 0; i < 16; ++i) y[i] = (y[i] - mu) * rstd * g[lane + 64 * i] + b[lane + 64 * i];
}

DEVI void route_token(const float (&y)[16], float* ys, int t, int lane, const float* wg, const float* bg, const float* we, const float* be, int* eid, float* gw, unsigned* counts) {
    float lg[36];
#pragma unroll
    for (int j = 0; j < 36; ++j) lg[j] = 0.f;
#pragma unroll
    for (int i = 0; i < 16; ++i) ys[lane + 64 * i] = y[i];
#pragma unroll 1
    for (int i = 0; i < 16; ++i) {
        const int c = lane + 64 * i;
        const float yv = ys[c];
        const float4 g4 = *(const float4*)(wg + (size_t)c * 4);
        lg[0] += yv * g4.x; lg[1] += yv * g4.y; lg[2] += yv * g4.z; lg[3] += yv * g4.w;
#pragma unroll
        for (int j = 0; j < 8; ++j) { const float4 e4 = *(const float4*)(we + (size_t)c * 32 + j * 4);
            lg[4 + j * 4 + 0] += yv * e4.x; lg[4 + j * 4 + 1] += yv * e4.y; lg[4 + j * 4 + 2] += yv * e4.z; lg[4 + j * 4 + 3] += yv * e4.w; }
    }
#pragma unroll
    for (int j = 0; j < 36; ++j) lg[j] = wave_sum(lg[j]);
    if (lane == 0) {
        float gl[4]; int g = 0;
#pragma unroll
        for (int j = 0; j < 4; ++j) gl[j] = lg[j] + bg[j];
#pragma unroll
        for (int j = 1; j < 4; ++j) if (gl[j] > gl[g]) g = j;
        float den = 0.f;
#pragma unroll
        for (int j = 0; j < 4; ++j) den += expf(gl[j] - gl[g]);
        const float gp = 1.0f / den;
        float el[8];
#pragma unroll
        for (int j = 0; j < 8; ++j) { float v = 0.f;
#pragma unroll
            for (int gg = 0; gg < 4; ++gg) v = (gg == g) ? lg[4 + gg * 8 + j] + be[gg * 8 + j] : v;
            el[j] = v; }
        int i1 = 0;
#pragma unroll
        for (int j = 1; j < 8; ++j) if (el[j] > el[i1]) i1 = j;
        int i2 = (i1 == 0) ? 1 : 0;
#pragma unroll
        for (int j = 0; j < 8; ++j) if (j != i1 && el[j] > el[i2]) i2 = j;
        const float ex = expf(el[i2] - el[i1]);
        const float p1 = 1.0f / (1.0f + ex), p2 = ex / (1.0f + ex);
        const int e1 = g * 8 + i1, e2 = g * 8 + i2;
        eid[2 * t] = e1; eid[2 * t + 1] = e2; gw[2 * t] = gp * p1; gw[2 * t + 1] = gp * p2;
        atomicAdd(&counts[e1], 1u); atomicAdd(&counts[e2], 1u);
    }
}


DEVI void ln_row1024v(float (&y)[16], const float* g, const float* b, int lane) {
    float s = 0.f;
#pragma unroll
    for (int i = 0; i < 16; ++i) s += y[i];
    const float mu = wave_sum(s) * (1.0f / 1024.0f);
    float q = 0.f;
#pragma unroll
    for (int i = 0; i < 16; ++i) { const float d = y[i] - mu; q += d * d; }
    const float rstd = 1.0f / sqrtf(wave_sum(q) * (1.0f / 1024.0f) + LN_EPS);
#pragma unroll
    for (int i4 = 0; i4 < 4; ++i4) { const float4 g4 = *(const float4*)(g + 16 * lane + 4 * i4), b4 = *(const float4*)(b + 16 * lane + 4 * i4);
        y[4 * i4] = (y[4 * i4] - mu) * rstd * g4.x + b4.x; y[4 * i4 + 1] = (y[4 * i4 + 1] - mu) * rstd * g4.y + b4.y; y[4 * i4 + 2] = (y[4 * i4 + 2] - mu) * rstd * g4.z + b4.z; y[4 * i4 + 3] = (y[4 * i4 + 3] - mu) * rstd * g4.w + b4.w; }
}
DEVI void ln_row1024w(float (&y)[16], const float* g, const float* b, int lane) {
    float s = 0.f;
#pragma unroll
    for (int i = 0; i < 16; ++i) s += y[i];
    const float mu = wave_sum(s) * (1.0f / 1024.0f);
    float q = 0.f;
#pragma unroll
    for (int i = 0; i < 16; ++i) { const float d = y[i] - mu; q += d * d; }
    const float rstd = 1.0f / sqrtf(wave_sum(q) * (1.0f / 1024.0f) + LN_EPS);
#pragma unroll
    for (int i4 = 0; i4 < 4; ++i4) { const float4 g4 = *(const float4*)(g + 256 * i4 + 4 * lane), b4 = *(const float4*)(b + 256 * i4 + 4 * lane);
        y[4 * i4] = (y[4 * i4] - mu) * rstd * g4.x + b4.x; y[4 * i4 + 1] = (y[4 * i4 + 1] - mu) * rstd * g4.y + b4.y; y[4 * i4 + 2] = (y[4 * i4 + 2] - mu) * rstd * g4.z + b4.z; y[4 * i4 + 3] = (y[4 * i4 + 3] - mu) * rstd * g4.w + b4.w; }
}
DEVI void combine_row(float (&y)[16], const float* h, const unsigned short* Y0, const unsigned short* Y1, float g0, float g1, int lane) {
    uint2 aw[4], bw[4]; float4 hv[4];
#pragma unroll
    for (int i4 = 0; i4 < 4; ++i4) { aw[i4] = *(const uint2*)(Y0 + 256 * i4 + 4 * lane); bw[i4] = *(const uint2*)(Y1 + 256 * i4 + 4 * lane); hv[i4] = *(const float4*)(h + 256 * i4 + 4 * lane); }
#pragma unroll
    for (int i4 = 0; i4 < 4; ++i4) {
        y[4 * i4]     = DN_ALPHA * hv[i4].x + (g0 * __uint_as_float(aw[i4].x << 16) + g1 * __uint_as_float(bw[i4].x << 16));
        y[4 * i4 + 1] = DN_ALPHA * hv[i4].y + (g0 * __uint_as_float(aw[i4].x & 0xFFFF0000u) + g1 * __uint_as_float(bw[i4].x & 0xFFFF0000u));
        y[4 * i4 + 2] = DN_ALPHA * hv[i4].z + (g0 * __uint_as_float(aw[i4].y << 16) + g1 * __uint_as_float(bw[i4].y << 16));
        y[4 * i4 + 3] = DN_ALPHA * hv[i4].w + (g0 * __uint_as_float(aw[i4].y & 0xFFFF0000u) + g1 * __uint_as_float(bw[i4].y & 0xFFFF0000u)); }
}
typedef float f32x4v __attribute__((ext_vector_type(4)));
DEVI void ln_route_block(int tb, int ntok, const float* Zsrc, float* Hdst, const float* g, const float* b, const float4* __restrict__ Wr, const float* bg, const float* be,
                         int* eid, float* gw, unsigned* counts, float* sm) {
    const int tid = otid(), lane = tid & 63, wave = tid >> 6;
    unsigned* lcnt = (unsigned*)(sm + 8 * 16 * 48);
    if (tid < NE) lcnt[tid] = 0u;
    { float yy[8][16];
#pragma unroll
      for (int i = 0; i < 8; ++i) { const int tl = wave * 8 + i; const size_t t = (size_t)(tb + (tl < ntok ? tl : ntok - 1));
#pragma unroll
          for (int i4 = 0; i4 < 4; ++i4) { const float4 v = *(const float4*)(Zsrc + t * D + 256 * i4 + 4 * lane); yy[i][4 * i4] = v.x; yy[i][4 * i4 + 1] = v.y; yy[i][4 * i4 + 2] = v.z; yy[i][4 * i4 + 3] = v.w; } }
#pragma unroll
      for (int i = 0; i < 8; ++i) { const int tl = wave * 8 + i;
          if (tl < ntok) { const size_t t = (size_t)(tb + tl);
              ln_row1024w(yy[i], g, b, lane);
#pragma unroll
              for (int i4 = 0; i4 < 4; ++i4) *(float4*)(Hdst + t * D + 256 * i4 + 4 * lane) = make_float4(yy[i][4 * i4], yy[i][4 * i4 + 1], yy[i][4 * i4 + 2], yy[i][4 * i4 + 3]); } } }
    asm volatile("s_waitcnt vmcnt(0)" ::: "memory");
    __syncthreads();
    const int grp = wave & 3, khalf = wave >> 2;
    if (grp * 16 < ntok) {
        const int t0 = tb + 16 * grp, row = lane & 15, kg = lane >> 4;
        f32x4v acc[3];
#pragma unroll
        for (int ct = 0; ct < 3; ++ct) acc[ct] = (f32x4v){0.f, 0.f, 0.f, 0.f};
        const float* arow = Hdst + (size_t)(t0 + row) * D + 4 * kg;
        float4 aN[4], bN[4][3];
#pragma unroll
        for (int u = 0; u < 4; ++u) { const int sstep = 32 * khalf + u; aN[u] = *(const float4*)(arow + 16 * sstep);
#pragma unroll
            for (int ct = 0; ct < 3; ++ct) bN[u][ct] = Wr[(sstep * 3 + ct) * 64 + lane]; }
#pragma unroll 1
        for (int s0 = 32 * khalf; s0 < 32 * khalf + 32; s0 += 4) {
            float4 aC[4], bC[4][3];
#pragma unroll
            for (int u = 0; u < 4; ++u) { aC[u] = aN[u];
#pragma unroll
                for (int ct = 0; ct < 3; ++ct) bC[u][ct] = bN[u][ct]; }
            if (s0 + 4 < 32 * khalf + 32) {
#pragma unroll
                for (int u = 0; u < 4; ++u) { const int sstep = s0 + 4 + u; aN[u] = *(const float4*)(arow + 16 * sstep);
#pragma unroll
                    for (int ct = 0; ct < 3; ++ct) bN[u][ct] = Wr[(sstep * 3 + ct) * 64 + lane]; } }
#pragma unroll
            for (int u = 0; u < 4; ++u)
#pragma unroll
                for (int ct = 0; ct < 3; ++ct) { const float4 a4 = aC[u], b4 = bC[u][ct];
                    acc[ct] = __builtin_amdgcn_mfma_f32_16x16x4f32(a4.x, b4.x, acc[ct], 0, 0, 0); acc[ct] = __builtin_amdgcn_mfma_f32_16x16x4f32(a4.y, b4.y, acc[ct], 0, 0, 0);
                    acc[ct] = __builtin_amdgcn_mfma_f32_16x16x4f32(a4.z, b4.z, acc[ct], 0, 0, 0); acc[ct] = __builtin_amdgcn_mfma_f32_16x16x4f32(a4.w, b4.w, acc[ct], 0, 0, 0); }
        }
        float* Lg = sm + (khalf * 4 + grp) * 16 * 48;
#pragma unroll
        for (int ct = 0; ct < 3; ++ct)
#pragma unroll
            for (int j = 0; j < 4; ++j) Lg[(4 * kg + j) * 48 + 16 * ct + row] = acc[ct][j];
    }
    __syncthreads();
    if (wave < 4 && wave * 16 < ntok) {
        const int t0 = tb + 16 * wave;
        if (lane < 16) {
            const int t = t0 + lane; const float* lgA = sm + wave * 16 * 48 + lane * 48; const float* lgB = lgA + 4 * 16 * 48;
            float lg[36];
#pragma unroll
            for (int j = 0; j < 36; ++j) lg[j] = lgA[j] + lgB[j];
            float gl[4]; int gsel = 0;
#pragma unroll
            for (int j = 0; j < 4; ++j) gl[j] = lg[j] + bg[j];
#pragma unroll
            for (int j = 1; j < 4; ++j) if (gl[j] > gl[gsel]) gsel = j;
            float den = 0.f;
#pragma unroll
            for (int j = 0; j < 4; ++j) den += expf(gl[j] - gl[gsel]);
            const float gp = 1.0f / den;
            float el[8];
#pragma unroll
            for (int j = 0; j < 8; ++j) { float v = lg[4 + j];
#pragma unroll
                for (int gg = 1; gg < 4; ++gg) v = (gg == gsel) ? lg[4 + gg * 8 + j] : v;
                el[j] = v + be[gsel * 8 + j]; }
            int i1 = 0;
#pragma unroll
            for (int j = 1; j < 8; ++j) if (el[j] > el[i1]) i1 = j;
            int i2 = (i1 == 0) ? 1 : 0;
#pragma unroll
            for (int j = 0; j < 8; ++j) if (j != i1 && el[j] > el[i2]) i2 = j;
            float e1v = el[0], e2v = el[0];
#pragma unroll
            for (int j = 0; j < 8; ++j) { e1v = (j == i1) ? el[j] : e1v; e2v = (j == i2) ? el[j] : e2v; }
            const float ex = expf(e2v - e1v);
            const float p1 = 1.0f / (1.0f + ex), p2 = ex / (1.0f + ex);
            const int e1 = gsel * 8 + i1, e2 = gsel * 8 + i2;
            eid[2 * t] = e1; eid[2 * t + 1] = e2; gw[2 * t] = gp * p1; gw[2 * t + 1] = gp * p2;
            atomicAdd(&lcnt[e1], 1u); atomicAdd(&lcnt[e2], 1u);
        }
    }
    __syncthreads();
    if (tid < NE) { const unsigned c = lcnt[tid]; if (c) atomicAdd(&counts[tid], c); }
    __syncthreads();
}

using pg8::f32x4; using pg8::Unit; typedef unsigned short bf16_t;
DEVI float bf2f(unsigned short b) { return __uint_as_float(((unsigned)b) << 16); }
DEVI float bflo(unsigned w) { return __uint_as_float(w << 16); }
DEVI float bfhi(unsigned w) { return __uint_as_float(w & 0xFFFF0000u); }
DEVI unsigned cvt_pk_bf16(float lo, float hi) { unsigned r; asm volatile("v_cvt_pk_bf16_f32 %0, %1, %2" : "=v"(r) : "v"(lo), "v"(hi)); return r; }
DEVI uint2 pack4(const f32x4 v) { return make_uint2(cvt_pk_bf16(v[0], v[1]), cvt_pk_bf16(v[2], v[3])); }
DEVI float fsigm(float x) { return __builtin_amdgcn_rcpf(1.0f + __expf(-x)); }
DEVI unsigned pack4_fp8(const f32x4 v) { int w = __builtin_amdgcn_cvt_pk_fp8_f32(v[0], v[1], 0, false); w = __builtin_amdgcn_cvt_pk_fp8_f32(v[2], v[3], w, true); return (unsigned)w; }

DEVI int in0_srccol(int n) {
    if (n < 1024) { const int G = n >> 5, nn = (n >> 4) & 1, i = n & 15; return (nn ? OFF_AGATE : OFF_AVAL) + 16 * G + i; }
    if (n < 2048 || (n >= 2560 && n < 3072)) {
        const int base = n < 1536 ? OFF_Q : n < 2048 ? OFF_K : OFF_QI; const int loc = n & 511;
        const int G = loc >> 5, nn = (loc >> 4) & 1, i = loc & 15; return base + 64 * (G >> 1) + 32 * nn + 16 * (G & 1) + i; }
    if (n < 2560) return OFF_V + (n - 2048);
    if (n < 3136) { const int loc = n - 3072; const int G = loc >> 5, nn = (loc >> 4) & 1, i = loc & 15; return OFF_KI + 32 * nn + 16 * G + i; }
    if (n < 3144) return OFF_WI + (n - 3136);
    return -1;
}
struct EpiIn0 {
    static constexpr bool PERM = false, AFTER_DRAIN = false;
    bf16_t* GLU; bf16_t* KI; float* WI; const float* ropeC; const float* ropeS; unsigned char* KV8;
    DEVI void operator()(const f32x4 (&acc)[2][2][4][2], const Unit& u, int wr, int wc, int fr, int fq) const {
        const int pn = u.pn; const int rbase = u.pm * 256 + wr * 64 + fr;
        if (pn < 4) {
#pragma unroll
            for (int ai = 0; ai < 2; ++ai)
#pragma unroll
                for (int m = 0; m < 4; ++m) { const size_t row = rbase + ai * 128 + m * 16;
#pragma unroll
                    for (int bj = 0; bj < 2; ++bj) { const int G = 8 * pn + 4 * bj + wc; const f32x4 v = acc[ai][bj][m][0], g = acc[ai][bj][m][1]; f32x4 o;
#pragma unroll
                        for (int j = 0; j < 4; ++j) o[j] = v[j] * fsigm(g[j]);
                        *(uint2*)(GLU + row * 512 + 16 * G + 4 * fq) = pack4(o); } }
        } else if (pn == 8 || pn == 9) {
#pragma unroll
            for (int ai = 0; ai < 2; ++ai)
#pragma unroll
                for (int m = 0; m < 4; ++m) { const size_t row = rbase + ai * 128 + m * 16;
#pragma unroll
                    for (int bj = 0; bj < 2; ++bj)
#pragma unroll
                        for (int n = 0; n < 2; ++n) { const int col = 256 * (pn - 8) + 128 * bj + 32 * wc + 16 * n + 4 * fq;
                            *(unsigned*)(KV8 + row * 1024 + (size_t)(col >> 3) * 16 + 8 + (col & 7)) = pack4_fp8(acc[ai][bj][m][n]); } }
        } else if (pn == 12) {
            if (wc < 2) { const int d0 = 16 * wc + 4 * fq;
#pragma unroll
                for (int ai = 0; ai < 2; ++ai)
#pragma unroll
                    for (int m = 0; m < 4; ++m) { const size_t row = rbase + ai * 128 + m * 16;
                        const f32x4 c = *(const f32x4*)(ropeC + row * 32 + d0), s = *(const f32x4*)(ropeS + row * 32 + d0);
                        const f32x4 t1 = acc[ai][0][m][0], t2 = acc[ai][0][m][1];
                        *(uint2*)(KI + row * 64 + d0) = pack4(t1 * c - t2 * s); *(uint2*)(KI + row * 64 + 32 + d0) = pack4(t1 * s + t2 * c); }
            } else if (wc == 2 && fq < 2) {
#pragma unroll
                for (int ai = 0; ai < 2; ++ai)
#pragma unroll
                    for (int m = 0; m < 4; ++m) { const size_t row = rbase + ai * 128 + m * 16; *(f32x4*)(WI + row * 8 + 4 * fq) = acc[ai][0][m][0] * 0.35355339059327373f; }
            }
        } else {
            bf16_t* dst = GLU + (size_t)(pn < 6 ? 1 : pn < 8 ? 2 : 4) * LP * 512; const int pl = pn & 1; const int d0 = 16 * (wc & 1) + 4 * fq;
#pragma unroll
            for (int ai = 0; ai < 2; ++ai)
#pragma unroll
                for (int m = 0; m < 4; ++m) { const size_t row = rbase + ai * 128 + m * 16;
                    const f32x4 c = *(const f32x4*)(ropeC + row * 32 + d0), s = *(const f32x4*)(ropeS + row * 32 + d0);
#pragma unroll
                    for (int bj = 0; bj < 2; ++bj) { const int hh = 4 * pl + 2 * bj + (wc >> 1); const f32x4 t1 = acc[ai][bj][m][0], t2 = acc[ai][bj][m][1];
                        if (pn == 6 || pn == 7) { const int da = 64 * hh + d0, db = da + 32;
                            *(unsigned*)(KV8 + row * 1024 + (size_t)(da >> 3) * 16 + (da & 7)) = pack4_fp8(t1 * c - t2 * s); *(unsigned*)(KV8 + row * 1024 + (size_t)(db >> 3) * 16 + (db & 7)) = pack4_fp8(t1 * s + t2 * c);
                        } else { *(uint2*)(dst + row * 512 + 64 * hh + d0) = pack4(t1 * c - t2 * s); *(uint2*)(dst + row * 512 + 64 * hh + 32 + d0) = pack4(t1 * s + t2 * c); } } }
        }
    }
};
struct EpiRes0 {
    static constexpr bool PERM = false, AFTER_DRAIN = false;
    const float* x; const float* meta; float* Z;
    DEVI void operator()(const f32x4 (&acc)[2][2][4][2], const Unit& u, int wr, int wc, int fr, int fq) const {
        const int rbase = u.pm * 256 + wr * 64 + fr, cbase = u.pn * 256 + wc * 32 + 4 * fq;
#pragma unroll
        for (int ai = 0; ai < 2; ++ai)
#pragma unroll
            for (int m = 0; m < 4; ++m) { const int row = rbase + ai * 128 + m * 16;
                if (row < L) { const float* rs = row < NMETA ? meta + (size_t)row * D : x + (size_t)(row - NMETA) * D;
#pragma unroll
                    for (int bj = 0; bj < 2; ++bj)
#pragma unroll
                        for (int n = 0; n < 2; ++n) { const int col = cbase + 128 * bj + 16 * n; const f32x4 r4 = *(const f32x4*)(rs + col); *(f32x4*)(Z + (size_t)row * D + col) = r4 * DN_ALPHA + acc[ai][bj][m][n]; } } }
    }
};
struct EpiGateUp {
    static constexpr bool PERM = false, AFTER_DRAIN = false;
    bf16_t* Hm;
    DEVI void operator()(const f32x4 (&acc)[2][2][4][2], const Unit& u, int wr, int wc, int fr, int fq) const {
        const int pl = u.pn & 3; const int rbase = u.pm * 256 + wr * 64 + fr;
#pragma unroll
        for (int ai = 0; ai < 2; ++ai)
#pragma unroll
            for (int m = 0; m < 4; ++m) { const size_t row = rbase + ai * 128 + m * 16;
#pragma unroll
                for (int bj = 0; bj < 2; ++bj) { const int G = 8 * pl + 4 * bj + wc; const f32x4 g = acc[ai][bj][m][0], up = acc[ai][bj][m][1]; f32x4 o;
#pragma unroll
                    for (int j = 0; j < 4; ++j) o[j] = g[j] * fsigm(g[j]) * up[j];
                    *(uint2*)(Hm + row * 512 + 16 * G + 4 * fq) = pack4(o); } }
    }
};
struct EpiDown {
    static constexpr bool PERM = false, AFTER_DRAIN = false;
    bf16_t* Y;
    DEVI void operator()(const f32x4 (&acc)[2][2][4][2], const Unit& u, int wr, int wc, int fr, int fq) const {
        const int pl = u.pn & 3; const int rbase = u.pm * 256 + wr * 64 + fr, cbase = pl * 256 + wc * 32 + 4 * fq;
#pragma unroll
        for (int ai = 0; ai < 2; ++ai)
#pragma unroll
            for (int m = 0; m < 4; ++m) { const size_t row = rbase + ai * 128 + m * 16;
#pragma unroll
                for (int bj = 0; bj < 2; ++bj)
#pragma unroll
                    for (int n = 0; n < 2; ++n) *(uint2*)(Y + row * 1024 + cbase + 128 * bj + 16 * n) = pack4(acc[ai][bj][m][n]); }
    }
};
struct MoeOrder {
    const int* mt; int nunits, G, c;
    DEVI void init(const int* t, int G_, int c_) { mt = t; nunits = t[0] * 4; G = G_; c = c_; }
    DEVI bool next(int i, Unit& u) const { const int li = i * G + c; if (li >= nunits) return false; const int ti = li >> 2; u.pm = ti; u.pn = mt[4 + ti] * 4 + (li & 3); return true; }
    DEVI void a_ready(const Unit&) const {}
    DEVI void done(const Unit&) const {}
};

template <class F> DEVI void tr_tile(bf16_t* dst, int K, int n0, int k0, F src, float* sm) {
    const int tid = otid();
    __syncthreads();
    { const int nn = tid & 63, kb = tid >> 6;
#pragma unroll
      for (int p = 0; p < 8; ++p) { const int kk = kb + 8 * p; sm[kk * 65 + nn] = src(n0 + nn, k0 + kk); } }
    __syncthreads();
    { const int nn = tid >> 3, kq = (tid & 7) * 8; float v[8];
#pragma unroll
      for (int j = 0; j < 8; ++j) v[j] = sm[(kq + j) * 65 + nn];
      uint4 w; w.x = cvt_pk_bf16(v[0], v[1]); w.y = cvt_pk_bf16(v[2], v[3]); w.z = cvt_pk_bf16(v[4], v[5]); w.w = cvt_pk_bf16(v[6], v[7]);
      *(uint4*)(dst + (size_t)(n0 + nn) * K + k0 + kq) = w; }
}

struct TrJob { bf16_t* dst; const float* s0; const float* s1; int K, n0, k0, ld, mode; };
DEVI float tr_src(const TrJob& J, int n, int k) {
    if (J.mode == 0) return __builtin_nontemporal_load(J.s0 + (size_t)k * J.ld + n);
    if (J.mode == 1) { const int sc = in0_srccol(n); return sc < 0 ? 0.f : __builtin_nontemporal_load(J.s0 + (size_t)k * IN_AB + sc); }
    const int ch = (n >> 5) * 16 + (n & 15); return ((n >> 4) & 1) ? __builtin_nontemporal_load(J.s1 + (size_t)k * DE + ch) : __builtin_nontemporal_load(J.s0 + (size_t)k * DE + ch);
}
DEVI void tr_fetch(const TrJob& J, float (&v)[8]) {
    const int tid = otid(), nn = tid & 63, kb = tid >> 6;
#pragma unroll
    for (int p = 0; p < 8; ++p) v[p] = tr_src(J, J.n0 + nn, J.k0 + kb + 8 * p);
}
DEVI void tr_commit(const TrJob& J, const float (&v)[8], float* sm) {
    const int tid = otid();
    __syncthreads();
    { const int nn = tid & 63, kb = tid >> 6;
#pragma unroll
      for (int p = 0; p < 8; ++p) sm[(kb + 8 * p) * 65 + nn] = v[p]; }
    __syncthreads();
    { const int nn = tid >> 3, kq = (tid & 7) * 8; float x[8];
#pragma unroll
      for (int j = 0; j < 8; ++j) x[j] = sm[(kq + j) * 65 + nn];
      uint4 w; w.x = cvt_pk_bf16(x[0], x[1]); w.y = cvt_pk_bf16(x[2], x[3]); w.z = cvt_pk_bf16(x[4], x[5]); w.w = cvt_pk_bf16(x[6], x[7]);
      *(uint4*)(J.dst + (size_t)(J.n0 + nn) * J.K + J.k0 + kq) = w; }
}
template <class Dec> DEVI void tr_run(int njobs, Dec dec, float* sm, int rank = (int)blockIdx.x, int G = (int)gridDim.x) {
    int j = rank;
    TrJob Ja{}, Jb{}; float va[8], vb[8];
    if (j < njobs) { Ja = dec(j); tr_fetch(Ja, va); }
    while (j < njobs) {
        int jn = j + G; if (jn < njobs) { Jb = dec(jn); tr_fetch(Jb, vb); }
        tr_commit(Ja, va, sm);
        j = jn; if (j >= njobs) break;
        jn = j + G; if (jn < njobs) { Ja = dec(jn); tr_fetch(Ja, va); }
        tr_commit(Jb, vb, sm);
        j = jn;
    }
    __syncthreads();
}

DEVI void moe_dispatch_mfma(const float* H, const int* eid, const unsigned* counts, unsigned* cursor, int* slot, int* mtiles, bf16_t* Xperm, int* sm_i, int gwave, int nwaves, int lane, int p_begin) {
    { const int tid = otid();
      if (tid == 0) { int o = 0; for (int e = 0; e < NE; ++e) { sm_i[e] = o; o += (((int)counts[e] + 255) >> 8) << 8; } }
      if (tid < NE) sm_i[32 + tid] = 0; }
    __syncthreads();
    { const int ppw = (NPAIR - p_begin + nwaves - 1) / nwaves; const int pb = p_begin + gwave * ppw; const int pe = pb + ppw < NPAIR ? pb + ppw : NPAIR;
      int e_ = 0, rk = 0; const bool act = lane < ppw && pb + lane < pe;
      if (act) { e_ = eid[pb + lane]; rk = atomicAdd(&sm_i[32 + e_], 1); }
      __syncthreads();
      { const int tid = otid(); if (tid < NE) { const int c = sm_i[32 + tid]; if (c) sm_i[64 + tid] = sm_i[tid] + (int)atomicAdd(&cursor[tid], (unsigned)c); } }
      __syncthreads();
      if (pb < pe) {
        int sl = 0;
        if (act) { sl = sm_i[64 + e_] + rk; slot[pb + lane] = sl; }
        for (int k0 = 0; pb + k0 < pe; k0 += 8) {
            float4 v[8][4];
#pragma unroll
            for (int k = 0; k < 8; ++k) { const int p = pb + k0 + k < pe ? pb + k0 + k : pe - 1; const float4* src = (const float4*)(H + (size_t)(p >> 1) * D);
#pragma unroll
                for (int r = 0; r < 4; ++r) v[k][r] = src[lane + 64 * r]; }
#pragma unroll
            for (int k = 0; k < 8; ++k) { const int s = __shfl(sl, k0 + k);
                if (pb + k0 + k < pe) { uint2* dst = (uint2*)(Xperm + (size_t)s * D);
#pragma unroll
                    for (int r = 0; r < 4; ++r) dst[lane + 64 * r] = make_uint2(cvt_pk_bf16(v[k][r].x, v[k][r].y), cvt_pk_bf16(v[k][r].z, v[k][r].w)); } }
        }
      } }
    if (blockIdx.x == 0 && otid() == 0) { int n = 0; for (int e = 0; e < NE; ++e) { const int nt = ((int)counts[e] + 255) >> 8; for (int i = 0; i < nt; ++i) mtiles[4 + n++] = e; } mtiles[0] = n; }
    __syncthreads();
}

DEVI float gelu_fast(float x) { return x * fsigm(1.5957691216057308f * (x + 0.044715f * x * x * x)); }
struct EpiIn1 {
    static constexpr bool PERM = false, AFTER_DRAIN = false;
    bf16_t* G;
    DEVI void operator()(const f32x4 (&acc)[2][2][4][2], const Unit& u, int wr, int wc, int fr, int fq) const {
        const int pn = u.pn; const bool is_gate = pn < 5; const int rbase = u.pm * 256 + wr * 64 + fr;
        bf16_t* dst = G + (is_gate ? (size_t)0 : (size_t)LP * RNN_W) + (size_t)((is_gate ? pn : pn - 5) * 256 + wc * 32 + 4 * fq);
#pragma unroll
        for (int ai = 0; ai < 2; ++ai)
#pragma unroll
            for (int m = 0; m < 4; ++m) { const size_t row = rbase + ai * 128 + m * 16;
#pragma unroll
                for (int bj = 0; bj < 2; ++bj)
#pragma unroll
                    for (int n = 0; n < 2; ++n) { f32x4 v = acc[ai][bj][m][n];
                        if (is_gate) {
#pragma unroll
                            for (int j = 0; j < 4; ++j) v[j] = gelu_fast(v[j]); }
                        *(uint2*)(dst + row * RNN_W + 128 * bj + 16 * n) = pack4(v); } }
    }
};
struct EpiRes1 {
    static constexpr bool PERM = false, AFTER_DRAIN = false;
    const float* R; float* Z;
    DEVI void operator()(const f32x4 (&acc)[2][2][4][2], const Unit& u, int wr, int wc, int fr, int fq) const {
        const int rbase = u.pm * 256 + wr * 64 + fr, cbase = u.pn * 256 + wc * 32 + 4 * fq;
#pragma unroll
        for (int ai = 0; ai < 2; ++ai)
#pragma unroll
            for (int m = 0; m < 4; ++m) { const size_t row = rbase + ai * 128 + m * 16;
#pragma unroll
                for (int bj = 0; bj < 2; ++bj)
#pragma unroll
                    for (int n = 0; n < 2; ++n) { const int col = cbase + 128 * bj + 16 * n; const f32x4 r4 = *(const f32x4*)(R + row * D + col); *(f32x4*)(Z + row * D + col) = r4 * DN_ALPHA + acc[ai][bj][m][n]; } }
    }
};

typedef short bf16x8_t __attribute__((ext_vector_type(8)));
struct RgIn { uint4 x[2][4]; };
DEVI void rglru_fetch(int c, int ch0, const bf16_t* __restrict__ XR, int tid, RgIn& R) {
    const int c8 = tid & 15, tr = tid >> 4;
#pragma unroll
    for (int half = 0; half < 2; ++half) { const int t = c * 64 + tr + 32 * half;
#pragma unroll
        for (int j = 0; j < 4; ++j) { const int tt = t - 3 + j; R.x[half][j] = tt >= 0 ? *(const uint4*)(XR + (size_t)tt * RNN_W + ch0 + 8 * c8) : make_uint4(0u, 0u, 0u, 0u); } }
}
template <bool FINAL>
DEVI void rglru_unit(int c, int nb, const RgIn& R, const bf16x8_t (&fa)[4], const bf16x8_t (&fx)[4], float bav, float bxv, float sp,
                     const bf16_t* __restrict__ GATEg, float* __restrict__ Aend, float* __restrict__ Hend, const float* __restrict__ CIN, bf16_t* __restrict__ YY,
                     unsigned char* lds, int tid) {
    const int lane = tid & 63, w = tid >> 6, col = lane & 15, quad = lane >> 4;
    bf16_t* xcb = (bf16_t*)lds;
    float* xcf = (float*)(lds + 64 * 136 * 2);
    const float* cwl = (const float*)(lds + 64 * 136 * 2 + 64 * 132 * 4);
    const int t0 = c * 64, ch0 = nb * RNN_BW, ch = ch0 + 16 * w + col;
    const float cinv = FINAL ? CIN[(size_t)ch * CP + c] : 0.f;
    const int c8 = tid & 15, tr = tid >> 4;
    uint4 g[2];
    if (FINAL) {
#pragma unroll
        for (int half = 0; half < 2; ++half) { const int t = t0 + tr + 32 * half; g[half] = (t < L) ? *(const uint4*)(GATEg + (size_t)t * RNN_W + ch0 + 8 * c8) : make_uint4(0u, 0u, 0u, 0u); } }
    __syncthreads();
    {
        float bv[8];
        { const float4 b0 = *(const float4*)(cwl + 512 + 8 * c8), b1 = *(const float4*)(cwl + 512 + 8 * c8 + 4); bv[0] = b0.x; bv[1] = b0.y; bv[2] = b0.z; bv[3] = b0.w; bv[4] = b1.x; bv[5] = b1.y; bv[6] = b1.z; bv[7] = b1.w; }
#pragma unroll
        for (int half = 0; half < 2; ++half) { const int tl = tr + 32 * half;
            float v[8];
#pragma unroll
            for (int i = 0; i < 8; ++i) v[i] = bv[i];
#pragma unroll
            for (int j = 0; j < 4; ++j) { const uint4 xv = R.x[half][j];
                const float4 w0 = *(const float4*)(cwl + j * 128 + 8 * c8), w1 = *(const float4*)(cwl + j * 128 + 8 * c8 + 4);
                v[0] += w0.x * bflo(xv.x); v[1] += w0.y * bfhi(xv.x); v[2] += w0.z * bflo(xv.y); v[3] += w0.w * bfhi(xv.y);
                v[4] += w1.x * bflo(xv.z); v[5] += w1.y * bfhi(xv.z); v[6] += w1.z * bflo(xv.w); v[7] += w1.w * bfhi(xv.w); }
            *(float4*)(xcf + tl * 132 + 8 * c8) = make_float4(v[0], v[1], v[2], v[3]); *(float4*)(xcf + tl * 132 + 8 * c8 + 4) = make_float4(v[4], v[5], v[6], v[7]);
            uint4 pk; pk.x = cvt_pk_bf16(v[0], v[1]); pk.y = cvt_pk_bf16(v[2], v[3]); pk.z = cvt_pk_bf16(v[4], v[5]); pk.w = cvt_pk_bf16(v[6], v[7]);
            *(uint4*)(xcb + (16 * ((tl >> 2) & 3) + 4 * (tl >> 4) + (tl & 3)) * 136 + 8 * c8) = pk; }
    }
    __syncthreads();
    f32x4 ca[4], cx[4];
#pragma unroll
    for (int mt = 0; mt < 4; ++mt) { ca[mt] = (f32x4){0.f, 0.f, 0.f, 0.f}; cx[mt] = (f32x4){0.f, 0.f, 0.f, 0.f};
#pragma unroll
        for (int ks = 0; ks < 4; ++ks) { const bf16x8_t af = *(const bf16x8_t*)(xcb + (16 * mt + col) * 136 + 32 * ks + 8 * quad);
            ca[mt] = __builtin_amdgcn_mfma_f32_16x16x32_bf16(af, fa[ks], ca[mt], 0, 0, 0);
            cx[mt] = __builtin_amdgcn_mfma_f32_16x16x32_bf16(af, fx[ks], cx[mt], 0, 0, 0); } }
    float av[4][4], uv[4][4]; float A = 1.f, H = 0.f;
#pragma unroll
    for (int mt = 0; mt < 4; ++mt) {
#pragma unroll
        for (int j = 0; j < 4; ++j) { const int tl = 16 * quad + 4 * mt + j;
            const float xcv = xcf[tl * 132 + 16 * w + col];
            const float r = fsigm(ca[mt][j] + bav), ig = fsigm(cx[mt][j] + bxv);
            const float la = -8.0f * r * sp;
            const float x2 = 2.0f * la;
            float em1 = x2 * (1.0f + x2 * (0.5f + x2 * (0.16666667f + x2 * (0.041666668f + x2 * (0.0083333338f + x2 * (0.0013888889f + x2 * 0.0001984127f))))));
            if (x2 < -0.5f) em1 = expm1f(x2);
            float a_ = __expf(la), u_ = __builtin_amdgcn_sqrtf(-em1) * (ig * xcv);
            if (t0 + tl >= L) { a_ = 1.f; u_ = 0.f; }
            av[mt][j] = a_; uv[mt][j] = u_; H = a_ * H + u_; A *= a_; } }
    float carry = cinv, prod = 1.f, hin = 0.f;
#pragma unroll
    for (int q = 0; q < 4; ++q) {
        if (quad == q) hin = carry;
        const float nw = A * carry + H, np = A * prod;
        carry = __shfl(nw, q * 16 + col); prod = __shfl(np, q * 16 + col); }
    if (!FINAL) {
        if (quad == 0) { Aend[(size_t)ch * CP + c] = prod; Hend[(size_t)ch * CP + c] = carry; }
    } else {
        float h = hin;
#pragma unroll
        for (int mt = 0; mt < 4; ++mt)
#pragma unroll
            for (int j = 0; j < 4; ++j) { h = av[mt][j] * h + uv[mt][j]; xcf[(16 * quad + 4 * mt + j) * 132 + 16 * w + col] = h; }
        __syncthreads();
#pragma unroll
        for (int half = 0; half < 2; ++half) { const int tl = tr + 32 * half, t = t0 + tl;
            if (t >= NMETA && t < L) {
                const float4 h0 = *(const float4*)(xcf + tl * 132 + 8 * c8), h1 = *(const float4*)(xcf + tl * 132 + 8 * c8 + 4);
                const uint4 gg = g[half];
                uint4 pk; pk.x = cvt_pk_bf16(bflo(gg.x) * h0.x, bfhi(gg.x) * h0.y); pk.y = cvt_pk_bf16(bflo(gg.y) * h0.z, bfhi(gg.y) * h0.w);
                pk.z = cvt_pk_bf16(bflo(gg.z) * h1.x, bfhi(gg.z) * h1.y); pk.w = cvt_pk_bf16(bflo(gg.w) * h1.z, bfhi(gg.w) * h1.w);
                *(uint4*)(YY + (size_t)t * RNN_W + ch0 + 8 * c8) = pk; } }
    }
}
template <bool FINAL>
DEVI void rglru_phase(const bf16_t* __restrict__ XR, const bf16_t* __restrict__ GATEg, const bf16_t* __restrict__ Wta, const bf16_t* __restrict__ Wtx,
                      const float* __restrict__ cw, const float* __restrict__ cb, const float* __restrict__ ba, const float* __restrict__ bx, const float* __restrict__ lam,
                      float* __restrict__ Aend, float* __restrict__ Hend, const float* __restrict__ CIN, bf16_t* __restrict__ YY, unsigned char* lds) {
    const int tid = otid(), lane = tid & 63, w = tid >> 6, col = lane & 15, quad = lane >> 4;
    const int G = gridDim.x, nb = blockIdx.x % RNN_NB, rank = blockIdx.x / RNN_NB, nblk = (G - nb + RNN_NB - 1) / RNN_NB;
    const int ch0 = nb * RNN_BW, ch = ch0 + 16 * w + col;
    float* cwl = (float*)(lds + 64 * 136 * 2 + 64 * 132 * 4);
    __syncthreads();
    for (int i = tid; i < 640; i += NTHREADS) cwl[i] = i < 512 ? cw[(i >> 7) * RNN_W + ch0 + (i & 127)] : cb[ch0 + (i - 512)];
    bf16x8_t fa[4], fx[4];
    { const size_t wrow = ((size_t)nb * 128 + 16 * w + col) * 128 + 8 * quad;
#pragma unroll
      for (int ks = 0; ks < 4; ++ks) { fa[ks] = *(const bf16x8_t*)(Wta + wrow + 32 * ks); fx[ks] = *(const bf16x8_t*)(Wtx + wrow + 32 * ks); } }
    const float bav = ba[ch], bxv = bx[ch], sp = log1pf(expf(-lam[ch]));
    RgIn Ra, Rb;
    int c = rank;
    if (c < NCHUNK) rglru_fetch(c, ch0, XR, tid, Ra);
    while (c < NCHUNK) {
        int cn = c + nblk;
        if (cn < NCHUNK) rglru_fetch(cn, ch0, XR, tid, Rb);
        rglru_unit<FINAL>(c, nb, Ra, fa, fx, bav, bxv, sp, GATEg, Aend, Hend, CIN, YY, lds, tid);
        c = cn; if (c >= NCHUNK) break;
        cn = c + nblk;
        if (cn < NCHUNK) rglru_fetch(cn, ch0, XR, tid, Ra);
        rglru_unit<FINAL>(c, nb, Rb, fa, fx, bav, bxv, sp, GATEg, Aend, Hend, CIN, YY, lds, tid);
        c = cn;
    }
    __syncthreads();
}

constexpr int SW = 544;
constexpr int CB = 512;
constexpr int NTILE = L / 16;
typedef float f32x16 __attribute__((ext_vector_type(16)));
typedef float f32x2v __attribute__((ext_vector_type(2)));
constexpr int HROW = 2112;
constexpr int IL_HIST = 0, IL_CKEY = 0, IL_CIDX = 16 * CB * 4, IL_HIST2 = 2 * 16 * CB * 4, IL_ROWS = IL_HIST2 + 16 * 256 * 4, IL_WI = 16 * HROW * 4, IL_QST = IL_WI + 512, IL_QST2 = IL_QST + 256, IL_CCNT = IL_QST2 + 256, IL_FLAG = IL_CCNT + 64;
constexpr int IL_QF = IL_ROWS + 16 * SW * 4;
static_assert(IL_QF + 8 * 512 <= IL_WI && IL_FLAG + 64 <= LDS_BYTES - 16, "indexer LDS");

constexpr int AW_BYTES = 512;
typedef short s16x2 __attribute__((ext_vector_type(2)));
DEVI float dot2bf(unsigned a, unsigned b, float c) { return __builtin_amdgcn_fdot2_f32_bf16(__builtin_bit_cast(s16x2, a), __builtin_bit_cast(s16x2, b), c, false); }
#define LDS_FENCE() asm volatile("s_waitcnt lgkmcnt(0)" ::: "memory")

struct AttnQ { float m, l, o[8]; };

DEVI void attn_issue(int b0, int n, const unsigned short* lst, const unsigned char* __restrict__ KV8, int lane, uint4 (&kv)[8]) {
    const int last = n - 1;
#pragma unroll
    for (int kk = 0; kk < 8; ++kk) { const int ii = b0 + kk; const int key = lst[ii < last ? ii : last]; kv[kk] = *(const uint4*)(KV8 + (size_t)key * 1024 + lane * 16); }
}
DEVI void attn_compute(AttnQ& S, int b0, int n, const float (&q)[8], const uint4 (&kv)[8]) {
    float sc[8]; float mx = S.m;
#pragma unroll
    for (int u = 0; u < 8; ++u) {
        const f32x2v k0 = __builtin_amdgcn_cvt_pk_f32_fp8((int)kv[u].x, false), k1 = __builtin_amdgcn_cvt_pk_f32_fp8((int)kv[u].x, true),
                     k2 = __builtin_amdgcn_cvt_pk_f32_fp8((int)kv[u].y, false), k3 = __builtin_amdgcn_cvt_pk_f32_fp8((int)kv[u].y, true);
        f32x2v d2 = k0 * (f32x2v){q[0], q[1]}; d2 = k1 * (f32x2v){q[2], q[3]} + d2; d2 = k2 * (f32x2v){q[4], q[5]} + d2; d2 = k3 * (f32x2v){q[6], q[7]} + d2;
        float d = d2[0] + d2[1];
        d += dpp_f<0xB1>(d); d += dpp_f<0x4E>(d); d += dpp_f<0x141>(d);
        sc[u] = (b0 + u < n) ? d : -INFINITY;
        mx = fmaxf(mx, sc[u]); }
    const float scale = __builtin_amdgcn_exp2f(S.m - mx);
    float ls = S.l * scale;
#pragma unroll
    for (int i = 0; i < 8; ++i) S.o[i] *= scale;
#pragma unroll
    for (int u = 0; u < 8; ++u) {
        const float p = __builtin_amdgcn_exp2f(sc[u] - mx); ls += p;
        const f32x2v v0 = __builtin_amdgcn_cvt_pk_f32_fp8((int)kv[u].z, false), v1 = __builtin_amdgcn_cvt_pk_f32_fp8((int)kv[u].z, true),
                     v2 = __builtin_amdgcn_cvt_pk_f32_fp8((int)kv[u].w, false), v3 = __builtin_amdgcn_cvt_pk_f32_fp8((int)kv[u].w, true);
        S.o[0] += p * v0[0]; S.o[1] += p * v0[1]; S.o[2] += p * v1[0]; S.o[3] += p * v1[1]; S.o[4] += p * v2[0]; S.o[5] += p * v2[1]; S.o[6] += p * v3[0]; S.o[7] += p * v3[1]; }
    S.l = ls; S.m = mx;
}

DEVI void attn_query(int t, const bf16_t* __restrict__ Qb, const unsigned char* __restrict__ KV8,
                     const unsigned* SR  , bf16_t* __restrict__ AO, unsigned char* wl, int lane) {
    unsigned short* lst = (unsigned short*)wl;
    LDS_FENCE();
    const int nw = (t >> 5) + 1; int base = 0;
    for (int w0 = 0; w0 < nw; w0 += 64) {
        const int wi = w0 + lane; const unsigned wv = wi < nw ? SR[wi] : 0u;
        const int pc = __popc(wv); int pre = pc;
#pragma unroll
        for (int off = 1; off < 64; off <<= 1) { const int o_ = __shfl_up(pre, off); if (lane >= off) pre += o_; }
        int pos = base + pre - pc; unsigned mm = wv;
        while (mm) { const int bpos = __ffs((int)mm) - 1; mm &= mm - 1u; if (pos < TOPK) lst[pos] = (unsigned short)(wi * 32 + bpos); ++pos; }
        base += __shfl(pre, 63);
    }
    const int n = base < TOPK ? base : TOPK;
    float q[8];
    { const uint4 qv = ((const uint4*)(Qb + (size_t)t * 512))[lane]; const float qs = 0.18033688011112042f;
      q[0] = bflo(qv.x) * qs; q[1] = bfhi(qv.x) * qs; q[2] = bflo(qv.y) * qs; q[3] = bfhi(qv.y) * qs; q[4] = bflo(qv.z) * qs; q[5] = bfhi(qv.z) * qs; q[6] = bflo(qv.w) * qs; q[7] = bfhi(qv.w) * qs; }
    LDS_FENCE();
    AttnQ S; S.m = -INFINITY; S.l = 0.f;
#pragma unroll
    for (int d = 0; d < 8; ++d) S.o[d] = 0.f;
    uint4 ka[8], kb_[8], kc[8];
    attn_issue(0, n, lst, KV8, lane, ka);
    if (8 < n) attn_issue(8, n, lst, KV8, lane, kb_);
    for (int b0 = 0; b0 < n; b0 += 24) {
        if (b0 + 16 < n) attn_issue(b0 + 16, n, lst, KV8, lane, kc);
        attn_compute(S, b0, n, q, ka);
        if (b0 + 8 < n) {
            if (b0 + 24 < n) attn_issue(b0 + 24, n, lst, KV8, lane, ka);
            attn_compute(S, b0 + 8, n, q, kb_);
            if (b0 + 16 < n) {
                if (b0 + 32 < n) attn_issue(b0 + 32, n, lst, KV8, lane, kb_);
                attn_compute(S, b0 + 16, n, q, kc);
            }
        }
    }
    const int hd = lane >> 3, ch = lane & 7;
    const float inv = 1.0f / S.l;
    uint4 pk; pk.x = cvt_pk_bf16(S.o[0] * inv, S.o[1] * inv); pk.y = cvt_pk_bf16(S.o[2] * inv, S.o[3] * inv); pk.z = cvt_pk_bf16(S.o[4] * inv, S.o[5] * inv); pk.w = cvt_pk_bf16(S.o[6] * inv, S.o[7] * inv);
    *(uint4*)(AO + (size_t)t * 1024 + 512 + hd * 64 + ch * 8) = pk;
}

DEVI float relu_i(float x) { const int v = __float_as_int(x); return __int_as_float(v > 0 ? v : 0); }
DEVI int hpos(unsigned w) { return (int)(w + (w >> 5)); }
template <int PASS, bool L0>
DEVI void idx_sweep(int q0, int nkb, int wave, int lane, const bf16x8_t (&Af)[4][4], const bf16_t* __restrict__ KI, unsigned char* lds, unsigned* __restrict__ SELM) {
    const int l31 = lane & 31, h2 = lane >> 5;
    unsigned* hist = (unsigned*)(lds + IL_HIST);
    const float* wiL = (const float*)(lds + IL_WI);
    const uint4* qst = (const uint4*)(lds + IL_QST);
    const uint4* qst2 = (const uint4*)(lds + IL_QST2);
    unsigned* ckey = (unsigned*)(lds + IL_CKEY); unsigned* cidx = (unsigned*)(lds + IL_CIDX); unsigned* ccnt = (unsigned*)(lds + IL_CCNT); unsigned* rows = (unsigned*)(lds + IL_ROWS);
    const bf16_t* kp = KI + (size_t)l31 * 64 + 8 * h2;
    bf16x8_t Bn[4];
    if (wave < nkb) {
#pragma unroll
        for (int ks = 0; ks < 4; ++ks) Bn[ks] = *(const bf16x8_t*)(kp + (size_t)wave * 2048 + 16 * ks); }
    for (int kb = wave; kb < nkb; kb += 8) {
        const int s = kb * 32 + l31;
        bf16x8_t Bf[4];
#pragma unroll
        for (int ks = 0; ks < 4; ++ks) Bf[ks] = Bn[ks];
        if (kb + 8 < nkb) {
#pragma unroll
            for (int ks = 0; ks < 4; ++ks) Bn[ks] = *(const bf16x8_t*)(kp + (size_t)(kb + 8) * 2048 + 16 * ks); }
        f32x16 acc[4];
#pragma unroll
        for (int rb = 0; rb < 4; ++rb) {
#pragma unroll
            for (int i = 0; i < 16; ++i) acc[rb][i] = 0.f; }
#pragma unroll
        for (int ks = 0; ks < 4; ++ks) acc[0] = __builtin_amdgcn_mfma_f32_32x32x16_bf16(Af[0][ks], Bf[ks], acc[0], 0, 0, 0);
        const bool edge = kb * 32 + 31 > q0;
        float4 wn[2][2]; uint4 stn[2];
#pragma unroll
        for (int e = 0; e < 2; ++e) { wn[e][0] = *(const float4*)(wiL + (2 * h2 + e) * 8); wn[e][1] = *(const float4*)(wiL + (2 * h2 + e) * 8 + 4);
            if (PASS == 2) stn[e] = qst2[2 * h2 + e]; else if (!L0) stn[e] = qst[2 * h2 + e]; }
#pragma unroll
        for (int rb = 0; rb < 4; ++rb) {
            if (rb + 1 < 4) {
#pragma unroll
                for (int ks = 0; ks < 4; ++ks) acc[rb + 1] = __builtin_amdgcn_mfma_f32_32x32x16_bf16(Af[rb + 1][ks], Bf[ks], acc[rb + 1], 0, 0, 0); }
            const int qa = 4 * rb + 2 * h2;
            float4 w[2][2]; uint4 st[2];
#pragma unroll
            for (int e = 0; e < 2; ++e) { w[e][0] = wn[e][0]; w[e][1] = wn[e][1]; st[e] = stn[e]; }
            if (rb + 1 < 4) {
#pragma unroll
                for (int e = 0; e < 2; ++e) { wn[e][0] = *(const float4*)(wiL + (qa + 4 + e) * 8); wn[e][1] = *(const float4*)(wiL + (qa + 4 + e) * 8 + 4);
                    if (PASS == 2) stn[e] = qst2[qa + 4 + e]; else if (!L0) stn[e] = qst[qa + 4 + e]; } }
#pragma unroll
            for (int e = 0; e < 2; ++e) {
                const int qs = qa + e;
                f32x2v s2 = (f32x2v){relu_i(acc[rb][8 * e + 0]), relu_i(acc[rb][8 * e + 1])} * (f32x2v){w[e][0].x, w[e][0].y};
                s2 = (f32x2v){relu_i(acc[rb][8 * e + 2]), relu_i(acc[rb][8 * e + 3])} * (f32x2v){w[e][0].z, w[e][0].w} + s2;
                s2 = (f32x2v){relu_i(acc[rb][8 * e + 4]), relu_i(acc[rb][8 * e + 5])} * (f32x2v){w[e][1].x, w[e][1].y} + s2;
                s2 = (f32x2v){relu_i(acc[rb][8 * e + 6]), relu_i(acc[rb][8 * e + 7])} * (f32x2v){w[e][1].z, w[e][1].w} + s2;
                const float sc = s2[0] + s2[1];
                const bool valid = !edge || s <= q0 + qs;
                const unsigned key = f2key(sc);
                if (PASS == 1) {
                    if (L0) { if (valid) { const unsigned bin = key >> 20; atomicAdd(&hist[qs * HROW + hpos(bin >> 1)], (bin & 1u) ? 0x10000u : 1u); } }
                    else if (valid && (key & st[e].x) == st[e].y) { const unsigned bin = (key >> st[e].z) & st[e].w; atomicAdd(&hist[qs * HROW + hpos(bin >> 1)], (bin & 1u) ? 0x10000u : 1u); }
                } else {
                    const bool all = st[e].z == 0xFFFFFFFFu;
                    const bool sel = valid && (all || key >= st[e].y);
                    const bool cnd = valid && !all && key >= st[e].x && key < st[e].y;
                    const unsigned long long bal = __ballot(sel);
                    rows[qs * SW + kb] = h2 ? (unsigned)(bal >> 32) : (unsigned)bal;
                    if (cnd) { const unsigned n = atomicAdd(&ccnt[qs], 1u); if (n < (unsigned)CB) { ckey[qs * CB + n] = key; cidx[qs * CB + n] = (unsigned)s; } }
                }
            }
        }
    }
}

DEVI void indexer_tile(int q0, const bf16_t* __restrict__ QI, const bf16_t* __restrict__ KI, const float* __restrict__ WI, const bf16_t* __restrict__ Qb, const unsigned char* __restrict__ KV8, bf16_t* __restrict__ AO, unsigned char* lds) {
    const int tid = otid(), lane = tid & 63, wave = tid >> 6;
    unsigned* hist = (unsigned*)(lds + IL_HIST);
    float* wiL = (float*)(lds + IL_WI);
    uint4* qst = (uint4*)(lds + IL_QST); uint4* qst2 = (uint4*)(lds + IL_QST2);
    unsigned* ckey = (unsigned*)(lds + IL_CKEY); unsigned* cidx = (unsigned*)(lds + IL_CIDX); unsigned* hist2 = (unsigned*)(lds + IL_HIST2); unsigned* ccnt = (unsigned*)(lds + IL_CCNT);
    volatile unsigned* flag = (volatile unsigned*)(lds + IL_FLAG);
    const int nkb = (q0 + 16 + 31) >> 5;
    bf16x8_t Af[4][4];
    { const int rho = lane & 31, hq = lane >> 5; const int qq = 2 * ((rho >> 2) & 1) + (rho >> 4), head = 4 * ((rho >> 3) & 1) + (rho & 3);
#pragma unroll
      for (int rb = 0; rb < 4; ++rb)
#pragma unroll
          for (int ks = 0; ks < 4; ++ks) Af[rb][ks] = *(const bf16x8_t*)(QI + (size_t)(q0 + 4 * rb + qq) * 512 + head * 64 + 16 * ks + 8 * hq); }
    __syncthreads();
    if (tid < 128) wiL[tid] = WI[(size_t)q0 * 8 + tid] * 0.125f;
    if (tid < 16) { const unsigned z = opq(0u); qst[tid] = make_uint4(z, z, opq(20u), opq(4095u)); qst2[tid] = make_uint4(z, z, opq((unsigned)TOPK), z); ccnt[tid] = z; }
    for (int level = 0; level < 3; ++level) {
        for (int i = tid; i < 16 * HROW / 4; i += NTHREADS) ((uint4*)hist)[i] = make_uint4(0u, 0u, 0u, 0u);
        if (tid == 0) flag[0] = 0u;
        __syncthreads();
        if (level == 0) idx_sweep<1, true>(q0, nkb, wave, lane, Af, KI, lds, nullptr); else idx_sweep<1, false>(q0, nkb, wave, lane, Af, KI, lds, nullptr);
        __syncthreads();
#pragma unroll 1
        for (int qi = 0; qi < 2; ++qi) {
            const int qs = 2 * wave + qi;
            const uint4 st = qst[qs]; const uint4 b = qst2[qs];
            if (st.x == 0xFFFFFFFFu && st.y == 0u && st.w == 0u) continue;
            unsigned wv[32]; unsigned loc = 0u;
#pragma unroll
            for (int i = 0; i < 32; ++i) { wv[i] = hist[qs * HROW + 33 * lane + i]; loc += (wv[i] & 0xFFFFu) + (wv[i] >> 16); }
            unsigned suf = loc;
#pragma unroll
            for (int off = 1; off < 64; off <<= 1) { const unsigned o = __shfl_down(suf, off); if (lane + off < 64) suf += o; }
            const unsigned total = __shfl(suf, 0), above = suf - loc, need = b.z;
            if (level == 0 && total <= need) { if (lane == 0) { qst[qs] = make_uint4(0xFFFFFFFFu, 0u, 0u, 0u); qst2[qs] = make_uint4(0u, 0u, 0xFFFFFFFFu, 0u); } continue; }
            const bool mine = above < need && need <= above + loc;
            unsigned cum = above, c = 0u; int d = 0; bool found = false;
#pragma unroll
            for (int i = 31; i >= 0; --i) {
                const unsigned chi = wv[i] >> 16, clo = wv[i] & 0xFFFFu;
                if (!found && cum + chi >= need) { found = true; d = 64 * lane + 2 * i + 1; c = chi; } if (!found) cum += chi;
                if (!found && cum + clo >= need) { found = true; d = 64 * lane + 2 * i; c = clo; } if (!found) cum += clo; }
            if (mine) {
                const unsigned pval = st.y | ((unsigned)d << st.z), pmask = st.x | (st.w << st.z);
                const unsigned nneed = need - cum;
                const unsigned long long hi64 = (unsigned long long)pval + (1ull << st.z);
                const unsigned hi = hi64 > 0xFFFFFFFFull ? 0xFFFFFFFFu : (unsigned)hi64;
                if (c <= (unsigned)CB || level == 2) { qst[qs] = make_uint4(0xFFFFFFFFu, 0u, 0u, 0u); qst2[qs] = make_uint4(pval, hi, nneed, st.z); }
                else { const unsigned nsh = (level == 0) ? 8u : 0u, ndm = (level == 0) ? 4095u : 255u; qst[qs] = make_uint4(pmask, pval, nsh, ndm); qst2[qs] = make_uint4(pval, hi, nneed, st.z); flag[0] = 1u; }
            }
        }
        __syncthreads();
        if (flag[0] == 0u) break;
        __syncthreads();
    }
    __syncthreads();
    idx_sweep<2, false>(q0, nkb, wave, lane, Af, KI, lds, nullptr);
    asm volatile("s_waitcnt vmcnt(0)" ::: "memory");
    __syncthreads();
    unsigned* rows = (unsigned*)(lds + IL_ROWS);
#pragma unroll 1
    for (int qi = 0; qi < 2; ++qi) {
        const int qs = 2 * wave + qi;
        const uint4 b = qst2[qs];
        unsigned* row = rows + qs * SW;
        if (b.z != 0xFFFFFFFFu) {
            const unsigned need = b.z; const unsigned cn = ccnt[qs]; const int n = (int)(cn < (unsigned)CB ? cn : (unsigned)CB);
            const unsigned rem = b.w;
            const unsigned sh8 = rem > 8u ? rem - 8u : 0u; const unsigned m8 = rem >= 8u ? 255u : ((1u << rem) - 1u);
#pragma unroll
            for (int i = 0; i < 4; ++i) hist2[qs * 256 + 4 * lane + i] = 0u;
            asm volatile("s_waitcnt lgkmcnt(0)" ::: "memory");
            for (int i = lane; i < n; i += 64) atomicAdd(&hist2[qs * 256 + ((ckey[qs * CB + i] >> sh8) & m8)], 1u);
            asm volatile("s_waitcnt lgkmcnt(0)" ::: "memory");
            unsigned c4[4]; unsigned loc = 0u;
#pragma unroll
            for (int i = 0; i < 4; ++i) { c4[i] = hist2[qs * 256 + 4 * lane + i]; loc += c4[i]; }
            unsigned suf = loc;
#pragma unroll
            for (int off = 1; off < 64; off <<= 1) { const unsigned o = __shfl_down(suf, off); if (lane + off < 64) suf += o; }
            const unsigned above = suf - loc;
            const bool mine = above < need && need <= above + loc;
            unsigned b2 = 0u, need2 = 0u;
            if (mine) { unsigned cum = above; int i = 3; for (; i > 0; --i) { if (cum + c4[i] >= need) break; cum += c4[i]; } b2 = 4u * lane + i; need2 = need - cum; }
            const unsigned long long mb = __ballot(mine);
            if (mb == 0ull) {
                for (int i = lane; i < n; i += 64) if ((unsigned)i < need) { const unsigned ii = cidx[qs * CB + i]; atomicOr(&row[ii >> 5], 1u << (ii & 31u)); }
            } else {
                const int src = __ffsll((long long)mb) - 1;
                b2 = __shfl(b2, src); need2 = __shfl(need2, src);
                for (int i0 = 0; i0 < n; i0 += 64) {
                    const int i = i0 + lane; const bool act = i < n;
                    const unsigned ki = act ? ckey[qs * CB + i] : 0u, ii = act ? cidx[qs * CB + i] : 0u; const unsigned d8 = (ki >> sh8) & m8;
                    if (act && d8 > b2) atomicOr(&row[ii >> 5], 1u << (ii & 31u));
                    unsigned long long tie = __ballot(act && d8 == b2);
                    while (tie) {
                        const int ml = __ffsll((long long)tie) - 1; tie &= tie - 1ull;
                        const unsigned km = __shfl(ki, ml), im = __shfl(ii, ml);
                        unsigned rank = 0u;
                        for (int j0 = 0; j0 < n; j0 += 64) { const int j = j0 + lane; bool beats = false;
                            if (j < n) { const unsigned kj = ckey[qs * CB + j], ij = cidx[qs * CB + j]; beats = ((kj >> sh8) & m8) == b2 && (kj > km || (kj == km && ij < im)); }
                            rank += (unsigned)__popcll(__ballot(beats)); }
                        if (rank < need2 && lane == ml) atomicOr(&row[im >> 5], 1u << (im & 31u));
                    }
                }
            }
        }
    }
    asm volatile("s_waitcnt lgkmcnt(0)" ::: "memory");
    __syncthreads();
    for (int qi = 0; qi < 2; ++qi) { const int qs = 2 * wave + qi;
        attn_query(q0 + qs, Qb, KV8, rows + qs * SW, AO, lds + IL_QF + wave * 512, lane); }
}

DEVI TrJob moe_job(int j, const float* wg, const float* wu, const float* wd, bf16_t* WGU, bf16_t* WD) {
    TrJob J{};
    if (j < 32 * 256) { const int e = j >> 8, t = j & 255; J.dst = WGU + (size_t)e * 1024 * 1024; J.s0 = wg + (size_t)e * D * DE; J.s1 = wu + (size_t)e * D * DE; J.K = 1024; J.n0 = (t >> 4) * 64; J.k0 = (t & 15) * 64; J.mode = 2; return J; }
    j -= 32 * 256;
    { const int e = j >> 7, t = j & 127; J.dst = WD + (size_t)e * 1024 * 512; J.s0 = wd + (size_t)e * DE * D; J.ld = D; J.K = 512; J.n0 = (t >> 3) * 64; J.k0 = (t & 7) * 64; J.mode = 0; return J; }
}
constexpr int MOE0_ALL = 32 * 256 + 32 * 128, MOE0_P1W = 28, MOE0_P4W = 10;
constexpr int P1_BUSY = (LP / 256) * 13 - 3 * 256, P4_BUSY = 8;
constexpr int MOE0_P7 = 2688;
constexpr int MOE0_P1 = (256 - P1_BUSY) * MOE0_P1W, MOE0_P4 = (256 - P4_BUSY) * MOE0_P4W, MOE0_P0 = MOE0_ALL - MOE0_P1 - MOE0_P4 - MOE0_P7;
static_assert(MOE0_P0 > 0 && P1_BUSY == 77 && MOE0_P0 + MOE0_P1 + MOE0_P4 >= 32 * 256, "tail split (the P7 tail may only write WD)");
constexpr int P10_BUSY = (LP / 256) * 10 - 2 * 256;
constexpr int MOE1_P8 = 1536, MOE1_P10 = (256 - P10_BUSY) * 25, MOE1_P15 = MOE0_ALL - MOE1_P8 - MOE1_P10;
static_assert(P10_BUSY == 138 && MOE1_P8 <= 32 * 256 && MOE1_P15 > 0, "tail split, layer 1");
DEVI void moe_idle(const int* mtiles, int& rank, int& cnt) { const int G = (int)gridDim.x, nun = mtiles[0] * 4, busy = nun % G;
    if (busy == 0) { rank = (int)blockIdx.x; cnt = G; } else { rank = (int)blockIdx.x - busy; cnt = G - busy; } }

__global__ void __launch_bounds__(NTHREADS, 2) fwd(Args a) {
    extern __shared__ __attribute__((aligned(16))) unsigned char lds_raw[];
    float* smf = (float*)lds_raw;
    PG8_LAS unsigned char* ldsp = (PG8_LAS unsigned char*)lds_raw;
    const int nwaves = gridDim.x * 8;
#define PHASE_VARS const int tid = otid(); const int lane = tid & 63, wave = tid >> 6; const int gwave = blockIdx.x * 8 + wave; (void)lane; (void)wave; (void)gwave;
    unsigned char* ws = a.ws;
    unsigned* ctl = (unsigned*)(ws + WS_CTL);
    const int lo = a.ph_lo, hi = a.ph_hi;

    volatile LAS unsigned* bst = (volatile LAS unsigned*)((LAS unsigned char*)lds_raw + (LDS_BYTES - 16));
    if (threadIdx.x == 0) { bst[0] = 0u; bst[1] = 0u; bst[2] = 0u; bst[3] = 0u; }
    __syncthreads();
    XcdBarrier bar; bar.bar = ctl; bar.x = 0; bar.st = bst;
    if (hi - lo > 1) bar = xcd_barrier_post(ctl, bst);
#define IN(k) (lo <= (k) && (k) < hi)
#define SEAM(k) do { if (IN(k) && IN((k) + 1)) xcd_barrier(bar); } while (0)

    const float* x = a.in[0]; const float* meta = a.in[1];
    float* ropeC = (float*)(ws + WS_ROPEC); float* ropeS = (float*)(ws + WS_ROPES);
    int* eid = (int*)(ws + WS_EID); float* gw = (float*)(ws + WS_GW); int* slot = (int*)(ws + WS_SLOT); int* mtiles = (int*)(ws + WS_MTILES);
    unsigned* counts0 = (unsigned*)(ws + CTL_CNT); unsigned* counts1 = counts0 + 32;
    unsigned* cursor0 = (unsigned*)(ws + CTL_CUR); unsigned* cursor1 = cursor0 + 32;
    bf16_t* Wta = (bf16_t*)(ws + WS_WTA); bf16_t* Wtx = (bf16_t*)(ws + WS_WTX);
    float* Aend = (float*)(ws + WS_AEND); float* Hend = (float*)(ws + WS_HEND); float* CIN = (float*)(ws + WS_CIN);
    unsigned char* big = ws + WS_BIG;
    bf16_t* WIN0 = (bf16_t*)(big + R_WIN0); bf16_t* WOUT0 = (bf16_t*)(big + R_WOUT0); bf16_t* WGU = (bf16_t*)(big + R_WGU); bf16_t* WD = (bf16_t*)(big + R_WD);
    bf16_t* WIN1 = (bf16_t*)(big + R_WIN1); bf16_t* WOUT1 = (bf16_t*)(big + R_WOUT1);
    bf16_t* X0b = (bf16_t*)(big + R_A); bf16_t* AO = (bf16_t*)(big + R_A); bf16_t* Xperm = (bf16_t*)(big + R_A); bf16_t* X2b = (bf16_t*)(big + R_A); bf16_t* YY = (bf16_t*)(big + R_A);
    float* H1 = (float*)(big + R_H1); float* H3 = (float*)(big + R_H1); float* H2 = (float*)(big + R_H2); unsigned* SELM = (unsigned*)(big + R_H1); unsigned* SELM2 = (unsigned*)(big + R_H1 + 36 * MiB);
    float* Z = (float*)(big + R_C); bf16_t* Yb = (bf16_t*)(big + R_C); float* Z1 = (float*)(big + R_C);
    unsigned char* KV8 = big + R_K;
    bf16_t* GLU = (bf16_t*)(big + R_GLU); bf16_t* Qb = (bf16_t*)(big + R_Q); bf16_t* Kb = (bf16_t*)(big + R_K); bf16_t* Vb = (bf16_t*)(big + R_V);
    bf16_t* QIb = (bf16_t*)(big + R_QI); bf16_t* KIb = (bf16_t*)(big + R_KI); float* WIf = (float*)(big + R_WI);
    bf16_t* GATEg = (bf16_t*)(big + R_GATE); bf16_t* XRb = (bf16_t*)(big + R_XR);
    bf16_t* Hm = (bf16_t*)(big + R_HM);

    if (IN(0)) { PHASE_VARS;
        const float* w_in = a.in[2]; const float* w_out = a.in[7]; const float* wg = a.in[21]; const float* wu = a.in[22]; const float* wd = a.in[23];
        constexpr int J_IN0 = 52 * 16, J_OUT0 = 16 * 16, J_GU = 32 * 256, J_D = 32 * 128, J_IN1 = 40 * 16, J_OUT1 = 16 * 20, J_GT = 80;
        const float* w_in1 = a.in[8]; const float* w_out1 = a.in[16]; const float* wga = a.in[11]; const float* wgx = a.in[13];
        const int moe_p0 = gridDim.x == 256 ? MOE0_P0 : MOE0_ALL;
        tr_run(J_IN0 + J_OUT0 + moe_p0 + J_IN1 + J_OUT1 + J_GT, [&](int j) -> TrJob {
            TrJob J{};
            if (j < J_IN0) { J.dst = WIN0; J.s0 = w_in; J.K = 1024; J.n0 = (j >> 4) * 64; J.k0 = (j & 15) * 64; J.mode = 1; return J; }
            j -= J_IN0;
            if (j < J_OUT0) { J.dst = WOUT0; J.s0 = w_out; J.ld = D; J.K = 1024; J.n0 = (j >> 4) * 64; J.k0 = (j & 15) * 64; J.mode = 0; return J; }
            j -= J_OUT0;
            if (j < moe_p0) return moe_job(j, wg, wu, wd, WGU, WD);
            j -= moe_p0;
            if (j < J_IN1) { J.dst = WIN1; J.s0 = w_in1; J.ld = 2 * RNN_W; J.K = 1024; J.n0 = (j >> 4) * 64; J.k0 = (j & 15) * 64; J.mode = 0; return J; }
            j -= J_IN1;
            if (j < J_OUT1) { J.dst = WOUT1; J.s0 = w_out1; J.ld = D; J.K = RNN_W; J.n0 = (j / 20) * 64; J.k0 = (j % 20) * 64; J.mode = 0; return J; }
            j -= J_OUT1;
            { const int which = j / 40, r = j % 40; const int nb = r >> 2;
              J.dst = (which ? Wtx : Wta) + (size_t)nb * 128 * 128; J.s0 = (which ? wgx : wga) + (size_t)nb * 128 * 128; J.ld = 128; J.K = 128; J.n0 = ((r >> 1) & 1) * 64; J.k0 = (r & 1) * 64; J.mode = 0; return J; }
        }, smf);
        for (size_t i = (size_t)blockIdx.x * NTHREADS + tid; i < (size_t)LP * 256; i += (size_t)gridDim.x * NTHREADS) {
            const size_t r = i >> 8, c4 = i & 255;
            float4 v = make_float4(0.f, 0.f, 0.f, 0.f);
            if (r < NMETA) v = ((const float4*)meta)[r * 256 + c4]; else if (r < L) v = ((const float4*)x)[(r - NMETA) * 256 + c4];
            ((uint2*)X0b)[i] = make_uint2(cvt_pk_bf16(v.x, v.y), cvt_pk_bf16(v.z, v.w));
        }
        for (int i = blockIdx.x * NTHREADS + tid; i < 2 * 64 * 3 * 64; i += gridDim.x * NTHREADS) {
            const int ln = i & 63, ct = (i >> 6) % 3, ss = (i / 192) & 63, ly = i / (192 * 64);
            const int col = 16 * ct + (ln & 15), k0 = 16 * ss + 4 * (ln >> 4);
            float v[4];
#pragma unroll
            for (int j = 0; j < 4; ++j) v[j] = col < 4 ? a.in[17][(size_t)ly * D * NGRP + (size_t)(k0 + j) * NGRP + col] : col < 36 ? a.in[19][(size_t)ly * D * NE + (size_t)(k0 + j) * NE + (col - 4)] : 0.f;
            ((float4*)(ws + WS_WR))[i] = make_float4(v[0], v[1], v[2], v[3]);
        }
        for (int i = blockIdx.x * NTHREADS + tid; i < LP * 32; i += gridDim.x * NTHREADS) {
            const int p = i >> 5, f = i & 31;
            const float inv = (float)pow(10000.0, -(double)f / 32.0);
            const float ang = (float)p * inv;
            ropeC[i] = (float)cos((double)ang); ropeS[i] = (float)sin((double)ang);
        }
    }
    SEAM(0);
    if (IN(1)) { PHASE_VARS;
        pg8::Gemm g{X0b, WIN0, LP, 3328, 1024}; pg8::StaticOrder S; S.init(LP, 3328, (int)gridDim.x, (int)blockIdx.x);
        EpiIn0 E{GLU, KIb, WIf, ropeC, ropeS, KV8};
        pg8::gemm_phase<EpiIn0, pg8::StaticOrder, GEMM_ALIGN, GEMM_SP2>(ldsp, g, S, E);
        if (gridDim.x == 256 && (int)blockIdx.x >= P1_BUSY) { __syncthreads();
            tr_run(MOE0_P1, [&](int j) -> TrJob { return moe_job(MOE0_P0 + j, a.in[21], a.in[22], a.in[23], WGU, WD); }, smf, (int)blockIdx.x - P1_BUSY, 256 - P1_BUSY); }
    }
    SEAM(1);
    if (IN(2)) { PHASE_VARS;
        const float* cw = a.in[3]; const float* cb = a.in[4]; const float* lg = a.in[5]; const float* lb = a.in[6];
        for (int g4 = gwave; g4 < L / 4; g4 += nwaves) {
            const int t0 = g4 * 4, c0 = lane * 8;
            float acc[4][8], wwin[4][8];
            { const float4 b0 = *(const float4*)(cb + c0), b1 = *(const float4*)(cb + c0 + 4);
#pragma unroll
              for (int q = 0; q < 4; ++q) { acc[q][0] = b0.x; acc[q][1] = b0.y; acc[q][2] = b0.z; acc[q][3] = b0.w; acc[q][4] = b1.x; acc[q][5] = b1.y; acc[q][6] = b1.z; acc[q][7] = b1.w; } }
#pragma unroll
            for (int r = 0; r < CONV_K + 3; ++r) {
                const int tt = t0 - (CONV_K - 1) + r;
                if (r < CONV_K) { const float4 w0 = *(const float4*)(cw + r * CONV_CH + c0), w1 = *(const float4*)(cw + r * CONV_CH + c0 + 4);
                    wwin[r & 3][0] = w0.x; wwin[r & 3][1] = w0.y; wwin[r & 3][2] = w0.z; wwin[r & 3][3] = w0.w; wwin[r & 3][4] = w1.x; wwin[r & 3][5] = w1.y; wwin[r & 3][6] = w1.z; wwin[r & 3][7] = w1.w; }
                if (tt >= 0) {
                    const uint4 xv = *(const uint4*)(GLU + (size_t)tt * 512 + c0);
                    const float x[8] = {bflo(xv.x), bfhi(xv.x), bflo(xv.y), bfhi(xv.y), bflo(xv.z), bfhi(xv.z), bflo(xv.w), bfhi(xv.w)};
#pragma unroll
                    for (int q = 0; q < 4; ++q) { const int j = r - q;
                        if (j >= 0 && j < CONV_K) {
#pragma unroll
                            for (int i = 0; i < 8; ++i) acc[q][i] += wwin[j & 3][i] * x[i]; } }
                }
            }
            float gv[8], bvv[8];
            { const float4 g0 = *(const float4*)(lg + c0), g1 = *(const float4*)(lg + c0 + 4), b0 = *(const float4*)(lb + c0), b1 = *(const float4*)(lb + c0 + 4);
              gv[0] = g0.x; gv[1] = g0.y; gv[2] = g0.z; gv[3] = g0.w; gv[4] = g1.x; gv[5] = g1.y; gv[6] = g1.z; gv[7] = g1.w; bvv[0] = b0.x; bvv[1] = b0.y; bvv[2] = b0.z; bvv[3] = b0.w; bvv[4] = b1.x; bvv[5] = b1.y; bvv[6] = b1.z; bvv[7] = b1.w; }
#pragma unroll
            for (int q = 0; q < 4; ++q) {
                float s_ = 0.f;
#pragma unroll
                for (int i = 0; i < 8; ++i) s_ += acc[q][i];
                const float mu = wave_sum(s_) * (1.0f / 512.0f);
                float qq = 0.f;
#pragma unroll
                for (int i = 0; i < 8; ++i) { const float d = acc[q][i] - mu; qq += d * d; }
                const float rstd = 1.0f / sqrtf(wave_sum(qq) * (1.0f / 512.0f) + LN_EPS);
                float o[8];
#pragma unroll
                for (int i = 0; i < 8; ++i) { const float yv = (acc[q][i] - mu) * rstd * gv[i] + bvv[i]; o[i] = yv * fsigm(yv); }
                uint4 w; w.x = cvt_pk_bf16(o[0], o[1]); w.y = cvt_pk_bf16(o[2], o[3]); w.z = cvt_pk_bf16(o[4], o[5]); w.w = cvt_pk_bf16(o[6], o[7]);
                *(uint4*)(AO + (size_t)(t0 + q) * 1024 + c0) = w;
            }
        }
        { const int b = (int)blockIdx.x, G = (int)gridDim.x; const int p = b & 3; const bool rev = (b >> 2) & 1;
          const int nfull = NTILE / G;
          for (int k = 0; k < nfull; ++k) {
              const int r = (nfull == 4) ? ((rev ? p - k : p + k) & 3) : k;
              const int idx = r * G + ((r & 1) ? G - 1 - b : b);
              indexer_tile((NTILE - 1 - idx) * 16, QIb, KIb, WIf, Qb, KV8, AO, lds_raw);
          }
          for (int idx = nfull * G + b; idx < NTILE; idx += G) indexer_tile((NTILE - 1 - idx) * 16, QIb, KIb, WIf, Qb, KV8, AO, lds_raw);
        }
    }
    SEAM(2);
    SEAM(3);
    if (IN(4)) { PHASE_VARS;
        pg8::Gemm g{AO, WOUT0, SEQ, 1024, 1024}; pg8::StaticOrder S; S.init(SEQ, 1024, (int)gridDim.x, (int)blockIdx.x);
        EpiRes0 E{x, meta, Z};
        pg8::gemm_phase<EpiRes0, pg8::StaticOrder, GEMM_ALIGN, GEMM_SP2>(ldsp, g, S, E);
        const int G = (int)gridDim.x, nsk = G >= 16 ? 8 : G;
        if ((int)blockIdx.x >= G - nsk) {
            for (int tl = ((int)blockIdx.x - (G - nsk)) * 8 + wave; tl < 64; tl += nsk * 8) {
                const int col = lane & 15, quad = lane >> 4, n0 = 16 * tl;
                const bf16_t* ap = AO + (size_t)(SEQ + col) * 1024 + 8 * quad; const bf16_t* bp = WOUT0 + (size_t)(n0 + col) * 1024 + 8 * quad;
                f32x4 c0 = {0.f, 0.f, 0.f, 0.f}, c1 = {0.f, 0.f, 0.f, 0.f};
#pragma unroll 8
                for (int ks = 0; ks < 32; ks += 2) {
                    c0 = __builtin_amdgcn_mfma_f32_16x16x32_bf16(*(const bf16x8_t*)(ap + 32 * ks), *(const bf16x8_t*)(bp + 32 * ks), c0, 0, 0, 0);
                    c1 = __builtin_amdgcn_mfma_f32_16x16x32_bf16(*(const bf16x8_t*)(ap + 32 * ks + 32), *(const bf16x8_t*)(bp + 32 * ks + 32), c1, 0, 0, 0); }
#pragma unroll
                for (int j = 0; j < 4; ++j) { const size_t row = (size_t)SEQ + 4 * quad + j;
                    Z[row * D + n0 + col] = DN_ALPHA * x[(row - NMETA) * D + n0 + col] + (c0[j] + c1[j]); }
            }
        } else if (G == 256) { __syncthreads();
            tr_run(MOE0_P4, [&](int j) -> TrJob { return moe_job(MOE0_P0 + MOE0_P1 + j, a.in[21], a.in[22], a.in[23], WGU, WD); }, smf, (int)blockIdx.x, 256 - 8); }
    }
    SEAM(4);
    if (IN(5)) {
        for (int blk = blockIdx.x; blk < SEQ / 64; blk += gridDim.x)
            ln_route_block(NMETA + 64 * blk, 64, Z, H1, a.in[24], a.in[25], (const float4*)(ws + WS_WR), a.in[18], a.in[20], eid, gw, counts0, smf);
        if (blockIdx.x == gridDim.x - 1)
            ln_route_block(0, NMETA, Z, H1, a.in[24], a.in[25], (const float4*)(ws + WS_WR), a.in[18], a.in[20], eid, gw, counts0, smf);
    }
    SEAM(5);
    if (IN(6)) { PHASE_VARS; moe_dispatch_mfma(H1, eid, counts0, cursor0, slot, mtiles, Xperm, (int*)lds_raw, gwave, nwaves, lane, 0); }
    SEAM(6);
    if (IN(7)) { PHASE_VARS;
        pg8::Gemm g{Xperm, WGU, MAXSLOT, 1024, 1024}; MoeOrder S; S.init(mtiles, (int)gridDim.x, (int)blockIdx.x);
        EpiGateUp E{Hm};
        pg8::gemm_phase<EpiGateUp, MoeOrder, GEMM_ALIGN, GEMM_SP2>(ldsp, g, S, E);
        if (gridDim.x == 256) { int rk, cn; moe_idle(mtiles, rk, cn); if (rk >= 0) { __syncthreads();
            tr_run(MOE0_P7, [&](int j) -> TrJob { return moe_job(MOE0_ALL - MOE0_P7 + j, a.in[21], a.in[22], a.in[23], WGU, WD); }, smf, rk, cn); } }
    }
    SEAM(7);
    if (IN(8)) { PHASE_VARS;
        pg8::Gemm g{Hm, WD, MAXSLOT, 1024, 512}; MoeOrder S; S.init(mtiles, (int)gridDim.x, (int)blockIdx.x);
        EpiDown E{Yb};
        pg8::gemm_phase<EpiDown, MoeOrder, GEMM_ALIGN, GEMM_SP2>(ldsp, g, S, E);
        if (gridDim.x == 256) { int rk, cn; moe_idle(mtiles, rk, cn); if (rk >= 0) { __syncthreads();
            tr_run(MOE1_P8, [&](int j) -> TrJob { return moe_job(j, a.in[21] + (size_t)NE * D * DE, a.in[22] + (size_t)NE * D * DE, a.in[23] + (size_t)NE * DE * D, WGU, WD); }, smf, rk, cn); } }
    }
    SEAM(8);
    if (IN(9)) { PHASE_VARS;
#pragma unroll 2
        for (int t = gwave; t < L; t += nwaves) {
            const int s0 = slot[2 * t], s1 = slot[2 * t + 1]; const float g0 = gw[2 * t], g1 = gw[2 * t + 1];
            float y[16];
            combine_row(y, H1 + (size_t)t * D, Yb + (size_t)s0 * D, Yb + (size_t)s1 * D, g0, g1, lane);
            ln_row1024w(y, a.in[26], a.in[27], lane);
#pragma unroll
            for (int i4 = 0; i4 < 4; ++i4) { *(float4*)(H2 + (size_t)t * D + 256 * i4 + 4 * lane) = make_float4(y[4 * i4], y[4 * i4 + 1], y[4 * i4 + 2], y[4 * i4 + 3]);
                *(uint2*)(X2b + (size_t)t * D + 256 * i4 + 4 * lane) = make_uint2(cvt_pk_bf16(y[4 * i4], y[4 * i4 + 1]), cvt_pk_bf16(y[4 * i4 + 2], y[4 * i4 + 3])); }
        }
        for (int i = blockIdx.x * NTHREADS + tid; i < (LP - L) * D / 8; i += gridDim.x * NTHREADS) ((uint4*)(X2b + (size_t)L * D))[i] = make_uint4(0u, 0u, 0u, 0u);
    }
    SEAM(9);
    if (IN(10)) {
        pg8::Gemm g{X2b, WIN1, LP, 2 * RNN_W, 1024}; pg8::StaticOrder S; S.init(LP, 2 * RNN_W, (int)gridDim.x, (int)blockIdx.x);
        EpiIn1 E{GATEg};
        pg8::gemm_phase<EpiIn1, pg8::StaticOrder, GEMM_ALIGN, GEMM_SP2>(ldsp, g, S, E);
        if (gridDim.x == 256 && (int)blockIdx.x >= P10_BUSY) { __syncthreads();
            tr_run(MOE1_P10, [&](int j) -> TrJob { return moe_job(MOE1_P8 + j, a.in[21] + (size_t)NE * D * DE, a.in[22] + (size_t)NE * D * DE, a.in[23] + (size_t)NE * DE * D, WGU, WD); }, smf, (int)blockIdx.x - P10_BUSY, 256 - P10_BUSY); }
    }
    SEAM(10);
    if (IN(11)) rglru_phase<false>(XRb, GATEg, Wta, Wtx, a.in[9], a.in[10], a.in[12], a.in[14], a.in[15], Aend, Hend, CIN, YY, lds_raw);
    SEAM(11);
    if (IN(12)) { PHASE_VARS;
        for (int ch = gwave; ch < RNN_W; ch += nwaves) {
            float A[5], H[5];
#pragma unroll
            for (int i = 0; i < 5; ++i) { const int c = 5 * lane + i; const bool ok = c < NCHUNK; A[i] = ok ? Aend[(size_t)ch * CP + c] : 1.f; H[i] = ok ? Hend[(size_t)ch * CP + c] : 0.f; }
            float Al = 1.f, Hl = 0.f;
#pragma unroll
            for (int i = 0; i < 5; ++i) { Hl = A[i] * Hl + H[i]; Al *= A[i]; }
#pragma unroll
            for (int off = 1; off < 64; off <<= 1) { const float Ap = __shfl_up(Al, off), Hp = __shfl_up(Hl, off); if (lane >= off) { Hl = Al * Hp + Hl; Al = Al * Ap; } }
            float cin = __shfl_up(Hl, 1); if (lane == 0) cin = 0.f;
#pragma unroll
            for (int i = 0; i < 5; ++i) { const int c = 5 * lane + i; if (c < NCHUNK) { CIN[(size_t)ch * CP + c] = cin; cin = A[i] * cin + H[i]; } }
        }
    }
    SEAM(12);
    if (IN(13)) rglru_phase<true>(XRb, GATEg, Wta, Wtx, a.in[9], a.in[10], a.in[12], a.in[14], a.in[15], Aend, Hend, CIN, YY, lds_raw);
    SEAM(13);
    if (IN(14)) {
        pg8::Gemm g{YY + (size_t)NMETA * RNN_W, WOUT1, SEQ, 1024, RNN_W}; pg8::StaticOrder S; S.init(SEQ, 1024, (int)gridDim.x, (int)blockIdx.x);
        EpiRes1 E{H2 + (size_t)NMETA * D, Z1 + (size_t)NMETA * D};
        pg8::gemm_phase<EpiRes1, pg8::StaticOrder, GEMM_ALIGN, GEMM_SP2>(ldsp, g, S, E);
    }
    SEAM(14);
    if (IN(15)) { PHASE_VARS;
        const float* wg = a.in[21] + (size_t)NE * D * DE; const float* wu = a.in[22] + (size_t)NE * D * DE; const float* wd = a.in[23] + (size_t)NE * DE * D;
        { const int done = gridDim.x == 256 ? MOE1_P8 + MOE1_P10 : 0;
          tr_run(MOE0_ALL - done, [&](int j) -> TrJob { return moe_job(done + j, wg, wu, wd, WGU, WD); }, smf); }
        __syncthreads();
        for (int tb = NMETA + blockIdx.x * 64; tb < L; tb += gridDim.x * 64)
            ln_route_block(tb, (L - tb) < 64 ? (L - tb) : 64, Z1, H3, a.in[24] + D, a.in[25] + D, (const float4*)(ws + WS_WR) + 64 * 3 * 64, a.in[18] + NGRP, a.in[20] + NE, eid, gw, counts1, smf);
    }
    SEAM(15);
    if (IN(16)) { PHASE_VARS; moe_dispatch_mfma(H3, eid, counts1, cursor1, slot, mtiles, Xperm, (int*)lds_raw, gwave, nwaves, lane, 2 * NMETA); }
    SEAM(16);
    if (IN(17)) {
        pg8::Gemm g{Xperm, WGU, MAXSLOT, 1024, 1024}; MoeOrder S; S.init(mtiles, (int)gridDim.x, (int)blockIdx.x);
        EpiGateUp E{Hm};
        pg8::gemm_phase<EpiGateUp, MoeOrder, GEMM_ALIGN, GEMM_SP2>(ldsp, g, S, E);
    }
    SEAM(17);
    if (IN(18)) {
        pg8::Gemm g{Hm, WD, MAXSLOT, 1024, 512}; MoeOrder S; S.init(mtiles, (int)gridDim.x, (int)blockIdx.x);
        EpiDown E{Yb};
        pg8::gemm_phase<EpiDown, MoeOrder, GEMM_ALIGN, GEMM_SP2>(ldsp, g, S, E);
    }
    SEAM(18);
    if (IN(19)) { PHASE_VARS;
#pragma unroll 2
        for (int t = NMETA + gwave; t < L; t += nwaves) {
            const int s0 = slot[2 * t], s1 = slot[2 * t + 1]; const float g0 = gw[2 * t], g1 = gw[2 * t + 1];
            float y[16];
            combine_row(y, H3 + (size_t)t * D, Yb + (size_t)s0 * D, Yb + (size_t)s1 * D, g0, g1, lane);
            ln_row1024w(y, a.in[26] + D, a.in[27] + D, lane);
#pragma unroll
            for (int i4 = 0; i4 < 4; ++i4) *(float4*)(a.out + (size_t)(t - NMETA) * D + 256 * i4 + 4 * lane) = make_float4(y[4 * i4], y[4 * i4 + 1], y[4 * i4 + 2], y[4 * i4 + 3]);
        }
    }
#undef IN
#undef SEAM
}
constexpr int N_PHASES = 20;

extern "C" void kernel_launch(void* const* d_in, const int* in_sizes, int n_in, void* d_out, int out_size, void* d_ws, size_t ws_size, hipStream_t stream) {
    static int grid = 0;
    if (grid == 0) {
        if (n_in != 28 || out_size != SEQ * D || ws_size < WS_END) { fprintf(stderr, "kernel_launch: unexpected shapes n_in %d out %d ws %zu (need %zu)\n", n_in, out_size, ws_size, (size_t)WS_END); grid = -1; return; }
        int dev = 0, cus = 0;
        if (hipGetDevice(&dev) != hipSuccess || hipDeviceGetAttribute(&cus, hipDeviceAttributeMultiprocessorCount, dev) != hipSuccess) { grid = -1; return; }
        if (hipFuncSetAttribute((const void*)fwd, hipFuncAttributeMaxDynamicSharedMemorySize, LDS_BYTES) != hipSuccess) { fprintf(stderr, "kernel_launch: hipFuncSetAttribute failed\n"); grid = -1; return; }
        int per_cu = 0;
        if (hipOccupancyMaxActiveBlocksPerMultiprocessor(&per_cu, (const void*)fwd, NTHREADS, LDS_BYTES) != hipSuccess || per_cu < 1) fprintf(stderr, "kernel_launch: occupancy query says %d\n", per_cu);
        (void)hipGetLastError();
        grid = cus;
    }
    if (grid < 0) return;
    (void)hipMemsetAsync((char*)d_ws + WS_CTL, 0, CTL_BYTES, stream);
    Args a{};
    for (int i = 0; i < 28; ++i) a.in[i] = (const float*)d_in[i];
    a.out = (float*)d_out; a.ws = (unsigned char*)d_ws;
#if N_LAUNCH_MODE == 1
    a.ph_lo = 0; a.ph_hi = N_PHASES;
    hipLaunchKernelGGL(fwd, dim3(grid), dim3(NTHREADS), LDS_BYTES, stream, a);
#else
    for (int p = 0; p < N_PHASES; ++p) { a.ph_lo = p; a.ph_hi = p + 1; hipLaunchKernelGGL(fwd, dim3(grid), dim3(NTHREADS), LDS_BYTES, stream, a); }
#endif
}
```

```cpp
#include <hip/hip_runtime.h>
#include <cstdio>
#include <cstdint>
#include <cmath>

#ifndef GEMM_ALIGN
#define GEMM_ALIGN true
#endif
#ifndef GEMM_SP2
#define GEMM_SP2 true
#endif
#ifndef N_LAUNCH_MODE
#define N_LAUNCH_MODE 1
#endif

#define DEVI __device__ __forceinline__
#define LAS __attribute__((address_space(3)))

constexpr int D = 1024, SEQ = 16384, NMETA = 16, L = SEQ + NMETA;
constexpr int CONV_CH = 512, CONV_K = 31, HD = 64, TOPK = 256;
constexpr int IN_AB = 3144;
constexpr int OFF_AVAL = 0, OFF_AGATE = 512, OFF_Q = 1024, OFF_K = 1536, OFF_V = 2048, OFF_QI = 2560, OFF_KI = 3072, OFF_WI = 3136;
constexpr int RNN_W = 1280, RNN_NB = 10, RNN_BW = 128, RNN_K = 4;
constexpr int NGRP = 4, EPG = 8, NE = 32, DE = 512;
constexpr int NPAIR = 2 * L;
constexpr float LN_EPS = 1e-5f;
constexpr float DN_ALPHA = 1.41421356237f;
constexpr int NTHREADS = 512;
constexpr int LDS_BYTES = 147456;

#define XB_TMO      128
#define XB_XCNT(j)  (256  + 64 * (j))
#define XB_XSUB(j)  (1280 + 64 * (j))
#define XB_XGEN(j)  (2304 + 64 * (j))
#define XB_TOP      3328
#define XB_TOPGEN   3392
#define XCD_BAR_WORDS 3456
#define XB_SPIN_CAP (1u << 22)
DEVI unsigned xb_ld(unsigned* p)              { return __hip_atomic_load(p, __ATOMIC_RELAXED, __HIP_MEMORY_SCOPE_AGENT); }
DEVI unsigned xb_add(unsigned* p, unsigned v) { return __hip_atomic_fetch_add(p, v, __ATOMIC_RELAXED, __HIP_MEMORY_SCOPE_AGENT); }
DEVI unsigned xb_xcc_id() { return (unsigned)__builtin_amdgcn_s_getreg((3 << 11) | 20) & 0xFu; }
#define XB_SPIN(cond, bar) do { unsigned _sp = 0; while (cond) { __builtin_amdgcn_s_sleep(1); \
    if ((++_sp & 255u) == 0u) { if (xb_ld(&(bar)[XB_TMO])) break; if (_sp > XB_SPIN_CAP) { atomicAdd(&(bar)[XB_TMO], 1u); break; } } } } while (0)
struct XcdBarrier { unsigned* bar; unsigned x; volatile LAS unsigned* st; };
DEVI XcdBarrier xcd_barrier_post(unsigned* bar, volatile LAS unsigned* st) {
    XcdBarrier b; b.bar = bar; b.x = xb_xcc_id(); b.st = st;
    if (threadIdx.x == 0) (void)xb_add(&bar[XB_XCNT(b.x)], 1u);
    return b;
}
DEVI void xcd_barrier_complete(unsigned* bar, unsigned x, unsigned& nloc, unsigned& nx) {
    const unsigned G = gridDim.x * gridDim.y * gridDim.z;
    unsigned sum, cnt, mine, sp = 0u;
    for (;;) {
        sum = 0u; cnt = 0u; mine = 0u;
#pragma unroll
        for (unsigned j = 0; j < 16; ++j) { const unsigned c = xb_ld(&bar[XB_XCNT(j)]); sum += c; cnt += (c > 0u) ? 1u : 0u; mine = (j == x) ? c : mine; }
        if (sum == G) break;
        __builtin_amdgcn_s_sleep(1);
        if ((++sp & 255u) == 0u) { if (xb_ld(&bar[XB_TMO])) break; if (sp > XB_SPIN_CAP) { atomicAdd(&bar[XB_TMO], 1u); break; } }
    }
    nloc = mine > 0u ? mine : 1u; nx = cnt > 0u ? cnt : 1u;
}
DEVI void xcd_barrier(const XcdBarrier& b) {
    asm volatile("s_waitcnt vmcnt(0)" ::: "memory");
    __syncthreads();
    if (threadIdx.x == 0) {
        unsigned* bar = b.bar;
        __builtin_amdgcn_s_waitcnt(0);
        unsigned nloc = b.st[0], nx = b.st[1];
        if (nloc == 0u) { xcd_barrier_complete(bar, b.x, nloc, nx); b.st[0] = nloc; b.st[1] = nx; }
        const unsigned old = xb_add(&bar[XB_XSUB(b.x)], 1u);
        const unsigned gen = old / nloc;
        if (old + 1u == (gen + 1u) * nloc) {
            __builtin_amdgcn_fence(__ATOMIC_RELEASE, "agent");
            asm volatile("s_waitcnt vmcnt(0)" ::: "memory");
            const unsigned og = xb_add(&bar[XB_TOP], 1u);
            const unsigned tg = og / nx;
            if (og + 1u == (tg + 1u) * nx) xb_add(&bar[XB_TOPGEN], 1u);
            else XB_SPIN(xb_ld(&bar[XB_TOPGEN]) == tg, bar);
            __builtin_amdgcn_fence(__ATOMIC_ACQUIRE, "agent");
            xb_add(&bar[XB_XGEN(b.x)], 1u);
            asm volatile("s_waitcnt vmcnt(0)" ::: "memory");
        } else {
            XB_SPIN(xb_ld(&bar[XB_XGEN(b.x)]) == gen, bar);
            __builtin_amdgcn_fence(__ATOMIC_ACQUIRE, "agent");
            asm volatile("s_waitcnt vmcnt(0)" ::: "memory");
        }
    }
    __syncthreads();
}

constexpr int LP = 16640;
constexpr int MAXSLOT = 40960;
constexpr int NCHUNK = 257, CP = 272;
constexpr size_t MiB = 1048576;
constexpr size_t WS_CTL = 0;
constexpr size_t CTL_CNT = 16384;
constexpr size_t CTL_CUR = 16384 + 256;
constexpr size_t CTL_BYTES = 32768;
constexpr size_t WS_ROPEC = 32768;
constexpr size_t WS_ROPES = WS_ROPEC + (size_t)LP * 32 * 4;
constexpr size_t WS_EID = WS_ROPES + (size_t)LP * 32 * 4;
constexpr size_t WS_GW = WS_EID + (size_t)NPAIR * 4;
constexpr size_t WS_SLOT = WS_GW + (size_t)NPAIR * 4;
constexpr size_t WS_MTILES = WS_SLOT + (size_t)NPAIR * 4;
constexpr size_t WS_WTA = WS_MTILES + 4096;
constexpr size_t WS_WTX = WS_WTA + (size_t)RNN_NB * 128 * 128 * 2;
constexpr size_t WS_AEND = WS_WTX + (size_t)RNN_NB * 128 * 128 * 2;
constexpr size_t WS_HEND = WS_AEND + (size_t)RNN_W * CP * 4;
constexpr size_t WS_CIN = WS_HEND + (size_t)RNN_W * CP * 4;
constexpr size_t WS_WR = WS_CIN + (size_t)RNN_W * CP * 4;
constexpr size_t WS_BIG = ((WS_WR + (size_t)2 * 64 * 3 * 64 * 16 + 255) / 256) * 256;
constexpr size_t R_WIN0 = 0;
constexpr size_t R_WOUT0 = R_WIN0 + (size_t)3328 * 1024 * 2;
constexpr size_t R_WGU = R_WOUT0 + (size_t)1024 * 1024 * 2;
constexpr size_t R_WD = R_WGU + (size_t)32 * 1024 * 1024 * 2;
constexpr size_t R_WIN1 = R_WD + (size_t)32 * 1024 * 512 * 2;
constexpr size_t R_WOUT1 = R_WIN1 + (size_t)2560 * 1024 * 2;
static_assert(R_WOUT1 + (size_t)1024 * 1280 * 2 <= 112 * MiB, "weights");
constexpr size_t R_A = 112 * MiB;
constexpr size_t R_H1 = 192 * MiB;
constexpr size_t R_H2 = 257 * MiB;
constexpr size_t R_C = 322 * MiB;
constexpr size_t R_GLU = 322 * MiB;
constexpr size_t SZ512 = (size_t)LP * 512 * 2;
constexpr size_t R_Q = R_GLU + SZ512, R_K = R_Q + SZ512, R_V = R_K + SZ512, R_QI = R_V + SZ512, R_KI = R_QI + SZ512, R_WI = R_KI + (size_t)LP * 64 * 2;
static_assert(R_WI + (size_t)LP * 8 * 4 <= 406 * MiB, "in-proj outputs");
constexpr size_t R_GATE = 322 * MiB;
constexpr size_t R_XR = R_GATE + (size_t)LP * 1280 * 2;
static_assert(R_XR + (size_t)LP * 1280 * 2 <= 406 * MiB, "layer-1 in-proj outputs");
constexpr size_t R_HM = 406 * MiB;
constexpr size_t WS_END = WS_BIG + R_HM + (size_t)MAXSLOT * 512 * 2;
static_assert(WS_END <= 512 * MiB, "ws");

struct Args { const float* in[28]; float* out; unsigned char* ws; int ph_lo, ph_hi; };

DEVI unsigned opq(unsigned v) { asm volatile("" : "+v"(v)); return v; }
DEVI int otid() { int v = (int)threadIdx.x; asm volatile("" : "+v"(v)); return v; }
template <int CTRL> DEVI float dpp_f(float v) { return __int_as_float(__builtin_amdgcn_mov_dpp(__float_as_int(v), CTRL, 0xF, 0xF, true)); }
DEVI float wave_sum(float v) {
    v += dpp_f<0xB1>(v); v += dpp_f<0x4E>(v); v += dpp_f<0x141>(v); v += dpp_f<0x140>(v);
    return __int_as_float(__builtin_amdgcn_readlane(__float_as_int(v), 0)) + __int_as_float(__builtin_amdgcn_readlane(__float_as_int(v), 16))
         + __int_as_float(__builtin_amdgcn_readlane(__float_as_int(v), 32)) + __int_as_float(__builtin_amdgcn_readlane(__float_as_int(v), 48));
}
DEVI float wave_max(float v) {
#pragma unroll
    for (int o = 32; o > 0; o >>= 1) v = fmaxf(v, __shfl_xor(v, o));
    return v;
}
DEVI float sigm(float x) { return 1.0f / (1.0f + expf(-x)); }
DEVI float gelu_tanh(float x) { return 0.5f * x * (1.0f + tanhf(0.7978845608028654f * (x + 0.044715f * x * x * x))); }
DEVI unsigned f2key(float f) { unsigned u = __float_as_uint(f); return (u & 0x80000000u) ? ~u : (u | 0x80000000u); }

namespace pg8 {
#define PG8_LAS __attribute__((address_space(3)))
typedef unsigned short bf16_t;
typedef short bf16x8 __attribute__((ext_vector_type(8)));
typedef float f32x4 __attribute__((ext_vector_type(4)));
typedef unsigned u32x4 __attribute__((ext_vector_type(4)));
constexpr int BM = 256, BK = 64, HALF = 128, HTB = HALF * BK * 2  , STAGE_BYTES = 8 * HTB, NXCD = 8, WGM = 8;

__host__ __device__ __forceinline__ int lds_byte(int r, int c) { const int st = (r >> 4) * 2 + (c >> 5), rr = r & 15, cc = c & 31, ob = rr * 64 + cc * 2; return st * 1024 + (ob ^ (((ob >> 9) & 1) << 5)); }
__host__ __device__ __forceinline__ void stage_rc(int b, int& R, int& C) { const int st = b / 1024, sb = b % 1024, swz = sb ^ (((sb >> 9) & 1) << 5); R = (st >> 1) * 16 + swz / 64; C = (st & 1) * 32 + (swz % 64) / 2; }
__host__ __device__ __forceinline__ int perm32(int rho) { const int n = rho >> 4, i = rho & 15; return 8 * (i >> 2) + 4 * n + (i & 3); }

struct Unit { int pm, pn; };
struct Gemm { const bf16_t* A; const bf16_t* Bt; int M, N, K; };

struct StaticOrder {
    int nM, nN, nwg, G, c;
    __host__ __device__ void init(int M, int N, int G_, int c_) { nM = M / BM; nN = N / BM; nwg = nM * nN; G = G_; c = c_; }
    __host__ __device__ bool next(int i, Unit& u) const {
        const long L = (long)i * G + c; if (L >= nwg) return false;
        int wgid = (int)L; { const int q = nwg / NXCD, r = nwg % NXCD, xcd = wgid % NXCD, off = wgid / NXCD; wgid = (xcd < r ? xcd * (q + 1) : r * (q + 1) + (xcd - r) * q) + off; }
        const int nig = WGM * nN, gid = wgid / nig, fm = gid * WGM, gsz = (nM - fm) < WGM ? (nM - fm) : WGM;
        u.pm = fm + ((wgid % nig) % gsz); u.pn = (wgid % nig) / gsz; return true;
    }
    __device__ __forceinline__ void a_ready(const Unit&) const {}
    __device__ __forceinline__ void done(const Unit&) const {}
};

template <class Epi, class Sched, bool ALIGN_EPI = false, bool SP2 = false>
__device__ __forceinline__ void gemm_phase(PG8_LAS unsigned char* lds, const Gemm g, const Sched& S, const Epi& E) {
    const int tid = threadIdx.x, wid = __builtin_amdgcn_readfirstlane(tid >> 6), lane = tid & 63, wr = wid >> 2, wc = wid & 3, fr = lane & 15, fq = lane >> 4;
    const int K = g.K, nt = K / BK;
    unsigned voffA[2], voffB[2];
#pragma unroll
    for (int i = 0; i < 2; ++i) { int R, C; stage_rc(tid * 16 + i * 8192, R, C); const int Rb = Epi::PERM ? ((R & ~31) + perm32(R & 31)) : R;
        voffA[i] = (unsigned)(R * K + C) * 2u; voffB[i] = (unsigned)(Rb * K + C) * 2u; }
    const size_t kstep = (size_t)(BK * 2);
    const size_t hstep = (size_t)HALF * K * 2;
    const size_t tstep = 2 * hstep;
    const unsigned ldsw = (unsigned)wid * 1024u;
    const int aoff = lds_byte(wr * 64 + fr, fq * 8), boff = lds_byte(wc * 32 + fr, fq * 8);
#define PG8_SA(b, h) (((b) * 2 + (h)) * HTB)
#define PG8_SB(b, h) ((4 + (b) * 2 + (h)) * HTB)
#define PG8_STAGE(bufoff, gbase, voff) do { _Pragma("unroll") for (int _i = 0; _i < 2; ++_i) \
        __builtin_amdgcn_global_load_lds((const unsigned*)((const char*)(gbase) + (voff)[_i]), (PG8_LAS unsigned*)(lds + (bufoff) + ldsw + _i * 8192), 16, 0, 0); } while (0)
#define PG8_LDA(dst, b, h) do { _Pragma("unroll") for (int m = 0; m < 4; ++m) _Pragma("unroll") for (int k = 0; k < 2; ++k) dst[m][k] = *(const PG8_LAS bf16x8*)(lds + PG8_SA(b, h) + aoff + m * 2048 + k * 1024); } while (0)
#define PG8_LDB(dst, b, h) do { _Pragma("unroll") for (int n = 0; n < 2; ++n) _Pragma("unroll") for (int k = 0; k < 2; ++k) dst[n][k] = *(const PG8_LAS bf16x8*)(lds + PG8_SB(b, h) + boff + n * 2048 + k * 1024); } while (0)
#define PG8_MMA(ai, bj, At, Bt) do { __builtin_amdgcn_s_setprio(1); _Pragma("unroll") for (int m = 0; m < 4; ++m) _Pragma("unroll") for (int n = 0; n < 2; ++n) _Pragma("unroll") for (int k = 0; k < 2; ++k) \
        acc[ai][bj][m][n] = __builtin_amdgcn_mfma_f32_16x16x32_bf16(Bt[n][k], At[m][k], acc[ai][bj][m][n], 0, 0, 0); __builtin_amdgcn_s_setprio(0); } while (0)
#define PG8_WAIT_V(n) asm volatile("s_waitcnt vmcnt(" #n ")" ::: "memory")
#define PG8_WAIT_L(n) asm volatile("s_waitcnt lgkmcnt(" #n ")" ::: "memory")
#define PG8_BAR __builtin_amdgcn_s_barrier()
#define PG8_SCHED __builtin_amdgcn_sched_barrier(0)
    Unit cur, nxt; int ui = 0;
    if (!S.next(0, cur)) return;
    f32x4 acc[2][2][4][2];
#pragma unroll
    for (int a = 0; a < 2; ++a)
#pragma unroll
        for (int b = 0; b < 2; ++b)
#pragma unroll
            for (int m = 0; m < 4; ++m)
#pragma unroll
                for (int n = 0; n < 2; ++n) acc[a][b][m][n] = (f32x4){0.f, 0.f, 0.f, 0.f};
    bf16x8 At[4][2], B0[2][2], B1[2][2];
    const char* cA = (const char*)g.A + (size_t)cur.pm * tstep; const char* cB = (const char*)g.Bt + (size_t)cur.pn * tstep;
    S.a_ready(cur);
    if constexpr (SP2) {
        PG8_STAGE(PG8_SB(0, 0), cB, voffB); PG8_STAGE(PG8_SB(0, 1), cB + hstep, voffB); PG8_STAGE(PG8_SA(0, 0), cA, voffA); PG8_STAGE(PG8_SA(0, 1), cA + hstep, voffA);
        if (wr == 1) PG8_BAR;
        PG8_WAIT_V(2); PG8_BAR;
        PG8_STAGE(PG8_SB(1, 0), cB + kstep, voffB); PG8_STAGE(PG8_SA(1, 0), cA + kstep, voffA); PG8_STAGE(PG8_SB(1, 1), cB + hstep + kstep, voffB);
        PG8_WAIT_V(6); PG8_BAR;
    } else {
        PG8_STAGE(PG8_SB(0, 0), cB, voffB); PG8_STAGE(PG8_SA(0, 0), cA, voffA); PG8_STAGE(PG8_SB(0, 1), cB + hstep, voffB); PG8_STAGE(PG8_SA(0, 1), cA + hstep, voffA);
        if (wr == 1) PG8_BAR;
        PG8_WAIT_V(4); PG8_BAR;
        PG8_STAGE(PG8_SB(1, 0), cB + kstep, voffB); PG8_STAGE(PG8_SA(1, 0), cA + kstep, voffA); PG8_STAGE(PG8_SB(1, 1), cB + hstep + kstep, voffB);
        PG8_WAIT_V(6); PG8_BAR;
    }
    for (;;) {
        const bool has_next = S.next(ui + 1, nxt);
        const char* nA = has_next ? (const char*)g.A + (size_t)nxt.pm * tstep : cA; const char* nB = has_next ? (const char*)g.Bt + (size_t)nxt.pn * tstep : cB;
        for (int t = 0; t < nt; t += 2) {
            const bool last = (t == nt - 2);
            const char* a1 = cA + (size_t)(t + 1) * kstep;
            const char* a2 = last ? nA : cA + (size_t)(t + 2) * kstep; const char* b2 = last ? nB : cB + (size_t)(t + 2) * kstep;
            const char* a3 = a2 + kstep; const char* b3 = b2 + kstep;
            if (last && has_next) S.a_ready(nxt);
            if constexpr (SP2) {
            PG8_LDB(B0, 0, 0); PG8_LDB(B1, 0, 1); PG8_SCHED; PG8_LDA(At, 0, 0); PG8_STAGE(PG8_SA(1, 1), a1 + hstep, voffA);
            PG8_WAIT_V(8); PG8_WAIT_L(0); PG8_BAR; PG8_MMA(0, 0, At, B0); PG8_MMA(0, 1, At, B1); PG8_BAR; PG8_SCHED;
            PG8_LDA(At, 0, 1); PG8_STAGE(PG8_SB(0, 0), b2, voffB); PG8_STAGE(PG8_SB(0, 1), b2 + hstep, voffB); PG8_STAGE(PG8_SA(0, 0), a2, voffA);
            PG8_WAIT_V(8); PG8_WAIT_L(0); PG8_BAR; PG8_MMA(1, 0, At, B0); PG8_MMA(1, 1, At, B1); PG8_BAR; PG8_SCHED;
            PG8_LDB(B0, 1, 0); PG8_LDB(B1, 1, 1); PG8_SCHED; PG8_LDA(At, 1, 0); PG8_STAGE(PG8_SA(0, 1), a2 + hstep, voffA);
            PG8_WAIT_V(8); PG8_WAIT_L(0); PG8_BAR; PG8_MMA(0, 0, At, B0); PG8_MMA(0, 1, At, B1); PG8_BAR; PG8_SCHED;
            PG8_LDA(At, 1, 1); PG8_STAGE(PG8_SB(1, 0), b3, voffB); PG8_STAGE(PG8_SB(1, 1), b3 + hstep, voffB); PG8_STAGE(PG8_SA(1, 0), a3, voffA);
            PG8_WAIT_V(8); PG8_WAIT_L(0); PG8_BAR; PG8_MMA(1, 0, At, B0); PG8_MMA(1, 1, At, B1); PG8_BAR; PG8_SCHED;
            } else {
            PG8_LDB(B0, 0, 0); PG8_SCHED; PG8_LDA(At, 0, 0); PG8_STAGE(PG8_SA(1, 1), a1 + hstep, voffA);
            PG8_WAIT_L(8); PG8_BAR; PG8_WAIT_L(0); PG8_MMA(0, 0, At, B0); PG8_BAR; PG8_SCHED;
            PG8_LDB(B1, 0, 1); PG8_STAGE(PG8_SB(0, 0), b2, voffB);
            PG8_BAR; PG8_WAIT_L(0); PG8_MMA(0, 1, At, B1); PG8_BAR;
            PG8_LDA(At, 0, 1); PG8_STAGE(PG8_SA(0, 0), a2, voffA);
            PG8_BAR; PG8_WAIT_L(0); PG8_MMA(1, 0, At, B0); PG8_BAR; PG8_SCHED;
            PG8_STAGE(PG8_SB(0, 1), b2 + hstep, voffB);
            PG8_WAIT_V(6); PG8_BAR; PG8_MMA(1, 1, At, B1); PG8_BAR;
            PG8_LDB(B0, 1, 0); PG8_SCHED; PG8_LDA(At, 1, 0); PG8_STAGE(PG8_SA(0, 1), a2 + hstep, voffA);
            PG8_WAIT_L(8); PG8_BAR; PG8_WAIT_L(0); PG8_MMA(0, 0, At, B0); PG8_BAR; PG8_SCHED;
            PG8_LDB(B1, 1, 1); PG8_STAGE(PG8_SB(1, 0), b3, voffB);
            PG8_BAR; PG8_WAIT_L(0); PG8_MMA(0, 1, At, B1); PG8_BAR;
            PG8_LDA(At, 1, 1); PG8_STAGE(PG8_SA(1, 0), a3, voffA);
            PG8_BAR; PG8_WAIT_L(0); PG8_MMA(1, 0, At, B0); PG8_BAR; PG8_SCHED;
            PG8_STAGE(PG8_SB(1, 1), b3 + hstep, voffB);
            PG8_WAIT_V(6); PG8_BAR; PG8_MMA(1, 1, At, B1); PG8_BAR;
            }
        }
        if constexpr (ALIGN_EPI) { if (wr == 0) PG8_BAR; }
        if constexpr (!Epi::AFTER_DRAIN) { E(acc, cur, wr, wc, fr, fq); S.done(cur); }
        if (!has_next) break;
#pragma unroll
        for (int a = 0; a < 2; ++a)
#pragma unroll
            for (int b = 0; b < 2; ++b)
#pragma unroll
                for (int m = 0; m < 4; ++m)
#pragma unroll
                    for (int n = 0; n < 2; ++n) acc[a][b][m][n] = (f32x4){0.f, 0.f, 0.f, 0.f};
        cur = nxt; cA = nA; cB = nB; ++ui;
        if constexpr (ALIGN_EPI) { if (wr == 1) PG8_BAR; }
    }
    PG8_WAIT_V(0);
    if constexpr (!ALIGN_EPI) { if (wr == 0) PG8_BAR; }
    PG8_BAR;
    if constexpr (Epi::AFTER_DRAIN) { E.fused(acc, cur, wr, wc, fr, fq, lds, wid, lane); S.done(cur); }
#undef PG8_SA
#undef PG8_SB
#undef PG8_STAGE
#undef PG8_LDA
#undef PG8_LDB
#undef PG8_MMA
#undef PG8_WAIT_V
#undef PG8_WAIT_L
#undef PG8_BAR
#undef PG8_SCHED
}
}

DEVI void ln_row1024(float (&y)[16], const float* g, const float* b, int lane) {
    float s = 0.f;
#pragma unroll
    for (int i = 0; i < 16; ++i) s += y[i];
    const float mu = wave_sum(s) * (1.0f / 1024.0f);
    float q = 0.f;
#pragma unroll
    for (int i = 0; i < 16; ++i) { const float d = y[i] - mu; q += d * d; }
    const float rstd = 1.0f / sqrtf(wave_sum(q) * (1.0f / 1024.0f) + LN_EPS);
#pragma unroll
    for (int i = 0; i < 16; ++i) y[i] = (y[i] - mu) * rstd * g[lane + 64 * i] + b[lane + 64 * i];
}

DEVI void route_token(const float (&y)[16], float* ys, int t, int lane, const float* wg, const float* bg, const float* we, const float* be, int* eid, float* gw, unsigned* counts) {
    float lg[36];
#pragma unroll
    for (int j = 0; j < 36; ++j) lg[j] = 0.f;
#pragma unroll
    for (int i = 0; i < 16; ++i) ys[lane + 64 * i] = y[i];
#pragma unroll 1
    for (int i = 0; i < 16; ++i) {
        const int c = lane + 64 * i;
        const float yv = ys[c];
        const float4 g4 = *(const float4*)(wg + (size_t)c * 4);
        lg[0] += yv * g4.x; lg[1] += yv * g4.y; lg[2] += yv * g4.z; lg[3] += yv * g4.w;
#pragma unroll
        for (int j = 0; j < 8; ++j) { const float4 e4 = *(const float4*)(we + (size_t)c * 32 + j * 4);
            lg[4 + j * 4 + 0] += yv * e4.x; lg[4 + j * 4 + 1] += yv * e4.y; lg[4 + j * 4 + 2] += yv * e4.z; lg[4 + j * 4 + 3] += yv * e4.w; }
    }
#pragma unroll
    for (int j = 0; j < 36; ++j) lg[j] = wave_sum(lg[j]);
    if (lane == 0) {
        float gl[4]; int g = 0;
#pragma unroll
        for (int j = 0; j < 4; ++j) gl[j] = lg[j] + bg[j];
#pragma unroll
        for (int j = 1; j < 4; ++j) if (gl[j] > gl[g]) g = j;
        float den = 0.f;
#pragma unroll
        for (int j = 0; j < 4; ++j) den += expf(gl[j] - gl[g]);
        const float gp = 1.0f / den;
        float el[8];
#pragma unroll
        for (int j = 0; j < 8; ++j) { float v = 0.f;
#pragma unroll
            for (int gg = 0; gg < 4; ++gg) v = (gg == g) ? lg[4 + gg * 8 + j] + be[gg * 8 + j] : v;
            el[j] = v; }
        int i1 = 0;
#pragma unroll
        for (int j = 1; j < 8; ++j) if (el[j] > el[i1]) i1 = j;
        int i2 = (i1 == 0) ? 1 : 0;
#pragma unroll
        for (int j = 0; j < 8; ++j) if (j != i1 && el[j] > el[i2]) i2 = j;
        const float ex = expf(el[i2] - el[i1]);
        const float p1 = 1.0f / (1.0f + ex), p2 = ex / (1.0f + ex);
        const int e1 = g * 8 + i1, e2 = g * 8 + i2;
        eid[2 * t] = e1; eid[2 * t + 1] = e2; gw[2 * t] = gp * p1; gw[2 * t + 1] = gp * p2;
        atomicAdd(&counts[e1], 1u); atomicAdd(&counts[e2], 1u);
    }
}


DEVI void ln_row1024v(float (&y)[16], const float* g, const float* b, int lane) {
    float s = 0.f;
#pragma unroll
    for (int i = 0; i < 16; ++i) s += y[i];
    const float mu = wave_sum(s) * (1.0f / 1024.0f);
    float q = 0.f;
#pragma unroll
    for (int i = 0; i < 16; ++i) { const float d = y[i] - mu; q += d * d; }
    const float rstd = 1.0f / sqrtf(wave_sum(q) * (1.0f / 1024.0f) + LN_EPS);
#pragma unroll
    for (int i4 = 0; i4 < 4; ++i4) { const float4 g4 = *(const float4*)(g + 16 * lane + 4 * i4), b4 = *(const float4*)(b + 16 * lane + 4 * i4);
        y[4 * i4] = (y[4 * i4] - mu) * rstd * g4.x + b4.x; y[4 * i4 + 1] = (y[4 * i4 + 1] - mu) * rstd * g4.y + b4.y; y[4 * i4 + 2] = (y[4 * i4 + 2] - mu) * rstd * g4.z + b4.z; y[4 * i4 + 3] = (y[4 * i4 + 3] - mu) * rstd * g4.w + b4.w; }
}
DEVI void ln_row1024w(float (&y)[16], const float* g, const float* b, int lane) {
    float s = 0.f;
#pragma unroll
    for (int i = 0; i < 16; ++i) s += y[i];
    const float mu = wave_sum(s) * (1.0f / 1024.0f);
    float q = 0.f;
#pragma unroll
    for (int i = 0; i < 16; ++i) { const float d = y[i] - mu; q += d * d; }
    const float rstd = 1.0f / sqrtf(wave_sum(q) * (1.0f / 1024.0f) + LN_EPS);
#pragma unroll
    for (int i4 = 0; i4 < 4; ++i4) { const float4 g4 = *(const float4*)(g + 256 * i4 + 4 * lane), b4 = *(const float4*)(b + 256 * i4 + 4 * lane);
        y[4 * i4] = (y[4 * i4] - mu) * rstd * g4.x + b4.x; y[4 * i4 + 1] = (y[4 * i4 + 1] - mu) * rstd * g4.y + b4.y; y[4 * i4 + 2] = (y[4 * i4 + 2] - mu) * rstd * g4.z + b4.z; y[4 * i4 + 3] = (y[4 * i4 + 3] - mu) * rstd * g4.w + b4.w; }
}
DEVI void combine_row(float (&y)[16], const float* h, const unsigned short* Y0, const unsigned short* Y1, float g0, float g1, int lane) {
    uint2 aw[4], bw[4]; float4 hv[4];
#pragma unroll
    for (int i4 = 0; i4 < 4; ++i4) { aw[i4] = *(const uint2*)(Y0 + 256 * i4 + 4 * lane); bw[i4] = *(const uint2*)(Y1 + 256 * i4 + 4 * lane); hv[i4] = *(const float4*)(h + 256 * i4 + 4 * lane); }
#pragma unroll
    for (int i4 = 0; i4 < 4; ++i4) {
        y[4 * i4]     = DN_ALPHA * hv[i4].x + (g0 * __uint_as_float(aw[i4].x << 16) + g1 * __uint_as_float(bw[i4].x << 16));
        y[4 * i4 + 1] = DN_ALPHA * hv[i4].y + (g0 * __uint_as_float(aw[i4].x & 0xFFFF0000u) + g1 * __uint_as_float(bw[i4].x & 0xFFFF0000u));
        y[4 * i4 + 2] = DN_ALPHA * hv[i4].z + (g0 * __uint_as_float(aw[i4].y << 16) + g1 * __uint_as_float(bw[i4].y << 16));
        y[4 * i4 + 3] = DN_ALPHA * hv[i4].w + (g0 * __uint_as_float(aw[i4].y & 0xFFFF0000u) + g1 * __uint_as_float(bw[i4].y & 0xFFFF0000u)); }
}
typedef float f32x4v __attribute__((ext_vector_type(4)));
DEVI void ln_route_block(int tb, int ntok, const float* Zsrc, float* Hdst, const float* g, const float* b, const float4* __restrict__ Wr, const float* bg, const float* be,
                         int* eid, float* gw, unsigned* counts, float* sm) {
    const int tid = otid(), lane = tid & 63, wave = tid >> 6;
    unsigned* lcnt = (unsigned*)(sm + 8 * 16 * 48);
    if (tid < NE) lcnt[tid] = 0u;
    { float yy[8][16];
#pragma unroll
      for (int i = 0; i < 8; ++i) { const int tl = wave * 8 + i; const size_t t = (size_t)(tb + (tl < ntok ? tl : ntok - 1));
#pragma unroll
          for (int i4 = 0; i4 < 4; ++i4) { const float4 v = *(const float4*)(Zsrc + t * D + 256 * i4 + 4 * lane); yy[i][4 * i4] = v.x; yy[i][4 * i4 + 1] = v.y; yy[i][4 * i4 + 2] = v.z; yy[i][4 * i4 + 3] = v.w; } }
#pragma unroll
      for (int i = 0; i < 8; ++i) { const int tl = wave * 8 + i;
          if (tl < ntok) { const size_t t = (size_t)(tb + tl);
              ln_row1024w(yy[i], g, b, lane);
#pragma unroll
              for (int i4 = 0; i4 < 4; ++i4) *(float4*)(Hdst + t * D + 256 * i4 + 4 * lane) = make_float4(yy[i][4 * i4], yy[i][4 * i4 + 1], yy[i][4 * i4 + 2], yy[i][4 * i4 + 3]); } } }
    asm volatile("s_waitcnt vmcnt(0)" ::: "memory");
    __syncthreads();
    const int grp = wave & 3, khalf = wave >> 2;
    if (grp * 16 < ntok) {
        const int t0 = tb + 16 * grp, row = lane & 15, kg = lane >> 4;
        f32x4v acc[3];
#pragma unroll
        for (int ct = 0; ct < 3; ++ct) acc[ct] = (f32x4v){0.f, 0.f, 0.f, 0.f};
        const float* arow = Hdst + (size_t)(t0 + row) * D + 4 * kg;
        float4 aN[4], bN[4][3];
#pragma unroll
        for (int u = 0; u < 4; ++u) { const int sstep = 32 * khalf + u; aN[u] = *(const float4*)(arow + 16 * sstep);
#pragma unroll
            for (int ct = 0; ct < 3; ++ct) bN[u][ct] = Wr[(sstep * 3 + ct) * 64 + lane]; }
#pragma unroll 1
        for (int s0 = 32 * khalf; s0 < 32 * khalf + 32; s0 += 4) {
            float4 aC[4], bC[4][3];
#pragma unroll
            for (int u = 0; u < 4; ++u) { aC[u] = aN[u];
#pragma unroll
                for (int ct = 0; ct < 3; ++ct) bC[u][ct] = bN[u][ct]; }
            if (s0 + 4 < 32 * khalf + 32) {
#pragma unroll
                for (int u = 0; u < 4; ++u) { const int sstep = s0 + 4 + u; aN[u] = *(const float4*)(arow + 16 * sstep);
#pragma unroll
                    for (int ct = 0; ct < 3; ++ct) bN[u][ct] = Wr[(sstep * 3 + ct) * 64 + lane]; } }
#pragma unroll
            for (int u = 0; u < 4; ++u)
#pragma unroll
                for (int ct = 0; ct < 3; ++ct) { const float4 a4 = aC[u], b4 = bC[u][ct];
                    acc[ct] = __builtin_amdgcn_mfma_f32_16x16x4f32(a4.x, b4.x, acc[ct], 0, 0, 0); acc[ct] = __builtin_amdgcn_mfma_f32_16x16x4f32(a4.y, b4.y, acc[ct], 0, 0, 0);
                    acc[ct] = __builtin_amdgcn_mfma_f32_16x16x4f32(a4.z, b4.z, acc[ct], 0, 0, 0); acc[ct] = __builtin_amdgcn_mfma_f32_16x16x4f32(a4.w, b4.w, acc[ct], 0, 0, 0); }
        }
        float* Lg = sm + (khalf * 4 + grp) * 16 * 48;
#pragma unroll
        for (int ct = 0; ct < 3; ++ct)
#pragma unroll
            for (int j = 0; j < 4; ++j) Lg[(4 * kg + j) * 48 + 16 * ct + row] = acc[ct][j];
    }
    __syncthreads();
    if (wave < 4 && wave * 16 < ntok) {
        const int t0 = tb + 16 * wave;
        if (lane < 16) {
            const int t = t0 + lane; const float* lgA = sm + wave * 16 * 48 + lane * 48; const float* lgB = lgA + 4 * 16 * 48;
            float lg[36];
#pragma unroll
            for (int j = 0; j < 36; ++j) lg[j] = lgA[j] + lgB[j];
            float gl[4]; int gsel = 0;
#pragma unroll
            for (int j = 0; j < 4; ++j) gl[j] = lg[j] + bg[j];
#pragma unroll
            for (int j = 1; j < 4; ++j) if (gl[j] > gl[gsel]) gsel = j;
            float den = 0.f;
#pragma unroll
            for (int j = 0; j < 4; ++j) den += expf(gl[j] - gl[gsel]);
            const float gp = 1.0f / den;
            float el[8];
#pragma unroll
            for (int j = 0; j < 8; ++j) { float v = lg[4 + j];
#pragma unroll
                for (int gg = 1; gg < 4; ++gg) v = (gg == gsel) ? lg[4 + gg * 8 + j] : v;
                el[j] = v + be[gsel * 8 + j]; }
            int i1 = 0;
#pragma unroll
            for (int j = 1; j < 8; ++j) if (el[j] > el[i1]) i1 = j;
            int i2 = (i1 == 0) ? 1 : 0;
#pragma unroll
            for (int j = 0; j < 8; ++j) if (j != i1 && el[j] > el[i2]) i2 = j;
            float e1v = el[0], e2v = el[0];
#pragma unroll
            for (int j = 0; j < 8; ++j) { e1v = (j == i1) ? el[j] : e1v; e2v = (j == i2) ? el[j] : e2v; }
            const float ex = expf(e2v - e1v);
            const float p1 = 1.0f / (1.0f + ex), p2 = ex / (1.0f + ex);
            const int e1 = gsel * 8 + i1, e2 = gsel * 8 + i2;
            eid[2 * t] = e1; eid[2 * t + 1] = e2; gw[2 * t] = gp * p1; gw[2 * t + 1] = gp * p2;
            atomicAdd(&lcnt[e1], 1u); atomicAdd(&lcnt[e2], 1u);
        }
    }
    __syncthreads();
    if (tid < NE) { const unsigned c = lcnt[tid]; if (c) atomicAdd(&counts[tid], c); }
    __syncthreads();
}

using pg8::f32x4; using pg8::Unit; typedef unsigned short bf16_t;
DEVI float bf2f(unsigned short b) { return __uint_as_float(((unsigned)b) << 16); }
DEVI float bflo(unsigned w) { return __uint_as_float(w << 16); }
DEVI float bfhi(unsigned w) { return __uint_as_float(w & 0xFFFF0000u); }
DEVI unsigned cvt_pk_bf16(float lo, float hi) { unsigned r; asm volatile("v_cvt_pk_bf16_f32 %0, %1, %2" : "=v"(r) : "v"(lo), "v"(hi)); return r; }
DEVI uint2 pack4(const f32x4 v) { return make_uint2(cvt_pk_bf16(v[0], v[1]), cvt_pk_bf16(v[2], v[3])); }
DEVI float fsigm(float x) { return __builtin_amdgcn_rcpf(1.0f + __expf(-x)); }
DEVI unsigned pack4_fp8(const f32x4 v) { int w = __builtin_amdgcn_cvt_pk_fp8_f32(v[0], v[1], 0, false); w = __builtin_amdgcn_cvt_pk_fp8_f32(v[2], v[3], w, true); return (unsigned)w; }

DEVI int in0_srccol(int n) {
    if (n < 1024) { const int G = n >> 5, nn = (n >> 4) & 1, i = n & 15; return (nn ? OFF_AGATE : OFF_AVAL) + 16 * G + i; }
    if (n < 2048 || (n >= 2560 && n < 3072)) {
        const int base = n < 1536 ? OFF_Q : n < 2048 ? OFF_K : OFF_QI; const int loc = n & 511;
        const int G = loc >> 5, nn = (loc >> 4) & 1, i = loc & 15; return base + 64 * (G >> 1) + 32 * nn + 16 * (G & 1) + i; }
    if (n < 2560) return OFF_V + (n - 2048);
    if (n < 3136) { const int loc = n - 3072; const int G = loc >> 5, nn = (loc >> 4) & 1, i = loc & 15; return OFF_KI + 32 * nn + 16 * G + i; }
    if (n < 3144) return OFF_WI + (n - 3136);
    return -1;
}
struct EpiIn0 {
    static constexpr bool PERM = false, AFTER_DRAIN = false;
    bf16_t* GLU; bf16_t* KI; float* WI; const float* ropeC; const float* ropeS; unsigned char* KV8;
    DEVI void operator()(const f32x4 (&acc)[2][2][4][2], const Unit& u, int wr, int wc, int fr, int fq) const {
        const int pn = u.pn; const int rbase = u.pm * 256 + wr * 64 + fr;
        if (pn < 4) {
#pragma unroll
            for (int ai = 0; ai < 2; ++ai)
#pragma unroll
                for (int m = 0; m < 4; ++m) { const size_t row = rbase + ai * 128 + m * 16;
#pragma unroll
                    for (int bj = 0; bj < 2; ++bj) { const int G = 8 * pn + 4 * bj + wc; const f32x4 v = acc[ai][bj][m][0], g = acc[ai][bj][m][1]; f32x4 o;
#pragma unroll
                        for (int j = 0; j < 4; ++j) o[j] = v[j] * fsigm(g[j]);
                        *(uint2*)(GLU + row * 512 + 16 * G + 4 * fq) = pack4(o); } }
        } else if (pn == 8 || pn == 9) {
#pragma unroll
            for (int ai = 0; ai < 2; ++ai)
#pragma unroll
                for (int m = 0; m < 4; ++m) { const size_t row = rbase + ai * 128 + m * 16;
#pragma unroll
                    for (int bj = 0; bj < 2; ++bj)
#pragma unroll
                        for (int n = 0; n < 2; ++n) { const int col = 256 * (pn - 8) + 128 * bj + 32 * wc + 16 * n + 4 * fq;
                            *(unsigned*)(KV8 + row * 1024 + (size_t)(col >> 3) * 16 + 8 + (col & 7)) = pack4_fp8(acc[ai][bj][m][n]); } }
        } else if (pn == 12) {
            if (wc < 2) { const int d0 = 16 * wc + 4 * fq;
#pragma unroll
                for (int ai = 0; ai < 2; ++ai)
#pragma unroll
                    for (int m = 0; m < 4; ++m) { const size_t row = rbase + ai * 128 + m * 16;
                        const f32x4 c = *(const f32x4*)(ropeC + row * 32 + d0), s = *(const f32x4*)(ropeS + row * 32 + d0);
                        const f32x4 t1 = acc[ai][0][m][0], t2 = acc[ai][0][m][1];
                        *(uint2*)(KI + row * 64 + d0) = pack4(t1 * c - t2 * s); *(uint2*)(KI + row * 64 + 32 + d0) = pack4(t1 * s + t2 * c); }
            } else if (wc == 2 && fq < 2) {
#pragma unroll
                for (int ai = 0; ai < 2; ++ai)
#pragma unroll
                    for (int m = 0; m < 4; ++m) { const size_t row = rbase + ai * 128 + m * 16; *(f32x4*)(WI + row * 8 + 4 * fq) = acc[ai][0][m][0] * 0.35355339059327373f; }
            }
        } else {
            bf16_t* dst = GLU + (size_t)(pn < 6 ? 1 : pn < 8 ? 2 : 4) * LP * 512; const int pl = pn & 1; const int d0 = 16 * (wc & 1) + 4 * fq;
#pragma unroll
            for (int ai = 0; ai < 2; ++ai)
#pragma unroll
                for (int m = 0; m < 4; ++m) { const size_t row = rbase + ai * 128 + m * 16;
                    const f32x4 c = *(const f32x4*)(ropeC + row * 32 + d0), s = *(const f32x4*)(ropeS + row * 32 + d0);
#pragma unroll
                    for (int bj = 0; bj < 2; ++bj) { const int hh = 4 * pl + 2 * bj + (wc >> 1); const f32x4 t1 = acc[ai][bj][m][0], t2 = acc[ai][bj][m][1];
                        if (pn == 6 || pn == 7) { const int da = 64 * hh + d0, db = da + 32;
                            *(unsigned*)(KV8 + row * 1024 + (size_t)(da >> 3) * 16 + (da & 7)) = pack4_fp8(t1 * c - t2 * s); *(unsigned*)(KV8 + row * 1024 + (size_t)(db >> 3) * 16 + (db & 7)) = pack4_fp8(t1 * s + t2 * c);
                        } else { *(uint2*)(dst + row * 512 + 64 * hh + d0) = pack4(t1 * c - t2 * s); *(uint2*)(dst + row * 512 + 64 * hh + 32 + d0) = pack4(t1 * s + t2 * c); } } }
        }
    }
};
struct EpiRes0 {
    static constexpr bool PERM = false, AFTER_DRAIN = false;
    const float* x; const float* meta; float* Z;
    DEVI void operator()(const f32x4 (&acc)[2][2][4][2], const Unit& u, int wr, int wc, int fr, int fq) const {
        const int rbase = u.pm * 256 + wr * 64 + fr, cbase = u.pn * 256 + wc * 32 + 4 * fq;
#pragma unroll
        for (int ai = 0; ai < 2; ++ai)
#pragma unroll
            for (int m = 0; m < 4; ++m) { const int row = rbase + ai * 128 + m * 16;
                if (row < L) { const float* rs = row < NMETA ? meta + (size_t)row * D : x + (size_t)(row - NMETA) * D;
#pragma unroll
                    for (int bj = 0; bj < 2; ++bj)
#pragma unroll
                        for (int n = 0; n < 2; ++n) { const int col = cbase + 128 * bj + 16 * n; const f32x4 r4 = *(const f32x4*)(rs + col); *(f32x4*)(Z + (size_t)row * D + col) = r4 * DN_ALPHA + acc[ai][bj][m][n]; } } }
    }
};
struct EpiGateUp {
    static constexpr bool PERM = false, AFTER_DRAIN = false;
    bf16_t* Hm;
    DEVI void operator()(const f32x4 (&acc)[2][2][4][2], const Unit& u, int wr, int wc, int fr, int fq) const {
        const int pl = u.pn & 3; const int rbase = u.pm * 256 + wr * 64 + fr;
#pragma unroll
        for (int ai = 0; ai < 2; ++ai)
#pragma unroll
            for (int m = 0; m < 4; ++m) { const size_t row = rbase + ai * 128 + m * 16;
#pragma unroll
                for (int bj = 0; bj < 2; ++bj) { const int G = 8 * pl + 4 * bj + wc; const f32x4 g = acc[ai][bj][m][0], up = acc[ai][bj][m][1]; f32x4 o;
#pragma unroll
                    for (int j = 0; j < 4; ++j) o[j] = g[j] * fsigm(g[j]) * up[j];
                    *(uint2*)(Hm + row * 512 + 16 * G + 4 * fq) = pack4(o); } }
    }
};
struct EpiDown {
    static constexpr bool PERM = false, AFTER_DRAIN = false;
    bf16_t* Y;
    DEVI void operator()(const f32x4 (&acc)[2][2][4][2], const Unit& u, int wr, int wc, int fr, int fq) const {
        const int pl = u.pn & 3; const int rbase = u.pm * 256 + wr * 64 + fr, cbase = pl * 256 + wc * 32 + 4 * fq;
#pragma unroll
        for (int ai = 0; ai < 2; ++ai)
#pragma unroll
            for (int m = 0; m < 4; ++m) { const size_t row = rbase + ai * 128 + m * 16;
#pragma unroll
                for (int bj = 0; bj < 2; ++bj)
#pragma unroll
                    for (int n = 0; n < 2; ++n) *(uint2*)(Y + row * 1024 + cbase + 128 * bj + 16 * n) = pack4(acc[ai][bj][m][n]); }
    }
};
struct MoeOrder {
    const int* mt; int nunits, G, c;
    DEVI void init(const int* t, int G_, int c_) { mt = t; nunits = t[0] * 4; G = G_; c = c_; }
    DEVI bool next(int i, Unit& u) const { const int li = i * G + c; if (li >= nunits) return false; const int ti = li >> 2; u.pm = ti; u.pn = mt[4 + ti] * 4 + (li & 3); return true; }
    DEVI void a_ready(const Unit&) const {}
    DEVI void done(const Unit&) const {}
};

template <class F> DEVI void tr_tile(bf16_t* dst, int K, int n0, int k0, F src, float* sm) {
    const int tid = otid();
    __syncthreads();
    { const int nn = tid & 63, kb = tid >> 6;
#pragma unroll
      for (int p = 0; p < 8; ++p) { const int kk = kb + 8 * p; sm[kk * 65 + nn] = src(n0 + nn, k0 + kk); } }
    __syncthreads();
    { const int nn = tid >> 3, kq = (tid & 7) * 8; float v[8];
#pragma unroll
      for (int j = 0; j < 8; ++j) v[j] = sm[(kq + j) * 65 + nn];
      uint4 w; w.x = cvt_pk_bf16(v[0], v[1]); w.y = cvt_pk_bf16(v[2], v[3]); w.z = cvt_pk_bf16(v[4], v[5]); w.w = cvt_pk_bf16(v[6], v[7]);
      *(uint4*)(dst + (size_t)(n0 + nn) * K + k0 + kq) = w; }
}

struct TrJob { bf16_t* dst; const float* s0; const float* s1; int K, n0, k0, ld, mode; };
DEVI float tr_src(const TrJob& J, int n, int k) {
    if (J.mode == 0) return __builtin_nontemporal_load(J.s0 + (size_t)k * J.ld + n);
    if (J.mode == 1) { const int sc = in0_srccol(n); return sc < 0 ? 0.f : __builtin_nontemporal_load(J.s0 + (size_t)k * IN_AB + sc); }
    const int ch = (n >> 5) * 16 + (n & 15); return ((n >> 4) & 1) ? __builtin_nontemporal_load(J.s1 + (size_t)k * DE + ch) : __builtin_nontemporal_load(J.s0 + (size_t)k * DE + ch);
}
DEVI void tr_fetch(const TrJob& J, float (&v)[8]) {
    const int tid = otid(), nn = tid & 63, kb = tid >> 6;
#pragma unroll
    for (int p = 0; p < 8; ++p) v[p] = tr_src(J, J.n0 + nn, J.k0 + kb + 8 * p);
}
DEVI void tr_commit(const TrJob& J, const float (&v)[8], float* sm) {
    const int tid = otid();
    __syncthreads();
    { const int nn = tid & 63, kb = tid >> 6;
#pragma unroll
      for (int p = 0; p < 8; ++p) sm[(kb + 8 * p) * 65 + nn] = v[p]; }
    __syncthreads();
    { const int nn = tid >> 3, kq = (tid & 7) * 8; float x[8];
#pragma unroll
      for (int j = 0; j < 8; ++j) x[j] = sm[(kq + j) * 65 + nn];
      uint4 w; w.x = cvt_pk_bf16(x[0], x[1]); w.y = cvt_pk_bf16(x[2], x[3]); w.z = cvt_pk_bf16(x[4], x[5]); w.w = cvt_pk_bf16(x[6], x[7]);
      *(uint4*)(J.dst + (size_t)(J.n0 + nn) * J.K + J.k0 + kq) = w; }
}
template <class Dec> DEVI void tr_run(int njobs, Dec dec, float* sm, int rank = (int)blockIdx.x, int G = (int)gridDim.x) {
    int j = rank;
    TrJob Ja{}, Jb{}; float va[8], vb[8];
    if (j < njobs) { Ja = dec(j); tr_fetch(Ja, va); }
    while (j < njobs) {
        int jn = j + G; if (jn < njobs) { Jb = dec(jn); tr_fetch(Jb, vb); }
        tr_commit(Ja, va, sm);
        j = jn; if (j >= njobs) break;
        jn = j + G; if (jn < njobs) { Ja = dec(jn); tr_fetch(Ja, va); }
        tr_commit(Jb, vb, sm);
        j = jn;
    }
    __syncthreads();
}

DEVI void moe_dispatch_mfma(const float* H, const int* eid, const unsigned* counts, unsigned* cursor, int* slot, int* mtiles, bf16_t* Xperm, int* sm_i, int gwave, int nwaves, int lane, int p_begin) {
    { const int tid = otid();
      if (tid == 0) { int o = 0; for (int e = 0; e < NE; ++e) { sm_i[e] = o; o += (((int)counts[e] + 255) >> 8) << 8; } }
      if (tid < NE) sm_i[32 + tid] = 0; }
    __syncthreads();
    { const int ppw = (NPAIR - p_begin + nwaves - 1) / nwaves; const int pb = p_begin + gwave * ppw; const int pe = pb + ppw < NPAIR ? pb + ppw : NPAIR;
      int e_ = 0, rk = 0; const bool act = lane < ppw && pb + lane < pe;
      if (act) { e_ = eid[pb + lane]; rk = atomicAdd(&sm_i[32 + e_], 1); }
      __syncthreads();
      { const int tid = otid(); if (tid < NE) { const int c = sm_i[32 + tid]; if (c) sm_i[64 + tid] = sm_i[tid] + (int)atomicAdd(&cursor[tid], (unsigned)c); } }
      __syncthreads();
      if (pb < pe) {
        int sl = 0;
        if (act) { sl = sm_i[64 + e_] + rk; slot[pb + lane] = sl; }
        for (int k0 = 0; pb + k0 < pe; k0 += 8) {
            float4 v[8][4];
#pragma unroll
            for (int k = 0; k < 8; ++k) { const int p = pb + k0 + k < pe ? pb + k0 + k : pe - 1; const float4* src = (const float4*)(H + (size_t)(p >> 1) * D);
#pragma unroll
                for (int r = 0; r < 4; ++r) v[k][r] = src[lane + 64 * r]; }
#pragma unroll
            for (int k = 0; k < 8; ++k) { const int s = __shfl(sl, k0 + k);
                if (pb + k0 + k < pe) { uint2* dst = (uint2*)(Xperm + (size_t)s * D);
#pragma unroll
                    for (int r = 0; r < 4; ++r) dst[lane + 64 * r] = make_uint2(cvt_pk_bf16(v[k][r].x, v[k][r].y), cvt_pk_bf16(v[k][r].z, v[k][r].w)); } }
        }
      } }
    if (blockIdx.x == 0 && otid() == 0) { int n = 0; for (int e = 0; e < NE; ++e) { const int nt = ((int)counts[e] + 255) >> 8; for (int i = 0; i < nt; ++i) mtiles[4 + n++] = e; } mtiles[0] = n; }
    __syncthreads();
}

DEVI float gelu_fast(float x) { return x * fsigm(1.5957691216057308f * (x + 0.044715f * x * x * x)); }
struct EpiIn1 {
    static constexpr bool PERM = false, AFTER_DRAIN = false;
    bf16_t* G;
    DEVI void operator()(const f32x4 (&acc)[2][2][4][2], const Unit& u, int wr, int wc, int fr, int fq) const {
        const int pn = u.pn; const bool is_gate = pn < 5; const int rbase = u.pm * 256 + wr * 64 + fr;
        bf16_t* dst = G + (is_gate ? (size_t)0 : (size_t)LP * RNN_W) + (size_t)((is_gate ? pn : pn - 5) * 256 + wc * 32 + 4 * fq);
#pragma unroll
        for (int ai = 0; ai < 2; ++ai)
#pragma unroll
            for (int m = 0; m < 4; ++m) { const size_t row = rbase + ai * 128 + m * 16;
#pragma unroll
                for (int bj = 0; bj < 2; ++bj)
#pragma unroll
                    for (int n = 0; n < 2; ++n) { f32x4 v = acc[ai][bj][m][n];
                        if (is_gate) {
#pragma unroll
                            for (int j = 0; j < 4; ++j) v[j] = gelu_fast(v[j]); }
                        *(uint2*)(dst + row * RNN_W + 128 * bj + 16 * n) = pack4(v); } }
    }
};
struct EpiRes1 {
    static constexpr bool PERM = false, AFTER_DRAIN = false;
    const float* R; float* Z;
    DEVI void operator()(const f32x4 (&acc)[2][2][4][2], const Unit& u, int wr, int wc, int fr, int fq) const {
        const int rbase = u.pm * 256 + wr * 64 + fr, cbase = u.pn * 256 + wc * 32 + 4 * fq;
#pragma unroll
        for (int ai = 0; ai < 2; ++ai)
#pragma unroll
            for (int m = 0; m < 4; ++m) { const size_t row = rbase + ai * 128 + m * 16;
#pragma unroll
                for (int bj = 0; bj < 2; ++bj)
#pragma unroll
                    for (int n = 0; n < 2; ++n) { const int col = cbase + 128 * bj + 16 * n; const f32x4 r4 = *(const f32x4*)(R + row * D + col); *(f32x4*)(Z + row * D + col) = r4 * DN_ALPHA + acc[ai][bj][m][n]; } }
    }
};

typedef short bf16x8_t __attribute__((ext_vector_type(8)));
struct RgIn { uint4 x[2][4]; };
DEVI void rglru_fetch(int c, int ch0, const bf16_t* __restrict__ XR, int tid, RgIn& R) {
    const int c8 = tid & 15, tr = tid >> 4;
#pragma unroll
    for (int half = 0; half < 2; ++half) { const int t = c * 64 + tr + 32 * half;
#pragma unroll
        for (int j = 0; j < 4; ++j) { const int tt = t - 3 + j; R.x[half][j] = tt >= 0 ? *(const uint4*)(XR + (size_t)tt * RNN_W + ch0 + 8 * c8) : make_uint4(0u, 0u, 0u, 0u); } }
}
template <bool FINAL>
DEVI void rglru_unit(int c, int nb, const RgIn& R, const bf16x8_t (&fa)[4], const bf16x8_t (&fx)[4], float bav, float bxv, float sp,
                     const bf16_t* __restrict__ GATEg, float* __restrict__ Aend, float* __restrict__ Hend, const float* __restrict__ CIN, bf16_t* __restrict__ YY,
                     unsigned char* lds, int tid) {
    const int lane = tid & 63, w = tid >> 6, col = lane & 15, quad = lane >> 4;
    bf16_t* xcb = (bf16_t*)lds;
    float* xcf = (float*)(lds + 64 * 136 * 2);
    const float* cwl = (const float*)(lds + 64 * 136 * 2 + 64 * 132 * 4);
    const int t0 = c * 64, ch0 = nb * RNN_BW, ch = ch0 + 16 * w + col;
    const float cinv = FINAL ? CIN[(size_t)ch * CP + c] : 0.f;
    const int c8 = tid & 15, tr = tid >> 4;
    uint4 g[2];
    if (FINAL) {
#pragma unroll
        for (int half = 0; half < 2; ++half) { const int t = t0 + tr + 32 * half; g[half] = (t < L) ? *(const uint4*)(GATEg + (size_t)t * RNN_W + ch0 + 8 * c8) : make_uint4(0u, 0u, 0u, 0u); } }
    __syncthreads();
    {
        float bv[8];
        { const float4 b0 = *(const float4*)(cwl + 512 + 8 * c8), b1 = *(const float4*)(cwl + 512 + 8 * c8 + 4); bv[0] = b0.x; bv[1] = b0.y; bv[2] = b0.z; bv[3] = b0.w; bv[4] = b1.x; bv[5] = b1.y; bv[6] = b1.z; bv[7] = b1.w; }
#pragma unroll
        for (int half = 0; half < 2; ++half) { const int tl = tr + 32 * half;
            float v[8];
#pragma unroll
            for (int i = 0; i < 8; ++i) v[i] = bv[i];
#pragma unroll
            for (int j = 0; j < 4; ++j) { const uint4 xv = R.x[half][j];
                const float4 w0 = *(const float4*)(cwl + j * 128 + 8 * c8), w1 = *(const float4*)(cwl + j * 128 + 8 * c8 + 4);
                v[0] += w0.x * bflo(xv.x); v[1] += w0.y * bfhi(xv.x); v[2] += w0.z * bflo(xv.y); v[3] += w0.w * bfhi(xv.y);
                v[4] += w1.x * bflo(xv.z); v[5] += w1.y * bfhi(xv.z); v[6] += w1.z * bflo(xv.w); v[7] += w1.w * bfhi(xv.w); }
            *(float4*)(xcf + tl * 132 + 8 * c8) = make_float4(v[0], v[1], v[2], v[3]); *(float4*)(xcf + tl * 132 + 8 * c8 + 4) = make_float4(v[4], v[5], v[6], v[7]);
            uint4 pk; pk.x = cvt_pk_bf16(v[0], v[1]); pk.y = cvt_pk_bf16(v[2], v[3]); pk.z = cvt_pk_bf16(v[4], v[5]); pk.w = cvt_pk_bf16(v[6], v[7]);
            *(uint4*)(xcb + (16 * ((tl >> 2) & 3) + 4 * (tl >> 4) + (tl & 3)) * 136 + 8 * c8) = pk; }
    }
    __syncthreads();
    f32x4 ca[4], cx[4];
#pragma unroll
    for (int mt = 0; mt < 4; ++mt) { ca[mt] = (f32x4){0.f, 0.f, 0.f, 0.f}; cx[mt] = (f32x4){0.f, 0.f, 0.f, 0.f};
#pragma unroll
        for (int ks = 0; ks < 4; ++ks) { const bf16x8_t af = *(const bf16x8_t*)(xcb + (16 * mt + col) * 136 + 32 * ks + 8 * quad);
            ca[mt] = __builtin_amdgcn_mfma_f32_16x16x32_bf16(af, fa[ks], ca[mt], 0, 0, 0);
            cx[mt] = __builtin_amdgcn_mfma_f32_16x16x32_bf16(af, fx[ks], cx[mt], 0, 0, 0); } }
    float av[4][4], uv[4][4]; float A = 1.f, H = 0.f;
#pragma unroll
    for (int mt = 0; mt < 4; ++mt) {
#pragma unroll
        for (int j = 0; j < 4; ++j) { const int tl = 16 * quad + 4 * mt + j;
            const float xcv = xcf[tl * 132 + 16 * w + col];
            const float r = fsigm(ca[mt][j] + bav), ig = fsigm(cx[mt][j] + bxv);
            const float la = -8.0f * r * sp;
            const float x2 = 2.0f * la;
            float em1 = x2 * (1.0f + x2 * (0.5f + x2 * (0.16666667f + x2 * (0.041666668f + x2 * (0.0083333338f + x2 * (0.0013888889f + x2 * 0.0001984127f))))));
            if (x2 < -0.5f) em1 = expm1f(x2);
            float a_ = __expf(la), u_ = __builtin_amdgcn_sqrtf(-em1) * (ig * xcv);
            if (t0 + tl >= L) { a_ = 1.f; u_ = 0.f; }
            av[mt][j] = a_; uv[mt][j] = u_; H = a_ * H + u_; A *= a_; } }
    float carry = cinv, prod = 1.f, hin = 0.f;
#pragma unroll
    for (int q = 0; q < 4; ++q) {
        if (quad == q) hin = carry;
        const float nw = A * carry + H, np = A * prod;
        carry = __shfl(nw, q * 16 + col); prod = __shfl(np, q * 16 + col); }
    if (!FINAL) {
        if (quad == 0) { Aend[(size_t)ch * CP + c] = prod; Hend[(size_t)ch * CP + c] = carry; }
    } else {
        float h = hin;
#pragma unroll
        for (int mt = 0; mt < 4; ++mt)
#pragma unroll
            for (int j = 0; j < 4; ++j) { h = av[mt][j] * h + uv[mt][j]; xcf[(16 * quad + 4 * mt + j) * 132 + 16 * w + col] = h; }
        __syncthreads();
#pragma unroll
        for (int half = 0; half < 2; ++half) { const int tl = tr + 32 * half, t = t0 + tl;
            if (t >= NMETA && t < L) {
                const float4 h0 = *(const float4*)(xcf + tl * 132 + 8 * c8), h1 = *(const float4*)(xcf + tl * 132 + 8 * c8 + 4);
                const uint4 gg = g[half];
                uint4 pk; pk.x = cvt_pk_bf16(bflo(gg.x) * h0.x, bfhi(gg.x) * h0.y); pk.y = cvt_pk_bf16(bflo(gg.y) * h0.z, bfhi(gg.y) * h0.w);
                pk.z = cvt_pk_bf16(bflo(gg.z) * h1.x, bfhi(gg.z) * h1.y); pk.w = cvt_pk_bf16(bflo(gg.w) * h1.z, bfhi(gg.w) * h1.w);
                *(uint4*)(YY + (size_t)t * RNN_W + ch0 + 8 * c8) = pk; } }
    }
}
template <bool FINAL>
DEVI void rglru_phase(const bf16_t* __restrict__ XR, const bf16_t* __restrict__ GATEg, const bf16_t* __restrict__ Wta, const bf16_t* __restrict__ Wtx,
                      const float* __restrict__ cw, const float* __restrict__ cb, const float* __restrict__ ba, const float* __restrict__ bx, const float* __restrict__ lam,
                      float* __restrict__ Aend, float* __restrict__ Hend, const float* __restrict__ CIN, bf16_t* __restrict__ YY, unsigned char* lds) {
    const int tid = otid(), lane = tid & 63, w = tid >> 6, col = lane & 15, quad = lane >> 4;
    const int G = gridDim.x, nb = blockIdx.x % RNN_NB, rank = blockIdx.x / RNN_NB, nblk = (G - nb + RNN_NB - 1) / RNN_NB;
    const int ch0 = nb * RNN_BW, ch = ch0 + 16 * w + col;
    float* cwl = (float*)(lds + 64 * 136 * 2 + 64 * 132 * 4);
    __syncthreads();
    for (int i = tid; i < 640; i += NTHREADS) cwl[i] = i < 512 ? cw[(i >> 7) * RNN_W + ch0 + (i & 127)] : cb[ch0 + (i - 512)];
    bf16x8_t fa[4], fx[4];
    { const size_t wrow = ((size_t)nb * 128 + 16 * w + col) * 128 + 8 * quad;
#pragma unroll
      for (int ks = 0; ks < 4; ++ks) { fa[ks] = *(const bf16x8_t*)(Wta + wrow + 32 * ks); fx[ks] = *(const bf16x8_t*)(Wtx + wrow + 32 * ks); } }
    const float bav = ba[ch], bxv = bx[ch], sp = log1pf(expf(-lam[ch]));
    RgIn Ra, Rb;
    int c = rank;
    if (c < NCHUNK) rglru_fetch(c, ch0, XR, tid, Ra);
    while (c < NCHUNK) {
        int cn = c + nblk;
        if (cn < NCHUNK) rglru_fetch(cn, ch0, XR, tid, Rb);
        rglru_unit<FINAL>(c, nb, Ra, fa, fx, bav, bxv, sp, GATEg, Aend, Hend, CIN, YY, lds, tid);
        c = cn; if (c >= NCHUNK) break;
        cn = c + nblk;
        if (cn < NCHUNK) rglru_fetch(cn, ch0, XR, tid, Ra);
        rglru_unit<FINAL>(c, nb, Rb, fa, fx, bav, bxv, sp, GATEg, Aend, Hend, CIN, YY, lds, tid);
        c = cn;
    }
    __syncthreads();
}

constexpr int SW = 544;
constexpr int CB = 512;
constexpr int NTILE = L / 16;
typedef float f32x16 __attribute__((ext_vector_type(16)));
typedef float f32x2v __attribute__((ext_vector_type(2)));
constexpr int HROW = 2112;
constexpr int IL_HIST = 0, IL_CKEY = 0, IL_CIDX = 16 * CB * 4, IL_HIST2 = 2 * 16 * CB * 4, IL_ROWS = IL_HIST2 + 16 * 256 * 4, IL_WI = 16 * HROW * 4, IL_QST = IL_WI + 512, IL_QST2 = IL_QST + 256, IL_CCNT = IL_QST2 + 256, IL_FLAG = IL_CCNT + 64;
constexpr int IL_QF = IL_ROWS + 16 * SW * 4;
constexpr int AT_LB = 1280;
static_assert(IL_QF + 8 * AT_LB <= IL_WI && IL_FLAG + 64 <= LDS_BYTES - 16, "indexer LDS");

constexpr int AW_BYTES = 512;
typedef short s16x2 __attribute__((ext_vector_type(2)));
DEVI float dot2bf(unsigned a, unsigned b, float c) { return __builtin_amdgcn_fdot2_f32_bf16(__builtin_bit_cast(s16x2, a), __builtin_bit_cast(s16x2, b), c, false); }
#define LDS_FENCE() asm volatile("s_waitcnt lgkmcnt(0)" ::: "memory")

struct AttnQ { float m, l, o[8]; };

DEVI void attn_issue(int b0, const unsigned* lst, const unsigned char* __restrict__ KV8, unsigned lane16, uint4 (&kv)[8]) {
    const uint4 o0 = *(const uint4*)(lst + b0), o1 = *(const uint4*)(lst + b0 + 4);
    const unsigned o[8] = {o0.x, o0.y, o0.z, o0.w, o1.x, o1.y, o1.z, o1.w};
#pragma unroll
    for (int kk = 0; kk < 8; ++kk) kv[kk] = *(const uint4*)(KV8 + (o[kk] + lane16));
}
template <bool MASK>
DEVI void attn_compute(AttnQ& S, int b0, int n, const float (&q)[8], const uint4 (&kv)[8], int ch) {
    float sc[8]; float mx = S.m;
#pragma unroll
    for (int u = 0; u < 8; ++u) {
        const f32x2v k0 = __builtin_amdgcn_cvt_pk_f32_fp8((int)kv[u].x, false), k1 = __builtin_amdgcn_cvt_pk_f32_fp8((int)kv[u].x, true),
                     k2 = __builtin_amdgcn_cvt_pk_f32_fp8((int)kv[u].y, false), k3 = __builtin_amdgcn_cvt_pk_f32_fp8((int)kv[u].y, true);
        f32x2v d2 = k0 * (f32x2v){q[0], q[1]}; d2 = k1 * (f32x2v){q[2], q[3]} + d2; d2 = k2 * (f32x2v){q[4], q[5]} + d2; d2 = k3 * (f32x2v){q[6], q[7]} + d2;
        float d = d2[0] + d2[1];
        d += dpp_f<0xB1>(d); d += dpp_f<0x4E>(d); d += dpp_f<0x141>(d);
        sc[u] = (!MASK || b0 + u < n) ? d : -INFINITY;
        mx = fmaxf(mx, sc[u]); }
    const float scale = __builtin_amdgcn_exp2f(S.m - mx);
    float ls = S.l * scale;
#pragma unroll
    for (int i = 0; i < 8; ++i) S.o[i] *= scale;
    float my = sc[0];
#pragma unroll
    for (int k = 1; k < 8; ++k) my = (ch == k) ? sc[k] : my;
    const int pmy = __float_as_int(__builtin_amdgcn_exp2f(my - mx));
    float pv[8];
    pv[0] = __int_as_float(__builtin_amdgcn_ds_swizzle(pmy, 0x18 | (0 << 5))); pv[1] = __int_as_float(__builtin_amdgcn_ds_swizzle(pmy, 0x18 | (1 << 5)));
    pv[2] = __int_as_float(__builtin_amdgcn_ds_swizzle(pmy, 0x18 | (2 << 5))); pv[3] = __int_as_float(__builtin_amdgcn_ds_swizzle(pmy, 0x18 | (3 << 5)));
    pv[4] = __int_as_float(__builtin_amdgcn_ds_swizzle(pmy, 0x18 | (4 << 5))); pv[5] = __int_as_float(__builtin_amdgcn_ds_swizzle(pmy, 0x18 | (5 << 5)));
    pv[6] = __int_as_float(__builtin_amdgcn_ds_swizzle(pmy, 0x18 | (6 << 5))); pv[7] = __int_as_float(__builtin_amdgcn_ds_swizzle(pmy, 0x18 | (7 << 5)));
#pragma unroll
    for (int u = 0; u < 8; ++u) {
        const float p = pv[u]; ls += p;
        const f32x2v v0 = __builtin_amdgcn_cvt_pk_f32_fp8((int)kv[u].z, false), v1 = __builtin_amdgcn_cvt_pk_f32_fp8((int)kv[u].z, true),
                     v2 = __builtin_amdgcn_cvt_pk_f32_fp8((int)kv[u].w, false), v3 = __builtin_amdgcn_cvt_pk_f32_fp8((int)kv[u].w, true);
        S.o[0] += p * v0[0]; S.o[1] += p * v0[1]; S.o[2] += p * v1[0]; S.o[3] += p * v1[1]; S.o[4] += p * v2[0]; S.o[5] += p * v2[1]; S.o[6] += p * v3[0]; S.o[7] += p * v3[1]; }
    S.l = ls; S.m = mx;
}

DEVI void attn_query(int t, const bf16_t* __restrict__ Qb, const unsigned char* __restrict__ KV8,
                     const unsigned* SR  , bf16_t* __restrict__ AO, unsigned char* wl, int lane) {
    unsigned* lst = (unsigned*)wl;
    LDS_FENCE();
    const int nw = (t >> 5) + 1; int base = 0;
    for (int w0 = 0; w0 < nw; w0 += 64) {
        const int wi = w0 + lane; const unsigned wv = wi < nw ? SR[wi] : 0u;
        const int pc = __popc(wv); int pre = pc;
#pragma unroll
        for (int off = 1; off < 64; off <<= 1) { const int o_ = __shfl_up(pre, off); if (lane >= off) pre += o_; }
        int pos = base + pre - pc; unsigned mm = wv;
        while (mm) { const int bpos = __ffs((int)mm) - 1; mm &= mm - 1u; if (pos < TOPK) lst[pos] = (unsigned)(wi * 32 + bpos) << 10; ++pos; }
        base += __shfl(pre, 63);
    }
    const int n = base < TOPK ? base : TOPK;
    float q[8];
    { const uint4 qv = ((const uint4*)(Qb + (size_t)t * 512))[lane]; const float qs = 0.18033688011112042f;
      q[0] = bflo(qv.x) * qs; q[1] = bfhi(qv.x) * qs; q[2] = bflo(qv.y) * qs; q[3] = bfhi(qv.y) * qs; q[4] = bflo(qv.z) * qs; q[5] = bfhi(qv.z) * qs; q[6] = bflo(qv.w) * qs; q[7] = bfhi(qv.w) * qs; }
    LDS_FENCE();
    { const unsigned lastk = lst[n - 1]; if (lane < 40) lst[n + lane] = lastk; }
    LDS_FENCE();
    AttnQ S; S.m = -INFINITY; S.l = 0.f;
#pragma unroll
    for (int d = 0; d < 8; ++d) S.o[d] = 0.f;
    uint4 ka[8], kb_[8], kc[8];
    const unsigned lane16 = (unsigned)lane * 16u; const int chq = lane & 7;
#define AT_COMP(b, kv) do { if ((b) + 8 <= n) attn_compute<false>(S, (b), n, q, kv, chq); else attn_compute<true>(S, (b), n, q, kv, chq); } while (0)
    attn_issue(0, lst, KV8, lane16, ka);
    if (8 < n) attn_issue(8, lst, KV8, lane16, kb_);
    for (int b0 = 0; b0 < n; b0 += 24) {
        if (b0 + 16 < n) attn_issue(b0 + 16, lst, KV8, lane16, kc);
        AT_COMP(b0, ka);
        if (b0 + 8 < n) {
            if (b0 + 24 < n) attn_issue(b0 + 24, lst, KV8, lane16, ka);
            AT_COMP(b0 + 8, kb_);
            if (b0 + 16 < n) {
                if (b0 + 32 < n) attn_issue(b0 + 32, lst, KV8, lane16, kb_);
                AT_COMP(b0 + 16, kc);
            }
        }
    }
    const int hd = lane >> 3, ch = lane & 7;
    const float inv = 1.0f / S.l;
    uint4 pk; pk.x = cvt_pk_bf16(S.o[0] * inv, S.o[1] * inv); pk.y = cvt_pk_bf16(S.o[2] * inv, S.o[3] * inv); pk.z = cvt_pk_bf16(S.o[4] * inv, S.o[5] * inv); pk.w = cvt_pk_bf16(S.o[6] * inv, S.o[7] * inv);
    *(uint4*)(AO + (size_t)t * 1024 + 512 + hd * 64 + ch * 8) = pk;
}

DEVI float relu_i(float x) { const int v = __float_as_int(x); return __int_as_float(v > 0 ? v : 0); }
DEVI int hpos(unsigned w) { return (int)(w + (w >> 5)); }
template <int PASS, bool L0>
DEVI void idx_sweep(int q0, int nkb, int wave, int lane, const bf16x8_t (&Af)[4][4], const bf16_t* __restrict__ KI, unsigned char* lds, unsigned* __restrict__ SELM) {
    const int l31 = lane & 31, h2 = lane >> 5;
    unsigned* hist = (unsigned*)(lds + IL_HIST);
    const float* wiL = (const float*)(lds + IL_WI);
    const uint4* qst = (const uint4*)(lds + IL_QST);
    const uint4* qst2 = (const uint4*)(lds + IL_QST2);
    unsigned* ckey = (unsigned*)(lds + IL_CKEY); unsigned* cidx = (unsigned*)(lds + IL_CIDX); unsigned* ccnt = (unsigned*)(lds + IL_CCNT); unsigned* rows = (unsigned*)(lds + IL_ROWS);
    const bf16_t* kp = KI + (size_t)l31 * 64 + 8 * h2;
    bf16x8_t Bn[4];
    if (wave < nkb) {
#pragma unroll
        for (int ks = 0; ks < 4; ++ks) Bn[ks] = *(const bf16x8_t*)(kp + (size_t)wave * 2048 + 16 * ks); }
    for (int kb = wave; kb < nkb; kb += 8) {
        const int s = kb * 32 + l31;
        bf16x8_t Bf[4];
#pragma unroll
        for (int ks = 0; ks < 4; ++ks) Bf[ks] = Bn[ks];
        if (kb + 8 < nkb) {
#pragma unroll
            for (int ks = 0; ks < 4; ++ks) Bn[ks] = *(const bf16x8_t*)(kp + (size_t)(kb + 8) * 2048 + 16 * ks); }
        f32x16 acc[4];
#pragma unroll
        for (int rb = 0; rb < 4; ++rb) {
#pragma unroll
            for (int i = 0; i < 16; ++i) acc[rb][i] = 0.f; }
#pragma unroll
        for (int ks = 0; ks < 4; ++ks) acc[0] = __builtin_amdgcn_mfma_f32_32x32x16_bf16(Af[0][ks], Bf[ks], acc[0], 0, 0, 0);
        const bool edge = kb * 32 + 31 > q0;
        float4 wn[2][2]; uint4 stn[2];
#pragma unroll
        for (int e = 0; e < 2; ++e) { wn[e][0] = *(const float4*)(wiL + (2 * h2 + e) * 8); wn[e][1] = *(const float4*)(wiL + (2 * h2 + e) * 8 + 4);
            if (PASS == 2) stn[e] = qst2[2 * h2 + e]; else if (!L0) stn[e] = qst[2 * h2 + e]; }
#pragma unroll
        for (int rb = 0; rb < 4; ++rb) {
            if (rb + 1 < 4) {
#pragma unroll
                for (int ks = 0; ks < 4; ++ks) acc[rb + 1] = __builtin_amdgcn_mfma_f32_32x32x16_bf16(Af[rb + 1][ks], Bf[ks], acc[rb + 1], 0, 0, 0); }
            const int qa = 4 * rb + 2 * h2;
            float4 w[2][2]; uint4 st[2];
#pragma unroll
            for (int e = 0; e < 2; ++e) { w[e][0] = wn[e][0]; w[e][1] = wn[e][1]; st[e] = stn[e]; }
            if (rb + 1 < 4) {
#pragma unroll
                for (int e = 0; e < 2; ++e) { wn[e][0] = *(const float4*)(wiL + (qa + 4 + e) * 8); wn[e][1] = *(const float4*)(wiL + (qa + 4 + e) * 8 + 4);
                    if (PASS == 2) stn[e] = qst2[qa + 4 + e]; else if (!L0) stn[e] = qst[qa + 4 + e]; } }
#pragma unroll
            for (int e = 0; e < 2; ++e) {
                const int qs = qa + e;
                f32x2v s2 = (f32x2v){relu_i(acc[rb][8 * e + 0]), relu_i(acc[rb][8 * e + 1])} * (f32x2v){w[e][0].x, w[e][0].y};
                s2 = (f32x2v){relu_i(acc[rb][8 * e + 2]), relu_i(acc[rb][8 * e + 3])} * (f32x2v){w[e][0].z, w[e][0].w} + s2;
                s2 = (f32x2v){relu_i(acc[rb][8 * e + 4]), relu_i(acc[rb][8 * e + 5])} * (f32x2v){w[e][1].x, w[e][1].y} + s2;
                s2 = (f32x2v){relu_i(acc[rb][8 * e + 6]), relu_i(acc[rb][8 * e + 7])} * (f32x2v){w[e][1].z, w[e][1].w} + s2;
                const float sc = s2[0] + s2[1];
                const bool valid = !edge || s <= q0 + qs;
                const unsigned key = f2key(sc);
                if (PASS == 1) {
                    if (L0) { if (valid) { const unsigned bin = key >> 20; atomicAdd(&hist[qs * HROW + hpos(bin >> 1)], (bin & 1u) ? 0x10000u : 1u); } }
                    else if (valid && (key & st[e].x) == st[e].y) { const unsigned bin = (key >> st[e].z) & st[e].w; atomicAdd(&hist[qs * HROW + hpos(bin >> 1)], (bin & 1u) ? 0x10000u : 1u); }
                } else {
                    const bool all = st[e].z == 0xFFFFFFFFu;
                    const bool sel = valid && (all || key >= st[e].y);
                    const bool cnd = valid && !all && key >= st[e].x && key < st[e].y;
                    const unsigned long long bal = __ballot(sel);
                    rows[qs * SW + kb] = h2 ? (unsigned)(bal >> 32) : (unsigned)bal;
                    if (cnd) { const unsigned n = atomicAdd(&ccnt[qs], 1u); if (n < (unsigned)CB) { ckey[qs * CB + n] = key; cidx[qs * CB + n] = (unsigned)s; } }
                }
            }
        }
    }
}

DEVI void indexer_tile(int q0, const bf16_t* __restrict__ QI, const bf16_t* __restrict__ KI, const float* __restrict__ WI, const bf16_t* __restrict__ Qb, const unsigned char* __restrict__ KV8, bf16_t* __restrict__ AO, unsigned char* lds) {
    const int tid = otid(), lane = tid & 63, wave = tid >> 6;
    unsigned* hist = (unsigned*)(lds + IL_HIST);
    float* wiL = (float*)(lds + IL_WI);
    uint4* qst = (uint4*)(lds + IL_QST); uint4* qst2 = (uint4*)(lds + IL_QST2);
    unsigned* ckey = (unsigned*)(lds + IL_CKEY); unsigned* cidx = (unsigned*)(lds + IL_CIDX); unsigned* hist2 = (unsigned*)(lds + IL_HIST2); unsigned* ccnt = (unsigned*)(lds + IL_CCNT);
    volatile unsigned* flag = (volatile unsigned*)(lds + IL_FLAG);
    const int nkb = (q0 + 16 + 31) >> 5;
    bf16x8_t Af[4][4];
    { const int rho = lane & 31, hq = lane >> 5; const int qq = 2 * ((rho >> 2) & 1) + (rho >> 4), head = 4 * ((rho >> 3) & 1) + (rho & 3);
#pragma unroll
      for (int rb = 0; rb < 4; ++rb)
#pragma unroll
          for (int ks = 0; ks < 4; ++ks) Af[rb][ks] = *(const bf16x8_t*)(QI + (size_t)(q0 + 4 * rb + qq) * 512 + head * 64 + 16 * ks + 8 * hq); }
    __syncthreads();
    if (tid < 128) wiL[tid] = WI[(size_t)q0 * 8 + tid] * 0.125f;
    if (tid < 16) { const unsigned z = opq(0u); qst[tid] = make_uint4(z, z, opq(20u), opq(4095u)); qst2[tid] = make_uint4(z, z, opq((unsigned)TOPK), z); ccnt[tid] = z; }
    for (int level = 0; level < 3; ++level) {
        for (int i = tid; i < 16 * HROW / 4; i += NTHREADS) ((uint4*)hist)[i] = make_uint4(0u, 0u, 0u, 0u);
        if (tid == 0) flag[0] = 0u;
        __syncthreads();
        if (level == 0) idx_sweep<1, true>(q0, nkb, wave, lane, Af, KI, lds, nullptr); else idx_sweep<1, false>(q0, nkb, wave, lane, Af, KI, lds, nullptr);
        __syncthreads();
#pragma unroll 1
        for (int qi = 0; qi < 2; ++qi) {
            const int qs = 2 * wave + qi;
            const uint4 st = qst[qs]; const uint4 b = qst2[qs];
            if (st.x == 0xFFFFFFFFu && st.y == 0u && st.w == 0u) continue;
            unsigned wv[32]; unsigned loc = 0u;
#pragma unroll
            for (int i = 0; i < 32; ++i) { wv[i] = hist[qs * HROW + 33 * lane + i]; loc += (wv[i] & 0xFFFFu) + (wv[i] >> 16); }
            unsigned suf = loc;
#pragma unroll
            for (int off = 1; off < 64; off <<= 1) { const unsigned o = __shfl_down(suf, off); if (lane + off < 64) suf += o; }
            const unsigned total = __shfl(suf, 0), above = suf - loc, need = b.z;
            if (level == 0 && total <= need) { if (lane == 0) { qst[qs] = make_uint4(0xFFFFFFFFu, 0u, 0u, 0u); qst2[qs] = make_uint4(0u, 0u, 0xFFFFFFFFu, 0u); } continue; }
            const bool mine = above < need && need <= above + loc;
            unsigned cum = above, c = 0u; int d = 0; bool found = false;
#pragma unroll
            for (int i = 31; i >= 0; --i) {
                const unsigned chi = wv[i] >> 16, clo = wv[i] & 0xFFFFu;
                if (!found && cum + chi >= need) { found = true; d = 64 * lane + 2 * i + 1; c = chi; } if (!found) cum += chi;
                if (!found && cum + clo >= need) { found = true; d = 64 * lane + 2 * i; c = clo; } if (!found) cum += clo; }
            if (mine) {
                const unsigned pval = st.y | ((unsigned)d << st.z), pmask = st.x | (st.w << st.z);
                const unsigned nneed = need - cum;
                const unsigned long long hi64 = (unsigned long long)pval + (1ull << st.z);
                const unsigned hi = hi64 > 0xFFFFFFFFull ? 0xFFFFFFFFu : (unsigned)hi64;
                if (c <= (unsigned)CB || level == 2) { qst[qs] = make_uint4(0xFFFFFFFFu, 0u, 0u, 0u); qst2[qs] = make_uint4(pval, hi, nneed, st.z); }
                else { const unsigned nsh = (level == 0) ? 8u : 0u, ndm = (level == 0) ? 4095u : 255u; qst[qs] = make_uint4(pmask, pval, nsh, ndm); qst2[qs] = make_uint4(pval, hi, nneed, st.z); flag[0] = 1u; }
            }
        }
        __syncthreads();
        if (flag[0] == 0u) break;
        __syncthreads();
    }
    __syncthreads();
    idx_sweep<2, false>(q0, nkb, wave, lane, Af, KI, lds, nullptr);
    asm volatile("s_waitcnt vmcnt(0)" ::: "memory");
    __syncthreads();
    unsigned* rows = (unsigned*)(lds + IL_ROWS);
#pragma unroll 1
    for (int qi = 0; qi < 2; ++qi) {
        const int qs = 2 * wave + qi;
        const uint4 b = qst2[qs];
        unsigned* row = rows + qs * SW;
        if (b.z != 0xFFFFFFFFu) {
            const unsigned need = b.z; const unsigned cn = ccnt[qs]; const int n = (int)(cn < (unsigned)CB ? cn : (unsigned)CB);
            const unsigned rem = b.w;
            const unsigned sh8 = rem > 8u ? rem - 8u : 0u; const unsigned m8 = rem >= 8u ? 255u : ((1u << rem) - 1u);
#pragma unroll
            for (int i = 0; i < 4; ++i) hist2[qs * 256 + 4 * lane + i] = 0u;
            asm volatile("s_waitcnt lgkmcnt(0)" ::: "memory");
            for (int i = lane; i < n; i += 64) atomicAdd(&hist2[qs * 256 + ((ckey[qs * CB + i] >> sh8) & m8)], 1u);
            asm volatile("s_waitcnt lgkmcnt(0)" ::: "memory");
            unsigned c4[4]; unsigned loc = 0u;
#pragma unroll
            for (int i = 0; i < 4; ++i) { c4[i] = hist2[qs * 256 + 4 * lane + i]; loc += c4[i]; }
            unsigned suf = loc;
#pragma unroll
            for (int off = 1; off < 64; off <<= 1) { const unsigned o = __shfl_down(suf, off); if (lane + off < 64) suf += o; }
            const unsigned above = suf - loc;
            const bool mine = above < need && need <= above + loc;
            unsigned b2 = 0u, need2 = 0u;
            if (mine) { unsigned cum = above; int i = 3; for (; i > 0; --i) { if (cum + c4[i] >= need) break; cum += c4[i]; } b2 = 4u * lane + i; need2 = need - cum; }
            const unsigned long long mb = __ballot(mine);
            if (mb == 0ull) {
                for (int i = lane; i < n; i += 64) if ((unsigned)i < need) { const unsigned ii = cidx[qs * CB + i]; atomicOr(&row[ii >> 5], 1u << (ii & 31u)); }
            } else {
                const int src = __ffsll((long long)mb) - 1;
                b2 = __shfl(b2, src); need2 = __shfl(need2, src);
                for (int i0 = 0; i0 < n; i0 += 64) {
                    const int i = i0 + lane; const bool act = i < n;
                    const unsigned ki = act ? ckey[qs * CB + i] : 0u, ii = act ? cidx[qs * CB + i] : 0u; const unsigned d8 = (ki >> sh8) & m8;
                    if (act && d8 > b2) atomicOr(&row[ii >> 5], 1u << (ii & 31u));
                    unsigned long long tie = __ballot(act && d8 == b2);
                    while (tie) {
                        const int ml = __ffsll((long long)tie) - 1; tie &= tie - 1ull;
                        const unsigned km = __shfl(ki, ml), im = __shfl(ii, ml);
                        unsigned rank = 0u;
                        for (int j0 = 0; j0 < n; j0 += 64) { const int j = j0 + lane; bool beats = false;
                            if (j < n) { const unsigned kj = ckey[qs * CB + j], ij = cidx[qs * CB + j]; beats = ((kj >> sh8) & m8) == b2 && (kj > km || (kj == km && ij < im)); }
                            rank += (unsigned)__popcll(__ballot(beats)); }
                        if (rank < need2 && lane == ml) atomicOr(&row[im >> 5], 1u << (im & 31u));
                    }
                }
            }
        }
    }
    asm volatile("s_waitcnt lgkmcnt(0)" ::: "memory");
    __syncthreads();
    for (int qi = 0; qi < 2; ++qi) { const int qs = 2 * wave + qi;
        attn_query(q0 + qs, Qb, KV8, rows + qs * SW, AO, lds + IL_QF + wave * AT_LB, lane); }
}

DEVI TrJob moe_job(int j, const float* wg, const float* wu, const float* wd, bf16_t* WGU, bf16_t* WD) {
    TrJob J{};
    if (j < 32 * 256) { const int e = j >> 8, t = j & 255; J.dst = WGU + (size_t)e * 1024 * 1024; J.s0 = wg + (size_t)e * D * DE; J.s1 = wu + (size_t)e * D * DE; J.K = 1024; J.n0 = (t >> 4) * 64; J.k0 = (t & 15) * 64; J.mode = 2; return J; }
    j -= 32 * 256;
    { const int e = j >> 7, t = j & 127; J.dst = WD + (size_t)e * 1024 * 512; J.s0 = wd + (size_t)e * DE * D; J.ld = D; J.K = 512; J.n0 = (t >> 3) * 64; J.k0 = (t & 7) * 64; J.mode = 0; return J; }
}
constexpr int MOE0_ALL = 32 * 256 + 32 * 128, MOE0_P1W = 28, MOE0_P4W = 10;
constexpr int P1_BUSY = (LP / 256) * 13 - 3 * 256, P4_BUSY = 8;
constexpr int MOE0_P7 = 2688;
constexpr int MOE0_P1 = (256 - P1_BUSY) * MOE0_P1W, MOE0_P4 = (256 - P4_BUSY) * MOE0_P4W, MOE0_P0 = MOE0_ALL - MOE0_P1 - MOE0_P4 - MOE0_P7;
static_assert(MOE0_P0 > 0 && P1_BUSY == 77 && MOE0_P0 + MOE0_P1 + MOE0_P4 >= 32 * 256, "tail split (the P7 tail may only write WD)");
constexpr int P10_BUSY = (LP / 256) * 10 - 2 * 256;
constexpr int MOE1_P8 = 1536, MOE1_P10 = (256 - P10_BUSY) * 25, MOE1_P15 = MOE0_ALL - MOE1_P8 - MOE1_P10;
static_assert(P10_BUSY == 138 && MOE1_P8 <= 32 * 256 && MOE1_P15 > 0, "tail split, layer 1");
DEVI void moe_idle(const int* mtiles, int& rank, int& cnt) { const int G = (int)gridDim.x, nun = mtiles[0] * 4, busy = nun % G;
    if (busy == 0) { rank = (int)blockIdx.x; cnt = G; } else { rank = (int)blockIdx.x - busy; cnt = G - busy; } }

__global__ void __launch_bounds__(NTHREADS, 2) fwd(Args a) {
    extern __shared__ __attribute__((aligned(16))) unsigned char lds_raw[];
    float* smf = (float*)lds_raw;
    PG8_LAS unsigned char* ldsp = (PG8_LAS unsigned char*)lds_raw;
    const int nwaves = gridDim.x * 8;
#define PHASE_VARS const int tid = otid(); const int lane = tid & 63, wave = tid >> 6; const int gwave = blockIdx.x * 8 + wave; (void)lane; (void)wave; (void)gwave;
    unsigned char* ws = a.ws;
    unsigned* ctl = (unsigned*)(ws + WS_CTL);
    const int lo = a.ph_lo, hi = a.ph_hi;

    volatile LAS unsigned* bst = (volatile LAS unsigned*)((LAS unsigned char*)lds_raw + (LDS_BYTES - 16));
    if (threadIdx.x == 0) { bst[0] = 0u; bst[1] = 0u; bst[2] = 0u; bst[3] = 0u; }
    __syncthreads();
    XcdBarrier bar; bar.bar = ctl; bar.x = 0; bar.st = bst;
    if (hi - lo > 1) bar = xcd_barrier_post(ctl, bst);
#define IN(k) (lo <= (k) && (k) < hi)
#define SEAM(k) do { if (IN(k) && IN((k) + 1)) xcd_barrier(bar); } while (0)

    const float* x = a.in[0]; const float* meta = a.in[1];
    float* ropeC = (float*)(ws + WS_ROPEC); float* ropeS = (float*)(ws + WS_ROPES);
    int* eid = (int*)(ws + WS_EID); float* gw = (float*)(ws + WS_GW); int* slot = (int*)(ws + WS_SLOT); int* mtiles = (int*)(ws + WS_MTILES);
    unsigned* counts0 = (unsigned*)(ws + CTL_CNT); unsigned* counts1 = counts0 + 32;
    unsigned* cursor0 = (unsigned*)(ws + CTL_CUR); unsigned* cursor1 = cursor0 + 32;
    bf16_t* Wta = (bf16_t*)(ws + WS_WTA); bf16_t* Wtx = (bf16_t*)(ws + WS_WTX);
    float* Aend = (float*)(ws + WS_AEND); float* Hend = (float*)(ws + WS_HEND); float* CIN = (float*)(ws + WS_CIN);
    unsigned char* big = ws + WS_BIG;
    bf16_t* WIN0 = (bf16_t*)(big + R_WIN0); bf16_t* WOUT0 = (bf16_t*)(big + R_WOUT0); bf16_t* WGU = (bf16_t*)(big + R_WGU); bf16_t* WD = (bf16_t*)(big + R_WD);
    bf16_t* WIN1 = (bf16_t*)(big + R_WIN1); bf16_t* WOUT1 = (bf16_t*)(big + R_WOUT1);
    bf16_t* X0b = (bf16_t*)(big + R_A); bf16_t* AO = (bf16_t*)(big + R_A); bf16_t* Xperm = (bf16_t*)(big + R_A); bf16_t* X2b = (bf16_t*)(big + R_A); bf16_t* YY = (bf16_t*)(big + R_A);
    float* H1 = (float*)(big + R_H1); float* H3 = (float*)(big + R_H1); float* H2 = (float*)(big + R_H2); unsigned* SELM = (unsigned*)(big + R_H1); unsigned* SELM2 = (unsigned*)(big + R_H1 + 36 * MiB);
    float* Z = (float*)(big + R_C); bf16_t* Yb = (bf16_t*)(big + R_C); float* Z1 = (float*)(big + R_C);
    unsigned char* KV8 = big + R_K;
    bf16_t* GLU = (bf16_t*)(big + R_GLU); bf16_t* Qb = (bf16_t*)(big + R_Q); bf16_t* Kb = (bf16_t*)(big + R_K); bf16_t* Vb = (bf16_t*)(big + R_V);
    bf16_t* QIb = (bf16_t*)(big + R_QI); bf16_t* KIb = (bf16_t*)(big + R_KI); float* WIf = (float*)(big + R_WI);
    bf16_t* GATEg = (bf16_t*)(big + R_GATE); bf16_t* XRb = (bf16_t*)(big + R_XR);
    bf16_t* Hm = (bf16_t*)(big + R_HM);

    if (IN(0)) { PHASE_VARS;
        const float* w_in = a.in[2]; const float* w_out = a.in[7]; const float* wg = a.in[21]; const float* wu = a.in[22]; const float* wd = a.in[23];
        constexpr int J_IN0 = 52 * 16, J_OUT0 = 16 * 16, J_GU = 32 * 256, J_D = 32 * 128, J_IN1 = 40 * 16, J_OUT1 = 16 * 20, J_GT = 80;
        const float* w_in1 = a.in[8]; const float* w_out1 = a.in[16]; const float* wga = a.in[11]; const float* wgx = a.in[13];
        const int moe_p0 = gridDim.x == 256 ? MOE0_P0 : MOE0_ALL;
        tr_run(J_IN0 + J_OUT0 + moe_p0 + J_IN1 + J_OUT1 + J_GT, [&](int j) -> TrJob {
            TrJob J{};
            if (j < J_IN0) { J.dst = WIN0; J.s0 = w_in; J.K = 1024; J.n0 = (j >> 4) * 64; J.k0 = (j & 15) * 64; J.mode = 1; return J; }
            j -= J_IN0;
            if (j < J_OUT0) { J.dst = WOUT0; J.s0 = w_out; J.ld = D; J.K = 1024; J.n0 = (j >> 4) * 64; J.k0 = (j & 15) * 64; J.mode = 0; return J; }
            j -= J_OUT0;
            if (j < moe_p0) return moe_job(j, wg, wu, wd, WGU, WD);
            j -= moe_p0;
            if (j < J_IN1) { J.dst = WIN1; J.s0 = w_in1; J.ld = 2 * RNN_W; J.K = 1024; J.n0 = (j >> 4) * 64; J.k0 = (j & 15) * 64; J.mode = 0; return J; }
            j -= J_IN1;
            if (j < J_OUT1) { J.dst = WOUT1; J.s0 = w_out1; J.ld = D; J.K = RNN_W; J.n0 = (j / 20) * 64; J.k0 = (j % 20) * 64; J.mode = 0; return J; }
            j -= J_OUT1;
            { const int which = j / 40, r = j % 40; const int nb = r >> 2;
              J.dst = (which ? Wtx : Wta) + (size_t)nb * 128 * 128; J.s0 = (which ? wgx : wga) + (size_t)nb * 128 * 128; J.ld = 128; J.K = 128; J.n0 = ((r >> 1) & 1) * 64; J.k0 = (r & 1) * 64; J.mode = 0; return J; }
        }, smf);
        for (size_t i = (size_t)blockIdx.x * NTHREADS + tid; i < (size_t)LP * 256; i += (size_t)gridDim.x * NTHREADS) {
            const size_t r = i >> 8, c4 = i & 255;
            float4 v = make_float4(0.f, 0.f, 0.f, 0.f);
            if (r < NMETA) v = ((const float4*)meta)[r * 256 + c4]; else if (r < L) v = ((const float4*)x)[(r - NMETA) * 256 + c4];
            ((uint2*)X0b)[i] = make_uint2(cvt_pk_bf16(v.x, v.y), cvt_pk_bf16(v.z, v.w));
        }
        for (int i = blockIdx.x * NTHREADS + tid; i < 2 * 64 * 3 * 64; i += gridDim.x * NTHREADS) {
            const int ln = i & 63, ct = (i >> 6) % 3, ss = (i / 192) & 63, ly = i / (192 * 64);
            const int col = 16 * ct + (ln & 15), k0 = 16 * ss + 4 * (ln >> 4);
            float v[4];
#pragma unroll
            for (int j = 0; j < 4; ++j) v[j] = col < 4 ? a.in[17][(size_t)ly * D * NGRP + (size_t)(k0 + j) * NGRP + col] : col < 36 ? a.in[19][(size_t)ly * D * NE + (size_t)(k0 + j) * NE + (col - 4)] : 0.f;
            ((float4*)(ws + WS_WR))[i] = make_float4(v[0], v[1], v[2], v[3]);
        }
        for (int i = blockIdx.x * NTHREADS + tid; i < LP * 32; i += gridDim.x * NTHREADS) {
            const int p = i >> 5, f = i & 31;
            const float inv = (float)pow(10000.0, -(double)f / 32.0);
            const float ang = (float)p * inv;
            ropeC[i] = (float)cos((double)ang); ropeS[i] = (float)sin((double)ang);
        }
    }
    SEAM(0);
    if (IN(1)) { PHASE_VARS;
        pg8::Gemm g{X0b, WIN0, LP, 3328, 1024}; pg8::StaticOrder S; S.init(LP, 3328, (int)gridDim.x, (int)blockIdx.x);
        EpiIn0 E{GLU, KIb, WIf, ropeC, ropeS, KV8};
        pg8::gemm_phase<EpiIn0, pg8::StaticOrder, GEMM_ALIGN, GEMM_SP2>(ldsp, g, S, E);
        if (gridDim.x == 256 && (int)blockIdx.x >= P1_BUSY) { __syncthreads();
            tr_run(MOE0_P1, [&](int j) -> TrJob { return moe_job(MOE0_P0 + j, a.in[21], a.in[22], a.in[23], WGU, WD); }, smf, (int)blockIdx.x - P1_BUSY, 256 - P1_BUSY); }
    }
    SEAM(1);
    if (IN(2)) { PHASE_VARS;
        const float* cw = a.in[3]; const float* cb = a.in[4]; const float* lg = a.in[5]; const float* lb = a.in[6];
        for (int g4 = gwave; g4 < L / 4; g4 += nwaves) {
            const int t0 = g4 * 4, c0 = lane * 8;
            float acc[4][8], wwin[4][8];
            { const float4 b0 = *(const float4*)(cb + c0), b1 = *(const float4*)(cb + c0 + 4);
#pragma unroll
              for (int q = 0; q < 4; ++q) { acc[q][0] = b0.x; acc[q][1] = b0.y; acc[q][2] = b0.z; acc[q][3] = b0.w; acc[q][4] = b1.x; acc[q][5] = b1.y; acc[q][6] = b1.z; acc[q][7] = b1.w; } }
#pragma unroll
            for (int r = 0; r < CONV_K + 3; ++r) {
                const int tt = t0 - (CONV_K - 1) + r;
                if (r < CONV_K) { const float4 w0 = *(const float4*)(cw + r * CONV_CH + c0), w1 = *(const float4*)(cw + r * CONV_CH + c0 + 4);
                    wwin[r & 3][0] = w0.x; wwin[r & 3][1] = w0.y; wwin[r & 3][2] = w0.z; wwin[r & 3][3] = w0.w; wwin[r & 3][4] = w1.x; wwin[r & 3][5] = w1.y; wwin[r & 3][6] = w1.z; wwin[r & 3][7] = w1.w; }
                if (tt >= 0) {
                    const uint4 xv = *(const uint4*)(GLU + (size_t)tt * 512 + c0);
                    const float x[8] = {bflo(xv.x), bfhi(xv.x), bflo(xv.y), bfhi(xv.y), bflo(xv.z), bfhi(xv.z), bflo(xv.w), bfhi(xv.w)};
#pragma unroll
                    for (int q = 0; q < 4; ++q) { const int j = r - q;
                        if (j >= 0 && j < CONV_K) {
#pragma unroll
                            for (int i = 0; i < 8; ++i) acc[q][i] += wwin[j & 3][i] * x[i]; } }
                }
            }
            float gv[8], bvv[8];
            { const float4 g0 = *(const float4*)(lg + c0), g1 = *(const float4*)(lg + c0 + 4), b0 = *(const float4*)(lb + c0), b1 = *(const float4*)(lb + c0 + 4);
              gv[0] = g0.x; gv[1] = g0.y; gv[2] = g0.z; gv[3] = g0.w; gv[4] = g1.x; gv[5] = g1.y; gv[6] = g1.z; gv[7] = g1.w; bvv[0] = b0.x; bvv[1] = b0.y; bvv[2] = b0.z; bvv[3] = b0.w; bvv[4] = b1.x; bvv[5] = b1.y; bvv[6] = b1.z; bvv[7] = b1.w; }
#pragma unroll
            for (int q = 0; q < 4; ++q) {
                float s_ = 0.f;
#pragma unroll
                for (int i = 0; i < 8; ++i) s_ += acc[q][i];
                const float mu = wave_sum(s_) * (1.0f / 512.0f);
                float qq = 0.f;
#pragma unroll
                for (int i = 0; i < 8; ++i) { const float d = acc[q][i] - mu; qq += d * d; }
                const float rstd = 1.0f / sqrtf(wave_sum(qq) * (1.0f / 512.0f) + LN_EPS);
                float o[8];
#pragma unroll
                for (int i = 0; i < 8; ++i) { const float yv = (acc[q][i] - mu) * rstd * gv[i] + bvv[i]; o[i] = yv * fsigm(yv); }
                uint4 w; w.x = cvt_pk_bf16(o[0], o[1]); w.y = cvt_pk_bf16(o[2], o[3]); w.z = cvt_pk_bf16(o[4], o[5]); w.w = cvt_pk_bf16(o[6], o[7]);
                *(uint4*)(AO + (size_t)(t0 + q) * 1024 + c0) = w;
            }
        }
        { const int b = (int)blockIdx.x, G = (int)gridDim.x; const int p = b & 3; const bool rev = (b >> 2) & 1;
          const int nfull = NTILE / G;
          for (int k = 0; k < nfull; ++k) {
              const int r = (nfull == 4) ? ((rev ? p - k : p + k) & 3) : k;
              const int idx = r * G + ((r & 1) ? G - 1 - b : b);
              indexer_tile((NTILE - 1 - idx) * 16, QIb, KIb, WIf, Qb, KV8, AO, lds_raw);
          }
          for (int idx = nfull * G + b; idx < NTILE; idx += G) indexer_tile((NTILE - 1 - idx) * 16, QIb, KIb, WIf, Qb, KV8, AO, lds_raw);
        }
    }
    SEAM(2);
    SEAM(3);
    if (IN(4)) { PHASE_VARS;
        pg8::Gemm g{AO, WOUT0, SEQ, 1024, 1024}; pg8::StaticOrder S; S.init(SEQ, 1024, (int)gridDim.x, (int)blockIdx.x);
        EpiRes0 E{x, meta, Z};
        pg8::gemm_phase<EpiRes0, pg8::StaticOrder, GEMM_ALIGN, GEMM_SP2>(ldsp, g, S, E);
        const int G = (int)gridDim.x, nsk = G >= 16 ? 8 : G;
        if ((int)blockIdx.x >= G - nsk) {
            for (int tl = ((int)blockIdx.x - (G - nsk)) * 8 + wave; tl < 64; tl += nsk * 8) {
                const int col = lane & 15, quad = lane >> 4, n0 = 16 * tl;
                const bf16_t* ap = AO + (size_t)(SEQ + col) * 1024 + 8 * quad; const bf16_t* bp = WOUT0 + (size_t)(n0 + col) * 1024 + 8 * quad;
                f32x4 c0 = {0.f, 0.f, 0.f, 0.f}, c1 = {0.f, 0.f, 0.f, 0.f};
#pragma unroll 8
                for (int ks = 0; ks < 32; ks += 2) {
                    c0 = __builtin_amdgcn_mfma_f32_16x16x32_bf16(*(const bf16x8_t*)(ap + 32 * ks), *(const bf16x8_t*)(bp + 32 * ks), c0, 0, 0, 0);
                    c1 = __builtin_amdgcn_mfma_f32_16x16x32_bf16(*(const bf16x8_t*)(ap + 32 * ks + 32), *(const bf16x8_t*)(bp + 32 * ks + 32), c1, 0, 0, 0); }
#pragma unroll
                for (int j = 0; j < 4; ++j) { const size_t row = (size_t)SEQ + 4 * quad + j;
                    Z[row * D + n0 + col] = DN_ALPHA * x[(row - NMETA) * D + n0 + col] + (c0[j] + c1[j]); }
            }
        } else if (G == 256) { __syncthreads();
            tr_run(MOE0_P4, [&](int j) -> TrJob { return moe_job(MOE0_P0 + MOE0_P1 + j, a.in[21], a.in[22], a.in[23], WGU, WD); }, smf, (int)blockIdx.x, 256 - 8); }
    }
    SEAM(4);
    if (IN(5)) {
        for (int blk = blockIdx.x; blk < SEQ / 64; blk += gridDim.x)
            ln_route_block(NMETA + 64 * blk, 64, Z, H1, a.in[24], a.in[25], (const float4*)(ws + WS_WR), a.in[18], a.in[20], eid, gw, counts0, smf);
        if (blockIdx.x == gridDim.x - 1)
            ln_route_block(0, NMETA, Z, H1, a.in[24], a.in[25], (const float4*)(ws + WS_WR), a.in[18], a.in[20], eid, gw, counts0, smf);
    }
    SEAM(5);
    if (IN(6)) { PHASE_VARS; moe_dispatch_mfma(H1, eid, counts0, cursor0, slot, mtiles, Xperm, (int*)lds_raw, gwave, nwaves, lane, 0); }
    SEAM(6);
    if (IN(7)) { PHASE_VARS;
        pg8::Gemm g{Xperm, WGU, MAXSLOT, 1024, 1024}; MoeOrder S; S.init(mtiles, (int)gridDim.x, (int)blockIdx.x);
        EpiGateUp E{Hm};
        pg8::gemm_phase<EpiGateUp, MoeOrder, GEMM_ALIGN, GEMM_SP2>(ldsp, g, S, E);
        if (gridDim.x == 256) { int rk, cn; moe_idle(mtiles, rk, cn); if (rk >= 0) { __syncthreads();
            tr_run(MOE0_P7, [&](int j) -> TrJob { return moe_job(MOE0_ALL - MOE0_P7 + j, a.in[21], a.in[22], a.in[23], WGU, WD); }, smf, rk, cn); } }
    }
    SEAM(7);
    if (IN(8)) { PHASE_VARS;
        pg8::Gemm g{Hm, WD, MAXSLOT, 1024, 512}; MoeOrder S; S.init(mtiles, (int)gridDim.x, (int)blockIdx.x);
        EpiDown E{Yb};
        pg8::gemm_phase<EpiDown, MoeOrder, GEMM_ALIGN, GEMM_SP2>(ldsp, g, S, E);
        if (gridDim.x == 256) { int rk, cn; moe_idle(mtiles, rk, cn); if (rk >= 0) { __syncthreads();
            tr_run(MOE1_P8, [&](int j) -> TrJob { return moe_job(j, a.in[21] + (size_t)NE * D * DE, a.in[22] + (size_t)NE * D * DE, a.in[23] + (size_t)NE * DE * D, WGU, WD); }, smf, rk, cn); } }
    }
    SEAM(8);
    if (IN(9)) { PHASE_VARS;
#pragma unroll 2
        for (int t = gwave; t < L; t += nwaves) {
            const int s0 = slot[2 * t], s1 = slot[2 * t + 1]; const float g0 = gw[2 * t], g1 = gw[2 * t + 1];
            float y[16];
            combine_row(y, H1 + (size_t)t * D, Yb + (size_t)s0 * D, Yb + (size_t)s1 * D, g0, g1, lane);
            ln_row1024w(y, a.in[26], a.in[27], lane);
#pragma unroll
            for (int i4 = 0; i4 < 4; ++i4) { *(float4*)(H2 + (size_t)t * D + 256 * i4 + 4 * lane) = make_float4(y[4 * i4], y[4 * i4 + 1], y[4 * i4 + 2], y[4 * i4 + 3]);
                *(uint2*)(X2b + (size_t)t * D + 256 * i4 + 4 * lane) = make_uint2(cvt_pk_bf16(y[4 * i4], y[4 * i4 + 1]), cvt_pk_bf16(y[4 * i4 + 2], y[4 * i4 + 3])); }
        }
        for (int i = blockIdx.x * NTHREADS + tid; i < (LP - L) * D / 8; i += gridDim.x * NTHREADS) ((uint4*)(X2b + (size_t)L * D))[i] = make_uint4(0u, 0u, 0u, 0u);
    }
    SEAM(9);
    if (IN(10)) {
        pg8::Gemm g{X2b, WIN1, LP, 2 * RNN_W, 1024}; pg8::StaticOrder S; S.init(LP, 2 * RNN_W, (int)gridDim.x, (int)blockIdx.x);
        EpiIn1 E{GATEg};
        pg8::gemm_phase<EpiIn1, pg8::StaticOrder, GEMM_ALIGN, GEMM_SP2>(ldsp, g, S, E);
        if (gridDim.x == 256 && (int)blockIdx.x >= P10_BUSY) { __syncthreads();
            tr_run(MOE1_P10, [&](int j) -> TrJob { return moe_job(MOE1_P8 + j, a.in[21] + (size_t)NE * D * DE, a.in[22] + (size_t)NE * D * DE, a.in[23] + (size_t)NE * DE * D, WGU, WD); }, smf, (int)blockIdx.x - P10_BUSY, 256 - P10_BUSY); }
    }
    SEAM(10);
    if (IN(11)) rglru_phase<false>(XRb, GATEg, Wta, Wtx, a.in[9], a.in[10], a.in[12], a.in[14], a.in[15], Aend, Hend, CIN, YY, lds_raw);
    SEAM(11);
    if (IN(12)) { PHASE_VARS;
        for (int ch = gwave; ch < RNN_W; ch += nwaves) {
            float A[5], H[5];
#pragma unroll
            for (int i = 0; i < 5; ++i) { const int c = 5 * lane + i; const bool ok = c < NCHUNK; A[i] = ok ? Aend[(size_t)ch * CP + c] : 1.f; H[i] = ok ? Hend[(size_t)ch * CP + c] : 0.f; }
            float Al = 1.f, Hl = 0.f;
#pragma unroll
            for (int i = 0; i < 5; ++i) { Hl = A[i] * Hl + H[i]; Al *= A[i]; }
#pragma unroll
            for (int off = 1; off < 64; off <<= 1) { const float Ap = __shfl_up(Al, off), Hp = __shfl_up(Hl, off); if (lane >= off) { Hl = Al * Hp + Hl; Al = Al * Ap; } }
            float cin = __shfl_up(Hl, 1); if (lane == 0) cin = 0.f;
#pragma unroll
            for (int i = 0; i < 5; ++i) { const int c = 5 * lane + i; if (c < NCHUNK) { CIN[(size_t)ch * CP + c] = cin; cin = A[i] * cin + H[i]; } }
        }
    }
    SEAM(12);
    if (IN(13)) rglru_phase<true>(XRb, GATEg, Wta, Wtx, a.in[9], a.in[10], a.in[12], a.in[14], a.in[15], Aend, Hend, CIN, YY, lds_raw);
    SEAM(13);
    if (IN(14)) {
        pg8::Gemm g{YY + (size_t)NMETA * RNN_W, WOUT1, SEQ, 1024, RNN_W}; pg8::StaticOrder S; S.init(SEQ, 1024, (int)gridDim.x, (int)blockIdx.x);
        EpiRes1 E{H2 + (size_t)NMETA * D, Z1 + (size_t)NMETA * D};
        pg8::gemm_phase<EpiRes1, pg8::StaticOrder, GEMM_ALIGN, GEMM_SP2>(ldsp, g, S, E);
    }
    SEAM(14);
    if (IN(15)) { PHASE_VARS;
        const float* wg = a.in[21] + (size_t)NE * D * DE; const float* wu = a.in[22] + (size_t)NE * D * DE; const float* wd = a.in[23] + (size_t)NE * DE * D;
        { const int done = gridDim.x == 256 ? MOE1_P8 + MOE1_P10 : 0;
          tr_run(MOE0_ALL - done, [&](int j) -> TrJob { return moe_job(done + j, wg, wu, wd, WGU, WD); }, smf); }
        __syncthreads();
        for (int tb = NMETA + blockIdx.x * 64; tb < L; tb += gridDim.x * 64)
            ln_route_block(tb, (L - tb) < 64 ? (L - tb) : 64, Z1, H3, a.in[24] + D, a.in[25] + D, (const float4*)(ws + WS_WR) + 64 * 3 * 64, a.in[18] + NGRP, a.in[20] + NE, eid, gw, counts1, smf);
    }
    SEAM(15);
    if (IN(16)) { PHASE_VARS; moe_dispatch_mfma(H3, eid, counts1, cursor1, slot, mtiles, Xperm, (int*)lds_raw, gwave, nwaves, lane, 2 * NMETA); }
    SEAM(16);
    if (IN(17)) {
        pg8::Gemm g{Xperm, WGU, MAXSLOT, 1024, 1024}; MoeOrder S; S.init(mtiles, (int)gridDim.x, (int)blockIdx.x);
        EpiGateUp E{Hm};
        pg8::gemm_phase<EpiGateUp, MoeOrder, GEMM_ALIGN, GEMM_SP2>(ldsp, g, S, E);
    }
    SEAM(17);
    if (IN(18)) {
        pg8::Gemm g{Hm, WD, MAXSLOT, 1024, 512}; MoeOrder S; S.init(mtiles, (int)gridDim.x, (int)blockIdx.x);
        EpiDown E{Yb};
        pg8::gemm_phase<EpiDown, MoeOrder, GEMM_ALIGN, GEMM_SP2>(ldsp, g, S, E);
    }
    SEAM(18);
    if (IN(19)) { PHASE_VARS;
#pragma unroll 2
        for (int t = NMETA + gwave; t < L; t += nwaves) {
            const int s0 = slot[2 * t], s1 = slot[2 * t + 1]; const float g0 = gw[2 * t], g1 = gw[2 * t + 1];
            float y[16];
            combine_row(y, H3 + (size_t)t * D, Yb + (size_t)s0 * D, Yb + (size_t)s1 * D, g0, g1, lane);
            ln_row1024w(y, a.in[26] + D, a.in[27] + D, lane);
#pragma unroll
            for (int i4 = 0; i4 < 4; ++i4) *(float4*)(a.out + (size_t)(t - NMETA) * D + 256 * i4 + 4 * lane) = make_float4(y[4 * i4], y[4 * i4 + 1], y[4 * i4 + 2], y[4 * i4 + 3]);
        }
    }
#undef IN
#undef SEAM
}
constexpr int N_PHASES = 20;

extern "C" void kernel_launch(void* const* d_in, const int* in_sizes, int n_in, void* d_out, int out_size, void* d_ws, size_t ws_size, hipStream_t stream) {
    static int grid = 0;
    if (grid == 0) {
        if (n_in != 28 || out_size != SEQ * D || ws_size < WS_END) { fprintf(stderr, "kernel_launch: unexpected shapes n_in %d out %d ws %zu (need %zu)\n", n_in, out_size, ws_size, (size_t)WS_END); grid = -1; return; }
        int dev = 0, cus = 0;
        if (hipGetDevice(&dev) != hipSuccess || hipDeviceGetAttribute(&cus, hipDeviceAttributeMultiprocessorCount, dev) != hipSuccess) { grid = -1; return; }
        if (hipFuncSetAttribute((const void*)fwd, hipFuncAttributeMaxDynamicSharedMemorySize, LDS_BYTES) != hipSuccess) { fprintf(stderr, "kernel_launch: hipFuncSetAttribute failed\n"); grid = -1; return; }
        int per_cu = 0;
        if (hipOccupancyMaxActiveBlocksPerMultiprocessor(&per_cu, (const void*)fwd, NTHREADS, LDS_BYTES) != hipSuccess || per_cu < 1) fprintf(stderr, "kernel_launch: occupancy query says %d\n", per_cu);
        (void)hipGetLastError();
        grid = cus;
    }
    if (grid < 0) return;
    (void)hipMemsetAsync((char*)d_ws + WS_CTL, 0, CTL_BYTES, stream);
    Args a{};
    for (int i = 0; i < 28; ++i) a.in[i] = (const float*)d_in[i];
    a.out = (float*)d_out; a.ws = (unsigned char*)d_ws;
#if N_LAUNCH_MODE == 1
    a.ph_lo = 0; a.ph_hi = N_PHASES;
    hipLaunchKernelGGL(fwd, dim3(grid), dim3(NTHREADS), LDS_BYTES, stream, a);
#else
    for (int p = 0; p < N_PHASES; ++p) { a.ph_lo = p; a.ph_hi = p + 1; hipLaunchKernelGGL(fwd, dim3(grid), dim3(NTHREADS), LDS_BYTES, stream, a); }
#endif
}
```

```cpp
#include <hip/hip_runtime.h>
#include <cstdio>
#include <cstdint>
#include <cmath>

#ifndef GEMM_ALIGN
#define GEMM_ALIGN true
#endif
#ifndef GEMM_SP2
#define GEMM_SP2 true
#endif
#ifndef N_LAUNCH_MODE
#define N_LAUNCH_MODE 1
#endif

#define DEVI __device__ __forceinline__
#define LAS __attribute__((address_space(3)))

constexpr int D = 1024, SEQ = 16384, NMETA = 16, L = SEQ + NMETA;
constexpr int CONV_CH = 512, CONV_K = 31, HD = 64, TOPK = 256;
constexpr int IN_AB = 3144;
constexpr int OFF_AVAL = 0, OFF_AGATE = 512, OFF_Q = 1024, OFF_K = 1536, OFF_V = 2048, OFF_QI = 2560, OFF_KI = 3072, OFF_WI = 3136;
constexpr int RNN_W = 1280, RNN_NB = 10, RNN_BW = 128, RNN_K = 4;
constexpr int NGRP = 4, EPG = 8, NE = 32, DE = 512;
constexpr int NPAIR = 2 * L;
constexpr float LN_EPS = 1e-5f;
constexpr float DN_ALPHA = 1.41421356237f;
constexpr int NTHREADS = 512;
constexpr int LDS_BYTES = 147456;

#define XB_TMO      128
#define XB_XCNT(j)  (256  + 64 * (j))
#define XB_XSUB(j)  (1280 + 64 * (j))
#define XB_XGEN(j)  (2304 + 64 * (j))
#define XB_TOP      3328
#define XB_TOPGEN   3392
#define XCD_BAR_WORDS 3456
#define XB_SPIN_CAP (1u << 22)
DEVI unsigned xb_ld(unsigned* p)              { return __hip_atomic_load(p, __ATOMIC_RELAXED, __HIP_MEMORY_SCOPE_AGENT); }
DEVI unsigned xb_add(unsigned* p, unsigned v) { return __hip_atomic_fetch_add(p, v, __ATOMIC_RELAXED, __HIP_MEMORY_SCOPE_AGENT); }
DEVI unsigned xb_xcc_id() { return (unsigned)__builtin_amdgcn_s_getreg((3 << 11) | 20) & 0xFu; }
#define XB_SPIN(cond, bar) do { unsigned _sp = 0; while (cond) { __builtin_amdgcn_s_sleep(1); \
    if ((++_sp & 255u) == 0u) { if (xb_ld(&(bar)[XB_TMO])) break; if (_sp > XB_SPIN_CAP) { atomicAdd(&(bar)[XB_TMO], 1u); break; } } } } while (0)
struct XcdBarrier { unsigned* bar; unsigned x; volatile LAS unsigned* st; };
DEVI XcdBarrier xcd_barrier_post(unsigned* bar, volatile LAS unsigned* st) {
    XcdBarrier b; b.bar = bar; b.x = xb_xcc_id(); b.st = st;
    if (threadIdx.x == 0) (void)xb_add(&bar[XB_XCNT(b.x)], 1u);
    return b;
}
DEVI void xcd_barrier_complete(unsigned* bar, unsigned x, unsigned& nloc, unsigned& nx) {
    const unsigned G = gridDim.x * gridDim.y * gridDim.z;
    unsigned sum, cnt, mine, sp = 0u;
    for (;;) {
        sum = 0u; cnt = 0u; mine = 0u;
#pragma unroll
        for (unsigned j = 0; j < 16; ++j) { const unsigned c = xb_ld(&bar[XB_XCNT(j)]); sum += c; cnt += (c > 0u) ? 1u : 0u; mine = (j == x) ? c : mine; }
        if (sum == G) break;
        __builtin_amdgcn_s_sleep(1);
        if ((++sp & 255u) == 0u) { if (xb_ld(&bar[XB_TMO])) break; if (sp > XB_SPIN_CAP) { atomicAdd(&bar[XB_TMO], 1u); break; } }
    }
    nloc = mine > 0u ? mine : 1u; nx = cnt > 0u ? cnt : 1u;
}
DEVI void xcd_barrier(const XcdBarrier& b) {
    asm volatile("s_waitcnt vmcnt(0)" ::: "memory");
    __syncthreads();
    if (threadIdx.x == 0) {
        unsigned* bar = b.bar;
        __builtin_amdgcn_s_waitcnt(0);
        unsigned nloc = b.st[0], nx = b.st[1];
        if (nloc == 0u) { xcd_barrier_complete(bar, b.x, nloc, nx); b.st[0] = nloc; b.st[1] = nx; }
        const unsigned old = xb_add(&bar[XB_XSUB(b.x)], 1u);
        const unsigned gen = old / nloc;
        if (old + 1u == (gen + 1u) * nloc) {
            __builtin_amdgcn_fence(__ATOMIC_RELEASE, "agent");
            asm volatile("s_waitcnt vmcnt(0)" ::: "memory");
            const unsigned og = xb_add(&bar[XB_TOP], 1u);
            const unsigned tg = og / nx;
            if (og + 1u == (tg + 1u) * nx) xb_add(&bar[XB_TOPGEN], 1u);
            else XB_SPIN(xb_ld(&bar[XB_TOPGEN]) == tg, bar);
            __builtin_amdgcn_fence(__ATOMIC_ACQUIRE, "agent");
            xb_add(&bar[XB_XGEN(b.x)], 1u);
            asm volatile("s_waitcnt vmcnt(0)" ::: "memory");
        } else {
            XB_SPIN(xb_ld(&bar[XB_XGEN(b.x)]) == gen, bar);
            __builtin_amdgcn_fence(__ATOMIC_ACQUIRE, "agent");
            asm volatile("s_waitcnt vmcnt(0)" ::: "memory");
        }
    }
    __syncthreads();
}

constexpr int LP = 16640;
constexpr int MAXSLOT = 40960;
constexpr int NCHUNK = 257, CP = 272;
constexpr size_t MiB = 1048576;
constexpr size_t WS_CTL = 0;
constexpr size_t CTL_CNT = 16384;
constexpr size_t CTL_CUR = 16384 + 256;
constexpr size_t CTL_BYTES = 32768;
constexpr size_t WS_ROPEC = 32768;
constexpr size_t WS_ROPES = WS_ROPEC + (size_t)LP * 32 * 4;
constexpr size_t WS_EID = WS_ROPES + (size_t)LP * 32 * 4;
constexpr size_t WS_GW = WS_EID + (size_t)NPAIR * 4;
constexpr size_t WS_SLOT = WS_GW + (size_t)NPAIR * 4;
constexpr size_t WS_MTILES = WS_SLOT + (size_t)NPAIR * 4;
constexpr size_t WS_WTA = WS_MTILES + 4096;
constexpr size_t WS_WTX = WS_WTA + (size_t)RNN_NB * 128 * 128 * 2;
constexpr size_t WS_AEND = WS_WTX + (size_t)RNN_NB * 128 * 128 * 2;
constexpr size_t WS_HEND = WS_AEND + (size_t)RNN_W * CP * 4;
constexpr size_t WS_CIN = WS_HEND + (size_t)RNN_W * CP * 4;
constexpr size_t WS_WR = WS_CIN + (size_t)RNN_W * CP * 4;
constexpr size_t WS_BIG = ((WS_WR + (size_t)2 * 64 * 3 * 64 * 16 + 255) / 256) * 256;
constexpr size_t R_WIN0 = 0;
constexpr size_t R_WOUT0 = R_WIN0 + (size_t)3328 * 1024 * 2;
constexpr size_t R_WGU = R_WOUT0 + (size_t)1024 * 1024 * 2;
constexpr size_t R_WD = R_WGU + (size_t)32 * 1024 * 1024 * 2;
constexpr size_t R_WIN1 = R_WD + (size_t)32 * 1024 * 512 * 2;
constexpr size_t R_WOUT1 = R_WIN1 + (size_t)2560 * 1024 * 2;
static_assert(R_WOUT1 + (size_t)1024 * 1280 * 2 <= 112 * MiB, "weights");
constexpr size_t R_A = 112 * MiB;
constexpr size_t R_H1 = 192 * MiB;
constexpr size_t R_H2 = 257 * MiB;
constexpr size_t R_C = 322 * MiB;
constexpr size_t R_GLU = 322 * MiB;
constexpr size_t SZ512 = (size_t)LP * 512 * 2;
constexpr size_t R_Q = R_GLU + SZ512, R_K = R_Q + SZ512, R_V = R_K + SZ512, R_QI = R_V + SZ512, R_KI = R_QI + SZ512, R_WI = R_KI + (size_t)LP * 64 * 2;
static_assert(R_WI + (size_t)LP * 8 * 4 <= 406 * MiB, "in-proj outputs");
constexpr size_t R_GATE = 322 * MiB;
constexpr size_t R_XR = R_GATE + (size_t)LP * 1280 * 2;
static_assert(R_XR + (size_t)LP * 1280 * 2 <= 406 * MiB, "layer-1 in-proj outputs");
constexpr size_t R_HM = 406 * MiB;
constexpr size_t WS_END = WS_BIG + R_HM + (size_t)MAXSLOT * 512 * 2;
static_assert(WS_END <= 512 * MiB, "ws");

struct Args { const float* in[28]; float* out; unsigned char* ws; int ph_lo, ph_hi; };

DEVI unsigned opq(unsigned v) { asm volatile("" : "+v"(v)); return v; }
DEVI int otid() { int v = (int)threadIdx.x; asm volatile("" : "+v"(v)); return v; }
template <int CTRL> DEVI float dpp_f(float v) { return __int_as_float(__builtin_amdgcn_mov_dpp(__float_as_int(v), CTRL, 0xF, 0xF, true)); }
DEVI float wave_sum(float v) {
    v += dpp_f<0xB1>(v); v += dpp_f<0x4E>(v); v += dpp_f<0x141>(v); v += dpp_f<0x140>(v);
    return __int_as_float(__builtin_amdgcn_readlane(__float_as_int(v), 0)) + __int_as_float(__builtin_amdgcn_readlane(__float_as_int(v), 16))
         + __int_as_float(__builtin_amdgcn_readlane(__float_as_int(v), 32)) + __int_as_float(__builtin_amdgcn_readlane(__float_as_int(v), 48));
}
DEVI float wave_max(float v) {
#pragma unroll
    for (int o = 32; o > 0; o >>= 1) v = fmaxf(v, __shfl_xor(v, o));
    return v;
}
DEVI float sigm(float x) { return 1.0f / (1.0f + expf(-x)); }
DEVI float gelu_tanh(float x) { return 0.5f * x * (1.0f + tanhf(0.7978845608028654f * (x + 0.044715f * x * x * x))); }
DEVI unsigned f2key(float f) { const unsigned u = __float_as_uint(f); return u ^ ((unsigned)((int)u >> 31) | 0x80000000u); }

namespace pg8 {
#define PG8_LAS __attribute__((address_space(3)))
typedef unsigned short bf16_t;
typedef short bf16x8 __attribute__((ext_vector_type(8)));
typedef float f32x4 __attribute__((ext_vector_type(4)));
typedef unsigned u32x4 __attribute__((ext_vector_type(4)));
constexpr int BM = 256, BK = 64, HALF = 128, HTB = HALF * BK * 2  , STAGE_BYTES = 8 * HTB, NXCD = 8, WGM = 8;

__host__ __device__ __forceinline__ int lds_byte(int r, int c) { const int st = (r >> 4) * 2 + (c >> 5), rr = r & 15, cc = c & 31, ob = rr * 64 + cc * 2; return st * 1024 + (ob ^ (((ob >> 9) & 1) << 5)); }
__host__ __device__ __forceinline__ void stage_rc(int b, int& R, int& C) { const int st = b / 1024, sb = b % 1024, swz = sb ^ (((sb >> 9) & 1) << 5); R = (st >> 1) * 16 + swz / 64; C = (st & 1) * 32 + (swz % 64) / 2; }
__host__ __device__ __forceinline__ int perm32(int rho) { const int n = rho >> 4, i = rho & 15; return 8 * (i >> 2) + 4 * n + (i & 3); }

struct Unit { int pm, pn; };
struct Gemm { const bf16_t* A; const bf16_t* Bt; int M, N, K; };

struct StaticOrder {
    int nM, nN, nwg, G, c;
    __host__ __device__ void init(int M, int N, int G_, int c_) { nM = M / BM; nN = N / BM; nwg = nM * nN; G = G_; c = c_; }
    __host__ __device__ bool next(int i, Unit& u) const {
        const long L = (long)i * G + c; if (L >= nwg) return false;
        int wgid = (int)L; { const int q = nwg / NXCD, r = nwg % NXCD, xcd = wgid % NXCD, off = wgid / NXCD; wgid = (xcd < r ? xcd * (q + 1) : r * (q + 1) + (xcd - r) * q) + off; }
        const int nig = WGM * nN, gid = wgid / nig, fm = gid * WGM, gsz = (nM - fm) < WGM ? (nM - fm) : WGM;
        u.pm = fm + ((wgid % nig) % gsz); u.pn = (wgid % nig) / gsz; return true;
    }
    __device__ __forceinline__ void a_ready(const Unit&) const {}
    __device__ __forceinline__ void done(const Unit&) const {}
};

template <class Epi, class Sched, bool ALIGN_EPI = false, bool SP2 = false>
__device__ __forceinline__ void gemm_phase(PG8_LAS unsigned char* lds, const Gemm g, const Sched& S, const Epi& E) {
    const int tid = threadIdx.x, wid = __builtin_amdgcn_readfirstlane(tid >> 6), lane = tid & 63, wr = wid >> 2, wc = wid & 3, fr = lane & 15, fq = lane >> 4;
    const int K = g.K, nt = K / BK;
    unsigned voffA[2], voffB[2];
#pragma unroll
    for (int i = 0; i < 2; ++i) { int R, C; stage_rc(tid * 16 + i * 8192, R, C); const int Rb = Epi::PERM ? ((R & ~31) + perm32(R & 31)) : R;
        voffA[i] = (unsigned)(R * K + C) * 2u; voffB[i] = (unsigned)(Rb * K + C) * 2u; }
    const size_t kstep = (size_t)(BK * 2);
    const size_t hstep = (size_t)HALF * K * 2;
    const size_t tstep = 2 * hstep;
    const unsigned ldsw = (unsigned)wid * 1024u;
    const int aoff = lds_byte(wr * 64 + fr, fq * 8), boff = lds_byte(wc * 32 + fr, fq * 8);
#define PG8_SA(b, h) (((b) * 2 + (h)) * HTB)
#define PG8_SB(b, h) ((4 + (b) * 2 + (h)) * HTB)
#define PG8_STAGE(bufoff, gbase, voff) do { _Pragma("unroll") for (int _i = 0; _i < 2; ++_i) \
        __builtin_amdgcn_global_load_lds((const unsigned*)((const char*)(gbase) + (voff)[_i]), (PG8_LAS unsigned*)(lds + (bufoff) + ldsw + _i * 8192), 16, 0, 0); } while (0)
#define PG8_LDA(dst, b, h) do { _Pragma("unroll") for (int m = 0; m < 4; ++m) _Pragma("unroll") for (int k = 0; k < 2; ++k) dst[m][k] = *(const PG8_LAS bf16x8*)(lds + PG8_SA(b, h) + aoff + m * 2048 + k * 1024); } while (0)
#define PG8_LDB(dst, b, h) do { _Pragma("unroll") for (int n = 0; n < 2; ++n) _Pragma("unroll") for (int k = 0; k < 2; ++k) dst[n][k] = *(const PG8_LAS bf16x8*)(lds + PG8_SB(b, h) + boff + n * 2048 + k * 1024); } while (0)
#define PG8_MMA(ai, bj, At, Bt) do { __builtin_amdgcn_s_setprio(1); _Pragma("unroll") for (int m = 0; m < 4; ++m) _Pragma("unroll") for (int n = 0; n < 2; ++n) _Pragma("unroll") for (int k = 0; k < 2; ++k) \
        acc[ai][bj][m][n] = __builtin_amdgcn_mfma_f32_16x16x32_bf16(Bt[n][k], At[m][k], acc[ai][bj][m][n], 0, 0, 0); __builtin_amdgcn_s_setprio(0); } while (0)
#define PG8_WAIT_V(n) asm volatile("s_waitcnt vmcnt(" #n ")" ::: "memory")
#define PG8_WAIT_L(n) asm volatile("s_waitcnt lgkmcnt(" #n ")" ::: "memory")
#define PG8_BAR __builtin_amdgcn_s_barrier()
#define PG8_SCHED __builtin_amdgcn_sched_barrier(0)
    Unit cur, nxt; int ui = 0;
    if (!S.next(0, cur)) return;
    f32x4 acc[2][2][4][2];
#pragma unroll
    for (int a = 0; a < 2; ++a)
#pragma unroll
        for (int b = 0; b < 2; ++b)
#pragma unroll
            for (int m = 0; m < 4; ++m)
#pragma unroll
                for (int n = 0; n < 2; ++n) acc[a][b][m][n] = (f32x4){0.f, 0.f, 0.f, 0.f};
    bf16x8 At[4][2], B0[2][2], B1[2][2];
    const char* cA = (const char*)g.A + (size_t)cur.pm * tstep; const char* cB = (const char*)g.Bt + (size_t)cur.pn * tstep;
    S.a_ready(cur);
    if constexpr (SP2) {
        PG8_STAGE(PG8_SB(0, 0), cB, voffB); PG8_STAGE(PG8_SB(0, 1), cB + hstep, voffB); PG8_STAGE(PG8_SA(0, 0), cA, voffA); PG8_STAGE(PG8_SA(0, 1), cA + hstep, voffA);
        if (wr == 1) PG8_BAR;
        PG8_WAIT_V(2); PG8_BAR;
        PG8_STAGE(PG8_SB(1, 0), cB + kstep, voffB); PG8_STAGE(PG8_SA(1, 0), cA + kstep, voffA); PG8_STAGE(PG8_SB(1, 1), cB + hstep + kstep, voffB);
        PG8_WAIT_V(6); PG8_BAR;
    } else {
        PG8_STAGE(PG8_SB(0, 0), cB, voffB); PG8_STAGE(PG8_SA(0, 0), cA, voffA); PG8_STAGE(PG8_SB(0, 1), cB + hstep, voffB); PG8_STAGE(PG8_SA(0, 1), cA + hstep, voffA);
        if (wr == 1) PG8_BAR;
        PG8_WAIT_V(4); PG8_BAR;
        PG8_STAGE(PG8_SB(1, 0), cB + kstep, voffB); PG8_STAGE(PG8_SA(1, 0), cA + kstep, voffA); PG8_STAGE(PG8_SB(1, 1), cB + hstep + kstep, voffB);
        PG8_WAIT_V(6); PG8_BAR;
    }
    for (;;) {
        const bool has_next = S.next(ui + 1, nxt);
        const char* nA = has_next ? (const char*)g.A + (size_t)nxt.pm * tstep : cA; const char* nB = has_next ? (const char*)g.Bt + (size_t)nxt.pn * tstep : cB;
        for (int t = 0; t < nt; t += 2) {
            const bool last = (t == nt - 2);
            const char* a1 = cA + (size_t)(t + 1) * kstep;
            const char* a2 = last ? nA : cA + (size_t)(t + 2) * kstep; const char* b2 = last ? nB : cB + (size_t)(t + 2) * kstep;
            const char* a3 = a2 + kstep; const char* b3 = b2 + kstep;
            if (last && has_next) S.a_ready(nxt);
            if constexpr (SP2) {
            PG8_LDB(B0, 0, 0); PG8_LDB(B1, 0, 1); PG8_SCHED; PG8_LDA(At, 0, 0); PG8_STAGE(PG8_SA(1, 1), a1 + hstep, voffA);
            PG8_WAIT_V(8); PG8_WAIT_L(0); PG8_BAR; PG8_MMA(0, 0, At, B0); PG8_MMA(0, 1, At, B1); PG8_BAR; PG8_SCHED;
            PG8_LDA(At, 0, 1); PG8_STAGE(PG8_SB(0, 0), b2, voffB); PG8_STAGE(PG8_SB(0, 1), b2 + hstep, voffB); PG8_STAGE(PG8_SA(0, 0), a2, voffA);
            PG8_WAIT_V(8); PG8_WAIT_L(0); PG8_BAR; PG8_MMA(1, 0, At, B0); PG8_MMA(1, 1, At, B1); PG8_BAR; PG8_SCHED;
            PG8_LDB(B0, 1, 0); PG8_LDB(B1, 1, 1); PG8_SCHED; PG8_LDA(At, 1, 0); PG8_STAGE(PG8_SA(0, 1), a2 + hstep, voffA);
            PG8_WAIT_V(8); PG8_WAIT_L(0); PG8_BAR; PG8_MMA(0, 0, At, B0); PG8_MMA(0, 1, At, B1); PG8_BAR; PG8_SCHED;
            PG8_LDA(At, 1, 1); PG8_STAGE(PG8_SB(1, 0), b3, voffB); PG8_STAGE(PG8_SB(1, 1), b3 + hstep, voffB); PG8_STAGE(PG8_SA(1, 0), a3, voffA);
            PG8_WAIT_V(8); PG8_WAIT_L(0); PG8_BAR; PG8_MMA(1, 0, At, B0); PG8_MMA(1, 1, At, B1); PG8_BAR; PG8_SCHED;
            } else {
            PG8_LDB(B0, 0, 0); PG8_SCHED; PG8_LDA(At, 0, 0); PG8_STAGE(PG8_SA(1, 1), a1 + hstep, voffA);
            PG8_WAIT_L(8); PG8_BAR; PG8_WAIT_L(0); PG8_MMA(0, 0, At, B0); PG8_BAR; PG8_SCHED;
            PG8_LDB(B1, 0, 1); PG8_STAGE(PG8_SB(0, 0), b2, voffB);
            PG8_BAR; PG8_WAIT_L(0); PG8_MMA(0, 1, At, B1); PG8_BAR;
            PG8_LDA(At, 0, 1); PG8_STAGE(PG8_SA(0, 0), a2, voffA);
            PG8_BAR; PG8_WAIT_L(0); PG8_MMA(1, 0, At, B0); PG8_BAR; PG8_SCHED;
            PG8_STAGE(PG8_SB(0, 1), b2 + hstep, voffB);
            PG8_WAIT_V(6); PG8_BAR; PG8_MMA(1, 1, At, B1); PG8_BAR;
            PG8_LDB(B0, 1, 0); PG8_SCHED; PG8_LDA(At, 1, 0); PG8_STAGE(PG8_SA(0, 1), a2 + hstep, voffA);
            PG8_WAIT_L(8); PG8_BAR; PG8_WAIT_L(0); PG8_MMA(0, 0, At, B0); PG8_BAR; PG8_SCHED;
            PG8_LDB(B1, 1, 1); PG8_STAGE(PG8_SB(1, 0), b3, voffB);
            PG8_BAR; PG8_WAIT_L(0); PG8_MMA(0, 1, At, B1); PG8_BAR;
            PG8_LDA(At, 1, 1); PG8_STAGE(PG8_SA(1, 0), a3, voffA);
            PG8_BAR; PG8_WAIT_L(0); PG8_MMA(1, 0, At, B0); PG8_BAR; PG8_SCHED;
            PG8_STAGE(PG8_SB(1, 1), b3 + hstep, voffB);
            PG8_WAIT_V(6); PG8_BAR; PG8_MMA(1, 1, At, B1); PG8_BAR;
            }
        }
        if constexpr (ALIGN_EPI) { if (wr == 0) PG8_BAR; }
        if constexpr (!Epi::AFTER_DRAIN) { E(acc, cur, wr, wc, fr, fq); S.done(cur); }
        if (!has_next) break;
#pragma unroll
        for (int a = 0; a < 2; ++a)
#pragma unroll
            for (int b = 0; b < 2; ++b)
#pragma unroll
                for (int m = 0; m < 4; ++m)
#pragma unroll
                    for (int n = 0; n < 2; ++n) acc[a][b][m][n] = (f32x4){0.f, 0.f, 0.f, 0.f};
        cur = nxt; cA = nA; cB = nB; ++ui;
        if constexpr (ALIGN_EPI) { if (wr == 1) PG8_BAR; }
    }
    PG8_WAIT_V(0);
    if constexpr (!ALIGN_EPI) { if (wr == 0) PG8_BAR; }
    PG8_BAR;
    if constexpr (Epi::AFTER_DRAIN) { E.fused(acc, cur, wr, wc, fr, fq, lds, wid, lane); S.done(cur); }
#undef PG8_SA
#undef PG8_SB
#undef PG8_STAGE
#undef PG8_LDA
#undef PG8_LDB
#undef PG8_MMA
#undef PG8_WAIT_V
#undef PG8_WAIT_L
#undef PG8_BAR
#undef PG8_SCHED
}
}

DEVI void ln_row1024(float (&y)[16], const float* g, const float* b, int lane) {
    float s = 0.f;
#pragma unroll
    for (int i = 0; i < 16; ++i) s += y[i];
    const float mu = wave_sum(s) * (1.0f / 1024.0f);
    float q = 0.f;
#pragma unroll
    for (int i = 0; i < 16; ++i) { const float d = y[i] - mu; q += d * d; }
    const float rstd = 1.0f / sqrtf(wave_sum(q) * (1.0f / 1024.0f) + LN_EPS);
#pragma unroll
    for (int i = 0; i < 16; ++i) y[i] = (y[i] - mu) * rstd * g[lane + 64 * i] + b[lane + 64 * i];
}

DEVI void route_token(const float (&y)[16], float* ys, int t, int lane, const float* wg, const float* bg, const float* we, const float* be, int* eid, float* gw, unsigned* counts) {
    float lg[36];
#pragma unroll
    for (int j = 0; j < 36; ++j) lg[j] = 0.f;
#pragma unroll
    for (int i = 0; i < 16; ++i) ys[lane + 64 * i] = y[i];
#pragma unroll 1
    for (int i = 0; i < 16; ++i) {
        const int c = lane + 64 * i;
        const float yv = ys[c];
        const float4 g4 = *(const float4*)(wg + (size_t)c * 4);
        lg[0] += yv * g4.x; lg[1] += yv * g4.y; lg[2] += yv * g4.z; lg[3] += yv * g4.w;
#pragma unroll
        for (int j = 0; j < 8; ++j) { const float4 e4 = *(const float4*)(we + (size_t)c * 32 + j * 4);
            lg[4 + j * 4 + 0] += yv * e4.x; lg[4 + j * 4 + 1] += yv * e4.y; lg[4 + j * 4 + 2] += yv * e4.z; lg[4 + j * 4 + 3] += yv * e4.w; }
    }
#pragma unroll
    for (int j = 0; j < 36; ++j) lg[j] = wave_sum(lg[j]);
    if (lane == 0) {
        float gl[4]; int g = 0;
#pragma unroll
        for (int j = 0; j < 4; ++j) gl[j] = lg[j] + bg[j];
#pragma unroll
        for (int j = 1; j < 4; ++j) if (gl[j] > gl[g]) g = j;
        float den = 0.f;
#pragma unroll
        for (int j = 0; j < 4; ++j) den += expf(gl[j] - gl[g]);
        const float gp = 1.0f / den;
        float el[8];
#pragma unroll
        for (int j = 0; j < 8; ++j) { float v = 0.f;
#pragma unroll
            for (int gg = 0; gg < 4; ++gg) v = (gg == g) ? lg[4 + gg * 8 + j] + be[gg * 8 + j] : v;
            el[j] = v; }
        int i1 = 0;
#pragma unroll
        for (int j = 1; j < 8; ++j) if (el[j] > el[i1]) i1 = j;
        int i2 = (i1 == 0) ? 1 : 0;
#pragma unroll
        for (int j = 0; j < 8; ++j) if (j != i1 && el[j] > el[i2]) i2 = j;
        const float ex = expf(el[i2] - el[i1]);
        const float p1 = 1.0f / (1.0f + ex), p2 = ex / (1.0f + ex);
        const int e1 = g * 8 + i1, e2 = g * 8 + i2;
        eid[2 * t] = e1; eid[2 * t + 1] = e2; gw[2 * t] = gp * p1; gw[2 * t + 1] = gp * p2;
        atomicAdd(&counts[e1], 1u); atomicAdd(&counts[e2], 1u);
    }
}


DEVI void ln_row1024v(float (&y)[16], const float* g, const float* b, int lane) {
    float s = 0.f;
#pragma unroll
    for (int i = 0; i < 16; ++i) s += y[i];
    const float mu = wave_sum(s) * (1.0f / 1024.0f);
    float q = 0.f;
#pragma unroll
    for (int i = 0; i < 16; ++i) { const float d = y[i] - mu; q += d * d; }
    const float rstd = 1.0f / sqrtf(wave_sum(q) * (1.0f / 1024.0f) + LN_EPS);
#pragma unroll
    for (int i4 = 0; i4 < 4; ++i4) { const float4 g4 = *(const float4*)(g + 16 * lane + 4 * i4), b4 = *(const float4*)(b + 16 * lane + 4 * i4);
        y[4 * i4] = (y[4 * i4] - mu) * rstd * g4.x + b4.x; y[4 * i4 + 1] = (y[4 * i4 + 1] - mu) * rstd * g4.y + b4.y; y[4 * i4 + 2] = (y[4 * i4 + 2] - mu) * rstd * g4.z + b4.z; y[4 * i4 + 3] = (y[4 * i4 + 3] - mu) * rstd * g4.w + b4.w; }
}
DEVI void ln_row1024w(float (&y)[16], const float* g, const float* b, int lane) {
    float s = 0.f;
#pragma unroll
    for (int i = 0; i < 16; ++i) s += y[i];
    const float mu = wave_sum(s) * (1.0f / 1024.0f);
    float q = 0.f;
#pragma unroll
    for (int i = 0; i < 16; ++i) { const float d = y[i] - mu; q += d * d; }
    const float rstd = 1.0f / sqrtf(wave_sum(q) * (1.0f / 1024.0f) + LN_EPS);
#pragma unroll
    for (int i4 = 0; i4 < 4; ++i4) { const float4 g4 = *(const float4*)(g + 256 * i4 + 4 * lane), b4 = *(const float4*)(b + 256 * i4 + 4 * lane);
        y[4 * i4] = (y[4 * i4] - mu) * rstd * g4.x + b4.x; y[4 * i4 + 1] = (y[4 * i4 + 1] - mu) * rstd * g4.y + b4.y; y[4 * i4 + 2] = (y[4 * i4 + 2] - mu) * rstd * g4.z + b4.z; y[4 * i4 + 3] = (y[4 * i4 + 3] - mu) * rstd * g4.w + b4.w; }
}
DEVI void combine_row(float (&y)[16], const float* h, const unsigned short* Y0, const unsigned short* Y1, float g0, float g1, int lane) {
    uint2 aw[4], bw[4]; float4 hv[4];
#pragma unroll
    for (int i4 = 0; i4 < 4; ++i4) { aw[i4] = *(const uint2*)(Y0 + 256 * i4 + 4 * lane); bw[i4] = *(const uint2*)(Y1 + 256 * i4 + 4 * lane); hv[i4] = *(const float4*)(h + 256 * i4 + 4 * lane); }
#pragma unroll
    for (int i4 = 0; i4 < 4; ++i4) {
        y[4 * i4]     = DN_ALPHA * hv[i4].x + (g0 * __uint_as_float(aw[i4].x << 16) + g1 * __uint_as_float(bw[i4].x << 16));
        y[4 * i4 + 1] = DN_ALPHA * hv[i4].y + (g0 * __uint_as_float(aw[i4].x & 0xFFFF0000u) + g1 * __uint_as_float(bw[i4].x & 0xFFFF0000u));
        y[4 * i4 + 2] = DN_ALPHA * hv[i4].z + (g0 * __uint_as_float(aw[i4].y << 16) + g1 * __uint_as_float(bw[i4].y << 16));
        y[4 * i4 + 3] = DN_ALPHA * hv[i4].w + (g0 * __uint_as_float(aw[i4].y & 0xFFFF0000u) + g1 * __uint_as_float(bw[i4].y & 0xFFFF0000u)); }
}
typedef float f32x4v __attribute__((ext_vector_type(4)));
DEVI void ln_route_block(int tb, int ntok, const float* Zsrc, float* Hdst, const float* g, const float* b, const float4* __restrict__ Wr, const float* bg, const float* be,
                         int* eid, float* gw, unsigned* counts, float* sm) {
    const int tid = otid(), lane = tid & 63, wave = tid >> 6;
    unsigned* lcnt = (unsigned*)(sm + 8 * 16 * 48);
    if (tid < NE) lcnt[tid] = 0u;
    { float yy[8][16];
#pragma unroll
      for (int i = 0; i < 8; ++i) { const int tl = wave * 8 + i; const size_t t = (size_t)(tb + (tl < ntok ? tl : ntok - 1));
#pragma unroll
          for (int i4 = 0; i4 < 4; ++i4) { const float4 v = *(const float4*)(Zsrc + t * D + 256 * i4 + 4 * lane); yy[i][4 * i4] = v.x; yy[i][4 * i4 + 1] = v.y; yy[i][4 * i4 + 2] = v.z; yy[i][4 * i4 + 3] = v.w; } }
#pragma unroll
      for (int i = 0; i < 8; ++i) { const int tl = wave * 8 + i;
          if (tl < ntok) { const size_t t = (size_t)(tb + tl);
              ln_row1024w(yy[i], g, b, lane);
#pragma unroll
              for (int i4 = 0; i4 < 4; ++i4) *(float4*)(Hdst + t * D + 256 * i4 + 4 * lane) = make_float4(yy[i][4 * i4], yy[i][4 * i4 + 1], yy[i][4 * i4 + 2], yy[i][4 * i4 + 3]); } } }
    asm volatile("s_waitcnt vmcnt(0)" ::: "memory");
    __syncthreads();
    const int grp = wave & 3, khalf = wave >> 2;
    if (grp * 16 < ntok) {
        const int t0 = tb + 16 * grp, row = lane & 15, kg = lane >> 4;
        f32x4v acc[3];
#pragma unroll
        for (int ct = 0; ct < 3; ++ct) acc[ct] = (f32x4v){0.f, 0.f, 0.f, 0.f};
        const float* arow = Hdst + (size_t)(t0 + row) * D + 4 * kg;
        float4 aN[4], bN[4][3];
#pragma unroll
        for (int u = 0; u < 4; ++u) { const int sstep = 32 * khalf + u; aN[u] = *(const float4*)(arow + 16 * sstep);
#pragma unroll
            for (int ct = 0; ct < 3; ++ct) bN[u][ct] = Wr[(sstep * 3 + ct) * 64 + lane]; }
#pragma unroll 1
        for (int s0 = 32 * khalf; s0 < 32 * khalf + 32; s0 += 4) {
            float4 aC[4], bC[4][3];
#pragma unroll
            for (int u = 0; u < 4; ++u) { aC[u] = aN[u];
#pragma unroll
                for (int ct = 0; ct < 3; ++ct) bC[u][ct] = bN[u][ct]; }
            if (s0 + 4 < 32 * khalf + 32) {
#pragma unroll
                for (int u = 0; u < 4; ++u) { const int sstep = s0 + 4 + u; aN[u] = *(const float4*)(arow + 16 * sstep);
#pragma unroll
                    for (int ct = 0; ct < 3; ++ct) bN[u][ct] = Wr[(sstep * 3 + ct) * 64 + lane]; } }
#pragma unroll
            for (int u = 0; u < 4; ++u)
#pragma unroll
                for (int ct = 0; ct < 3; ++ct) { const float4 a4 = aC[u], b4 = bC[u][ct];
                    acc[ct] = __builtin_amdgcn_mfma_f32_16x16x4f32(a4.x, b4.x, acc[ct], 0, 0, 0); acc[ct] = __builtin_amdgcn_mfma_f32_16x16x4f32(a4.y, b4.y, acc[ct], 0, 0, 0);
                    acc[ct] = __builtin_amdgcn_mfma_f32_16x16x4f32(a4.z, b4.z, acc[ct], 0, 0, 0); acc[ct] = __builtin_amdgcn_mfma_f32_16x16x4f32(a4.w, b4.w, acc[ct], 0, 0, 0); }
        }
        float* Lg = sm + (khalf * 4 + grp) * 16 * 48;
#pragma unroll
        for (int ct = 0; ct < 3; ++ct)
#pragma unroll
            for (int j = 0; j < 4; ++j) Lg[(4 * kg + j) * 48 + 16 * ct + row] = acc[ct][j];
    }
    __syncthreads();
    if (wave < 4 && wave * 16 < ntok) {
        const int t0 = tb + 16 * wave;
        if (lane < 16) {
            const int t = t0 + lane; const float* lgA = sm + wave * 16 * 48 + lane * 48; const float* lgB = lgA + 4 * 16 * 48;
            float lg[36];
#pragma unroll
            for (int j = 0; j < 36; ++j) lg[j] = lgA[j] + lgB[j];
            float gl[4]; int gsel = 0;
#pragma unroll
            for (int j = 0; j < 4; ++j) gl[j] = lg[j] + bg[j];
#pragma unroll
            for (int j = 1; j < 4; ++j) if (gl[j] > gl[gsel]) gsel = j;
            float den = 0.f;
#pragma unroll
            for (int j = 0; j < 4; ++j) den += expf(gl[j] - gl[gsel]);
            const float gp = 1.0f / den;
            float el[8];
#pragma unroll
            for (int j = 0; j < 8; ++j) { float v = lg[4 + j];
#pragma unroll
                for (int gg = 1; gg < 4; ++gg) v = (gg == gsel) ? lg[4 + gg * 8 + j] : v;
                el[j] = v + be[gsel * 8 + j]; }
            int i1 = 0;
#pragma unroll
            for (int j = 1; j < 8; ++j) if (el[j] > el[i1]) i1 = j;
            int i2 = (i1 == 0) ? 1 : 0;
#pragma unroll
            for (int j = 0; j < 8; ++j) if (j != i1 && el[j] > el[i2]) i2 = j;
            float e1v = el[0], e2v = el[0];
#pragma unroll
            for (int j = 0; j < 8; ++j) { e1v = (j == i1) ? el[j] : e1v; e2v = (j == i2) ? el[j] : e2v; }
            const float ex = expf(e2v - e1v);
            const float p1 = 1.0f / (1.0f + ex), p2 = ex / (1.0f + ex);
            const int e1 = gsel * 8 + i1, e2 = gsel * 8 + i2;
            eid[2 * t] = e1; eid[2 * t + 1] = e2; gw[2 * t] = gp * p1; gw[2 * t + 1] = gp * p2;
            atomicAdd(&lcnt[e1], 1u); atomicAdd(&lcnt[e2], 1u);
        }
    }
    __syncthreads();
    if (tid < NE) { const unsigned c = lcnt[tid]; if (c) atomicAdd(&counts[tid], c); }
    __syncthreads();
}

using pg8::f32x4; using pg8::Unit; typedef unsigned short bf16_t;
DEVI float bf2f(unsigned short b) { return __uint_as_float(((unsigned)b) << 16); }
DEVI float bflo(unsigned w) { return __uint_as_float(w << 16); }
DEVI float bfhi(unsigned w) { return __uint_as_float(w & 0xFFFF0000u); }
DEVI unsigned cvt_pk_bf16(float lo, float hi) { unsigned r; asm volatile("v_cvt_pk_bf16_f32 %0, %1, %2" : "=v"(r) : "v"(lo), "v"(hi)); return r; }
DEVI uint2 pack4(const f32x4 v) { return make_uint2(cvt_pk_bf16(v[0], v[1]), cvt_pk_bf16(v[2], v[3])); }
DEVI float fsigm(float x) { return __builtin_amdgcn_rcpf(1.0f + __expf(-x)); }
DEVI unsigned pack4_fp8(const f32x4 v) { int w = __builtin_amdgcn_cvt_pk_fp8_f32(v[0], v[1], 0, false); w = __builtin_amdgcn_cvt_pk_fp8_f32(v[2], v[3], w, true); return (unsigned)w; }

DEVI int in0_srccol(int n) {
    if (n < 1024) { const int G = n >> 5, nn = (n >> 4) & 1, i = n & 15; return (nn ? OFF_AGATE : OFF_AVAL) + 16 * G + i; }
    if (n < 2048 || (n >= 2560 && n < 3072)) {
        const int base = n < 1536 ? OFF_Q : n < 2048 ? OFF_K : OFF_QI; const int loc = n & 511;
        const int G = loc >> 5, nn = (loc >> 4) & 1, i = loc & 15; return base + 64 * (G >> 1) + 32 * nn + 16 * (G & 1) + i; }
    if (n < 2560) return OFF_V + (n - 2048);
    if (n < 3136) { const int loc = n - 3072; const int G = loc >> 5, nn = (loc >> 4) & 1, i = loc & 15; return OFF_KI + 32 * nn + 16 * G + i; }
    if (n < 3144) return OFF_WI + (n - 3136);
    return -1;
}
struct EpiIn0 {
    static constexpr bool PERM = false, AFTER_DRAIN = false;
    bf16_t* GLU; bf16_t* KI; float* WI; const float* ropeC; const float* ropeS; unsigned char* KV8;
    DEVI void operator()(const f32x4 (&acc)[2][2][4][2], const Unit& u, int wr, int wc, int fr, int fq) const {
        const int pn = u.pn; const int rbase = u.pm * 256 + wr * 64 + fr;
        if (pn < 4) {
#pragma unroll
            for (int ai = 0; ai < 2; ++ai)
#pragma unroll
                for (int m = 0; m < 4; ++m) { const size_t row = rbase + ai * 128 + m * 16;
#pragma unroll
                    for (int bj = 0; bj < 2; ++bj) { const int G = 8 * pn + 4 * bj + wc; const f32x4 v = acc[ai][bj][m][0], g = acc[ai][bj][m][1]; f32x4 o;
#pragma unroll
                        for (int j = 0; j < 4; ++j) o[j] = v[j] * fsigm(g[j]);
                        *(uint2*)(GLU + row * 512 + 16 * G + 4 * fq) = pack4(o); } }
        } else if (pn == 8 || pn == 9) {
#pragma unroll
            for (int ai = 0; ai < 2; ++ai)
#pragma unroll
                for (int m = 0; m < 4; ++m) { const size_t row = rbase + ai * 128 + m * 16;
#pragma unroll
                    for (int bj = 0; bj < 2; ++bj)
#pragma unroll
                        for (int n = 0; n < 2; ++n) { const int col = 256 * (pn - 8) + 128 * bj + 32 * wc + 16 * n + 4 * fq;
                            *(unsigned*)(KV8 + row * 1024 + (size_t)(col >> 3) * 16 + 8 + (col & 7)) = pack4_fp8(acc[ai][bj][m][n]); } }
        } else if (pn == 12) {
            if (wc < 2) { const int d0 = 16 * wc + 4 * fq;
#pragma unroll
                for (int ai = 0; ai < 2; ++ai)
#pragma unroll
                    for (int m = 0; m < 4; ++m) { const size_t row = rbase + ai * 128 + m * 16;
                        const f32x4 c = *(const f32x4*)(ropeC + row * 32 + d0), s = *(const f32x4*)(ropeS + row * 32 + d0);
                        const f32x4 t1 = acc[ai][0][m][0], t2 = acc[ai][0][m][1];
                        *(uint2*)(KI + row * 64 + d0) = pack4(t1 * c - t2 * s); *(uint2*)(KI + row * 64 + 32 + d0) = pack4(t1 * s + t2 * c); }
            } else if (wc == 2 && fq < 2) {
#pragma unroll
                for (int ai = 0; ai < 2; ++ai)
#pragma unroll
                    for (int m = 0; m < 4; ++m) { const size_t row = rbase + ai * 128 + m * 16; *(f32x4*)(WI + row * 8 + 4 * fq) = acc[ai][0][m][0] * 0.35355339059327373f; }
            }
        } else {
            bf16_t* dst = GLU + (size_t)(pn < 6 ? 1 : pn < 8 ? 2 : 4) * LP * 512; const int pl = pn & 1; const int d0 = 16 * (wc & 1) + 4 * fq;
#pragma unroll
            for (int ai = 0; ai < 2; ++ai)
#pragma unroll
                for (int m = 0; m < 4; ++m) { const size_t row = rbase + ai * 128 + m * 16;
                    const f32x4 c = *(const f32x4*)(ropeC + row * 32 + d0), s = *(const f32x4*)(ropeS + row * 32 + d0);
#pragma unroll
                    for (int bj = 0; bj < 2; ++bj) { const int hh = 4 * pl + 2 * bj + (wc >> 1); const f32x4 t1 = acc[ai][bj][m][0], t2 = acc[ai][bj][m][1];
                        if (pn == 6 || pn == 7) { const int da = 64 * hh + d0, db = da + 32;
                            *(unsigned*)(KV8 + row * 1024 + (size_t)(da >> 3) * 16 + (da & 7)) = pack4_fp8(t1 * c - t2 * s); *(unsigned*)(KV8 + row * 1024 + (size_t)(db >> 3) * 16 + (db & 7)) = pack4_fp8(t1 * s + t2 * c);
                        } else { *(uint2*)(dst + row * 512 + 64 * hh + d0) = pack4(t1 * c - t2 * s); *(uint2*)(dst + row * 512 + 64 * hh + 32 + d0) = pack4(t1 * s + t2 * c); } } }
        }
    }
};
struct EpiRes0 {
    static constexpr bool PERM = false, AFTER_DRAIN = false;
    const float* x; const float* meta; float* Z;
    DEVI void operator()(const f32x4 (&acc)[2][2][4][2], const Unit& u, int wr, int wc, int fr, int fq) const {
        const int rbase = u.pm * 256 + wr * 64 + fr, cbase = u.pn * 256 + wc * 32 + 4 * fq;
#pragma unroll
        for (int ai = 0; ai < 2; ++ai)
#pragma unroll
            for (int m = 0; m < 4; ++m) { const int row = rbase + ai * 128 + m * 16;
                if (row < L) { const float* rs = row < NMETA ? meta + (size_t)row * D : x + (size_t)(row - NMETA) * D;
#pragma unroll
                    for (int bj = 0; bj < 2; ++bj)
#pragma unroll
                        for (int n = 0; n < 2; ++n) { const int col = cbase + 128 * bj + 16 * n; const f32x4 r4 = *(const f32x4*)(rs + col); *(f32x4*)(Z + (size_t)row * D + col) = r4 * DN_ALPHA + acc[ai][bj][m][n]; } } }
    }
};
struct EpiGateUp {
    static constexpr bool PERM = false, AFTER_DRAIN = false;
    bf16_t* Hm;
    DEVI void operator()(const f32x4 (&acc)[2][2][4][2], const Unit& u, int wr, int wc, int fr, int fq) const {
        const int pl = u.pn & 3; const int rbase = u.pm * 256 + wr * 64 + fr;
#pragma unroll
        for (int ai = 0; ai < 2; ++ai)
#pragma unroll
            for (int m = 0; m < 4; ++m) { const size_t row = rbase + ai * 128 + m * 16;
#pragma unroll
                for (int bj = 0; bj < 2; ++bj) { const int G = 8 * pl + 4 * bj + wc; const f32x4 g = acc[ai][bj][m][0], up = acc[ai][bj][m][1]; f32x4 o;
#pragma unroll
                    for (int j = 0; j < 4; ++j) o[j] = g[j] * fsigm(g[j]) * up[j];
                    *(uint2*)(Hm + row * 512 + 16 * G + 4 * fq) = pack4(o); } }
    }
};
struct EpiDown {
    static constexpr bool PERM = false, AFTER_DRAIN = false;
    bf16_t* Y;
    DEVI void operator()(const f32x4 (&acc)[2][2][4][2], const Unit& u, int wr, int wc, int fr, int fq) const {
        const int pl = u.pn & 3; const int rbase = u.pm * 256 + wr * 64 + fr, cbase = pl * 256 + wc * 32 + 4 * fq;
#pragma unroll
        for (int ai = 0; ai < 2; ++ai)
#pragma unroll
            for (int m = 0; m < 4; ++m) { const size_t row = rbase + ai * 128 + m * 16;
#pragma unroll
                for (int bj = 0; bj < 2; ++bj)
#pragma unroll
                    for (int n = 0; n < 2; ++n) *(uint2*)(Y + row * 1024 + cbase + 128 * bj + 16 * n) = pack4(acc[ai][bj][m][n]); }
    }
};
struct MoeOrder {
    const int* mt; int nunits, G, c;
    DEVI void init(const int* t, int G_, int c_) { mt = t; nunits = t[0] * 4; G = G_; c = c_; }
    DEVI bool next(int i, Unit& u) const { const int li = i * G + c; if (li >= nunits) return false; const int ti = li >> 2; u.pm = ti; u.pn = mt[4 + ti] * 4 + (li & 3); return true; }
    DEVI void a_ready(const Unit&) const {}
    DEVI void done(const Unit&) const {}
};

template <class F> DEVI void tr_tile(bf16_t* dst, int K, int n0, int k0, F src, float* sm) {
    const int tid = otid();
    __syncthreads();
    { const int nn = tid & 63, kb = tid >> 6;
#pragma unroll
      for (int p = 0; p < 8; ++p) { const int kk = kb + 8 * p; sm[kk * 65 + nn] = src(n0 + nn, k0 + kk); } }
    __syncthreads();
    { const int nn = tid >> 3, kq = (tid & 7) * 8; float v[8];
#pragma unroll
      for (int j = 0; j < 8; ++j) v[j] = sm[(kq + j) * 65 + nn];
      uint4 w; w.x = cvt_pk_bf16(v[0], v[1]); w.y = cvt_pk_bf16(v[2], v[3]); w.z = cvt_pk_bf16(v[4], v[5]); w.w = cvt_pk_bf16(v[6], v[7]);
      *(uint4*)(dst + (size_t)(n0 + nn) * K + k0 + kq) = w; }
}

struct TrJob { bf16_t* dst; const float* s0; const float* s1; int K, n0, k0, ld, mode; };
DEVI float tr_src(const TrJob& J, int n, int k) {
    if (J.mode == 0) return __builtin_nontemporal_load(J.s0 + (size_t)k * J.ld + n);
    if (J.mode == 1) { const int sc = in0_srccol(n); return sc < 0 ? 0.f : __builtin_nontemporal_load(J.s0 + (size_t)k * IN_AB + sc); }
    const int ch = (n >> 5) * 16 + (n & 15); return ((n >> 4) & 1) ? __builtin_nontemporal_load(J.s1 + (size_t)k * DE + ch) : __builtin_nontemporal_load(J.s0 + (size_t)k * DE + ch);
}
DEVI void tr_fetch(const TrJob& J, float (&v)[8]) {
    const int tid = otid(), nn = tid & 63, kb = tid >> 6;
#pragma unroll
    for (int p = 0; p < 8; ++p) v[p] = tr_src(J, J.n0 + nn, J.k0 + kb + 8 * p);
}
DEVI void tr_commit(const TrJob& J, const float (&v)[8], float* sm) {
    const int tid = otid();
    __syncthreads();
    { const int nn = tid & 63, kb = tid >> 6;
#pragma unroll
      for (int p = 0; p < 8; ++p) sm[(kb + 8 * p) * 65 + nn] = v[p]; }
    __syncthreads();
    { const int nn = tid >> 3, kq = (tid & 7) * 8; float x[8];
#pragma unroll
      for (int j = 0; j < 8; ++j) x[j] = sm[(kq + j) * 65 + nn];
      uint4 w; w.x = cvt_pk_bf16(x[0], x[1]); w.y = cvt_pk_bf16(x[2], x[3]); w.z = cvt_pk_bf16(x[4], x[5]); w.w = cvt_pk_bf16(x[6], x[7]);
      *(uint4*)(J.dst + (size_t)(J.n0 + nn) * J.K + J.k0 + kq) = w; }
}
template <class Dec> DEVI void tr_run(int njobs, Dec dec, float* sm, int rank = (int)blockIdx.x, int G = (int)gridDim.x) {
    int j = rank;
    TrJob Ja{}, Jb{}; float va[8], vb[8];
    if (j < njobs) { Ja = dec(j); tr_fetch(Ja, va); }
    while (j < njobs) {
        int jn = j + G; if (jn < njobs) { Jb = dec(jn); tr_fetch(Jb, vb); }
        tr_commit(Ja, va, sm);
        j = jn; if (j >= njobs) break;
        jn = j + G; if (jn < njobs) { Ja = dec(jn); tr_fetch(Ja, va); }
        tr_commit(Jb, vb, sm);
        j = jn;
    }
    __syncthreads();
}

DEVI void moe_dispatch_mfma(const float* H, const int* eid, const unsigned* counts, unsigned* cursor, int* slot, int* mtiles, bf16_t* Xperm, int* sm_i, int gwave, int nwaves, int lane, int p_begin) {
    { const int tid = otid();
      if (tid == 0) { int o = 0; for (int e = 0; e < NE; ++e) { sm_i[e] = o; o += (((int)counts[e] + 255) >> 8) << 8; } }
      if (tid < NE) sm_i[32 + tid] = 0; }
    __syncthreads();
    { const int ppw = (NPAIR - p_begin + nwaves - 1) / nwaves; const int pb = p_begin + gwave * ppw; const int pe = pb + ppw < NPAIR ? pb + ppw : NPAIR;
      int e_ = 0, rk = 0; const bool act = lane < ppw && pb + lane < pe;
      if (act) { e_ = eid[pb + lane]; rk = atomicAdd(&sm_i[32 + e_], 1); }
      __syncthreads();
      { const int tid = otid(); if (tid < NE) { const int c = sm_i[32 + tid]; if (c) sm_i[64 + tid] = sm_i[tid] + (int)atomicAdd(&cursor[tid], (unsigned)c); } }
      __syncthreads();
      if (pb < pe) {
        int sl = 0;
        if (act) { sl = sm_i[64 + e_] + rk; slot[pb + lane] = sl; }
        for (int k0 = 0; pb + k0 < pe; k0 += 8) {
            float4 v[8][4];
#pragma unroll
            for (int k = 0; k < 8; ++k) { const int p = pb + k0 + k < pe ? pb + k0 + k : pe - 1; const float4* src = (const float4*)(H + (size_t)(p >> 1) * D);
#pragma unroll
                for (int r = 0; r < 4; ++r) v[k][r] = src[lane + 64 * r]; }
#pragma unroll
            for (int k = 0; k < 8; ++k) { const int s = __shfl(sl, k0 + k);
                if (pb + k0 + k < pe) { uint2* dst = (uint2*)(Xperm + (size_t)s * D);
#pragma unroll
                    for (int r = 0; r < 4; ++r) dst[lane + 64 * r] = make_uint2(cvt_pk_bf16(v[k][r].x, v[k][r].y), cvt_pk_bf16(v[k][r].z, v[k][r].w)); } }
        }
      } }
    if (blockIdx.x == 0 && otid() == 0) { int n = 0; for (int e = 0; e < NE; ++e) { const int nt = ((int)counts[e] + 255) >> 8; for (int i = 0; i < nt; ++i) mtiles[4 + n++] = e; } mtiles[0] = n; }
    __syncthreads();
}

DEVI float gelu_fast(float x) { return x * fsigm(1.5957691216057308f * (x + 0.044715f * x * x * x)); }
struct EpiIn1 {
    static constexpr bool PERM = false, AFTER_DRAIN = false;
    bf16_t* G;
    DEVI void operator()(const f32x4 (&acc)[2][2][4][2], const Unit& u, int wr, int wc, int fr, int fq) const {
        const int pn = u.pn; const bool is_gate = pn < 5; const int rbase = u.pm * 256 + wr * 64 + fr;
        bf16_t* dst = G + (is_gate ? (size_t)0 : (size_t)LP * RNN_W) + (size_t)((is_gate ? pn : pn - 5) * 256 + wc * 32 + 4 * fq);
#pragma unroll
        for (int ai = 0; ai < 2; ++ai)
#pragma unroll
            for (int m = 0; m < 4; ++m) { const size_t row = rbase + ai * 128 + m * 16;
#pragma unroll
                for (int bj = 0; bj < 2; ++bj)
#pragma unroll
                    for (int n = 0; n < 2; ++n) { f32x4 v = acc[ai][bj][m][n];
                        if (is_gate) {
#pragma unroll
                            for (int j = 0; j < 4; ++j) v[j] = gelu_fast(v[j]); }
                        *(uint2*)(dst + row * RNN_W + 128 * bj + 16 * n) = pack4(v); } }
    }
};
struct EpiRes1 {
    static constexpr bool PERM = false, AFTER_DRAIN = false;
    const float* R; float* Z;
    DEVI void operator()(const f32x4 (&acc)[2][2][4][2], const Unit& u, int wr, int wc, int fr, int fq) const {
        const int rbase = u.pm * 256 + wr * 64 + fr, cbase = u.pn * 256 + wc * 32 + 4 * fq;
#pragma unroll
        for (int ai = 0; ai < 2; ++ai)
#pragma unroll
            for (int m = 0; m < 4; ++m) { const size_t row = rbase + ai * 128 + m * 16;
#pragma unroll
                for (int bj = 0; bj < 2; ++bj)
#pragma unroll
                    for (int n = 0; n < 2; ++n) { const int col = cbase + 128 * bj + 16 * n; const f32x4 r4 = *(const f32x4*)(R + row * D + col); *(f32x4*)(Z + row * D + col) = r4 * DN_ALPHA + acc[ai][bj][m][n]; } }
    }
};

typedef short bf16x8_t __attribute__((ext_vector_type(8)));
struct RgIn { uint4 x[2][4]; };
DEVI void rglru_fetch(int c, int ch0, const bf16_t* __restrict__ XR, int tid, RgIn& R) {
    const int c8 = tid & 15, tr = tid >> 4;
#pragma unroll
    for (int half = 0; half < 2; ++half) { const int t = c * 64 + tr + 32 * half;
#pragma unroll
        for (int j = 0; j < 4; ++j) { const int tt = t - 3 + j; R.x[half][j] = tt >= 0 ? *(const uint4*)(XR + (size_t)tt * RNN_W + ch0 + 8 * c8) : make_uint4(0u, 0u, 0u, 0u); } }
}
template <bool FINAL>
DEVI void rglru_unit(int c, int nb, const RgIn& R, const bf16x8_t (&fa)[4], const bf16x8_t (&fx)[4], float bav, float bxv, float sp,
                     const bf16_t* __restrict__ GATEg, float* __restrict__ Aend, float* __restrict__ Hend, const float* __restrict__ CIN, bf16_t* __restrict__ YY,
                     unsigned char* lds, int tid) {
    const int lane = tid & 63, w = tid >> 6, col = lane & 15, quad = lane >> 4;
    bf16_t* xcb = (bf16_t*)lds;
    float* xcf = (float*)(lds + 64 * 136 * 2);
    const float* cwl = (const float*)(lds + 64 * 136 * 2 + 64 * 132 * 4);
    const int t0 = c * 64, ch0 = nb * RNN_BW, ch = ch0 + 16 * w + col;
    const float cinv = FINAL ? CIN[(size_t)ch * CP + c] : 0.f;
    const int c8 = tid & 15, tr = tid >> 4;
    uint4 g[2];
    if (FINAL) {
#pragma unroll
        for (int half = 0; half < 2; ++half) { const int t = t0 + tr + 32 * half; g[half] = (t < L) ? *(const uint4*)(GATEg + (size_t)t * RNN_W + ch0 + 8 * c8) : make_uint4(0u, 0u, 0u, 0u); } }
    __syncthreads();
    {
        float bv[8];
        { const float4 b0 = *(const float4*)(cwl + 512 + 8 * c8), b1 = *(const float4*)(cwl + 512 + 8 * c8 + 4); bv[0] = b0.x; bv[1] = b0.y; bv[2] = b0.z; bv[3] = b0.w; bv[4] = b1.x; bv[5] = b1.y; bv[6] = b1.z; bv[7] = b1.w; }
#pragma unroll
        for (int half = 0; half < 2; ++half) { const int tl = tr + 32 * half;
            float v[8];
#pragma unroll
            for (int i = 0; i < 8; ++i) v[i] = bv[i];
#pragma unroll
            for (int j = 0; j < 4; ++j) { const uint4 xv = R.x[half][j];
                const float4 w0 = *(const float4*)(cwl + j * 128 + 8 * c8), w1 = *(const float4*)(cwl + j * 128 + 8 * c8 + 4);
                v[0] += w0.x * bflo(xv.x); v[1] += w0.y * bfhi(xv.x); v[2] += w0.z * bflo(xv.y); v[3] += w0.w * bfhi(xv.y);
                v[4] += w1.x * bflo(xv.z); v[5] += w1.y * bfhi(xv.z); v[6] += w1.z * bflo(xv.w); v[7] += w1.w * bfhi(xv.w); }
            *(float4*)(xcf + tl * 132 + 8 * c8) = make_float4(v[0], v[1], v[2], v[3]); *(float4*)(xcf + tl * 132 + 8 * c8 + 4) = make_float4(v[4], v[5], v[6], v[7]);
            uint4 pk; pk.x = cvt_pk_bf16(v[0], v[1]); pk.y = cvt_pk_bf16(v[2], v[3]); pk.z = cvt_pk_bf16(v[4], v[5]); pk.w = cvt_pk_bf16(v[6], v[7]);
            *(uint4*)(xcb + (16 * ((tl >> 2) & 3) + 4 * (tl >> 4) + (tl & 3)) * 136 + 8 * c8) = pk; }
    }
    __syncthreads();
    f32x4 ca[4], cx[4];
#pragma unroll
    for (int mt = 0; mt < 4; ++mt) { ca[mt] = (f32x4){0.f, 0.f, 0.f, 0.f}; cx[mt] = (f32x4){0.f, 0.f, 0.f, 0.f};
#pragma unroll
        for (int ks = 0; ks < 4; ++ks) { const bf16x8_t af = *(const bf16x8_t*)(xcb + (16 * mt + col) * 136 + 32 * ks + 8 * quad);
            ca[mt] = __builtin_amdgcn_mfma_f32_16x16x32_bf16(af, fa[ks], ca[mt], 0, 0, 0);
            cx[mt] = __builtin_amdgcn_mfma_f32_16x16x32_bf16(af, fx[ks], cx[mt], 0, 0, 0); } }
    float av[4][4], uv[4][4]; float A = 1.f, H = 0.f;
#pragma unroll
    for (int mt = 0; mt < 4; ++mt) {
#pragma unroll
        for (int j = 0; j < 4; ++j) { const int tl = 16 * quad + 4 * mt + j;
            const float xcv = xcf[tl * 132 + 16 * w + col];
            const float r = fsigm(ca[mt][j] + bav), ig = fsigm(cx[mt][j] + bxv);
            const float la = -8.0f * r * sp;
            const float x2 = 2.0f * la;
            float em1 = x2 * (1.0f + x2 * (0.5f + x2 * (0.16666667f + x2 * (0.041666668f + x2 * (0.0083333338f + x2 * (0.0013888889f + x2 * 0.0001984127f))))));
            if (x2 < -0.5f) em1 = expm1f(x2);
            float a_ = __expf(la), u_ = __builtin_amdgcn_sqrtf(-em1) * (ig * xcv);
            if (t0 + tl >= L) { a_ = 1.f; u_ = 0.f; }
            av[mt][j] = a_; uv[mt][j] = u_; H = a_ * H + u_; A *= a_; } }
    float carry = cinv, prod = 1.f, hin = 0.f;
#pragma unroll
    for (int q = 0; q < 4; ++q) {
        if (quad == q) hin = carry;
        const float nw = A * carry + H, np = A * prod;
        carry = __shfl(nw, q * 16 + col); prod = __shfl(np, q * 16 + col); }
    if (!FINAL) {
        if (quad == 0) { Aend[(size_t)ch * CP + c] = prod; Hend[(size_t)ch * CP + c] = carry; }
    } else {
        float h = hin;
#pragma unroll
        for (int mt = 0; mt < 4; ++mt)
#pragma unroll
            for (int j = 0; j < 4; ++j) { h = av[mt][j] * h + uv[mt][j]; xcf[(16 * quad + 4 * mt + j) * 132 + 16 * w + col] = h; }
        __syncthreads();
#pragma unroll
        for (int half = 0; half < 2; ++half) { const int tl = tr + 32 * half, t = t0 + tl;
            if (t >= NMETA && t < L) {
                const float4 h0 = *(const float4*)(xcf + tl * 132 + 8 * c8), h1 = *(const float4*)(xcf + tl * 132 + 8 * c8 + 4);
                const uint4 gg = g[half];
                uint4 pk; pk.x = cvt_pk_bf16(bflo(gg.x) * h0.x, bfhi(gg.x) * h0.y); pk.y = cvt_pk_bf16(bflo(gg.y) * h0.z, bfhi(gg.y) * h0.w);
                pk.z = cvt_pk_bf16(bflo(gg.z) * h1.x, bfhi(gg.z) * h1.y); pk.w = cvt_pk_bf16(bflo(gg.w) * h1.z, bfhi(gg.w) * h1.w);
                *(uint4*)(YY + (size_t)t * RNN_W + ch0 + 8 * c8) = pk; } }
    }
}
template <bool FINAL>
DEVI void rglru_phase(const bf16_t* __restrict__ XR, const bf16_t* __restrict__ GATEg, const bf16_t* __restrict__ Wta, const bf16_t* __restrict__ Wtx,
                      const float* __restrict__ cw, const float* __restrict__ cb, const float* __restrict__ ba, const float* __restrict__ bx, const float* __restrict__ lam,
                      float* __restrict__ Aend, float* __restrict__ Hend, const float* __restrict__ CIN, bf16_t* __restrict__ YY, unsigned char* lds) {
    const int tid = otid(), lane = tid & 63, w = tid >> 6, col = lane & 15, quad = lane >> 4;
    const int G = gridDim.x, nb = blockIdx.x % RNN_NB, rank = blockIdx.x / RNN_NB, nblk = (G - nb + RNN_NB - 1) / RNN_NB;
    const int ch0 = nb * RNN_BW, ch = ch0 + 16 * w + col;
    float* cwl = (float*)(lds + 64 * 136 * 2 + 64 * 132 * 4);
    __syncthreads();
    for (int i = tid; i < 640; i += NTHREADS) cwl[i] = i < 512 ? cw[(i >> 7) * RNN_W + ch0 + (i & 127)] : cb[ch0 + (i - 512)];
    bf16x8_t fa[4], fx[4];
    { const size_t wrow = ((size_t)nb * 128 + 16 * w + col) * 128 + 8 * quad;
#pragma unroll
      for (int ks = 0; ks < 4; ++ks) { fa[ks] = *(const bf16x8_t*)(Wta + wrow + 32 * ks); fx[ks] = *(const bf16x8_t*)(Wtx + wrow + 32 * ks); } }
    const float bav = ba[ch], bxv = bx[ch], sp = log1pf(expf(-lam[ch]));
    RgIn Ra, Rb;
    int c = rank;
    if (c < NCHUNK) rglru_fetch(c, ch0, XR, tid, Ra);
    while (c < NCHUNK) {
        int cn = c + nblk;
        if (cn < NCHUNK) rglru_fetch(cn, ch0, XR, tid, Rb);
        rglru_unit<FINAL>(c, nb, Ra, fa, fx, bav, bxv, sp, GATEg, Aend, Hend, CIN, YY, lds, tid);
        c = cn; if (c >= NCHUNK) break;
        cn = c + nblk;
        if (cn < NCHUNK) rglru_fetch(cn, ch0, XR, tid, Ra);
        rglru_unit<FINAL>(c, nb, Rb, fa, fx, bav, bxv, sp, GATEg, Aend, Hend, CIN, YY, lds, tid);
        c = cn;
    }
    __syncthreads();
}

constexpr int SW = 544;
constexpr int CB = 512;
constexpr int NTILE = L / 16;
typedef float f32x16 __attribute__((ext_vector_type(16)));
typedef float f32x2v __attribute__((ext_vector_type(2)));
constexpr int HROW = 2112;
constexpr int IL_HIST = 0, IL_CKEY = 0, IL_CIDX = 16 * CB * 4, IL_HIST2 = 2 * 16 * CB * 4, IL_ROWS = IL_HIST2 + 16 * 256 * 4, IL_WI = 16 * HROW * 4, IL_QST = IL_WI + 512, IL_QST2 = IL_QST + 256, IL_CCNT = IL_QST2 + 256, IL_FLAG = IL_CCNT + 64;
constexpr int IL_QF = IL_ROWS + 16 * SW * 4;
constexpr int AT_LB = 1280;
static_assert(IL_QF + 8 * AT_LB <= IL_WI && IL_FLAG + 64 <= LDS_BYTES - 16, "indexer LDS");

constexpr int AW_BYTES = 512;
typedef short s16x2 __attribute__((ext_vector_type(2)));
DEVI float dot2bf(unsigned a, unsigned b, float c) { return __builtin_amdgcn_fdot2_f32_bf16(__builtin_bit_cast(s16x2, a), __builtin_bit_cast(s16x2, b), c, false); }
#define LDS_FENCE() asm volatile("s_waitcnt lgkmcnt(0)" ::: "memory")

struct AttnQ { float m, l, o[8]; };

DEVI void attn_issue(int b0, const unsigned* lst, const unsigned char* __restrict__ KV8, unsigned lane16, uint4 (&kv)[8]) {
    const uint4 o0 = *(const uint4*)(lst + b0), o1 = *(const uint4*)(lst + b0 + 4);
    const unsigned o[8] = {o0.x, o0.y, o0.z, o0.w, o1.x, o1.y, o1.z, o1.w};
#pragma unroll
    for (int kk = 0; kk < 8; ++kk) kv[kk] = *(const uint4*)(KV8 + (o[kk] + lane16));
}
template <bool MASK>
DEVI void attn_compute(AttnQ& S, int b0, int n, const float (&q)[8], const uint4 (&kv)[8], int ch) {
    float sc[8]; float mx = S.m;
#pragma unroll
    for (int u = 0; u < 8; ++u) {
        const f32x2v k0 = __builtin_amdgcn_cvt_pk_f32_fp8((int)kv[u].x, false), k1 = __builtin_amdgcn_cvt_pk_f32_fp8((int)kv[u].x, true),
                     k2 = __builtin_amdgcn_cvt_pk_f32_fp8((int)kv[u].y, false), k3 = __builtin_amdgcn_cvt_pk_f32_fp8((int)kv[u].y, true);
        f32x2v d2 = k0 * (f32x2v){q[0], q[1]}; d2 = k1 * (f32x2v){q[2], q[3]} + d2; d2 = k2 * (f32x2v){q[4], q[5]} + d2; d2 = k3 * (f32x2v){q[6], q[7]} + d2;
        float d = d2[0] + d2[1];
        d += dpp_f<0xB1>(d); d += dpp_f<0x4E>(d); d += dpp_f<0x141>(d);
        sc[u] = (!MASK || b0 + u < n) ? d : -INFINITY;
        mx = fmaxf(mx, sc[u]); }
    if (__builtin_amdgcn_ballot_w64(mx > S.m) != 0ull) {
        const float scale = __builtin_amdgcn_exp2f(S.m - mx);
        S.l *= scale;
#pragma unroll
        for (int i = 0; i < 8; ++i) S.o[i] *= scale;
        S.m = mx; }
    float my = sc[0];
#pragma unroll
    for (int k = 1; k < 8; ++k) my = (ch == k) ? sc[k] : my;
    const float pmf = __builtin_amdgcn_exp2f(my - mx);
    S.l += pmf;
    const int pmy = __float_as_int(pmf);
    float pv[8];
    pv[0] = __int_as_float(__builtin_amdgcn_ds_swizzle(pmy, 0x18 | (0 << 5))); pv[1] = __int_as_float(__builtin_amdgcn_ds_swizzle(pmy, 0x18 | (1 << 5)));
    pv[2] = __int_as_float(__builtin_amdgcn_ds_swizzle(pmy, 0x18 | (2 << 5))); pv[3] = __int_as_float(__builtin_amdgcn_ds_swizzle(pmy, 0x18 | (3 << 5)));
    pv[4] = __int_as_float(__builtin_amdgcn_ds_swizzle(pmy, 0x18 | (4 << 5))); pv[5] = __int_as_float(__builtin_amdgcn_ds_swizzle(pmy, 0x18 | (5 << 5)));
    pv[6] = __int_as_float(__builtin_amdgcn_ds_swizzle(pmy, 0x18 | (6 << 5))); pv[7] = __int_as_float(__builtin_amdgcn_ds_swizzle(pmy, 0x18 | (7 << 5)));
#pragma unroll
    for (int u = 0; u < 8; ++u) {
        const float p = pv[u];
        const f32x2v v0 = __builtin_amdgcn_cvt_pk_f32_fp8((int)kv[u].z, false), v1 = __builtin_amdgcn_cvt_pk_f32_fp8((int)kv[u].z, true),
                     v2 = __builtin_amdgcn_cvt_pk_f32_fp8((int)kv[u].w, false), v3 = __builtin_amdgcn_cvt_pk_f32_fp8((int)kv[u].w, true);
        S.o[0] += p * v0[0]; S.o[1] += p * v0[1]; S.o[2] += p * v1[0]; S.o[3] += p * v1[1]; S.o[4] += p * v2[0]; S.o[5] += p * v2[1]; S.o[6] += p * v3[0]; S.o[7] += p * v3[1]; }
}

DEVI void attn_query(int t, const bf16_t* __restrict__ Qb, const unsigned char* __restrict__ KV8,
                     const unsigned* SR  , bf16_t* __restrict__ AO, unsigned char* wl, int lane) {
    unsigned* lst = (unsigned*)wl;
    LDS_FENCE();
    const int nw = (t >> 5) + 1; int base = 0;
    for (int w0 = 0; w0 < nw; w0 += 64) {
        const int wi = w0 + lane; const unsigned wv = wi < nw ? SR[wi] : 0u;
        const int pc = __popc(wv); int pre = pc;
#pragma unroll
        for (int off = 1; off < 64; off <<= 1) { const int o_ = __shfl_up(pre, off); if (lane >= off) pre += o_; }
        int pos = base + pre - pc; unsigned mm = wv;
        while (mm) { const int bpos = __ffs((int)mm) - 1; mm &= mm - 1u; if (pos < TOPK) lst[pos] = (unsigned)(wi * 32 + bpos) << 10; ++pos; }
        base += __shfl(pre, 63);
    }
    const int n = base < TOPK ? base : TOPK;
    float q[8];
    { const uint4 qv = ((const uint4*)(Qb + (size_t)t * 512))[lane]; const float qs = 0.18033688011112042f;
      q[0] = bflo(qv.x) * qs; q[1] = bfhi(qv.x) * qs; q[2] = bflo(qv.y) * qs; q[3] = bfhi(qv.y) * qs; q[4] = bflo(qv.z) * qs; q[5] = bfhi(qv.z) * qs; q[6] = bflo(qv.w) * qs; q[7] = bfhi(qv.w) * qs; }
    LDS_FENCE();
    { const unsigned lastk = lst[n - 1]; if (lane < 40) lst[n + lane] = lastk; }
    LDS_FENCE();
    AttnQ S; S.m = -INFINITY; S.l = 0.f;
#pragma unroll
    for (int d = 0; d < 8; ++d) S.o[d] = 0.f;
    uint4 ka[8], kb_[8], kc[8];
    const unsigned lane16 = (unsigned)lane * 16u; const int chq = lane & 7;
#define AT_COMP(b, kv) do { if ((b) + 8 <= n) attn_compute<false>(S, (b), n, q, kv, chq); else attn_compute<true>(S, (b), n, q, kv, chq); } while (0)
    attn_issue(0, lst, KV8, lane16, ka);
    if (8 < n) attn_issue(8, lst, KV8, lane16, kb_);
    for (int b0 = 0; b0 < n; b0 += 24) {
        if (b0 + 16 < n) attn_issue(b0 + 16, lst, KV8, lane16, kc);
        AT_COMP(b0, ka);
        if (b0 + 8 < n) {
            if (b0 + 24 < n) attn_issue(b0 + 24, lst, KV8, lane16, ka);
            AT_COMP(b0 + 8, kb_);
            if (b0 + 16 < n) {
                if (b0 + 32 < n) attn_issue(b0 + 32, lst, KV8, lane16, kb_);
                AT_COMP(b0 + 16, kc);
            }
        }
    }
    const int hd = lane >> 3, ch = lane & 7;
    float lsum = S.l; lsum += dpp_f<0xB1>(lsum); lsum += dpp_f<0x4E>(lsum); lsum += dpp_f<0x141>(lsum);
    const float inv = 1.0f / lsum;
    uint4 pk; pk.x = cvt_pk_bf16(S.o[0] * inv, S.o[1] * inv); pk.y = cvt_pk_bf16(S.o[2] * inv, S.o[3] * inv); pk.z = cvt_pk_bf16(S.o[4] * inv, S.o[5] * inv); pk.w = cvt_pk_bf16(S.o[6] * inv, S.o[7] * inv);
    *(uint4*)(AO + (size_t)t * 1024 + 512 + hd * 64 + ch * 8) = pk;
}

DEVI float relu_i(float x) { const int v = __float_as_int(x); return __int_as_float(v > 0 ? v : 0); }
DEVI int hpos(unsigned w) { return (int)(w + (w >> 5)); }
template <int PASS, bool L0>
DEVI void idx_sweep(int q0, int nkb, int wave, int lane, const bf16x8_t (&Af)[4][4], const bf16_t* __restrict__ KI, unsigned char* lds, unsigned* __restrict__ SELM) {
    const int l31 = lane & 31, h2 = lane >> 5;
    unsigned* hist = (unsigned*)(lds + IL_HIST);
    const float* wiL = (const float*)(lds + IL_WI);
    const uint4* qst = (const uint4*)(lds + IL_QST);
    const uint4* qst2 = (const uint4*)(lds + IL_QST2);
    unsigned* ckey = (unsigned*)(lds + IL_CKEY); unsigned* cidx = (unsigned*)(lds + IL_CIDX); unsigned* ccnt = (unsigned*)(lds + IL_CCNT); unsigned* rows = (unsigned*)(lds + IL_ROWS);
    const bf16_t* kp = KI + (size_t)l31 * 64 + 8 * h2;
    bf16x8_t Bn[4];
    if (wave < nkb) {
#pragma unroll
        for (int ks = 0; ks < 4; ++ks) Bn[ks] = *(const bf16x8_t*)(kp + (size_t)wave * 2048 + 16 * ks); }
    for (int kb = wave; kb < nkb; kb += 8) {
        const int s = kb * 32 + l31;
        bf16x8_t Bf[4];
#pragma unroll
        for (int ks = 0; ks < 4; ++ks) Bf[ks] = Bn[ks];
        if (kb + 8 < nkb) {
#pragma unroll
            for (int ks = 0; ks < 4; ++ks) Bn[ks] = *(const bf16x8_t*)(kp + (size_t)(kb + 8) * 2048 + 16 * ks); }
        f32x16 acc[4];
#pragma unroll
        for (int rb = 0; rb < 4; ++rb) {
#pragma unroll
            for (int i = 0; i < 16; ++i) acc[rb][i] = 0.f; }
#pragma unroll
        for (int ks = 0; ks < 4; ++ks) acc[0] = __builtin_amdgcn_mfma_f32_32x32x16_bf16(Af[0][ks], Bf[ks], acc[0], 0, 0, 0);
        const bool edge = kb * 32 + 31 > q0;
        float4 wn[2][2]; uint4 stn[2];
#pragma unroll
        for (int e = 0; e < 2; ++e) { wn[e][0] = *(const float4*)(wiL + (2 * h2 + e) * 8); wn[e][1] = *(const float4*)(wiL + (2 * h2 + e) * 8 + 4);
            if (PASS == 2) stn[e] = qst2[2 * h2 + e]; else if (!L0) stn[e] = qst[2 * h2 + e]; }
#pragma unroll
        for (int rb = 0; rb < 4; ++rb) {
            if (rb + 1 < 4) {
#pragma unroll
                for (int ks = 0; ks < 4; ++ks) acc[rb + 1] = __builtin_amdgcn_mfma_f32_32x32x16_bf16(Af[rb + 1][ks], Bf[ks], acc[rb + 1], 0, 0, 0); }
            const int qa = 4 * rb + 2 * h2;
            float4 w[2][2]; uint4 st[2];
#pragma unroll
            for (int e = 0; e < 2; ++e) { w[e][0] = wn[e][0]; w[e][1] = wn[e][1]; st[e] = stn[e]; }
            if (rb + 1 < 4) {
#pragma unroll
                for (int e = 0; e < 2; ++e) { wn[e][0] = *(const float4*)(wiL + (qa + 4 + e) * 8); wn[e][1] = *(const float4*)(wiL + (qa + 4 + e) * 8 + 4);
                    if (PASS == 2) stn[e] = qst2[qa + 4 + e]; else if (!L0) stn[e] = qst[qa + 4 + e]; } }
#pragma unroll
            for (int e = 0; e < 2; ++e) {
                const int qs = qa + e;
                f32x2v s2 = (f32x2v){relu_i(acc[rb][8 * e + 0]), relu_i(acc[rb][8 * e + 1])} * (f32x2v){w[e][0].x, w[e][0].y};
                s2 = (f32x2v){relu_i(acc[rb][8 * e + 2]), relu_i(acc[rb][8 * e + 3])} * (f32x2v){w[e][0].z, w[e][0].w} + s2;
                s2 = (f32x2v){relu_i(acc[rb][8 * e + 4]), relu_i(acc[rb][8 * e + 5])} * (f32x2v){w[e][1].x, w[e][1].y} + s2;
                s2 = (f32x2v){relu_i(acc[rb][8 * e + 6]), relu_i(acc[rb][8 * e + 7])} * (f32x2v){w[e][1].z, w[e][1].w} + s2;
                const float sc = s2[0] + s2[1];
                const bool valid = !edge || s <= q0 + qs;
                const unsigned key = f2key(sc);
                if (PASS == 1) {
                    if (L0) { if (valid) { const unsigned bin = key >> 20; atomicAdd(&hist[qs * HROW + hpos(bin >> 1)], (bin & 1u) ? 0x10000u : 1u); } }
                    else if (valid && (key & st[e].x) == st[e].y) { const unsigned bin = (key >> st[e].z) & st[e].w; atomicAdd(&hist[qs * HROW + hpos(bin >> 1)], (bin & 1u) ? 0x10000u : 1u); }
                } else {
                    const bool ge_hi = key >= st[e].y;
                    const bool sel = valid && ge_hi;
                    const bool cnd = valid && !ge_hi && key >= st[e].x;
                    const unsigned long long bal = __ballot(sel);
                    rows[qs * SW + kb] = h2 ? (unsigned)(bal >> 32) : (unsigned)bal;
                    if (cnd) { const unsigned n = atomicAdd(&ccnt[qs], 1u); if (n < (unsigned)CB) { ckey[qs * CB + n] = key; cidx[qs * CB + n] = (unsigned)s; } }
                }
            }
        }
    }
}

DEVI void indexer_tile(int q0, const bf16_t* __restrict__ QI, const bf16_t* __restrict__ KI, const float* __restrict__ WI, const bf16_t* __restrict__ Qb, const unsigned char* __restrict__ KV8, bf16_t* __restrict__ AO, unsigned char* lds) {
    const int tid = otid(), lane = tid & 63, wave = tid >> 6;
    unsigned* hist = (unsigned*)(lds + IL_HIST);
    float* wiL = (float*)(lds + IL_WI);
    uint4* qst = (uint4*)(lds + IL_QST); uint4* qst2 = (uint4*)(lds + IL_QST2);
    unsigned* ckey = (unsigned*)(lds + IL_CKEY); unsigned* cidx = (unsigned*)(lds + IL_CIDX); unsigned* hist2 = (unsigned*)(lds + IL_HIST2); unsigned* ccnt = (unsigned*)(lds + IL_CCNT);
    volatile unsigned* flag = (volatile unsigned*)(lds + IL_FLAG);
    const int nkb = (q0 + 16 + 31) >> 5;
    bf16x8_t Af[4][4];
    { const int rho = lane & 31, hq = lane >> 5; const int qq = 2 * ((rho >> 2) & 1) + (rho >> 4), head = 4 * ((rho >> 3) & 1) + (rho & 3);
#pragma unroll
      for (int rb = 0; rb < 4; ++rb)
#pragma unroll
          for (int ks = 0; ks < 4; ++ks) Af[rb][ks] = *(const bf16x8_t*)(QI + (size_t)(q0 + 4 * rb + qq) * 512 + head * 64 + 16 * ks + 8 * hq); }
    __syncthreads();
    if (tid < 128) wiL[tid] = WI[(size_t)q0 * 8 + tid] * 0.125f;
    if (tid < 16) { const unsigned z = opq(0u); qst[tid] = make_uint4(z, z, opq(20u), opq(4095u)); qst2[tid] = make_uint4(z, z, opq((unsigned)TOPK), z); ccnt[tid] = z; }
    for (int level = 0; level < 3; ++level) {
        for (int i = tid; i < 16 * HROW / 4; i += NTHREADS) ((uint4*)hist)[i] = make_uint4(0u, 0u, 0u, 0u);
        if (tid == 0) flag[0] = 0u;
        __syncthreads();
        if (level == 0) idx_sweep<1, true>(q0, nkb, wave, lane, Af, KI, lds, nullptr); else idx_sweep<1, false>(q0, nkb, wave, lane, Af, KI, lds, nullptr);
        __syncthreads();
#pragma unroll 1
        for (int qi = 0; qi < 2; ++qi) {
            const int qs = 2 * wave + qi;
            const uint4 st = qst[qs]; const uint4 b = qst2[qs];
            if (st.x == 0xFFFFFFFFu && st.y == 0u && st.w == 0u) continue;
            unsigned wv[32]; unsigned loc = 0u;
#pragma unroll
            for (int i = 0; i < 32; ++i) { wv[i] = hist[qs * HROW + 33 * lane + i]; loc += (wv[i] & 0xFFFFu) + (wv[i] >> 16); }
            unsigned suf = loc;
#pragma unroll
            for (int off = 1; off < 64; off <<= 1) { const unsigned o = __shfl_down(suf, off); if (lane + off < 64) suf += o; }
            const unsigned total = __shfl(suf, 0), above = suf - loc, need = b.z;
            if (level == 0 && total <= need) { if (lane == 0) { qst[qs] = make_uint4(0xFFFFFFFFu, 0u, 0u, 0u); qst2[qs] = make_uint4(0u, 0u, 0xFFFFFFFFu, 0u); } continue; }
            const bool mine = above < need && need <= above + loc;
            unsigned cum = above, c = 0u; int d = 0; bool found = false;
#pragma unroll
            for (int i = 31; i >= 0; --i) {
                const unsigned chi = wv[i] >> 16, clo = wv[i] & 0xFFFFu;
                if (!found && cum + chi >= need) { found = true; d = 64 * lane + 2 * i + 1; c = chi; } if (!found) cum += chi;
                if (!found && cum + clo >= need) { found = true; d = 64 * lane + 2 * i; c = clo; } if (!found) cum += clo; }
            if (mine) {
                const unsigned pval = st.y | ((unsigned)d << st.z), pmask = st.x | (st.w << st.z);
                const unsigned nneed = need - cum;
                const unsigned long long hi64 = (unsigned long long)pval + (1ull << st.z);
                const unsigned hi = hi64 > 0xFFFFFFFFull ? 0xFFFFFFFFu : (unsigned)hi64;
                if (c <= (unsigned)CB || level == 2) { qst[qs] = make_uint4(0xFFFFFFFFu, 0u, 0u, 0u); qst2[qs] = make_uint4(pval, hi, nneed, st.z); }
                else { const unsigned nsh = (level == 0) ? 8u : 0u, ndm = (level == 0) ? 4095u : 255u; qst[qs] = make_uint4(pmask, pval, nsh, ndm); qst2[qs] = make_uint4(pval, hi, nneed, st.z); flag[0] = 1u; }
            }
        }
        __syncthreads();
        if (flag[0] == 0u) break;
        __syncthreads();
    }
    __syncthreads();
    idx_sweep<2, false>(q0, nkb, wave, lane, Af, KI, lds, nullptr);
    asm volatile("s_waitcnt vmcnt(0)" ::: "memory");
    __syncthreads();
    unsigned* rows = (unsigned*)(lds + IL_ROWS);
#pragma unroll 1
    for (int qi = 0; qi < 2; ++qi) {
        const int qs = 2 * wave + qi;
        const uint4 b = qst2[qs];
        unsigned* row = rows + qs * SW;
        if (b.z != 0xFFFFFFFFu) {
            const unsigned need = b.z; const unsigned cn = ccnt[qs]; const int n = (int)(cn < (unsigned)CB ? cn : (unsigned)CB);
            const unsigned rem = b.w;
            const unsigned sh8 = rem > 8u ? rem - 8u : 0u; const unsigned m8 = rem >= 8u ? 255u : ((1u << rem) - 1u);
#pragma unroll
            for (int i = 0; i < 4; ++i) hist2[qs * 256 + 4 * lane + i] = 0u;
            asm volatile("s_waitcnt lgkmcnt(0)" ::: "memory");
            for (int i = lane; i < n; i += 64) atomicAdd(&hist2[qs * 256 + ((ckey[qs * CB + i] >> sh8) & m8)], 1u);
            asm volatile("s_waitcnt lgkmcnt(0)" ::: "memory");
            unsigned c4[4]; unsigned loc = 0u;
#pragma unroll
            for (int i = 0; i < 4; ++i) { c4[i] = hist2[qs * 256 + 4 * lane + i]; loc += c4[i]; }
            unsigned suf = loc;
#pragma unroll
            for (int off = 1; off < 64; off <<= 1) { const unsigned o = __shfl_down(suf, off); if (lane + off < 64) suf += o; }
            const unsigned above = suf - loc;
            const bool mine = above < need && need <= above + loc;
            unsigned b2 = 0u, need2 = 0u;
            if (mine) { unsigned cum = above; int i = 3; for (; i > 0; --i) { if (cum + c4[i] >= need) break; cum += c4[i]; } b2 = 4u * lane + i; need2 = need - cum; }
            const unsigned long long mb = __ballot(mine);
            if (mb == 0ull) {
                for (int i = lane; i < n; i += 64) if ((unsigned)i < need) { const unsigned ii = cidx[qs * CB + i]; atomicOr(&row[ii >> 5], 1u << (ii & 31u)); }
            } else {
                const int src = __ffsll((long long)mb) - 1;
                b2 = __shfl(b2, src); need2 = __shfl(need2, src);
                for (int i0 = 0; i0 < n; i0 += 64) {
                    const int i = i0 + lane; const bool act = i < n;
                    const unsigned ki = act ? ckey[qs * CB + i] : 0u, ii = act ? cidx[qs * CB + i] : 0u; const unsigned d8 = (ki >> sh8) & m8;
                    if (act && d8 > b2) atomicOr(&row[ii >> 5], 1u << (ii & 31u));
                    unsigned long long tie = __ballot(act && d8 == b2);
                    while (tie) {
                        const int ml = __ffsll((long long)tie) - 1; tie &= tie - 1ull;
                        const unsigned km = __shfl(ki, ml), im = __shfl(ii, ml);
                        unsigned rank = 0u;
                        for (int j0 = 0; j0 < n; j0 += 64) { const int j = j0 + lane; bool beats = false;
                            if (j < n) { const unsigned kj = ckey[qs * CB + j], ij = cidx[qs * CB + j]; beats = ((kj >> sh8) & m8) == b2 && (kj > km || (kj == km && ij < im)); }
                            rank += (unsigned)__popcll(__ballot(beats)); }
                        if (rank < need2 && lane == ml) atomicOr(&row[im >> 5], 1u << (im & 31u));
                    }
                }
            }
        }
    }
    asm volatile("s_waitcnt lgkmcnt(0)" ::: "memory");
    __syncthreads();
    for (int qi = 0; qi < 2; ++qi) { const int qs = 2 * wave + qi;
        attn_query(q0 + qs, Qb, KV8, rows + qs * SW, AO, lds + IL_QF + wave * AT_LB, lane); }
}

DEVI TrJob moe_job(int j, const float* wg, const float* wu, const float* wd, bf16_t* WGU, bf16_t* WD) {
    TrJob J{};
    if (j < 32 * 256) { const int e = j >> 8, t = j & 255; J.dst = WGU + (size_t)e * 1024 * 1024; J.s0 = wg + (size_t)e * D * DE; J.s1 = wu + (size_t)e * D * DE; J.K = 1024; J.n0 = (t >> 4) * 64; J.k0 = (t & 15) * 64; J.mode = 2; return J; }
    j -= 32 * 256;
    { const int e = j >> 7, t = j & 127; J.dst = WD + (size_t)e * 1024 * 512; J.s0 = wd + (size_t)e * DE * D; J.ld = D; J.K = 512; J.n0 = (t >> 3) * 64; J.k0 = (t & 7) * 64; J.mode = 0; return J; }
}
constexpr int MOE0_ALL = 32 * 256 + 32 * 128, MOE0_P1W = 28, MOE0_P4W = 10;
constexpr int P1_BUSY = (LP / 256) * 13 - 3 * 256, P4_BUSY = 8;
constexpr int MOE0_P7 = 2688;
constexpr int MOE0_P1 = (256 - P1_BUSY) * MOE0_P1W, MOE0_P4 = (256 - P4_BUSY) * MOE0_P4W, MOE0_P0 = MOE0_ALL - MOE0_P1 - MOE0_P4 - MOE0_P7;
static_assert(MOE0_P0 > 0 && P1_BUSY == 77 && MOE0_P0 + MOE0_P1 + MOE0_P4 >= 32 * 256, "tail split (the P7 tail may only write WD)");
constexpr int P10_BUSY = (LP / 256) * 10 - 2 * 256;
constexpr int MOE1_P8 = 1536, MOE1_P10 = (256 - P10_BUSY) * 25, MOE1_P15 = MOE0_ALL - MOE1_P8 - MOE1_P10;
static_assert(P10_BUSY == 138 && MOE1_P8 <= 32 * 256 && MOE1_P15 > 0, "tail split, layer 1");
DEVI void moe_idle(const int* mtiles, int& rank, int& cnt) { const int G = (int)gridDim.x, nun = mtiles[0] * 4, busy = nun % G;
    if (busy == 0) { rank = (int)blockIdx.x; cnt = G; } else { rank = (int)blockIdx.x - busy; cnt = G - busy; } }

__global__ void __launch_bounds__(NTHREADS, 2) fwd(Args a) {
    extern __shared__ __attribute__((aligned(16))) unsigned char lds_raw[];
    float* smf = (float*)lds_raw;
    PG8_LAS unsigned char* ldsp = (PG8_LAS unsigned char*)lds_raw;
    const int nwaves = gridDim.x * 8;
#define PHASE_VARS const int tid = otid(); const int lane = tid & 63, wave = tid >> 6; const int gwave = blockIdx.x * 8 + wave; (void)lane; (void)wave; (void)gwave;
    unsigned char* ws = a.ws;
    unsigned* ctl = (unsigned*)(ws + WS_CTL);
    const int lo = a.ph_lo, hi = a.ph_hi;

    volatile LAS unsigned* bst = (volatile LAS unsigned*)((LAS unsigned char*)lds_raw + (LDS_BYTES - 16));
    if (threadIdx.x == 0) { bst[0] = 0u; bst[1] = 0u; bst[2] = 0u; bst[3] = 0u; }
    __syncthreads();
    XcdBarrier bar; bar.bar = ctl; bar.x = 0; bar.st = bst;
    if (hi - lo > 1) bar = xcd_barrier_post(ctl, bst);
#define IN(k) (lo <= (k) && (k) < hi)
#define SEAM(k) do { if (IN(k) && IN((k) + 1)) xcd_barrier(bar); } while (0)

    const float* x = a.in[0]; const float* meta = a.in[1];
    float* ropeC = (float*)(ws + WS_ROPEC); float* ropeS = (float*)(ws + WS_ROPES);
    int* eid = (int*)(ws + WS_EID); float* gw = (float*)(ws + WS_GW); int* slot = (int*)(ws + WS_SLOT); int* mtiles = (int*)(ws + WS_MTILES);
    unsigned* counts0 = (unsigned*)(ws + CTL_CNT); unsigned* counts1 = counts0 + 32;
    unsigned* cursor0 = (unsigned*)(ws + CTL_CUR); unsigned* cursor1 = cursor0 + 32;
    bf16_t* Wta = (bf16_t*)(ws + WS_WTA); bf16_t* Wtx = (bf16_t*)(ws + WS_WTX);
    float* Aend = (float*)(ws + WS_AEND); float* Hend = (float*)(ws + WS_HEND); float* CIN = (float*)(ws + WS_CIN);
    unsigned char* big = ws + WS_BIG;
    bf16_t* WIN0 = (bf16_t*)(big + R_WIN0); bf16_t* WOUT0 = (bf16_t*)(big + R_WOUT0); bf16_t* WGU = (bf16_t*)(big + R_WGU); bf16_t* WD = (bf16_t*)(big + R_WD);
    bf16_t* WIN1 = (bf16_t*)(big + R_WIN1); bf16_t* WOUT1 = (bf16_t*)(big + R_WOUT1);
    bf16_t* X0b = (bf16_t*)(big + R_A); bf16_t* AO = (bf16_t*)(big + R_A); bf16_t* Xperm = (bf16_t*)(big + R_A); bf16_t* X2b = (bf16_t*)(big + R_A); bf16_t* YY = (bf16_t*)(big + R_A);
    float* H1 = (float*)(big + R_H1); float* H3 = (float*)(big + R_H1); float* H2 = (float*)(big + R_H2); unsigned* SELM = (unsigned*)(big + R_H1); unsigned* SELM2 = (unsigned*)(big + R_H1 + 36 * MiB);
    float* Z = (float*)(big + R_C); bf16_t* Yb = (bf16_t*)(big + R_C); float* Z1 = (float*)(big + R_C);
    unsigned char* KV8 = big + R_K;
    bf16_t* GLU = (bf16_t*)(big + R_GLU); bf16_t* Qb = (bf16_t*)(big + R_Q); bf16_t* Kb = (bf16_t*)(big + R_K); bf16_t* Vb = (bf16_t*)(big + R_V);
    bf16_t* QIb = (bf16_t*)(big + R_QI); bf16_t* KIb = (bf16_t*)(big + R_KI); float* WIf = (float*)(big + R_WI);
    bf16_t* GATEg = (bf16_t*)(big + R_GATE); bf16_t* XRb = (bf16_t*)(big + R_XR);
    bf16_t* Hm = (bf16_t*)(big + R_HM);

    if (IN(0)) { PHASE_VARS;
        const float* w_in = a.in[2]; const float* w_out = a.in[7]; const float* wg = a.in[21]; const float* wu = a.in[22]; const float* wd = a.in[23];
        constexpr int J_IN0 = 52 * 16, J_OUT0 = 16 * 16, J_GU = 32 * 256, J_D = 32 * 128, J_IN1 = 40 * 16, J_OUT1 = 16 * 20, J_GT = 80;
        const float* w_in1 = a.in[8]; const float* w_out1 = a.in[16]; const float* wga = a.in[11]; const float* wgx = a.in[13];
        const int moe_p0 = gridDim.x == 256 ? MOE0_P0 : MOE0_ALL;
        tr_run(J_IN0 + J_OUT0 + moe_p0 + J_IN1 + J_OUT1 + J_GT, [&](int j) -> TrJob {
            TrJob J{};
            if (j < J_IN0) { J.dst = WIN0; J.s0 = w_in; J.K = 1024; J.n0 = (j >> 4) * 64; J.k0 = (j & 15) * 64; J.mode = 1; return J; }
            j -= J_IN0;
            if (j < J_OUT0) { J.dst = WOUT0; J.s0 = w_out; J.ld = D; J.K = 1024; J.n0 = (j >> 4) * 64; J.k0 = (j & 15) * 64; J.mode = 0; return J; }
            j -= J_OUT0;
            if (j < moe_p0) return moe_job(j, wg, wu, wd, WGU, WD);
            j -= moe_p0;
            if (j < J_IN1) { J.dst = WIN1; J.s0 = w_in1; J.ld = 2 * RNN_W; J.K = 1024; J.n0 = (j >> 4) * 64; J.k0 = (j & 15) * 64; J.mode = 0; return J; }
            j -= J_IN1;
            if (j < J_OUT1) { J.dst = WOUT1; J.s0 = w_out1; J.ld = D; J.K = RNN_W; J.n0 = (j / 20) * 64; J.k0 = (j % 20) * 64; J.mode = 0; return J; }
            j -= J_OUT1;
            { const int which = j / 40, r = j % 40; const int nb = r >> 2;
              J.dst = (which ? Wtx : Wta) + (size_t)nb * 128 * 128; J.s0 = (which ? wgx : wga) + (size_t)nb * 128 * 128; J.ld = 128; J.K = 128; J.n0 = ((r >> 1) & 1) * 64; J.k0 = (r & 1) * 64; J.mode = 0; return J; }
        }, smf);
        for (size_t i = (size_t)blockIdx.x * NTHREADS + tid; i < (size_t)LP * 256; i += (size_t)gridDim.x * NTHREADS) {
            const size_t r = i >> 8, c4 = i & 255;
            float4 v = make_float4(0.f, 0.f, 0.f, 0.f);
            if (r < NMETA) v = ((const float4*)meta)[r * 256 + c4]; else if (r < L) v = ((const float4*)x)[(r - NMETA) * 256 + c4];
            ((uint2*)X0b)[i] = make_uint2(cvt_pk_bf16(v.x, v.y), cvt_pk_bf16(v.z, v.w));
        }
        for (int i = blockIdx.x * NTHREADS + tid; i < 2 * 64 * 3 * 64; i += gridDim.x * NTHREADS) {
            const int ln = i & 63, ct = (i >> 6) % 3, ss = (i / 192) & 63, ly = i / (192 * 64);
            const int col = 16 * ct + (ln & 15), k0 = 16 * ss + 4 * (ln >> 4);
            float v[4];
#pragma unroll
            for (int j = 0; j < 4; ++j) v[j] = col < 4 ? a.in[17][(size_t)ly * D * NGRP + (size_t)(k0 + j) * NGRP + col] : col < 36 ? a.in[19][(size_t)ly * D * NE + (size_t)(k0 + j) * NE + (col - 4)] : 0.f;
            ((float4*)(ws + WS_WR))[i] = make_float4(v[0], v[1], v[2], v[3]);
        }
        for (int i = blockIdx.x * NTHREADS + tid; i < LP * 32; i += gridDim.x * NTHREADS) {
            const int p = i >> 5, f = i & 31;
            const float inv = (float)pow(10000.0, -(double)f / 32.0);
            const float ang = (float)p * inv;
            ropeC[i] = (float)cos((double)ang); ropeS[i] = (float)sin((double)ang);
        }
    }
    SEAM(0);
    if (IN(1)) { PHASE_VARS;
        pg8::Gemm g{X0b, WIN0, LP, 3328, 1024}; pg8::StaticOrder S; S.init(LP, 3328, (int)gridDim.x, (int)blockIdx.x);
        EpiIn0 E{GLU, KIb, WIf, ropeC, ropeS, KV8};
        pg8::gemm_phase<EpiIn0, pg8::StaticOrder, GEMM_ALIGN, GEMM_SP2>(ldsp, g, S, E);
        if (gridDim.x == 256 && (int)blockIdx.x >= P1_BUSY) { __syncthreads();
            tr_run(MOE0_P1, [&](int j) -> TrJob { return moe_job(MOE0_P0 + j, a.in[21], a.in[22], a.in[23], WGU, WD); }, smf, (int)blockIdx.x - P1_BUSY, 256 - P1_BUSY); }
    }
    SEAM(1);
    if (IN(2)) { PHASE_VARS;
        const float* cw = a.in[3]; const float* cb = a.in[4]; const float* lg = a.in[5]; const float* lb = a.in[6];
        for (int g4 = gwave; g4 < L / 4; g4 += nwaves) {
            const int t0 = g4 * 4, c0 = lane * 8;
            float acc[4][8], wwin[4][8];
            { const float4 b0 = *(const float4*)(cb + c0), b1 = *(const float4*)(cb + c0 + 4);
#pragma unroll
              for (int q = 0; q < 4; ++q) { acc[q][0] = b0.x; acc[q][1] = b0.y; acc[q][2] = b0.z; acc[q][3] = b0.w; acc[q][4] = b1.x; acc[q][5] = b1.y; acc[q][6] = b1.z; acc[q][7] = b1.w; } }
#pragma unroll
            for (int r = 0; r < CONV_K + 3; ++r) {
                const int tt = t0 - (CONV_K - 1) + r;
                if (r < CONV_K) { const float4 w0 = *(const float4*)(cw + r * CONV_CH + c0), w1 = *(const float4*)(cw + r * CONV_CH + c0 + 4);
                    wwin[r & 3][0] = w0.x; wwin[r & 3][1] = w0.y; wwin[r & 3][2] = w0.z; wwin[r & 3][3] = w0.w; wwin[r & 3][4] = w1.x; wwin[r & 3][5] = w1.y; wwin[r & 3][6] = w1.z; wwin[r & 3][7] = w1.w; }
                if (tt >= 0) {
                    const uint4 xv = *(const uint4*)(GLU + (size_t)tt * 512 + c0);
                    const float x[8] = {bflo(xv.x), bfhi(xv.x), bflo(xv.y), bfhi(xv.y), bflo(xv.z), bfhi(xv.z), bflo(xv.w), bfhi(xv.w)};
#pragma unroll
                    for (int q = 0; q < 4; ++q) { const int j = r - q;
                        if (j >= 0 && j < CONV_K) {
#pragma unroll
                            for (int i = 0; i < 8; ++i) acc[q][i] += wwin[j & 3][i] * x[i]; } }
                }
            }
            float gv[8], bvv[8];
            { const float4 g0 = *(const float4*)(lg + c0), g1 = *(const float4*)(lg + c0 + 4), b0 = *(const float4*)(lb + c0), b1 = *(const float4*)(lb + c0 + 4);
              gv[0] = g0.x; gv[1] = g0.y; gv[2] = g0.z; gv[3] = g0.w; gv[4] = g1.x; gv[5] = g1.y; gv[6] = g1.z; gv[7] = g1.w; bvv[0] = b0.x; bvv[1] = b0.y; bvv[2] = b0.z; bvv[3] = b0.w; bvv[4] = b1.x; bvv[5] = b1.y; bvv[6] = b1.z; bvv[7] = b1.w; }
#pragma unroll
            for (int q = 0; q < 4; ++q) {
                float s_ = 0.f;
#pragma unroll
                for (int i = 0; i < 8; ++i) s_ += acc[q][i];
                const float mu = wave_sum(s_) * (1.0f / 512.0f);
                float qq = 0.f;
#pragma unroll
                for (int i = 0; i < 8; ++i) { const float d = acc[q][i] - mu; qq += d * d; }
                const float rstd = 1.0f / sqrtf(wave_sum(qq) * (1.0f / 512.0f) + LN_EPS);
                float o[8];
#pragma unroll
                for (int i = 0; i < 8; ++i) { const float yv = (acc[q][i] - mu) * rstd * gv[i] + bvv[i]; o[i] = yv * fsigm(yv); }
                uint4 w; w.x = cvt_pk_bf16(o[0], o[1]); w.y = cvt_pk_bf16(o[2], o[3]); w.z = cvt_pk_bf16(o[4], o[5]); w.w = cvt_pk_bf16(o[6], o[7]);
                *(uint4*)(AO + (size_t)(t0 + q) * 1024 + c0) = w;
            }
        }
        { const int b = (int)blockIdx.x, G = (int)gridDim.x; const int p = b & 3; const bool rev = (b >> 2) & 1;
          const int nfull = NTILE / G;
          for (int k = 0; k < nfull; ++k) {
              const int r = (nfull == 4) ? ((rev ? p - k : p + k) & 3) : k;
              const int idx = r * G + ((r & 1) ? G - 1 - b : b);
              indexer_tile((NTILE - 1 - idx) * 16, QIb, KIb, WIf, Qb, KV8, AO, lds_raw);
          }
          for (int idx = nfull * G + b; idx < NTILE; idx += G) indexer_tile((NTILE - 1 - idx) * 16, QIb, KIb, WIf, Qb, KV8, AO, lds_raw);
        }
    }
    SEAM(2);
    SEAM(3);
    if (IN(4)) { PHASE_VARS;
        pg8::Gemm g{AO, WOUT0, SEQ, 1024, 1024}; pg8::StaticOrder S; S.init(SEQ, 1024, (int)gridDim.x, (int)blockIdx.x);
        EpiRes0 E{x, meta, Z};
        pg8::gemm_phase<EpiRes0, pg8::StaticOrder, GEMM_ALIGN, GEMM_SP2>(ldsp, g, S, E);
        const int G = (int)gridDim.x, nsk = G >= 16 ? 8 : G;
        if ((int)blockIdx.x >= G - nsk) {
            for (int tl = ((int)blockIdx.x - (G - nsk)) * 8 + wave; tl < 64; tl += nsk * 8) {
                const int col = lane & 15, quad = lane >> 4, n0 = 16 * tl;
                const bf16_t* ap = AO + (size_t)(SEQ + col) * 1024 + 8 * quad; const bf16_t* bp = WOUT0 + (size_t)(n0 + col) * 1024 + 8 * quad;
                f32x4 c0 = {0.f, 0.f, 0.f, 0.f}, c1 = {0.f, 0.f, 0.f, 0.f};
#pragma unroll 8
                for (int ks = 0; ks < 32; ks += 2) {
                    c0 = __builtin_amdgcn_mfma_f32_16x16x32_bf16(*(const bf16x8_t*)(ap + 32 * ks), *(const bf16x8_t*)(bp + 32 * ks), c0, 0, 0, 0);
                    c1 = __builtin_amdgcn_mfma_f32_16x16x32_bf16(*(const bf16x8_t*)(ap + 32 * ks + 32), *(const bf16x8_t*)(bp + 32 * ks + 32), c1, 0, 0, 0); }
#pragma unroll
                for (int j = 0; j < 4; ++j) { const size_t row = (size_t)SEQ + 4 * quad + j;
                    Z[row * D + n0 + col] = DN_ALPHA * x[(row - NMETA) * D + n0 + col] + (c0[j] + c1[j]); }
            }
        } else if (G == 256) { __syncthreads();
            tr_run(MOE0_P4, [&](int j) -> TrJob { return moe_job(MOE0_P0 + MOE0_P1 + j, a.in[21], a.in[22], a.in[23], WGU, WD); }, smf, (int)blockIdx.x, 256 - 8); }
    }
    SEAM(4);
    if (IN(5)) {
        for (int blk = blockIdx.x; blk < SEQ / 64; blk += gridDim.x)
            ln_route_block(NMETA + 64 * blk, 64, Z, H1, a.in[24], a.in[25], (const float4*)(ws + WS_WR), a.in[18], a.in[20], eid, gw, counts0, smf);
        if (blockIdx.x == gridDim.x - 1)
            ln_route_block(0, NMETA, Z, H1, a.in[24], a.in[25], (const float4*)(ws + WS_WR), a.in[18], a.in[20], eid, gw, counts0, smf);
    }
    SEAM(5);
    if (IN(6)) { PHASE_VARS; moe_dispatch_mfma(H1, eid, counts0, cursor0, slot, mtiles, Xperm, (int*)lds_raw, gwave, nwaves, lane, 0); }
    SEAM(6);
    if (IN(7)) { PHASE_VARS;
        pg8::Gemm g{Xperm, WGU, MAXSLOT, 1024, 1024}; MoeOrder S; S.init(mtiles, (int)gridDim.x, (int)blockIdx.x);
        EpiGateUp E{Hm};
        pg8::gemm_phase<EpiGateUp, MoeOrder, GEMM_ALIGN, GEMM_SP2>(ldsp, g, S, E);
        if (gridDim.x == 256) { int rk, cn; moe_idle(mtiles, rk, cn); if (rk >= 0) { __syncthreads();
            tr_run(MOE0_P7, [&](int j) -> TrJob { return moe_job(MOE0_ALL - MOE0_P7 + j, a.in[21], a.in[22], a.in[23], WGU, WD); }, smf, rk, cn); } }
    }
    SEAM(7);
    if (IN(8)) { PHASE_VARS;
        pg8::Gemm g{Hm, WD, MAXSLOT, 1024, 512}; MoeOrder S; S.init(mtiles, (int)gridDim.x, (int)blockIdx.x);
        EpiDown E{Yb};
        pg8::gemm_phase<EpiDown, MoeOrder, GEMM_ALIGN, GEMM_SP2>(ldsp, g, S, E);
        if (gridDim.x == 256) { int rk, cn; moe_idle(mtiles, rk, cn); if (rk >= 0) { __syncthreads();
            tr_run(MOE1_P8, [&](int j) -> TrJob { return moe_job(j, a.in[21] + (size_t)NE * D * DE, a.in[22] + (size_t)NE * D * DE, a.in[23] + (size_t)NE * DE * D, WGU, WD); }, smf, rk, cn); } }
    }
    SEAM(8);
    if (IN(9)) { PHASE_VARS;
#pragma unroll 2
        for (int t = gwave; t < L; t += nwaves) {
            const int s0 = slot[2 * t], s1 = slot[2 * t + 1]; const float g0 = gw[2 * t], g1 = gw[2 * t + 1];
            float y[16];
            combine_row(y, H1 + (size_t)t * D, Yb + (size_t)s0 * D, Yb + (size_t)s1 * D, g0, g1, lane);
            ln_row1024w(y, a.in[26], a.in[27], lane);
#pragma unroll
            for (int i4 = 0; i4 < 4; ++i4) { *(float4*)(H2 + (size_t)t * D + 256 * i4 + 4 * lane) = make_float4(y[4 * i4], y[4 * i4 + 1], y[4 * i4 + 2], y[4 * i4 + 3]);
                *(uint2*)(X2b + (size_t)t * D + 256 * i4 + 4 * lane) = make_uint2(cvt_pk_bf16(y[4 * i4], y[4 * i4 + 1]), cvt_pk_bf16(y[4 * i4 + 2], y[4 * i4 + 3])); }
        }
        for (int i = blockIdx.x * NTHREADS + tid; i < (LP - L) * D / 8; i += gridDim.x * NTHREADS) ((uint4*)(X2b + (size_t)L * D))[i] = make_uint4(0u, 0u, 0u, 0u);
    }
    SEAM(9);
    if (IN(10)) {
        pg8::Gemm g{X2b, WIN1, LP, 2 * RNN_W, 1024}; pg8::StaticOrder S; S.init(LP, 2 * RNN_W, (int)gridDim.x, (int)blockIdx.x);
        EpiIn1 E{GATEg};
        pg8::gemm_phase<EpiIn1, pg8::StaticOrder, GEMM_ALIGN, GEMM_SP2>(ldsp, g, S, E);
        if (gridDim.x == 256 && (int)blockIdx.x >= P10_BUSY) { __syncthreads();
            tr_run(MOE1_P10, [&](int j) -> TrJob { return moe_job(MOE1_P8 + j, a.in[21] + (size_t)NE * D * DE, a.in[22] + (size_t)NE * D * DE, a.in[23] + (size_t)NE * DE * D, WGU, WD); }, smf, (int)blockIdx.x - P10_BUSY, 256 - P10_BUSY); }
    }
    SEAM(10);
    if (IN(11)) rglru_phase<false>(XRb, GATEg, Wta, Wtx, a.in[9], a.in[10], a.in[12], a.in[14], a.in[15], Aend, Hend, CIN, YY, lds_raw);
    SEAM(11);
    if (IN(12)) { PHASE_VARS;
        for (int ch = gwave; ch < RNN_W; ch += nwaves) {
            float A[5], H[5];
#pragma unroll
            for (int i = 0; i < 5; ++i) { const int c = 5 * lane + i; const bool ok = c < NCHUNK; A[i] = ok ? Aend[(size_t)ch * CP + c] : 1.f; H[i] = ok ? Hend[(size_t)ch * CP + c] : 0.f; }
            float Al = 1.f, Hl = 0.f;
#pragma unroll
            for (int i = 0; i < 5; ++i) { Hl = A[i] * Hl + H[i]; Al *= A[i]; }
#pragma unroll
            for (int off = 1; off < 64; off <<= 1) { const float Ap = __shfl_up(Al, off), Hp = __shfl_up(Hl, off); if (lane >= off) { Hl = Al * Hp + Hl; Al = Al * Ap; } }
            float cin = __shfl_up(Hl, 1); if (lane == 0) cin = 0.f;
#pragma unroll
            for (int i = 0; i < 5; ++i) { const int c = 5 * lane + i; if (c < NCHUNK) { CIN[(size_t)ch * CP + c] = cin; cin = A[i] * cin + H[i]; } }
        }
    }
    SEAM(12);
    if (IN(13)) rglru_phase<true>(XRb, GATEg, Wta, Wtx, a.in[9], a.in[10], a.in[12], a.in[14], a.in[15], Aend, Hend, CIN, YY, lds_raw);
    SEAM(13);
    if (IN(14)) {
        pg8::Gemm g{YY + (size_t)NMETA * RNN_W, WOUT1, SEQ, 1024, RNN_W}; pg8::StaticOrder S; S.init(SEQ, 1024, (int)gridDim.x, (int)blockIdx.x);
        EpiRes1 E{H2 + (size_t)NMETA * D, Z1 + (size_t)NMETA * D};
        pg8::gemm_phase<EpiRes1, pg8::StaticOrder, GEMM_ALIGN, GEMM_SP2>(ldsp, g, S, E);
    }
    SEAM(14);
    if (IN(15)) { PHASE_VARS;
        const float* wg = a.in[21] + (size_t)NE * D * DE; const float* wu = a.in[22] + (size_t)NE * D * DE; const float* wd = a.in[23] + (size_t)NE * DE * D;
        { const int done = gridDim.x == 256 ? MOE1_P8 + MOE1_P10 : 0;
          tr_run(MOE0_ALL - done, [&](int j) -> TrJob { return moe_job(done + j, wg, wu, wd, WGU, WD); }, smf); }
        __syncthreads();
        for (int tb = NMETA + blockIdx.x * 64; tb < L; tb += gridDim.x * 64)
            ln_route_block(tb, (L - tb) < 64 ? (L - tb) : 64, Z1, H3, a.in[24] + D, a.in[25] + D, (const float4*)(ws + WS_WR) + 64 * 3 * 64, a.in[18] + NGRP, a.in[20] + NE, eid, gw, counts1, smf);
    }
    SEAM(15);
    if (IN(16)) { PHASE_VARS; moe_dispatch_mfma(H3, eid, counts1, cursor1, slot, mtiles, Xperm, (int*)lds_raw, gwave, nwaves, lane, 2 * NMETA); }
    SEAM(16);
    if (IN(17)) {
        pg8::Gemm g{Xperm, WGU, MAXSLOT, 1024, 1024}; MoeOrder S; S.init(mtiles, (int)gridDim.x, (int)blockIdx.x);
        EpiGateUp E{Hm};
        pg8::gemm_phase<EpiGateUp, MoeOrder, GEMM_ALIGN, GEMM_SP2>(ldsp, g, S, E);
    }
    SEAM(17);
    if (IN(18)) {
        pg8::Gemm g{Hm, WD, MAXSLOT, 1024, 512}; MoeOrder S; S.init(mtiles, (int)gridDim.x, (int)blockIdx.x);
        EpiDown E{Yb};
        pg8::gemm_phase<EpiDown, MoeOrder, GEMM_ALIGN, GEMM_SP2>(ldsp, g, S, E);
    }
    SEAM(18);
    if (IN(19)) { PHASE_VARS;
#pragma unroll 2
        for (int t = NMETA + gwave; t < L; t += nwaves) {
            const int s0 = slot[2 * t], s1 = slot[2 * t + 1]; const float g0 = gw[2 * t], g1 = gw[2 * t + 1];
            float y[16];
            combine_row(y, H3 + (size_t)t * D, Yb + (size_t)s0 * D, Yb + (size_t)s1 * D, g0, g1, lane);
            ln_row1024w(y, a.in[26] + D, a.in[27] + D, lane);
#pragma unroll
            for (int i4 = 0; i4 < 4; ++i4) *(float4*)(a.out + (size_t)(t - NMETA) * D + 256 * i4 + 4 * lane) = make_float4(y[4 * i4], y[4 * i4 + 1], y[4 * i4 + 2], y[4 * i4 + 3]);
        }
    }
#undef IN
#undef SEAM
}
constexpr int N_PHASES = 20;

extern "C" void kernel_launch(void* const* d_in, const int* in_sizes, int n_in, void* d_out, int out_size, void* d_ws, size_t ws_size, hipStream_t stream) {
    static int grid = 0;
    if (grid == 0) {
        if (n_in != 28 || out_size != SEQ * D || ws_size < WS_END) { fprintf(stderr, "kernel_launch: unexpected shapes n_in %d out %d ws %zu (need %zu)\n", n_in, out_size, ws_size, (size_t)WS_END); grid = -1; return; }
        int dev = 0, cus = 0;
        if (hipGetDevice(&dev) != hipSuccess || hipDeviceGetAttribute(&cus, hipDeviceAttributeMultiprocessorCount, dev) != hipSuccess) { grid = -1; return; }
        if (hipFuncSetAttribute((const void*)fwd, hipFuncAttributeMaxDynamicSharedMemorySize, LDS_BYTES) != hipSuccess) { fprintf(stderr, "kernel_launch: hipFuncSetAttribute failed\n"); grid = -1; return; }
        int per_cu = 0;
        if (hipOccupancyMaxActiveBlocksPerMultiprocessor(&per_cu, (const void*)fwd, NTHREADS, LDS_BYTES) != hipSuccess || per_cu < 1) fprintf(stderr, "kernel_launch: occupancy query says %d\n", per_cu);
        (void)hipGetLastError();
        grid = cus;
    }
    if (grid < 0) return;
    (void)hipMemsetAsync((char*)d_ws + WS_CTL, 0, CTL_BYTES, stream);
    Args a{};
    for (int i = 0; i < 28; ++i) a.in[i] = (const float*)d_in[i];
    a.out = (float*)d_out; a.ws = (unsigned char*)d_ws;
#if N_LAUNCH_MODE == 1
    a.ph_lo = 0; a.ph_hi = N_PHASES;
    hipLaunchKernelGGL(fwd, dim3(grid), dim3(NTHREADS), LDS_BYTES, stream, a);
#else
    for (int p = 0; p < N_PHASES; ++p) { a.ph_lo = p; a.ph_hi = p + 1; hipLaunchKernelGGL(fwd, dim3(grid), dim3(NTHREADS), LDS_BYTES, stream, a); }
#endif
}
```
